# Optimizing an MI355X kernel written in HIP

```python
import jax, jax.numpy as jnp
from jax import lax
import numpy as np

D_MODEL = 2048
BATCH = 16
SEQ = 2048
DEPTH = 2

HEAD_DIM = 64
D_MIX = D_MODEL
GROUP_WIDTH = D_MIX // 4
NORM_EPS = 1e-6
D_FF = 5632
FFN_RES_WEIGHT = 0.5

RWKV_HEADS = GROUP_WIDTH // HEAD_DIM
RWKV_W_RANK = 64
RWKV_A_RANK = 64
RWKV_G_RANK = 128
RWKV_LN_EPS = 64e-5

ATTN_HEADS = GROUP_WIDTH // HEAD_DIM
ATTN_KV_HEADS = 2
ATTN_WINDOW = 128
ATTN_BLOCK = 128
ROPE_THETA = 500000.0
ROPE_DIM = HEAD_DIM // 4

S5_CHANNELS = GROUP_WIDTH
S5_GROUP = 16
S5_GROUPS = S5_CHANNELS // S5_GROUP
S5_STATE = 64
S5_DT_MIN = 0.001
S5_DT_MAX = 0.1

HGRN_HEADS = GROUP_WIDTH // HEAD_DIM
HGRN_DK = 64
HGRN_DV = GROUP_WIDTH // HGRN_HEADS
HGRN_CHUNK = 16

RWKV_IN = 3 * GROUP_WIDTH + RWKV_W_RANK + RWKV_A_RANK + RWKV_G_RANK
ATTN_IN = (ATTN_HEADS + 2 * ATTN_KV_HEADS) * HEAD_DIM
S5_IN = S5_CHANNELS
HGRN_IN = 2 * HGRN_HEADS * HGRN_DK + 2 * HGRN_HEADS * HGRN_DV
D_IN = RWKV_IN + ATTN_IN + S5_IN + HGRN_IN

kernel_name = 'hybrid_parallel_head_groups_trunk'


def rmsnorm(x, g, eps=NORM_EPS):
    xf = x.astype(jnp.float32)
    y = xf * lax.rsqrt(jnp.mean(xf * xf, axis=-1, keepdims=True) + eps)
    return (y * g.astype(jnp.float32)).astype(x.dtype)


def swiglu_ffn(x, norm_g, w_gate, w_up, w_down):
    h = rmsnorm(x, norm_g)
    return (jax.nn.silu(h @ w_gate) * (h @ w_up)) @ w_down


def token_shift(p):
    return jnp.pad(p, ((0, 0), (1, 0), (0, 0)))[:, :-1]


def rwkv7_time_mix(p, mu, w0, w_up, a0, a_up, g_up, k_k, k_a, r_k, ln_w, ln_b):
    B_, S_, _ = p.shape
    H, N = RWKV_HEADS, HEAD_DIM
    f32 = jnp.float32
    p = p + (token_shift(p) - p) * mu
    cut = [GROUP_WIDTH, 2 * GROUP_WIDTH, 3 * GROUP_WIDTH,
           3 * GROUP_WIDTH + RWKV_W_RANK, 3 * GROUP_WIDTH + RWKV_W_RANK + RWKV_A_RANK]
    r, k, v, w_lo, a_lo, g_lo = jnp.split(p, cut, axis=-1)
    w_log = -jax.nn.softplus(-(w0 + jnp.tanh(w_lo) @ w_up)) - 0.5
    a = jax.nn.sigmoid(a0 + a_lo @ a_up)
    g = jax.nn.sigmoid(g_lo) @ g_up
    heads = lambda t: t.astype(f32).reshape(B_, S_, H, N)
    decay = jnp.exp(-jnp.exp(heads(w_log)))
    a = heads(a)
    kk = heads(k * k_k)
    kk = kk * lax.rsqrt(jnp.maximum(jnp.sum(kk * kk, axis=-1, keepdims=True), 1e-24))
    r, v = heads(r), heads(v)
    k = heads(k) * (1.0 + (a - 1.0) * k_a.astype(f32).reshape(H, N))
    xs = tuple(jnp.moveaxis(t, 1, 0) for t in (r, decay, k, v, kk, kk * a))

    def step(state, inp):
        r_t, w_t, k_t, v_t, kk_t, b_t = inp
        sa = jnp.einsum('bhij,bhj->bhi', state, -kk_t)
        state = (state * w_t[:, :, None, :] + sa[..., None] * b_t[:, :, None, :]
                 + v_t[..., None] * k_t[:, :, None, :])
        return state, jnp.einsum('bhij,bhj->bhi', state, r_t)

    _, ys = lax.scan(step, jnp.zeros((B_, H, N, N), f32), xs)
    o = jnp.moveaxis(ys, 0, 1)
    mean = jnp.mean(o, axis=-1, keepdims=True)
    var = jnp.mean(jnp.square(o - mean), axis=-1, keepdims=True)
    o = ((o - mean) * lax.rsqrt(var + RWKV_LN_EPS)).reshape(B_, S_, H * N) * ln_w + ln_b
    bonus = jnp.sum(r * k * r_k.astype(f32), axis=-1, keepdims=True) * v
    return ((o + bonus.reshape(B_, S_, H * N)) * g).astype(p.dtype)


def apply_partial_rope(x, cos, sin):
    half = ROPE_DIM // 2
    x1, x2, rest = x[..., :half], x[..., half:ROPE_DIM], x[..., ROPE_DIM:]
    return jnp.concatenate([x1 * cos - x2 * sin, x2 * cos + x1 * sin, rest], axis=-1)


def swa_sink_attention(p, positions, q_norm, k_norm, sinks):
    B_, S_, _ = p.shape
    H, KV, D = ATTN_HEADS, ATTN_KV_HEADS, HEAD_DIM
    G = H // KV
    f32 = jnp.float32
    q, k, v = jnp.split(p, [H * D, (H + KV) * D], axis=-1)
    q = rmsnorm(q.reshape(B_, S_, H, D), q_norm).astype(f32)
    k = rmsnorm(k.reshape(B_, S_, KV, D), k_norm).astype(f32)
    v = v.reshape(B_, S_, KV, D).astype(f32)
    inv_freq = ROPE_THETA ** (-jnp.arange(0, ROPE_DIM, 2, dtype=f32) / ROPE_DIM)
    ang = positions.astype(f32)[..., None] * inv_freq
    cos, sin = jnp.cos(ang)[:, :, None, :], jnp.sin(ang)[:, :, None, :]
    q = apply_partial_rope(q, cos, sin)
    k = apply_partial_rope(k, cos, sin)
    nb = S_ // ATTN_BLOCK
    qb = q.reshape(B_, nb, ATTN_BLOCK, KV, G, D) * (D ** -0.5)
    kb = k.reshape(B_, nb, ATTN_BLOCK, KV, D)
    vb = v.reshape(B_, nb, ATTN_BLOCK, KV, D)
    shift = lambda t: jnp.pad(t, ((0, 0), (1, 0), (0, 0), (0, 0), (0, 0)))[:, :-1]
    kcat = jnp.concatenate([shift(kb), kb], axis=2)
    vcat = jnp.concatenate([shift(vb), vb], axis=2)
    s = jnp.einsum('bnqhgd,bnkhd->bnhgqk', qb, kcat)
    blk = jnp.arange(nb)[:, None] * ATTN_BLOCK
    qpos = blk + jnp.arange(ATTN_BLOCK)[None, :]
    kpos = blk - ATTN_BLOCK + jnp.arange(2 * ATTN_BLOCK)[None, :]
    diff = qpos[:, :, None] - kpos[:, None, :]
    mask = (diff >= 0) & (diff < ATTN_WINDOW) & (kpos[:, None, :] >= 0)
    s = jnp.where(mask[None, :, None, None], s, -jnp.inf)
    sink = jnp.broadcast_to(sinks.astype(f32).reshape(1, 1, KV, G, 1, 1), s.shape[:-1] + (1,))
    probs = jax.nn.softmax(jnp.concatenate([s, sink], axis=-1), axis=-1)[..., :-1]
    o = jnp.einsum('bnhgqk,bnkhd->bnqhgd', probs, vcat)
    return o.reshape(B_, S_, H * D).astype(p.dtype)


def _linear_combine(e1, e2):
    a1, b1 = e1
    a2, b2 = e2
    return a1 * a2, a2 * b1 + b2


def s5_mix(u, lam_re, lam_im, log_step, b_re, b_im, c_re, c_im, d_skip, glu_w, glu_b):
    B_, S_, _ = u.shape
    f32 = jnp.float32
    uf = u.astype(f32)
    lam = lax.complex(lam_re.astype(f32), lam_im.astype(f32))
    dt = jnp.exp(log_step.astype(f32))[:, None]
    lam_bar = jnp.exp(lam * dt)
    b_bar = ((lam_bar - 1.0) / lam)[..., None] * lax.complex(b_re.astype(f32), b_im.astype(f32))
    c = lax.complex(c_re.astype(f32), c_im.astype(f32))
    ug = uf.reshape(B_, S_, S5_GROUPS, S5_GROUP)
    bu = jnp.einsum('gph,bsgh->bsgp', b_bar, ug.astype(jnp.complex64))
    a = jnp.broadcast_to(lam_bar, (1, S_, S5_GROUPS, S5_STATE))
    _, states = lax.associative_scan(_linear_combine, (a, bu), axis=1)
    y = jnp.einsum('ghp,bsgp->bsgh', c, states).real.reshape(B_, S_, S5_CHANNELS)
    y = y + d_skip.astype(f32) * uf
    z = jax.nn.gelu(y, approximate=False)
    out = z * jax.nn.sigmoid(z @ glu_w.astype(f32) + glu_b.astype(f32))
    return out.astype(u.dtype)


def hgrn2_mix(p, lower_bound, g_norm):
    B_, S_, _ = p.shape
    H, DK, DV, C = HGRN_HEADS, HGRN_DK, HGRN_DV, HGRN_CHUNK
    f32 = jnp.float32
    nc = S_ // C
    q, f, i, g = jnp.split(p, [H * DK, 2 * H * DK, 2 * H * DK + H * DV], axis=-1)
    q = jax.nn.silu(q.astype(f32)).reshape(B_, S_, H, DK) * (DK ** -0.5)
    lb = lower_bound.astype(f32).reshape(H, DK)
    f_gate = lb + (1.0 - lb) * jax.nn.sigmoid(f.astype(f32).reshape(B_, S_, H, DK))
    log_f = jnp.log(f_gate)
    k = 1.0 - f_gate
    v = i.astype(f32).reshape(B_, S_, H, DV)
    to_chunks = lambda t: t.reshape(B_, nc, C, H, t.shape[-1]).transpose(0, 3, 1, 2, 4)
    qc, kc, vc, lfc = to_chunks(q), to_chunks(k), to_chunks(v), to_chunks(log_f)
    b = jnp.cumsum(lfc, axis=3)
    bm = b[:, :, :, C // 2 - 1:C // 2]
    att = jnp.einsum('bhnid,bhnjd->bhnij', qc * jnp.exp(b - bm), kc * jnp.exp(bm - b))
    tri = jnp.tril(jnp.ones((C, C), dtype=bool))
    o_intra = jnp.einsum('bhnij,bhnjv->bhniv', jnp.where(tri, att, 0.0), vc)
    b_last = b[:, :, :, -1]
    kv = jnp.einsum('bhnjd,bhnjv->bhndv', kc * jnp.exp(b_last[:, :, :, None] - b), vc)

    def step(state, inp):
        dec, kv_n = inp
        return state * dec[..., None] + kv_n, state

    _, s_prev = lax.scan(step, jnp.zeros((B_, H, DK, DV), f32),
                         (jnp.moveaxis(jnp.exp(b_last), 2, 0), jnp.moveaxis(kv, 2, 0)))
    o_inter = jnp.einsum('bhnid,nbhdv->bhniv', qc * jnp.exp(b), s_prev)
    o = (o_intra + o_inter).transpose(0, 2, 3, 1, 4).reshape(B_, S_, H, DV)
    o = rmsnorm(o, g_norm) * jax.nn.silu(g.astype(f32).reshape(B_, S_, H, DV))
    return o.reshape(B_, S_, H * DV).astype(p.dtype)


def setup_inputs(seed: int = 0) -> dict:
    key = jax.random.key(seed)
    ks = iter(jax.random.split(key, 40))
    f32 = jnp.float32
    L, D, F, GW = DEPTH, D_MODEL, D_FF, GROUP_WIDTH
    nrm = lambda shape, scale: scale * jax.random.normal(next(ks), shape, f32)
    gain = lambda shape: 1.0 + 0.05 * jax.random.normal(next(ks), shape, f32)
    uni = lambda shape, lo, hi: jax.random.uniform(next(ks), shape, f32, lo, hi)
    x = jax.random.normal(next(ks), (BATCH, SEQ, D), f32)
    positions = (jnp.arange(SEQ, dtype=jnp.int32)[None, :]
                 + jax.random.randint(next(ks), (BATCH, 1), 0, 4096, dtype=jnp.int32))
    return {
        'x': x,
        'positions': positions,
        'ffn1_norm': gain((L, D)),
        'ffn1_w_gate': nrm((L, D, F), D ** -0.5),
        'ffn1_w_up': nrm((L, D, F), D ** -0.5),
        'ffn1_w_down': nrm((L, F, D), F ** -0.5),
        'mix_norm': gain((L, D)),
        'w_in': nrm((L, D, D_IN), D ** -0.5),
        'rwkv_mu': uni((L, RWKV_IN), 0.0, 1.0),
        'rwkv_w0': uni((L, GW), -6.5, -1.5),
        'rwkv_w_up': nrm((L, RWKV_W_RANK, GW), 0.5 * RWKV_W_RANK ** -0.5),
        'rwkv_a0': nrm((L, GW), 0.1),
        'rwkv_a_up': nrm((L, RWKV_A_RANK, GW), RWKV_A_RANK ** -0.5),
        'rwkv_g_up': nrm((L, RWKV_G_RANK, GW), RWKV_G_RANK ** -0.5),
        'rwkv_k_k': 0.85 + nrm((L, GW), 0.05),
        'rwkv_k_a': 1.0 + nrm((L, GW), 0.05),
        'rwkv_r_k': nrm((L, RWKV_HEADS, HEAD_DIM), 0.1),
        'rwkv_ln_w': gain((L, GW)),
        'rwkv_ln_b': nrm((L, GW), 0.02),
        'attn_q_norm': gain((L, HEAD_DIM)),
        'attn_k_norm': gain((L, HEAD_DIM)),
        'attn_sinks': nrm((L, ATTN_HEADS), 0.5),
        's5_lambda_re': -0.5 + nrm((L, S5_GROUPS, S5_STATE), 0.01),
        's5_lambda_im': (jnp.pi * jnp.arange(S5_STATE, dtype=f32))[None, None, :] + nrm((L, S5_GROUPS, S5_STATE), 0.01),
        's5_log_step': uni((L, S5_GROUPS), float(np.log(S5_DT_MIN)), float(np.log(S5_DT_MAX))),
        's5_b_re': nrm((L, S5_GROUPS, S5_STATE, S5_GROUP), (2 * S5_GROUP) ** -0.5),
        's5_b_im': nrm((L, S5_GROUPS, S5_STATE, S5_GROUP), (2 * S5_GROUP) ** -0.5),
        's5_c_re': nrm((L, S5_GROUPS, S5_GROUP, S5_STATE), (2 * S5_STATE) ** -0.5),
        's5_c_im': nrm((L, S5_GROUPS, S5_GROUP, S5_STATE), (2 * S5_STATE) ** -0.5),
        's5_d': nrm((L, S5_CHANNELS), 0.5),
        's5_glu_w': nrm((L, S5_CHANNELS, S5_CHANNELS), S5_CHANNELS ** -0.5),
        's5_glu_b': nrm((L, S5_CHANNELS), 0.02),
        'hgrn_lower_bounds': nrm((L, HGRN_HEADS * HGRN_DK), 0.1),
        'hgrn_g_norm': gain((L, HGRN_DV)),
        'w_out': nrm((L, D_MIX, D), D_MIX ** -0.5),
        'ffn2_norm': gain((L, D)),
        'ffn2_w_gate': nrm((L, D, F), D ** -0.5),
        'ffn2_w_up': nrm((L, D, F), D ** -0.5),
        'ffn2_w_down': nrm((L, F, D), F ** -0.5),
    }


def reference(x, positions, ffn1_norm, ffn1_w_gate, ffn1_w_up, ffn1_w_down, mix_norm, w_in,
              rwkv_mu, rwkv_w0, rwkv_w_up, rwkv_a0, rwkv_a_up, rwkv_g_up, rwkv_k_k, rwkv_k_a,
              rwkv_r_k, rwkv_ln_w, rwkv_ln_b, attn_q_norm, attn_k_norm, attn_sinks,
              s5_lambda_re, s5_lambda_im, s5_log_step, s5_b_re, s5_b_im, s5_c_re, s5_c_im,
              s5_d, s5_glu_w, s5_glu_b, hgrn_lower_bounds, hgrn_g_norm, w_out,
              ffn2_norm, ffn2_w_gate, ffn2_w_up, ffn2_w_down):
    lb_all = jnp.cumsum(jax.nn.softmax(hgrn_lower_bounds.astype(jnp.float32), axis=0), axis=0)
    lb_all = lb_all - lb_all[0]
    cut = [RWKV_IN, RWKV_IN + ATTN_IN, RWKV_IN + ATTN_IN + S5_IN]
    for l in range(DEPTH):
        x = x + FFN_RES_WEIGHT * swiglu_ffn(x, ffn1_norm[l], ffn1_w_gate[l], ffn1_w_up[l], ffn1_w_down[l])
        h = rmsnorm(x, mix_norm[l])
        proj = h @ w_in[l]
        p_a, p_b, p_c, p_d = jnp.split(proj, cut, axis=-1)
        y_a = rwkv7_time_mix(p_a, rwkv_mu[l], rwkv_w0[l], rwkv_w_up[l], rwkv_a0[l], rwkv_a_up[l],
                             rwkv_g_up[l], rwkv_k_k[l], rwkv_k_a[l], rwkv_r_k[l], rwkv_ln_w[l], rwkv_ln_b[l])
        y_b = swa_sink_attention(p_b, positions, attn_q_norm[l], attn_k_norm[l], attn_sinks[l])
        y_c = s5_mix(p_c, s5_lambda_re[l], s5_lambda_im[l], s5_log_step[l], s5_b_re[l], s5_b_im[l],
                     s5_c_re[l], s5_c_im[l], s5_d[l], s5_glu_w[l], s5_glu_b[l])
        y_d = hgrn2_mix(p_d, lb_all[l], hgrn_g_norm[l])
        x = x + jnp.concatenate([y_a, y_b, y_c, y_d], axis=-1) @ w_out[l]
        x = x + FFN_RES_WEIGHT * swiglu_ffn(x, ffn2_norm[l], ffn2_w_gate[l], ffn2_w_up[l], ffn2_w_down[l])
    return x
```

```cpp
#include <hip/hip_runtime.h>
#include <hip/hip_cooperative_groups.h>
#include <cstdio>
#include <cstdint>
namespace cg = cooperative_groups;

#ifndef ONE_LAUNCH
#define ONE_LAUNCH 1
#endif

#define LAS __attribute__((address_space(3)))
typedef unsigned short bf16_t;
typedef short bf16x8 __attribute__((ext_vector_type(8)));
typedef float f32x4 __attribute__((ext_vector_type(4)));
typedef float f32x2 __attribute__((ext_vector_type(2)));
typedef unsigned u32x4 __attribute__((ext_vector_type(4)));
typedef unsigned u32x2 __attribute__((ext_vector_type(2)));

constexpr int T = 32768, SEQ = 2048, NB = 16, D = 2048, FF = 5632, DIN = 5120, NL = 2;
constexpr int C_RWKV = 0, C_ATT = 1792, C_S5 = 2560, C_HG = 3072;
constexpr int NTHREADS = 512, NWAVES = 8;

constexpr size_t SZ_UP = (size_t)2 * FF * D * 2, SZ_DN = (size_t)D * FF * 2, SZ_IN = (size_t)DIN * D * 2, SZ_LR = (size_t)1536 * 256 * 2,
                 SZ_GLU = (size_t)512 * 512 * 2, SZ_OUT = (size_t)D * D * 2;
constexpr size_t W_UP1 = 0, W_DN1 = W_UP1 + SZ_UP, W_IN = W_DN1 + SZ_DN, W_LR = W_IN + SZ_IN, W_GLU = W_LR + SZ_LR, W_OUT = W_GLU + SZ_GLU,
                 W_UP2 = W_OUT + SZ_OUT, W_DN2 = W_UP2 + SZ_UP, W_END = W_DN2 + SZ_DN;
constexpr size_t WS_XN = W_END, WS_BIG = WS_XN + (size_t)T * D * 2;
constexpr size_t WS_HID = WS_BIG;
constexpr size_t WS_PROJ = WS_BIG, WS_LRO = WS_PROJ + (size_t)T * DIN * 2, WS_ALR = WS_LRO + (size_t)T * 1536 * 2, WS_Z = WS_ALR + (size_t)T * 256 * 2,
                 WS_OR = WS_Z + (size_t)T * 512 * 2, WS_OH = WS_OR + (size_t)T * 512 * 4, WS_BON = WS_OH + (size_t)T * 512 * 4, WS_END = WS_BON + (size_t)T * 8 * 4;
static_assert(WS_END <= (size_t)1 << 30, "workspace");
static_assert(WS_HID + (size_t)T * FF * 2 <= (size_t)1 << 30, "workspace");

constexpr int LDS_BYTES = 135168;

struct Args { const void* in[39]; float* out; unsigned char* ws; };

__device__ __forceinline__ unsigned pk2(float lo, float hi) { unsigned r; asm volatile("v_cvt_pk_bf16_f32 %0, %1, %2" : "=v"(r) : "v"(lo), "v"(hi)); return r; }
__device__ __forceinline__ float bflo(unsigned w) { return __uint_as_float(w << 16); }
__device__ __forceinline__ float bfhi(unsigned w) { return __uint_as_float(w & 0xffff0000u); }
__device__ __forceinline__ void unpack8(u32x4 q, float* f) { f[0] = bflo(q.x); f[1] = bfhi(q.x); f[2] = bflo(q.y); f[3] = bfhi(q.y); f[4] = bflo(q.z); f[5] = bfhi(q.z); f[6] = bflo(q.w); f[7] = bfhi(q.w); }
__device__ __forceinline__ u32x4 pack8(const float* f) { u32x4 o; o.x = pk2(f[0], f[1]); o.y = pk2(f[2], f[3]); o.z = pk2(f[4], f[5]); o.w = pk2(f[6], f[7]); return o; }
template <int CTRL> __device__ __forceinline__ float dpp(float x) { return __builtin_bit_cast(float, __builtin_amdgcn_mov_dpp(__builtin_bit_cast(int, x), CTRL, 0xf, 0xf, true)); }
constexpr int XOR1 = 0xB1, XOR2 = 0x4E, XOR7 = 0x141, XOR8 = 0x128;
__device__ __forceinline__ float red8(float v) { v += dpp<XOR1>(v); v += dpp<XOR2>(v); v += dpp<XOR7>(v); return v; }
__device__ __forceinline__ float red16(float v) { v = red8(v); v += dpp<XOR8>(v); return v; }
__device__ __forceinline__ float wave_sum(float v) {
#pragma unroll
    for (int o = 1; o < 64; o <<= 1) v += __shfl_xor(v, o);
    return v;
}
__device__ __forceinline__ float sigmoidf_(float x) { return 1.0f / (1.0f + __expf(-x)); }
__device__ __forceinline__ float siluf_(float x) { return x / (1.0f + __expf(-x)); }
__device__ __forceinline__ int opaque_tid() { int t = threadIdx.x; asm volatile("" : "+v"(t)); return t; }
__device__ __forceinline__ int opaque_bid() { int t = blockIdx.x; asm volatile("" : "+s"(t)); return t; }
#define LDS_FENCE() asm volatile("s_waitcnt lgkmcnt(0)" ::: "memory")
__device__ __forceinline__ void sincos_big(float x, float& sn, float& cs) {
    const float n = rintf(x * 0.15915494309189535f);
    float r = fmaf(-n, 6.28318548202514648f, x); r = fmaf(-n, -1.7484555e-7f, r);
    sn = __sinf(r); cs = __cosf(r);
}

namespace pg8 {
constexpr int BM = 256, BK = 64, HALF = 128, HTB = HALF * BK * 2, STAGE_BYTES = 8 * HTB, NXCD = 8, WGM = 8;
__host__ __device__ __forceinline__ int lds_byte(int r, int c) { const int st = (r >> 4) * 2 + (c >> 5), rr = r & 15, cc = c & 31, ob = rr * 64 + cc * 2; return st * 1024 + (ob ^ (((ob >> 9) & 1) << 5)); }
__host__ __device__ __forceinline__ void stage_rc(int b, int& R, int& C) { const int st = b / 1024, sb = b % 1024, swz = sb ^ (((sb >> 9) & 1) << 5); R = (st >> 1) * 16 + swz / 64; C = (st & 1) * 32 + (swz % 64) / 2; }
__host__ __device__ __forceinline__ int perm32(int rho) { const int n = rho >> 4, i = rho & 15; return 8 * (i >> 2) + 4 * n + (i & 3); }
struct Unit { int pm, pn; };
struct Gemm { const bf16_t* A; const bf16_t* Bt; int M, N, K; };
struct StaticOrder {
    int nM, nN, nwg, G, c;
    __device__ void init(int M, int N, int G_, int c_) { nM = M / BM; nN = N / BM; nwg = nM * nN; G = G_; c = c_; }
    __device__ bool next(int i, Unit& u) const {
        const long L = (long)i * G + c; if (L >= nwg) return false;
        int wgid = (int)L; { const int q = nwg / NXCD, r = nwg % NXCD, xcd = wgid % NXCD, off = wgid / NXCD; wgid = (xcd < r ? xcd * (q + 1) : r * (q + 1) + (xcd - r) * q) + off; }
        const int nig = WGM * nN, gid = wgid / nig, fm = gid * WGM, gsz = (nM - fm) < WGM ? (nM - fm) : WGM;
        u.pm = fm + ((wgid % nig) % gsz); u.pn = (wgid % nig) / gsz; return true;
    }
};
template <class Epi>
__device__ __forceinline__ void gemm_phase(LAS unsigned char* lds, const Gemm g, const StaticOrder& S, const Epi& E) {
    const int TID = opaque_tid(), BID = opaque_bid(); (void)TID; (void)BID;
    const int tid = TID, wid = __builtin_amdgcn_readfirstlane(tid >> 6), lane = tid & 63, wr = wid >> 2, wc = wid & 3, fr = lane & 15, fq = lane >> 4;
    const int K = g.K, nt = K / BK;
    unsigned voffA[2], voffB[2];
#pragma unroll
    for (int i = 0; i < 2; ++i) { int R, C; stage_rc(tid * 16 + i * 8192, R, C); const int Rb = Epi::PERM ? ((R & ~31) + perm32(R & 31)) : R;
        voffA[i] = (unsigned)(R * K + C) * 2u; voffB[i] = (unsigned)(Rb * K + C) * 2u; }
    const size_t kstep = (size_t)(BK * 2);
    const size_t hstep = (size_t)HALF * K * 2;
    const size_t tstep = 2 * hstep;
    const unsigned ldsw = (unsigned)wid * 1024u;
    const int aoff = lds_byte(wr * 64 + fr, fq * 8), boff = lds_byte(wc * 32 + fr, fq * 8);
#define PG8_SA(b, h) (((b) * 2 + (h)) * HTB)
#define PG8_SB(b, h) ((4 + (b) * 2 + (h)) * HTB)
#define PG8_STAGE(bufoff, gbase, voff) do { _Pragma("unroll") for (int _i = 0; _i < 2; ++_i) \
        __builtin_amdgcn_global_load_lds((const unsigned*)((const char*)(gbase) + (voff)[_i]), (LAS unsigned*)(lds + (bufoff) + ldsw + _i * 8192), 16, 0, 0); } while (0)
#define PG8_LDA(dst, b, h) do { _Pragma("unroll") for (int m = 0; m < 4; ++m) _Pragma("unroll") for (int k = 0; k < 2; ++k) dst[m][k] = *(const LAS bf16x8*)(lds + PG8_SA(b, h) + aoff + m * 2048 + k * 1024); } while (0)
#define PG8_LDB(dst, b, h) do { _Pragma("unroll") for (int n = 0; n < 2; ++n) _Pragma("unroll") for (int k = 0; k < 2; ++k) dst[n][k] = *(const LAS bf16x8*)(lds + PG8_SB(b, h) + boff + n * 2048 + k * 1024); } while (0)
#define PG8_MMA(ai, bj, At, Bt) do { __builtin_amdgcn_s_setprio(1); _Pragma("unroll") for (int m = 0; m < 4; ++m) _Pragma("unroll") for (int n = 0; n < 2; ++n) _Pragma("unroll") for (int k = 0; k < 2; ++k) \
        acc[ai][bj][m][n] = __builtin_amdgcn_mfma_f32_16x16x32_bf16(Bt[n][k], At[m][k], acc[ai][bj][m][n], 0, 0, 0); __builtin_amdgcn_s_setprio(0); } while (0)
#define PG8_WAIT_V(n) asm volatile("s_waitcnt vmcnt(" #n ")" ::: "memory")
#define PG8_WAIT_L(n) asm volatile("s_waitcnt lgkmcnt(" #n ")" ::: "memory")
#define PG8_BAR __builtin_amdgcn_s_barrier()
#define PG8_SCHED __builtin_amdgcn_sched_barrier(0)
    Unit cur, nxt; int ui = 0;
    if (!S.next(0, cur)) return;
    f32x4 acc[2][2][4][2];
#pragma unroll
    for (int a = 0; a < 2; ++a)
#pragma unroll
        for (int b = 0; b < 2; ++b)
#pragma unroll
            for (int m = 0; m < 4; ++m)
#pragma unroll
                for (int n = 0; n < 2; ++n) acc[a][b][m][n] = (f32x4){0.f, 0.f, 0.f, 0.f};
    bf16x8 At[4][2], B0[2][2], B1[2][2];
    const char* cA = (const char*)g.A + (size_t)cur.pm * tstep; const char* cB = (const char*)g.Bt + (size_t)cur.pn * tstep;
    PG8_STAGE(PG8_SB(0, 0), cB, voffB); PG8_STAGE(PG8_SA(0, 0), cA, voffA); PG8_STAGE(PG8_SB(0, 1), cB + hstep, voffB); PG8_STAGE(PG8_SA(0, 1), cA + hstep, voffA);
    if (wr == 1) PG8_BAR;
    PG8_WAIT_V(4); PG8_BAR;
    PG8_STAGE(PG8_SB(1, 0), cB + kstep, voffB); PG8_STAGE(PG8_SA(1, 0), cA + kstep, voffA); PG8_STAGE(PG8_SB(1, 1), cB + hstep + kstep, voffB);
    PG8_WAIT_V(6); PG8_BAR;
    for (;;) {
        const bool has_next = S.next(ui + 1, nxt);
        const char* nA = has_next ? (const char*)g.A + (size_t)nxt.pm * tstep : cA; const char* nB = has_next ? (const char*)g.Bt + (size_t)nxt.pn * tstep : cB;
#pragma unroll 1
        for (int t = 0; t < nt; t += 2) {
            const bool last = (t == nt - 2);
            const char* a1 = cA + (size_t)(t + 1) * kstep;
            const char* a2 = last ? nA : cA + (size_t)(t + 2) * kstep; const char* b2 = last ? nB : cB + (size_t)(t + 2) * kstep;
            const char* a3 = a2 + kstep; const char* b3 = b2 + kstep;
            PG8_LDB(B0, 0, 0); PG8_SCHED; PG8_LDA(At, 0, 0); PG8_STAGE(PG8_SA(1, 1), a1 + hstep, voffA);
            PG8_WAIT_L(8); PG8_BAR; PG8_WAIT_L(0); PG8_MMA(0, 0, At, B0); PG8_BAR; PG8_SCHED;
            PG8_LDB(B1, 0, 1); PG8_STAGE(PG8_SB(0, 0), b2, voffB);
            PG8_BAR; PG8_WAIT_L(0); PG8_MMA(0, 1, At, B1); PG8_BAR;
            PG8_LDA(At, 0, 1); PG8_STAGE(PG8_SA(0, 0), a2, voffA);
            PG8_BAR; PG8_WAIT_L(0); PG8_MMA(1, 0, At, B0); PG8_BAR; PG8_SCHED;
            PG8_STAGE(PG8_SB(0, 1), b2 + hstep, voffB);
            PG8_WAIT_V(6); PG8_BAR; PG8_MMA(1, 1, At, B1); PG8_BAR;
            PG8_LDB(B0, 1, 0); PG8_SCHED; PG8_LDA(At, 1, 0); PG8_STAGE(PG8_SA(0, 1), a2 + hstep, voffA);
            PG8_WAIT_L(8); PG8_BAR; PG8_WAIT_L(0); PG8_MMA(0, 0, At, B0); PG8_BAR; PG8_SCHED;
            PG8_LDB(B1, 1, 1); PG8_STAGE(PG8_SB(1, 0), b3, voffB);
            PG8_BAR; PG8_WAIT_L(0); PG8_MMA(0, 1, At, B1); PG8_BAR;
            PG8_LDA(At, 1, 1); PG8_STAGE(PG8_SA(1, 0), a3, voffA);
            PG8_BAR; PG8_WAIT_L(0); PG8_MMA(1, 0, At, B0); PG8_BAR; PG8_SCHED;
            PG8_STAGE(PG8_SB(1, 1), b3 + hstep, voffB);
            PG8_WAIT_V(6); PG8_BAR; PG8_MMA(1, 1, At, B1); PG8_BAR;
        }
        E(acc, cur, wr, wc, fr, fq);
        if (!has_next) break;
#pragma unroll
        for (int a = 0; a < 2; ++a)
#pragma unroll
            for (int b = 0; b < 2; ++b)
#pragma unroll
                for (int m = 0; m < 4; ++m)
#pragma unroll
                    for (int n = 0; n < 2; ++n) acc[a][b][m][n] = (f32x4){0.f, 0.f, 0.f, 0.f};
        cur = nxt; cA = nA; cB = nB; ++ui;
    }
    PG8_WAIT_V(0);
    if (wr == 0) PG8_BAR;
    PG8_BAR;
#undef PG8_SA
#undef PG8_SB
#undef PG8_STAGE
#undef PG8_LDA
#undef PG8_LDB
#undef PG8_MMA
#undef PG8_WAIT_V
#undef PG8_WAIT_L
#undef PG8_BAR
#undef PG8_SCHED
}

struct EpiSwiGLU {
    static constexpr bool PERM = true;
    bf16_t* H;
    __device__ __forceinline__ void operator()(const f32x4 (&acc)[2][2][4][2], const Unit& u, int wr, int wc, int fr, int fq) const {
        const int row0 = u.pm * BM + wr * 64 + fr, col0 = u.pn * 128 + wc * 32 + 8 * fq;
#pragma unroll
        for (int ai = 0; ai < 2; ++ai)
#pragma unroll
            for (int m = 0; m < 4; ++m) {
                float v[8];
#pragma unroll
                for (int n = 0; n < 2; ++n)
#pragma unroll
                    for (int j = 0; j < 4; ++j) { const float gt = acc[ai][0][m][n][j], up = acc[ai][1][m][n][j]; v[4 * n + j] = siluf_(gt) * up; }
                *(u32x4*)(H + (size_t)(row0 + ai * HALF + m * 16) * FF + col0) = pack8(v);
            }
    }
};
struct EpiResidual {
    static constexpr bool PERM = false;
    const float* base; float* out; float scale;
    __device__ __forceinline__ void operator()(const f32x4 (&acc)[2][2][4][2], const Unit& u, int wr, int wc, int fr, int fq) const {
        const int row0 = u.pm * BM + wr * 64 + fr, col0 = u.pn * BM + wc * 32 + 4 * fq;
#pragma unroll
        for (int ai = 0; ai < 2; ++ai)
#pragma unroll
            for (int m = 0; m < 4; ++m) { const size_t ro = (size_t)(row0 + ai * HALF + m * 16) * D + col0;
#pragma unroll
                for (int bj = 0; bj < 2; ++bj)
#pragma unroll
                    for (int n = 0; n < 2; ++n) { const f32x4 b = *(const f32x4*)(base + ro + bj * HALF + n * 16); *(f32x4*)(out + ro + bj * HALF + n * 16) = b + acc[ai][bj][m][n] * scale; } }
    }
};
struct EpiBf16 {
    static constexpr bool PERM = true;
    bf16_t* O; int ldc;
    __device__ __forceinline__ void operator()(const f32x4 (&acc)[2][2][4][2], const Unit& u, int wr, int wc, int fr, int fq) const {
        const int row0 = u.pm * BM + wr * 64 + fr, col0 = u.pn * BM + wc * 32 + 8 * fq;
#pragma unroll
        for (int ai = 0; ai < 2; ++ai)
#pragma unroll
            for (int m = 0; m < 4; ++m) { bf16_t* rowp = O + (size_t)(row0 + ai * HALF + m * 16) * ldc + col0;
#pragma unroll
                for (int bj = 0; bj < 2; ++bj) { const f32x4 v0 = acc[ai][bj][m][0], v1 = acc[ai][bj][m][1];
                    u32x4 w; w.x = pk2(v0[0], v0[1]); w.y = pk2(v0[2], v0[3]); w.z = pk2(v1[0], v1[1]); w.w = pk2(v1[2], v1[3]);
                    *(u32x4*)(rowp + bj * HALF) = w; } }
    }
};
struct EpiLR {
    static constexpr bool PERM = true;
    bf16_t* O; const float* w0; const float* a0;
    template <int KIND> __device__ __forceinline__ void body(const f32x4 (&acc)[2][2][4][2], const float* bp, int row0, int col0) const {
#pragma unroll
        for (int bj = 0; bj < 2; ++bj) {
            f32x4 b0 = (f32x4){0.f, 0.f, 0.f, 0.f}, b1 = b0;
            if (KIND < 2) { b0 = *(const f32x4*)(bp + bj * HALF); b1 = *(const f32x4*)(bp + bj * HALF + 4); }
#pragma unroll
            for (int ai = 0; ai < 2; ++ai)
#pragma unroll
                for (int m = 0; m < 4; ++m) {
                    u32x4 w;
#pragma unroll
                    for (int n = 0; n < 2; ++n) {
                        float r[4];
#pragma unroll
                        for (int j = 0; j < 4; ++j) { const float x = acc[ai][bj][m][n][j] + (n == 0 ? b0[j] : b1[j]);
                            if (KIND == 0) { const float e = __expf(-x); r[j] = -0.60653065971f / (1.0f + e); }
                            else if (KIND == 1) r[j] = 1.0f / (1.0f + __expf(-x)); else r[j] = x; }
                        if (n == 0) { w.x = pk2(r[0], r[1]); w.y = pk2(r[2], r[3]); } else { w.z = pk2(r[0], r[1]); w.w = pk2(r[2], r[3]); }
                    }
                    *(u32x4*)(O + (size_t)(row0 + ai * HALF + m * 16) * 1536 + col0 + bj * HALF) = w;
                }
        }
    }
    __device__ __forceinline__ void operator()(const f32x4 (&acc)[2][2][4][2], const Unit& u, int wr, int wc, int fr, int fq) const {
        const int row0 = u.pm * BM + wr * 64 + fr, col0 = u.pn * BM + wc * 32 + 8 * fq, kind = u.pn >> 1, f0 = col0 - 512 * kind;
        if (kind == 0) body<0>(acc, w0 + f0, row0, col0); else if (kind == 1) body<1>(acc, a0 + f0, row0, col0); else body<2>(acc, nullptr, row0, col0);
    }
};
struct EpiGLU {
    static constexpr bool PERM = true;
    const bf16_t* Z; bf16_t* Y; const float* b;
    __device__ __forceinline__ void operator()(const f32x4 (&acc)[2][2][4][2], const Unit& u, int wr, int wc, int fr, int fq) const {
        const int row0 = u.pm * BM + wr * 64 + fr, col0 = u.pn * BM + wc * 32 + 8 * fq;
#pragma unroll
        for (int bj = 0; bj < 2; ++bj) {
            const f32x4 bias0 = *(const f32x4*)(b + col0 + bj * HALF), bias1 = *(const f32x4*)(b + col0 + bj * HALF + 4);
#pragma unroll
            for (int ai = 0; ai < 2; ++ai)
#pragma unroll
                for (int m = 0; m < 4; ++m) { const size_t r = (size_t)(row0 + ai * HALF + m * 16);
                    float z[8], v[8]; unpack8(*(const u32x4*)(Z + r * 512 + col0 + bj * HALF), z);
#pragma unroll
                    for (int n = 0; n < 2; ++n)
#pragma unroll
                        for (int j = 0; j < 4; ++j) v[4 * n + j] = z[4 * n + j] * sigmoidf_(acc[ai][bj][m][n][j] + (n == 0 ? bias0[j] : bias1[j]));
                    *(u32x4*)(Y + r * D + 1024 + col0 + bj * HALF) = pack8(v); }
        }
    }
};
}

template <class Epi> __device__ __forceinline__ void run_gemm(LAS unsigned char* lds, const bf16_t* A, const bf16_t* Bt, int N, int K, const Epi& E) {
    pg8::Gemm g; g.A = A; g.Bt = Bt; g.M = T; g.N = N; g.K = K;
    pg8::StaticOrder S; S.init(T, N, gridDim.x, opaque_bid());
    pg8::gemm_phase<Epi>(lds, g, S, E);
}

__device__ __forceinline__ void tr_item(const float* W, int ldw, int k0, int n0, const float* gs, bf16_t* Dst, int ldd, int drow0, int dk0, LAS float* scr, int lane) {
    if (W) {
#pragma unroll 8
        for (int i = 0; i < 32; ++i) { const int kk = 2 * i + (lane >> 5); float v = W[(size_t)(k0 + kk) * ldw + n0 + (lane & 31)]; if (gs) v *= gs[k0 + kk]; scr[kk * 33 + (lane & 31)] = v; }
    } else {
#pragma unroll 8
        for (int i = 0; i < 32; ++i) { const int kk = 2 * i + (lane >> 5); scr[kk * 33 + (lane & 31)] = 0.f; }
    }
    LDS_FENCE();
    const int c = lane & 7;
#pragma unroll
    for (int j = 0; j < 4; ++j) { const int n = (lane >> 3) + 8 * j; const LAS float* s = scr + (8 * c) * 33 + n;
        u32x4 o; o.x = pk2(s[0 * 33], s[1 * 33]); o.y = pk2(s[2 * 33], s[3 * 33]); o.z = pk2(s[4 * 33], s[5 * 33]); o.w = pk2(s[6 * 33], s[7 * 33]);
        *(u32x4*)(Dst + (size_t)(drow0 + n) * ldd + dk0 + k0 - 0 + 8 * c - 0) = o; }
    LDS_FENCE();
}

__device__ __forceinline__ void conv_phase(const Args& a, int l, LAS unsigned char* lds) {
    const int TID = opaque_tid(), BID = opaque_bid(); (void)TID; (void)BID;
    const int wave = TID >> 6, lane = TID & 63;
    LAS float* scr = (LAS float*)(lds + wave * 8704);
    const int gw = BID * NWAVES + wave, NGW = gridDim.x * NWAVES;
    unsigned char* ws = a.ws;
    constexpr int I_GU = (D / 64) * (FF / 32), I_DN = (FF / 64) * (D / 32), I_IN = (D / 64) * (DIN / 32), I_OUT = (D / 64) * (D / 32), I_GLU = 8 * 16, I_LR = 48 * 4;
    constexpr int NITEMS = 6 * I_GU + I_IN + I_OUT + I_GLU + I_LR;
    static_assert(I_GU == I_DN, "items");
    for (int it = gw; it < NITEMS; it += NGW) {
        int r = it;
        if (r < 6 * I_GU) {
            const int which = r / I_GU; r -= which * I_GU;
            const int f = which >= 3, m = which % 3;
            if (m < 2) {
                const float* W = (const float*)a.in[(f ? 36 : 3) + m] + (size_t)l * D * FF;
                const float* gs = (const float*)a.in[f ? 35 : 2] + (size_t)l * D;
                bf16_t* dst = (bf16_t*)(ws + (f ? W_UP2 : W_UP1));
                const int nblk = FF / 32, kb = r / nblk, nb = r % nblk, n0 = 32 * nb;
                tr_item(W, FF, 64 * kb, n0, gs, dst, D, (n0 >> 7) * 256 + (n0 & 127) + 128 * m, 0, scr, lane);
            } else {
                const float* W = (const float*)a.in[f ? 38 : 5] + (size_t)l * FF * D;
                bf16_t* dst = (bf16_t*)(ws + (f ? W_DN2 : W_DN1));
                const int nblk = D / 32, kb = r / nblk, nb = r % nblk;
                tr_item(W, D, 64 * kb, 32 * nb, nullptr, dst, FF, 32 * nb, 0, scr, lane);
            }
            continue;
        }
        r -= 6 * I_GU;
        if (r < I_IN) { const int nblk = DIN / 32, kb = r / nblk, nb = r % nblk;
            tr_item((const float*)a.in[7] + (size_t)l * D * DIN, DIN, 64 * kb, 32 * nb, (const float*)a.in[6] + (size_t)l * D, (bf16_t*)(ws + W_IN), D, 32 * nb, 0, scr, lane); continue; }
        r -= I_IN;
        if (r < I_OUT) { const int nblk = D / 32, kb = r / nblk, nb = r % nblk;
            tr_item((const float*)a.in[34] + (size_t)l * D * D, D, 64 * kb, 32 * nb, nullptr, (bf16_t*)(ws + W_OUT), D, 32 * nb, 0, scr, lane); continue; }
        r -= I_OUT;
        if (r < I_GLU) { const int kb = r / 16, nb = r % 16;
            tr_item((const float*)a.in[30] + (size_t)l * 512 * 512, 512, 64 * kb, 32 * nb, nullptr, (bf16_t*)(ws + W_GLU), 512, 32 * nb, 0, scr, lane); continue; }
        r -= I_GLU;
        {
            const int nb = r >> 2, kb = r & 3, kind = nb >> 4, nn0 = 32 * (nb & 15);
            const float* W = nullptr; int k0 = 0;
            if (kind == 0 && kb == 0) { W = (const float*)a.in[10] + (size_t)l * 64 * 512; k0 = 0; }
            else if (kind == 1 && kb == 1) { W = (const float*)a.in[12] + (size_t)l * 64 * 512; k0 = 0; }
            else if (kind == 2 && kb >= 2) { W = (const float*)a.in[13] + (size_t)l * 128 * 512; k0 = 64 * (kb - 2); }
            tr_item(W, 512, k0, nn0, nullptr, (bf16_t*)(ws + W_LR), 256, 32 * nb, 64 * kb - k0, scr, lane);
        }
    }
}

__device__ __forceinline__ void norm_phase(const float* x, bf16_t* XN) {
    const int TID = opaque_tid(), BID = opaque_bid(); (void)TID; (void)BID;
    const int wave = TID >> 6, lane = TID & 63;
    const int gw = BID * NWAVES + wave, NGW = gridDim.x * NWAVES;
    for (int m = gw; m < T; m += NGW) {
        const f32x4* xr = (const f32x4*)(x + (size_t)m * D) + lane;
        f32x4 v[8]; float s = 0.f;
#pragma unroll
        for (int j = 0; j < 8; ++j) { v[j] = xr[64 * j]; s += (v[j].x * v[j].x + v[j].y * v[j].y) + (v[j].z * v[j].z + v[j].w * v[j].w); }
        const float rs = 1.0f / sqrtf(wave_sum(s) * (1.0f / D) + 1e-6f);
        u32x2* o = (u32x2*)(XN + (size_t)m * D) + lane;
#pragma unroll
        for (int j = 0; j < 8; ++j) { u32x2 w; w.x = pk2(v[j].x * rs, v[j].y * rs); w.y = pk2(v[j].z * rs, v[j].w * rs); o[64 * j] = w; }
    }
}

__device__ __forceinline__ void alr_phase(const Args& a, int l) {
    const int TID = opaque_tid(), BID = opaque_bid(); (void)TID; (void)BID;
    const bf16_t* P = (const bf16_t*)(a.ws + WS_PROJ); bf16_t* ALR = (bf16_t*)(a.ws + WS_ALR);
    const float* mu = (const float*)a.in[8] + (size_t)l * 1792 + 1536;
    const int gt = BID * NTHREADS + TID, NGT = gridDim.x * NTHREADS;
    for (int it = gt; it < T * 32; it += NGT) {
        const int t = it >> 5, cg = it & 31, c0 = 8 * cg;
        float cur[8], prv[8], o[8];
        unpack8(*(const u32x4*)(P + (size_t)t * DIN + 1536 + c0), cur);
        if ((t & (SEQ - 1)) != 0) unpack8(*(const u32x4*)(P + (size_t)(t - 1) * DIN + 1536 + c0), prv);
        else {
#pragma unroll
            for (int j = 0; j < 8; ++j) prv[j] = 0.f; }
#pragma unroll
        for (int j = 0; j < 8; ++j) { const float v = cur[j] + (prv[j] - cur[j]) * mu[c0 + j];
            o[j] = c0 < 64 ? tanhf(v) : (c0 < 128 ? v : sigmoidf_(v)); }
        *(u32x4*)(ALR + (size_t)t * 256 + c0) = pack8(o);
    }
}

__device__ __forceinline__ void rwkv_phase(const Args& a, int l, LAS unsigned char* lds) {
    const int TID = opaque_tid(), BID = opaque_bid(); (void)TID; (void)BID;
    const bf16_t* P = (const bf16_t*)(a.ws + WS_PROJ); const bf16_t* LR = (const bf16_t*)(a.ws + WS_LRO);
    float* OR = (float*)(a.ws + WS_OR); float* BON = (float*)(a.ws + WS_BON);
    LAS float* sR = (LAS float*)lds; LAS float* sW = sR + 4096; LAS float* sK = sW + 4096; LAS float* sKK = sK + 4096; LAS float* sB = sKK + 4096;
    LAS float* sV = sB + 4096; LAS float* sO = sV + 2048;
    const int tid = TID, wave = tid >> 6, lane = tid & 63;
    const int tt = tid >> 3, cg = tid & 7;
    for (int job = BID; job < 256; job += gridDim.x) {
        const int b = job >> 4, h = (job >> 1) & 7, half = job & 1;
        const int c0 = 64 * h + 8 * cg;
        float mur[8], muk[8], muv[8], kkw[8], kaw[8], rkw[8];
#pragma unroll
        for (int j = 0; j < 8; ++j) {
            mur[j] = ((const float*)a.in[8])[(size_t)l * 1792 + c0 + j]; muk[j] = ((const float*)a.in[8])[(size_t)l * 1792 + 512 + c0 + j]; muv[j] = ((const float*)a.in[8])[(size_t)l * 1792 + 1024 + c0 + j];
            kkw[j] = ((const float*)a.in[14])[(size_t)l * 512 + c0 + j]; kaw[j] = ((const float*)a.in[15])[(size_t)l * 512 + c0 + j]; rkw[j] = ((const float*)a.in[16])[(size_t)l * 512 + c0 + j]; }
        float st0 = 0.f, st1 = 0.f, st2 = 0.f, st3 = 0.f;
        const int rloc = 4 * wave + (lane >> 4), jq = lane & 15;
        for (int ch = 0; ch < SEQ / 64; ++ch) {
            __syncthreads();
            {
                const int s = ch * 64 + tt; const size_t t = (size_t)b * SEQ + s;
                float r[8], k[8], v[8], pr[8], ld[8], av[8];
                unpack8(*(const u32x4*)(P + t * DIN + c0), r); unpack8(*(const u32x4*)(P + t * DIN + 512 + c0), k); unpack8(*(const u32x4*)(P + t * DIN + 1024 + c0), v);
                if (s != 0) {
                    unpack8(*(const u32x4*)(P + (t - 1) * DIN + c0), pr);
#pragma unroll
                    for (int j = 0; j < 8; ++j) r[j] += (pr[j] - r[j]) * mur[j];
                    unpack8(*(const u32x4*)(P + (t - 1) * DIN + 512 + c0), pr);
#pragma unroll
                    for (int j = 0; j < 8; ++j) k[j] += (pr[j] - k[j]) * muk[j];
                    unpack8(*(const u32x4*)(P + (t - 1) * DIN + 1024 + c0), pr);
#pragma unroll
                    for (int j = 0; j < 8; ++j) v[j] += (pr[j] - v[j]) * muv[j];
                } else {
#pragma unroll
                    for (int j = 0; j < 8; ++j) { r[j] -= r[j] * mur[j]; k[j] -= k[j] * muk[j]; v[j] -= v[j] * muv[j]; }
                }
                unpack8(*(const u32x4*)(LR + t * 1536 + c0), ld); unpack8(*(const u32x4*)(LR + t * 1536 + 512 + c0), av);
                float kk[8], ss = 0.f, bp = 0.f;
#pragma unroll
                for (int j = 0; j < 8; ++j) { kk[j] = k[j] * kkw[j]; ss += kk[j] * kk[j]; }
                ss = red8(ss);
                const float inv = 1.0f / sqrtf(fmaxf(ss, 1e-24f));
                float w8[8], k8[8], b8[8];
#pragma unroll
                for (int j = 0; j < 8; ++j) { kk[j] *= inv; k8[j] = k[j] * (1.0f + (av[j] - 1.0f) * kaw[j]); b8[j] = kk[j] * av[j]; w8[j] = __expf(ld[j]); bp += r[j] * k8[j] * rkw[j]; }
                bp = red8(bp);
                if (half == 0 && cg == 0) BON[t * 8 + h] = bp;
                LAS float* d;
                d = sR + tt * 64 + 8 * cg; *(LAS f32x4*)d = (f32x4){r[0], r[1], r[2], r[3]}; *(LAS f32x4*)(d + 4) = (f32x4){r[4], r[5], r[6], r[7]};
                d = sW + tt * 64 + 8 * cg; *(LAS f32x4*)d = (f32x4){w8[0], w8[1], w8[2], w8[3]}; *(LAS f32x4*)(d + 4) = (f32x4){w8[4], w8[5], w8[6], w8[7]};
                d = sK + tt * 64 + 8 * cg; *(LAS f32x4*)d = (f32x4){k8[0], k8[1], k8[2], k8[3]}; *(LAS f32x4*)(d + 4) = (f32x4){k8[4], k8[5], k8[6], k8[7]};
                d = sKK + tt * 64 + 8 * cg; *(LAS f32x4*)d = (f32x4){kk[0], kk[1], kk[2], kk[3]}; *(LAS f32x4*)(d + 4) = (f32x4){kk[4], kk[5], kk[6], kk[7]};
                d = sB + tt * 64 + 8 * cg; *(LAS f32x4*)d = (f32x4){b8[0], b8[1], b8[2], b8[3]}; *(LAS f32x4*)(d + 4) = (f32x4){b8[4], b8[5], b8[6], b8[7]};
                if ((cg >> 2) == half) { d = sV + tt * 32 + 8 * (cg & 3); *(LAS f32x4*)d = (f32x4){v[0], v[1], v[2], v[3]}; *(LAS f32x4*)(d + 4) = (f32x4){v[4], v[5], v[6], v[7]}; }
            }
            __syncthreads();
#pragma unroll 2
            for (int s = 0; s < 64; ++s) {
                const f32x4 w4 = *(const LAS f32x4*)(sW + s * 64 + 4 * jq), kk4 = *(const LAS f32x4*)(sKK + s * 64 + 4 * jq), b4 = *(const LAS f32x4*)(sB + s * 64 + 4 * jq),
                            k4 = *(const LAS f32x4*)(sK + s * 64 + 4 * jq), r4 = *(const LAS f32x4*)(sR + s * 64 + 4 * jq);
                const float vi = sV[s * 32 + rloc];
                float sa = (st0 * kk4.x + st1 * kk4.y) + (st2 * kk4.z + st3 * kk4.w);
                sa = -red16(sa);
                st0 = st0 * w4.x + (sa * b4.x + vi * k4.x); st1 = st1 * w4.y + (sa * b4.y + vi * k4.y);
                st2 = st2 * w4.z + (sa * b4.z + vi * k4.z); st3 = st3 * w4.w + (sa * b4.w + vi * k4.w);
                float y = (st0 * r4.x + st1 * r4.y) + (st2 * r4.z + st3 * r4.w);
                y = red16(y);
                if (jq == 0) sO[s * 32 + rloc] = y;
            }
            __syncthreads();
            {
                const int s = ch * 64 + tt; const size_t t = (size_t)b * SEQ + s;
                *(f32x4*)(OR + t * 512 + 64 * h + 32 * half + 4 * cg) = *(const LAS f32x4*)(sO + tt * 32 + 4 * cg);
            }
        }
    }
    __syncthreads();
}

__device__ __forceinline__ void hgrn_phase(const Args& a, int l, LAS unsigned char* lds) {
    const int TID = opaque_tid(), BID = opaque_bid(); (void)TID; (void)BID;
    const bf16_t* P = (const bf16_t*)(a.ws + WS_PROJ); float* OH = (float*)(a.ws + WS_OH);
    LAS float* sQ = (LAS float*)lds; LAS float* sF = sQ + 4096; LAS float* sV = sF + 4096; LAS float* sO = sV + 2048;
    const int tid = TID, wave = tid >> 6, lane = tid & 63;
    const int tt = tid >> 3, cg = tid & 7;
    const float* lbp = (const float*)a.in[32];
    for (int job = BID; job < 256; job += gridDim.x) {
        const int b = job >> 4, h = (job >> 1) & 7, half = job & 1;
        const int c0 = 64 * h + 8 * cg;
        float lb[8];
#pragma unroll
        for (int j = 0; j < 8; ++j) lb[j] = (l == 0) ? 0.f : sigmoidf_(lbp[512 + c0 + j] - lbp[c0 + j]);
        float st0 = 0.f, st1 = 0.f, st2 = 0.f, st3 = 0.f;
        const int cloc = 4 * wave + (lane >> 4), dq = lane & 15;
        for (int ch = 0; ch < SEQ / 64; ++ch) {
            __syncthreads();
            {
                const int s = ch * 64 + tt; const size_t t = (size_t)b * SEQ + s;
                float q[8], f[8];
                unpack8(*(const u32x4*)(P + t * DIN + C_HG + c0), q); unpack8(*(const u32x4*)(P + t * DIN + C_HG + 512 + c0), f);
#pragma unroll
                for (int j = 0; j < 8; ++j) { q[j] = siluf_(q[j]) * 0.125f; f[j] = lb[j] + (1.0f - lb[j]) * sigmoidf_(f[j]); }
                LAS float* d;
                d = sQ + tt * 64 + 8 * cg; *(LAS f32x4*)d = (f32x4){q[0], q[1], q[2], q[3]}; *(LAS f32x4*)(d + 4) = (f32x4){q[4], q[5], q[6], q[7]};
                d = sF + tt * 64 + 8 * cg; *(LAS f32x4*)d = (f32x4){f[0], f[1], f[2], f[3]}; *(LAS f32x4*)(d + 4) = (f32x4){f[4], f[5], f[6], f[7]};
                const u32x2 vv = *(const u32x2*)(P + t * DIN + C_HG + 1024 + 64 * h + 32 * half + 4 * cg);
                *(LAS f32x4*)(sV + tt * 32 + 4 * cg) = (f32x4){bflo(vv.x), bfhi(vv.x), bflo(vv.y), bfhi(vv.y)};
            }
            __syncthreads();
#pragma unroll 2
            for (int s = 0; s < 64; ++s) {
                const f32x4 f4 = *(const LAS f32x4*)(sF + s * 64 + 4 * dq), q4 = *(const LAS f32x4*)(sQ + s * 64 + 4 * dq);
                const float vi = sV[s * 32 + cloc];
                st0 = f4.x * (st0 - vi) + vi; st1 = f4.y * (st1 - vi) + vi; st2 = f4.z * (st2 - vi) + vi; st3 = f4.w * (st3 - vi) + vi;
                float y = (st0 * q4.x + st1 * q4.y) + (st2 * q4.z + st3 * q4.w);
                y = red16(y);
                if (dq == 0) sO[s * 32 + cloc] = y;
            }
            __syncthreads();
            {
                const int s = ch * 64 + tt; const size_t t = (size_t)b * SEQ + s;
                *(f32x4*)(OH + t * 512 + 64 * h + 32 * half + 4 * cg) = *(const LAS f32x4*)(sO + tt * 32 + 4 * cg);
            }
        }
    }
    __syncthreads();
}

__device__ __forceinline__ void post_phase(const Args& a, int l) {
    const int TID = opaque_tid(), BID = opaque_bid(); (void)TID; (void)BID;
    const bf16_t* P = (const bf16_t*)(a.ws + WS_PROJ); const bf16_t* LR = (const bf16_t*)(a.ws + WS_LRO);
    const float* OR = (const float*)(a.ws + WS_OR); const float* OH = (const float*)(a.ws + WS_OH); const float* BON = (const float*)(a.ws + WS_BON);
    bf16_t* Y = (bf16_t*)(a.ws + WS_XN);
    const float* muv = (const float*)a.in[8] + (size_t)l * 1792 + 1024;
    const float* lnw = (const float*)a.in[17] + (size_t)l * 512; const float* lnb = (const float*)a.in[18] + (size_t)l * 512;
    const float* gn = (const float*)a.in[33] + (size_t)l * 64;
    const int gt = BID * NTHREADS + TID, NGT = gridDim.x * NTHREADS;
    for (int it = gt; it < T * 128; it += NGT) {
        const int cg = it & 7, hh = (it >> 3) & 15; const size_t t = (size_t)(it >> 7);
        float o[8], y[8];
        if (hh < 8) {
            const int c0 = 64 * hh + 8 * cg;
            const f32x4 o0 = *(const f32x4*)(OR + t * 512 + c0), o1 = *(const f32x4*)(OR + t * 512 + c0 + 4);
            o[0] = o0.x; o[1] = o0.y; o[2] = o0.z; o[3] = o0.w; o[4] = o1.x; o[5] = o1.y; o[6] = o1.z; o[7] = o1.w;
            float s = 0.f;
#pragma unroll
            for (int j = 0; j < 8; ++j) s += o[j];
            const float mean = red8(s) * (1.0f / 64.0f);
            float q = 0.f;
#pragma unroll
            for (int j = 0; j < 8; ++j) { o[j] -= mean; q += o[j] * o[j]; }
            const float rstd = 1.0f / sqrtf(red8(q) * (1.0f / 64.0f) + 64e-5f);
            float v[8], pv[8], g[8];
            unpack8(*(const u32x4*)(P + t * DIN + 1024 + c0), v);
            if ((t & (SEQ - 1)) != 0) unpack8(*(const u32x4*)(P + (t - 1) * DIN + 1024 + c0), pv);
            else {
#pragma unroll
                for (int j = 0; j < 8; ++j) pv[j] = 0.f; }
            unpack8(*(const u32x4*)(LR + t * 1536 + 1024 + c0), g);
            const float bon = BON[t * 8 + hh];
#pragma unroll
            for (int j = 0; j < 8; ++j) { const float vl = v[j] + (pv[j] - v[j]) * muv[c0 + j];
                y[j] = (o[j] * rstd * lnw[c0 + j] + lnb[c0 + j] + bon * vl) * g[j]; }
            *(u32x4*)(Y + t * D + c0) = pack8(y);
        } else {
            const int h = hh - 8, c0 = 64 * h + 8 * cg;
            const f32x4 o0 = *(const f32x4*)(OH + t * 512 + c0), o1 = *(const f32x4*)(OH + t * 512 + c0 + 4);
            o[0] = o0.x; o[1] = o0.y; o[2] = o0.z; o[3] = o0.w; o[4] = o1.x; o[5] = o1.y; o[6] = o1.z; o[7] = o1.w;
            float q = 0.f;
#pragma unroll
            for (int j = 0; j < 8; ++j) q += o[j] * o[j];
            const float rs = 1.0f / sqrtf(red8(q) * (1.0f / 64.0f) + 1e-6f);
            float g[8];
            unpack8(*(const u32x4*)(P + t * DIN + C_HG + 1536 + c0), g);
#pragma unroll
            for (int j = 0; j < 8; ++j) y[j] = o[j] * rs * gn[8 * cg + j] * siluf_(g[j]);
            *(u32x4*)(Y + t * D + 1536 + c0) = pack8(y);
        }
    }
}

__device__ __forceinline__ void attn_phase(const Args& a, int l, LAS unsigned char* lds) {
    const int TID = opaque_tid(), BID = opaque_bid(); (void)TID; (void)BID;
    const bf16_t* P = (const bf16_t*)(a.ws + WS_PROJ); bf16_t* Y = (bf16_t*)(a.ws + WS_XN);
    const int* pos = (const int*)a.in[1];
    const float* qn = (const float*)a.in[19] + (size_t)l * 64; const float* kn = (const float*)a.in[20] + (size_t)l * 64; const float* sinks = (const float*)a.in[21] + (size_t)l * 8;
    LAS float* sK = (LAS float*)lds; LAS float* sV = sK + 256 * 64;
    const int tid = TID, cg = tid & 7;
    float kmaxg = 0.f;
    for (int j = 0; j < 64; ++j) kmaxg = fmaxf(kmaxg, fabsf(kn[j]));
    const float kbound = 8.0f * kmaxg;
    for (int job = BID; job < 512; job += gridDim.x) {
        const int b = job >> 5, nb = (job >> 1) & 15, kvh = job & 1;
        __syncthreads();
#pragma unroll 1
        for (int r = 0; r < 4; ++r) {
            const int kj = (tid >> 3) + 64 * r, s = (nb - 1) * 128 + kj;
            float k[8], v[8];
            if (s >= 0) {
                const size_t t = (size_t)b * SEQ + s;
                unpack8(*(const u32x4*)(P + t * DIN + C_ATT + 512 + 64 * kvh + 8 * cg), k); unpack8(*(const u32x4*)(P + t * DIN + C_ATT + 640 + 64 * kvh + 8 * cg), v);
            } else {
#pragma unroll
                for (int j = 0; j < 8; ++j) { k[j] = 0.f; v[j] = 0.f; } }
            float ss = 0.f;
#pragma unroll
            for (int j = 0; j < 8; ++j) ss += k[j] * k[j];
            ss = red8(ss);
            const float rs = 1.0f / sqrtf(ss * (1.0f / 64.0f) + 1e-6f);
#pragma unroll
            for (int j = 0; j < 8; ++j) k[j] = k[j] * rs * kn[8 * cg + j];
            const float pf = (float)pos[b * SEQ + (s >= 0 ? s : 0)];
#pragma unroll
            for (int j = 0; j < 8; ++j) {
                const float other = dpp<XOR1>(k[j]);
                if (cg < 2) {
                    const float invf = exp2f(-(float)j * (18.931568569324174f / 8.0f));
                    float sn, cs; sincos_big(pf * invf, sn, cs);
                    k[j] = (cg == 0) ? (k[j] * cs - other * sn) : (k[j] * cs + other * sn);
                }
            }
            LAS float* d = sK + kj * 64 + 8 * cg; *(LAS f32x4*)d = (f32x4){k[0], k[1], k[2], k[3]}; *(LAS f32x4*)(d + 4) = (f32x4){k[4], k[5], k[6], k[7]};
            d = sV + kj * 64 + 8 * cg; *(LAS f32x4*)d = (f32x4){v[0], v[1], v[2], v[3]}; *(LAS f32x4*)(d + 4) = (f32x4){v[4], v[5], v[6], v[7]};
        }
        const int g = tid >> 7, qi = tid & 127, hq = 4 * kvh + g;
        const size_t tq = (size_t)b * SEQ + nb * 128 + qi;
        float q[64]; float mshift;
        {
            float ss = 0.f;
#pragma unroll
            for (int c = 0; c < 8; ++c) { float f[8]; unpack8(*(const u32x4*)(P + tq * DIN + C_ATT + 64 * hq + 8 * c), f);
#pragma unroll
                for (int j = 0; j < 8; ++j) { q[8 * c + j] = f[j]; ss += f[j] * f[j]; } }
            const float rs = 1.0f / sqrtf(ss * (1.0f / 64.0f) + 1e-6f);
#pragma unroll
            for (int j = 0; j < 64; ++j) q[j] = q[j] * rs * qn[j];
            const float pf = (float)pos[b * SEQ + nb * 128 + qi];
#pragma unroll
            for (int j = 0; j < 8; ++j) {
                const float invf = exp2f(-(float)j * (18.931568569324174f / 8.0f));
                float sn, cs; sincos_big(pf * invf, sn, cs);
                const float x1 = q[j], x2 = q[j + 8]; q[j] = x1 * cs - x2 * sn; q[j + 8] = x2 * cs + x1 * sn;
            }
            float qq = 0.f;
#pragma unroll
            for (int j = 0; j < 64; ++j) { q[j] *= 0.125f; qq += q[j] * q[j]; }
            mshift = sqrtf(qq) * kbound;
        }
        __syncthreads();
        float acc[64];
#pragma unroll
        for (int j = 0; j < 64; ++j) acc[j] = 0.f;
        float lsum = __expf(sinks[hq] - mshift);
        const int q0 = qi & ~63;
        const int kbeg = (nb == 0) ? 128 : (q0 + 1), kend = q0 + 63 + 128;
#pragma unroll 1
        for (int kj = kbeg; kj <= kend; ++kj) {
            const LAS f32x4* kr = (const LAS f32x4*)(sK + kj * 64);
            float s0 = 0.f, s1 = 0.f, s2 = 0.f, s3 = 0.f;
#pragma unroll
            for (int c = 0; c < 16; ++c) { const f32x4 kv = kr[c]; s0 += q[4 * c] * kv.x; s1 += q[4 * c + 1] * kv.y; s2 += q[4 * c + 2] * kv.z; s3 += q[4 * c + 3] * kv.w; }
            const float sc = (s0 + s1) + (s2 + s3);
            const bool valid = (kj >= qi + 1) && (kj <= qi + 128);
            const float p = valid ? __expf(sc - mshift) : 0.f;
            lsum += p;
            const LAS f32x4* vr = (const LAS f32x4*)(sV + kj * 64);
#pragma unroll
            for (int c = 0; c < 16; ++c) { const f32x4 vv = vr[c]; acc[4 * c] += p * vv.x; acc[4 * c + 1] += p * vv.y; acc[4 * c + 2] += p * vv.z; acc[4 * c + 3] += p * vv.w; }
        }
        const float inv = 1.0f / lsum;
#pragma unroll
        for (int c = 0; c < 8; ++c) { float o[8];
#pragma unroll
            for (int j = 0; j < 8; ++j) o[j] = acc[8 * c + j] * inv;
            *(u32x4*)(Y + tq * D + 512 + 64 * hq + 8 * c) = pack8(o); }
    }
    __syncthreads();
}

__device__ __forceinline__ void s5_phase(const Args& a, int l, LAS unsigned char* lds) {
    const int TID = opaque_tid(), BID = opaque_bid(); (void)TID; (void)BID;
    const bf16_t* P = (const bf16_t*)(a.ws + WS_PROJ); bf16_t* Z = (bf16_t*)(a.ws + WS_Z);
    const int tid = TID, wave = tid >> 6, lane = tid & 63;
    LAS float* sU = (LAS float*)lds + wave * 1024;
    LAS float* sX = (LAS float*)lds + 8192 + wave * (16 * 130);
    LAS float* sE = (LAS float*)lds + 8192 + 8 * 16 * 130;
    for (int job = BID; job < 512; job += gridDim.x) {
        const int b = job >> 5, g = job & 31;
        const float lre = ((const float*)a.in[22])[(size_t)l * 2048 + g * 64 + lane], lim = ((const float*)a.in[23])[(size_t)l * 2048 + g * 64 + lane];
        const float dt = expf(((const float*)a.in[24])[l * 32 + g]);
        float sn, cs; sincos_big(lim * dt, sn, cs);
        const float er = expf(lre * dt), lbr = er * cs, lbi = er * sn;
        const float den = 1.0f / (lre * lre + lim * lim);
        const float fr = ((lbr - 1.0f) * lre + lbi * lim) * den, fi = (lbi * lre - (lbr - 1.0f) * lim) * den;
        float bbr[16], bbi[16];
        {
            const f32x4* br = (const f32x4*)((const float*)a.in[25] + ((size_t)l * 2048 + g * 64 + lane) * 16); const f32x4* bi = (const f32x4*)((const float*)a.in[26] + ((size_t)l * 2048 + g * 64 + lane) * 16);
#pragma unroll
            for (int q = 0; q < 4; ++q) { const f32x4 r4 = br[q], i4 = bi[q];
                bbr[4 * q] = fr * r4.x - fi * i4.x; bbi[4 * q] = fr * i4.x + fi * r4.x; bbr[4 * q + 1] = fr * r4.y - fi * i4.y; bbi[4 * q + 1] = fr * i4.y + fi * r4.y;
                bbr[4 * q + 2] = fr * r4.z - fi * i4.z; bbi[4 * q + 2] = fr * i4.z + fi * r4.z; bbr[4 * q + 3] = fr * r4.w - fi * i4.w; bbi[4 * q + 3] = fr * i4.w + fi * r4.w; }
        }
        float creg[32];
        {
            const float* cre = (const float*)a.in[27] + ((size_t)l * 32 + g) * 1024 + (lane & 15) * 64 + (lane >> 4);
            const float* cim = (const float*)a.in[28] + ((size_t)l * 32 + g) * 1024 + (lane & 15) * 64 + (lane >> 4);
#pragma unroll
            for (int kk = 0; kk < 16; ++kk) { creg[kk] = cre[4 * kk]; creg[16 + kk] = -cim[4 * kk]; }
        }
        f32x4 dsk;
        { const float* dp = (const float*)a.in[29] + (size_t)l * 512 + 16 * g + 4 * (lane >> 4); dsk = (f32x4){dp[0], dp[1], dp[2], dp[3]}; }
        const size_t tbase = (size_t)b * SEQ + wave * 256;
        float xr = 0.f, xi = 0.f;
        for (int c = 0; c < 4; ++c) {
            { const size_t t = tbase + c * 64 + lane; float u[16]; unpack8(*(const u32x4*)(P + t * DIN + C_S5 + 16 * g), u); unpack8(*(const u32x4*)(P + t * DIN + C_S5 + 16 * g + 8), u + 8);
              LAS f32x4* d = (LAS f32x4*)(sU + lane * 16); d[0] = (f32x4){u[0], u[1], u[2], u[3]}; d[1] = (f32x4){u[4], u[5], u[6], u[7]}; d[2] = (f32x4){u[8], u[9], u[10], u[11]}; d[3] = (f32x4){u[12], u[13], u[14], u[15]}; }
            LDS_FENCE();
#pragma unroll 2
            for (int s = 0; s < 64; ++s) {
                const LAS f32x4* up = (const LAS f32x4*)(sU + s * 16);
                float bur = 0.f, bui = 0.f;
#pragma unroll
                for (int q = 0; q < 4; ++q) { const f32x4 u4 = up[q];
                    bur += bbr[4 * q] * u4.x; bui += bbi[4 * q] * u4.x; bur += bbr[4 * q + 1] * u4.y; bui += bbi[4 * q + 1] * u4.y;
                    bur += bbr[4 * q + 2] * u4.z; bui += bbi[4 * q + 2] * u4.z; bur += bbr[4 * q + 3] * u4.w; bui += bbi[4 * q + 3] * u4.w; }
                const float nr = lbr * xr - lbi * xi + bur, ni = lbr * xi + lbi * xr + bui; xr = nr; xi = ni;
            }
            LDS_FENCE();
        }
        sE[wave * 128 + lane] = xr; sE[wave * 128 + 64 + lane] = xi;
        float pr = lbr, pi = lbi;
#pragma unroll
        for (int i = 0; i < 8; ++i) { const float nr = pr * pr - pi * pi, ni = 2.0f * pr * pi; pr = nr; pi = ni; }
        __syncthreads();
        xr = 0.f; xi = 0.f;
        for (int w = 0; w < wave; ++w) { const float er_ = sE[w * 128 + lane], ei_ = sE[w * 128 + 64 + lane];
            const float nr = pr * xr - pi * xi + er_, ni = pr * xi + pi * xr + ei_; xr = nr; xi = ni; }
        for (int c = 0; c < 4; ++c) {
            { const size_t t = tbase + c * 64 + lane; float u[16]; unpack8(*(const u32x4*)(P + t * DIN + C_S5 + 16 * g), u); unpack8(*(const u32x4*)(P + t * DIN + C_S5 + 16 * g + 8), u + 8);
              LAS f32x4* d = (LAS f32x4*)(sU + lane * 16); d[0] = (f32x4){u[0], u[1], u[2], u[3]}; d[1] = (f32x4){u[4], u[5], u[6], u[7]}; d[2] = (f32x4){u[8], u[9], u[10], u[11]}; d[3] = (f32x4){u[12], u[13], u[14], u[15]}; }
            LDS_FENCE();
#pragma unroll 1
            for (int s16 = 0; s16 < 4; ++s16) {
#pragma unroll 2
                for (int s = 0; s < 16; ++s) {
                    const LAS f32x4* up = (const LAS f32x4*)(sU + (s16 * 16 + s) * 16);
                    float bur = 0.f, bui = 0.f;
#pragma unroll
                    for (int q = 0; q < 4; ++q) { const f32x4 u4 = up[q];
                        bur += bbr[4 * q] * u4.x; bui += bbi[4 * q] * u4.x; bur += bbr[4 * q + 1] * u4.y; bui += bbi[4 * q + 1] * u4.y;
                        bur += bbr[4 * q + 2] * u4.z; bui += bbi[4 * q + 2] * u4.z; bur += bbr[4 * q + 3] * u4.w; bui += bbi[4 * q + 3] * u4.w; }
                    const float nr = lbr * xr - lbi * xi + bur, ni = lbr * xi + lbi * xr + bui; xr = nr; xi = ni;
                    sX[s * 130 + lane] = xr; sX[s * 130 + 64 + lane] = xi;
                }
                LDS_FENCE();
                f32x4 yacc = (f32x4){0.f, 0.f, 0.f, 0.f};
                const LAS float* xp = sX + (lane & 15) * 130 + (lane >> 4);
#pragma unroll
                for (int kk = 0; kk < 32; ++kk) yacc = __builtin_amdgcn_mfma_f32_16x16x4f32(creg[kk], xp[4 * kk], yacc, 0, 0, 0);
                const int tok = s16 * 16 + (lane & 15);
                const f32x4 u4 = *(const LAS f32x4*)(sU + tok * 16 + 4 * (lane >> 4));
                float z[4];
#pragma unroll
                for (int j = 0; j < 4; ++j) { const float y = yacc[j] + dsk[j] * u4[j]; z[j] = 0.5f * y * (1.0f + erff(y * 0.70710678118654752f)); }
                u32x2 w; w.x = pk2(z[0], z[1]); w.y = pk2(z[2], z[3]);
                *(u32x2*)(Z + (tbase + c * 64 + tok) * 512 + 16 * g + 4 * (lane >> 4)) = w;
                LDS_FENCE();
            }
        }
        __syncthreads();
    }
}

constexpr int NPH = 13;
__global__ void __launch_bounds__(NTHREADS, 2) mega(Args a_, int lo, int hi) {
    extern __shared__ __attribute__((aligned(16))) unsigned char lds_raw[];
    LAS unsigned char* lds = (LAS unsigned char*)lds_raw;
#pragma unroll 1
    for (int step = lo; step < hi; ++step) {
        const Args* ap = (const Args*)__builtin_amdgcn_kernarg_segment_ptr();
        asm volatile("" : "+s"(ap));
        const Args& a = *ap;
        unsigned char* ws = a.ws;
        const int l = step / NPH, ph = step % NPH;
        const float* xin = (l == 0) ? (const float*)a.in[0] : (const float*)a.out;
#ifndef PHMASK
#define PHMASK 0x1fff
#endif
        switch (ph) {
        case 0: if (PHMASK & (1 << 0)) { conv_phase(a, l, lds); norm_phase(xin, (bf16_t*)(ws + WS_XN)); } break;
        case 1: if (PHMASK & (1 << 1)) { pg8::EpiSwiGLU E; E.H = (bf16_t*)(ws + WS_HID); run_gemm(lds, (const bf16_t*)(ws + WS_XN), (const bf16_t*)(ws + W_UP1), 2 * FF, D, E); } break;
        case 2: if (PHMASK & (1 << 2)) { pg8::EpiResidual E; E.base = xin; E.out = a.out; E.scale = 0.5f; run_gemm(lds, (const bf16_t*)(ws + WS_HID), (const bf16_t*)(ws + W_DN1), D, FF, E); } break;
        case 3: if (PHMASK & (1 << 3)) norm_phase(a.out, (bf16_t*)(ws + WS_XN)); break;
        case 4: if (PHMASK & (1 << 4)) { pg8::EpiBf16 E; E.O = (bf16_t*)(ws + WS_PROJ); E.ldc = DIN; run_gemm(lds, (const bf16_t*)(ws + WS_XN), (const bf16_t*)(ws + W_IN), DIN, D, E); } break;
        case 5: if (PHMASK & (1 << 5)) { alr_phase(a, l); attn_phase(a, l, lds); s5_phase(a, l, lds); hgrn_phase(a, l, lds); } break;
        case 6: if (PHMASK & (1 << 6)) { pg8::EpiLR E; E.O = (bf16_t*)(ws + WS_LRO); E.w0 = (const float*)a.in[9] + (size_t)l * 512; E.a0 = (const float*)a.in[11] + (size_t)l * 512;
#ifndef P6
#define P6 3
#endif
                  if (P6 & 1) run_gemm(lds, (const bf16_t*)(ws + WS_ALR), (const bf16_t*)(ws + W_LR), 1536, 256, E);
                  pg8::EpiGLU G; G.Z = (const bf16_t*)(ws + WS_Z); G.Y = (bf16_t*)(ws + WS_XN); G.b = (const float*)a.in[31] + (size_t)l * 512;
                  if (P6 & 2) run_gemm(lds, (const bf16_t*)(ws + WS_Z), (const bf16_t*)(ws + W_GLU), 512, 512, G); } break;
        case 7: if (PHMASK & (1 << 7)) rwkv_phase(a, l, lds); break;
        case 8: if (PHMASK & (1 << 8)) post_phase(a, l); break;
        case 9: if (PHMASK & (1 << 9)) { pg8::EpiResidual E; E.base = a.out; E.out = a.out; E.scale = 1.0f; run_gemm(lds, (const bf16_t*)(ws + WS_XN), (const bf16_t*)(ws + W_OUT), D, D, E); } break;
        case 10: if (PHMASK & (1 << 10)) norm_phase(a.out, (bf16_t*)(ws + WS_XN)); break;
        case 11: if (PHMASK & (1 << 11)) { pg8::EpiSwiGLU E; E.H = (bf16_t*)(ws + WS_HID); run_gemm(lds, (const bf16_t*)(ws + WS_XN), (const bf16_t*)(ws + W_UP2), 2 * FF, D, E); } break;
        case 12: if (PHMASK & (1 << 12)) { pg8::EpiResidual E; E.base = a.out; E.out = a.out; E.scale = 0.5f; run_gemm(lds, (const bf16_t*)(ws + WS_HID), (const bf16_t*)(ws + W_DN2), D, FF, E); } break;
        }
        if (step + 1 < hi) { __syncthreads(); cg::this_grid().sync(); }
    }
}

extern "C" void kernel_launch(void* const* d_in, const int* in_sizes, int n_in, void* d_out, int out_size, void* d_ws, size_t ws_size, hipStream_t stream) {
    static int grid = 0;
    if (!grid) {
        int dev = 0, cus = 0, per_cu = 0;
        hipGetDevice(&dev);
        hipDeviceGetAttribute(&cus, hipDeviceAttributeMultiprocessorCount, dev);
        hipFuncSetAttribute((const void*)mega, hipFuncAttributeMaxDynamicSharedMemorySize, LDS_BYTES);
        hipOccupancyMaxActiveBlocksPerMultiprocessor(&per_cu, (const void*)mega, NTHREADS, LDS_BYTES);
        if (per_cu < 1) per_cu = 1;
        grid = cus * 1;
        if (grid != 256) fprintf(stderr, "kernel_launch: grid %d (cus %d, per_cu %d)\n", grid, cus, per_cu);
    }
    Args a{};
    for (int i = 0; i < 39; ++i) a.in[i] = d_in[i];
    a.out = (float*)d_out; a.ws = (unsigned char*)d_ws;
#if ONE_LAUNCH
    int lo = 0, hi = NL * NPH;
    void* args[] = {&a, &lo, &hi};
    hipError_t e = hipLaunchCooperativeKernel((void*)mega, dim3(grid), dim3(NTHREADS), args, LDS_BYTES, stream);
    if (e != hipSuccess) fprintf(stderr, "cooperative launch failed: %s (grid %d)\n", hipGetErrorString(e), grid);
#else
    for (int s = 0; s < NL * NPH; ++s) hipLaunchKernelGGL(mega, dim3(grid), dim3(NTHREADS), LDS_BYTES, stream, a, s, s + 1);
#endif
}
```

```cpp
#include <hip/hip_runtime.h>
#include <hip/hip_cooperative_groups.h>
#include <cstdio>
#include <cstdint>
namespace cg = cooperative_groups;

#ifndef ONE_LAUNCH
#define ONE_LAUNCH 1
#endif

#define LAS __attribute__((address_space(3)))
typedef unsigned short bf16_t;
typedef short bf16x8 __attribute__((ext_vector_type(8)));
typedef float f32x4 __attribute__((ext_vector_type(4)));
typedef float f32x2 __attribute__((ext_vector_type(2)));
typedef unsigned u32x4 __attribute__((ext_vector_type(4)));
typedef unsigned u32x2 __attribute__((ext_vector_type(2)));

constexpr int T = 32768, SEQ = 2048, NB = 16, D = 2048, FF = 5632, DIN = 5120, NL = 2;
constexpr int C_RWKV = 0, C_ATT = 1792, C_S5 = 2560, C_HG = 3072;
constexpr int NTHREADS = 512, NWAVES = 8;

constexpr size_t SZ_UP = (size_t)2 * FF * D * 2, SZ_DN = (size_t)D * FF * 2, SZ_IN = (size_t)DIN * D * 2, SZ_LR = (size_t)1536 * 256 * 2,
                 SZ_GLU = (size_t)512 * 512 * 2, SZ_OUT = (size_t)D * D * 2;
constexpr size_t W_UP1 = 0, W_DN1 = W_UP1 + SZ_UP, W_IN = W_DN1 + SZ_DN, W_LR = W_IN + SZ_IN, W_GLU = W_LR + SZ_LR, W_OUT = W_GLU + SZ_GLU,
                 W_UP2 = W_OUT + SZ_OUT, W_DN2 = W_UP2 + SZ_UP, W_END = W_DN2 + SZ_DN;
constexpr size_t WS_XN = W_END, WS_BIG = WS_XN + (size_t)T * D * 2;
constexpr size_t WS_HID = WS_BIG;
constexpr size_t WS_PROJ = WS_BIG, WS_LRO = WS_PROJ + (size_t)T * DIN * 2, WS_ALR = WS_LRO + (size_t)T * 1536 * 2, WS_Z = WS_ALR + (size_t)T * 256 * 2,
                 WS_OR = WS_Z + (size_t)T * 512 * 2, WS_OH = WS_OR + (size_t)T * 512 * 4, WS_BON = WS_OH + (size_t)T * 512 * 4, WS_YC = WS_BON + (size_t)T * 8 * 4, WS_SS = WS_YC + (size_t)T * D * 2, WS_END = WS_SS + (size_t)3 * T * 4;
static_assert(WS_END <= (size_t)1 << 30, "workspace");
static_assert(WS_HID + (size_t)T * FF * 2 <= (size_t)1 << 30, "workspace");

constexpr int LDS_BYTES = 135168;

struct Args { const void* in[39]; float* out; unsigned char* ws; };
typedef const __attribute__((address_space(4))) Args& ArgsRef;

__device__ __forceinline__ unsigned pk2(float lo, float hi) { unsigned r; asm volatile("v_cvt_pk_bf16_f32 %0, %1, %2" : "=v"(r) : "v"(lo), "v"(hi)); return r; }
__device__ __forceinline__ float bflo(unsigned w) { return __uint_as_float(w << 16); }
__device__ __forceinline__ float bfhi(unsigned w) { return __uint_as_float(w & 0xffff0000u); }
__device__ __forceinline__ void unpack8(u32x4 q, float* f) { f[0] = bflo(q.x); f[1] = bfhi(q.x); f[2] = bflo(q.y); f[3] = bfhi(q.y); f[4] = bflo(q.z); f[5] = bfhi(q.z); f[6] = bflo(q.w); f[7] = bfhi(q.w); }
__device__ __forceinline__ u32x4 pack8(const float* f) { u32x4 o; o.x = pk2(f[0], f[1]); o.y = pk2(f[2], f[3]); o.z = pk2(f[4], f[5]); o.w = pk2(f[6], f[7]); return o; }
template <int CTRL> __device__ __forceinline__ float dpp(float x) { return __builtin_bit_cast(float, __builtin_amdgcn_mov_dpp(__builtin_bit_cast(int, x), CTRL, 0xf, 0xf, true)); }
constexpr int XOR1 = 0xB1, XOR2 = 0x4E, XOR7 = 0x141, XOR8 = 0x128;
__device__ __forceinline__ float red8(float v) { v += dpp<XOR1>(v); v += dpp<XOR2>(v); v += dpp<XOR7>(v); return v; }
__device__ __forceinline__ float red16(float v) { v = red8(v); v += dpp<XOR8>(v); return v; }
__device__ __forceinline__ float wave_sum(float v) {
#pragma unroll
    for (int o = 1; o < 64; o <<= 1) v += __shfl_xor(v, o);
    return v;
}
__device__ __forceinline__ float sigmoidf_(float x) { return 1.0f / (1.0f + __expf(-x)); }
__device__ __forceinline__ float siluf_(float x) { return x / (1.0f + __expf(-x)); }
__device__ __forceinline__ int opaque_tid() { int t = threadIdx.x; asm volatile("" : "+v"(t)); return t; }
__device__ __forceinline__ int opaque_bid() { int t = blockIdx.x; asm volatile("" : "+s"(t)); return t; }
__device__ __forceinline__ f32x2 pfma(f32x2 a, f32x2 b, f32x2 c) { return __builtin_elementwise_fma(a, b, c); }
#define LDS_FENCE() asm volatile("s_waitcnt lgkmcnt(0)" ::: "memory")
__device__ __forceinline__ void sincos_big(float x, float& sn, float& cs) {
    const float n = rintf(x * 0.15915494309189535f);
    float r = fmaf(-n, 6.28318548202514648f, x); r = fmaf(-n, -1.7484555e-7f, r);
    sn = __sinf(r); cs = __cosf(r);
}

namespace pg8 {
constexpr int BM = 256, BK = 64, HALF = 128, HTB = HALF * BK * 2, STAGE_BYTES = 8 * HTB, NXCD = 8, WGM = 8;
__host__ __device__ __forceinline__ int lds_byte(int r, int c) { const int st = (r >> 4) * 2 + (c >> 5), rr = r & 15, cc = c & 31, ob = rr * 64 + cc * 2; return st * 1024 + (ob ^ (((ob >> 9) & 1) << 5)); }
__host__ __device__ __forceinline__ void stage_rc(int b, int& R, int& C) { const int st = b / 1024, sb = b % 1024, swz = sb ^ (((sb >> 9) & 1) << 5); R = (st >> 1) * 16 + swz / 64; C = (st & 1) * 32 + (swz % 64) / 2; }
__host__ __device__ __forceinline__ int perm32(int rho) { const int n = rho >> 4, i = rho & 15; return 8 * (i >> 2) + 4 * n + (i & 3); }
struct Unit { int pm, pn; };
struct Gemm { const bf16_t* A; const bf16_t* Bt; int M, N, K; };
struct StaticOrder {
    int nM, nN, nwg, G, c;
    __device__ void init(int M, int N, int G_, int c_) { nM = M / BM; nN = N / BM; nwg = nM * nN; G = G_; c = c_; }
    __device__ bool next(int i, Unit& u) const {
        const long L = (long)i * G + c; if (L >= nwg) return false;
        int wgid = (int)L; { const int q = nwg / NXCD, r = nwg % NXCD, xcd = wgid % NXCD, off = wgid / NXCD; wgid = (xcd < r ? xcd * (q + 1) : r * (q + 1) + (xcd - r) * q) + off; }
        const int nig = WGM * nN, gid = wgid / nig, fm = gid * WGM, gsz = (nM - fm) < WGM ? (nM - fm) : WGM;
        u.pm = fm + ((wgid % nig) % gsz); u.pn = (wgid % nig) / gsz; return true;
    }
};
template <class Epi>
__device__ __forceinline__ void gemm_phase(LAS unsigned char* lds, const Gemm g, const StaticOrder S, const Epi E) {
    const int TID = opaque_tid(), BID = opaque_bid(); (void)TID; (void)BID;
    const int tid = TID, wid = __builtin_amdgcn_readfirstlane(tid >> 6), lane = tid & 63, wr = wid >> 2, wc = wid & 3, fr = lane & 15, fq = lane >> 4;
    const int K = g.K, nt = K / BK;
    unsigned voffA[2], voffB[2];
#pragma unroll
    for (int i = 0; i < 2; ++i) { int R, C; stage_rc(tid * 16 + i * 8192, R, C); const int Rb = Epi::PERM ? ((R & ~31) + perm32(R & 31)) : R;
        voffA[i] = (unsigned)(R * K + C) * 2u; voffB[i] = (unsigned)(Rb * K + C) * 2u; }
    const size_t kstep = (size_t)(BK * 2);
    const size_t hstep = (size_t)HALF * K * 2;
    const size_t tstep = 2 * hstep;
    const unsigned ldsw = (unsigned)wid * 1024u;
    const int aoff = lds_byte(wr * 64 + fr, fq * 8), boff = lds_byte(wc * 32 + fr, fq * 8);
#define PG8_SA(b, h) (((b) * 2 + (h)) * HTB)
#define PG8_SB(b, h) ((4 + (b) * 2 + (h)) * HTB)
#define PG8_STAGE(bufoff, gbase, voff) do { _Pragma("unroll") for (int _i = 0; _i < 2; ++_i) \
        __builtin_amdgcn_global_load_lds((const unsigned*)((const char*)(gbase) + (voff)[_i]), (LAS unsigned*)(lds + (bufoff) + ldsw + _i * 8192), 16, 0, 0); } while (0)
#define PG8_LDA(dst, b, h) do { _Pragma("unroll") for (int m = 0; m < 4; ++m) _Pragma("unroll") for (int k = 0; k < 2; ++k) dst[m][k] = *(const LAS bf16x8*)(lds + PG8_SA(b, h) + aoff + m * 2048 + k * 1024); } while (0)
#define PG8_LDB(dst, b, h) do { _Pragma("unroll") for (int n = 0; n < 2; ++n) _Pragma("unroll") for (int k = 0; k < 2; ++k) dst[n][k] = *(const LAS bf16x8*)(lds + PG8_SB(b, h) + boff + n * 2048 + k * 1024); } while (0)
#define PG8_MMA(ai, bj, At, Bt) do { __builtin_amdgcn_s_setprio(1); _Pragma("unroll") for (int m = 0; m < 4; ++m) _Pragma("unroll") for (int n = 0; n < 2; ++n) _Pragma("unroll") for (int k = 0; k < 2; ++k) \
        acc[ai][bj][m][n] = __builtin_amdgcn_mfma_f32_16x16x32_bf16(Bt[n][k], At[m][k], acc[ai][bj][m][n], 0, 0, 0); __builtin_amdgcn_s_setprio(0); } while (0)
#define PG8_WAIT_V(n) asm volatile("s_waitcnt vmcnt(" #n ")" ::: "memory")
#define PG8_WAIT_L(n) asm volatile("s_waitcnt lgkmcnt(" #n ")" ::: "memory")
#define PG8_BAR __builtin_amdgcn_s_barrier()
#define PG8_SCHED __builtin_amdgcn_sched_barrier(0)
    Unit cur, nxt; int ui = 0;
    if (!S.next(0, cur)) return;
    f32x4 acc[2][2][4][2];
#pragma unroll
    for (int a = 0; a < 2; ++a)
#pragma unroll
        for (int b = 0; b < 2; ++b)
#pragma unroll
            for (int m = 0; m < 4; ++m)
#pragma unroll
                for (int n = 0; n < 2; ++n) acc[a][b][m][n] = (f32x4){0.f, 0.f, 0.f, 0.f};
    bf16x8 At[4][2], B0[2][2], B1[2][2];
    const char* cA = (const char*)g.A + (size_t)cur.pm * tstep; const char* cB = (const char*)g.Bt + (size_t)cur.pn * tstep;
    PG8_STAGE(PG8_SB(0, 0), cB, voffB); PG8_STAGE(PG8_SA(0, 0), cA, voffA); PG8_STAGE(PG8_SB(0, 1), cB + hstep, voffB); PG8_STAGE(PG8_SA(0, 1), cA + hstep, voffA);
    if (wr == 1) PG8_BAR;
    PG8_WAIT_V(4); PG8_BAR;
    PG8_STAGE(PG8_SB(1, 0), cB + kstep, voffB); PG8_STAGE(PG8_SA(1, 0), cA + kstep, voffA); PG8_STAGE(PG8_SB(1, 1), cB + hstep + kstep, voffB);
    PG8_WAIT_V(6); PG8_BAR;
    for (;;) {
        const bool has_next = S.next(ui + 1, nxt);
        const char* nA = has_next ? (const char*)g.A + (size_t)nxt.pm * tstep : cA; const char* nB = has_next ? (const char*)g.Bt + (size_t)nxt.pn * tstep : cB;
#pragma unroll 1
        for (int t = 0; t < nt; t += 2) {
            const bool last = (t == nt - 2);
            const char* a1 = cA + (size_t)(t + 1) * kstep;
            const char* a2 = last ? nA : cA + (size_t)(t + 2) * kstep; const char* b2 = last ? nB : cB + (size_t)(t + 2) * kstep;
            const char* a3 = a2 + kstep; const char* b3 = b2 + kstep;
            PG8_LDB(B0, 0, 0); PG8_SCHED; PG8_LDA(At, 0, 0); PG8_STAGE(PG8_SA(1, 1), a1 + hstep, voffA);
            PG8_WAIT_L(8); PG8_BAR; PG8_WAIT_L(0); PG8_MMA(0, 0, At, B0); PG8_BAR; PG8_SCHED;
            PG8_LDB(B1, 0, 1); PG8_STAGE(PG8_SB(0, 0), b2, voffB);
            PG8_BAR; PG8_WAIT_L(0); PG8_MMA(0, 1, At, B1); PG8_BAR;
            PG8_LDA(At, 0, 1); PG8_STAGE(PG8_SA(0, 0), a2, voffA);
            PG8_BAR; PG8_WAIT_L(0); PG8_MMA(1, 0, At, B0); PG8_BAR; PG8_SCHED;
            PG8_STAGE(PG8_SB(0, 1), b2 + hstep, voffB);
            PG8_WAIT_V(6); PG8_BAR; PG8_MMA(1, 1, At, B1); PG8_BAR;
            PG8_LDB(B0, 1, 0); PG8_SCHED; PG8_LDA(At, 1, 0); PG8_STAGE(PG8_SA(0, 1), a2 + hstep, voffA);
            PG8_WAIT_L(8); PG8_BAR; PG8_WAIT_L(0); PG8_MMA(0, 0, At, B0); PG8_BAR; PG8_SCHED;
            PG8_LDB(B1, 1, 1); PG8_STAGE(PG8_SB(1, 0), b3, voffB);
            PG8_BAR; PG8_WAIT_L(0); PG8_MMA(0, 1, At, B1); PG8_BAR;
            PG8_LDA(At, 1, 1); PG8_STAGE(PG8_SA(1, 0), a3, voffA);
            PG8_BAR; PG8_WAIT_L(0); PG8_MMA(1, 0, At, B0); PG8_BAR; PG8_SCHED;
            PG8_STAGE(PG8_SB(1, 1), b3 + hstep, voffB);
            PG8_WAIT_V(6); PG8_BAR; PG8_MMA(1, 1, At, B1); PG8_BAR;
        }
        E(acc, cur, wr, wc, fr, fq);
        if (!has_next) break;
#pragma unroll
        for (int a = 0; a < 2; ++a)
#pragma unroll
            for (int b = 0; b < 2; ++b)
#pragma unroll
                for (int m = 0; m < 4; ++m)
#pragma unroll
                    for (int n = 0; n < 2; ++n) acc[a][b][m][n] = (f32x4){0.f, 0.f, 0.f, 0.f};
        cur = nxt; cA = nA; cB = nB; ++ui;
    }
    PG8_WAIT_V(0);
    if (wr == 0) PG8_BAR;
    PG8_BAR;
#undef PG8_SA
#undef PG8_SB
#undef PG8_STAGE
#undef PG8_LDA
#undef PG8_LDB
#undef PG8_MMA
#undef PG8_WAIT_V
#undef PG8_WAIT_L
#undef PG8_BAR
#undef PG8_SCHED
}

struct EpiSwiGLU {
    static constexpr bool PERM = true;
    bf16_t* H; const float* SS;
    __device__ __forceinline__ void operator()(const f32x4 (&acc)[2][2][4][2], const Unit& u, int wr, int wc, int fr, int fq) const {
        const int row0 = u.pm * BM + wr * 64 + fr, col0 = u.pn * 128 + wc * 32 + 8 * fq;
#pragma unroll
        for (int ai = 0; ai < 2; ++ai)
#pragma unroll
            for (int m = 0; m < 4; ++m) {
                const float rs = 1.0f / sqrtf(SS[row0 + ai * HALF + m * 16] * (1.0f / D) + 1e-6f);
                float v[8];
#pragma unroll
                for (int n = 0; n < 2; ++n)
#pragma unroll
                    for (int j = 0; j < 4; ++j) { const float gt = acc[ai][0][m][n][j] * rs, up = acc[ai][1][m][n][j] * rs; v[4 * n + j] = siluf_(gt) * up; }
                *(u32x4*)(H + (size_t)(row0 + ai * HALF + m * 16) * FF + col0) = pack8(v);
            }
    }
};
template <bool HALFSTEP> struct EpiResidual {
    static constexpr bool PERM = false;
    static constexpr float scale = HALFSTEP ? 0.5f : 1.0f;
    const float* base; float* out; bf16_t* XN; float* SS;
    __device__ __forceinline__ void operator()(const f32x4 (&acc)[2][2][4][2], const Unit& u, int wr, int wc, int fr, int fq) const {
        const int row0 = u.pm * BM + wr * 64 + fr, col0 = u.pn * BM + wc * 32 + 4 * fq;
#pragma unroll
        for (int ai = 0; ai < 2; ++ai)
#pragma unroll
            for (int m = 0; m < 4; ++m) { const int row = row0 + ai * HALF + m * 16; const size_t ro = (size_t)row * D + col0; float ss = 0.f;
#pragma unroll
                for (int bj = 0; bj < 2; ++bj)
#pragma unroll
                    for (int n = 0; n < 2; ++n) { const f32x4 b = *(const f32x4*)(base + ro + bj * HALF + n * 16); const f32x4 r = b + acc[ai][bj][m][n] * scale; *(f32x4*)(out + ro + bj * HALF + n * 16) = r;
                        if (XN) { u32x2 w; w.x = pk2(r.x, r.y); w.y = pk2(r.z, r.w); *(u32x2*)(XN + ro + bj * HALF + n * 16) = w; ss += (r.x * r.x + r.y * r.y) + (r.z * r.z + r.w * r.w); } }
                if (XN) { ss += __shfl_xor(ss, 16); ss += __shfl_xor(ss, 32); if (fq == 0) atomicAdd(SS + row, ss); } }
    }
};
struct EpiBf16 {
    static constexpr bool PERM = true;
    bf16_t* O; int ldc; const float* SS;
    __device__ __forceinline__ void operator()(const f32x4 (&acc)[2][2][4][2], const Unit& u, int wr, int wc, int fr, int fq) const {
        const int row0 = u.pm * BM + wr * 64 + fr, col0 = u.pn * BM + wc * 32 + 8 * fq;
#pragma unroll
        for (int ai = 0; ai < 2; ++ai)
#pragma unroll
            for (int m = 0; m < 4; ++m) { bf16_t* rowp = O + (size_t)(row0 + ai * HALF + m * 16) * ldc + col0;
                const float rs = 1.0f / sqrtf(SS[row0 + ai * HALF + m * 16] * (1.0f / D) + 1e-6f);
#pragma unroll
                for (int bj = 0; bj < 2; ++bj) { const f32x4 v0 = acc[ai][bj][m][0] * rs, v1 = acc[ai][bj][m][1] * rs;
                    u32x4 w; w.x = pk2(v0[0], v0[1]); w.y = pk2(v0[2], v0[3]); w.z = pk2(v1[0], v1[1]); w.w = pk2(v1[2], v1[3]);
                    *(u32x4*)(rowp + bj * HALF) = w; } }
    }
};
struct EpiLR {
    static constexpr bool PERM = true;
    bf16_t* O; const float* w0; const float* a0;
    template <int KIND> __device__ __forceinline__ void body(const f32x4 (&acc)[2][2][4][2], const float* bp, int row0, int col0) const {
#pragma unroll
        for (int bj = 0; bj < 2; ++bj) {
            f32x4 b0 = (f32x4){0.f, 0.f, 0.f, 0.f}, b1 = b0;
            if (KIND < 2) { b0 = *(const f32x4*)(bp + bj * HALF); b1 = *(const f32x4*)(bp + bj * HALF + 4); }
#pragma unroll
            for (int ai = 0; ai < 2; ++ai)
#pragma unroll
                for (int m = 0; m < 4; ++m) {
                    u32x4 w;
#pragma unroll
                    for (int n = 0; n < 2; ++n) {
                        float r[4];
#pragma unroll
                        for (int j = 0; j < 4; ++j) { const float x = acc[ai][bj][m][n][j] + (n == 0 ? b0[j] : b1[j]);
                            if (KIND == 0) { const float e = __expf(-x); r[j] = -0.60653065971f / (1.0f + e); }
                            else if (KIND == 1) r[j] = 1.0f / (1.0f + __expf(-x)); else r[j] = x; }
                        if (n == 0) { w.x = pk2(r[0], r[1]); w.y = pk2(r[2], r[3]); } else { w.z = pk2(r[0], r[1]); w.w = pk2(r[2], r[3]); }
                    }
                    *(u32x4*)(O + (size_t)(row0 + ai * HALF + m * 16) * 1536 + col0 + bj * HALF) = w;
                }
        }
    }
    __device__ __forceinline__ void operator()(const f32x4 (&acc)[2][2][4][2], const Unit& u, int wr, int wc, int fr, int fq) const {
        const int row0 = u.pm * BM + wr * 64 + fr, col0 = u.pn * BM + wc * 32 + 8 * fq, kind = u.pn >> 1, f0 = col0 - 512 * kind;
        if (kind == 0) body<0>(acc, w0 + f0, row0, col0); else if (kind == 1) body<1>(acc, a0 + f0, row0, col0); else body<2>(acc, nullptr, row0, col0);
    }
};
struct EpiGLU {
    static constexpr bool PERM = true;
    const bf16_t* Z; bf16_t* Y; const float* b;
    __device__ __forceinline__ void operator()(const f32x4 (&acc)[2][2][4][2], const Unit& u, int wr, int wc, int fr, int fq) const {
        const int row0 = u.pm * BM + wr * 64 + fr, col0 = u.pn * BM + wc * 32 + 8 * fq;
#pragma unroll
        for (int bj = 0; bj < 2; ++bj) {
            const f32x4 bias0 = *(const f32x4*)(b + col0 + bj * HALF), bias1 = *(const f32x4*)(b + col0 + bj * HALF + 4);
#pragma unroll
            for (int ai = 0; ai < 2; ++ai)
#pragma unroll
                for (int m = 0; m < 4; ++m) { const size_t r = (size_t)(row0 + ai * HALF + m * 16);
                    float z[8], v[8]; unpack8(*(const u32x4*)(Z + r * 512 + col0 + bj * HALF), z);
#pragma unroll
                    for (int n = 0; n < 2; ++n)
#pragma unroll
                        for (int j = 0; j < 4; ++j) v[4 * n + j] = z[4 * n + j] * sigmoidf_(acc[ai][bj][m][n][j] + (n == 0 ? bias0[j] : bias1[j]));
                    *(u32x4*)(Y + r * D + 1024 + col0 + bj * HALF) = pack8(v); }
        }
    }
};
}

template <class Epi> __device__ __forceinline__ void run_gemm(LAS unsigned char* lds, const bf16_t* A, const bf16_t* Bt, int N, int K, const Epi E) {
    pg8::Gemm g; g.A = A; g.Bt = Bt; g.M = T; g.N = N; g.K = K;
    pg8::StaticOrder S; S.init(T, N, gridDim.x, opaque_bid());
    pg8::gemm_phase<Epi>(lds, g, S, E);
}

__device__ __forceinline__ void tr_item(const float* W, int ldw, int k0, int n0, const float* gs, bf16_t* Dst, int ldd, int drow0, int dk0, LAS float* scr, int lane) {
    if (W) {
#pragma unroll 8
        for (int i = 0; i < 32; ++i) { const int kk = 2 * i + (lane >> 5); float v = W[(size_t)(k0 + kk) * ldw + n0 + (lane & 31)]; if (gs) v *= gs[k0 + kk]; scr[kk * 33 + (lane & 31)] = v; }
    } else {
#pragma unroll 8
        for (int i = 0; i < 32; ++i) { const int kk = 2 * i + (lane >> 5); scr[kk * 33 + (lane & 31)] = 0.f; }
    }
    LDS_FENCE();
    const int c = lane & 7;
#pragma unroll
    for (int j = 0; j < 4; ++j) { const int n = (lane >> 3) + 8 * j; const LAS float* s = scr + (8 * c) * 33 + n;
        u32x4 o; o.x = pk2(s[0 * 33], s[1 * 33]); o.y = pk2(s[2 * 33], s[3 * 33]); o.z = pk2(s[4 * 33], s[5 * 33]); o.w = pk2(s[6 * 33], s[7 * 33]);
        *(u32x4*)(Dst + (size_t)(drow0 + n) * ldd + dk0 + k0 - 0 + 8 * c - 0) = o; }
    LDS_FENCE();
}

__device__ __forceinline__ void conv_phase(ArgsRef a, int l, LAS unsigned char* lds) {
    const int TID = opaque_tid(), BID = opaque_bid(); (void)TID; (void)BID;
    const int wave = TID >> 6, lane = TID & 63;
    LAS float* scr = (LAS float*)(lds + wave * 8704);
    const int gw = BID * NWAVES + wave, NGW = gridDim.x * NWAVES;
    unsigned char* ws = a.ws;
    constexpr int I_GU = (D / 64) * (FF / 32), I_DN = (FF / 64) * (D / 32), I_IN = (D / 64) * (DIN / 32), I_OUT = (D / 64) * (D / 32), I_GLU = 8 * 16, I_LR = 48 * 4;
    constexpr int NITEMS = 6 * I_GU + I_IN + I_OUT + I_GLU + I_LR;
    static_assert(I_GU == I_DN, "items");
    for (int it = gw; it < NITEMS; it += NGW) {
        int r = it;
        if (r < 6 * I_GU) {
            const int which = r / I_GU; r -= which * I_GU;
            const int f = which >= 3, m = which % 3;
            if (m < 2) {
                const float* W = (const float*)a.in[(f ? 36 : 3) + m] + (size_t)l * D * FF;
                const float* gs = (const float*)a.in[f ? 35 : 2] + (size_t)l * D;
                bf16_t* dst = (bf16_t*)(ws + (f ? W_UP2 : W_UP1));
                const int nblk = FF / 32, kb = r / nblk, nb = r % nblk, n0 = 32 * nb;
                tr_item(W, FF, 64 * kb, n0, gs, dst, D, (n0 >> 7) * 256 + (n0 & 127) + 128 * m, 0, scr, lane);
            } else {
                const float* W = (const float*)a.in[f ? 38 : 5] + (size_t)l * FF * D;
                bf16_t* dst = (bf16_t*)(ws + (f ? W_DN2 : W_DN1));
                const int nblk = D / 32, kb = r / nblk, nb = r % nblk;
                tr_item(W, D, 64 * kb, 32 * nb, nullptr, dst, FF, 32 * nb, 0, scr, lane);
            }
            continue;
        }
        r -= 6 * I_GU;
        if (r < I_IN) { const int nblk = DIN / 32, kb = r / nblk, nb = r % nblk;
            tr_item((const float*)a.in[7] + (size_t)l * D * DIN, DIN, 64 * kb, 32 * nb, (const float*)a.in[6] + (size_t)l * D, (bf16_t*)(ws + W_IN), D, 32 * nb, 0, scr, lane); continue; }
        r -= I_IN;
        if (r < I_OUT) { const int nblk = D / 32, kb = r / nblk, nb = r % nblk;
            tr_item((const float*)a.in[34] + (size_t)l * D * D, D, 64 * kb, 32 * nb, nullptr, (bf16_t*)(ws + W_OUT), D, 32 * nb, 0, scr, lane); continue; }
        r -= I_OUT;
        if (r < I_GLU) { const int kb = r / 16, nb = r % 16;
            tr_item((const float*)a.in[30] + (size_t)l * 512 * 512, 512, 64 * kb, 32 * nb, nullptr, (bf16_t*)(ws + W_GLU), 512, 32 * nb, 0, scr, lane); continue; }
        r -= I_GLU;
        {
            const int nb = r >> 2, kb = r & 3, kind = nb >> 4, nn0 = 32 * (nb & 15);
            const float* W = nullptr; int k0 = 0;
            if (kind == 0 && kb == 0) { W = (const float*)a.in[10] + (size_t)l * 64 * 512; k0 = 0; }
            else if (kind == 1 && kb == 1) { W = (const float*)a.in[12] + (size_t)l * 64 * 512; k0 = 0; }
            else if (kind == 2 && kb >= 2) { W = (const float*)a.in[13] + (size_t)l * 128 * 512; k0 = 64 * (kb - 2); }
            tr_item(W, 512, k0, nn0, nullptr, (bf16_t*)(ws + W_LR), 256, 32 * nb, 64 * kb - k0, scr, lane);
        }
    }
}

__device__ __forceinline__ void norm_phase(const float* x, bf16_t* XN, float* SS) {
    const int TID = opaque_tid(), BID = opaque_bid(); (void)TID; (void)BID;
    const int wave = TID >> 6, lane = TID & 63;
    const int gw = BID * NWAVES + wave, NGW = gridDim.x * NWAVES;
    for (int m = gw; m < T; m += NGW) {
        const f32x4* xr = (const f32x4*)(x + (size_t)m * D) + lane;
        f32x4 v[8]; float s = 0.f;
#pragma unroll
        for (int j = 0; j < 8; ++j) { v[j] = xr[64 * j]; s += (v[j].x * v[j].x + v[j].y * v[j].y) + (v[j].z * v[j].z + v[j].w * v[j].w); }
        s = wave_sum(s); if (lane == 0) SS[m] = s;
        u32x2* o = (u32x2*)(XN + (size_t)m * D) + lane;
#pragma unroll
        for (int j = 0; j < 8; ++j) { u32x2 w; w.x = pk2(v[j].x, v[j].y); w.y = pk2(v[j].z, v[j].w); o[64 * j] = w; }
    }
}

__device__ __forceinline__ void zero_phase(float* p, int n) {
    const int TID = opaque_tid(), BID = opaque_bid();
    for (int i = BID * NTHREADS + TID; i < n; i += gridDim.x * NTHREADS) p[i] = 0.f;
}
__device__ __forceinline__ void alr_phase(ArgsRef a, int l) {
    const int TID = opaque_tid(), BID = opaque_bid(); (void)TID; (void)BID;
    const bf16_t* P = (const bf16_t*)(a.ws + WS_PROJ); bf16_t* ALR = (bf16_t*)(a.ws + WS_ALR);
    const float* mu = (const float*)a.in[8] + (size_t)l * 1792 + 1536;
    const int gt = BID * NTHREADS + TID, NGT = gridDim.x * NTHREADS;
    for (int it = gt; it < T * 32; it += NGT) {
        const int t = it >> 5, cg = it & 31, c0 = 8 * cg;
        float cur[8], prv[8], o[8];
        unpack8(*(const u32x4*)(P + (size_t)t * DIN + 1536 + c0), cur);
        if ((t & (SEQ - 1)) != 0) unpack8(*(const u32x4*)(P + (size_t)(t - 1) * DIN + 1536 + c0), prv);
        else {
#pragma unroll
            for (int j = 0; j < 8; ++j) prv[j] = 0.f; }
#pragma unroll
        for (int j = 0; j < 8; ++j) { const float v = cur[j] + (prv[j] - cur[j]) * mu[c0 + j];
            o[j] = c0 < 64 ? tanhf(v) : (c0 < 128 ? v : sigmoidf_(v)); }
        *(u32x4*)(ALR + (size_t)t * 256 + c0) = pack8(o);
    }
}

__device__ __forceinline__ void rwkv_phase(ArgsRef a, int l, LAS unsigned char* lds) {
    const int TID = opaque_tid(), BID = opaque_bid(); (void)TID; (void)BID;
    const bf16_t* P = (const bf16_t*)(a.ws + WS_PROJ); const bf16_t* LR = (const bf16_t*)(a.ws + WS_LRO);
    float* OR = (float*)(a.ws + WS_OR); float* BON = (float*)(a.ws + WS_BON);
    LAS float* sR = (LAS float*)lds; LAS float* sW = sR + 4096; LAS float* sK = sW + 4096; LAS float* sKK = sK + 4096; LAS float* sB = sKK + 4096;
    LAS float* sV = sB + 4096; LAS float* sO = sV + 2048;
    const int tid = TID, wave = tid >> 6, lane = tid & 63;
    const int tt = tid >> 3, cg = tid & 7;
    for (int job = BID; job < 256; job += gridDim.x) {
        const int b = job >> 4, h = (job >> 1) & 7, half = job & 1;
        const int c0 = 64 * h + 8 * cg;
        float mur[8], muk[8], muv[8], kkw[8], kaw[8], rkw[8];
#pragma unroll
        for (int j = 0; j < 8; ++j) {
            mur[j] = ((const float*)a.in[8])[(size_t)l * 1792 + c0 + j]; muk[j] = ((const float*)a.in[8])[(size_t)l * 1792 + 512 + c0 + j]; muv[j] = ((const float*)a.in[8])[(size_t)l * 1792 + 1024 + c0 + j];
            kkw[j] = ((const float*)a.in[14])[(size_t)l * 512 + c0 + j]; kaw[j] = ((const float*)a.in[15])[(size_t)l * 512 + c0 + j]; rkw[j] = ((const float*)a.in[16])[(size_t)l * 512 + c0 + j]; }
        f32x2 stA = (f32x2){0.f, 0.f}, stB = stA;
        const int rloc = 4 * wave + (lane >> 4), jq = lane & 15;
        for (int ch = 0; ch < SEQ / 64; ++ch) {
            __syncthreads();
            {
                const int s = ch * 64 + tt; const size_t t = (size_t)b * SEQ + s;
                float r[8], k[8], v[8], pr[8], ld[8], av[8];
                unpack8(*(const u32x4*)(P + t * DIN + c0), r); unpack8(*(const u32x4*)(P + t * DIN + 512 + c0), k); unpack8(*(const u32x4*)(P + t * DIN + 1024 + c0), v);
                if (s != 0) {
                    unpack8(*(const u32x4*)(P + (t - 1) * DIN + c0), pr);
#pragma unroll
                    for (int j = 0; j < 8; ++j) r[j] += (pr[j] - r[j]) * mur[j];
                    unpack8(*(const u32x4*)(P + (t - 1) * DIN + 512 + c0), pr);
#pragma unroll
                    for (int j = 0; j < 8; ++j) k[j] += (pr[j] - k[j]) * muk[j];
                    unpack8(*(const u32x4*)(P + (t - 1) * DIN + 1024 + c0), pr);
#pragma unroll
                    for (int j = 0; j < 8; ++j) v[j] += (pr[j] - v[j]) * muv[j];
                } else {
#pragma unroll
                    for (int j = 0; j < 8; ++j) { r[j] -= r[j] * mur[j]; k[j] -= k[j] * muk[j]; v[j] -= v[j] * muv[j]; }
                }
                unpack8(*(const u32x4*)(LR + t * 1536 + c0), ld); unpack8(*(const u32x4*)(LR + t * 1536 + 512 + c0), av);
                float kk[8], ss = 0.f, bp = 0.f;
#pragma unroll
                for (int j = 0; j < 8; ++j) { kk[j] = k[j] * kkw[j]; ss += kk[j] * kk[j]; }
                ss = red8(ss);
                const float inv = 1.0f / sqrtf(fmaxf(ss, 1e-24f));
                float w8[8], k8[8], b8[8];
#pragma unroll
                for (int j = 0; j < 8; ++j) { kk[j] *= inv; k8[j] = k[j] * (1.0f + (av[j] - 1.0f) * kaw[j]); b8[j] = kk[j] * av[j]; w8[j] = __expf(ld[j]); bp += r[j] * k8[j] * rkw[j]; }
                bp = red8(bp);
                if (half == 0 && cg == 0) BON[t * 8 + h] = bp;
                LAS float* d;
                d = sR + tt * 64 + 8 * cg; *(LAS f32x4*)d = (f32x4){r[0], r[1], r[2], r[3]}; *(LAS f32x4*)(d + 4) = (f32x4){r[4], r[5], r[6], r[7]};
                d = sW + tt * 64 + 8 * cg; *(LAS f32x4*)d = (f32x4){w8[0], w8[1], w8[2], w8[3]}; *(LAS f32x4*)(d + 4) = (f32x4){w8[4], w8[5], w8[6], w8[7]};
                d = sK + tt * 64 + 8 * cg; *(LAS f32x4*)d = (f32x4){k8[0], k8[1], k8[2], k8[3]}; *(LAS f32x4*)(d + 4) = (f32x4){k8[4], k8[5], k8[6], k8[7]};
                d = sKK + tt * 64 + 8 * cg; *(LAS f32x4*)d = (f32x4){kk[0], kk[1], kk[2], kk[3]}; *(LAS f32x4*)(d + 4) = (f32x4){kk[4], kk[5], kk[6], kk[7]};
                d = sB + tt * 64 + 8 * cg; *(LAS f32x4*)d = (f32x4){b8[0], b8[1], b8[2], b8[3]}; *(LAS f32x4*)(d + 4) = (f32x4){b8[4], b8[5], b8[6], b8[7]};
                if ((cg >> 2) == half) { d = sV + tt * 32 + 8 * (cg & 3); *(LAS f32x4*)d = (f32x4){v[0], v[1], v[2], v[3]}; *(LAS f32x4*)(d + 4) = (f32x4){v[4], v[5], v[6], v[7]}; }
            }
            __syncthreads();
#pragma unroll 2
            for (int s = 0; s < 64; ++s) {
                const f32x4 w4 = *(const LAS f32x4*)(sW + s * 64 + 4 * jq), kk4 = *(const LAS f32x4*)(sKK + s * 64 + 4 * jq), b4 = *(const LAS f32x4*)(sB + s * 64 + 4 * jq),
                            k4 = *(const LAS f32x4*)(sK + s * 64 + 4 * jq), r4 = *(const LAS f32x4*)(sR + s * 64 + 4 * jq);
                const float vi = sV[s * 32 + rloc];
                const f32x2 pa = pfma(stB, (f32x2){kk4.z, kk4.w}, stA * (f32x2){kk4.x, kk4.y});
                const float sa = -red16(pa.x + pa.y);
                const f32x2 sa2 = (f32x2){sa, sa}, vi2 = (f32x2){vi, vi};
                const f32x2 tA = pfma(vi2, (f32x2){k4.x, k4.y}, sa2 * (f32x2){b4.x, b4.y}), tB = pfma(vi2, (f32x2){k4.z, k4.w}, sa2 * (f32x2){b4.z, b4.w});
                stA = pfma(stA, (f32x2){w4.x, w4.y}, tA); stB = pfma(stB, (f32x2){w4.z, w4.w}, tB);
                const f32x2 py = pfma(stB, (f32x2){r4.z, r4.w}, stA * (f32x2){r4.x, r4.y});
                const float y = red16(py.x + py.y);
                if (jq == 0) sO[s * 32 + rloc] = y;
            }
            __syncthreads();
            {
                const int s = ch * 64 + tt; const size_t t = (size_t)b * SEQ + s;
                *(f32x4*)(OR + t * 512 + 64 * h + 32 * half + 4 * cg) = *(const LAS f32x4*)(sO + tt * 32 + 4 * cg);
            }
        }
    }
    __syncthreads();
}

__device__ __forceinline__ void hgrn_phase(ArgsRef a, int l, LAS unsigned char* lds) {
    const int TID = opaque_tid(), BID = opaque_bid(); (void)TID; (void)BID;
    const bf16_t* P = (const bf16_t*)(a.ws + WS_PROJ); float* OH = (float*)(a.ws + WS_OH);
    LAS float* sQ = (LAS float*)lds; LAS float* sF = sQ + 4096; LAS float* sV = sF + 4096; LAS float* sO = sV + 2048;
    const int tid = TID, wave = tid >> 6, lane = tid & 63;
    const int tt = tid >> 3, cg = tid & 7;
    const float* lbp = (const float*)a.in[32];
    for (int job = BID; job < 256; job += gridDim.x) {
        const int b = job >> 4, h = (job >> 1) & 7, half = job & 1;
        const int c0 = 64 * h + 8 * cg;
        float lb[8];
#pragma unroll
        for (int j = 0; j < 8; ++j) lb[j] = (l == 0) ? 0.f : sigmoidf_(lbp[512 + c0 + j] - lbp[c0 + j]);
        f32x2 stA = (f32x2){0.f, 0.f}, stB = stA;
        const int cloc = 4 * wave + (lane >> 4), dq = lane & 15;
        for (int ch = 0; ch < SEQ / 64; ++ch) {
            __syncthreads();
            {
                const int s = ch * 64 + tt; const size_t t = (size_t)b * SEQ + s;
                float q[8], f[8];
                unpack8(*(const u32x4*)(P + t * DIN + C_HG + c0), q); unpack8(*(const u32x4*)(P + t * DIN + C_HG + 512 + c0), f);
#pragma unroll
                for (int j = 0; j < 8; ++j) { q[j] = siluf_(q[j]) * 0.125f; f[j] = lb[j] + (1.0f - lb[j]) * sigmoidf_(f[j]); }
                LAS float* d;
                d = sQ + tt * 64 + 8 * cg; *(LAS f32x4*)d = (f32x4){q[0], q[1], q[2], q[3]}; *(LAS f32x4*)(d + 4) = (f32x4){q[4], q[5], q[6], q[7]};
                d = sF + tt * 64 + 8 * cg; *(LAS f32x4*)d = (f32x4){f[0], f[1], f[2], f[3]}; *(LAS f32x4*)(d + 4) = (f32x4){f[4], f[5], f[6], f[7]};
                const u32x2 vv = *(const u32x2*)(P + t * DIN + C_HG + 1024 + 64 * h + 32 * half + 4 * cg);
                *(LAS f32x4*)(sV + tt * 32 + 4 * cg) = (f32x4){bflo(vv.x), bfhi(vv.x), bflo(vv.y), bfhi(vv.y)};
            }
            __syncthreads();
#pragma unroll 2
            for (int s = 0; s < 64; ++s) {
                const f32x4 f4 = *(const LAS f32x4*)(sF + s * 64 + 4 * dq), q4 = *(const LAS f32x4*)(sQ + s * 64 + 4 * dq);
                const float vi = sV[s * 32 + cloc];
                const f32x2 vi2 = (f32x2){vi, vi};
                stA = pfma((f32x2){f4.x, f4.y}, stA - vi2, vi2); stB = pfma((f32x2){f4.z, f4.w}, stB - vi2, vi2);
                const f32x2 py = pfma(stB, (f32x2){q4.z, q4.w}, stA * (f32x2){q4.x, q4.y});
                const float y = red16(py.x + py.y);
                if (dq == 0) sO[s * 32 + cloc] = y;
            }
            __syncthreads();
            {
                const int s = ch * 64 + tt; const size_t t = (size_t)b * SEQ + s;
                *(f32x4*)(OH + t * 512 + 64 * h + 32 * half + 4 * cg) = *(const LAS f32x4*)(sO + tt * 32 + 4 * cg);
            }
        }
    }
    __syncthreads();
}

__device__ __forceinline__ void post_phase(ArgsRef a, int l) {
    const int TID = opaque_tid(), BID = opaque_bid(); (void)TID; (void)BID;
    const bf16_t* P = (const bf16_t*)(a.ws + WS_PROJ); const bf16_t* LR = (const bf16_t*)(a.ws + WS_LRO);
    const float* OR = (const float*)(a.ws + WS_OR); const float* OH = (const float*)(a.ws + WS_OH); const float* BON = (const float*)(a.ws + WS_BON);
    bf16_t* Y = (bf16_t*)(a.ws + WS_YC);
    const float* muv = (const float*)a.in[8] + (size_t)l * 1792 + 1024;
    const float* lnw = (const float*)a.in[17] + (size_t)l * 512; const float* lnb = (const float*)a.in[18] + (size_t)l * 512;
    const float* gn = (const float*)a.in[33] + (size_t)l * 64;
    const int gt = BID * NTHREADS + TID, NGT = gridDim.x * NTHREADS;
    for (int it = gt; it < T * 128; it += NGT) {
        const int cg = it & 7, hh = (it >> 3) & 15; const size_t t = (size_t)(it >> 7);
        float o[8], y[8];
        if (hh < 8) {
            const int c0 = 64 * hh + 8 * cg;
            const f32x4 o0 = *(const f32x4*)(OR + t * 512 + c0), o1 = *(const f32x4*)(OR + t * 512 + c0 + 4);
            o[0] = o0.x; o[1] = o0.y; o[2] = o0.z; o[3] = o0.w; o[4] = o1.x; o[5] = o1.y; o[6] = o1.z; o[7] = o1.w;
            float s = 0.f;
#pragma unroll
            for (int j = 0; j < 8; ++j) s += o[j];
            const float mean = red8(s) * (1.0f / 64.0f);
            float q = 0.f;
#pragma unroll
            for (int j = 0; j < 8; ++j) { o[j] -= mean; q += o[j] * o[j]; }
            const float rstd = 1.0f / sqrtf(red8(q) * (1.0f / 64.0f) + 64e-5f);
            float v[8], pv[8], g[8];
            unpack8(*(const u32x4*)(P + t * DIN + 1024 + c0), v);
            if ((t & (SEQ - 1)) != 0) unpack8(*(const u32x4*)(P + (t - 1) * DIN + 1024 + c0), pv);
            else {
#pragma unroll
                for (int j = 0; j < 8; ++j) pv[j] = 0.f; }
            unpack8(*(const u32x4*)(LR + t * 1536 + 1024 + c0), g);
            const float bon = BON[t * 8 + hh];
#pragma unroll
            for (int j = 0; j < 8; ++j) { const float vl = v[j] + (pv[j] - v[j]) * muv[c0 + j];
                y[j] = (o[j] * rstd * lnw[c0 + j] + lnb[c0 + j] + bon * vl) * g[j]; }
            *(u32x4*)(Y + t * D + c0) = pack8(y);
        } else {
            const int h = hh - 8, c0 = 64 * h + 8 * cg;
            const f32x4 o0 = *(const f32x4*)(OH + t * 512 + c0), o1 = *(const f32x4*)(OH + t * 512 + c0 + 4);
            o[0] = o0.x; o[1] = o0.y; o[2] = o0.z; o[3] = o0.w; o[4] = o1.x; o[5] = o1.y; o[6] = o1.z; o[7] = o1.w;
            float q = 0.f;
#pragma unroll
            for (int j = 0; j < 8; ++j) q += o[j] * o[j];
            const float rs = 1.0f / sqrtf(red8(q) * (1.0f / 64.0f) + 1e-6f);
            float g[8];
            unpack8(*(const u32x4*)(P + t * DIN + C_HG + 1536 + c0), g);
#pragma unroll
            for (int j = 0; j < 8; ++j) y[j] = o[j] * rs * gn[8 * cg + j] * siluf_(g[j]);
            *(u32x4*)(Y + t * D + 1536 + c0) = pack8(y);
        }
    }
}

__device__ __forceinline__ void attn_phase(ArgsRef a, int l, LAS unsigned char* lds) {
    const int TID = opaque_tid(), BID = opaque_bid(); (void)TID; (void)BID;
    const bf16_t* P = (const bf16_t*)(a.ws + WS_PROJ); bf16_t* Y = (bf16_t*)(a.ws + WS_YC);
    const int* pos = (const int*)a.in[1];
    const float* qn = (const float*)a.in[19] + (size_t)l * 64; const float* kn = (const float*)a.in[20] + (size_t)l * 64; const float* sinks = (const float*)a.in[21] + (size_t)l * 8;
    LAS float* sK = (LAS float*)lds; LAS float* sV = sK + 256 * 64;
    const int tid = TID, cg = tid & 7;
    float kmaxg = 0.f;
    for (int j = 0; j < 64; ++j) kmaxg = fmaxf(kmaxg, fabsf(kn[j]));
    const float kbound = 8.0f * kmaxg;
    for (int job = BID; job < 512; job += gridDim.x) {
        const int b = job >> 5, nb = (job >> 1) & 15, kvh = job & 1;
        __syncthreads();
#pragma unroll 1
        for (int r = 0; r < 4; ++r) {
            const int kj = (tid >> 3) + 64 * r, s = (nb - 1) * 128 + kj;
            float k[8], v[8];
            if (s >= 0) {
                const size_t t = (size_t)b * SEQ + s;
                unpack8(*(const u32x4*)(P + t * DIN + C_ATT + 512 + 64 * kvh + 8 * cg), k); unpack8(*(const u32x4*)(P + t * DIN + C_ATT + 640 + 64 * kvh + 8 * cg), v);
            } else {
#pragma unroll
                for (int j = 0; j < 8; ++j) { k[j] = 0.f; v[j] = 0.f; } }
            float ss = 0.f;
#pragma unroll
            for (int j = 0; j < 8; ++j) ss += k[j] * k[j];
            ss = red8(ss);
            const float rs = 1.0f / sqrtf(ss * (1.0f / 64.0f) + 1e-6f);
#pragma unroll
            for (int j = 0; j < 8; ++j) k[j] = k[j] * rs * kn[8 * cg + j];
            const float pf = (float)pos[b * SEQ + (s >= 0 ? s : 0)];
#pragma unroll
            for (int j = 0; j < 8; ++j) {
                const float other = dpp<XOR1>(k[j]);
                if (cg < 2) {
                    const float invf = exp2f(-(float)j * (18.931568569324174f / 8.0f));
                    float sn, cs; sincos_big(pf * invf, sn, cs);
                    k[j] = (cg == 0) ? (k[j] * cs - other * sn) : (k[j] * cs + other * sn);
                }
            }
            LAS float* d = sK + kj * 64 + 8 * cg; *(LAS f32x4*)d = (f32x4){k[0], k[1], k[2], k[3]}; *(LAS f32x4*)(d + 4) = (f32x4){k[4], k[5], k[6], k[7]};
            d = sV + kj * 64 + 8 * cg; *(LAS f32x4*)d = (f32x4){v[0], v[1], v[2], v[3]}; *(LAS f32x4*)(d + 4) = (f32x4){v[4], v[5], v[6], v[7]};
        }
        const int g = tid >> 7, qi = tid & 127, hq = 4 * kvh + g;
        const size_t tq = (size_t)b * SEQ + nb * 128 + qi;
        float q[64]; float mshift;
        {
            float ss = 0.f;
#pragma unroll
            for (int c = 0; c < 8; ++c) { float f[8]; unpack8(*(const u32x4*)(P + tq * DIN + C_ATT + 64 * hq + 8 * c), f);
#pragma unroll
                for (int j = 0; j < 8; ++j) { q[8 * c + j] = f[j]; ss += f[j] * f[j]; } }
            const float rs = 1.0f / sqrtf(ss * (1.0f / 64.0f) + 1e-6f);
#pragma unroll
            for (int j = 0; j < 64; ++j) q[j] = q[j] * rs * qn[j];
            const float pf = (float)pos[b * SEQ + nb * 128 + qi];
#pragma unroll
            for (int j = 0; j < 8; ++j) {
                const float invf = exp2f(-(float)j * (18.931568569324174f / 8.0f));
                float sn, cs; sincos_big(pf * invf, sn, cs);
                const float x1 = q[j], x2 = q[j + 8]; q[j] = x1 * cs - x2 * sn; q[j + 8] = x2 * cs + x1 * sn;
            }
            float qq = 0.f;
#pragma unroll
            for (int j = 0; j < 64; ++j) { q[j] *= 0.125f; qq += q[j] * q[j]; }
            mshift = sqrtf(qq) * kbound;
        }
        __syncthreads();
        float acc[64];
#pragma unroll
        for (int j = 0; j < 64; ++j) acc[j] = 0.f;
        float lsum = __expf(sinks[hq] - mshift);
        const int q0 = qi & ~63;
        const int kbeg = (nb == 0) ? 128 : (q0 + 1), kend = q0 + 63 + 128;
#pragma unroll 1
        for (int kj = kbeg; kj <= kend; ++kj) {
            const LAS f32x4* kr = (const LAS f32x4*)(sK + kj * 64);
            float s0 = 0.f, s1 = 0.f, s2 = 0.f, s3 = 0.f;
#pragma unroll
            for (int c = 0; c < 16; ++c) { const f32x4 kv = kr[c]; s0 += q[4 * c] * kv.x; s1 += q[4 * c + 1] * kv.y; s2 += q[4 * c + 2] * kv.z; s3 += q[4 * c + 3] * kv.w; }
            const float sc = (s0 + s1) + (s2 + s3);
            const bool valid = (kj >= qi + 1) && (kj <= qi + 128);
            const float p = valid ? __expf(sc - mshift) : 0.f;
            lsum += p;
            const LAS f32x4* vr = (const LAS f32x4*)(sV + kj * 64);
#pragma unroll
            for (int c = 0; c < 16; ++c) { const f32x4 vv = vr[c]; acc[4 * c] += p * vv.x; acc[4 * c + 1] += p * vv.y; acc[4 * c + 2] += p * vv.z; acc[4 * c + 3] += p * vv.w; }
        }
        const float inv = 1.0f / lsum;
#pragma unroll
        for (int c = 0; c < 8; ++c) { float o[8];
#pragma unroll
            for (int j = 0; j < 8; ++j) o[j] = acc[8 * c + j] * inv;
            *(u32x4*)(Y + tq * D + 512 + 64 * hq + 8 * c) = pack8(o); }
    }
    __syncthreads();
}

__device__ __forceinline__ void s5_phase(ArgsRef a, int l, LAS unsigned char* lds) {
    const int TID = opaque_tid(), BID = opaque_bid(); (void)TID; (void)BID;
    const bf16_t* P = (const bf16_t*)(a.ws + WS_PROJ); bf16_t* Z = (bf16_t*)(a.ws + WS_Z);
    const int tid = TID, wave = tid >> 6, lane = tid & 63;
    LAS float* sU = (LAS float*)lds + wave * 1024;
    LAS float* sX = (LAS float*)lds + 8192 + wave * (16 * 130);
    LAS float* sE = (LAS float*)lds + 8192 + 8 * 16 * 130;
    for (int job = BID; job < 512; job += gridDim.x) {
        const int b = job >> 5, g = job & 31;
        const float lre = ((const float*)a.in[22])[(size_t)l * 2048 + g * 64 + lane], lim = ((const float*)a.in[23])[(size_t)l * 2048 + g * 64 + lane];
        const float dt = expf(((const float*)a.in[24])[l * 32 + g]);
        float sn, cs; sincos_big(lim * dt, sn, cs);
        const float er = expf(lre * dt), lbr = er * cs, lbi = er * sn;
        const float den = 1.0f / (lre * lre + lim * lim);
        const float fr = ((lbr - 1.0f) * lre + lbi * lim) * den, fi = (lbi * lre - (lbr - 1.0f) * lim) * den;
        f32x2 bb[16];
        {
            const f32x4* br = (const f32x4*)((const float*)a.in[25] + ((size_t)l * 2048 + g * 64 + lane) * 16); const f32x4* bi = (const f32x4*)((const float*)a.in[26] + ((size_t)l * 2048 + g * 64 + lane) * 16);
#pragma unroll
            for (int q = 0; q < 4; ++q) { const f32x4 r4 = br[q], i4 = bi[q];
                bb[4 * q] = (f32x2){fr * r4.x - fi * i4.x, fr * i4.x + fi * r4.x}; bb[4 * q + 1] = (f32x2){fr * r4.y - fi * i4.y, fr * i4.y + fi * r4.y};
                bb[4 * q + 2] = (f32x2){fr * r4.z - fi * i4.z, fr * i4.z + fi * r4.z}; bb[4 * q + 3] = (f32x2){fr * r4.w - fi * i4.w, fr * i4.w + fi * r4.w}; }
        }
        float creg[32];
        {
            const float* cre = (const float*)a.in[27] + ((size_t)l * 32 + g) * 1024 + (lane & 15) * 64 + (lane >> 4);
            const float* cim = (const float*)a.in[28] + ((size_t)l * 32 + g) * 1024 + (lane & 15) * 64 + (lane >> 4);
#pragma unroll
            for (int kk = 0; kk < 16; ++kk) { creg[kk] = cre[4 * kk]; creg[16 + kk] = -cim[4 * kk]; }
        }
        f32x4 dsk;
        { const float* dp = (const float*)a.in[29] + (size_t)l * 512 + 16 * g + 4 * (lane >> 4); dsk = (f32x4){dp[0], dp[1], dp[2], dp[3]}; }
        const size_t tbase = (size_t)b * SEQ + wave * 256;
        f32x2 xs = (f32x2){0.f, 0.f}; const f32x2 lbr2 = (f32x2){lbr, lbr}, lbi2 = (f32x2){lbi, lbi};
        for (int c = 0; c < 4; ++c) {
            { const size_t t = tbase + c * 64 + lane; float u[16]; unpack8(*(const u32x4*)(P + t * DIN + C_S5 + 16 * g), u); unpack8(*(const u32x4*)(P + t * DIN + C_S5 + 16 * g + 8), u + 8);
              LAS f32x4* d = (LAS f32x4*)(sU + lane * 16); d[0] = (f32x4){u[0], u[1], u[2], u[3]}; d[1] = (f32x4){u[4], u[5], u[6], u[7]}; d[2] = (f32x4){u[8], u[9], u[10], u[11]}; d[3] = (f32x4){u[12], u[13], u[14], u[15]}; }
            LDS_FENCE();
#pragma unroll 2
            for (int s = 0; s < 64; ++s) {
                const LAS f32x4* up = (const LAS f32x4*)(sU + s * 16);
                f32x2 bu0 = (f32x2){0.f, 0.f}, bu1 = bu0;
#pragma unroll
                for (int q = 0; q < 4; ++q) { const f32x4 u4 = up[q];
                    bu0 = pfma(bb[4 * q], (f32x2){u4.x, u4.x}, bu0); bu1 = pfma(bb[4 * q + 1], (f32x2){u4.y, u4.y}, bu1);
                    bu0 = pfma(bb[4 * q + 2], (f32x2){u4.z, u4.z}, bu0); bu1 = pfma(bb[4 * q + 3], (f32x2){u4.w, u4.w}, bu1); }
                { const f32x2 nx = pfma(lbr2, xs, bu0 + bu1); xs = pfma(lbi2, (f32x2){-xs.y, xs.x}, nx); }
            }
            LDS_FENCE();
        }
        sE[wave * 128 + lane] = xs.x; sE[wave * 128 + 64 + lane] = xs.y;
        float pr = lbr, pi = lbi;
#pragma unroll
        for (int i = 0; i < 8; ++i) { const float nr = pr * pr - pi * pi, ni = 2.0f * pr * pi; pr = nr; pi = ni; }
        __syncthreads();
        xs = (f32x2){0.f, 0.f};
        for (int w = 0; w < wave; ++w) { const float er_ = sE[w * 128 + lane], ei_ = sE[w * 128 + 64 + lane];
            const float nr = pr * xs.x - pi * xs.y + er_, ni = pr * xs.y + pi * xs.x + ei_; xs.x = nr; xs.y = ni; }
        for (int c = 0; c < 4; ++c) {
            { const size_t t = tbase + c * 64 + lane; float u[16]; unpack8(*(const u32x4*)(P + t * DIN + C_S5 + 16 * g), u); unpack8(*(const u32x4*)(P + t * DIN + C_S5 + 16 * g + 8), u + 8);
              LAS f32x4* d = (LAS f32x4*)(sU + lane * 16); d[0] = (f32x4){u[0], u[1], u[2], u[3]}; d[1] = (f32x4){u[4], u[5], u[6], u[7]}; d[2] = (f32x4){u[8], u[9], u[10], u[11]}; d[3] = (f32x4){u[12], u[13], u[14], u[15]}; }
            LDS_FENCE();
#pragma unroll 1
            for (int s16 = 0; s16 < 4; ++s16) {
#pragma unroll 2
                for (int s = 0; s < 16; ++s) {
                    const LAS f32x4* up = (const LAS f32x4*)(sU + (s16 * 16 + s) * 16);
                    f32x2 bu0 = (f32x2){0.f, 0.f}, bu1 = bu0;
#pragma unroll
                    for (int q = 0; q < 4; ++q) { const f32x4 u4 = up[q];
                        bu0 = pfma(bb[4 * q], (f32x2){u4.x, u4.x}, bu0); bu1 = pfma(bb[4 * q + 1], (f32x2){u4.y, u4.y}, bu1);
                        bu0 = pfma(bb[4 * q + 2], (f32x2){u4.z, u4.z}, bu0); bu1 = pfma(bb[4 * q + 3], (f32x2){u4.w, u4.w}, bu1); }
                    { const f32x2 nx = pfma(lbr2, xs, bu0 + bu1); xs = pfma(lbi2, (f32x2){-xs.y, xs.x}, nx); }
                    sX[s * 130 + lane] = xs.x; sX[s * 130 + 64 + lane] = xs.y;
                }
                LDS_FENCE();
                f32x4 yacc = (f32x4){0.f, 0.f, 0.f, 0.f};
                const LAS float* xp = sX + (lane & 15) * 130 + (lane >> 4);
#pragma unroll
                for (int kk = 0; kk < 32; ++kk) yacc = __builtin_amdgcn_mfma_f32_16x16x4f32(creg[kk], xp[4 * kk], yacc, 0, 0, 0);
                const int tok = s16 * 16 + (lane & 15);
                const f32x4 u4 = *(const LAS f32x4*)(sU + tok * 16 + 4 * (lane >> 4));
                float z[4];
#pragma unroll
                for (int j = 0; j < 4; ++j) { const float y = yacc[j] + dsk[j] * u4[j]; z[j] = 0.5f * y * (1.0f + erff(y * 0.70710678118654752f)); }
                u32x2 w; w.x = pk2(z[0], z[1]); w.y = pk2(z[2], z[3]);
                *(u32x2*)(Z + (tbase + c * 64 + tok) * 512 + 16 * g + 4 * (lane >> 4)) = w;
                LDS_FENCE();
            }
        }
        __syncthreads();
    }
}

constexpr int NPH = 11;
#ifndef DUPMASK
#define DUPMASK 0
#endif
__global__ void __launch_bounds__(NTHREADS, 2) mega(Args a_, int lo, int hi) {
    extern __shared__ __attribute__((aligned(16))) unsigned char lds_raw[];
    LAS unsigned char* lds = (LAS unsigned char*)lds_raw;
#pragma unroll 1
    for (int step2 = 2 * lo; step2 < 2 * hi; ++step2) {
        const int step = step2 >> 1;
        if ((step2 & 1) && !((DUPMASK >> (step % NPH)) & 1)) continue;
        const __attribute__((address_space(4))) Args* ap = (const __attribute__((address_space(4))) Args*)__builtin_amdgcn_kernarg_segment_ptr();
        asm volatile("" : "+s"(ap));
        ArgsRef a = *ap;
        unsigned char* ws = a.ws;
        float* SSa = (float*)(ws + WS_SS); float* SSb = SSa + T; float* SSc = SSb + T;
        const int l = step / NPH, ph = step % NPH;
        const float* xin = (l == 0) ? (const float*)a.in[0] : (const float*)a.out;
#ifndef PHMASK
#define PHMASK 0x7ff
#endif
        switch (ph) {
        case 0: if (PHMASK & (1 << 0)) { conv_phase(a, l, lds); if (l == 0) norm_phase(xin, (bf16_t*)(ws + WS_XN), SSa); zero_phase(SSb, T); } break;
        case 1: if (PHMASK & (1 << 1)) { pg8::EpiSwiGLU E; E.H = (bf16_t*)(ws + WS_HID); E.SS = SSa; run_gemm(lds, (const bf16_t*)(ws + WS_XN), (const bf16_t*)(ws + W_UP1), 2 * FF, D, E); } break;
        case 2: if (PHMASK & (1 << 2)) { pg8::EpiResidual<true> E; E.base = xin; E.out = a.out; E.XN = (bf16_t*)(ws + WS_XN); E.SS = SSb; run_gemm(lds, (const bf16_t*)(ws + WS_HID), (const bf16_t*)(ws + W_DN1), D, FF, E); } break;
        case 3: if (PHMASK & (1 << 3)) { pg8::EpiBf16 E; E.O = (bf16_t*)(ws + WS_PROJ); E.ldc = DIN; E.SS = SSb; run_gemm(lds, (const bf16_t*)(ws + WS_XN), (const bf16_t*)(ws + W_IN), DIN, D, E); } break;
        case 4: if (PHMASK & (1 << 4)) { zero_phase(SSa, T); zero_phase(SSc, T); alr_phase(a, l); attn_phase(a, l, lds); s5_phase(a, l, lds); hgrn_phase(a, l, lds); } break;
        case 5: if (PHMASK & (1 << 5)) { pg8::EpiLR E; E.O = (bf16_t*)(ws + WS_LRO); E.w0 = (const float*)a.in[9] + (size_t)l * 512; E.a0 = (const float*)a.in[11] + (size_t)l * 512;
                  run_gemm(lds, (const bf16_t*)(ws + WS_ALR), (const bf16_t*)(ws + W_LR), 1536, 256, E);
                  pg8::EpiGLU G; G.Z = (const bf16_t*)(ws + WS_Z); G.Y = (bf16_t*)(ws + WS_YC); G.b = (const float*)a.in[31] + (size_t)l * 512;
                  run_gemm(lds, (const bf16_t*)(ws + WS_Z), (const bf16_t*)(ws + W_GLU), 512, 512, G); } break;
        case 6: if (PHMASK & (1 << 6)) rwkv_phase(a, l, lds); break;
        case 7: if (PHMASK & (1 << 7)) post_phase(a, l); break;
        case 8: if (PHMASK & (1 << 8)) { pg8::EpiResidual<false> E; E.base = a.out; E.out = a.out; E.XN = (bf16_t*)(ws + WS_XN); E.SS = SSc; run_gemm(lds, (const bf16_t*)(ws + WS_YC), (const bf16_t*)(ws + W_OUT), D, D, E); } break;
        case 9: if (PHMASK & (1 << 9)) { pg8::EpiSwiGLU E; E.H = (bf16_t*)(ws + WS_HID); E.SS = SSc; run_gemm(lds, (const bf16_t*)(ws + WS_XN), (const bf16_t*)(ws + W_UP2), 2 * FF, D, E); } break;
        case 10: if (PHMASK & (1 << 10)) { pg8::EpiResidual<true> E; E.base = a.out; E.out = a.out; E.XN = (l + 1 < NL) ? (bf16_t*)(ws + WS_XN) : nullptr; E.SS = SSa; run_gemm(lds, (const bf16_t*)(ws + WS_HID), (const bf16_t*)(ws + W_DN2), D, FF, E); } break;
        }
        if (step2 + 1 < 2 * hi) { __syncthreads(); cg::this_grid().sync(); }
    }
}

extern "C" void kernel_launch(void* const* d_in, const int* in_sizes, int n_in, void* d_out, int out_size, void* d_ws, size_t ws_size, hipStream_t stream) {
    static int grid = 0;
    if (!grid) {
        int dev = 0, cus = 0, per_cu = 0;
        hipGetDevice(&dev);
        hipDeviceGetAttribute(&cus, hipDeviceAttributeMultiprocessorCount, dev);
        hipFuncSetAttribute((const void*)mega, hipFuncAttributeMaxDynamicSharedMemorySize, LDS_BYTES);
        hipOccupancyMaxActiveBlocksPerMultiprocessor(&per_cu, (const void*)mega, NTHREADS, LDS_BYTES);
        if (per_cu < 1) per_cu = 1;
        grid = cus * 1;
        if (grid != 256) fprintf(stderr, "kernel_launch: grid %d (cus %d, per_cu %d)\n", grid, cus, per_cu);
    }
    Args a{};
    for (int i = 0; i < 39; ++i) a.in[i] = d_in[i];
    a.out = (float*)d_out; a.ws = (unsigned char*)d_ws;
#if ONE_LAUNCH
    int lo = 0, hi = NL * NPH;
    void* args[] = {&a, &lo, &hi};
    hipError_t e = hipLaunchCooperativeKernel((void*)mega, dim3(grid), dim3(NTHREADS), args, LDS_BYTES, stream);
    if (e != hipSuccess) fprintf(stderr, "cooperative launch failed: %s (grid %d)\n", hipGetErrorString(e), grid);
#else
    for (int s = 0; s < NL * NPH; ++s) hipLaunchKernelGGL(mega, dim3(grid), dim3(NTHREADS), LDS_BYTES, stream, a, s, s + 1);
#endif
}
```

```cpp
#include <hip/hip_runtime.h>
#include <hip/hip_cooperative_groups.h>
#include <cstdio>
#include <cstdint>
namespace cg = cooperative_groups;

#ifndef ONE_LAUNCH
#define ONE_LAUNCH 1
#endif

#define LAS __attribute__((address_space(3)))
typedef unsigned short bf16_t;
typedef short bf16x8 __attribute__((ext_vector_type(8)));
typedef float f32x4 __attribute__((ext_vector_type(4)));
typedef float f32x2 __attribute__((ext_vector_type(2)));
typedef unsigned u32x4 __attribute__((ext_vector_type(4)));
typedef unsigned u32x2 __attribute__((ext_vector_type(2)));

constexpr int T = 32768, SEQ = 2048, NB = 16, D = 2048, FF = 5632, DIN = 5120, NL = 2;
constexpr int C_RWKV = 0, C_ATT = 1792, C_S5 = 2560, C_HG = 3072;
constexpr int NTHREADS = 512, NWAVES = 8;

constexpr size_t SZ_UP = (size_t)2 * FF * D * 2, SZ_DN = (size_t)D * FF * 2, SZ_IN = (size_t)DIN * D * 2, SZ_LR = (size_t)1536 * 256 * 2,
                 SZ_GLU = (size_t)512 * 512 * 2, SZ_OUT = (size_t)D * D * 2;
constexpr size_t W_UP1 = 0, W_DN1 = W_UP1 + SZ_UP, W_IN = W_DN1 + SZ_DN, W_LR = W_IN + SZ_IN, W_GLU = W_LR + SZ_LR, W_OUT = W_GLU + SZ_GLU,
                 W_UP2 = W_OUT + SZ_OUT, W_DN2 = W_UP2 + SZ_UP, W_END = W_DN2 + SZ_DN;
constexpr size_t WS_XN = W_END, WS_BIG = WS_XN + (size_t)T * D * 2;
constexpr size_t WS_HID = WS_BIG;
constexpr size_t WS_PROJ = WS_BIG, WS_LRO = WS_PROJ + (size_t)T * DIN * 2, WS_ALR = WS_LRO + (size_t)T * 1536 * 2, WS_Z = WS_ALR + (size_t)T * 256 * 2,
                 WS_OR = WS_Z + (size_t)T * 512 * 2, WS_OH = WS_OR + (size_t)T * 512 * 4, WS_BON = WS_OH + (size_t)T * 512 * 4, WS_YC = WS_BON + (size_t)T * 8 * 4, WS_SS = WS_YC + (size_t)T * D * 2, WS_END = WS_SS + (size_t)3 * T * 4;
static_assert(WS_END <= (size_t)1 << 30, "workspace");
static_assert(WS_HID + (size_t)T * FF * 2 <= (size_t)1 << 30, "workspace");

constexpr int LDS_BYTES = 147456;

struct Args { const void* in[39]; float* out; unsigned char* ws; };
typedef const __attribute__((address_space(4))) Args& ArgsRef;

__device__ __forceinline__ unsigned pk2(float lo, float hi) { unsigned r; asm volatile("v_cvt_pk_bf16_f32 %0, %1, %2" : "=v"(r) : "v"(lo), "v"(hi)); return r; }
__device__ __forceinline__ float bflo(unsigned w) { return __uint_as_float(w << 16); }
__device__ __forceinline__ float bfhi(unsigned w) { return __uint_as_float(w & 0xffff0000u); }
__device__ __forceinline__ void unpack8(u32x4 q, float* f) { f[0] = bflo(q.x); f[1] = bfhi(q.x); f[2] = bflo(q.y); f[3] = bfhi(q.y); f[4] = bflo(q.z); f[5] = bfhi(q.z); f[6] = bflo(q.w); f[7] = bfhi(q.w); }
__device__ __forceinline__ u32x4 pack8(const float* f) { u32x4 o; o.x = pk2(f[0], f[1]); o.y = pk2(f[2], f[3]); o.z = pk2(f[4], f[5]); o.w = pk2(f[6], f[7]); return o; }
template <int CTRL> __device__ __forceinline__ float dpp(float x) { return __builtin_bit_cast(float, __builtin_amdgcn_mov_dpp(__builtin_bit_cast(int, x), CTRL, 0xf, 0xf, true)); }
constexpr int XOR1 = 0xB1, XOR2 = 0x4E, XOR7 = 0x141, XOR8 = 0x128;
__device__ __forceinline__ float red8(float v) { v += dpp<XOR1>(v); v += dpp<XOR2>(v); v += dpp<XOR7>(v); return v; }
__device__ __forceinline__ float red16(float v) { v = red8(v); v += dpp<XOR8>(v); return v; }
__device__ __forceinline__ float wave_sum(float v) {
#pragma unroll
    for (int o = 1; o < 64; o <<= 1) v += __shfl_xor(v, o);
    return v;
}
__device__ __forceinline__ float sigmoidf_(float x) { return 1.0f / (1.0f + __expf(-x)); }
__device__ __forceinline__ float siluf_(float x) { return x / (1.0f + __expf(-x)); }
__device__ __forceinline__ int opaque_tid() { int t = threadIdx.x; asm volatile("" : "+v"(t)); return t; }
__device__ __forceinline__ int opaque_bid() { int t = blockIdx.x; asm volatile("" : "+s"(t)); return t; }
__device__ __forceinline__ f32x2 pfma(f32x2 a, f32x2 b, f32x2 c) { return __builtin_elementwise_fma(a, b, c); }
#define LDS_FENCE() asm volatile("s_waitcnt lgkmcnt(0)" ::: "memory")
__device__ __forceinline__ void sincos_big(float x, float& sn, float& cs) {
    const float n = rintf(x * 0.15915494309189535f);
    float r = fmaf(-n, 6.28318548202514648f, x); r = fmaf(-n, -1.7484555e-7f, r);
    sn = __sinf(r); cs = __cosf(r);
}

namespace pg8 {
constexpr int BM = 256, BK = 64, HALF = 128, HTB = HALF * BK * 2, STAGE_BYTES = 8 * HTB, NXCD = 8, WGM = 8;
__host__ __device__ __forceinline__ int lds_byte(int r, int c) { const int st = (r >> 4) * 2 + (c >> 5), rr = r & 15, cc = c & 31, ob = rr * 64 + cc * 2; return st * 1024 + (ob ^ (((ob >> 9) & 1) << 5)); }
__host__ __device__ __forceinline__ void stage_rc(int b, int& R, int& C) { const int st = b / 1024, sb = b % 1024, swz = sb ^ (((sb >> 9) & 1) << 5); R = (st >> 1) * 16 + swz / 64; C = (st & 1) * 32 + (swz % 64) / 2; }
__host__ __device__ __forceinline__ int perm32(int rho) { const int n = rho >> 4, i = rho & 15; return 8 * (i >> 2) + 4 * n + (i & 3); }
struct Unit { int pm, pn; };
struct Gemm { const bf16_t* A; const bf16_t* Bt; int M, N, K; };
struct StaticOrder {
    int nM, nN, nwg, G, c;
    __device__ void init(int M, int N, int G_, int c_) { nM = M / BM; nN = N / BM; nwg = nM * nN; G = G_; c = c_; }
    __device__ bool next(int i, Unit& u) const {
        const long L = (long)i * G + c; if (L >= nwg) return false;
        int wgid = (int)L; { const int q = nwg / NXCD, r = nwg % NXCD, xcd = wgid % NXCD, off = wgid / NXCD; wgid = (xcd < r ? xcd * (q + 1) : r * (q + 1) + (xcd - r) * q) + off; }
        const int nig = WGM * nN, gid = wgid / nig, fm = gid * WGM, gsz = (nM - fm) < WGM ? (nM - fm) : WGM;
        u.pm = fm + ((wgid % nig) % gsz); u.pn = (wgid % nig) / gsz; return true;
    }
};
template <class Epi>
__device__ __forceinline__ void gemm_phase(LAS unsigned char* lds, const Gemm g, const StaticOrder S, const Epi E) {
    const int TID = opaque_tid(), BID = opaque_bid(); (void)TID; (void)BID;
    const int tid = TID, wid = __builtin_amdgcn_readfirstlane(tid >> 6), lane = tid & 63, wr = wid >> 2, wc = wid & 3, fr = lane & 15, fq = lane >> 4;
    const int K = g.K, nt = K / BK;
    unsigned voffA[2], voffB[2];
#pragma unroll
    for (int i = 0; i < 2; ++i) { int R, C; stage_rc(tid * 16 + i * 8192, R, C); const int Rb = Epi::PERM ? ((R & ~31) + perm32(R & 31)) : R;
        voffA[i] = (unsigned)(R * K + C) * 2u; voffB[i] = (unsigned)(Rb * K + C) * 2u; }
    const size_t kstep = (size_t)(BK * 2);
    const size_t hstep = (size_t)HALF * K * 2;
    const size_t tstep = 2 * hstep;
    const unsigned ldsw = (unsigned)wid * 1024u;
    const int aoff = lds_byte(wr * 64 + fr, fq * 8), boff = lds_byte(wc * 32 + fr, fq * 8);
#define PG8_SA(b, h) (((b) * 2 + (h)) * HTB)
#define PG8_SB(b, h) ((4 + (b) * 2 + (h)) * HTB)
#define PG8_STAGE(bufoff, gbase, voff) do { _Pragma("unroll") for (int _i = 0; _i < 2; ++_i) \
        __builtin_amdgcn_global_load_lds((const unsigned*)((const char*)(gbase) + (voff)[_i]), (LAS unsigned*)(lds + (bufoff) + ldsw + _i * 8192), 16, 0, 0); } while (0)
#define PG8_LDA(dst, b, h) do { _Pragma("unroll") for (int m = 0; m < 4; ++m) _Pragma("unroll") for (int k = 0; k < 2; ++k) dst[m][k] = *(const LAS bf16x8*)(lds + PG8_SA(b, h) + aoff + m * 2048 + k * 1024); } while (0)
#define PG8_LDB(dst, b, h) do { _Pragma("unroll") for (int n = 0; n < 2; ++n) _Pragma("unroll") for (int k = 0; k < 2; ++k) dst[n][k] = *(const LAS bf16x8*)(lds + PG8_SB(b, h) + boff + n * 2048 + k * 1024); } while (0)
#define PG8_MMA(ai, bj, At, Bt) do { __builtin_amdgcn_s_setprio(1); _Pragma("unroll") for (int m = 0; m < 4; ++m) _Pragma("unroll") for (int n = 0; n < 2; ++n) _Pragma("unroll") for (int k = 0; k < 2; ++k) \
        acc[ai][bj][m][n] = __builtin_amdgcn_mfma_f32_16x16x32_bf16(Bt[n][k], At[m][k], acc[ai][bj][m][n], 0, 0, 0); __builtin_amdgcn_s_setprio(0); } while (0)
#define PG8_WAIT_V(n) asm volatile("s_waitcnt vmcnt(" #n ")" ::: "memory")
#define PG8_WAIT_L(n) asm volatile("s_waitcnt lgkmcnt(" #n ")" ::: "memory")
#define PG8_BAR __builtin_amdgcn_s_barrier()
#define PG8_SCHED __builtin_amdgcn_sched_barrier(0)
    Unit cur, nxt; int ui = 0;
    if (!S.next(0, cur)) return;
    f32x4 acc[2][2][4][2];
#pragma unroll
    for (int a = 0; a < 2; ++a)
#pragma unroll
        for (int b = 0; b < 2; ++b)
#pragma unroll
            for (int m = 0; m < 4; ++m)
#pragma unroll
                for (int n = 0; n < 2; ++n) acc[a][b][m][n] = (f32x4){0.f, 0.f, 0.f, 0.f};
    bf16x8 At[4][2], B0[2][2], B1[2][2];
    const char* cA = (const char*)g.A + (size_t)cur.pm * tstep; const char* cB = (const char*)g.Bt + (size_t)cur.pn * tstep;
    PG8_STAGE(PG8_SB(0, 0), cB, voffB); PG8_STAGE(PG8_SA(0, 0), cA, voffA); PG8_STAGE(PG8_SB(0, 1), cB + hstep, voffB); PG8_STAGE(PG8_SA(0, 1), cA + hstep, voffA);
    if (wr == 1) PG8_BAR;
    PG8_WAIT_V(4); PG8_BAR;
    PG8_STAGE(PG8_SB(1, 0), cB + kstep, voffB); PG8_STAGE(PG8_SA(1, 0), cA + kstep, voffA); PG8_STAGE(PG8_SB(1, 1), cB + hstep + kstep, voffB);
    PG8_WAIT_V(6); PG8_BAR;
    for (;;) {
        const bool has_next = S.next(ui + 1, nxt);
        const char* nA = has_next ? (const char*)g.A + (size_t)nxt.pm * tstep : cA; const char* nB = has_next ? (const char*)g.Bt + (size_t)nxt.pn * tstep : cB;
#pragma unroll 1
        for (int t = 0; t < nt; t += 2) {
            const bool last = (t == nt - 2);
            const char* a1 = cA + (size_t)(t + 1) * kstep;
            const char* a2 = last ? nA : cA + (size_t)(t + 2) * kstep; const char* b2 = last ? nB : cB + (size_t)(t + 2) * kstep;
            const char* a3 = a2 + kstep; const char* b3 = b2 + kstep;
            PG8_LDB(B0, 0, 0); PG8_SCHED; PG8_LDA(At, 0, 0); PG8_STAGE(PG8_SA(1, 1), a1 + hstep, voffA);
            PG8_WAIT_L(8); PG8_BAR; PG8_WAIT_L(0); PG8_MMA(0, 0, At, B0); PG8_BAR; PG8_SCHED;
            PG8_LDB(B1, 0, 1); PG8_STAGE(PG8_SB(0, 0), b2, voffB);
            PG8_BAR; PG8_WAIT_L(0); PG8_MMA(0, 1, At, B1); PG8_BAR;
            PG8_LDA(At, 0, 1); PG8_STAGE(PG8_SA(0, 0), a2, voffA);
            PG8_BAR; PG8_WAIT_L(0); PG8_MMA(1, 0, At, B0); PG8_BAR; PG8_SCHED;
            PG8_STAGE(PG8_SB(0, 1), b2 + hstep, voffB);
            PG8_WAIT_V(6); PG8_BAR; PG8_MMA(1, 1, At, B1); PG8_BAR;
            PG8_LDB(B0, 1, 0); PG8_SCHED; PG8_LDA(At, 1, 0); PG8_STAGE(PG8_SA(0, 1), a2 + hstep, voffA);
            PG8_WAIT_L(8); PG8_BAR; PG8_WAIT_L(0); PG8_MMA(0, 0, At, B0); PG8_BAR; PG8_SCHED;
            PG8_LDB(B1, 1, 1); PG8_STAGE(PG8_SB(1, 0), b3, voffB);
            PG8_BAR; PG8_WAIT_L(0); PG8_MMA(0, 1, At, B1); PG8_BAR;
            PG8_LDA(At, 1, 1); PG8_STAGE(PG8_SA(1, 0), a3, voffA);
            PG8_BAR; PG8_WAIT_L(0); PG8_MMA(1, 0, At, B0); PG8_BAR; PG8_SCHED;
            PG8_STAGE(PG8_SB(1, 1), b3 + hstep, voffB);
            PG8_WAIT_V(6); PG8_BAR; PG8_MMA(1, 1, At, B1); PG8_BAR;
        }
        E(acc, cur, wr, wc, fr, fq);
        if (!has_next) break;
#pragma unroll
        for (int a = 0; a < 2; ++a)
#pragma unroll
            for (int b = 0; b < 2; ++b)
#pragma unroll
                for (int m = 0; m < 4; ++m)
#pragma unroll
                    for (int n = 0; n < 2; ++n) acc[a][b][m][n] = (f32x4){0.f, 0.f, 0.f, 0.f};
        cur = nxt; cA = nA; cB = nB; ++ui;
    }
    PG8_WAIT_V(0);
    if (wr == 0) PG8_BAR;
    PG8_BAR;
#undef PG8_SA
#undef PG8_SB
#undef PG8_STAGE
#undef PG8_LDA
#undef PG8_LDB
#undef PG8_MMA
#undef PG8_WAIT_V
#undef PG8_WAIT_L
#undef PG8_BAR
#undef PG8_SCHED
}

struct EpiSwiGLU {
    static constexpr bool PERM = true;
    bf16_t* H; const float* SS;
    __device__ __forceinline__ void operator()(const f32x4 (&acc)[2][2][4][2], const Unit& u, int wr, int wc, int fr, int fq) const {
        const int row0 = u.pm * BM + wr * 64 + fr, col0 = u.pn * 128 + wc * 32 + 8 * fq;
#pragma unroll
        for (int ai = 0; ai < 2; ++ai)
#pragma unroll
            for (int m = 0; m < 4; ++m) {
                const float rs = 1.0f / sqrtf(SS[row0 + ai * HALF + m * 16] * (1.0f / D) + 1e-6f);
                float v[8];
#pragma unroll
                for (int n = 0; n < 2; ++n)
#pragma unroll
                    for (int j = 0; j < 4; ++j) { const float gt = acc[ai][0][m][n][j] * rs, up = acc[ai][1][m][n][j] * rs; v[4 * n + j] = siluf_(gt) * up; }
                *(u32x4*)(H + (size_t)(row0 + ai * HALF + m * 16) * FF + col0) = pack8(v);
            }
    }
};
template <bool HALFSTEP> struct EpiResidual {
    static constexpr bool PERM = false;
    static constexpr float scale = HALFSTEP ? 0.5f : 1.0f;
    const float* base; float* out; bf16_t* XN; float* SS;
    __device__ __forceinline__ void operator()(const f32x4 (&acc)[2][2][4][2], const Unit& u, int wr, int wc, int fr, int fq) const {
        const int row0 = u.pm * BM + wr * 64 + fr, col0 = u.pn * BM + wc * 32 + 4 * fq;
#pragma unroll
        for (int ai = 0; ai < 2; ++ai)
#pragma unroll
            for (int m = 0; m < 4; ++m) { const int row = row0 + ai * HALF + m * 16; const size_t ro = (size_t)row * D + col0; float ss = 0.f;
#pragma unroll
                for (int bj = 0; bj < 2; ++bj)
#pragma unroll
                    for (int n = 0; n < 2; ++n) { const f32x4 b = *(const f32x4*)(base + ro + bj * HALF + n * 16); const f32x4 r = b + acc[ai][bj][m][n] * scale; *(f32x4*)(out + ro + bj * HALF + n * 16) = r;
                        if (XN) { u32x2 w; w.x = pk2(r.x, r.y); w.y = pk2(r.z, r.w); *(u32x2*)(XN + ro + bj * HALF + n * 16) = w; ss += (r.x * r.x + r.y * r.y) + (r.z * r.z + r.w * r.w); } }
                if (XN) { ss += __shfl_xor(ss, 16); ss += __shfl_xor(ss, 32); if (fq == 0) atomicAdd(SS + row, ss); } }
    }
};
struct EpiBf16 {
    static constexpr bool PERM = true;
    bf16_t* O; int ldc; const float* SS;
    __device__ __forceinline__ void operator()(const f32x4 (&acc)[2][2][4][2], const Unit& u, int wr, int wc, int fr, int fq) const {
        const int row0 = u.pm * BM + wr * 64 + fr, col0 = u.pn * BM + wc * 32 + 8 * fq;
#pragma unroll
        for (int ai = 0; ai < 2; ++ai)
#pragma unroll
            for (int m = 0; m < 4; ++m) { bf16_t* rowp = O + (size_t)(row0 + ai * HALF + m * 16) * ldc + col0;
                const float rs = 1.0f / sqrtf(SS[row0 + ai * HALF + m * 16] * (1.0f / D) + 1e-6f);
#pragma unroll
                for (int bj = 0; bj < 2; ++bj) { const f32x4 v0 = acc[ai][bj][m][0] * rs, v1 = acc[ai][bj][m][1] * rs;
                    u32x4 w; w.x = pk2(v0[0], v0[1]); w.y = pk2(v0[2], v0[3]); w.z = pk2(v1[0], v1[1]); w.w = pk2(v1[2], v1[3]);
                    *(u32x4*)(rowp + bj * HALF) = w; } }
    }
};
struct EpiLR {
    static constexpr bool PERM = true;
    bf16_t* O; const float* w0; const float* a0;
    template <int KIND> __device__ __forceinline__ void body(const f32x4 (&acc)[2][2][4][2], const float* bp, int row0, int col0) const {
#pragma unroll
        for (int bj = 0; bj < 2; ++bj) {
            f32x4 b0 = (f32x4){0.f, 0.f, 0.f, 0.f}, b1 = b0;
            if (KIND < 2) { b0 = *(const f32x4*)(bp + bj * HALF); b1 = *(const f32x4*)(bp + bj * HALF + 4); }
#pragma unroll
            for (int ai = 0; ai < 2; ++ai)
#pragma unroll
                for (int m = 0; m < 4; ++m) {
                    u32x4 w;
#pragma unroll
                    for (int n = 0; n < 2; ++n) {
                        float r[4];
#pragma unroll
                        for (int j = 0; j < 4; ++j) { const float x = acc[ai][bj][m][n][j] + (n == 0 ? b0[j] : b1[j]);
                            if (KIND == 0) { const float e = __expf(-x); r[j] = -0.60653065971f / (1.0f + e); }
                            else if (KIND == 1) r[j] = 1.0f / (1.0f + __expf(-x)); else r[j] = x; }
                        if (n == 0) { w.x = pk2(r[0], r[1]); w.y = pk2(r[2], r[3]); } else { w.z = pk2(r[0], r[1]); w.w = pk2(r[2], r[3]); }
                    }
                    *(u32x4*)(O + (size_t)(row0 + ai * HALF + m * 16) * 1536 + col0 + bj * HALF) = w;
                }
        }
    }
    __device__ __forceinline__ void operator()(const f32x4 (&acc)[2][2][4][2], const Unit& u, int wr, int wc, int fr, int fq) const {
        const int row0 = u.pm * BM + wr * 64 + fr, col0 = u.pn * BM + wc * 32 + 8 * fq, kind = u.pn >> 1, f0 = col0 - 512 * kind;
        if (kind == 0) body<0>(acc, w0 + f0, row0, col0); else if (kind == 1) body<1>(acc, a0 + f0, row0, col0); else body<2>(acc, nullptr, row0, col0);
    }
};
struct EpiGLU {
    static constexpr bool PERM = true;
    const bf16_t* Z; bf16_t* Y; const float* b;
    __device__ __forceinline__ void operator()(const f32x4 (&acc)[2][2][4][2], const Unit& u, int wr, int wc, int fr, int fq) const {
        const int row0 = u.pm * BM + wr * 64 + fr, col0 = u.pn * BM + wc * 32 + 8 * fq;
#pragma unroll
        for (int bj = 0; bj < 2; ++bj) {
            const f32x4 bias0 = *(const f32x4*)(b + col0 + bj * HALF), bias1 = *(const f32x4*)(b + col0 + bj * HALF + 4);
#pragma unroll
            for (int ai = 0; ai < 2; ++ai)
#pragma unroll
                for (int m = 0; m < 4; ++m) { const size_t r = (size_t)(row0 + ai * HALF + m * 16);
                    float z[8], v[8]; unpack8(*(const u32x4*)(Z + r * 512 + col0 + bj * HALF), z);
#pragma unroll
                    for (int n = 0; n < 2; ++n)
#pragma unroll
                        for (int j = 0; j < 4; ++j) v[4 * n + j] = z[4 * n + j] * sigmoidf_(acc[ai][bj][m][n][j] + (n == 0 ? bias0[j] : bias1[j]));
                    *(u32x4*)(Y + r * D + 1024 + col0 + bj * HALF) = pack8(v); }
        }
    }
};
}

template <class Epi> __device__ __forceinline__ void run_gemm(LAS unsigned char* lds, const bf16_t* A, const bf16_t* Bt, int N, int K, const Epi E) {
    pg8::Gemm g; g.A = A; g.Bt = Bt; g.M = T; g.N = N; g.K = K;
    pg8::StaticOrder S; S.init(T, N, gridDim.x, opaque_bid());
    pg8::gemm_phase<Epi>(lds, g, S, E);
}

__device__ __forceinline__ void tr_item(const float* W, int ldw, int k0, int n0, const float* gs, bf16_t* Dst, int ldd, int drow0, int dk0, LAS float* scr, int lane) {
    if (W) {
#pragma unroll 8
        for (int i = 0; i < 32; ++i) { const int kk = 2 * i + (lane >> 5); float v = W[(size_t)(k0 + kk) * ldw + n0 + (lane & 31)]; if (gs) v *= gs[k0 + kk]; scr[kk * 33 + (lane & 31)] = v; }
    } else {
#pragma unroll 8
        for (int i = 0; i < 32; ++i) { const int kk = 2 * i + (lane >> 5); scr[kk * 33 + (lane & 31)] = 0.f; }
    }
    LDS_FENCE();
    const int c = lane & 7;
#pragma unroll
    for (int j = 0; j < 4; ++j) { const int n = (lane >> 3) + 8 * j; const LAS float* s = scr + (8 * c) * 33 + n;
        u32x4 o; o.x = pk2(s[0 * 33], s[1 * 33]); o.y = pk2(s[2 * 33], s[3 * 33]); o.z = pk2(s[4 * 33], s[5 * 33]); o.w = pk2(s[6 * 33], s[7 * 33]);
        *(u32x4*)(Dst + (size_t)(drow0 + n) * ldd + dk0 + k0 - 0 + 8 * c - 0) = o; }
    LDS_FENCE();
}

__device__ __forceinline__ void conv_phase(ArgsRef a, int l, LAS unsigned char* lds) {
    const int TID = opaque_tid(), BID = opaque_bid(); (void)TID; (void)BID;
    const int wave = TID >> 6, lane = TID & 63;
    LAS float* scr = (LAS float*)(lds + wave * 8704);
    const int gw = BID * NWAVES + wave, NGW = gridDim.x * NWAVES;
    unsigned char* ws = a.ws;
    constexpr int I_GU = (D / 64) * (FF / 32), I_DN = (FF / 64) * (D / 32), I_IN = (D / 64) * (DIN / 32), I_OUT = (D / 64) * (D / 32), I_GLU = 8 * 16, I_LR = 48 * 4;
    constexpr int NITEMS = 6 * I_GU + I_IN + I_OUT + I_GLU + I_LR;
    static_assert(I_GU == I_DN, "items");
    for (int it = gw; it < NITEMS; it += NGW) {
        int r = it;
        if (r < 6 * I_GU) {
            const int which = r / I_GU; r -= which * I_GU;
            const int f = which >= 3, m = which % 3;
            if (m < 2) {
                const float* W = (const float*)a.in[(f ? 36 : 3) + m] + (size_t)l * D * FF;
                const float* gs = (const float*)a.in[f ? 35 : 2] + (size_t)l * D;
                bf16_t* dst = (bf16_t*)(ws + (f ? W_UP2 : W_UP1));
                const int nblk = FF / 32, kb = r / nblk, nb = r % nblk, n0 = 32 * nb;
                tr_item(W, FF, 64 * kb, n0, gs, dst, D, (n0 >> 7) * 256 + (n0 & 127) + 128 * m, 0, scr, lane);
            } else {
                const float* W = (const float*)a.in[f ? 38 : 5] + (size_t)l * FF * D;
                bf16_t* dst = (bf16_t*)(ws + (f ? W_DN2 : W_DN1));
                const int nblk = D / 32, kb = r / nblk, nb = r % nblk;
                tr_item(W, D, 64 * kb, 32 * nb, nullptr, dst, FF, 32 * nb, 0, scr, lane);
            }
            continue;
        }
        r -= 6 * I_GU;
        if (r < I_IN) { const int nblk = DIN / 32, kb = r / nblk, nb = r % nblk;
            tr_item((const float*)a.in[7] + (size_t)l * D * DIN, DIN, 64 * kb, 32 * nb, (const float*)a.in[6] + (size_t)l * D, (bf16_t*)(ws + W_IN), D, 32 * nb, 0, scr, lane); continue; }
        r -= I_IN;
        if (r < I_OUT) { const int nblk = D / 32, kb = r / nblk, nb = r % nblk;
            tr_item((const float*)a.in[34] + (size_t)l * D * D, D, 64 * kb, 32 * nb, nullptr, (bf16_t*)(ws + W_OUT), D, 32 * nb, 0, scr, lane); continue; }
        r -= I_OUT;
        if (r < I_GLU) { const int kb = r / 16, nb = r % 16;
            tr_item((const float*)a.in[30] + (size_t)l * 512 * 512, 512, 64 * kb, 32 * nb, nullptr, (bf16_t*)(ws + W_GLU), 512, 32 * nb, 0, scr, lane); continue; }
        r -= I_GLU;
        {
            const int nb = r >> 2, kb = r & 3, kind = nb >> 4, nn0 = 32 * (nb & 15);
            const float* W = nullptr; int k0 = 0;
            if (kind == 0 && kb == 0) { W = (const float*)a.in[10] + (size_t)l * 64 * 512; k0 = 0; }
            else if (kind == 1 && kb == 1) { W = (const float*)a.in[12] + (size_t)l * 64 * 512; k0 = 0; }
            else if (kind == 2 && kb >= 2) { W = (const float*)a.in[13] + (size_t)l * 128 * 512; k0 = 64 * (kb - 2); }
            tr_item(W, 512, k0, nn0, nullptr, (bf16_t*)(ws + W_LR), 256, 32 * nb, 64 * kb - k0, scr, lane);
        }
    }
}

__device__ __forceinline__ void norm_phase(const float* x, bf16_t* XN, float* SS) {
    const int TID = opaque_tid(), BID = opaque_bid(); (void)TID; (void)BID;
    const int wave = TID >> 6, lane = TID & 63;
    const int gw = BID * NWAVES + wave, NGW = gridDim.x * NWAVES;
    for (int m = gw; m < T; m += NGW) {
        const f32x4* xr = (const f32x4*)(x + (size_t)m * D) + lane;
        f32x4 v[8]; float s = 0.f;
#pragma unroll
        for (int j = 0; j < 8; ++j) { v[j] = xr[64 * j]; s += (v[j].x * v[j].x + v[j].y * v[j].y) + (v[j].z * v[j].z + v[j].w * v[j].w); }
        s = wave_sum(s); if (lane == 0) SS[m] = s;
        u32x2* o = (u32x2*)(XN + (size_t)m * D) + lane;
#pragma unroll
        for (int j = 0; j < 8; ++j) { u32x2 w; w.x = pk2(v[j].x, v[j].y); w.y = pk2(v[j].z, v[j].w); o[64 * j] = w; }
    }
}

__device__ __forceinline__ void zero_phase(float* p, int n) {
    const int TID = opaque_tid(), BID = opaque_bid();
    for (int i = BID * NTHREADS + TID; i < n; i += gridDim.x * NTHREADS) p[i] = 0.f;
}
__device__ __forceinline__ void alr_phase(ArgsRef a, int l) {
    const int TID = opaque_tid(), BID = opaque_bid(); (void)TID; (void)BID;
    const bf16_t* P = (const bf16_t*)(a.ws + WS_PROJ); bf16_t* ALR = (bf16_t*)(a.ws + WS_ALR);
    const float* mu = (const float*)a.in[8] + (size_t)l * 1792 + 1536;
    const int gt = BID * NTHREADS + TID, NGT = gridDim.x * NTHREADS;
    for (int it = gt; it < T * 32; it += NGT) {
        const int t = it >> 5, cg = it & 31, c0 = 8 * cg;
        float cur[8], prv[8], o[8];
        unpack8(*(const u32x4*)(P + (size_t)t * DIN + 1536 + c0), cur);
        if ((t & (SEQ - 1)) != 0) unpack8(*(const u32x4*)(P + (size_t)(t - 1) * DIN + 1536 + c0), prv);
        else {
#pragma unroll
            for (int j = 0; j < 8; ++j) prv[j] = 0.f; }
#pragma unroll
        for (int j = 0; j < 8; ++j) { const float v = cur[j] + (prv[j] - cur[j]) * mu[c0 + j];
            o[j] = c0 < 64 ? tanhf(v) : (c0 < 128 ? v : sigmoidf_(v)); }
        *(u32x4*)(ALR + (size_t)t * 256 + c0) = pack8(o);
    }
}

__device__ __forceinline__ void rwkv_phase(ArgsRef a, int l, LAS unsigned char* lds) {
    const int TID = opaque_tid(), BID = opaque_bid(); (void)TID; (void)BID;
    const bf16_t* P = (const bf16_t*)(a.ws + WS_PROJ); const bf16_t* LR = (const bf16_t*)(a.ws + WS_LRO);
    float* OR = (float*)(a.ws + WS_OR); float* BON = (float*)(a.ws + WS_BON);
    LAS float* sR = (LAS float*)lds; LAS float* sW = sR + 4096; LAS float* sK = sW + 4096; LAS float* sKK = sK + 4096; LAS float* sB = sKK + 4096;
    LAS float* sV = sB + 4096; LAS float* sO = sV + 2048;
    const int tid = TID, wave = tid >> 6, lane = tid & 63;
    const int tt = tid >> 3, cg = tid & 7;
    for (int job = BID; job < 256; job += gridDim.x) {
        const int b = job >> 4, h = (job >> 1) & 7, half = job & 1;
        const int c0 = 64 * h + 8 * cg;
        float mur[8], muk[8], muv[8], kkw[8], kaw[8], rkw[8];
#pragma unroll
        for (int j = 0; j < 8; ++j) {
            mur[j] = ((const float*)a.in[8])[(size_t)l * 1792 + c0 + j]; muk[j] = ((const float*)a.in[8])[(size_t)l * 1792 + 512 + c0 + j]; muv[j] = ((const float*)a.in[8])[(size_t)l * 1792 + 1024 + c0 + j];
            kkw[j] = ((const float*)a.in[14])[(size_t)l * 512 + c0 + j]; kaw[j] = ((const float*)a.in[15])[(size_t)l * 512 + c0 + j]; rkw[j] = ((const float*)a.in[16])[(size_t)l * 512 + c0 + j]; }
        f32x2 stA = (f32x2){0.f, 0.f}, stB = stA;
        const int rloc = 4 * wave + (lane >> 4), jq = lane & 15;
        for (int ch = 0; ch < SEQ / 64; ++ch) {
            __syncthreads();
            {
                const int s = ch * 64 + tt; const size_t t = (size_t)b * SEQ + s;
                float r[8], k[8], v[8], pr[8], ld[8], av[8];
                unpack8(*(const u32x4*)(P + t * DIN + c0), r); unpack8(*(const u32x4*)(P + t * DIN + 512 + c0), k); unpack8(*(const u32x4*)(P + t * DIN + 1024 + c0), v);
                if (s != 0) {
                    unpack8(*(const u32x4*)(P + (t - 1) * DIN + c0), pr);
#pragma unroll
                    for (int j = 0; j < 8; ++j) r[j] += (pr[j] - r[j]) * mur[j];
                    unpack8(*(const u32x4*)(P + (t - 1) * DIN + 512 + c0), pr);
#pragma unroll
                    for (int j = 0; j < 8; ++j) k[j] += (pr[j] - k[j]) * muk[j];
                    unpack8(*(const u32x4*)(P + (t - 1) * DIN + 1024 + c0), pr);
#pragma unroll
                    for (int j = 0; j < 8; ++j) v[j] += (pr[j] - v[j]) * muv[j];
                } else {
#pragma unroll
                    for (int j = 0; j < 8; ++j) { r[j] -= r[j] * mur[j]; k[j] -= k[j] * muk[j]; v[j] -= v[j] * muv[j]; }
                }
                unpack8(*(const u32x4*)(LR + t * 1536 + c0), ld); unpack8(*(const u32x4*)(LR + t * 1536 + 512 + c0), av);
                float kk[8], ss = 0.f, bp = 0.f;
#pragma unroll
                for (int j = 0; j < 8; ++j) { kk[j] = k[j] * kkw[j]; ss += kk[j] * kk[j]; }
                ss = red8(ss);
                const float inv = 1.0f / sqrtf(fmaxf(ss, 1e-24f));
                float w8[8], k8[8], b8[8];
#pragma unroll
                for (int j = 0; j < 8; ++j) { kk[j] *= inv; k8[j] = k[j] * (1.0f + (av[j] - 1.0f) * kaw[j]); b8[j] = kk[j] * av[j]; w8[j] = __expf(ld[j]); bp += r[j] * k8[j] * rkw[j]; }
                bp = red8(bp);
                if (half == 0 && cg == 0) BON[t * 8 + h] = bp;
                LAS float* d;
                d = sR + tt * 64 + 8 * cg; *(LAS f32x4*)d = (f32x4){r[0], r[1], r[2], r[3]}; *(LAS f32x4*)(d + 4) = (f32x4){r[4], r[5], r[6], r[7]};
                d = sW + tt * 64 + 8 * cg; *(LAS f32x4*)d = (f32x4){w8[0], w8[1], w8[2], w8[3]}; *(LAS f32x4*)(d + 4) = (f32x4){w8[4], w8[5], w8[6], w8[7]};
                d = sK + tt * 64 + 8 * cg; *(LAS f32x4*)d = (f32x4){k8[0], k8[1], k8[2], k8[3]}; *(LAS f32x4*)(d + 4) = (f32x4){k8[4], k8[5], k8[6], k8[7]};
                d = sKK + tt * 64 + 8 * cg; *(LAS f32x4*)d = (f32x4){kk[0], kk[1], kk[2], kk[3]}; *(LAS f32x4*)(d + 4) = (f32x4){kk[4], kk[5], kk[6], kk[7]};
                d = sB + tt * 64 + 8 * cg; *(LAS f32x4*)d = (f32x4){b8[0], b8[1], b8[2], b8[3]}; *(LAS f32x4*)(d + 4) = (f32x4){b8[4], b8[5], b8[6], b8[7]};
                if ((cg >> 2) == half) { d = sV + tt * 32 + 8 * (cg & 3); *(LAS f32x4*)d = (f32x4){v[0], v[1], v[2], v[3]}; *(LAS f32x4*)(d + 4) = (f32x4){v[4], v[5], v[6], v[7]}; }
            }
            __syncthreads();
#pragma unroll 2
            for (int s = 0; s < 64; ++s) {
                const f32x4 w4 = *(const LAS f32x4*)(sW + s * 64 + 4 * jq), kk4 = *(const LAS f32x4*)(sKK + s * 64 + 4 * jq), b4 = *(const LAS f32x4*)(sB + s * 64 + 4 * jq),
                            k4 = *(const LAS f32x4*)(sK + s * 64 + 4 * jq), r4 = *(const LAS f32x4*)(sR + s * 64 + 4 * jq);
                const float vi = sV[s * 32 + rloc];
                const f32x2 pa = pfma(stB, (f32x2){kk4.z, kk4.w}, stA * (f32x2){kk4.x, kk4.y});
                const float sa = -red16(pa.x + pa.y);
                const f32x2 sa2 = (f32x2){sa, sa}, vi2 = (f32x2){vi, vi};
                const f32x2 tA = pfma(vi2, (f32x2){k4.x, k4.y}, sa2 * (f32x2){b4.x, b4.y}), tB = pfma(vi2, (f32x2){k4.z, k4.w}, sa2 * (f32x2){b4.z, b4.w});
                stA = pfma(stA, (f32x2){w4.x, w4.y}, tA); stB = pfma(stB, (f32x2){w4.z, w4.w}, tB);
                const f32x2 py = pfma(stB, (f32x2){r4.z, r4.w}, stA * (f32x2){r4.x, r4.y});
                const float y = red16(py.x + py.y);
                if (jq == 0) sO[s * 32 + rloc] = y;
            }
            __syncthreads();
            {
                const int s = ch * 64 + tt; const size_t t = (size_t)b * SEQ + s;
                *(f32x4*)(OR + t * 512 + 64 * h + 32 * half + 4 * cg) = *(const LAS f32x4*)(sO + tt * 32 + 4 * cg);
            }
        }
    }
    __syncthreads();
}

__device__ __forceinline__ void hgrn_phase(ArgsRef a, int l, LAS unsigned char* lds) {
    const int TID = opaque_tid(), BID = opaque_bid(); (void)TID; (void)BID;
    const bf16_t* P = (const bf16_t*)(a.ws + WS_PROJ); float* OH = (float*)(a.ws + WS_OH);
    LAS float* sQ = (LAS float*)lds; LAS float* sF = sQ + 4096; LAS float* sV = sF + 4096; LAS float* sO = sV + 2048;
    const int tid = TID, wave = tid >> 6, lane = tid & 63;
    const int tt = tid >> 3, cg = tid & 7;
    const float* lbp = (const float*)a.in[32];
    for (int job = BID; job < 256; job += gridDim.x) {
        const int b = job >> 4, h = (job >> 1) & 7, half = job & 1;
        const int c0 = 64 * h + 8 * cg;
        float lb[8];
#pragma unroll
        for (int j = 0; j < 8; ++j) lb[j] = (l == 0) ? 0.f : sigmoidf_(lbp[512 + c0 + j] - lbp[c0 + j]);
        f32x2 stA = (f32x2){0.f, 0.f}, stB = stA;
        const int cloc = 4 * wave + (lane >> 4), dq = lane & 15;
        for (int ch = 0; ch < SEQ / 64; ++ch) {
            __syncthreads();
            {
                const int s = ch * 64 + tt; const size_t t = (size_t)b * SEQ + s;
                float q[8], f[8];
                unpack8(*(const u32x4*)(P + t * DIN + C_HG + c0), q); unpack8(*(const u32x4*)(P + t * DIN + C_HG + 512 + c0), f);
#pragma unroll
                for (int j = 0; j < 8; ++j) { q[j] = siluf_(q[j]) * 0.125f; f[j] = lb[j] + (1.0f - lb[j]) * sigmoidf_(f[j]); }
                LAS float* d;
                d = sQ + tt * 64 + 8 * cg; *(LAS f32x4*)d = (f32x4){q[0], q[1], q[2], q[3]}; *(LAS f32x4*)(d + 4) = (f32x4){q[4], q[5], q[6], q[7]};
                d = sF + tt * 64 + 8 * cg; *(LAS f32x4*)d = (f32x4){f[0], f[1], f[2], f[3]}; *(LAS f32x4*)(d + 4) = (f32x4){f[4], f[5], f[6], f[7]};
                const u32x2 vv = *(const u32x2*)(P + t * DIN + C_HG + 1024 + 64 * h + 32 * half + 4 * cg);
                *(LAS f32x4*)(sV + tt * 32 + 4 * cg) = (f32x4){bflo(vv.x), bfhi(vv.x), bflo(vv.y), bfhi(vv.y)};
            }
            __syncthreads();
#pragma unroll 2
            for (int s = 0; s < 64; ++s) {
                const f32x4 f4 = *(const LAS f32x4*)(sF + s * 64 + 4 * dq), q4 = *(const LAS f32x4*)(sQ + s * 64 + 4 * dq);
                const float vi = sV[s * 32 + cloc];
                const f32x2 vi2 = (f32x2){vi, vi};
                stA = pfma((f32x2){f4.x, f4.y}, stA - vi2, vi2); stB = pfma((f32x2){f4.z, f4.w}, stB - vi2, vi2);
                const f32x2 py = pfma(stB, (f32x2){q4.z, q4.w}, stA * (f32x2){q4.x, q4.y});
                const float y = red16(py.x + py.y);
                if (dq == 0) sO[s * 32 + cloc] = y;
            }
            __syncthreads();
            {
                const int s = ch * 64 + tt; const size_t t = (size_t)b * SEQ + s;
                *(f32x4*)(OH + t * 512 + 64 * h + 32 * half + 4 * cg) = *(const LAS f32x4*)(sO + tt * 32 + 4 * cg);
            }
        }
    }
    __syncthreads();
}

__device__ __forceinline__ void post_phase(ArgsRef a, int l) {
    const int TID = opaque_tid(), BID = opaque_bid(); (void)TID; (void)BID;
    const bf16_t* P = (const bf16_t*)(a.ws + WS_PROJ); const bf16_t* LR = (const bf16_t*)(a.ws + WS_LRO);
    const float* OR = (const float*)(a.ws + WS_OR); const float* OH = (const float*)(a.ws + WS_OH); const float* BON = (const float*)(a.ws + WS_BON);
    bf16_t* Y = (bf16_t*)(a.ws + WS_YC);
    const float* muv = (const float*)a.in[8] + (size_t)l * 1792 + 1024;
    const float* lnw = (const float*)a.in[17] + (size_t)l * 512; const float* lnb = (const float*)a.in[18] + (size_t)l * 512;
    const float* gn = (const float*)a.in[33] + (size_t)l * 64;
    const int gt = BID * NTHREADS + TID, NGT = gridDim.x * NTHREADS;
    for (int it = gt; it < T * 128; it += NGT) {
        const int cg = it & 7, hh = (it >> 3) & 15; const size_t t = (size_t)(it >> 7);
        float o[8], y[8];
        if (hh < 8) {
            const int c0 = 64 * hh + 8 * cg;
            const f32x4 o0 = *(const f32x4*)(OR + t * 512 + c0), o1 = *(const f32x4*)(OR + t * 512 + c0 + 4);
            o[0] = o0.x; o[1] = o0.y; o[2] = o0.z; o[3] = o0.w; o[4] = o1.x; o[5] = o1.y; o[6] = o1.z; o[7] = o1.w;
            float s = 0.f;
#pragma unroll
            for (int j = 0; j < 8; ++j) s += o[j];
            const float mean = red8(s) * (1.0f / 64.0f);
            float q = 0.f;
#pragma unroll
            for (int j = 0; j < 8; ++j) { o[j] -= mean; q += o[j] * o[j]; }
            const float rstd = 1.0f / sqrtf(red8(q) * (1.0f / 64.0f) + 64e-5f);
            float v[8], pv[8], g[8];
            unpack8(*(const u32x4*)(P + t * DIN + 1024 + c0), v);
            if ((t & (SEQ - 1)) != 0) unpack8(*(const u32x4*)(P + (t - 1) * DIN + 1024 + c0), pv);
            else {
#pragma unroll
                for (int j = 0; j < 8; ++j) pv[j] = 0.f; }
            unpack8(*(const u32x4*)(LR + t * 1536 + 1024 + c0), g);
            const float bon = BON[t * 8 + hh];
#pragma unroll
            for (int j = 0; j < 8; ++j) { const float vl = v[j] + (pv[j] - v[j]) * muv[c0 + j];
                y[j] = (o[j] * rstd * lnw[c0 + j] + lnb[c0 + j] + bon * vl) * g[j]; }
            *(u32x4*)(Y + t * D + c0) = pack8(y);
        } else {
            const int h = hh - 8, c0 = 64 * h + 8 * cg;
            const f32x4 o0 = *(const f32x4*)(OH + t * 512 + c0), o1 = *(const f32x4*)(OH + t * 512 + c0 + 4);
            o[0] = o0.x; o[1] = o0.y; o[2] = o0.z; o[3] = o0.w; o[4] = o1.x; o[5] = o1.y; o[6] = o1.z; o[7] = o1.w;
            float q = 0.f;
#pragma unroll
            for (int j = 0; j < 8; ++j) q += o[j] * o[j];
            const float rs = 1.0f / sqrtf(red8(q) * (1.0f / 64.0f) + 1e-6f);
            float g[8];
            unpack8(*(const u32x4*)(P + t * DIN + C_HG + 1536 + c0), g);
#pragma unroll
            for (int j = 0; j < 8; ++j) y[j] = o[j] * rs * gn[8 * cg + j] * siluf_(g[j]);
            *(u32x4*)(Y + t * D + 1536 + c0) = pack8(y);
        }
    }
}

__device__ __forceinline__ void attn_phase(ArgsRef a, int l, LAS unsigned char* lds) {
    const int TID = opaque_tid(), BID = opaque_bid();
    const bf16_t* P = (const bf16_t*)(a.ws + WS_PROJ); bf16_t* Y = (bf16_t*)(a.ws + WS_YC);
    const int* pos = (const int*)a.in[1];
    const float* qn = (const float*)a.in[19] + (size_t)l * 64; const float* kn = (const float*)a.in[20] + (size_t)l * 64; const float* sinks = (const float*)a.in[21] + (size_t)l * 8;
    constexpr int KST = 144, VST = 528;
    LAS unsigned char* sK = lds; LAS unsigned char* sVt = sK + 256 * KST; LAS unsigned char* sQ = sVt + 64 * VST; LAS float* sM = (LAS float*)(sQ + 512 * KST);
    const int tid = TID, cg = tid & 7, wave = tid >> 6, lane = tid & 63;
    float kmaxg = 0.f;
    for (int j = 0; j < 64; ++j) kmaxg = fmaxf(kmaxg, fabsf(kn[j]));
    const float kbound = 8.0f * kmaxg;
    float gk[8], gq[8], invf[8];
#pragma unroll
    for (int j = 0; j < 8; ++j) { gk[j] = kn[8 * cg + j]; gq[j] = qn[8 * cg + j]; invf[j] = exp2f(-(float)j * (18.931568569324174f / 8.0f)); }
    for (int job = BID; job < 512; job += gridDim.x) {
        const int b = job >> 5, nb = (job >> 1) & 15, kvh = job & 1;
        __syncthreads();
#pragma unroll 1
        for (int r = 0; r < 4; ++r) {
            const int kj = (tid >> 3) + 64 * r, s = (nb - 1) * 128 + kj;
            float k[8], v[8];
            if (s >= 0) {
                const size_t t = (size_t)b * SEQ + s;
                unpack8(*(const u32x4*)(P + t * DIN + C_ATT + 512 + 64 * kvh + 8 * cg), k); unpack8(*(const u32x4*)(P + t * DIN + C_ATT + 640 + 64 * kvh + 8 * cg), v);
            } else {
#pragma unroll
                for (int j = 0; j < 8; ++j) { k[j] = 0.f; v[j] = 0.f; } }
            float ss = 0.f;
#pragma unroll
            for (int j = 0; j < 8; ++j) ss += k[j] * k[j];
            ss = red8(ss);
            const float rs = 1.0f / sqrtf(ss * (1.0f / 64.0f) + 1e-6f);
#pragma unroll
            for (int j = 0; j < 8; ++j) k[j] = k[j] * rs * gk[j];
            const float pf = (float)pos[b * SEQ + (s >= 0 ? s : 0)];
#pragma unroll
            for (int j = 0; j < 8; ++j) {
                const float other = dpp<XOR1>(k[j]);
                if (cg < 2) { float sn, cs; sincos_big(pf * invf[j], sn, cs); k[j] = (cg == 0) ? (k[j] * cs - other * sn) : (k[j] * cs + other * sn); }
            }
            *(LAS u32x4*)(sK + kj * KST + 16 * cg) = pack8(k);
#pragma unroll
            for (int j = 0; j < 8; j += 2) { const unsigned w = pk2(v[j], v[j + 1]);
                *(LAS unsigned short*)(sVt + (8 * cg + j) * VST + 2 * kj) = (unsigned short)(w & 0xffffu); *(LAS unsigned short*)(sVt + (8 * cg + j + 1) * VST + 2 * kj) = (unsigned short)(w >> 16); }
        }
#pragma unroll 1
        for (int r = 0; r < 8; ++r) {
            const int row = (tid >> 3) + 64 * r, g = row >> 7, qi = row & 127, hq = 4 * kvh + g;
            const size_t tq = (size_t)b * SEQ + nb * 128 + qi;
            float q[8];
            unpack8(*(const u32x4*)(P + tq * DIN + C_ATT + 64 * hq + 8 * cg), q);
            float ss = 0.f;
#pragma unroll
            for (int j = 0; j < 8; ++j) ss += q[j] * q[j];
            ss = red8(ss);
            const float rs = 0.125f / sqrtf(ss * (1.0f / 64.0f) + 1e-6f);
#pragma unroll
            for (int j = 0; j < 8; ++j) q[j] = q[j] * rs * gq[j];
            const float pf = (float)pos[b * SEQ + nb * 128 + qi];
            float qq = 0.f;
#pragma unroll
            for (int j = 0; j < 8; ++j) {
                const float other = dpp<XOR1>(q[j]);
                if (cg < 2) { float sn, cs; sincos_big(pf * invf[j], sn, cs); q[j] = (cg == 0) ? (q[j] * cs - other * sn) : (q[j] * cs + other * sn); }
                qq += q[j] * q[j];
            }
            qq = red8(qq);
            if (cg == 0) sM[row] = sqrtf(qq) * kbound;
            *(LAS u32x4*)(sQ + row * KST + 16 * cg) = pack8(q);
        }
        __syncthreads();
        const int g = wave >> 1, qh = wave & 1, hq = 4 * kvh + g, fr = lane & 15, fq = lane >> 4;
        const float sinkv = sinks[hq];
#pragma unroll 1
        for (int qt = 0; qt < 4; ++qt) {
            const int qi0 = 64 * qh + 16 * qt, R0 = g * 128 + qi0, kt0 = qi0 >> 4;
            const bf16x8 qf0 = *(const LAS bf16x8*)(sQ + (R0 + fr) * KST + 16 * fq), qf1 = *(const LAS bf16x8*)(sQ + (R0 + fr) * KST + 16 * fq + 64);
            const float msh = sM[R0 + fr];
            const int ql = qi0 + fr;
            f32x4 oacc[4];
#pragma unroll
            for (int dt = 0; dt < 4; ++dt) oacc[dt] = (f32x4){0.f, 0.f, 0.f, 0.f};
            float lsum = 0.f;
#pragma unroll
            for (int ks = 0; ks < 5; ++ks) {
                unsigned pw[4];
#pragma unroll
                for (int h2 = 0; h2 < 2; ++h2) {
                    const int ti = 2 * ks + h2, kt = (kt0 + ti) < 15 ? (kt0 + ti) : 15;
                    const bf16x8 kf0 = *(const LAS bf16x8*)(sK + (16 * kt + fr) * KST + 16 * fq), kf1 = *(const LAS bf16x8*)(sK + (16 * kt + fr) * KST + 16 * fq + 64);
                    f32x4 sc = (f32x4){0.f, 0.f, 0.f, 0.f};
                    sc = __builtin_amdgcn_mfma_f32_16x16x32_bf16(kf0, qf0, sc, 0, 0, 0);
                    sc = __builtin_amdgcn_mfma_f32_16x16x32_bf16(kf1, qf1, sc, 0, 0, 0);
                    float p[4];
#pragma unroll
                    for (int j = 0; j < 4; ++j) { const int kj = 16 * (kt0 + ti) + 4 * fq + j;
                        const bool valid = (kj > ql) && (kj <= ql + 128) && (nb > 0 || kj >= 128);
                        p[j] = valid ? __expf(sc[j] - msh) : 0.f; lsum += p[j]; }
                    pw[2 * h2] = pk2(p[0], p[1]); pw[2 * h2 + 1] = pk2(p[2], p[3]);
                }
                const u32x4 pq = (u32x4){pw[0], pw[1], pw[2], pw[3]};
                const bf16x8 pf = __builtin_bit_cast(bf16x8, pq);
                const int kta = (kt0 + 2 * ks) < 15 ? (kt0 + 2 * ks) : 15, ktb = (kt0 + 2 * ks + 1) < 15 ? (kt0 + 2 * ks + 1) : 15;
#pragma unroll
                for (int dt = 0; dt < 4; ++dt) {
                    const u32x2 va = *(const LAS u32x2*)(sVt + (16 * dt + fr) * VST + (16 * kta + 4 * fq) * 2), vb = *(const LAS u32x2*)(sVt + (16 * dt + fr) * VST + (16 * ktb + 4 * fq) * 2);
                    const u32x4 vq = (u32x4){va.x, va.y, vb.x, vb.y};
                    oacc[dt] = __builtin_amdgcn_mfma_f32_16x16x32_bf16(__builtin_bit_cast(bf16x8, vq), pf, oacc[dt], 0, 0, 0);
                }
            }
            lsum += __shfl_xor(lsum, 16); lsum += __shfl_xor(lsum, 32);
            const float inv = 1.0f / (lsum + __expf(sinkv - msh));
            const size_t tq = (size_t)b * SEQ + nb * 128 + ql;
#pragma unroll
            for (int dt = 0; dt < 4; ++dt) { u32x2 w; w.x = pk2(oacc[dt][0] * inv, oacc[dt][1] * inv); w.y = pk2(oacc[dt][2] * inv, oacc[dt][3] * inv);
                *(u32x2*)(Y + tq * D + 512 + 64 * hq + 16 * dt + 4 * fq) = w; }
        }
    }
    __syncthreads();
}

__device__ __forceinline__ void s5_phase(ArgsRef a, int l, LAS unsigned char* lds) {
    const int TID = opaque_tid(), BID = opaque_bid(); (void)TID; (void)BID;
    const bf16_t* P = (const bf16_t*)(a.ws + WS_PROJ); bf16_t* Z = (bf16_t*)(a.ws + WS_Z);
    const int tid = TID, wave = tid >> 6, lane = tid & 63;
    LAS float* sU = (LAS float*)lds + wave * 1024;
    LAS float* sX = (LAS float*)lds + 8192 + wave * (16 * 130);
    LAS float* sE = (LAS float*)lds + 8192 + 8 * 16 * 130;
    for (int job = BID; job < 512; job += gridDim.x) {
        const int b = job >> 5, g = job & 31;
        const float lre = ((const float*)a.in[22])[(size_t)l * 2048 + g * 64 + lane], lim = ((const float*)a.in[23])[(size_t)l * 2048 + g * 64 + lane];
        const float dt = expf(((const float*)a.in[24])[l * 32 + g]);
        float sn, cs; sincos_big(lim * dt, sn, cs);
        const float er = expf(lre * dt), lbr = er * cs, lbi = er * sn;
        const float den = 1.0f / (lre * lre + lim * lim);
        const float fr = ((lbr - 1.0f) * lre + lbi * lim) * den, fi = (lbi * lre - (lbr - 1.0f) * lim) * den;
        f32x2 bb[16];
        {
            const f32x4* br = (const f32x4*)((const float*)a.in[25] + ((size_t)l * 2048 + g * 64 + lane) * 16); const f32x4* bi = (const f32x4*)((const float*)a.in[26] + ((size_t)l * 2048 + g * 64 + lane) * 16);
#pragma unroll
            for (int q = 0; q < 4; ++q) { const f32x4 r4 = br[q], i4 = bi[q];
                bb[4 * q] = (f32x2){fr * r4.x - fi * i4.x, fr * i4.x + fi * r4.x}; bb[4 * q + 1] = (f32x2){fr * r4.y - fi * i4.y, fr * i4.y + fi * r4.y};
                bb[4 * q + 2] = (f32x2){fr * r4.z - fi * i4.z, fr * i4.z + fi * r4.z}; bb[4 * q + 3] = (f32x2){fr * r4.w - fi * i4.w, fr * i4.w + fi * r4.w}; }
        }
        float creg[32];
        {
            const float* cre = (const float*)a.in[27] + ((size_t)l * 32 + g) * 1024 + (lane & 15) * 64 + (lane >> 4);
            const float* cim = (const float*)a.in[28] + ((size_t)l * 32 + g) * 1024 + (lane & 15) * 64 + (lane >> 4);
#pragma unroll
            for (int kk = 0; kk < 16; ++kk) { creg[kk] = cre[4 * kk]; creg[16 + kk] = -cim[4 * kk]; }
        }
        f32x4 dsk;
        { const float* dp = (const float*)a.in[29] + (size_t)l * 512 + 16 * g + 4 * (lane >> 4); dsk = (f32x4){dp[0], dp[1], dp[2], dp[3]}; }
        const size_t tbase = (size_t)b * SEQ + wave * 256;
        f32x2 xs = (f32x2){0.f, 0.f}; const f32x2 lbr2 = (f32x2){lbr, lbr}, lbi2 = (f32x2){lbi, lbi};
        for (int c = 0; c < 4; ++c) {
            { const size_t t = tbase + c * 64 + lane; float u[16]; unpack8(*(const u32x4*)(P + t * DIN + C_S5 + 16 * g), u); unpack8(*(const u32x4*)(P + t * DIN + C_S5 + 16 * g + 8), u + 8);
              LAS f32x4* d = (LAS f32x4*)(sU + lane * 16); d[0] = (f32x4){u[0], u[1], u[2], u[3]}; d[1] = (f32x4){u[4], u[5], u[6], u[7]}; d[2] = (f32x4){u[8], u[9], u[10], u[11]}; d[3] = (f32x4){u[12], u[13], u[14], u[15]}; }
            LDS_FENCE();
#pragma unroll 2
            for (int s = 0; s < 64; ++s) {
                const LAS f32x4* up = (const LAS f32x4*)(sU + s * 16);
                f32x2 bu0 = (f32x2){0.f, 0.f}, bu1 = bu0;
#pragma unroll
                for (int q = 0; q < 4; ++q) { const f32x4 u4 = up[q];
                    bu0 = pfma(bb[4 * q], (f32x2){u4.x, u4.x}, bu0); bu1 = pfma(bb[4 * q + 1], (f32x2){u4.y, u4.y}, bu1);
                    bu0 = pfma(bb[4 * q + 2], (f32x2){u4.z, u4.z}, bu0); bu1 = pfma(bb[4 * q + 3], (f32x2){u4.w, u4.w}, bu1); }
                { const f32x2 nx = pfma(lbr2, xs, bu0 + bu1); xs = pfma(lbi2, (f32x2){-xs.y, xs.x}, nx); }
            }
            LDS_FENCE();
        }
        sE[wave * 128 + lane] = xs.x; sE[wave * 128 + 64 + lane] = xs.y;
        float pr = lbr, pi = lbi;
#pragma unroll
        for (int i = 0; i < 8; ++i) { const float nr = pr * pr - pi * pi, ni = 2.0f * pr * pi; pr = nr; pi = ni; }
        __syncthreads();
        xs = (f32x2){0.f, 0.f};
        for (int w = 0; w < wave; ++w) { const float er_ = sE[w * 128 + lane], ei_ = sE[w * 128 + 64 + lane];
            const float nr = pr * xs.x - pi * xs.y + er_, ni = pr * xs.y + pi * xs.x + ei_; xs.x = nr; xs.y = ni; }
        for (int c = 0; c < 4; ++c) {
            { const size_t t = tbase + c * 64 + lane; float u[16]; unpack8(*(const u32x4*)(P + t * DIN + C_S5 + 16 * g), u); unpack8(*(const u32x4*)(P + t * DIN + C_S5 + 16 * g + 8), u + 8);
              LAS f32x4* d = (LAS f32x4*)(sU + lane * 16); d[0] = (f32x4){u[0], u[1], u[2], u[3]}; d[1] = (f32x4){u[4], u[5], u[6], u[7]}; d[2] = (f32x4){u[8], u[9], u[10], u[11]}; d[3] = (f32x4){u[12], u[13], u[14], u[15]}; }
            LDS_FENCE();
#pragma unroll 1
            for (int s16 = 0; s16 < 4; ++s16) {
#pragma unroll 2
                for (int s = 0; s < 16; ++s) {
                    const LAS f32x4* up = (const LAS f32x4*)(sU + (s16 * 16 + s) * 16);
                    f32x2 bu0 = (f32x2){0.f, 0.f}, bu1 = bu0;
#pragma unroll
                    for (int q = 0; q < 4; ++q) { const f32x4 u4 = up[q];
                        bu0 = pfma(bb[4 * q], (f32x2){u4.x, u4.x}, bu0); bu1 = pfma(bb[4 * q + 1], (f32x2){u4.y, u4.y}, bu1);
                        bu0 = pfma(bb[4 * q + 2], (f32x2){u4.z, u4.z}, bu0); bu1 = pfma(bb[4 * q + 3], (f32x2){u4.w, u4.w}, bu1); }
                    { const f32x2 nx = pfma(lbr2, xs, bu0 + bu1); xs = pfma(lbi2, (f32x2){-xs.y, xs.x}, nx); }
                    sX[s * 130 + lane] = xs.x; sX[s * 130 + 64 + lane] = xs.y;
                }
                LDS_FENCE();
                f32x4 yacc = (f32x4){0.f, 0.f, 0.f, 0.f};
                const LAS float* xp = sX + (lane & 15) * 130 + (lane >> 4);
#pragma unroll
                for (int kk = 0; kk < 32; ++kk) yacc = __builtin_amdgcn_mfma_f32_16x16x4f32(creg[kk], xp[4 * kk], yacc, 0, 0, 0);
                const int tok = s16 * 16 + (lane & 15);
                const f32x4 u4 = *(const LAS f32x4*)(sU + tok * 16 + 4 * (lane >> 4));
                float z[4];
#pragma unroll
                for (int j = 0; j < 4; ++j) { const float y = yacc[j] + dsk[j] * u4[j]; z[j] = 0.5f * y * (1.0f + erff(y * 0.70710678118654752f)); }
                u32x2 w; w.x = pk2(z[0], z[1]); w.y = pk2(z[2], z[3]);
                *(u32x2*)(Z + (tbase + c * 64 + tok) * 512 + 16 * g + 4 * (lane >> 4)) = w;
                LDS_FENCE();
            }
        }
        __syncthreads();
    }
}

constexpr int NPH = 11;
#ifndef DUPMASK
#define DUPMASK 0
#endif
__global__ void __launch_bounds__(NTHREADS, 2) mega(Args a_, int lo, int hi) {
    extern __shared__ __attribute__((aligned(16))) unsigned char lds_raw[];
    LAS unsigned char* lds = (LAS unsigned char*)lds_raw;
#pragma unroll 1
    for (int step2 = 2 * lo; step2 < 2 * hi; ++step2) {
        const int step = step2 >> 1;
        if ((step2 & 1) && !((DUPMASK >> (step % NPH)) & 1)) continue;
        const __attribute__((address_space(4))) Args* ap = (const __attribute__((address_space(4))) Args*)__builtin_amdgcn_kernarg_segment_ptr();
        asm volatile("" : "+s"(ap));
        ArgsRef a = *ap;
        unsigned char* ws = a.ws;
        float* SSa = (float*)(ws + WS_SS); float* SSb = SSa + T; float* SSc = SSb + T;
        const int l = step / NPH, ph = step % NPH;
        const float* xin = (l == 0) ? (const float*)a.in[0] : (const float*)a.out;
#ifndef PHMASK
#define PHMASK 0x7ff
#endif
        switch (ph) {
        case 0: if (PHMASK & (1 << 0)) { conv_phase(a, l, lds); if (l == 0) norm_phase(xin, (bf16_t*)(ws + WS_XN), SSa); zero_phase(SSb, T); } break;
        case 1: if (PHMASK & (1 << 1)) { pg8::EpiSwiGLU E; E.H = (bf16_t*)(ws + WS_HID); E.SS = SSa; run_gemm(lds, (const bf16_t*)(ws + WS_XN), (const bf16_t*)(ws + W_UP1), 2 * FF, D, E); } break;
        case 2: if (PHMASK & (1 << 2)) { pg8::EpiResidual<true> E; E.base = xin; E.out = a.out; E.XN = (bf16_t*)(ws + WS_XN); E.SS = SSb; run_gemm(lds, (const bf16_t*)(ws + WS_HID), (const bf16_t*)(ws + W_DN1), D, FF, E); } break;
        case 3: if (PHMASK & (1 << 3)) { pg8::EpiBf16 E; E.O = (bf16_t*)(ws + WS_PROJ); E.ldc = DIN; E.SS = SSb; run_gemm(lds, (const bf16_t*)(ws + WS_XN), (const bf16_t*)(ws + W_IN), DIN, D, E); } break;
        case 4: if (PHMASK & (1 << 4)) { zero_phase(SSa, T); zero_phase(SSc, T); alr_phase(a, l); attn_phase(a, l, lds); s5_phase(a, l, lds); hgrn_phase(a, l, lds); } break;
        case 5: if (PHMASK & (1 << 5)) { pg8::EpiLR E; E.O = (bf16_t*)(ws + WS_LRO); E.w0 = (const float*)a.in[9] + (size_t)l * 512; E.a0 = (const float*)a.in[11] + (size_t)l * 512;
                  run_gemm(lds, (const bf16_t*)(ws + WS_ALR), (const bf16_t*)(ws + W_LR), 1536, 256, E);
                  pg8::EpiGLU G; G.Z = (const bf16_t*)(ws + WS_Z); G.Y = (bf16_t*)(ws + WS_YC); G.b = (const float*)a.in[31] + (size_t)l * 512;
                  run_gemm(lds, (const bf16_t*)(ws + WS_Z), (const bf16_t*)(ws + W_GLU), 512, 512, G); } break;
        case 6: if (PHMASK & (1 << 6)) rwkv_phase(a, l, lds); break;
        case 7: if (PHMASK & (1 << 7)) post_phase(a, l); break;
        case 8: if (PHMASK & (1 << 8)) { pg8::EpiResidual<false> E; E.base = a.out; E.out = a.out; E.XN = (bf16_t*)(ws + WS_XN); E.SS = SSc; run_gemm(lds, (const bf16_t*)(ws + WS_YC), (const bf16_t*)(ws + W_OUT), D, D, E); } break;
        case 9: if (PHMASK & (1 << 9)) { pg8::EpiSwiGLU E; E.H = (bf16_t*)(ws + WS_HID); E.SS = SSc; run_gemm(lds, (const bf16_t*)(ws + WS_XN), (const bf16_t*)(ws + W_UP2), 2 * FF, D, E); } break;
        case 10: if (PHMASK & (1 << 10)) { pg8::EpiResidual<true> E; E.base = a.out; E.out = a.out; E.XN = (l + 1 < NL) ? (bf16_t*)(ws + WS_XN) : nullptr; E.SS = SSa; run_gemm(lds, (const bf16_t*)(ws + WS_HID), (const bf16_t*)(ws + W_DN2), D, FF, E); } break;
        }
        if (step2 + 1 < 2 * hi) { __syncthreads(); cg::this_grid().sync(); }
    }
}

extern "C" void kernel_launch(void* const* d_in, const int* in_sizes, int n_in, void* d_out, int out_size, void* d_ws, size_t ws_size, hipStream_t stream) {
    static int grid = 0;
    if (!grid) {
        int dev = 0, cus = 0, per_cu = 0;
        hipGetDevice(&dev);
        hipDeviceGetAttribute(&cus, hipDeviceAttributeMultiprocessorCount, dev);
        hipFuncSetAttribute((const void*)mega, hipFuncAttributeMaxDynamicSharedMemorySize, LDS_BYTES);
        hipOccupancyMaxActiveBlocksPerMultiprocessor(&per_cu, (const void*)mega, NTHREADS, LDS_BYTES);
        if (per_cu < 1) per_cu = 1;
        grid = cus * 1;
        if (grid != 256) fprintf(stderr, "kernel_launch: grid %d (cus %d, per_cu %d)\n", grid, cus, per_cu);
    }
    Args a{};
    for (int i = 0; i < 39; ++i) a.in[i] = d_in[i];
    a.out = (float*)d_out; a.ws = (unsigned char*)d_ws;
#if ONE_LAUNCH
    int lo = 0, hi = NL * NPH;
    void* args[] = {&a, &lo, &hi};
    hipError_t e = hipLaunchCooperativeKernel((void*)mega, dim3(grid), dim3(NTHREADS), args, LDS_BYTES, stream);
    if (e != hipSuccess) fprintf(stderr, "cooperative launch failed: %s (grid %d)\n", hipGetErrorString(e), grid);
#else
    for (int s = 0; s < NL * NPH; ++s) hipLaunchKernelGGL(mega, dim3(grid), dim3(NTHREADS), LDS_BYTES, stream, a, s, s + 1);
#endif
}
```

```cpp
#include <hip/hip_runtime.h>
#include <hip/hip_cooperative_groups.h>
#include <cstdio>
#include <cstdint>
namespace cg = cooperative_groups;

#ifndef ONE_LAUNCH
#define ONE_LAUNCH 1
#endif

#define LAS __attribute__((address_space(3)))
typedef unsigned short bf16_t;
typedef short bf16x8 __attribute__((ext_vector_type(8)));
typedef float f32x4 __attribute__((ext_vector_type(4)));
typedef float f32x2 __attribute__((ext_vector_type(2)));
typedef unsigned u32x4 __attribute__((ext_vector_type(4)));
typedef unsigned u32x2 __attribute__((ext_vector_type(2)));

constexpr int T = 32768, SEQ = 2048, NB = 16, D = 2048, FF = 5632, DIN = 5120, NL = 2;
constexpr int C_RWKV = 0, C_ATT = 1792, C_S5 = 2560, C_HG = 3072;
constexpr int NTHREADS = 512, NWAVES = 8;

constexpr size_t SZ_UP = (size_t)2 * FF * D * 2, SZ_DN = (size_t)D * FF * 2, SZ_IN = (size_t)DIN * D * 2, SZ_LR = (size_t)1536 * 256 * 2,
                 SZ_GLU = (size_t)512 * 512 * 2, SZ_OUT = (size_t)D * D * 2;
constexpr size_t W_UP1 = 0, W_DN1 = W_UP1 + SZ_UP, W_IN = W_DN1 + SZ_DN, W_LR = W_IN + SZ_IN, W_GLU = W_LR + SZ_LR, W_OUT = W_GLU + SZ_GLU,
                 W_UP2 = W_OUT + SZ_OUT, W_DN2 = W_UP2 + SZ_UP, W_END = W_DN2 + SZ_DN;
constexpr size_t WS_XN = W_END, WS_BIG = WS_XN + (size_t)T * D * 2;
constexpr size_t WS_HID = WS_BIG;
constexpr size_t WS_PROJ = WS_BIG, WS_LRO = WS_PROJ + (size_t)T * DIN * 2, WS_ALR = WS_LRO + (size_t)T * 1536 * 2, WS_Z = WS_ALR + (size_t)T * 256 * 2,
                 WS_OR = WS_Z + (size_t)T * 512 * 2, WS_OH = WS_OR + (size_t)T * 512 * 4, WS_BON = WS_OH + (size_t)T * 512 * 4, WS_YC = WS_BON + (size_t)T * 8 * 4, WS_SS = WS_YC + (size_t)T * D * 2, WS_END = WS_SS + (size_t)3 * T * 4;
static_assert(WS_END <= (size_t)1 << 30, "workspace");
static_assert(WS_HID + (size_t)T * FF * 2 <= (size_t)1 << 30, "workspace");

constexpr int LDS_BYTES = 147456;

struct Args { const void* in[39]; float* out; unsigned char* ws; };
typedef const __attribute__((address_space(4))) Args& ArgsRef;

__device__ __forceinline__ unsigned pk2(float lo, float hi) { unsigned r; asm volatile("v_cvt_pk_bf16_f32 %0, %1, %2" : "=v"(r) : "v"(lo), "v"(hi)); return r; }
__device__ __forceinline__ float bflo(unsigned w) { return __uint_as_float(w << 16); }
__device__ __forceinline__ float bfhi(unsigned w) { return __uint_as_float(w & 0xffff0000u); }
__device__ __forceinline__ void unpack8(u32x4 q, float* f) { f[0] = bflo(q.x); f[1] = bfhi(q.x); f[2] = bflo(q.y); f[3] = bfhi(q.y); f[4] = bflo(q.z); f[5] = bfhi(q.z); f[6] = bflo(q.w); f[7] = bfhi(q.w); }
__device__ __forceinline__ u32x4 pack8(const float* f) { u32x4 o; o.x = pk2(f[0], f[1]); o.y = pk2(f[2], f[3]); o.z = pk2(f[4], f[5]); o.w = pk2(f[6], f[7]); return o; }
template <int CTRL> __device__ __forceinline__ float dpp(float x) { return __builtin_bit_cast(float, __builtin_amdgcn_mov_dpp(__builtin_bit_cast(int, x), CTRL, 0xf, 0xf, true)); }
constexpr int XOR1 = 0xB1, XOR2 = 0x4E, XOR7 = 0x141, XOR8 = 0x128;
__device__ __forceinline__ float red8(float v) { v += dpp<XOR1>(v); v += dpp<XOR2>(v); v += dpp<XOR7>(v); return v; }
__device__ __forceinline__ float red16(float v) { v = red8(v); v += dpp<XOR8>(v); return v; }
__device__ __forceinline__ float wave_sum(float v) {
#pragma unroll
    for (int o = 1; o < 64; o <<= 1) v += __shfl_xor(v, o);
    return v;
}
__device__ __forceinline__ float sigmoidf_(float x) { return 1.0f / (1.0f + __expf(-x)); }
__device__ __forceinline__ float siluf_(float x) { return x / (1.0f + __expf(-x)); }
__device__ __forceinline__ int opaque_tid() { int t = threadIdx.x; asm volatile("" : "+v"(t)); return t; }
__device__ __forceinline__ int opaque_bid() { int t = blockIdx.x; asm volatile("" : "+s"(t)); return t; }
__device__ __forceinline__ f32x2 pfma(f32x2 a, f32x2 b, f32x2 c) { return __builtin_elementwise_fma(a, b, c); }
#define LDS_FENCE() asm volatile("s_waitcnt lgkmcnt(0)" ::: "memory")
__device__ __forceinline__ void sincos_big(float x, float& sn, float& cs) {
    const float n = rintf(x * 0.15915494309189535f);
    float r = fmaf(-n, 6.28318548202514648f, x); r = fmaf(-n, -1.7484555e-7f, r);
    sn = __sinf(r); cs = __cosf(r);
}

namespace pg8 {
constexpr int BM = 256, BK = 64, HALF = 128, HTB = HALF * BK * 2, STAGE_BYTES = 8 * HTB, NXCD = 8, WGM = 8;
__host__ __device__ __forceinline__ int lds_byte(int r, int c) { const int st = (r >> 4) * 2 + (c >> 5), rr = r & 15, cc = c & 31, ob = rr * 64 + cc * 2; return st * 1024 + (ob ^ (((ob >> 9) & 1) << 5)); }
__host__ __device__ __forceinline__ void stage_rc(int b, int& R, int& C) { const int st = b / 1024, sb = b % 1024, swz = sb ^ (((sb >> 9) & 1) << 5); R = (st >> 1) * 16 + swz / 64; C = (st & 1) * 32 + (swz % 64) / 2; }
__host__ __device__ __forceinline__ int perm32(int rho) { const int n = rho >> 4, i = rho & 15; return 8 * (i >> 2) + 4 * n + (i & 3); }
struct Unit { int pm, pn; };
struct Gemm { const bf16_t* A; const bf16_t* Bt; int M, N, K; };
struct StaticOrder {
    int nM, nN, nwg, G, c;
    __device__ void init(int M, int N, int G_, int c_) { nM = M / BM; nN = N / BM; nwg = nM * nN; G = G_; c = c_; }
    __device__ bool next(int i, Unit& u) const {
        const long L = (long)i * G + c; if (L >= nwg) return false;
        int wgid = (int)L; { const int q = nwg / NXCD, r = nwg % NXCD, xcd = wgid % NXCD, off = wgid / NXCD; wgid = (xcd < r ? xcd * (q + 1) : r * (q + 1) + (xcd - r) * q) + off; }
        const int nig = WGM * nN, gid = wgid / nig, fm = gid * WGM, gsz = (nM - fm) < WGM ? (nM - fm) : WGM;
        u.pm = fm + ((wgid % nig) % gsz); u.pn = (wgid % nig) / gsz; return true;
    }
};
template <class Epi>
__device__ __forceinline__ void gemm_phase(LAS unsigned char* lds, const Gemm g, const StaticOrder S, const Epi E) {
    const int TID = opaque_tid(), BID = opaque_bid(); (void)TID; (void)BID;
    const int tid = TID, wid = __builtin_amdgcn_readfirstlane(tid >> 6), lane = tid & 63, wr = wid >> 2, wc = wid & 3, fr = lane & 15, fq = lane >> 4;
    const int K = g.K, nt = K / BK;
    unsigned voffA[2], voffB[2];
#pragma unroll
    for (int i = 0; i < 2; ++i) { int R, C; stage_rc(tid * 16 + i * 8192, R, C); const int Rb = Epi::PERM ? ((R & ~31) + perm32(R & 31)) : R;
        voffA[i] = (unsigned)(R * K + C) * 2u; voffB[i] = (unsigned)(Rb * K + C) * 2u; }
    const size_t kstep = (size_t)(BK * 2);
    const size_t hstep = (size_t)HALF * K * 2;
    const size_t tstep = 2 * hstep;
    const unsigned ldsw = (unsigned)wid * 1024u;
    const int aoff = lds_byte(wr * 64 + fr, fq * 8), boff = lds_byte(wc * 32 + fr, fq * 8);
#define PG8_SA(b, h) (((b) * 2 + (h)) * HTB)
#define PG8_SB(b, h) ((4 + (b) * 2 + (h)) * HTB)
#define PG8_STAGE(bufoff, gbase, voff) do { _Pragma("unroll") for (int _i = 0; _i < 2; ++_i) \
        __builtin_amdgcn_global_load_lds((const unsigned*)((const char*)(gbase) + (voff)[_i]), (LAS unsigned*)(lds + (bufoff) + ldsw + _i * 8192), 16, 0, 0); } while (0)
#define PG8_LDA(dst, b, h) do { _Pragma("unroll") for (int m = 0; m < 4; ++m) _Pragma("unroll") for (int k = 0; k < 2; ++k) dst[m][k] = *(const LAS bf16x8*)(lds + PG8_SA(b, h) + aoff + m * 2048 + k * 1024); } while (0)
#define PG8_LDB(dst, b, h) do { _Pragma("unroll") for (int n = 0; n < 2; ++n) _Pragma("unroll") for (int k = 0; k < 2; ++k) dst[n][k] = *(const LAS bf16x8*)(lds + PG8_SB(b, h) + boff + n * 2048 + k * 1024); } while (0)
#define PG8_MMA(ai, bj, At, Bt) do { __builtin_amdgcn_s_setprio(1); _Pragma("unroll") for (int m = 0; m < 4; ++m) _Pragma("unroll") for (int n = 0; n < 2; ++n) _Pragma("unroll") for (int k = 0; k < 2; ++k) \
        acc[ai][bj][m][n] = __builtin_amdgcn_mfma_f32_16x16x32_bf16(Bt[n][k], At[m][k], acc[ai][bj][m][n], 0, 0, 0); __builtin_amdgcn_s_setprio(0); } while (0)
#define PG8_WAIT_V(n) asm volatile("s_waitcnt vmcnt(" #n ")" ::: "memory")
#define PG8_WAIT_L(n) asm volatile("s_waitcnt lgkmcnt(" #n ")" ::: "memory")
#define PG8_BAR __builtin_amdgcn_s_barrier()
#define PG8_SCHED __builtin_amdgcn_sched_barrier(0)
    Unit cur, nxt; int ui = 0;
    if (!S.next(0, cur)) return;
    f32x4 acc[2][2][4][2];
#pragma unroll
    for (int a = 0; a < 2; ++a)
#pragma unroll
        for (int b = 0; b < 2; ++b)
#pragma unroll
            for (int m = 0; m < 4; ++m)
#pragma unroll
                for (int n = 0; n < 2; ++n) acc[a][b][m][n] = (f32x4){0.f, 0.f, 0.f, 0.f};
    bf16x8 At[4][2], B0[2][2], B1[2][2];
    const char* cA = (const char*)g.A + (size_t)cur.pm * tstep; const char* cB = (const char*)g.Bt + (size_t)cur.pn * tstep;
    PG8_STAGE(PG8_SB(0, 0), cB, voffB); PG8_STAGE(PG8_SA(0, 0), cA, voffA); PG8_STAGE(PG8_SB(0, 1), cB + hstep, voffB); PG8_STAGE(PG8_SA(0, 1), cA + hstep, voffA);
    if (wr == 1) PG8_BAR;
    PG8_WAIT_V(4); PG8_BAR;
    PG8_STAGE(PG8_SB(1, 0), cB + kstep, voffB); PG8_STAGE(PG8_SA(1, 0), cA + kstep, voffA); PG8_STAGE(PG8_SB(1, 1), cB + hstep + kstep, voffB);
    PG8_WAIT_V(6); PG8_BAR;
    for (;;) {
        const bool has_next = S.next(ui + 1, nxt);
        const char* nA = has_next ? (const char*)g.A + (size_t)nxt.pm * tstep : cA; const char* nB = has_next ? (const char*)g.Bt + (size_t)nxt.pn * tstep : cB;
#pragma unroll 1
        for (int t = 0; t < nt; t += 2) {
            const bool last = (t == nt - 2);
            const char* a1 = cA + (size_t)(t + 1) * kstep;
            const char* a2 = last ? nA : cA + (size_t)(t + 2) * kstep; const char* b2 = last ? nB : cB + (size_t)(t + 2) * kstep;
            const char* a3 = a2 + kstep; const char* b3 = b2 + kstep;
            PG8_LDB(B0, 0, 0); PG8_SCHED; PG8_LDA(At, 0, 0); PG8_STAGE(PG8_SA(1, 1), a1 + hstep, voffA);
            PG8_WAIT_L(8); PG8_BAR; PG8_WAIT_L(0); PG8_MMA(0, 0, At, B0); PG8_BAR; PG8_SCHED;
            PG8_LDB(B1, 0, 1); PG8_STAGE(PG8_SB(0, 0), b2, voffB);
            PG8_BAR; PG8_WAIT_L(0); PG8_MMA(0, 1, At, B1); PG8_BAR;
            PG8_LDA(At, 0, 1); PG8_STAGE(PG8_SA(0, 0), a2, voffA);
            PG8_BAR; PG8_WAIT_L(0); PG8_MMA(1, 0, At, B0); PG8_BAR; PG8_SCHED;
            PG8_STAGE(PG8_SB(0, 1), b2 + hstep, voffB);
            PG8_WAIT_V(6); PG8_BAR; PG8_MMA(1, 1, At, B1); PG8_BAR;
            PG8_LDB(B0, 1, 0); PG8_SCHED; PG8_LDA(At, 1, 0); PG8_STAGE(PG8_SA(0, 1), a2 + hstep, voffA);
            PG8_WAIT_L(8); PG8_BAR; PG8_WAIT_L(0); PG8_MMA(0, 0, At, B0); PG8_BAR; PG8_SCHED;
            PG8_LDB(B1, 1, 1); PG8_STAGE(PG8_SB(1, 0), b3, voffB);
            PG8_BAR; PG8_WAIT_L(0); PG8_MMA(0, 1, At, B1); PG8_BAR;
            PG8_LDA(At, 1, 1); PG8_STAGE(PG8_SA(1, 0), a3, voffA);
            PG8_BAR; PG8_WAIT_L(0); PG8_MMA(1, 0, At, B0); PG8_BAR; PG8_SCHED;
            PG8_STAGE(PG8_SB(1, 1), b3 + hstep, voffB);
            PG8_WAIT_V(6); PG8_BAR; PG8_MMA(1, 1, At, B1); PG8_BAR;
        }
        E(acc, cur, wr, wc, fr, fq);
        if (!has_next) break;
#pragma unroll
        for (int a = 0; a < 2; ++a)
#pragma unroll
            for (int b = 0; b < 2; ++b)
#pragma unroll
                for (int m = 0; m < 4; ++m)
#pragma unroll
                    for (int n = 0; n < 2; ++n) acc[a][b][m][n] = (f32x4){0.f, 0.f, 0.f, 0.f};
        cur = nxt; cA = nA; cB = nB; ++ui;
    }
    PG8_WAIT_V(0);
    if (wr == 0) PG8_BAR;
    PG8_BAR;
#undef PG8_SA
#undef PG8_SB
#undef PG8_STAGE
#undef PG8_LDA
#undef PG8_LDB
#undef PG8_MMA
#undef PG8_WAIT_V
#undef PG8_WAIT_L
#undef PG8_BAR
#undef PG8_SCHED
}

struct EpiSwiGLU {
    static constexpr bool PERM = true;
    bf16_t* H; const float* SS;
    __device__ __forceinline__ void operator()(const f32x4 (&acc)[2][2][4][2], const Unit& u, int wr, int wc, int fr, int fq) const {
        const int row0 = u.pm * BM + wr * 64 + fr, col0 = u.pn * 128 + wc * 32 + 8 * fq;
#pragma unroll
        for (int ai = 0; ai < 2; ++ai)
#pragma unroll
            for (int m = 0; m < 4; ++m) {
                const float rs = 1.0f / sqrtf(SS[row0 + ai * HALF + m * 16] * (1.0f / D) + 1e-6f);
                float v[8];
#pragma unroll
                for (int n = 0; n < 2; ++n)
#pragma unroll
                    for (int j = 0; j < 4; ++j) { const float gt = acc[ai][0][m][n][j] * rs, up = acc[ai][1][m][n][j] * rs; v[4 * n + j] = siluf_(gt) * up; }
                *(u32x4*)(H + (size_t)(row0 + ai * HALF + m * 16) * FF + col0) = pack8(v);
            }
    }
};
template <bool HALFSTEP> struct EpiResidual {
    static constexpr bool PERM = false;
    static constexpr float scale = HALFSTEP ? 0.5f : 1.0f;
    const float* base; float* out; bf16_t* XN; float* SS;
    __device__ __forceinline__ void operator()(const f32x4 (&acc)[2][2][4][2], const Unit& u, int wr, int wc, int fr, int fq) const {
        const int row0 = u.pm * BM + wr * 64 + fr, col0 = u.pn * BM + wc * 32 + 4 * fq;
#pragma unroll
        for (int ai = 0; ai < 2; ++ai)
#pragma unroll
            for (int m = 0; m < 4; ++m) { const int row = row0 + ai * HALF + m * 16; const size_t ro = (size_t)row * D + col0; float ss = 0.f;
#pragma unroll
                for (int bj = 0; bj < 2; ++bj)
#pragma unroll
                    for (int n = 0; n < 2; ++n) { const f32x4 b = *(const f32x4*)(base + ro + bj * HALF + n * 16); const f32x4 r = b + acc[ai][bj][m][n] * scale; *(f32x4*)(out + ro + bj * HALF + n * 16) = r;
                        if (XN) { u32x2 w; w.x = pk2(r.x, r.y); w.y = pk2(r.z, r.w); *(u32x2*)(XN + ro + bj * HALF + n * 16) = w; ss += (r.x * r.x + r.y * r.y) + (r.z * r.z + r.w * r.w); } }
                if (XN) { ss += __shfl_xor(ss, 16); ss += __shfl_xor(ss, 32); if (fq == 0) atomicAdd(SS + row, ss); } }
    }
};
struct EpiBf16 {
    static constexpr bool PERM = true;
    bf16_t* O; int ldc; const float* SS;
    __device__ __forceinline__ void operator()(const f32x4 (&acc)[2][2][4][2], const Unit& u, int wr, int wc, int fr, int fq) const {
        const int row0 = u.pm * BM + wr * 64 + fr, col0 = u.pn * BM + wc * 32 + 8 * fq;
#pragma unroll
        for (int ai = 0; ai < 2; ++ai)
#pragma unroll
            for (int m = 0; m < 4; ++m) { bf16_t* rowp = O + (size_t)(row0 + ai * HALF + m * 16) * ldc + col0;
                const float rs = 1.0f / sqrtf(SS[row0 + ai * HALF + m * 16] * (1.0f / D) + 1e-6f);
#pragma unroll
                for (int bj = 0; bj < 2; ++bj) { const f32x4 v0 = acc[ai][bj][m][0] * rs, v1 = acc[ai][bj][m][1] * rs;
                    u32x4 w; w.x = pk2(v0[0], v0[1]); w.y = pk2(v0[2], v0[3]); w.z = pk2(v1[0], v1[1]); w.w = pk2(v1[2], v1[3]);
                    *(u32x4*)(rowp + bj * HALF) = w; } }
    }
};
struct EpiLR {
    static constexpr bool PERM = true;
    bf16_t* O; const float* w0; const float* a0;
    template <int KIND> __device__ __forceinline__ void body(const f32x4 (&acc)[2][2][4][2], const float* bp, int row0, int col0) const {
#pragma unroll
        for (int bj = 0; bj < 2; ++bj) {
            f32x4 b0 = (f32x4){0.f, 0.f, 0.f, 0.f}, b1 = b0;
            if (KIND < 2) { b0 = *(const f32x4*)(bp + bj * HALF); b1 = *(const f32x4*)(bp + bj * HALF + 4); }
#pragma unroll
            for (int ai = 0; ai < 2; ++ai)
#pragma unroll
                for (int m = 0; m < 4; ++m) {
                    u32x4 w;
#pragma unroll
                    for (int n = 0; n < 2; ++n) {
                        float r[4];
#pragma unroll
                        for (int j = 0; j < 4; ++j) { const float x = acc[ai][bj][m][n][j] + (n == 0 ? b0[j] : b1[j]);
                            if (KIND == 0) { const float e = __expf(-x); r[j] = -0.60653065971f / (1.0f + e); }
                            else if (KIND == 1) r[j] = 1.0f / (1.0f + __expf(-x)); else r[j] = x; }
                        if (n == 0) { w.x = pk2(r[0], r[1]); w.y = pk2(r[2], r[3]); } else { w.z = pk2(r[0], r[1]); w.w = pk2(r[2], r[3]); }
                    }
                    *(u32x4*)(O + (size_t)(row0 + ai * HALF + m * 16) * 1536 + col0 + bj * HALF) = w;
                }
        }
    }
    __device__ __forceinline__ void operator()(const f32x4 (&acc)[2][2][4][2], const Unit& u, int wr, int wc, int fr, int fq) const {
        const int row0 = u.pm * BM + wr * 64 + fr, col0 = u.pn * BM + wc * 32 + 8 * fq, kind = u.pn >> 1, f0 = col0 - 512 * kind;
        if (kind == 0) body<0>(acc, w0 + f0, row0, col0); else if (kind == 1) body<1>(acc, a0 + f0, row0, col0); else body<2>(acc, nullptr, row0, col0);
    }
};
struct EpiGLU {
    static constexpr bool PERM = true;
    const bf16_t* Z; bf16_t* Y; const float* b;
    __device__ __forceinline__ void operator()(const f32x4 (&acc)[2][2][4][2], const Unit& u, int wr, int wc, int fr, int fq) const {
        const int row0 = u.pm * BM + wr * 64 + fr, col0 = u.pn * BM + wc * 32 + 8 * fq;
#pragma unroll
        for (int bj = 0; bj < 2; ++bj) {
            const f32x4 bias0 = *(const f32x4*)(b + col0 + bj * HALF), bias1 = *(const f32x4*)(b + col0 + bj * HALF + 4);
#pragma unroll
            for (int ai = 0; ai < 2; ++ai)
#pragma unroll
                for (int m = 0; m < 4; ++m) { const size_t r = (size_t)(row0 + ai * HALF + m * 16);
                    float z[8], v[8]; unpack8(*(const u32x4*)(Z + r * 512 + col0 + bj * HALF), z);
#pragma unroll
                    for (int n = 0; n < 2; ++n)
#pragma unroll
                        for (int j = 0; j < 4; ++j) v[4 * n + j] = z[4 * n + j] * sigmoidf_(acc[ai][bj][m][n][j] + (n == 0 ? bias0[j] : bias1[j]));
                    *(u32x4*)(Y + r * D + 1024 + col0 + bj * HALF) = pack8(v); }
        }
    }
};
}

template <class Epi> __device__ __forceinline__ void run_gemm(LAS unsigned char* lds, const bf16_t* A, const bf16_t* Bt, int N, int K, const Epi E) {
    pg8::Gemm g; g.A = A; g.Bt = Bt; g.M = T; g.N = N; g.K = K;
    pg8::StaticOrder S; S.init(T, N, gridDim.x, opaque_bid());
    pg8::gemm_phase<Epi>(lds, g, S, E);
}

__device__ __forceinline__ void tr_item(const float* W, int ldw, int k0, int n0, const float* gs, bf16_t* Dst, int ldd, int drow0, int dk0, LAS float* scr, int lane) {
    if (W) {
#pragma unroll 8
        for (int i = 0; i < 32; ++i) { const int kk = 2 * i + (lane >> 5); float v = W[(size_t)(k0 + kk) * ldw + n0 + (lane & 31)]; if (gs) v *= gs[k0 + kk]; scr[kk * 33 + (lane & 31)] = v; }
    } else {
#pragma unroll 8
        for (int i = 0; i < 32; ++i) { const int kk = 2 * i + (lane >> 5); scr[kk * 33 + (lane & 31)] = 0.f; }
    }
    LDS_FENCE();
    const int c = lane & 7;
#pragma unroll
    for (int j = 0; j < 4; ++j) { const int n = (lane >> 3) + 8 * j; const LAS float* s = scr + (8 * c) * 33 + n;
        u32x4 o; o.x = pk2(s[0 * 33], s[1 * 33]); o.y = pk2(s[2 * 33], s[3 * 33]); o.z = pk2(s[4 * 33], s[5 * 33]); o.w = pk2(s[6 * 33], s[7 * 33]);
        *(u32x4*)(Dst + (size_t)(drow0 + n) * ldd + dk0 + k0 - 0 + 8 * c - 0) = o; }
    LDS_FENCE();
}

__device__ __forceinline__ void conv_phase(ArgsRef a, int l, LAS unsigned char* lds) {
    const int TID = opaque_tid(), BID = opaque_bid(); (void)TID; (void)BID;
    const int wave = TID >> 6, lane = TID & 63;
    LAS float* scr = (LAS float*)(lds + wave * 8704);
    const int gw = BID * NWAVES + wave, NGW = gridDim.x * NWAVES;
    unsigned char* ws = a.ws;
    constexpr int I_GU = (D / 64) * (FF / 32), I_DN = (FF / 64) * (D / 32), I_IN = (D / 64) * (DIN / 32), I_OUT = (D / 64) * (D / 32), I_GLU = 8 * 16, I_LR = 48 * 4;
    constexpr int NITEMS = 6 * I_GU + I_IN + I_OUT + I_GLU + I_LR;
    static_assert(I_GU == I_DN, "items");
    for (int it = gw; it < NITEMS; it += NGW) {
        int r = it;
        if (r < 6 * I_GU) {
            const int which = r / I_GU; r -= which * I_GU;
            const int f = which >= 3, m = which % 3;
            if (m < 2) {
                const float* W = (const float*)a.in[(f ? 36 : 3) + m] + (size_t)l * D * FF;
                const float* gs = (const float*)a.in[f ? 35 : 2] + (size_t)l * D;
                bf16_t* dst = (bf16_t*)(ws + (f ? W_UP2 : W_UP1));
                const int nblk = FF / 32, kb = r / nblk, nb = r % nblk, n0 = 32 * nb;
                tr_item(W, FF, 64 * kb, n0, gs, dst, D, (n0 >> 7) * 256 + (n0 & 127) + 128 * m, 0, scr, lane);
            } else {
                const float* W = (const float*)a.in[f ? 38 : 5] + (size_t)l * FF * D;
                bf16_t* dst = (bf16_t*)(ws + (f ? W_DN2 : W_DN1));
                const int nblk = D / 32, kb = r / nblk, nb = r % nblk;
                tr_item(W, D, 64 * kb, 32 * nb, nullptr, dst, FF, 32 * nb, 0, scr, lane);
            }
            continue;
        }
        r -= 6 * I_GU;
        if (r < I_IN) { const int nblk = DIN / 32, kb = r / nblk, nb = r % nblk;
            tr_item((const float*)a.in[7] + (size_t)l * D * DIN, DIN, 64 * kb, 32 * nb, (const float*)a.in[6] + (size_t)l * D, (bf16_t*)(ws + W_IN), D, 32 * nb, 0, scr, lane); continue; }
        r -= I_IN;
        if (r < I_OUT) { const int nblk = D / 32, kb = r / nblk, nb = r % nblk;
            tr_item((const float*)a.in[34] + (size_t)l * D * D, D, 64 * kb, 32 * nb, nullptr, (bf16_t*)(ws + W_OUT), D, 32 * nb, 0, scr, lane); continue; }
        r -= I_OUT;
        if (r < I_GLU) { const int kb = r / 16, nb = r % 16;
            tr_item((const float*)a.in[30] + (size_t)l * 512 * 512, 512, 64 * kb, 32 * nb, nullptr, (bf16_t*)(ws + W_GLU), 512, 32 * nb, 0, scr, lane); continue; }
        r -= I_GLU;
        {
            const int nb = r >> 2, kb = r & 3, kind = nb >> 4, nn0 = 32 * (nb & 15);
            const float* W = nullptr; int k0 = 0;
            if (kind == 0 && kb == 0) { W = (const float*)a.in[10] + (size_t)l * 64 * 512; k0 = 0; }
            else if (kind == 1 && kb == 1) { W = (const float*)a.in[12] + (size_t)l * 64 * 512; k0 = 0; }
            else if (kind == 2 && kb >= 2) { W = (const float*)a.in[13] + (size_t)l * 128 * 512; k0 = 64 * (kb - 2); }
            tr_item(W, 512, k0, nn0, nullptr, (bf16_t*)(ws + W_LR), 256, 32 * nb, 64 * kb - k0, scr, lane);
        }
    }
}

__device__ __forceinline__ void norm_phase(const float* x, bf16_t* XN, float* SS) {
    const int TID = opaque_tid(), BID = opaque_bid(); (void)TID; (void)BID;
    const int wave = TID >> 6, lane = TID & 63;
    const int gw = BID * NWAVES + wave, NGW = gridDim.x * NWAVES;
    for (int m = gw; m < T; m += NGW) {
        const f32x4* xr = (const f32x4*)(x + (size_t)m * D) + lane;
        f32x4 v[8]; float s = 0.f;
#pragma unroll
        for (int j = 0; j < 8; ++j) { v[j] = xr[64 * j]; s += (v[j].x * v[j].x + v[j].y * v[j].y) + (v[j].z * v[j].z + v[j].w * v[j].w); }
        s = wave_sum(s); if (lane == 0) SS[m] = s;
        u32x2* o = (u32x2*)(XN + (size_t)m * D) + lane;
#pragma unroll
        for (int j = 0; j < 8; ++j) { u32x2 w; w.x = pk2(v[j].x, v[j].y); w.y = pk2(v[j].z, v[j].w); o[64 * j] = w; }
    }
}

__device__ __forceinline__ void zero_phase(float* p, int n) {
    const int TID = opaque_tid(), BID = opaque_bid();
    for (int i = BID * NTHREADS + TID; i < n; i += gridDim.x * NTHREADS) p[i] = 0.f;
}
__device__ __forceinline__ void alr_phase(ArgsRef a, int l) {
    const int TID = opaque_tid(), BID = opaque_bid(); (void)TID; (void)BID;
    const bf16_t* P = (const bf16_t*)(a.ws + WS_PROJ); bf16_t* ALR = (bf16_t*)(a.ws + WS_ALR);
    const float* mu = (const float*)a.in[8] + (size_t)l * 1792 + 1536;
    const int gt = BID * NTHREADS + TID, NGT = gridDim.x * NTHREADS;
    for (int it = gt; it < T * 32; it += NGT) {
        const int t = it >> 5, cg = it & 31, c0 = 8 * cg;
        float cur[8], prv[8], o[8];
        unpack8(*(const u32x4*)(P + (size_t)t * DIN + 1536 + c0), cur);
        if ((t & (SEQ - 1)) != 0) unpack8(*(const u32x4*)(P + (size_t)(t - 1) * DIN + 1536 + c0), prv);
        else {
#pragma unroll
            for (int j = 0; j < 8; ++j) prv[j] = 0.f; }
#pragma unroll
        for (int j = 0; j < 8; ++j) { const float v = cur[j] + (prv[j] - cur[j]) * mu[c0 + j];
            o[j] = c0 < 64 ? tanhf(v) : (c0 < 128 ? v : sigmoidf_(v)); }
        *(u32x4*)(ALR + (size_t)t * 256 + c0) = pack8(o);
    }
}

__device__ __forceinline__ void rwkv_phase(ArgsRef a, int l, LAS unsigned char* lds) {
    const int TID = opaque_tid(), BID = opaque_bid(); (void)TID; (void)BID;
    const bf16_t* P = (const bf16_t*)(a.ws + WS_PROJ); const bf16_t* LR = (const bf16_t*)(a.ws + WS_LRO);
    float* OR = (float*)(a.ws + WS_OR); float* BON = (float*)(a.ws + WS_BON);
    LAS float* sR = (LAS float*)lds; LAS float* sW = sR + 4096; LAS float* sK = sW + 4096; LAS float* sKK = sK + 4096; LAS float* sB = sKK + 4096;
    LAS float* sV = sB + 4096; LAS float* sO = sV + 2048;
    const int tid = TID, wave = tid >> 6, lane = tid & 63;
    const int tt = tid >> 3, cg = tid & 7;
    for (int job = BID; job < 256; job += gridDim.x) {
        const int b = job >> 4, h = (job >> 1) & 7, half = job & 1;
        const int c0 = 64 * h + 8 * cg;
        float mur[8], muk[8], muv[8], kkw[8], kaw[8], rkw[8];
#pragma unroll
        for (int j = 0; j < 8; ++j) {
            mur[j] = ((const float*)a.in[8])[(size_t)l * 1792 + c0 + j]; muk[j] = ((const float*)a.in[8])[(size_t)l * 1792 + 512 + c0 + j]; muv[j] = ((const float*)a.in[8])[(size_t)l * 1792 + 1024 + c0 + j];
            kkw[j] = ((const float*)a.in[14])[(size_t)l * 512 + c0 + j]; kaw[j] = ((const float*)a.in[15])[(size_t)l * 512 + c0 + j]; rkw[j] = ((const float*)a.in[16])[(size_t)l * 512 + c0 + j]; }
        f32x2 stA = (f32x2){0.f, 0.f}, stB = stA;
        const int rloc = 4 * wave + (lane >> 4), jq = lane & 15;
        for (int ch = 0; ch < SEQ / 64; ++ch) {
            __syncthreads();
            {
                const int s = ch * 64 + tt; const size_t t = (size_t)b * SEQ + s;
                float r[8], k[8], v[8], pr[8], ld[8], av[8];
                unpack8(*(const u32x4*)(P + t * DIN + c0), r); unpack8(*(const u32x4*)(P + t * DIN + 512 + c0), k); unpack8(*(const u32x4*)(P + t * DIN + 1024 + c0), v);
                if (s != 0) {
                    unpack8(*(const u32x4*)(P + (t - 1) * DIN + c0), pr);
#pragma unroll
                    for (int j = 0; j < 8; ++j) r[j] += (pr[j] - r[j]) * mur[j];
                    unpack8(*(const u32x4*)(P + (t - 1) * DIN + 512 + c0), pr);
#pragma unroll
                    for (int j = 0; j < 8; ++j) k[j] += (pr[j] - k[j]) * muk[j];
                    unpack8(*(const u32x4*)(P + (t - 1) * DIN + 1024 + c0), pr);
#pragma unroll
                    for (int j = 0; j < 8; ++j) v[j] += (pr[j] - v[j]) * muv[j];
                } else {
#pragma unroll
                    for (int j = 0; j < 8; ++j) { r[j] -= r[j] * mur[j]; k[j] -= k[j] * muk[j]; v[j] -= v[j] * muv[j]; }
                }
                unpack8(*(const u32x4*)(LR + t * 1536 + c0), ld); unpack8(*(const u32x4*)(LR + t * 1536 + 512 + c0), av);
                float kk[8], ss = 0.f, bp = 0.f;
#pragma unroll
                for (int j = 0; j < 8; ++j) { kk[j] = k[j] * kkw[j]; ss += kk[j] * kk[j]; }
                ss = red8(ss);
                const float inv = 1.0f / sqrtf(fmaxf(ss, 1e-24f));
                float w8[8], k8[8], b8[8];
#pragma unroll
                for (int j = 0; j < 8; ++j) { kk[j] *= inv; k8[j] = k[j] * (1.0f + (av[j] - 1.0f) * kaw[j]); b8[j] = kk[j] * av[j]; w8[j] = __expf(ld[j]); bp += r[j] * k8[j] * rkw[j]; }
                bp = red8(bp);
                if (half == 0 && cg == 0) BON[t * 8 + h] = bp;
                LAS float* d;
                d = sR + tt * 64 + 8 * cg; *(LAS f32x4*)d = (f32x4){r[0], r[1], r[2], r[3]}; *(LAS f32x4*)(d + 4) = (f32x4){r[4], r[5], r[6], r[7]};
                d = sW + tt * 64 + 8 * cg; *(LAS f32x4*)d = (f32x4){w8[0], w8[1], w8[2], w8[3]}; *(LAS f32x4*)(d + 4) = (f32x4){w8[4], w8[5], w8[6], w8[7]};
                d = sK + tt * 64 + 8 * cg; *(LAS f32x4*)d = (f32x4){k8[0], k8[1], k8[2], k8[3]}; *(LAS f32x4*)(d + 4) = (f32x4){k8[4], k8[5], k8[6], k8[7]};
                d = sKK + tt * 64 + 8 * cg; *(LAS f32x4*)d = (f32x4){kk[0], kk[1], kk[2], kk[3]}; *(LAS f32x4*)(d + 4) = (f32x4){kk[4], kk[5], kk[6], kk[7]};
                d = sB + tt * 64 + 8 * cg; *(LAS f32x4*)d = (f32x4){b8[0], b8[1], b8[2], b8[3]}; *(LAS f32x4*)(d + 4) = (f32x4){b8[4], b8[5], b8[6], b8[7]};
                if ((cg >> 2) == half) { d = sV + tt * 32 + 8 * (cg & 3); *(LAS f32x4*)d = (f32x4){v[0], v[1], v[2], v[3]}; *(LAS f32x4*)(d + 4) = (f32x4){v[4], v[5], v[6], v[7]}; }
            }
            __syncthreads();
            {
                f32x4 w4 = *(const LAS f32x4*)(sW + 4 * jq), kk4 = *(const LAS f32x4*)(sKK + 4 * jq), b4 = *(const LAS f32x4*)(sB + 4 * jq),
                      k4 = *(const LAS f32x4*)(sK + 4 * jq), r4 = *(const LAS f32x4*)(sR + 4 * jq);
                float vi = sV[rloc];
                f32x2 pyp = (f32x2){0.f, 0.f}; float ykeep = 0.f;
#pragma unroll 1
                for (int s16 = 0; s16 < 64; s16 += 16) {
#pragma unroll
                    for (int u = 0; u < 16; ++u) {
                        const int sn = (s16 + u + 1) & 63;
                        const f32x4 nw4 = *(const LAS f32x4*)(sW + sn * 64 + 4 * jq), nkk4 = *(const LAS f32x4*)(sKK + sn * 64 + 4 * jq), nb4 = *(const LAS f32x4*)(sB + sn * 64 + 4 * jq),
                                    nk4 = *(const LAS f32x4*)(sK + sn * 64 + 4 * jq), nr4 = *(const LAS f32x4*)(sR + sn * 64 + 4 * jq);
                        const float nvi = sV[sn * 32 + rloc];
                        const f32x2 pa = pfma(stB, (f32x2){kk4.z, kk4.w}, stA * (f32x2){kk4.x, kk4.y});
                        float av = pa.x + pa.y, yv = pyp.x + pyp.y;
                        av += dpp<XOR1>(av); yv += dpp<XOR1>(yv); av += dpp<XOR2>(av); yv += dpp<XOR2>(yv);
                        av += dpp<XOR7>(av); yv += dpp<XOR7>(yv); av += dpp<XOR8>(av); yv += dpp<XOR8>(yv);
                        if (u > 0) ykeep = (jq == u - 1) ? yv : ykeep;
                        else if (s16 > 0) { ykeep = (jq == 15) ? yv : ykeep; sO[(s16 - 16 + jq) * 32 + rloc] = ykeep; }
                        const float sa = -av;
                        const f32x2 sa2 = (f32x2){sa, sa}, vi2 = (f32x2){vi, vi};
                        const f32x2 tA = pfma(vi2, (f32x2){k4.x, k4.y}, sa2 * (f32x2){b4.x, b4.y}), tB = pfma(vi2, (f32x2){k4.z, k4.w}, sa2 * (f32x2){b4.z, b4.w});
                        stA = pfma(stA, (f32x2){w4.x, w4.y}, tA); stB = pfma(stB, (f32x2){w4.z, w4.w}, tB);
                        pyp = pfma(stB, (f32x2){r4.z, r4.w}, stA * (f32x2){r4.x, r4.y});
                        w4 = nw4; kk4 = nkk4; b4 = nb4; k4 = nk4; r4 = nr4; vi = nvi;
                    }
                }
                float yv = red16(pyp.x + pyp.y);
                ykeep = (jq == 15) ? yv : ykeep; sO[(48 + jq) * 32 + rloc] = ykeep;
            }
            __syncthreads();
            {
                const int s = ch * 64 + tt; const size_t t = (size_t)b * SEQ + s;
                *(f32x4*)(OR + t * 512 + 64 * h + 32 * half + 4 * cg) = *(const LAS f32x4*)(sO + tt * 32 + 4 * cg);
            }
        }
    }
    __syncthreads();
}

__device__ __forceinline__ void hgrn_phase(ArgsRef a, int l, LAS unsigned char* lds) {
    const int TID = opaque_tid(), BID = opaque_bid(); (void)TID; (void)BID;
    const bf16_t* P = (const bf16_t*)(a.ws + WS_PROJ); float* OH = (float*)(a.ws + WS_OH);
    LAS float* sQ = (LAS float*)lds; LAS float* sF = sQ + 4096; LAS float* sV = sF + 4096; LAS float* sO = sV + 2048;
    const int tid = TID, wave = tid >> 6, lane = tid & 63;
    const int tt = tid >> 3, cg = tid & 7;
    const float* lbp = (const float*)a.in[32];
    for (int job = BID; job < 256; job += gridDim.x) {
        const int b = job >> 4, h = (job >> 1) & 7, half = job & 1;
        const int c0 = 64 * h + 8 * cg;
        float lb[8];
#pragma unroll
        for (int j = 0; j < 8; ++j) lb[j] = (l == 0) ? 0.f : sigmoidf_(lbp[512 + c0 + j] - lbp[c0 + j]);
        f32x2 stA = (f32x2){0.f, 0.f}, stB = stA;
        const int cloc = 4 * wave + (lane >> 4), dq = lane & 15;
        for (int ch = 0; ch < SEQ / 64; ++ch) {
            __syncthreads();
            {
                const int s = ch * 64 + tt; const size_t t = (size_t)b * SEQ + s;
                float q[8], f[8];
                unpack8(*(const u32x4*)(P + t * DIN + C_HG + c0), q); unpack8(*(const u32x4*)(P + t * DIN + C_HG + 512 + c0), f);
#pragma unroll
                for (int j = 0; j < 8; ++j) { q[j] = siluf_(q[j]) * 0.125f; f[j] = lb[j] + (1.0f - lb[j]) * sigmoidf_(f[j]); }
                LAS float* d;
                d = sQ + tt * 64 + 8 * cg; *(LAS f32x4*)d = (f32x4){q[0], q[1], q[2], q[3]}; *(LAS f32x4*)(d + 4) = (f32x4){q[4], q[5], q[6], q[7]};
                d = sF + tt * 64 + 8 * cg; *(LAS f32x4*)d = (f32x4){f[0], f[1], f[2], f[3]}; *(LAS f32x4*)(d + 4) = (f32x4){f[4], f[5], f[6], f[7]};
                const u32x2 vv = *(const u32x2*)(P + t * DIN + C_HG + 1024 + 64 * h + 32 * half + 4 * cg);
                *(LAS f32x4*)(sV + tt * 32 + 4 * cg) = (f32x4){bflo(vv.x), bfhi(vv.x), bflo(vv.y), bfhi(vv.y)};
            }
            __syncthreads();
            {
                f32x4 f4 = *(const LAS f32x4*)(sF + 4 * dq), q4 = *(const LAS f32x4*)(sQ + 4 * dq);
                float vi = sV[cloc];
                float ykeep = 0.f;
#pragma unroll 1
                for (int s16 = 0; s16 < 64; s16 += 16) {
#pragma unroll
                    for (int u = 0; u < 16; ++u) {
                        const int sn = (s16 + u + 1) & 63;
                        const f32x4 nf4 = *(const LAS f32x4*)(sF + sn * 64 + 4 * dq), nq4 = *(const LAS f32x4*)(sQ + sn * 64 + 4 * dq);
                        const float nvi = sV[sn * 32 + cloc];
                        const f32x2 vi2 = (f32x2){vi, vi};
                        stA = pfma((f32x2){f4.x, f4.y}, stA - vi2, vi2); stB = pfma((f32x2){f4.z, f4.w}, stB - vi2, vi2);
                        const f32x2 py = pfma(stB, (f32x2){q4.z, q4.w}, stA * (f32x2){q4.x, q4.y});
                        const float y = red16(py.x + py.y);
                        ykeep = (dq == u) ? y : ykeep;
                        f4 = nf4; q4 = nq4; vi = nvi;
                    }
                    sO[(s16 + dq) * 32 + cloc] = ykeep;
                }
            }
            __syncthreads();
            {
                const int s = ch * 64 + tt; const size_t t = (size_t)b * SEQ + s;
                *(f32x4*)(OH + t * 512 + 64 * h + 32 * half + 4 * cg) = *(const LAS f32x4*)(sO + tt * 32 + 4 * cg);
            }
        }
    }
    __syncthreads();
}

__device__ __forceinline__ void post_phase(ArgsRef a, int l) {
    const int TID = opaque_tid(), BID = opaque_bid(); (void)TID; (void)BID;
    const bf16_t* P = (const bf16_t*)(a.ws + WS_PROJ); const bf16_t* LR = (const bf16_t*)(a.ws + WS_LRO);
    const float* OR = (const float*)(a.ws + WS_OR); const float* OH = (const float*)(a.ws + WS_OH); const float* BON = (const float*)(a.ws + WS_BON);
    bf16_t* Y = (bf16_t*)(a.ws + WS_YC);
    const float* muv = (const float*)a.in[8] + (size_t)l * 1792 + 1024;
    const float* lnw = (const float*)a.in[17] + (size_t)l * 512; const float* lnb = (const float*)a.in[18] + (size_t)l * 512;
    const float* gn = (const float*)a.in[33] + (size_t)l * 64;
    const int gt = BID * NTHREADS + TID, NGT = gridDim.x * NTHREADS;
    for (int it = gt; it < T * 128; it += NGT) {
        const int cg = it & 7, hh = (it >> 3) & 15; const size_t t = (size_t)(it >> 7);
        float o[8], y[8];
        if (hh < 8) {
            const int c0 = 64 * hh + 8 * cg;
            const f32x4 o0 = *(const f32x4*)(OR + t * 512 + c0), o1 = *(const f32x4*)(OR + t * 512 + c0 + 4);
            o[0] = o0.x; o[1] = o0.y; o[2] = o0.z; o[3] = o0.w; o[4] = o1.x; o[5] = o1.y; o[6] = o1.z; o[7] = o1.w;
            float s = 0.f;
#pragma unroll
            for (int j = 0; j < 8; ++j) s += o[j];
            const float mean = red8(s) * (1.0f / 64.0f);
            float q = 0.f;
#pragma unroll
            for (int j = 0; j < 8; ++j) { o[j] -= mean; q += o[j] * o[j]; }
            const float rstd = 1.0f / sqrtf(red8(q) * (1.0f / 64.0f) + 64e-5f);
            float v[8], pv[8], g[8];
            unpack8(*(const u32x4*)(P + t * DIN + 1024 + c0), v);
            if ((t & (SEQ - 1)) != 0) unpack8(*(const u32x4*)(P + (t - 1) * DIN + 1024 + c0), pv);
            else {
#pragma unroll
                for (int j = 0; j < 8; ++j) pv[j] = 0.f; }
            unpack8(*(const u32x4*)(LR + t * 1536 + 1024 + c0), g);
            const float bon = BON[t * 8 + hh];
#pragma unroll
            for (int j = 0; j < 8; ++j) { const float vl = v[j] + (pv[j] - v[j]) * muv[c0 + j];
                y[j] = (o[j] * rstd * lnw[c0 + j] + lnb[c0 + j] + bon * vl) * g[j]; }
            *(u32x4*)(Y + t * D + c0) = pack8(y);
        } else {
            const int h = hh - 8, c0 = 64 * h + 8 * cg;
            const f32x4 o0 = *(const f32x4*)(OH + t * 512 + c0), o1 = *(const f32x4*)(OH + t * 512 + c0 + 4);
            o[0] = o0.x; o[1] = o0.y; o[2] = o0.z; o[3] = o0.w; o[4] = o1.x; o[5] = o1.y; o[6] = o1.z; o[7] = o1.w;
            float q = 0.f;
#pragma unroll
            for (int j = 0; j < 8; ++j) q += o[j] * o[j];
            const float rs = 1.0f / sqrtf(red8(q) * (1.0f / 64.0f) + 1e-6f);
            float g[8];
            unpack8(*(const u32x4*)(P + t * DIN + C_HG + 1536 + c0), g);
#pragma unroll
            for (int j = 0; j < 8; ++j) y[j] = o[j] * rs * gn[8 * cg + j] * siluf_(g[j]);
            *(u32x4*)(Y + t * D + 1536 + c0) = pack8(y);
        }
    }
}

__device__ __forceinline__ void attn_phase(ArgsRef a, int l, LAS unsigned char* lds) {
    const int TID = opaque_tid(), BID = opaque_bid();
    const bf16_t* P = (const bf16_t*)(a.ws + WS_PROJ); bf16_t* Y = (bf16_t*)(a.ws + WS_YC);
    const int* pos = (const int*)a.in[1];
    const float* qn = (const float*)a.in[19] + (size_t)l * 64; const float* kn = (const float*)a.in[20] + (size_t)l * 64; const float* sinks = (const float*)a.in[21] + (size_t)l * 8;
    constexpr int KST = 144, VST = 528;
    LAS unsigned char* sK = lds; LAS unsigned char* sVt = sK + 256 * KST; LAS unsigned char* sQ = sVt + 64 * VST; LAS float* sM = (LAS float*)(sQ + 512 * KST);
    const int tid = TID, cg = tid & 7, wave = tid >> 6, lane = tid & 63;
    float kmaxg = 0.f;
    for (int j = 0; j < 64; ++j) kmaxg = fmaxf(kmaxg, fabsf(kn[j]));
    const float kbound = 8.0f * kmaxg;
    float gk[8], gq[8], invf[8];
#pragma unroll
    for (int j = 0; j < 8; ++j) { gk[j] = kn[8 * cg + j]; gq[j] = qn[8 * cg + j]; invf[j] = exp2f(-(float)j * (18.931568569324174f / 8.0f)); }
    for (int job = BID; job < 512; job += gridDim.x) {
        const int b = job >> 5, nb = (job >> 1) & 15, kvh = job & 1;
        __syncthreads();
#pragma unroll 1
        for (int r = 0; r < 4; ++r) {
            const int kj = (tid >> 3) + 64 * r, s = (nb - 1) * 128 + kj;
            float k[8], v[8];
            if (s >= 0) {
                const size_t t = (size_t)b * SEQ + s;
                unpack8(*(const u32x4*)(P + t * DIN + C_ATT + 512 + 64 * kvh + 8 * cg), k); unpack8(*(const u32x4*)(P + t * DIN + C_ATT + 640 + 64 * kvh + 8 * cg), v);
            } else {
#pragma unroll
                for (int j = 0; j < 8; ++j) { k[j] = 0.f; v[j] = 0.f; } }
            float ss = 0.f;
#pragma unroll
            for (int j = 0; j < 8; ++j) ss += k[j] * k[j];
            ss = red8(ss);
            const float rs = 1.0f / sqrtf(ss * (1.0f / 64.0f) + 1e-6f);
#pragma unroll
            for (int j = 0; j < 8; ++j) k[j] = k[j] * rs * gk[j];
            const float pf = (float)pos[b * SEQ + (s >= 0 ? s : 0)];
#pragma unroll
            for (int j = 0; j < 8; ++j) {
                const float other = dpp<XOR1>(k[j]);
                if (cg < 2) { float sn, cs; sincos_big(pf * invf[j], sn, cs); k[j] = (cg == 0) ? (k[j] * cs - other * sn) : (k[j] * cs + other * sn); }
            }
            *(LAS u32x4*)(sK + kj * KST + 16 * cg) = pack8(k);
#pragma unroll
            for (int j = 0; j < 8; j += 2) { const unsigned w = pk2(v[j], v[j + 1]);
                *(LAS unsigned short*)(sVt + (8 * cg + j) * VST + 2 * kj) = (unsigned short)(w & 0xffffu); *(LAS unsigned short*)(sVt + (8 * cg + j + 1) * VST + 2 * kj) = (unsigned short)(w >> 16); }
        }
#pragma unroll 1
        for (int r = 0; r < 8; ++r) {
            const int row = (tid >> 3) + 64 * r, g = row >> 7, qi = row & 127, hq = 4 * kvh + g;
            const size_t tq = (size_t)b * SEQ + nb * 128 + qi;
            float q[8];
            unpack8(*(const u32x4*)(P + tq * DIN + C_ATT + 64 * hq + 8 * cg), q);
            float ss = 0.f;
#pragma unroll
            for (int j = 0; j < 8; ++j) ss += q[j] * q[j];
            ss = red8(ss);
            const float rs = 0.125f / sqrtf(ss * (1.0f / 64.0f) + 1e-6f);
#pragma unroll
            for (int j = 0; j < 8; ++j) q[j] = q[j] * rs * gq[j];
            const float pf = (float)pos[b * SEQ + nb * 128 + qi];
            float qq = 0.f;
#pragma unroll
            for (int j = 0; j < 8; ++j) {
                const float other = dpp<XOR1>(q[j]);
                if (cg < 2) { float sn, cs; sincos_big(pf * invf[j], sn, cs); q[j] = (cg == 0) ? (q[j] * cs - other * sn) : (q[j] * cs + other * sn); }
                qq += q[j] * q[j];
            }
            qq = red8(qq);
            if (cg == 0) sM[row] = sqrtf(qq) * kbound;
            *(LAS u32x4*)(sQ + row * KST + 16 * cg) = pack8(q);
        }
        __syncthreads();
        const int g = wave >> 1, qh = wave & 1, hq = 4 * kvh + g, fr = lane & 15, fq = lane >> 4;
        const float sinkv = sinks[hq];
#pragma unroll 1
        for (int qt = 0; qt < 4; ++qt) {
            const int qi0 = 64 * qh + 16 * qt, R0 = g * 128 + qi0, kt0 = qi0 >> 4;
            const bf16x8 qf0 = *(const LAS bf16x8*)(sQ + (R0 + fr) * KST + 16 * fq), qf1 = *(const LAS bf16x8*)(sQ + (R0 + fr) * KST + 16 * fq + 64);
            const float msh = sM[R0 + fr];
            const int ql = qi0 + fr;
            f32x4 oacc[4];
#pragma unroll
            for (int dt = 0; dt < 4; ++dt) oacc[dt] = (f32x4){0.f, 0.f, 0.f, 0.f};
            float lsum = 0.f;
#pragma unroll
            for (int ks = 0; ks < 5; ++ks) {
                unsigned pw[4];
#pragma unroll
                for (int h2 = 0; h2 < 2; ++h2) {
                    const int ti = 2 * ks + h2, kt = (kt0 + ti) < 15 ? (kt0 + ti) : 15;
                    const bf16x8 kf0 = *(const LAS bf16x8*)(sK + (16 * kt + fr) * KST + 16 * fq), kf1 = *(const LAS bf16x8*)(sK + (16 * kt + fr) * KST + 16 * fq + 64);
                    f32x4 sc = (f32x4){0.f, 0.f, 0.f, 0.f};
                    sc = __builtin_amdgcn_mfma_f32_16x16x32_bf16(kf0, qf0, sc, 0, 0, 0);
                    sc = __builtin_amdgcn_mfma_f32_16x16x32_bf16(kf1, qf1, sc, 0, 0, 0);
                    float p[4];
#pragma unroll
                    for (int j = 0; j < 4; ++j) { const int kj = 16 * (kt0 + ti) + 4 * fq + j;
                        const bool valid = (kj > ql) && (kj <= ql + 128) && (nb > 0 || kj >= 128);
                        p[j] = valid ? __expf(sc[j] - msh) : 0.f; lsum += p[j]; }
                    pw[2 * h2] = pk2(p[0], p[1]); pw[2 * h2 + 1] = pk2(p[2], p[3]);
                }
                const u32x4 pq = (u32x4){pw[0], pw[1], pw[2], pw[3]};
                const bf16x8 pf = __builtin_bit_cast(bf16x8, pq);
                const int kta = (kt0 + 2 * ks) < 15 ? (kt0 + 2 * ks) : 15, ktb = (kt0 + 2 * ks + 1) < 15 ? (kt0 + 2 * ks + 1) : 15;
#pragma unroll
                for (int dt = 0; dt < 4; ++dt) {
                    const u32x2 va = *(const LAS u32x2*)(sVt + (16 * dt + fr) * VST + (16 * kta + 4 * fq) * 2), vb = *(const LAS u32x2*)(sVt + (16 * dt + fr) * VST + (16 * ktb + 4 * fq) * 2);
                    const u32x4 vq = (u32x4){va.x, va.y, vb.x, vb.y};
                    oacc[dt] = __builtin_amdgcn_mfma_f32_16x16x32_bf16(__builtin_bit_cast(bf16x8, vq), pf, oacc[dt], 0, 0, 0);
                }
            }
            lsum += __shfl_xor(lsum, 16); lsum += __shfl_xor(lsum, 32);
            const float inv = 1.0f / (lsum + __expf(sinkv - msh));
            const size_t tq = (size_t)b * SEQ + nb * 128 + ql;
#pragma unroll
            for (int dt = 0; dt < 4; ++dt) { u32x2 w; w.x = pk2(oacc[dt][0] * inv, oacc[dt][1] * inv); w.y = pk2(oacc[dt][2] * inv, oacc[dt][3] * inv);
                *(u32x2*)(Y + tq * D + 512 + 64 * hq + 16 * dt + 4 * fq) = w; }
        }
    }
    __syncthreads();
}

__device__ __forceinline__ void s5_phase(ArgsRef a, int l, LAS unsigned char* lds) {
    const int TID = opaque_tid(), BID = opaque_bid(); (void)TID; (void)BID;
    const bf16_t* P = (const bf16_t*)(a.ws + WS_PROJ); bf16_t* Z = (bf16_t*)(a.ws + WS_Z);
    const int tid = TID, wave = tid >> 6, lane = tid & 63;
    LAS float* sU = (LAS float*)lds + wave * 1024;
    LAS float* sX = (LAS float*)lds + 8192 + wave * (16 * 130);
    LAS float* sE = (LAS float*)lds + 8192 + 8 * 16 * 130;
    for (int job = BID; job < 512; job += gridDim.x) {
        const int b = job >> 5, g = job & 31;
        const float lre = ((const float*)a.in[22])[(size_t)l * 2048 + g * 64 + lane], lim = ((const float*)a.in[23])[(size_t)l * 2048 + g * 64 + lane];
        const float dt = expf(((const float*)a.in[24])[l * 32 + g]);
        float sn, cs; sincos_big(lim * dt, sn, cs);
        const float er = expf(lre * dt), lbr = er * cs, lbi = er * sn;
        const float den = 1.0f / (lre * lre + lim * lim);
        const float fr = ((lbr - 1.0f) * lre + lbi * lim) * den, fi = (lbi * lre - (lbr - 1.0f) * lim) * den;
        f32x2 bb[16];
        {
            const f32x4* br = (const f32x4*)((const float*)a.in[25] + ((size_t)l * 2048 + g * 64 + lane) * 16); const f32x4* bi = (const f32x4*)((const float*)a.in[26] + ((size_t)l * 2048 + g * 64 + lane) * 16);
#pragma unroll
            for (int q = 0; q < 4; ++q) { const f32x4 r4 = br[q], i4 = bi[q];
                bb[4 * q] = (f32x2){fr * r4.x - fi * i4.x, fr * i4.x + fi * r4.x}; bb[4 * q + 1] = (f32x2){fr * r4.y - fi * i4.y, fr * i4.y + fi * r4.y};
                bb[4 * q + 2] = (f32x2){fr * r4.z - fi * i4.z, fr * i4.z + fi * r4.z}; bb[4 * q + 3] = (f32x2){fr * r4.w - fi * i4.w, fr * i4.w + fi * r4.w}; }
        }
        float creg[32];
        {
            const float* cre = (const float*)a.in[27] + ((size_t)l * 32 + g) * 1024 + (lane & 15) * 64 + (lane >> 4);
            const float* cim = (const float*)a.in[28] + ((size_t)l * 32 + g) * 1024 + (lane & 15) * 64 + (lane >> 4);
#pragma unroll
            for (int kk = 0; kk < 16; ++kk) { creg[kk] = cre[4 * kk]; creg[16 + kk] = -cim[4 * kk]; }
        }
        f32x4 dsk;
        { const float* dp = (const float*)a.in[29] + (size_t)l * 512 + 16 * g + 4 * (lane >> 4); dsk = (f32x4){dp[0], dp[1], dp[2], dp[3]}; }
        const size_t tbase = (size_t)b * SEQ + wave * 256;
        f32x2 xs = (f32x2){0.f, 0.f}; const f32x2 lbr2 = (f32x2){lbr, lbr}, lbi2 = (f32x2){lbi, lbi};
        for (int c = 0; c < 4; ++c) {
            { const size_t t = tbase + c * 64 + lane; float u[16]; unpack8(*(const u32x4*)(P + t * DIN + C_S5 + 16 * g), u); unpack8(*(const u32x4*)(P + t * DIN + C_S5 + 16 * g + 8), u + 8);
              LAS f32x4* d = (LAS f32x4*)(sU + lane * 16); d[0] = (f32x4){u[0], u[1], u[2], u[3]}; d[1] = (f32x4){u[4], u[5], u[6], u[7]}; d[2] = (f32x4){u[8], u[9], u[10], u[11]}; d[3] = (f32x4){u[12], u[13], u[14], u[15]}; }
            LDS_FENCE();
#pragma unroll 2
            for (int s = 0; s < 64; ++s) {
                const LAS f32x4* up = (const LAS f32x4*)(sU + s * 16);
                f32x2 bu0 = (f32x2){0.f, 0.f}, bu1 = bu0;
#pragma unroll
                for (int q = 0; q < 4; ++q) { const f32x4 u4 = up[q];
                    bu0 = pfma(bb[4 * q], (f32x2){u4.x, u4.x}, bu0); bu1 = pfma(bb[4 * q + 1], (f32x2){u4.y, u4.y}, bu1);
                    bu0 = pfma(bb[4 * q + 2], (f32x2){u4.z, u4.z}, bu0); bu1 = pfma(bb[4 * q + 3], (f32x2){u4.w, u4.w}, bu1); }
                { const f32x2 nx = pfma(lbr2, xs, bu0 + bu1); xs = pfma(lbi2, (f32x2){-xs.y, xs.x}, nx); }
            }
            LDS_FENCE();
        }
        sE[wave * 128 + lane] = xs.x; sE[wave * 128 + 64 + lane] = xs.y;
        float pr = lbr, pi = lbi;
#pragma unroll
        for (int i = 0; i < 8; ++i) { const float nr = pr * pr - pi * pi, ni = 2.0f * pr * pi; pr = nr; pi = ni; }
        __syncthreads();
        xs = (f32x2){0.f, 0.f};
        for (int w = 0; w < wave; ++w) { const float er_ = sE[w * 128 + lane], ei_ = sE[w * 128 + 64 + lane];
            const float nr = pr * xs.x - pi * xs.y + er_, ni = pr * xs.y + pi * xs.x + ei_; xs.x = nr; xs.y = ni; }
        for (int c = 0; c < 4; ++c) {
            { const size_t t = tbase + c * 64 + lane; float u[16]; unpack8(*(const u32x4*)(P + t * DIN + C_S5 + 16 * g), u); unpack8(*(const u32x4*)(P + t * DIN + C_S5 + 16 * g + 8), u + 8);
              LAS f32x4* d = (LAS f32x4*)(sU + lane * 16); d[0] = (f32x4){u[0], u[1], u[2], u[3]}; d[1] = (f32x4){u[4], u[5], u[6], u[7]}; d[2] = (f32x4){u[8], u[9], u[10], u[11]}; d[3] = (f32x4){u[12], u[13], u[14], u[15]}; }
            LDS_FENCE();
#pragma unroll 1
            for (int s16 = 0; s16 < 4; ++s16) {
#pragma unroll 2
                for (int s = 0; s < 16; ++s) {
                    const LAS f32x4* up = (const LAS f32x4*)(sU + (s16 * 16 + s) * 16);
                    f32x2 bu0 = (f32x2){0.f, 0.f}, bu1 = bu0;
#pragma unroll
                    for (int q = 0; q < 4; ++q) { const f32x4 u4 = up[q];
                        bu0 = pfma(bb[4 * q], (f32x2){u4.x, u4.x}, bu0); bu1 = pfma(bb[4 * q + 1], (f32x2){u4.y, u4.y}, bu1);
                        bu0 = pfma(bb[4 * q + 2], (f32x2){u4.z, u4.z}, bu0); bu1 = pfma(bb[4 * q + 3], (f32x2){u4.w, u4.w}, bu1); }
                    { const f32x2 nx = pfma(lbr2, xs, bu0 + bu1); xs = pfma(lbi2, (f32x2){-xs.y, xs.x}, nx); }
                    sX[s * 130 + lane] = xs.x; sX[s * 130 + 64 + lane] = xs.y;
                }
                LDS_FENCE();
                f32x4 yacc = (f32x4){0.f, 0.f, 0.f, 0.f};
                const LAS float* xp = sX + (lane & 15) * 130 + (lane >> 4);
#pragma unroll
                for (int kk = 0; kk < 32; ++kk) yacc = __builtin_amdgcn_mfma_f32_16x16x4f32(creg[kk], xp[4 * kk], yacc, 0, 0, 0);
                const int tok = s16 * 16 + (lane & 15);
                const f32x4 u4 = *(const LAS f32x4*)(sU + tok * 16 + 4 * (lane >> 4));
                float z[4];
#pragma unroll
                for (int j = 0; j < 4; ++j) { const float y = yacc[j] + dsk[j] * u4[j]; z[j] = 0.5f * y * (1.0f + erff(y * 0.70710678118654752f)); }
                u32x2 w; w.x = pk2(z[0], z[1]); w.y = pk2(z[2], z[3]);
                *(u32x2*)(Z + (tbase + c * 64 + tok) * 512 + 16 * g + 4 * (lane >> 4)) = w;
                LDS_FENCE();
            }
        }
        __syncthreads();
    }
}

constexpr int NPH = 11;
#ifndef DUPMASK
#define DUPMASK 0
#endif
__global__ void __launch_bounds__(NTHREADS, 2) mega(Args a_, int lo, int hi) {
    extern __shared__ __attribute__((aligned(16))) unsigned char lds_raw[];
    LAS unsigned char* lds = (LAS unsigned char*)lds_raw;
#pragma unroll 1
    for (int step2 = 2 * lo; step2 < 2 * hi; ++step2) {
        const int step = step2 >> 1;
        if ((step2 & 1) && !((DUPMASK >> (step % NPH)) & 1)) continue;
        const __attribute__((address_space(4))) Args* ap = (const __attribute__((address_space(4))) Args*)__builtin_amdgcn_kernarg_segment_ptr();
        asm volatile("" : "+s"(ap));
        ArgsRef a = *ap;
        unsigned char* ws = a.ws;
        float* SSa = (float*)(ws + WS_SS); float* SSb = SSa + T; float* SSc = SSb + T;
        const int l = step / NPH, ph = step % NPH;
        const float* xin = (l == 0) ? (const float*)a.in[0] : (const float*)a.out;
#ifndef PHMASK
#define PHMASK 0x7ff
#endif
        switch (ph) {
        case 0: if (PHMASK & (1 << 0)) { conv_phase(a, l, lds); if (l == 0) norm_phase(xin, (bf16_t*)(ws + WS_XN), SSa); zero_phase(SSb, T); } break;
        case 1: if (PHMASK & (1 << 1)) { pg8::EpiSwiGLU E; E.H = (bf16_t*)(ws + WS_HID); E.SS = SSa; run_gemm(lds, (const bf16_t*)(ws + WS_XN), (const bf16_t*)(ws + W_UP1), 2 * FF, D, E); } break;
        case 2: if (PHMASK & (1 << 2)) { pg8::EpiResidual<true> E; E.base = xin; E.out = a.out; E.XN = (bf16_t*)(ws + WS_XN); E.SS = SSb; run_gemm(lds, (const bf16_t*)(ws + WS_HID), (const bf16_t*)(ws + W_DN1), D, FF, E); } break;
        case 3: if (PHMASK & (1 << 3)) { pg8::EpiBf16 E; E.O = (bf16_t*)(ws + WS_PROJ); E.ldc = DIN; E.SS = SSb; run_gemm(lds, (const bf16_t*)(ws + WS_XN), (const bf16_t*)(ws + W_IN), DIN, D, E); } break;
        case 4: if (PHMASK & (1 << 4)) { zero_phase(SSa, T); zero_phase(SSc, T); alr_phase(a, l); attn_phase(a, l, lds); s5_phase(a, l, lds); hgrn_phase(a, l, lds); } break;
        case 5: if (PHMASK & (1 << 5)) { pg8::EpiLR E; E.O = (bf16_t*)(ws + WS_LRO); E.w0 = (const float*)a.in[9] + (size_t)l * 512; E.a0 = (const float*)a.in[11] + (size_t)l * 512;
                  run_gemm(lds, (const bf16_t*)(ws + WS_ALR), (const bf16_t*)(ws + W_LR), 1536, 256, E);
                  pg8::EpiGLU G; G.Z = (const bf16_t*)(ws + WS_Z); G.Y = (bf16_t*)(ws + WS_YC); G.b = (const float*)a.in[31] + (size_t)l * 512;
                  run_gemm(lds, (const bf16_t*)(ws + WS_Z), (const bf16_t*)(ws + W_GLU), 512, 512, G); } break;
        case 6: if (PHMASK & (1 << 6)) rwkv_phase(a, l, lds); break;
        case 7: if (PHMASK & (1 << 7)) post_phase(a, l); break;
        case 8: if (PHMASK & (1 << 8)) { pg8::EpiResidual<false> E; E.base = a.out; E.out = a.out; E.XN = (bf16_t*)(ws + WS_XN); E.SS = SSc; run_gemm(lds, (const bf16_t*)(ws + WS_YC), (const bf16_t*)(ws + W_OUT), D, D, E); } break;
        case 9: if (PHMASK & (1 << 9)) { pg8::EpiSwiGLU E; E.H = (bf16_t*)(ws + WS_HID); E.SS = SSc; run_gemm(lds, (const bf16_t*)(ws + WS_XN), (const bf16_t*)(ws + W_UP2), 2 * FF, D, E); } break;
        case 10: if (PHMASK & (1 << 10)) { pg8::EpiResidual<true> E; E.base = a.out; E.out = a.out; E.XN = (l + 1 < NL) ? (bf16_t*)(ws + WS_XN) : nullptr; E.SS = SSa; run_gemm(lds, (const bf16_t*)(ws + WS_HID), (const bf16_t*)(ws + W_DN2), D, FF, E); } break;
        }
        if (step2 + 1 < 2 * hi) { __syncthreads(); cg::this_grid().sync(); }
    }
}

extern "C" void kernel_launch(void* const* d_in, const int* in_sizes, int n_in, void* d_out, int out_size, void* d_ws, size_t ws_size, hipStream_t stream) {
    static int grid = 0;
    if (!grid) {
        int dev = 0, cus = 0, per_cu = 0;
        hipGetDevice(&dev);
        hipDeviceGetAttribute(&cus, hipDeviceAttributeMultiprocessorCount, dev);
        hipFuncSetAttribute((const void*)mega, hipFuncAttributeMaxDynamicSharedMemorySize, LDS_BYTES);
        hipOccupancyMaxActiveBlocksPerMultiprocessor(&per_cu, (const void*)mega, NTHREADS, LDS_BYTES);
        if (per_cu < 1) per_cu = 1;
        grid = cus * 1;
        if (grid != 256) fprintf(stderr, "kernel_launch: grid %d (cus %d, per_cu %d)\n", grid, cus, per_cu);
    }
    Args a{};
    for (int i = 0; i < 39; ++i) a.in[i] = d_in[i];
    a.out = (float*)d_out; a.ws = (unsigned char*)d_ws;
#if ONE_LAUNCH
    int lo = 0, hi = NL * NPH;
    void* args[] = {&a, &lo, &hi};
    hipError_t e = hipLaunchCooperativeKernel((void*)mega, dim3(grid), dim3(NTHREADS), args, LDS_BYTES, stream);
    if (e != hipSuccess) fprintf(stderr, "cooperative launch failed: %s (grid %d)\n", hipGetErrorString(e), grid);
#else
    for (int s = 0; s < NL * NPH; ++s) hipLaunchKernelGGL(mega, dim3(grid), dim3(NTHREADS), LDS_BYTES, stream, a, s, s + 1);
#endif
}
```

```cpp
#include <hip/hip_runtime.h>
#include <hip/hip_cooperative_groups.h>
#include <cstdio>
#include <cstdint>
namespace cg = cooperative_groups;

#ifndef ONE_LAUNCH
#define ONE_LAUNCH 1
#endif

#define LAS __attribute__((address_space(3)))
typedef unsigned short bf16_t;
typedef short bf16x8 __attribute__((ext_vector_type(8)));
typedef float f32x4 __attribute__((ext_vector_type(4)));
typedef float f32x2 __attribute__((ext_vector_type(2)));
typedef unsigned u32x4 __attribute__((ext_vector_type(4)));
typedef unsigned u32x2 __attribute__((ext_vector_type(2)));

constexpr int T = 32768, SEQ = 2048, NB = 16, D = 2048, FF = 5632, DIN = 5120, NL = 2;
constexpr int C_RWKV = 0, C_ATT = 1792, C_S5 = 2560, C_HG = 3072;
constexpr int NTHREADS = 512, NWAVES = 8;

constexpr size_t SZ_UP = (size_t)2 * FF * D * 2, SZ_DN = (size_t)D * FF * 2, SZ_IN = (size_t)DIN * D * 2, SZ_LR = (size_t)1536 * 256 * 2,
                 SZ_GLU = (size_t)512 * 512 * 2, SZ_OUT = (size_t)D * D * 2;
constexpr size_t W_UP1 = 0, W_DN1 = W_UP1 + SZ_UP, W_IN = W_DN1 + SZ_DN, W_LR = W_IN + SZ_IN, W_GLU = W_LR + SZ_LR, W_OUT = W_GLU + SZ_GLU,
                 W_UP2 = W_OUT + SZ_OUT, W_DN2 = W_UP2 + SZ_UP, W_END = W_DN2 + SZ_DN;
constexpr size_t WS_XN = W_END, WS_BIG = WS_XN + (size_t)T * D * 2;
constexpr size_t WS_HID = WS_BIG;
constexpr size_t WS_PROJ = WS_BIG, WS_LRO = WS_PROJ + (size_t)T * DIN * 2, WS_ALR = WS_LRO + (size_t)T * 1536 * 2, WS_Z = WS_ALR + (size_t)T * 256 * 2,
                 WS_OR = WS_Z + (size_t)T * 512 * 2, WS_OH = WS_OR + (size_t)T * 512 * 4, WS_BON = WS_OH + (size_t)T * 512 * 4, WS_YC = WS_BON + (size_t)T * 8 * 4, WS_SS = WS_YC + (size_t)T * D * 2, WS_BAR = WS_SS + (size_t)3 * T * 4, WS_END = WS_BAR + 16384;
static_assert(WS_END <= (size_t)1 << 30, "workspace");
static_assert(WS_HID + (size_t)T * FF * 2 <= (size_t)1 << 30, "workspace");

constexpr int LDS_BYTES = 147456;

struct Args { const void* in[39]; float* out; unsigned char* ws; };
typedef const __attribute__((address_space(4))) Args& ArgsRef;

__device__ __forceinline__ unsigned pk2(float lo, float hi) { unsigned r; asm volatile("v_cvt_pk_bf16_f32 %0, %1, %2" : "=v"(r) : "v"(lo), "v"(hi)); return r; }
__device__ __forceinline__ float bflo(unsigned w) { return __uint_as_float(w << 16); }
__device__ __forceinline__ float bfhi(unsigned w) { return __uint_as_float(w & 0xffff0000u); }
__device__ __forceinline__ void unpack8(u32x4 q, float* f) { f[0] = bflo(q.x); f[1] = bfhi(q.x); f[2] = bflo(q.y); f[3] = bfhi(q.y); f[4] = bflo(q.z); f[5] = bfhi(q.z); f[6] = bflo(q.w); f[7] = bfhi(q.w); }
__device__ __forceinline__ u32x4 pack8(const float* f) { u32x4 o; o.x = pk2(f[0], f[1]); o.y = pk2(f[2], f[3]); o.z = pk2(f[4], f[5]); o.w = pk2(f[6], f[7]); return o; }
template <int CTRL> __device__ __forceinline__ float dpp(float x) { return __builtin_bit_cast(float, __builtin_amdgcn_mov_dpp(__builtin_bit_cast(int, x), CTRL, 0xf, 0xf, true)); }
constexpr int XOR1 = 0xB1, XOR2 = 0x4E, XOR7 = 0x141, XOR8 = 0x128;
__device__ __forceinline__ float red8(float v) { v += dpp<XOR1>(v); v += dpp<XOR2>(v); v += dpp<XOR7>(v); return v; }
__device__ __forceinline__ float red16(float v) { v = red8(v); v += dpp<XOR8>(v); return v; }
__device__ __forceinline__ float wave_sum(float v) {
#pragma unroll
    for (int o = 1; o < 64; o <<= 1) v += __shfl_xor(v, o);
    return v;
}
__device__ __forceinline__ float sigmoidf_(float x) { return 1.0f / (1.0f + __expf(-x)); }
__device__ __forceinline__ float siluf_(float x) { return x / (1.0f + __expf(-x)); }
__device__ __forceinline__ int opaque_tid() { int t = threadIdx.x; asm volatile("" : "+v"(t)); return t; }
__device__ __forceinline__ int opaque_bid() { int t = blockIdx.x; asm volatile("" : "+s"(t)); return t; }
__device__ __forceinline__ f32x2 pfma(f32x2 a, f32x2 b, f32x2 c) { return __builtin_elementwise_fma(a, b, c); }
#define LDS_FENCE() asm volatile("s_waitcnt lgkmcnt(0)" ::: "memory")
__device__ __forceinline__ void sincos_big(float x, float& sn, float& cs) {
    const float n = rintf(x * 0.15915494309189535f);
    float r = fmaf(-n, 6.28318548202514648f, x); r = fmaf(-n, -1.7484555e-7f, r);
    sn = __sinf(r); cs = __cosf(r);
}

namespace pg8 {
constexpr int BM = 256, BK = 64, HALF = 128, HTB = HALF * BK * 2, STAGE_BYTES = 8 * HTB, NXCD = 8, WGM = 8;
__host__ __device__ __forceinline__ int lds_byte(int r, int c) { const int st = (r >> 4) * 2 + (c >> 5), rr = r & 15, cc = c & 31, ob = rr * 64 + cc * 2; return st * 1024 + (ob ^ (((ob >> 9) & 1) << 5)); }
__host__ __device__ __forceinline__ void stage_rc(int b, int& R, int& C) { const int st = b / 1024, sb = b % 1024, swz = sb ^ (((sb >> 9) & 1) << 5); R = (st >> 1) * 16 + swz / 64; C = (st & 1) * 32 + (swz % 64) / 2; }
__host__ __device__ __forceinline__ int perm32(int rho) { const int n = rho >> 4, i = rho & 15; return 8 * (i >> 2) + 4 * n + (i & 3); }
struct Unit { int pm, pn; };
struct Gemm { const bf16_t* A; const bf16_t* Bt; int M, N, K; };
struct StaticOrder {
    int nM, nN, nwg, G, c;
    __device__ void init(int M, int N, int G_, int c_) { nM = M / BM; nN = N / BM; nwg = nM * nN; G = G_; c = c_; }
    __device__ bool next(int i, Unit& u) const {
        const long L = (long)i * G + c; if (L >= nwg) return false;
        int wgid = (int)L; { const int q = nwg / NXCD, r = nwg % NXCD, xcd = wgid % NXCD, off = wgid / NXCD; wgid = (xcd < r ? xcd * (q + 1) : r * (q + 1) + (xcd - r) * q) + off; }
        const int nig = WGM * nN, gid = wgid / nig, fm = gid * WGM, gsz = (nM - fm) < WGM ? (nM - fm) : WGM;
        u.pm = fm + ((wgid % nig) % gsz); u.pn = (wgid % nig) / gsz; return true;
    }
};
template <class Epi>
__device__ __forceinline__ void gemm_phase(LAS unsigned char* lds, const Gemm g, const StaticOrder S, const Epi E) {
    const int TID = opaque_tid(), BID = opaque_bid(); (void)TID; (void)BID;
    const int tid = TID, wid = __builtin_amdgcn_readfirstlane(tid >> 6), lane = tid & 63, wr = wid >> 2, wc = wid & 3, fr = lane & 15, fq = lane >> 4;
    const int K = g.K, nt = K / BK;
    unsigned voffA[2], voffB[2];
#pragma unroll
    for (int i = 0; i < 2; ++i) { int R, C; stage_rc(tid * 16 + i * 8192, R, C); const int Rb = Epi::PERM ? ((R & ~31) + perm32(R & 31)) : R;
        voffA[i] = (unsigned)(R * K + C) * 2u; voffB[i] = (unsigned)(Rb * K + C) * 2u; }
    const size_t kstep = (size_t)(BK * 2);
    const size_t hstep = (size_t)HALF * K * 2;
    const size_t tstep = 2 * hstep;
    const unsigned ldsw = (unsigned)wid * 1024u;
    const int aoff = lds_byte(wr * 64 + fr, fq * 8), boff = lds_byte(wc * 32 + fr, fq * 8);
#define PG8_SA(b, h) (((b) * 2 + (h)) * HTB)
#define PG8_SB(b, h) ((4 + (b) * 2 + (h)) * HTB)
#define PG8_STAGE(bufoff, gbase, voff) do { _Pragma("unroll") for (int _i = 0; _i < 2; ++_i) \
        __builtin_amdgcn_global_load_lds((const unsigned*)((const char*)(gbase) + (voff)[_i]), (LAS unsigned*)(lds + (bufoff) + ldsw + _i * 8192), 16, 0, 0); } while (0)
#define PG8_LDA(dst, b, h) do { _Pragma("unroll") for (int m = 0; m < 4; ++m) _Pragma("unroll") for (int k = 0; k < 2; ++k) dst[m][k] = *(const LAS bf16x8*)(lds + PG8_SA(b, h) + aoff + m * 2048 + k * 1024); } while (0)
#define PG8_LDB(dst, b, h) do { _Pragma("unroll") for (int n = 0; n < 2; ++n) _Pragma("unroll") for (int k = 0; k < 2; ++k) dst[n][k] = *(const LAS bf16x8*)(lds + PG8_SB(b, h) + boff + n * 2048 + k * 1024); } while (0)
#define PG8_MMA(ai, bj, At, Bt) do { __builtin_amdgcn_s_setprio(1); _Pragma("unroll") for (int m = 0; m < 4; ++m) _Pragma("unroll") for (int n = 0; n < 2; ++n) _Pragma("unroll") for (int k = 0; k < 2; ++k) \
        acc[ai][bj][m][n] = __builtin_amdgcn_mfma_f32_16x16x32_bf16(Bt[n][k], At[m][k], acc[ai][bj][m][n], 0, 0, 0); __builtin_amdgcn_s_setprio(0); } while (0)
#define PG8_WAIT_V(n) asm volatile("s_waitcnt vmcnt(" #n ")" ::: "memory")
#define PG8_WAIT_L(n) asm volatile("s_waitcnt lgkmcnt(" #n ")" ::: "memory")
#define PG8_BAR __builtin_amdgcn_s_barrier()
#define PG8_SCHED __builtin_amdgcn_sched_barrier(0)
    Unit cur, nxt; int ui = 0;
    if (!S.next(0, cur)) return;
    f32x4 acc[2][2][4][2];
#pragma unroll
    for (int a = 0; a < 2; ++a)
#pragma unroll
        for (int b = 0; b < 2; ++b)
#pragma unroll
            for (int m = 0; m < 4; ++m)
#pragma unroll
                for (int n = 0; n < 2; ++n) acc[a][b][m][n] = (f32x4){0.f, 0.f, 0.f, 0.f};
    bf16x8 At[4][2], B0[2][2], B1[2][2];
    const char* cA = (const char*)g.A + (size_t)cur.pm * tstep; const char* cB = (const char*)g.Bt + (size_t)cur.pn * tstep;
    PG8_STAGE(PG8_SB(0, 0), cB, voffB); PG8_STAGE(PG8_SA(0, 0), cA, voffA); PG8_STAGE(PG8_SB(0, 1), cB + hstep, voffB); PG8_STAGE(PG8_SA(0, 1), cA + hstep, voffA);
    if (wr == 1) PG8_BAR;
    PG8_WAIT_V(4); PG8_BAR;
    PG8_STAGE(PG8_SB(1, 0), cB + kstep, voffB); PG8_STAGE(PG8_SA(1, 0), cA + kstep, voffA); PG8_STAGE(PG8_SB(1, 1), cB + hstep + kstep, voffB);
    PG8_WAIT_V(6); PG8_BAR;
    for (;;) {
        const bool has_next = S.next(ui + 1, nxt);
        const char* nA = has_next ? (const char*)g.A + (size_t)nxt.pm * tstep : cA; const char* nB = has_next ? (const char*)g.Bt + (size_t)nxt.pn * tstep : cB;
#pragma unroll 1
        for (int t = 0; t < nt; t += 2) {
            const bool last = (t == nt - 2);
            const char* a1 = cA + (size_t)(t + 1) * kstep;
            const char* a2 = last ? nA : cA + (size_t)(t + 2) * kstep; const char* b2 = last ? nB : cB + (size_t)(t + 2) * kstep;
            const char* a3 = a2 + kstep; const char* b3 = b2 + kstep;
            PG8_LDB(B0, 0, 0); PG8_SCHED; PG8_LDA(At, 0, 0); PG8_STAGE(PG8_SA(1, 1), a1 + hstep, voffA);
            PG8_WAIT_L(8); PG8_BAR; PG8_WAIT_L(0); PG8_MMA(0, 0, At, B0); PG8_BAR; PG8_SCHED;
            PG8_LDB(B1, 0, 1); PG8_STAGE(PG8_SB(0, 0), b2, voffB);
            PG8_BAR; PG8_WAIT_L(0); PG8_MMA(0, 1, At, B1); PG8_BAR;
            PG8_LDA(At, 0, 1); PG8_STAGE(PG8_SA(0, 0), a2, voffA);
            PG8_BAR; PG8_WAIT_L(0); PG8_MMA(1, 0, At, B0); PG8_BAR; PG8_SCHED;
            PG8_STAGE(PG8_SB(0, 1), b2 + hstep, voffB);
            PG8_WAIT_V(6); PG8_BAR; PG8_MMA(1, 1, At, B1); PG8_BAR;
            PG8_LDB(B0, 1, 0); PG8_SCHED; PG8_LDA(At, 1, 0); PG8_STAGE(PG8_SA(0, 1), a2 + hstep, voffA);
            PG8_WAIT_L(8); PG8_BAR; PG8_WAIT_L(0); PG8_MMA(0, 0, At, B0); PG8_BAR; PG8_SCHED;
            PG8_LDB(B1, 1, 1); PG8_STAGE(PG8_SB(1, 0), b3, voffB);
            PG8_BAR; PG8_WAIT_L(0); PG8_MMA(0, 1, At, B1); PG8_BAR;
            PG8_LDA(At, 1, 1); PG8_STAGE(PG8_SA(1, 0), a3, voffA);
            PG8_BAR; PG8_WAIT_L(0); PG8_MMA(1, 0, At, B0); PG8_BAR; PG8_SCHED;
            PG8_STAGE(PG8_SB(1, 1), b3 + hstep, voffB);
            PG8_WAIT_V(6); PG8_BAR; PG8_MMA(1, 1, At, B1); PG8_BAR;
        }
        E(acc, cur, wr, wc, fr, fq);
        if (!has_next) break;
#pragma unroll
        for (int a = 0; a < 2; ++a)
#pragma unroll
            for (int b = 0; b < 2; ++b)
#pragma unroll
                for (int m = 0; m < 4; ++m)
#pragma unroll
                    for (int n = 0; n < 2; ++n) acc[a][b][m][n] = (f32x4){0.f, 0.f, 0.f, 0.f};
        cur = nxt; cA = nA; cB = nB; ++ui;
    }
    PG8_WAIT_V(0);
    if (wr == 0) PG8_BAR;
    PG8_BAR;
#undef PG8_SA
#undef PG8_SB
#undef PG8_STAGE
#undef PG8_LDA
#undef PG8_LDB
#undef PG8_MMA
#undef PG8_WAIT_V
#undef PG8_WAIT_L
#undef PG8_BAR
#undef PG8_SCHED
}

struct EpiSwiGLU {
    static constexpr bool PERM = true;
    bf16_t* H; const float* SS;
    __device__ __forceinline__ void operator()(const f32x4 (&acc)[2][2][4][2], const Unit& u, int wr, int wc, int fr, int fq) const {
        const int row0 = u.pm * BM + wr * 64 + fr, col0 = u.pn * 128 + wc * 32 + 8 * fq;
#pragma unroll
        for (int ai = 0; ai < 2; ++ai)
#pragma unroll
            for (int m = 0; m < 4; ++m) {
                const float rs = 1.0f / sqrtf(SS[row0 + ai * HALF + m * 16] * (1.0f / D) + 1e-6f);
                float v[8];
#pragma unroll
                for (int n = 0; n < 2; ++n)
#pragma unroll
                    for (int j = 0; j < 4; ++j) { const float gt = acc[ai][0][m][n][j] * rs, up = acc[ai][1][m][n][j] * rs; v[4 * n + j] = siluf_(gt) * up; }
                *(u32x4*)(H + (size_t)(row0 + ai * HALF + m * 16) * FF + col0) = pack8(v);
            }
    }
};
template <bool HALFSTEP> struct EpiResidual {
    static constexpr bool PERM = false;
    static constexpr float scale = HALFSTEP ? 0.5f : 1.0f;
    const float* base; float* out; bf16_t* XN; float* SS;
    __device__ __forceinline__ void operator()(const f32x4 (&acc)[2][2][4][2], const Unit& u, int wr, int wc, int fr, int fq) const {
        const int row0 = u.pm * BM + wr * 64 + fr, col0 = u.pn * BM + wc * 32 + 4 * fq;
#pragma unroll
        for (int ai = 0; ai < 2; ++ai)
#pragma unroll
            for (int m = 0; m < 4; ++m) { const int row = row0 + ai * HALF + m * 16; const size_t ro = (size_t)row * D + col0; float ss = 0.f;
#pragma unroll
                for (int bj = 0; bj < 2; ++bj)
#pragma unroll
                    for (int n = 0; n < 2; ++n) { const f32x4 b = *(const f32x4*)(base + ro + bj * HALF + n * 16); const f32x4 r = b + acc[ai][bj][m][n] * scale; *(f32x4*)(out + ro + bj * HALF + n * 16) = r;
                        if (XN) { u32x2 w; w.x = pk2(r.x, r.y); w.y = pk2(r.z, r.w); *(u32x2*)(XN + ro + bj * HALF + n * 16) = w; ss += (r.x * r.x + r.y * r.y) + (r.z * r.z + r.w * r.w); } }
                if (XN) { ss += __shfl_xor(ss, 16); ss += __shfl_xor(ss, 32); if (fq == 0) atomicAdd(SS + row, ss); } }
    }
};
struct EpiBf16 {
    static constexpr bool PERM = true;
    bf16_t* O; int ldc; const float* SS;
    __device__ __forceinline__ void operator()(const f32x4 (&acc)[2][2][4][2], const Unit& u, int wr, int wc, int fr, int fq) const {
        const int row0 = u.pm * BM + wr * 64 + fr, col0 = u.pn * BM + wc * 32 + 8 * fq;
#pragma unroll
        for (int ai = 0; ai < 2; ++ai)
#pragma unroll
            for (int m = 0; m < 4; ++m) { bf16_t* rowp = O + (size_t)(row0 + ai * HALF + m * 16) * ldc + col0;
                const float rs = 1.0f / sqrtf(SS[row0 + ai * HALF + m * 16] * (1.0f / D) + 1e-6f);
#pragma unroll
                for (int bj = 0; bj < 2; ++bj) { const f32x4 v0 = acc[ai][bj][m][0] * rs, v1 = acc[ai][bj][m][1] * rs;
                    u32x4 w; w.x = pk2(v0[0], v0[1]); w.y = pk2(v0[2], v0[3]); w.z = pk2(v1[0], v1[1]); w.w = pk2(v1[2], v1[3]);
                    *(u32x4*)(rowp + bj * HALF) = w; } }
    }
};
struct EpiLR {
    static constexpr bool PERM = true;
    bf16_t* O; const float* w0; const float* a0;
    template <int KIND> __device__ __forceinline__ void body(const f32x4 (&acc)[2][2][4][2], const float* bp, int row0, int col0) const {
#pragma unroll
        for (int bj = 0; bj < 2; ++bj) {
            f32x4 b0 = (f32x4){0.f, 0.f, 0.f, 0.f}, b1 = b0;
            if (KIND < 2) { b0 = *(const f32x4*)(bp + bj * HALF); b1 = *(const f32x4*)(bp + bj * HALF + 4); }
#pragma unroll
            for (int ai = 0; ai < 2; ++ai)
#pragma unroll
                for (int m = 0; m < 4; ++m) {
                    u32x4 w;
#pragma unroll
                    for (int n = 0; n < 2; ++n) {
                        float r[4];
#pragma unroll
                        for (int j = 0; j < 4; ++j) { const float x = acc[ai][bj][m][n][j] + (n == 0 ? b0[j] : b1[j]);
                            if (KIND == 0) { const float e = __expf(-x); r[j] = -0.60653065971f / (1.0f + e); }
                            else if (KIND == 1) r[j] = 1.0f / (1.0f + __expf(-x)); else r[j] = x; }
                        if (n == 0) { w.x = pk2(r[0], r[1]); w.y = pk2(r[2], r[3]); } else { w.z = pk2(r[0], r[1]); w.w = pk2(r[2], r[3]); }
                    }
                    *(u32x4*)(O + (size_t)(row0 + ai * HALF + m * 16) * 1536 + col0 + bj * HALF) = w;
                }
        }
    }
    __device__ __forceinline__ void operator()(const f32x4 (&acc)[2][2][4][2], const Unit& u, int wr, int wc, int fr, int fq) const {
        const int row0 = u.pm * BM + wr * 64 + fr, col0 = u.pn * BM + wc * 32 + 8 * fq, kind = u.pn >> 1, f0 = col0 - 512 * kind;
        if (kind == 0) body<0>(acc, w0 + f0, row0, col0); else if (kind == 1) body<1>(acc, a0 + f0, row0, col0); else body<2>(acc, nullptr, row0, col0);
    }
};
struct EpiGLU {
    static constexpr bool PERM = true;
    const bf16_t* Z; bf16_t* Y; const float* b;
    __device__ __forceinline__ void operator()(const f32x4 (&acc)[2][2][4][2], const Unit& u, int wr, int wc, int fr, int fq) const {
        const int row0 = u.pm * BM + wr * 64 + fr, col0 = u.pn * BM + wc * 32 + 8 * fq;
#pragma unroll
        for (int bj = 0; bj < 2; ++bj) {
            const f32x4 bias0 = *(const f32x4*)(b + col0 + bj * HALF), bias1 = *(const f32x4*)(b + col0 + bj * HALF + 4);
#pragma unroll
            for (int ai = 0; ai < 2; ++ai)
#pragma unroll
                for (int m = 0; m < 4; ++m) { const size_t r = (size_t)(row0 + ai * HALF + m * 16);
                    float z[8], v[8]; unpack8(*(const u32x4*)(Z + r * 512 + col0 + bj * HALF), z);
#pragma unroll
                    for (int n = 0; n < 2; ++n)
#pragma unroll
                        for (int j = 0; j < 4; ++j) v[4 * n + j] = z[4 * n + j] * sigmoidf_(acc[ai][bj][m][n][j] + (n == 0 ? bias0[j] : bias1[j]));
                    *(u32x4*)(Y + r * D + 1024 + col0 + bj * HALF) = pack8(v); }
        }
    }
};
}

template <class Epi> __device__ __forceinline__ void run_gemm(LAS unsigned char* lds, const bf16_t* A, const bf16_t* Bt, int N, int K, const Epi E) {
    pg8::Gemm g; g.A = A; g.Bt = Bt; g.M = T; g.N = N; g.K = K;
    pg8::StaticOrder S; S.init(T, N, gridDim.x, opaque_bid());
    pg8::gemm_phase<Epi>(lds, g, S, E);
}

__device__ __forceinline__ void tr_item(const float* W, int ldw, int k0, int n0, const float* gs, bf16_t* Dst, int ldd, int drow0, int dk0, LAS float* scr, int lane) {
    if (W) {
#pragma unroll 8
        for (int i = 0; i < 32; ++i) { const int kk = 2 * i + (lane >> 5); float v = W[(size_t)(k0 + kk) * ldw + n0 + (lane & 31)]; if (gs) v *= gs[k0 + kk]; scr[kk * 33 + (lane & 31)] = v; }
    } else {
#pragma unroll 8
        for (int i = 0; i < 32; ++i) { const int kk = 2 * i + (lane >> 5); scr[kk * 33 + (lane & 31)] = 0.f; }
    }
    LDS_FENCE();
    const int c = lane & 7;
#pragma unroll
    for (int j = 0; j < 4; ++j) { const int n = (lane >> 3) + 8 * j; const LAS float* s = scr + (8 * c) * 33 + n;
        u32x4 o; o.x = pk2(s[0 * 33], s[1 * 33]); o.y = pk2(s[2 * 33], s[3 * 33]); o.z = pk2(s[4 * 33], s[5 * 33]); o.w = pk2(s[6 * 33], s[7 * 33]);
        *(u32x4*)(Dst + (size_t)(drow0 + n) * ldd + dk0 + k0 - 0 + 8 * c - 0) = o; }
    LDS_FENCE();
}

__device__ __forceinline__ void conv_phase(ArgsRef a, int l, LAS unsigned char* lds) {
    const int TID = opaque_tid(), BID = opaque_bid(); (void)TID; (void)BID;
    const int wave = TID >> 6, lane = TID & 63;
    LAS float* scr = (LAS float*)(lds + wave * 8704);
    const int gw = BID * NWAVES + wave, NGW = gridDim.x * NWAVES;
    unsigned char* ws = a.ws;
    constexpr int I_GU = (D / 64) * (FF / 32), I_DN = (FF / 64) * (D / 32), I_IN = (D / 64) * (DIN / 32), I_OUT = (D / 64) * (D / 32), I_GLU = 8 * 16, I_LR = 48 * 4;
    constexpr int NITEMS = 6 * I_GU + I_IN + I_OUT + I_GLU + I_LR;
    static_assert(I_GU == I_DN, "items");
    for (int it = gw; it < NITEMS; it += NGW) {
        int r = it;
        if (r < 6 * I_GU) {
            const int which = r / I_GU; r -= which * I_GU;
            const int f = which >= 3, m = which % 3;
            if (m < 2) {
                const float* W = (const float*)a.in[(f ? 36 : 3) + m] + (size_t)l * D * FF;
                const float* gs = (const float*)a.in[f ? 35 : 2] + (size_t)l * D;
                bf16_t* dst = (bf16_t*)(ws + (f ? W_UP2 : W_UP1));
                const int nblk = FF / 32, kb = r / nblk, nb = r % nblk, n0 = 32 * nb;
                tr_item(W, FF, 64 * kb, n0, gs, dst, D, (n0 >> 7) * 256 + (n0 & 127) + 128 * m, 0, scr, lane);
            } else {
                const float* W = (const float*)a.in[f ? 38 : 5] + (size_t)l * FF * D;
                bf16_t* dst = (bf16_t*)(ws + (f ? W_DN2 : W_DN1));
                const int nblk = D / 32, kb = r / nblk, nb = r % nblk;
                tr_item(W, D, 64 * kb, 32 * nb, nullptr, dst, FF, 32 * nb, 0, scr, lane);
            }
            continue;
        }
        r -= 6 * I_GU;
        if (r < I_IN) { const int nblk = DIN / 32, kb = r / nblk, nb = r % nblk;
            tr_item((const float*)a.in[7] + (size_t)l * D * DIN, DIN, 64 * kb, 32 * nb, (const float*)a.in[6] + (size_t)l * D, (bf16_t*)(ws + W_IN), D, 32 * nb, 0, scr, lane); continue; }
        r -= I_IN;
        if (r < I_OUT) { const int nblk = D / 32, kb = r / nblk, nb = r % nblk;
            tr_item((const float*)a.in[34] + (size_t)l * D * D, D, 64 * kb, 32 * nb, nullptr, (bf16_t*)(ws + W_OUT), D, 32 * nb, 0, scr, lane); continue; }
        r -= I_OUT;
        if (r < I_GLU) { const int kb = r / 16, nb = r % 16;
            tr_item((const float*)a.in[30] + (size_t)l * 512 * 512, 512, 64 * kb, 32 * nb, nullptr, (bf16_t*)(ws + W_GLU), 512, 32 * nb, 0, scr, lane); continue; }
        r -= I_GLU;
        {
            const int nb = r >> 2, kb = r & 3, kind = nb >> 4, nn0 = 32 * (nb & 15);
            const float* W = nullptr; int k0 = 0;
            if (kind == 0 && kb == 0) { W = (const float*)a.in[10] + (size_t)l * 64 * 512; k0 = 0; }
            else if (kind == 1 && kb == 1) { W = (const float*)a.in[12] + (size_t)l * 64 * 512; k0 = 0; }
            else if (kind == 2 && kb >= 2) { W = (const float*)a.in[13] + (size_t)l * 128 * 512; k0 = 64 * (kb - 2); }
            tr_item(W, 512, k0, nn0, nullptr, (bf16_t*)(ws + W_LR), 256, 32 * nb, 64 * kb - k0, scr, lane);
        }
    }
}

__device__ __forceinline__ void norm_phase(const float* x, bf16_t* XN, float* SS) {
    const int TID = opaque_tid(), BID = opaque_bid(); (void)TID; (void)BID;
    const int wave = TID >> 6, lane = TID & 63;
    const int gw = BID * NWAVES + wave, NGW = gridDim.x * NWAVES;
    for (int m = gw; m < T; m += NGW) {
        const f32x4* xr = (const f32x4*)(x + (size_t)m * D) + lane;
        f32x4 v[8]; float s = 0.f;
#pragma unroll
        for (int j = 0; j < 8; ++j) { v[j] = xr[64 * j]; s += (v[j].x * v[j].x + v[j].y * v[j].y) + (v[j].z * v[j].z + v[j].w * v[j].w); }
        s = wave_sum(s); if (lane == 0) SS[m] = s;
        u32x2* o = (u32x2*)(XN + (size_t)m * D) + lane;
#pragma unroll
        for (int j = 0; j < 8; ++j) { u32x2 w; w.x = pk2(v[j].x, v[j].y); w.y = pk2(v[j].z, v[j].w); o[64 * j] = w; }
    }
}

__device__ __forceinline__ void zero_phase(float* p, int n) {
    const int TID = opaque_tid(), BID = opaque_bid();
    for (int i = BID * NTHREADS + TID; i < n; i += gridDim.x * NTHREADS) p[i] = 0.f;
}
__device__ __forceinline__ void alr_phase(ArgsRef a, int l) {
    const int TID = opaque_tid(), BID = opaque_bid(); (void)TID; (void)BID;
    const bf16_t* P = (const bf16_t*)(a.ws + WS_PROJ); bf16_t* ALR = (bf16_t*)(a.ws + WS_ALR);
    const float* mu = (const float*)a.in[8] + (size_t)l * 1792 + 1536;
    const int gt = BID * NTHREADS + TID, NGT = gridDim.x * NTHREADS;
    for (int it = gt; it < T * 32; it += NGT) {
        const int t = it >> 5, cg = it & 31, c0 = 8 * cg;
        float cur[8], prv[8], o[8];
        unpack8(*(const u32x4*)(P + (size_t)t * DIN + 1536 + c0), cur);
        if ((t & (SEQ - 1)) != 0) unpack8(*(const u32x4*)(P + (size_t)(t - 1) * DIN + 1536 + c0), prv);
        else {
#pragma unroll
            for (int j = 0; j < 8; ++j) prv[j] = 0.f; }
#pragma unroll
        for (int j = 0; j < 8; ++j) { const float v = cur[j] + (prv[j] - cur[j]) * mu[c0 + j];
            o[j] = c0 < 64 ? tanhf(v) : (c0 < 128 ? v : sigmoidf_(v)); }
        *(u32x4*)(ALR + (size_t)t * 256 + c0) = pack8(o);
    }
}

__device__ __forceinline__ void rwkv_phase(ArgsRef a, int l, LAS unsigned char* lds) {
    const int TID = opaque_tid(), BID = opaque_bid(); (void)TID; (void)BID;
    const bf16_t* P = (const bf16_t*)(a.ws + WS_PROJ); const bf16_t* LR = (const bf16_t*)(a.ws + WS_LRO);
    float* OR = (float*)(a.ws + WS_OR); float* BON = (float*)(a.ws + WS_BON);
    LAS float* sR = (LAS float*)lds; LAS float* sW = sR + 4096; LAS float* sK = sW + 4096; LAS float* sKK = sK + 4096; LAS float* sB = sKK + 4096;
    LAS float* sV = sB + 4096; LAS float* sO = sV + 2048;
    const int tid = TID, wave = tid >> 6, lane = tid & 63;
    const int tt = tid >> 3, cg = tid & 7;
    for (int job = BID; job < 256; job += gridDim.x) {
        const int b = job >> 4, h = (job >> 1) & 7, half = job & 1;
        const int c0 = 64 * h + 8 * cg;
        float mur[8], muk[8], muv[8], kkw[8], kaw[8], rkw[8];
#pragma unroll
        for (int j = 0; j < 8; ++j) {
            mur[j] = ((const float*)a.in[8])[(size_t)l * 1792 + c0 + j]; muk[j] = ((const float*)a.in[8])[(size_t)l * 1792 + 512 + c0 + j]; muv[j] = ((const float*)a.in[8])[(size_t)l * 1792 + 1024 + c0 + j];
            kkw[j] = ((const float*)a.in[14])[(size_t)l * 512 + c0 + j]; kaw[j] = ((const float*)a.in[15])[(size_t)l * 512 + c0 + j]; rkw[j] = ((const float*)a.in[16])[(size_t)l * 512 + c0 + j]; }
        f32x2 stA = (f32x2){0.f, 0.f}, stB = stA;
        const int rloc = 4 * wave + (lane >> 4), jq = lane & 15;
        for (int ch = 0; ch < SEQ / 64; ++ch) {
            __syncthreads();
            {
                const int s = ch * 64 + tt; const size_t t = (size_t)b * SEQ + s;
                float r[8], k[8], v[8], pr[8], ld[8], av[8];
                unpack8(*(const u32x4*)(P + t * DIN + c0), r); unpack8(*(const u32x4*)(P + t * DIN + 512 + c0), k); unpack8(*(const u32x4*)(P + t * DIN + 1024 + c0), v);
                if (s != 0) {
                    unpack8(*(const u32x4*)(P + (t - 1) * DIN + c0), pr);
#pragma unroll
                    for (int j = 0; j < 8; ++j) r[j] += (pr[j] - r[j]) * mur[j];
                    unpack8(*(const u32x4*)(P + (t - 1) * DIN + 512 + c0), pr);
#pragma unroll
                    for (int j = 0; j < 8; ++j) k[j] += (pr[j] - k[j]) * muk[j];
                    unpack8(*(const u32x4*)(P + (t - 1) * DIN + 1024 + c0), pr);
#pragma unroll
                    for (int j = 0; j < 8; ++j) v[j] += (pr[j] - v[j]) * muv[j];
                } else {
#pragma unroll
                    for (int j = 0; j < 8; ++j) { r[j] -= r[j] * mur[j]; k[j] -= k[j] * muk[j]; v[j] -= v[j] * muv[j]; }
                }
                unpack8(*(const u32x4*)(LR + t * 1536 + c0), ld); unpack8(*(const u32x4*)(LR + t * 1536 + 512 + c0), av);
                float kk[8], ss = 0.f, bp = 0.f;
#pragma unroll
                for (int j = 0; j < 8; ++j) { kk[j] = k[j] * kkw[j]; ss += kk[j] * kk[j]; }
                ss = red8(ss);
                const float inv = 1.0f / sqrtf(fmaxf(ss, 1e-24f));
                float w8[8], k8[8], b8[8];
#pragma unroll
                for (int j = 0; j < 8; ++j) { kk[j] *= inv; k8[j] = k[j] * (1.0f + (av[j] - 1.0f) * kaw[j]); b8[j] = kk[j] * av[j]; w8[j] = __expf(ld[j]); bp += r[j] * k8[j] * rkw[j]; }
                bp = red8(bp);
                if (half == 0 && cg == 0) BON[t * 8 + h] = bp;
                LAS float* d;
                d = sR + tt * 64 + 8 * cg; *(LAS f32x4*)d = (f32x4){r[0], r[1], r[2], r[3]}; *(LAS f32x4*)(d + 4) = (f32x4){r[4], r[5], r[6], r[7]};
                d = sW + tt * 64 + 8 * cg; *(LAS f32x4*)d = (f32x4){w8[0], w8[1], w8[2], w8[3]}; *(LAS f32x4*)(d + 4) = (f32x4){w8[4], w8[5], w8[6], w8[7]};
                d = sK + tt * 64 + 8 * cg; *(LAS f32x4*)d = (f32x4){k8[0], k8[1], k8[2], k8[3]}; *(LAS f32x4*)(d + 4) = (f32x4){k8[4], k8[5], k8[6], k8[7]};
                d = sKK + tt * 64 + 8 * cg; *(LAS f32x4*)d = (f32x4){kk[0], kk[1], kk[2], kk[3]}; *(LAS f32x4*)(d + 4) = (f32x4){kk[4], kk[5], kk[6], kk[7]};
                d = sB + tt * 64 + 8 * cg; *(LAS f32x4*)d = (f32x4){b8[0], b8[1], b8[2], b8[3]}; *(LAS f32x4*)(d + 4) = (f32x4){b8[4], b8[5], b8[6], b8[7]};
                if ((cg >> 2) == half) { d = sV + tt * 32 + 8 * (cg & 3); *(LAS f32x4*)d = (f32x4){v[0], v[1], v[2], v[3]}; *(LAS f32x4*)(d + 4) = (f32x4){v[4], v[5], v[6], v[7]}; }
            }
            __syncthreads();
            {
                f32x4 w4 = *(const LAS f32x4*)(sW + 4 * jq), kk4 = *(const LAS f32x4*)(sKK + 4 * jq), b4 = *(const LAS f32x4*)(sB + 4 * jq),
                      k4 = *(const LAS f32x4*)(sK + 4 * jq), r4 = *(const LAS f32x4*)(sR + 4 * jq);
                float vi = sV[rloc];
                f32x2 pyp = (f32x2){0.f, 0.f}; float ykeep = 0.f;
#pragma unroll 1
                for (int s16 = 0; s16 < 64; s16 += 16) {
#pragma unroll
                    for (int u = 0; u < 16; ++u) {
                        const int sn = (s16 + u + 1) & 63;
                        const f32x4 nw4 = *(const LAS f32x4*)(sW + sn * 64 + 4 * jq), nkk4 = *(const LAS f32x4*)(sKK + sn * 64 + 4 * jq), nb4 = *(const LAS f32x4*)(sB + sn * 64 + 4 * jq),
                                    nk4 = *(const LAS f32x4*)(sK + sn * 64 + 4 * jq), nr4 = *(const LAS f32x4*)(sR + sn * 64 + 4 * jq);
                        const float nvi = sV[sn * 32 + rloc];
                        const f32x2 pa = pfma(stB, (f32x2){kk4.z, kk4.w}, stA * (f32x2){kk4.x, kk4.y});
                        float av = pa.x + pa.y, yv = pyp.x + pyp.y;
                        av += dpp<XOR1>(av); yv += dpp<XOR1>(yv); av += dpp<XOR2>(av); yv += dpp<XOR2>(yv);
                        av += dpp<XOR7>(av); yv += dpp<XOR7>(yv); av += dpp<XOR8>(av); yv += dpp<XOR8>(yv);
                        if (u > 0) ykeep = (jq == u - 1) ? yv : ykeep;
                        else if (s16 > 0) { ykeep = (jq == 15) ? yv : ykeep; sO[(s16 - 16 + jq) * 32 + rloc] = ykeep; }
                        const float sa = -av;
                        const f32x2 sa2 = (f32x2){sa, sa}, vi2 = (f32x2){vi, vi};
                        const f32x2 tA = pfma(vi2, (f32x2){k4.x, k4.y}, sa2 * (f32x2){b4.x, b4.y}), tB = pfma(vi2, (f32x2){k4.z, k4.w}, sa2 * (f32x2){b4.z, b4.w});
                        stA = pfma(stA, (f32x2){w4.x, w4.y}, tA); stB = pfma(stB, (f32x2){w4.z, w4.w}, tB);
                        pyp = pfma(stB, (f32x2){r4.z, r4.w}, stA * (f32x2){r4.x, r4.y});
                        w4 = nw4; kk4 = nkk4; b4 = nb4; k4 = nk4; r4 = nr4; vi = nvi;
                    }
                }
                float yv = red16(pyp.x + pyp.y);
                ykeep = (jq == 15) ? yv : ykeep; sO[(48 + jq) * 32 + rloc] = ykeep;
            }
            __syncthreads();
            {
                const int s = ch * 64 + tt; const size_t t = (size_t)b * SEQ + s;
                *(f32x4*)(OR + t * 512 + 64 * h + 32 * half + 4 * cg) = *(const LAS f32x4*)(sO + tt * 32 + 4 * cg);
            }
        }
    }
    __syncthreads();
}

__device__ __forceinline__ void hgrn_phase(ArgsRef a, int l, LAS unsigned char* lds) {
    const int TID = opaque_tid(), BID = opaque_bid(); (void)TID; (void)BID;
    const bf16_t* P = (const bf16_t*)(a.ws + WS_PROJ); float* OH = (float*)(a.ws + WS_OH);
    LAS float* sQ = (LAS float*)lds; LAS float* sF = sQ + 4096; LAS float* sV = sF + 4096; LAS float* sO = sV + 2048;
    const int tid = TID, wave = tid >> 6, lane = tid & 63;
    const int tt = tid >> 3, cg = tid & 7;
    const float* lbp = (const float*)a.in[32];
    for (int job = BID; job < 256; job += gridDim.x) {
        const int b = job >> 4, h = (job >> 1) & 7, half = job & 1;
        const int c0 = 64 * h + 8 * cg;
        float lb[8];
#pragma unroll
        for (int j = 0; j < 8; ++j) lb[j] = (l == 0) ? 0.f : sigmoidf_(lbp[512 + c0 + j] - lbp[c0 + j]);
        f32x2 stA = (f32x2){0.f, 0.f}, stB = stA;
        const int cloc = 4 * wave + (lane >> 4), dq = lane & 15;
        for (int ch = 0; ch < SEQ / 64; ++ch) {
            __syncthreads();
            {
                const int s = ch * 64 + tt; const size_t t = (size_t)b * SEQ + s;
                float q[8], f[8];
                unpack8(*(const u32x4*)(P + t * DIN + C_HG + c0), q); unpack8(*(const u32x4*)(P + t * DIN + C_HG + 512 + c0), f);
#pragma unroll
                for (int j = 0; j < 8; ++j) { q[j] = siluf_(q[j]) * 0.125f; f[j] = lb[j] + (1.0f - lb[j]) * sigmoidf_(f[j]); }
                LAS float* d;
                d = sQ + tt * 64 + 8 * cg; *(LAS f32x4*)d = (f32x4){q[0], q[1], q[2], q[3]}; *(LAS f32x4*)(d + 4) = (f32x4){q[4], q[5], q[6], q[7]};
                d = sF + tt * 64 + 8 * cg; *(LAS f32x4*)d = (f32x4){f[0], f[1], f[2], f[3]}; *(LAS f32x4*)(d + 4) = (f32x4){f[4], f[5], f[6], f[7]};
                const u32x2 vv = *(const u32x2*)(P + t * DIN + C_HG + 1024 + 64 * h + 32 * half + 4 * cg);
                *(LAS f32x4*)(sV + tt * 32 + 4 * cg) = (f32x4){bflo(vv.x), bfhi(vv.x), bflo(vv.y), bfhi(vv.y)};
            }
            __syncthreads();
            {
                f32x4 f4 = *(const LAS f32x4*)(sF + 4 * dq), q4 = *(const LAS f32x4*)(sQ + 4 * dq);
                float vi = sV[cloc];
                float ykeep = 0.f;
#pragma unroll 1
                for (int s16 = 0; s16 < 64; s16 += 16) {
#pragma unroll
                    for (int u = 0; u < 16; ++u) {
                        const int sn = (s16 + u + 1) & 63;
                        const f32x4 nf4 = *(const LAS f32x4*)(sF + sn * 64 + 4 * dq), nq4 = *(const LAS f32x4*)(sQ + sn * 64 + 4 * dq);
                        const float nvi = sV[sn * 32 + cloc];
                        const f32x2 vi2 = (f32x2){vi, vi};
                        stA = pfma((f32x2){f4.x, f4.y}, stA - vi2, vi2); stB = pfma((f32x2){f4.z, f4.w}, stB - vi2, vi2);
                        const f32x2 py = pfma(stB, (f32x2){q4.z, q4.w}, stA * (f32x2){q4.x, q4.y});
                        const float y = red16(py.x + py.y);
                        ykeep = (dq == u) ? y : ykeep;
                        f4 = nf4; q4 = nq4; vi = nvi;
                    }
                    sO[(s16 + dq) * 32 + cloc] = ykeep;
                }
            }
            __syncthreads();
            {
                const int s = ch * 64 + tt; const size_t t = (size_t)b * SEQ + s;
                *(f32x4*)(OH + t * 512 + 64 * h + 32 * half + 4 * cg) = *(const LAS f32x4*)(sO + tt * 32 + 4 * cg);
            }
        }
    }
    __syncthreads();
}

__device__ __forceinline__ void post_phase(ArgsRef a, int l) {
    const int TID = opaque_tid(), BID = opaque_bid(); (void)TID; (void)BID;
    const bf16_t* P = (const bf16_t*)(a.ws + WS_PROJ); const bf16_t* LR = (const bf16_t*)(a.ws + WS_LRO);
    const float* OR = (const float*)(a.ws + WS_OR); const float* OH = (const float*)(a.ws + WS_OH); const float* BON = (const float*)(a.ws + WS_BON);
    bf16_t* Y = (bf16_t*)(a.ws + WS_YC);
    const float* muv = (const float*)a.in[8] + (size_t)l * 1792 + 1024;
    const float* lnw = (const float*)a.in[17] + (size_t)l * 512; const float* lnb = (const float*)a.in[18] + (size_t)l * 512;
    const float* gn = (const float*)a.in[33] + (size_t)l * 64;
    const int gt = BID * NTHREADS + TID, NGT = gridDim.x * NTHREADS;
    for (int it = gt; it < T * 128; it += NGT) {
        const int cg = it & 7, hh = (it >> 3) & 15; const size_t t = (size_t)(it >> 7);
        float o[8], y[8];
        if (hh < 8) {
            const int c0 = 64 * hh + 8 * cg;
            const f32x4 o0 = *(const f32x4*)(OR + t * 512 + c0), o1 = *(const f32x4*)(OR + t * 512 + c0 + 4);
            o[0] = o0.x; o[1] = o0.y; o[2] = o0.z; o[3] = o0.w; o[4] = o1.x; o[5] = o1.y; o[6] = o1.z; o[7] = o1.w;
            float s = 0.f;
#pragma unroll
            for (int j = 0; j < 8; ++j) s += o[j];
            const float mean = red8(s) * (1.0f / 64.0f);
            float q = 0.f;
#pragma unroll
            for (int j = 0; j < 8; ++j) { o[j] -= mean; q += o[j] * o[j]; }
            const float rstd = 1.0f / sqrtf(red8(q) * (1.0f / 64.0f) + 64e-5f);
            float v[8], pv[8], g[8];
            unpack8(*(const u32x4*)(P + t * DIN + 1024 + c0), v);
            if ((t & (SEQ - 1)) != 0) unpack8(*(const u32x4*)(P + (t - 1) * DIN + 1024 + c0), pv);
            else {
#pragma unroll
                for (int j = 0; j < 8; ++j) pv[j] = 0.f; }
            unpack8(*(const u32x4*)(LR + t * 1536 + 1024 + c0), g);
            const float bon = BON[t * 8 + hh];
#pragma unroll
            for (int j = 0; j < 8; ++j) { const float vl = v[j] + (pv[j] - v[j]) * muv[c0 + j];
                y[j] = (o[j] * rstd * lnw[c0 + j] + lnb[c0 + j] + bon * vl) * g[j]; }
            *(u32x4*)(Y + t * D + c0) = pack8(y);
        } else {
            const int h = hh - 8, c0 = 64 * h + 8 * cg;
            const f32x4 o0 = *(const f32x4*)(OH + t * 512 + c0), o1 = *(const f32x4*)(OH + t * 512 + c0 + 4);
            o[0] = o0.x; o[1] = o0.y; o[2] = o0.z; o[3] = o0.w; o[4] = o1.x; o[5] = o1.y; o[6] = o1.z; o[7] = o1.w;
            float q = 0.f;
#pragma unroll
            for (int j = 0; j < 8; ++j) q += o[j] * o[j];
            const float rs = 1.0f / sqrtf(red8(q) * (1.0f / 64.0f) + 1e-6f);
            float g[8];
            unpack8(*(const u32x4*)(P + t * DIN + C_HG + 1536 + c0), g);
#pragma unroll
            for (int j = 0; j < 8; ++j) y[j] = o[j] * rs * gn[8 * cg + j] * siluf_(g[j]);
            *(u32x4*)(Y + t * D + 1536 + c0) = pack8(y);
        }
    }
}

__device__ __forceinline__ void attn_phase(ArgsRef a, int l, LAS unsigned char* lds) {
    const int TID = opaque_tid(), BID = opaque_bid();
    const bf16_t* P = (const bf16_t*)(a.ws + WS_PROJ); bf16_t* Y = (bf16_t*)(a.ws + WS_YC);
    const int* pos = (const int*)a.in[1];
    const float* qn = (const float*)a.in[19] + (size_t)l * 64; const float* kn = (const float*)a.in[20] + (size_t)l * 64; const float* sinks = (const float*)a.in[21] + (size_t)l * 8;
    constexpr int KST = 144, VST = 528;
    LAS unsigned char* sK = lds; LAS unsigned char* sVt = sK + 256 * KST; LAS unsigned char* sQ = sVt + 64 * VST; LAS float* sM = (LAS float*)(sQ + 512 * KST);
    const int tid = TID, cg = tid & 7, wave = tid >> 6, lane = tid & 63;
    float kmaxg = 0.f;
    for (int j = 0; j < 64; ++j) kmaxg = fmaxf(kmaxg, fabsf(kn[j]));
    const float kbound = 8.0f * kmaxg;
    float gk[8], gq[8], invf[8];
#pragma unroll
    for (int j = 0; j < 8; ++j) { gk[j] = kn[8 * cg + j]; gq[j] = qn[8 * cg + j]; invf[j] = exp2f(-(float)j * (18.931568569324174f / 8.0f)); }
    for (int job = BID; job < 512; job += gridDim.x) {
        const int b = job >> 5, nb = (job >> 1) & 15, kvh = job & 1;
        __syncthreads();
#pragma unroll 1
        for (int r = 0; r < 4; ++r) {
            const int kj = (tid >> 3) + 64 * r, s = (nb - 1) * 128 + kj;
            float k[8], v[8];
            if (s >= 0) {
                const size_t t = (size_t)b * SEQ + s;
                unpack8(*(const u32x4*)(P + t * DIN + C_ATT + 512 + 64 * kvh + 8 * cg), k); unpack8(*(const u32x4*)(P + t * DIN + C_ATT + 640 + 64 * kvh + 8 * cg), v);
            } else {
#pragma unroll
                for (int j = 0; j < 8; ++j) { k[j] = 0.f; v[j] = 0.f; } }
            float ss = 0.f;
#pragma unroll
            for (int j = 0; j < 8; ++j) ss += k[j] * k[j];
            ss = red8(ss);
            const float rs = 1.0f / sqrtf(ss * (1.0f / 64.0f) + 1e-6f);
#pragma unroll
            for (int j = 0; j < 8; ++j) k[j] = k[j] * rs * gk[j];
            const float pf = (float)pos[b * SEQ + (s >= 0 ? s : 0)];
#pragma unroll
            for (int j = 0; j < 8; ++j) {
                const float other = dpp<XOR1>(k[j]);
                if (cg < 2) { float sn, cs; sincos_big(pf * invf[j], sn, cs); k[j] = (cg == 0) ? (k[j] * cs - other * sn) : (k[j] * cs + other * sn); }
            }
            *(LAS u32x4*)(sK + kj * KST + 16 * cg) = pack8(k);
#pragma unroll
            for (int j = 0; j < 8; j += 2) { const unsigned w = pk2(v[j], v[j + 1]);
                *(LAS unsigned short*)(sVt + (8 * cg + j) * VST + 2 * kj) = (unsigned short)(w & 0xffffu); *(LAS unsigned short*)(sVt + (8 * cg + j + 1) * VST + 2 * kj) = (unsigned short)(w >> 16); }
        }
#pragma unroll 1
        for (int r = 0; r < 8; ++r) {
            const int row = (tid >> 3) + 64 * r, g = row >> 7, qi = row & 127, hq = 4 * kvh + g;
            const size_t tq = (size_t)b * SEQ + nb * 128 + qi;
            float q[8];
            unpack8(*(const u32x4*)(P + tq * DIN + C_ATT + 64 * hq + 8 * cg), q);
            float ss = 0.f;
#pragma unroll
            for (int j = 0; j < 8; ++j) ss += q[j] * q[j];
            ss = red8(ss);
            const float rs = 0.125f / sqrtf(ss * (1.0f / 64.0f) + 1e-6f);
#pragma unroll
            for (int j = 0; j < 8; ++j) q[j] = q[j] * rs * gq[j];
            const float pf = (float)pos[b * SEQ + nb * 128 + qi];
            float qq = 0.f;
#pragma unroll
            for (int j = 0; j < 8; ++j) {
                const float other = dpp<XOR1>(q[j]);
                if (cg < 2) { float sn, cs; sincos_big(pf * invf[j], sn, cs); q[j] = (cg == 0) ? (q[j] * cs - other * sn) : (q[j] * cs + other * sn); }
                qq += q[j] * q[j];
            }
            qq = red8(qq);
            if (cg == 0) sM[row] = sqrtf(qq) * kbound;
            *(LAS u32x4*)(sQ + row * KST + 16 * cg) = pack8(q);
        }
        __syncthreads();
        const int g = wave >> 1, qh = wave & 1, hq = 4 * kvh + g, fr = lane & 15, fq = lane >> 4;
        const float sinkv = sinks[hq];
#pragma unroll 1
        for (int qt = 0; qt < 4; ++qt) {
            const int qi0 = 64 * qh + 16 * qt, R0 = g * 128 + qi0, kt0 = qi0 >> 4;
            const bf16x8 qf0 = *(const LAS bf16x8*)(sQ + (R0 + fr) * KST + 16 * fq), qf1 = *(const LAS bf16x8*)(sQ + (R0 + fr) * KST + 16 * fq + 64);
            const float msh = sM[R0 + fr];
            const int ql = qi0 + fr;
            f32x4 oacc[4];
#pragma unroll
            for (int dt = 0; dt < 4; ++dt) oacc[dt] = (f32x4){0.f, 0.f, 0.f, 0.f};
            float lsum = 0.f;
#pragma unroll
            for (int ks = 0; ks < 5; ++ks) {
                unsigned pw[4];
#pragma unroll
                for (int h2 = 0; h2 < 2; ++h2) {
                    const int ti = 2 * ks + h2, kt = (kt0 + ti) < 15 ? (kt0 + ti) : 15;
                    const bf16x8 kf0 = *(const LAS bf16x8*)(sK + (16 * kt + fr) * KST + 16 * fq), kf1 = *(const LAS bf16x8*)(sK + (16 * kt + fr) * KST + 16 * fq + 64);
                    f32x4 sc = (f32x4){0.f, 0.f, 0.f, 0.f};
                    sc = __builtin_amdgcn_mfma_f32_16x16x32_bf16(kf0, qf0, sc, 0, 0, 0);
                    sc = __builtin_amdgcn_mfma_f32_16x16x32_bf16(kf1, qf1, sc, 0, 0, 0);
                    float p[4];
#pragma unroll
                    for (int j = 0; j < 4; ++j) { const int kj = 16 * (kt0 + ti) + 4 * fq + j;
                        const bool valid = (kj > ql) && (kj <= ql + 128) && (nb > 0 || kj >= 128);
                        p[j] = valid ? __expf(sc[j] - msh) : 0.f; lsum += p[j]; }
                    pw[2 * h2] = pk2(p[0], p[1]); pw[2 * h2 + 1] = pk2(p[2], p[3]);
                }
                const u32x4 pq = (u32x4){pw[0], pw[1], pw[2], pw[3]};
                const bf16x8 pf = __builtin_bit_cast(bf16x8, pq);
                const int kta = (kt0 + 2 * ks) < 15 ? (kt0 + 2 * ks) : 15, ktb = (kt0 + 2 * ks + 1) < 15 ? (kt0 + 2 * ks + 1) : 15;
#pragma unroll
                for (int dt = 0; dt < 4; ++dt) {
                    const u32x2 va = *(const LAS u32x2*)(sVt + (16 * dt + fr) * VST + (16 * kta + 4 * fq) * 2), vb = *(const LAS u32x2*)(sVt + (16 * dt + fr) * VST + (16 * ktb + 4 * fq) * 2);
                    const u32x4 vq = (u32x4){va.x, va.y, vb.x, vb.y};
                    oacc[dt] = __builtin_amdgcn_mfma_f32_16x16x32_bf16(__builtin_bit_cast(bf16x8, vq), pf, oacc[dt], 0, 0, 0);
                }
            }
            lsum += __shfl_xor(lsum, 16); lsum += __shfl_xor(lsum, 32);
            const float inv = 1.0f / (lsum + __expf(sinkv - msh));
            const size_t tq = (size_t)b * SEQ + nb * 128 + ql;
#pragma unroll
            for (int dt = 0; dt < 4; ++dt) { u32x2 w; w.x = pk2(oacc[dt][0] * inv, oacc[dt][1] * inv); w.y = pk2(oacc[dt][2] * inv, oacc[dt][3] * inv);
                *(u32x2*)(Y + tq * D + 512 + 64 * hq + 16 * dt + 4 * fq) = w; }
        }
    }
    __syncthreads();
}

__device__ __forceinline__ void s5_phase(ArgsRef a, int l, LAS unsigned char* lds) {
    const int TID = opaque_tid(), BID = opaque_bid(); (void)TID; (void)BID;
    const bf16_t* P = (const bf16_t*)(a.ws + WS_PROJ); bf16_t* Z = (bf16_t*)(a.ws + WS_Z);
    const int tid = TID, wave = tid >> 6, lane = tid & 63;
    LAS float* sU = (LAS float*)lds + wave * 1024;
    LAS float* sX = (LAS float*)lds + 8192 + wave * (16 * 130);
    LAS float* sE = (LAS float*)lds + 8192 + 8 * 16 * 130;
    for (int job = BID; job < 512; job += gridDim.x) {
        const int b = job >> 5, g = job & 31;
        const float lre = ((const float*)a.in[22])[(size_t)l * 2048 + g * 64 + lane], lim = ((const float*)a.in[23])[(size_t)l * 2048 + g * 64 + lane];
        const float dt = expf(((const float*)a.in[24])[l * 32 + g]);
        float sn, cs; sincos_big(lim * dt, sn, cs);
        const float er = expf(lre * dt), lbr = er * cs, lbi = er * sn;
        const float den = 1.0f / (lre * lre + lim * lim);
        const float fr = ((lbr - 1.0f) * lre + lbi * lim) * den, fi = (lbi * lre - (lbr - 1.0f) * lim) * den;
        f32x2 bb[16];
        {
            const f32x4* br = (const f32x4*)((const float*)a.in[25] + ((size_t)l * 2048 + g * 64 + lane) * 16); const f32x4* bi = (const f32x4*)((const float*)a.in[26] + ((size_t)l * 2048 + g * 64 + lane) * 16);
#pragma unroll
            for (int q = 0; q < 4; ++q) { const f32x4 r4 = br[q], i4 = bi[q];
                bb[4 * q] = (f32x2){fr * r4.x - fi * i4.x, fr * i4.x + fi * r4.x}; bb[4 * q + 1] = (f32x2){fr * r4.y - fi * i4.y, fr * i4.y + fi * r4.y};
                bb[4 * q + 2] = (f32x2){fr * r4.z - fi * i4.z, fr * i4.z + fi * r4.z}; bb[4 * q + 3] = (f32x2){fr * r4.w - fi * i4.w, fr * i4.w + fi * r4.w}; }
        }
        float creg[32];
        {
            const float* cre = (const float*)a.in[27] + ((size_t)l * 32 + g) * 1024 + (lane & 15) * 64 + (lane >> 4);
            const float* cim = (const float*)a.in[28] + ((size_t)l * 32 + g) * 1024 + (lane & 15) * 64 + (lane >> 4);
#pragma unroll
            for (int kk = 0; kk < 16; ++kk) { creg[kk] = cre[4 * kk]; creg[16 + kk] = -cim[4 * kk]; }
        }
        f32x4 dsk;
        { const float* dp = (const float*)a.in[29] + (size_t)l * 512 + 16 * g + 4 * (lane >> 4); dsk = (f32x4){dp[0], dp[1], dp[2], dp[3]}; }
        const size_t tbase = (size_t)b * SEQ + wave * 256;
        f32x2 xs = (f32x2){0.f, 0.f}; const f32x2 lbr2 = (f32x2){lbr, lbr}, lbi2 = (f32x2){lbi, lbi};
        for (int c = 0; c < 4; ++c) {
            { const size_t t = tbase + c * 64 + lane; float u[16]; unpack8(*(const u32x4*)(P + t * DIN + C_S5 + 16 * g), u); unpack8(*(const u32x4*)(P + t * DIN + C_S5 + 16 * g + 8), u + 8);
              LAS f32x4* d = (LAS f32x4*)(sU + lane * 16); d[0] = (f32x4){u[0], u[1], u[2], u[3]}; d[1] = (f32x4){u[4], u[5], u[6], u[7]}; d[2] = (f32x4){u[8], u[9], u[10], u[11]}; d[3] = (f32x4){u[12], u[13], u[14], u[15]}; }
            LDS_FENCE();
#pragma unroll 2
            for (int s = 0; s < 64; ++s) {
                const LAS f32x4* up = (const LAS f32x4*)(sU + s * 16);
                f32x2 bu0 = (f32x2){0.f, 0.f}, bu1 = bu0;
#pragma unroll
                for (int q = 0; q < 4; ++q) { const f32x4 u4 = up[q];
                    bu0 = pfma(bb[4 * q], (f32x2){u4.x, u4.x}, bu0); bu1 = pfma(bb[4 * q + 1], (f32x2){u4.y, u4.y}, bu1);
                    bu0 = pfma(bb[4 * q + 2], (f32x2){u4.z, u4.z}, bu0); bu1 = pfma(bb[4 * q + 3], (f32x2){u4.w, u4.w}, bu1); }
                { const f32x2 nx = pfma(lbr2, xs, bu0 + bu1); xs = pfma(lbi2, (f32x2){-xs.y, xs.x}, nx); }
            }
            LDS_FENCE();
        }
        sE[wave * 128 + lane] = xs.x; sE[wave * 128 + 64 + lane] = xs.y;
        float pr = lbr, pi = lbi;
#pragma unroll
        for (int i = 0; i < 8; ++i) { const float nr = pr * pr - pi * pi, ni = 2.0f * pr * pi; pr = nr; pi = ni; }
        __syncthreads();
        xs = (f32x2){0.f, 0.f};
        for (int w = 0; w < wave; ++w) { const float er_ = sE[w * 128 + lane], ei_ = sE[w * 128 + 64 + lane];
            const float nr = pr * xs.x - pi * xs.y + er_, ni = pr * xs.y + pi * xs.x + ei_; xs.x = nr; xs.y = ni; }
        for (int c = 0; c < 4; ++c) {
            { const size_t t = tbase + c * 64 + lane; float u[16]; unpack8(*(const u32x4*)(P + t * DIN + C_S5 + 16 * g), u); unpack8(*(const u32x4*)(P + t * DIN + C_S5 + 16 * g + 8), u + 8);
              LAS f32x4* d = (LAS f32x4*)(sU + lane * 16); d[0] = (f32x4){u[0], u[1], u[2], u[3]}; d[1] = (f32x4){u[4], u[5], u[6], u[7]}; d[2] = (f32x4){u[8], u[9], u[10], u[11]}; d[3] = (f32x4){u[12], u[13], u[14], u[15]}; }
            LDS_FENCE();
#pragma unroll 1
            for (int s16 = 0; s16 < 4; ++s16) {
#pragma unroll 2
                for (int s = 0; s < 16; ++s) {
                    const LAS f32x4* up = (const LAS f32x4*)(sU + (s16 * 16 + s) * 16);
                    f32x2 bu0 = (f32x2){0.f, 0.f}, bu1 = bu0;
#pragma unroll
                    for (int q = 0; q < 4; ++q) { const f32x4 u4 = up[q];
                        bu0 = pfma(bb[4 * q], (f32x2){u4.x, u4.x}, bu0); bu1 = pfma(bb[4 * q + 1], (f32x2){u4.y, u4.y}, bu1);
                        bu0 = pfma(bb[4 * q + 2], (f32x2){u4.z, u4.z}, bu0); bu1 = pfma(bb[4 * q + 3], (f32x2){u4.w, u4.w}, bu1); }
                    { const f32x2 nx = pfma(lbr2, xs, bu0 + bu1); xs = pfma(lbi2, (f32x2){-xs.y, xs.x}, nx); }
                    sX[s * 130 + lane] = xs.x; sX[s * 130 + 64 + lane] = xs.y;
                }
                LDS_FENCE();
                f32x4 yacc = (f32x4){0.f, 0.f, 0.f, 0.f};
                const LAS float* xp = sX + (lane & 15) * 130 + (lane >> 4);
#pragma unroll
                for (int kk = 0; kk < 32; ++kk) yacc = __builtin_amdgcn_mfma_f32_16x16x4f32(creg[kk], xp[4 * kk], yacc, 0, 0, 0);
                const int tok = s16 * 16 + (lane & 15);
                const f32x4 u4 = *(const LAS f32x4*)(sU + tok * 16 + 4 * (lane >> 4));
                float z[4];
#pragma unroll
                for (int j = 0; j < 4; ++j) { const float y = yacc[j] + dsk[j] * u4[j]; z[j] = 0.5f * y * (1.0f + erff(y * 0.70710678118654752f)); }
                u32x2 w; w.x = pk2(z[0], z[1]); w.y = pk2(z[2], z[3]);
                *(u32x2*)(Z + (tbase + c * 64 + tok) * 512 + 16 * g + 4 * (lane >> 4)) = w;
                LDS_FENCE();
            }
        }
        __syncthreads();
    }
}

#define XB_TMO      128
#define XB_XCNT(j)  (256  + 64 * (j))
#define XB_XSUB(j)  (1280 + 64 * (j))
#define XB_XGEN(j)  (2304 + 64 * (j))
#define XB_TOP      3328
#define XB_TOPGEN   3392
#define XCD_BAR_WORDS 3456
#define XB_SPIN_CAP (1u << 18)

__device__ __forceinline__ unsigned xb_ld(unsigned* p)              { return __hip_atomic_load(p, __ATOMIC_RELAXED, __HIP_MEMORY_SCOPE_AGENT); }
__device__ __forceinline__ unsigned xb_add(unsigned* p, unsigned v) { return __hip_atomic_fetch_add(p, v, __ATOMIC_RELAXED, __HIP_MEMORY_SCOPE_AGENT); }
__device__ __forceinline__ unsigned xb_xcc_id() { return (unsigned)__builtin_amdgcn_s_getreg((3 << 11) | 20) & 0xFu; }
#define XB_SPIN(cond, bar) do { unsigned _sp = 0; while (cond) { __builtin_amdgcn_s_sleep(1); \
    if ((++_sp & 255u) == 0u) { if (xb_ld(&(bar)[XB_TMO])) break; if (_sp > XB_SPIN_CAP) { atomicAdd(&(bar)[XB_TMO], 1u); break; } } } } while (0)

struct XcdBarrier {
    unsigned* bar; unsigned x;
    volatile LAS unsigned* st;
};

__device__ __forceinline__ XcdBarrier xcd_barrier_post(unsigned* bar, volatile LAS unsigned* st) {
    XcdBarrier b; b.bar = bar; b.x = xb_xcc_id(); b.st = st;
    if (threadIdx.x == 0) (void)xb_add(&bar[XB_XCNT(b.x)], 1u);
    return b;
}
__device__ __forceinline__ void xcd_barrier_complete(unsigned* bar, unsigned x, unsigned& nloc, unsigned& nx) {
    const unsigned G = gridDim.x * gridDim.y * gridDim.z;
    unsigned sum, cnt, mine, sp = 0u;
    for (;;) {
        sum = 0u; cnt = 0u; mine = 0u;
#pragma unroll
        for (unsigned j = 0; j < 16; ++j) { const unsigned c = xb_ld(&bar[XB_XCNT(j)]); sum += c; cnt += (c > 0u) ? 1u : 0u; mine = (j == x) ? c : mine; }
        if (sum == G) break;
        __builtin_amdgcn_s_sleep(1);
        if ((++sp & 255u) == 0u) { if (xb_ld(&bar[XB_TMO])) break; if (sp > XB_SPIN_CAP) { atomicAdd(&bar[XB_TMO], 1u); break; } }
    }
    nloc = mine > 0u ? mine : 1u; nx = cnt > 0u ? cnt : 1u;
}

__device__ __forceinline__ void xcd_barrier(const XcdBarrier& b) {
    asm volatile("s_waitcnt vmcnt(0)" ::: "memory");
    __syncthreads();
    if (threadIdx.x == 0) {
        unsigned* bar = b.bar;
        __builtin_amdgcn_s_waitcnt(0);
        unsigned nloc = b.st[0], nx = b.st[1];
        if (nloc == 0u) { xcd_barrier_complete(bar, b.x, nloc, nx); b.st[0] = nloc; b.st[1] = nx; }
        const unsigned old = xb_add(&bar[XB_XSUB(b.x)], 1u);
        const unsigned gen = old / nloc;
        if (old + 1u == (gen + 1u) * nloc) {
            __builtin_amdgcn_fence(__ATOMIC_RELEASE, "agent");
            asm volatile("s_waitcnt vmcnt(0)" ::: "memory");
            const unsigned og = xb_add(&bar[XB_TOP], 1u);
            const unsigned tg = og / nx;
            if (og + 1u == (tg + 1u) * nx) xb_add(&bar[XB_TOPGEN], 1u);
            else XB_SPIN(xb_ld(&bar[XB_TOPGEN]) == tg, bar);
            __builtin_amdgcn_fence(__ATOMIC_ACQUIRE, "agent");
            xb_add(&bar[XB_XGEN(b.x)], 1u);
            asm volatile("s_waitcnt vmcnt(0)" ::: "memory");
        } else {
            XB_SPIN(xb_ld(&bar[XB_XGEN(b.x)]) == gen, bar);
            __builtin_amdgcn_fence(__ATOMIC_ACQUIRE, "agent");
            asm volatile("s_waitcnt vmcnt(0)" ::: "memory");
        }
    }
    __syncthreads();
}


constexpr int NPH = 11;
#ifndef DUPMASK
#define DUPMASK 0
#endif
__global__ void __launch_bounds__(NTHREADS, 2) mega(Args a_, int lo, int hi) {
    extern __shared__ __attribute__((aligned(16))) unsigned char lds_raw[];
    LAS unsigned char* lds = (LAS unsigned char*)lds_raw;
#ifdef EXTRA_SYNCS
    for (int i = 0; i < EXTRA_SYNCS; ++i) { __syncthreads(); cg::this_grid().sync(); }
#endif
    LAS unsigned* xst = (LAS unsigned*)(lds + LDS_BYTES - 16);
    if (hi - lo > 1) {
        if (threadIdx.x == 0) { xst[0] = 0u; xst[1] = 0u; }
        __syncthreads();
        const __attribute__((address_space(4))) Args* ap0 = (const __attribute__((address_space(4))) Args*)__builtin_amdgcn_kernarg_segment_ptr();
        (void)xcd_barrier_post((unsigned*)(ap0->ws + WS_BAR), (volatile LAS unsigned*)xst);
    }
#pragma unroll 1
    for (int step2 = 2 * lo; step2 < 2 * hi; ++step2) {
        const int step = step2 >> 1;
        if ((step2 & 1) && !((DUPMASK >> (step % NPH)) & 1)) continue;
        const __attribute__((address_space(4))) Args* ap = (const __attribute__((address_space(4))) Args*)__builtin_amdgcn_kernarg_segment_ptr();
        asm volatile("" : "+s"(ap));
        ArgsRef a = *ap;
        unsigned char* ws = a.ws;
        float* SSa = (float*)(ws + WS_SS); float* SSb = SSa + T; float* SSc = SSb + T;
        const int l = step / NPH, ph = step % NPH;
        const float* xin = (l == 0) ? (const float*)a.in[0] : (const float*)a.out;
#ifndef PHMASK
#define PHMASK 0x7ff
#endif
        switch (ph) {
        case 0: if (PHMASK & (1 << 0)) { conv_phase(a, l, lds); if (l == 0) norm_phase(xin, (bf16_t*)(ws + WS_XN), SSa); zero_phase(SSb, T); } break;
        case 1: if (PHMASK & (1 << 1)) { pg8::EpiSwiGLU E; E.H = (bf16_t*)(ws + WS_HID); E.SS = SSa; run_gemm(lds, (const bf16_t*)(ws + WS_XN), (const bf16_t*)(ws + W_UP1), 2 * FF, D, E); } break;
        case 2: if (PHMASK & (1 << 2)) { pg8::EpiResidual<true> E; E.base = xin; E.out = a.out; E.XN = (bf16_t*)(ws + WS_XN); E.SS = SSb; run_gemm(lds, (const bf16_t*)(ws + WS_HID), (const bf16_t*)(ws + W_DN1), D, FF, E); } break;
        case 3: if (PHMASK & (1 << 3)) { pg8::EpiBf16 E; E.O = (bf16_t*)(ws + WS_PROJ); E.ldc = DIN; E.SS = SSb; run_gemm(lds, (const bf16_t*)(ws + WS_XN), (const bf16_t*)(ws + W_IN), DIN, D, E); } break;
        case 4: if (PHMASK & (1 << 4)) { zero_phase(SSa, T); zero_phase(SSc, T); alr_phase(a, l); attn_phase(a, l, lds); s5_phase(a, l, lds); hgrn_phase(a, l, lds); } break;
        case 5: if (PHMASK & (1 << 5)) { pg8::EpiLR E; E.O = (bf16_t*)(ws + WS_LRO); E.w0 = (const float*)a.in[9] + (size_t)l * 512; E.a0 = (const float*)a.in[11] + (size_t)l * 512;
                  run_gemm(lds, (const bf16_t*)(ws + WS_ALR), (const bf16_t*)(ws + W_LR), 1536, 256, E);
                  pg8::EpiGLU G; G.Z = (const bf16_t*)(ws + WS_Z); G.Y = (bf16_t*)(ws + WS_YC); G.b = (const float*)a.in[31] + (size_t)l * 512;
                  run_gemm(lds, (const bf16_t*)(ws + WS_Z), (const bf16_t*)(ws + W_GLU), 512, 512, G); } break;
        case 6: if (PHMASK & (1 << 6)) rwkv_phase(a, l, lds); break;
        case 7: if (PHMASK & (1 << 7)) post_phase(a, l); break;
        case 8: if (PHMASK & (1 << 8)) { pg8::EpiResidual<false> E; E.base = a.out; E.out = a.out; E.XN = (bf16_t*)(ws + WS_XN); E.SS = SSc; run_gemm(lds, (const bf16_t*)(ws + WS_YC), (const bf16_t*)(ws + W_OUT), D, D, E); } break;
        case 9: if (PHMASK & (1 << 9)) { pg8::EpiSwiGLU E; E.H = (bf16_t*)(ws + WS_HID); E.SS = SSc; run_gemm(lds, (const bf16_t*)(ws + WS_XN), (const bf16_t*)(ws + W_UP2), 2 * FF, D, E); } break;
        case 10: if (PHMASK & (1 << 10)) { pg8::EpiResidual<true> E; E.base = a.out; E.out = a.out; E.XN = (l + 1 < NL) ? (bf16_t*)(ws + WS_XN) : nullptr; E.SS = SSa; run_gemm(lds, (const bf16_t*)(ws + WS_HID), (const bf16_t*)(ws + W_DN2), D, FF, E); } break;
        }
        if (step2 + 1 < 2 * hi) {
            if (step2 == 2 * lo) { __syncthreads(); cg::this_grid().sync(); }
            else { XcdBarrier xb; xb.bar = (unsigned*)(ws + WS_BAR); xb.x = xb_xcc_id(); xb.st = (volatile LAS unsigned*)xst; xcd_barrier(xb); }
        }
    }
}

extern "C" void kernel_launch(void* const* d_in, const int* in_sizes, int n_in, void* d_out, int out_size, void* d_ws, size_t ws_size, hipStream_t stream) {
    static int grid = 0;
    if (!grid) {
        int dev = 0, cus = 0, per_cu = 0;
        hipGetDevice(&dev);
        hipDeviceGetAttribute(&cus, hipDeviceAttributeMultiprocessorCount, dev);
        hipFuncSetAttribute((const void*)mega, hipFuncAttributeMaxDynamicSharedMemorySize, LDS_BYTES);
        hipOccupancyMaxActiveBlocksPerMultiprocessor(&per_cu, (const void*)mega, NTHREADS, LDS_BYTES);
        if (per_cu < 1) per_cu = 1;
        grid = cus * 1;
        if (grid != 256) fprintf(stderr, "kernel_launch: grid %d (cus %d, per_cu %d)\n", grid, cus, per_cu);
    }
    Args a{};
    for (int i = 0; i < 39; ++i) a.in[i] = d_in[i];
    a.out = (float*)d_out; a.ws = (unsigned char*)d_ws;
#if ONE_LAUNCH
    (void)hipMemsetAsync((unsigned char*)d_ws + WS_BAR, 0, 16384, stream);
    int lo = 0, hi = NL * NPH;
    void* args[] = {&a, &lo, &hi};
    hipError_t e = hipLaunchCooperativeKernel((void*)mega, dim3(grid), dim3(NTHREADS), args, LDS_BYTES, stream);
    if (e != hipSuccess) fprintf(stderr, "cooperative launch failed: %s (grid %d)\n", hipGetErrorString(e), grid);
#else
    for (int s = 0; s < NL * NPH; ++s) hipLaunchKernelGGL(mega, dim3(grid), dim3(NTHREADS), LDS_BYTES, stream, a, s, s + 1);
#endif
}
```

```cpp
#include <hip/hip_runtime.h>
#include <hip/hip_cooperative_groups.h>
#include <cstdio>
#include <cstdint>
namespace cg = cooperative_groups;

#ifndef ONE_LAUNCH
#define ONE_LAUNCH 1
#endif

#define LAS __attribute__((address_space(3)))
typedef unsigned short bf16_t;
typedef short bf16x8 __attribute__((ext_vector_type(8)));
typedef float f32x4 __attribute__((ext_vector_type(4)));
typedef float f32x2 __attribute__((ext_vector_type(2)));
typedef unsigned u32x4 __attribute__((ext_vector_type(4)));
typedef unsigned u32x2 __attribute__((ext_vector_type(2)));

constexpr int T = 32768, SEQ = 2048, NB = 16, D = 2048, FF = 5632, DIN = 5120, NL = 2;
constexpr int C_RWKV = 0, C_ATT = 1792, C_S5 = 2560, C_HG = 3072;
constexpr int NTHREADS = 512, NWAVES = 8;

constexpr size_t SZ_UP = (size_t)2 * FF * D * 2, SZ_DN = (size_t)D * FF * 2, SZ_IN = (size_t)DIN * D * 2, SZ_LR = (size_t)1536 * 256 * 2,
                 SZ_GLU = (size_t)512 * 512 * 2, SZ_OUT = (size_t)D * D * 2;
constexpr size_t W_UP1 = 0, W_DN1 = W_UP1 + SZ_UP, W_IN = W_DN1 + SZ_DN, W_LR = W_IN + SZ_IN, W_GLU = W_LR + SZ_LR, W_OUT = W_GLU + SZ_GLU,
                 W_UP2 = W_OUT + SZ_OUT, W_DN2 = W_UP2 + SZ_UP, W_END = W_DN2 + SZ_DN;
constexpr size_t WS_XN = W_END, WS_BIG = WS_XN + (size_t)T * D * 2;
constexpr size_t WS_HID = WS_BIG;
constexpr size_t WS_PROJ = WS_BIG, WS_LRO = WS_PROJ + (size_t)T * DIN * 2, WS_ALR = WS_LRO + (size_t)T * 1536 * 2, WS_Z = WS_ALR + (size_t)T * 256 * 2,
                 WS_OR = WS_Z + (size_t)T * 512 * 2, WS_OH = WS_OR + (size_t)T * 512 * 4, WS_BON = WS_OH + (size_t)T * 512 * 4, WS_YC = WS_BON + (size_t)T * 8 * 4, WS_SS = WS_YC + (size_t)T * D * 2, WS_BAR = WS_SS + (size_t)3 * T * 4, WS_END = WS_BAR + 16384;
static_assert(WS_END <= (size_t)1 << 30, "workspace");
static_assert(WS_HID + (size_t)T * FF * 2 <= (size_t)1 << 30, "workspace");

constexpr int LDS_BYTES = 147456;

struct Args { const void* in[39]; float* out; unsigned char* ws; };
typedef const __attribute__((address_space(4))) Args& ArgsRef;

__device__ __forceinline__ unsigned pk2(float lo, float hi) { unsigned r; asm volatile("v_cvt_pk_bf16_f32 %0, %1, %2" : "=v"(r) : "v"(lo), "v"(hi)); return r; }
__device__ __forceinline__ float bflo(unsigned w) { return __uint_as_float(w << 16); }
__device__ __forceinline__ float bfhi(unsigned w) { return __uint_as_float(w & 0xffff0000u); }
__device__ __forceinline__ void unpack8(u32x4 q, float* f) { f[0] = bflo(q.x); f[1] = bfhi(q.x); f[2] = bflo(q.y); f[3] = bfhi(q.y); f[4] = bflo(q.z); f[5] = bfhi(q.z); f[6] = bflo(q.w); f[7] = bfhi(q.w); }
__device__ __forceinline__ u32x4 pack8(const float* f) { u32x4 o; o.x = pk2(f[0], f[1]); o.y = pk2(f[2], f[3]); o.z = pk2(f[4], f[5]); o.w = pk2(f[6], f[7]); return o; }
template <int CTRL> __device__ __forceinline__ float dpp(float x) { return __builtin_bit_cast(float, __builtin_amdgcn_mov_dpp(__builtin_bit_cast(int, x), CTRL, 0xf, 0xf, true)); }
constexpr int XOR1 = 0xB1, XOR2 = 0x4E, XOR7 = 0x141, XOR8 = 0x128;
__device__ __forceinline__ float red8(float v) { v += dpp<XOR1>(v); v += dpp<XOR2>(v); v += dpp<XOR7>(v); return v; }
__device__ __forceinline__ float red16(float v) { v = red8(v); v += dpp<XOR8>(v); return v; }
__device__ __forceinline__ float wave_sum(float v) {
#pragma unroll
    for (int o = 1; o < 64; o <<= 1) v += __shfl_xor(v, o);
    return v;
}
__device__ __forceinline__ float sigmoidf_(float x) { return 1.0f / (1.0f + __expf(-x)); }
__device__ __forceinline__ float siluf_(float x) { return x / (1.0f + __expf(-x)); }
__device__ __forceinline__ int opaque_tid() { int t = threadIdx.x; asm volatile("" : "+v"(t)); return t; }
__device__ __forceinline__ int opaque_bid() { int t = blockIdx.x; asm volatile("" : "+s"(t)); return t; }
__device__ __forceinline__ f32x2 pfma(f32x2 a, f32x2 b, f32x2 c) { return __builtin_elementwise_fma(a, b, c); }
#define LDS_FENCE() asm volatile("s_waitcnt lgkmcnt(0)" ::: "memory")
__device__ __forceinline__ void sincos_big(float x, float& sn, float& cs) {
    const float n = rintf(x * 0.15915494309189535f);
    float r = fmaf(-n, 6.28318548202514648f, x); r = fmaf(-n, -1.7484555e-7f, r);
    sn = __sinf(r); cs = __cosf(r);
}

namespace pg8 {
constexpr int BM = 256, BK = 64, HALF = 128, HTB = HALF * BK * 2, STAGE_BYTES = 8 * HTB, NXCD = 8, WGM = 8;
__host__ __device__ __forceinline__ int lds_byte(int r, int c) { const int st = (r >> 4) * 2 + (c >> 5), rr = r & 15, cc = c & 31, ob = rr * 64 + cc * 2; return st * 1024 + (ob ^ (((ob >> 9) & 1) << 5)); }
__host__ __device__ __forceinline__ void stage_rc(int b, int& R, int& C) { const int st = b / 1024, sb = b % 1024, swz = sb ^ (((sb >> 9) & 1) << 5); R = (st >> 1) * 16 + swz / 64; C = (st & 1) * 32 + (swz % 64) / 2; }
__host__ __device__ __forceinline__ int perm32(int rho) { const int n = rho >> 4, i = rho & 15; return 8 * (i >> 2) + 4 * n + (i & 3); }
struct Unit { int pm, pn; };
struct Gemm { const bf16_t* A; const bf16_t* Bt; int M, N, K; };
struct StaticOrder {
    int nM, nN, nwg, G, c;
    __device__ void init(int M, int N, int G_, int c_) { nM = M / BM; nN = N / BM; nwg = nM * nN; G = G_; c = c_; }
    __device__ bool next(int i, Unit& u) const {
        const long L = (long)i * G + c; if (L >= nwg) return false;
        int wgid = (int)L; { const int q = nwg / NXCD, r = nwg % NXCD, xcd = wgid % NXCD, off = wgid / NXCD; wgid = (xcd < r ? xcd * (q + 1) : r * (q + 1) + (xcd - r) * q) + off; }
        const int nig = WGM * nN, gid = wgid / nig, fm = gid * WGM, gsz = (nM - fm) < WGM ? (nM - fm) : WGM;
        u.pm = fm + ((wgid % nig) % gsz); u.pn = (wgid % nig) / gsz; return true;
    }
};
template <class Epi>
__device__ __forceinline__ void gemm_phase(LAS unsigned char* lds, const Gemm g, const StaticOrder S, const Epi E) {
    const int TID = opaque_tid(), BID = opaque_bid(); (void)TID; (void)BID;
    const int tid = TID, wid = __builtin_amdgcn_readfirstlane(tid >> 6), lane = tid & 63, wr = wid >> 2, wc = wid & 3, fr = lane & 15, fq = lane >> 4;
    const int K = g.K, nt = K / BK;
    unsigned voffA[2], voffB[2];
#pragma unroll
    for (int i = 0; i < 2; ++i) { int R, C; stage_rc(tid * 16 + i * 8192, R, C); const int Rb = Epi::PERM ? ((R & ~31) + perm32(R & 31)) : R;
        voffA[i] = (unsigned)(R * K + C) * 2u; voffB[i] = (unsigned)(Rb * K + C) * 2u; }
    const size_t kstep = (size_t)(BK * 2);
    const size_t hstep = (size_t)HALF * K * 2;
    const size_t tstep = 2 * hstep;
    const unsigned ldsw = (unsigned)wid * 1024u;
    const int aoff = lds_byte(wr * 64 + fr, fq * 8), boff = lds_byte(wc * 32 + fr, fq * 8);
#define PG8_SA(b, h) (((b) * 2 + (h)) * HTB)
#define PG8_SB(b, h) ((4 + (b) * 2 + (h)) * HTB)
#define PG8_STAGE(bufoff, gbase, voff) do { _Pragma("unroll") for (int _i = 0; _i < 2; ++_i) \
        __builtin_amdgcn_global_load_lds((const unsigned*)((const char*)(gbase) + (voff)[_i]), (LAS unsigned*)(lds + (bufoff) + ldsw + _i * 8192), 16, 0, 0); } while (0)
#define PG8_LDA(dst, b, h) do { _Pragma("unroll") for (int m = 0; m < 4; ++m) _Pragma("unroll") for (int k = 0; k < 2; ++k) dst[m][k] = *(const LAS bf16x8*)(lds + PG8_SA(b, h) + aoff + m * 2048 + k * 1024); } while (0)
#define PG8_LDB(dst, b, h) do { _Pragma("unroll") for (int n = 0; n < 2; ++n) _Pragma("unroll") for (int k = 0; k < 2; ++k) dst[n][k] = *(const LAS bf16x8*)(lds + PG8_SB(b, h) + boff + n * 2048 + k * 1024); } while (0)
#define PG8_MMA(ai, bj, At, Bt) do { __builtin_amdgcn_s_setprio(1); _Pragma("unroll") for (int m = 0; m < 4; ++m) _Pragma("unroll") for (int n = 0; n < 2; ++n) _Pragma("unroll") for (int k = 0; k < 2; ++k) \
        acc[ai][bj][m][n] = __builtin_amdgcn_mfma_f32_16x16x32_bf16(Bt[n][k], At[m][k], acc[ai][bj][m][n], 0, 0, 0); __builtin_amdgcn_s_setprio(0); } while (0)
#define PG8_WAIT_V(n) asm volatile("s_waitcnt vmcnt(" #n ")" ::: "memory")
#define PG8_WAIT_L(n) asm volatile("s_waitcnt lgkmcnt(" #n ")" ::: "memory")
#define PG8_BAR __builtin_amdgcn_s_barrier()
#define PG8_SCHED __builtin_amdgcn_sched_barrier(0)
    Unit cur, nxt; int ui = 0;
    if (!S.next(0, cur)) return;
    f32x4 acc[2][2][4][2];
#pragma unroll
    for (int a = 0; a < 2; ++a)
#pragma unroll
        for (int b = 0; b < 2; ++b)
#pragma unroll
            for (int m = 0; m < 4; ++m)
#pragma unroll
                for (int n = 0; n < 2; ++n) acc[a][b][m][n] = (f32x4){0.f, 0.f, 0.f, 0.f};
    bf16x8 At[4][2], B0[2][2], B1[2][2];
    const char* cA = (const char*)g.A + (size_t)cur.pm * tstep; const char* cB = (const char*)g.Bt + (size_t)cur.pn * tstep;
    PG8_STAGE(PG8_SB(0, 0), cB, voffB); PG8_STAGE(PG8_SA(0, 0), cA, voffA); PG8_STAGE(PG8_SB(0, 1), cB + hstep, voffB); PG8_STAGE(PG8_SA(0, 1), cA + hstep, voffA);
    if (wr == 1) PG8_BAR;
    PG8_WAIT_V(4); PG8_BAR;
    PG8_STAGE(PG8_SB(1, 0), cB + kstep, voffB); PG8_STAGE(PG8_SA(1, 0), cA + kstep, voffA); PG8_STAGE(PG8_SB(1, 1), cB + hstep + kstep, voffB);
    PG8_WAIT_V(6); PG8_BAR;
    for (;;) {
        const bool has_next = S.next(ui + 1, nxt);
        const char* nA = has_next ? (const char*)g.A + (size_t)nxt.pm * tstep : cA; const char* nB = has_next ? (const char*)g.Bt + (size_t)nxt.pn * tstep : cB;
#pragma unroll 1
        for (int t = 0; t < nt; t += 2) {
            const bool last = (t == nt - 2);
            const char* a1 = cA + (size_t)(t + 1) * kstep;
            const char* a2 = last ? nA : cA + (size_t)(t + 2) * kstep; const char* b2 = last ? nB : cB + (size_t)(t + 2) * kstep;
            const char* a3 = a2 + kstep; const char* b3 = b2 + kstep;
            PG8_LDB(B0, 0, 0); PG8_SCHED; PG8_LDA(At, 0, 0); PG8_STAGE(PG8_SA(1, 1), a1 + hstep, voffA);
            PG8_WAIT_L(8); PG8_BAR; PG8_WAIT_L(0); PG8_MMA(0, 0, At, B0); PG8_BAR; PG8_SCHED;
            PG8_LDB(B1, 0, 1); PG8_STAGE(PG8_SB(0, 0), b2, voffB);
            PG8_BAR; PG8_WAIT_L(0); PG8_MMA(0, 1, At, B1); PG8_BAR;
            PG8_LDA(At, 0, 1); PG8_STAGE(PG8_SA(0, 0), a2, voffA);
            PG8_BAR; PG8_WAIT_L(0); PG8_MMA(1, 0, At, B0); PG8_BAR; PG8_SCHED;
            PG8_STAGE(PG8_SB(0, 1), b2 + hstep, voffB);
            PG8_WAIT_V(6); PG8_BAR; PG8_MMA(1, 1, At, B1); PG8_BAR;
            PG8_LDB(B0, 1, 0); PG8_SCHED; PG8_LDA(At, 1, 0); PG8_STAGE(PG8_SA(0, 1), a2 + hstep, voffA);
            PG8_WAIT_L(8); PG8_BAR; PG8_WAIT_L(0); PG8_MMA(0, 0, At, B0); PG8_BAR; PG8_SCHED;
            PG8_LDB(B1, 1, 1); PG8_STAGE(PG8_SB(1, 0), b3, voffB);
            PG8_BAR; PG8_WAIT_L(0); PG8_MMA(0, 1, At, B1); PG8_BAR;
            PG8_LDA(At, 1, 1); PG8_STAGE(PG8_SA(1, 0), a3, voffA);
            PG8_BAR; PG8_WAIT_L(0); PG8_MMA(1, 0, At, B0); PG8_BAR; PG8_SCHED;
            PG8_STAGE(PG8_SB(1, 1), b3 + hstep, voffB);
            PG8_WAIT_V(6); PG8_BAR; PG8_MMA(1, 1, At, B1); PG8_BAR;
        }
        E(acc, cur, wr, wc, fr, fq);
        if (!has_next) break;
#pragma unroll
        for (int a = 0; a < 2; ++a)
#pragma unroll
            for (int b = 0; b < 2; ++b)
#pragma unroll
                for (int m = 0; m < 4; ++m)
#pragma unroll
                    for (int n = 0; n < 2; ++n) acc[a][b][m][n] = (f32x4){0.f, 0.f, 0.f, 0.f};
        cur = nxt; cA = nA; cB = nB; ++ui;
    }
    PG8_WAIT_V(0);
    if (wr == 0) PG8_BAR;
    PG8_BAR;
#undef PG8_SA
#undef PG8_SB
#undef PG8_STAGE
#undef PG8_LDA
#undef PG8_LDB
#undef PG8_MMA
#undef PG8_WAIT_V
#undef PG8_WAIT_L
#undef PG8_BAR
#undef PG8_SCHED
}

struct EpiSwiGLU {
    static constexpr bool PERM = true;
    bf16_t* H; const float* SS;
    __device__ __forceinline__ void operator()(const f32x4 (&acc)[2][2][4][2], const Unit& u, int wr, int wc, int fr, int fq) const {
        const int row0 = u.pm * BM + wr * 64 + fr, col0 = u.pn * 128 + wc * 32 + 8 * fq;
#pragma unroll
        for (int ai = 0; ai < 2; ++ai)
#pragma unroll
            for (int m = 0; m < 4; ++m) {
                const float rs = 1.0f / sqrtf(SS[row0 + ai * HALF + m * 16] * (1.0f / D) + 1e-6f);
                float v[8];
#pragma unroll
                for (int n = 0; n < 2; ++n)
#pragma unroll
                    for (int j = 0; j < 4; ++j) { const float gt = acc[ai][0][m][n][j] * rs, up = acc[ai][1][m][n][j] * rs; v[4 * n + j] = siluf_(gt) * up; }
                *(u32x4*)(H + (size_t)(row0 + ai * HALF + m * 16) * FF + col0) = pack8(v);
            }
    }
};
template <bool HALFSTEP> struct EpiResidual {
    static constexpr bool PERM = false;
    static constexpr float scale = HALFSTEP ? 0.5f : 1.0f;
    const float* base; float* out; bf16_t* XN; float* SS;
    __device__ __forceinline__ void operator()(const f32x4 (&acc)[2][2][4][2], const Unit& u, int wr, int wc, int fr, int fq) const {
        const int row0 = u.pm * BM + wr * 64 + fr, col0 = u.pn * BM + wc * 32 + 4 * fq;
#pragma unroll
        for (int ai = 0; ai < 2; ++ai)
#pragma unroll
            for (int m = 0; m < 4; ++m) { const int row = row0 + ai * HALF + m * 16; const size_t ro = (size_t)row * D + col0; float ss = 0.f;
#pragma unroll
                for (int bj = 0; bj < 2; ++bj)
#pragma unroll
                    for (int n = 0; n < 2; ++n) { const f32x4 b = *(const f32x4*)(base + ro + bj * HALF + n * 16); const f32x4 r = b + acc[ai][bj][m][n] * scale; *(f32x4*)(out + ro + bj * HALF + n * 16) = r;
                        if (XN) { u32x2 w; w.x = pk2(r.x, r.y); w.y = pk2(r.z, r.w); *(u32x2*)(XN + ro + bj * HALF + n * 16) = w; ss += (r.x * r.x + r.y * r.y) + (r.z * r.z + r.w * r.w); } }
                if (XN) { ss += __shfl_xor(ss, 16); ss += __shfl_xor(ss, 32); if (fq == 0) atomicAdd(SS + row, ss); } }
    }
};
struct EpiBf16 {
    static constexpr bool PERM = true;
    bf16_t* O; int ldc; const float* SS;
    __device__ __forceinline__ void operator()(const f32x4 (&acc)[2][2][4][2], const Unit& u, int wr, int wc, int fr, int fq) const {
        const int row0 = u.pm * BM + wr * 64 + fr, col0 = u.pn * BM + wc * 32 + 8 * fq;
#pragma unroll
        for (int ai = 0; ai < 2; ++ai)
#pragma unroll
            for (int m = 0; m < 4; ++m) { bf16_t* rowp = O + (size_t)(row0 + ai * HALF + m * 16) * ldc + col0;
                const float rs = 1.0f / sqrtf(SS[row0 + ai * HALF + m * 16] * (1.0f / D) + 1e-6f);
#pragma unroll
                for (int bj = 0; bj < 2; ++bj) { const f32x4 v0 = acc[ai][bj][m][0] * rs, v1 = acc[ai][bj][m][1] * rs;
                    u32x4 w; w.x = pk2(v0[0], v0[1]); w.y = pk2(v0[2], v0[3]); w.z = pk2(v1[0], v1[1]); w.w = pk2(v1[2], v1[3]);
                    *(u32x4*)(rowp + bj * HALF) = w; } }
    }
};
struct EpiLR {
    static constexpr bool PERM = true;
    bf16_t* O; const float* w0; const float* a0;
    template <int KIND> __device__ __forceinline__ void body(const f32x4 (&acc)[2][2][4][2], const float* bp, int row0, int col0) const {
#pragma unroll
        for (int bj = 0; bj < 2; ++bj) {
            f32x4 b0 = (f32x4){0.f, 0.f, 0.f, 0.f}, b1 = b0;
            if (KIND < 2) { b0 = *(const f32x4*)(bp + bj * HALF); b1 = *(const f32x4*)(bp + bj * HALF + 4); }
#pragma unroll
            for (int ai = 0; ai < 2; ++ai)
#pragma unroll
                for (int m = 0; m < 4; ++m) {
                    u32x4 w;
#pragma unroll
                    for (int n = 0; n < 2; ++n) {
                        float r[4];
#pragma unroll
                        for (int j = 0; j < 4; ++j) { const float x = acc[ai][bj][m][n][j] + (n == 0 ? b0[j] : b1[j]);
                            if (KIND == 0) { const float e = __expf(-x); r[j] = -0.60653065971f / (1.0f + e); }
                            else if (KIND == 1) r[j] = 1.0f / (1.0f + __expf(-x)); else r[j] = x; }
                        if (n == 0) { w.x = pk2(r[0], r[1]); w.y = pk2(r[2], r[3]); } else { w.z = pk2(r[0], r[1]); w.w = pk2(r[2], r[3]); }
                    }
                    *(u32x4*)(O + (size_t)(row0 + ai * HALF + m * 16) * 1536 + col0 + bj * HALF) = w;
                }
        }
    }
    __device__ __forceinline__ void operator()(const f32x4 (&acc)[2][2][4][2], const Unit& u, int wr, int wc, int fr, int fq) const {
        const int row0 = u.pm * BM + wr * 64 + fr, col0 = u.pn * BM + wc * 32 + 8 * fq, kind = u.pn >> 1, f0 = col0 - 512 * kind;
        if (kind == 0) body<0>(acc, w0 + f0, row0, col0); else if (kind == 1) body<1>(acc, a0 + f0, row0, col0); else body<2>(acc, nullptr, row0, col0);
    }
};
struct EpiGLU {
    static constexpr bool PERM = true;
    const bf16_t* Z; bf16_t* Y; const float* b;
    __device__ __forceinline__ void operator()(const f32x4 (&acc)[2][2][4][2], const Unit& u, int wr, int wc, int fr, int fq) const {
        const int row0 = u.pm * BM + wr * 64 + fr, col0 = u.pn * BM + wc * 32 + 8 * fq;
#pragma unroll
        for (int bj = 0; bj < 2; ++bj) {
            const f32x4 bias0 = *(const f32x4*)(b + col0 + bj * HALF), bias1 = *(const f32x4*)(b + col0 + bj * HALF + 4);
#pragma unroll
            for (int ai = 0; ai < 2; ++ai)
#pragma unroll
                for (int m = 0; m < 4; ++m) { const size_t r = (size_t)(row0 + ai * HALF + m * 16);
                    float z[8], v[8]; unpack8(*(const u32x4*)(Z + r * 512 + col0 + bj * HALF), z);
#pragma unroll
                    for (int n = 0; n < 2; ++n)
#pragma unroll
                        for (int j = 0; j < 4; ++j) v[4 * n + j] = z[4 * n + j] * sigmoidf_(acc[ai][bj][m][n][j] + (n == 0 ? bias0[j] : bias1[j]));
                    *(u32x4*)(Y + r * D + 1024 + col0 + bj * HALF) = pack8(v); }
        }
    }
};
}

template <class Epi> __device__ __forceinline__ void run_gemm(LAS unsigned char* lds, const bf16_t* A, const bf16_t* Bt, int N, int K, const Epi E) {
    pg8::Gemm g; g.A = A; g.Bt = Bt; g.M = T; g.N = N; g.K = K;
    pg8::StaticOrder S; S.init(T, N, gridDim.x, opaque_bid());
    pg8::gemm_phase<Epi>(lds, g, S, E);
}

__device__ __forceinline__ void tr_item(const float* W, int ldw, int k0, int n0, const float* gs, bf16_t* Dst, int ldd, int drow0, int dk0, LAS float* scr, int lane) {
    if (W) {
        f32x4 v[8];
#pragma unroll
        for (int i = 0; i < 8; ++i) { const int kk = 8 * i + (lane >> 3); v[i] = *(const f32x4*)(W + (size_t)(k0 + kk) * ldw + n0 + 4 * (lane & 7)); }
#pragma unroll
        for (int i = 0; i < 8; ++i) { const int kk = 8 * i + (lane >> 3); f32x4 x = v[i]; if (gs) x = x * gs[k0 + kk];
            LAS float* d = scr + kk * 33 + 4 * (lane & 7); d[0] = x.x; d[1] = x.y; d[2] = x.z; d[3] = x.w; }
    } else {
#pragma unroll 8
        for (int i = 0; i < 32; ++i) { const int kk = 2 * i + (lane >> 5); scr[kk * 33 + (lane & 31)] = 0.f; }
    }
    LDS_FENCE();
    const int c = lane & 7;
#pragma unroll
    for (int j = 0; j < 4; ++j) { const int n = (lane >> 3) + 8 * j; const LAS float* s = scr + (8 * c) * 33 + n;
        u32x4 o; o.x = pk2(s[0 * 33], s[1 * 33]); o.y = pk2(s[2 * 33], s[3 * 33]); o.z = pk2(s[4 * 33], s[5 * 33]); o.w = pk2(s[6 * 33], s[7 * 33]);
        *(u32x4*)(Dst + (size_t)(drow0 + n) * ldd + dk0 + k0 - 0 + 8 * c - 0) = o; }
    LDS_FENCE();
}

__device__ __forceinline__ void conv_phase(ArgsRef a, int l, LAS unsigned char* lds) {
    const int TID = opaque_tid(), BID = opaque_bid(); (void)TID; (void)BID;
    const int wave = TID >> 6, lane = TID & 63;
    LAS float* scr = (LAS float*)(lds + wave * 8704);
    const int gw = BID * NWAVES + wave, NGW = gridDim.x * NWAVES;
    unsigned char* ws = a.ws;
    constexpr int I_GU = (D / 64) * (FF / 32), I_DN = (FF / 64) * (D / 32), I_IN = (D / 64) * (DIN / 32), I_OUT = (D / 64) * (D / 32), I_GLU = 8 * 16, I_LR = 48 * 4;
    constexpr int NITEMS = 6 * I_GU + I_IN + I_OUT + I_GLU + I_LR;
    static_assert(I_GU == I_DN, "items");
    for (int it = gw; it < NITEMS; it += NGW) {
        int r = it;
        if (r < 6 * I_GU) {
            const int which = r / I_GU; r -= which * I_GU;
            const int f = which >= 3, m = which % 3;
            if (m < 2) {
                const float* W = (const float*)a.in[(f ? 36 : 3) + m] + (size_t)l * D * FF;
                const float* gs = (const float*)a.in[f ? 35 : 2] + (size_t)l * D;
                bf16_t* dst = (bf16_t*)(ws + (f ? W_UP2 : W_UP1));
                const int nblk = FF / 32, kb = r / nblk, nb = r % nblk, n0 = 32 * nb;
                tr_item(W, FF, 64 * kb, n0, gs, dst, D, (n0 >> 7) * 256 + (n0 & 127) + 128 * m, 0, scr, lane);
            } else {
                const float* W = (const float*)a.in[f ? 38 : 5] + (size_t)l * FF * D;
                bf16_t* dst = (bf16_t*)(ws + (f ? W_DN2 : W_DN1));
                const int nblk = D / 32, kb = r / nblk, nb = r % nblk;
                tr_item(W, D, 64 * kb, 32 * nb, nullptr, dst, FF, 32 * nb, 0, scr, lane);
            }
            continue;
        }
        r -= 6 * I_GU;
        if (r < I_IN) { const int nblk = DIN / 32, kb = r / nblk, nb = r % nblk;
            tr_item((const float*)a.in[7] + (size_t)l * D * DIN, DIN, 64 * kb, 32 * nb, (const float*)a.in[6] + (size_t)l * D, (bf16_t*)(ws + W_IN), D, 32 * nb, 0, scr, lane); continue; }
        r -= I_IN;
        if (r < I_OUT) { const int nblk = D / 32, kb = r / nblk, nb = r % nblk;
            tr_item((const float*)a.in[34] + (size_t)l * D * D, D, 64 * kb, 32 * nb, nullptr, (bf16_t*)(ws + W_OUT), D, 32 * nb, 0, scr, lane); continue; }
        r -= I_OUT;
        if (r < I_GLU) { const int kb = r / 16, nb = r % 16;
            tr_item((const float*)a.in[30] + (size_t)l * 512 * 512, 512, 64 * kb, 32 * nb, nullptr, (bf16_t*)(ws + W_GLU), 512, 32 * nb, 0, scr, lane); continue; }
        r -= I_GLU;
        {
            const int nb = r >> 2, kb = r & 3, kind = nb >> 4, nn0 = 32 * (nb & 15);
            const float* W = nullptr; int k0 = 0;
            if (kind == 0 && kb == 0) { W = (const float*)a.in[10] + (size_t)l * 64 * 512; k0 = 0; }
            else if (kind == 1 && kb == 1) { W = (const float*)a.in[12] + (size_t)l * 64 * 512; k0 = 0; }
            else if (kind == 2 && kb >= 2) { W = (const float*)a.in[13] + (size_t)l * 128 * 512; k0 = 64 * (kb - 2); }
            tr_item(W, 512, k0, nn0, nullptr, (bf16_t*)(ws + W_LR), 256, 32 * nb, 64 * kb - k0, scr, lane);
        }
    }
}

__device__ __forceinline__ void norm_phase(const float* x, bf16_t* XN, float* SS) {
    const int TID = opaque_tid(), BID = opaque_bid(); (void)TID; (void)BID;
    const int wave = TID >> 6, lane = TID & 63;
    const int gw = BID * NWAVES + wave, NGW = gridDim.x * NWAVES;
    for (int m = gw; m < T; m += NGW) {
        const f32x4* xr = (const f32x4*)(x + (size_t)m * D) + lane;
        f32x4 v[8]; float s = 0.f;
#pragma unroll
        for (int j = 0; j < 8; ++j) { v[j] = xr[64 * j]; s += (v[j].x * v[j].x + v[j].y * v[j].y) + (v[j].z * v[j].z + v[j].w * v[j].w); }
        s = wave_sum(s); if (lane == 0) SS[m] = s;
        u32x2* o = (u32x2*)(XN + (size_t)m * D) + lane;
#pragma unroll
        for (int j = 0; j < 8; ++j) { u32x2 w; w.x = pk2(v[j].x, v[j].y); w.y = pk2(v[j].z, v[j].w); o[64 * j] = w; }
    }
}

__device__ __forceinline__ void zero_phase(float* p, int n) {
    const int TID = opaque_tid(), BID = opaque_bid();
    for (int i = BID * NTHREADS + TID; i < n; i += gridDim.x * NTHREADS) p[i] = 0.f;
}
__device__ __forceinline__ void alr_phase(ArgsRef a, int l) {
    const int TID = opaque_tid(), BID = opaque_bid(); (void)TID; (void)BID;
    const bf16_t* P = (const bf16_t*)(a.ws + WS_PROJ); bf16_t* ALR = (bf16_t*)(a.ws + WS_ALR);
    const float* mu = (const float*)a.in[8] + (size_t)l * 1792 + 1536;
    const int gt = BID * NTHREADS + TID, NGT = gridDim.x * NTHREADS;
    for (int it = gt; it < T * 32; it += NGT) {
        const int t = it >> 5, cg = it & 31, c0 = 8 * cg;
        float cur[8], prv[8], o[8];
        unpack8(*(const u32x4*)(P + (size_t)t * DIN + 1536 + c0), cur);
        if ((t & (SEQ - 1)) != 0) unpack8(*(const u32x4*)(P + (size_t)(t - 1) * DIN + 1536 + c0), prv);
        else {
#pragma unroll
            for (int j = 0; j < 8; ++j) prv[j] = 0.f; }
#pragma unroll
        for (int j = 0; j < 8; ++j) { const float v = cur[j] + (prv[j] - cur[j]) * mu[c0 + j];
            o[j] = c0 < 64 ? tanhf(v) : (c0 < 128 ? v : sigmoidf_(v)); }
        *(u32x4*)(ALR + (size_t)t * 256 + c0) = pack8(o);
    }
}

__device__ __forceinline__ void rwkv_phase(ArgsRef a, int l, LAS unsigned char* lds) {
    const int TID = opaque_tid(), BID = opaque_bid(); (void)TID; (void)BID;
    const bf16_t* P = (const bf16_t*)(a.ws + WS_PROJ); const bf16_t* LR = (const bf16_t*)(a.ws + WS_LRO);
    float* OR = (float*)(a.ws + WS_OR); float* BON = (float*)(a.ws + WS_BON);
    LAS float* sR = (LAS float*)lds; LAS float* sW = sR + 4096; LAS float* sK = sW + 4096; LAS float* sKK = sK + 4096; LAS float* sB = sKK + 4096;
    LAS float* sV = sB + 4096; LAS float* sO = sV + 2048;
    const int tid = TID, wave = tid >> 6, lane = tid & 63;
    const int tt = tid >> 3, cg = tid & 7;
    for (int job = BID; job < 256; job += gridDim.x) {
        const int b = job >> 4, h = (job >> 1) & 7, half = job & 1;
        const int c0 = 64 * h + 8 * cg;
        float mur[8], muk[8], muv[8], kkw[8], kaw[8], rkw[8];
#pragma unroll
        for (int j = 0; j < 8; ++j) {
            mur[j] = ((const float*)a.in[8])[(size_t)l * 1792 + c0 + j]; muk[j] = ((const float*)a.in[8])[(size_t)l * 1792 + 512 + c0 + j]; muv[j] = ((const float*)a.in[8])[(size_t)l * 1792 + 1024 + c0 + j];
            kkw[j] = ((const float*)a.in[14])[(size_t)l * 512 + c0 + j]; kaw[j] = ((const float*)a.in[15])[(size_t)l * 512 + c0 + j]; rkw[j] = ((const float*)a.in[16])[(size_t)l * 512 + c0 + j]; }
        f32x2 stA = (f32x2){0.f, 0.f}, stB = stA;
        const int rloc = 4 * wave + (lane >> 4), jq = lane & 15;
        for (int ch = 0; ch < SEQ / 64; ++ch) {
            __syncthreads();
            {
                const int s = ch * 64 + tt; const size_t t = (size_t)b * SEQ + s;
                float r[8], k[8], v[8], pr[8], ld[8], av[8];
                unpack8(*(const u32x4*)(P + t * DIN + c0), r); unpack8(*(const u32x4*)(P + t * DIN + 512 + c0), k); unpack8(*(const u32x4*)(P + t * DIN + 1024 + c0), v);
                if (s != 0) {
                    unpack8(*(const u32x4*)(P + (t - 1) * DIN + c0), pr);
#pragma unroll
                    for (int j = 0; j < 8; ++j) r[j] += (pr[j] - r[j]) * mur[j];
                    unpack8(*(const u32x4*)(P + (t - 1) * DIN + 512 + c0), pr);
#pragma unroll
                    for (int j = 0; j < 8; ++j) k[j] += (pr[j] - k[j]) * muk[j];
                    unpack8(*(const u32x4*)(P + (t - 1) * DIN + 1024 + c0), pr);
#pragma unroll
                    for (int j = 0; j < 8; ++j) v[j] += (pr[j] - v[j]) * muv[j];
                } else {
#pragma unroll
                    for (int j = 0; j < 8; ++j) { r[j] -= r[j] * mur[j]; k[j] -= k[j] * muk[j]; v[j] -= v[j] * muv[j]; }
                }
                unpack8(*(const u32x4*)(LR + t * 1536 + c0), ld); unpack8(*(const u32x4*)(LR + t * 1536 + 512 + c0), av);
                float kk[8], ss = 0.f, bp = 0.f;
#pragma unroll
                for (int j = 0; j < 8; ++j) { kk[j] = k[j] * kkw[j]; ss += kk[j] * kk[j]; }
                ss = red8(ss);
                const float inv = 1.0f / sqrtf(fmaxf(ss, 1e-24f));
                float w8[8], k8[8], b8[8];
#pragma unroll
                for (int j = 0; j < 8; ++j) { kk[j] *= inv; k8[j] = k[j] * (1.0f + (av[j] - 1.0f) * kaw[j]); b8[j] = kk[j] * av[j]; w8[j] = __expf(ld[j]); bp += r[j] * k8[j] * rkw[j]; }
                bp = red8(bp);
                if (half == 0 && cg == 0) BON[t * 8 + h] = bp;
                LAS float* d;
                d = sR + tt * 64 + 8 * cg; *(LAS f32x4*)d = (f32x4){r[0], r[1], r[2], r[3]}; *(LAS f32x4*)(d + 4) = (f32x4){r[4], r[5], r[6], r[7]};
                d = sW + tt * 64 + 8 * cg; *(LAS f32x4*)d = (f32x4){w8[0], w8[1], w8[2], w8[3]}; *(LAS f32x4*)(d + 4) = (f32x4){w8[4], w8[5], w8[6], w8[7]};
                d = sK + tt * 64 + 8 * cg; *(LAS f32x4*)d = (f32x4){k8[0], k8[1], k8[2], k8[3]}; *(LAS f32x4*)(d + 4) = (f32x4){k8[4], k8[5], k8[6], k8[7]};
                d = sKK + tt * 64 + 8 * cg; *(LAS f32x4*)d = (f32x4){kk[0], kk[1], kk[2], kk[3]}; *(LAS f32x4*)(d + 4) = (f32x4){kk[4], kk[5], kk[6], kk[7]};
                d = sB + tt * 64 + 8 * cg; *(LAS f32x4*)d = (f32x4){b8[0], b8[1], b8[2], b8[3]}; *(LAS f32x4*)(d + 4) = (f32x4){b8[4], b8[5], b8[6], b8[7]};
                if ((cg >> 2) == half) { d = sV + tt * 32 + 8 * (cg & 3); *(LAS f32x4*)d = (f32x4){v[0], v[1], v[2], v[3]}; *(LAS f32x4*)(d + 4) = (f32x4){v[4], v[5], v[6], v[7]}; }
            }
            __syncthreads();
            {
                f32x4 w4 = *(const LAS f32x4*)(sW + 4 * jq), kk4 = *(const LAS f32x4*)(sKK + 4 * jq), b4 = *(const LAS f32x4*)(sB + 4 * jq),
                      k4 = *(const LAS f32x4*)(sK + 4 * jq), r4 = *(const LAS f32x4*)(sR + 4 * jq);
                float vi = sV[rloc];
                f32x2 pyp = (f32x2){0.f, 0.f}; float ykeep = 0.f;
#pragma unroll 1
                for (int s16 = 0; s16 < 64; s16 += 16) {
#pragma unroll
                    for (int u = 0; u < 16; ++u) {
                        const int sn = (s16 + u + 1) & 63;
                        const f32x4 nw4 = *(const LAS f32x4*)(sW + sn * 64 + 4 * jq), nkk4 = *(const LAS f32x4*)(sKK + sn * 64 + 4 * jq), nb4 = *(const LAS f32x4*)(sB + sn * 64 + 4 * jq),
                                    nk4 = *(const LAS f32x4*)(sK + sn * 64 + 4 * jq), nr4 = *(const LAS f32x4*)(sR + sn * 64 + 4 * jq);
                        const float nvi = sV[sn * 32 + rloc];
                        const f32x2 pa = pfma(stB, (f32x2){kk4.z, kk4.w}, stA * (f32x2){kk4.x, kk4.y});
                        float av = pa.x + pa.y, yv = pyp.x + pyp.y;
                        av += dpp<XOR1>(av); yv += dpp<XOR1>(yv); av += dpp<XOR2>(av); yv += dpp<XOR2>(yv);
                        av += dpp<XOR7>(av); yv += dpp<XOR7>(yv); av += dpp<XOR8>(av); yv += dpp<XOR8>(yv);
                        if (u > 0) ykeep = (jq == u - 1) ? yv : ykeep;
                        else if (s16 > 0) { ykeep = (jq == 15) ? yv : ykeep; sO[(s16 - 16 + jq) * 32 + rloc] = ykeep; }
                        const float sa = -av;
                        const f32x2 sa2 = (f32x2){sa, sa}, vi2 = (f32x2){vi, vi};
                        const f32x2 tA = pfma(vi2, (f32x2){k4.x, k4.y}, sa2 * (f32x2){b4.x, b4.y}), tB = pfma(vi2, (f32x2){k4.z, k4.w}, sa2 * (f32x2){b4.z, b4.w});
                        stA = pfma(stA, (f32x2){w4.x, w4.y}, tA); stB = pfma(stB, (f32x2){w4.z, w4.w}, tB);
                        pyp = pfma(stB, (f32x2){r4.z, r4.w}, stA * (f32x2){r4.x, r4.y});
                        w4 = nw4; kk4 = nkk4; b4 = nb4; k4 = nk4; r4 = nr4; vi = nvi;
                    }
                }
                float yv = red16(pyp.x + pyp.y);
                ykeep = (jq == 15) ? yv : ykeep; sO[(48 + jq) * 32 + rloc] = ykeep;
            }
            __syncthreads();
            {
                const int s = ch * 64 + tt; const size_t t = (size_t)b * SEQ + s;
                *(f32x4*)(OR + t * 512 + 64 * h + 32 * half + 4 * cg) = *(const LAS f32x4*)(sO + tt * 32 + 4 * cg);
            }
        }
    }
    __syncthreads();
}

__device__ __forceinline__ void hgrn_phase(ArgsRef a, int l, LAS unsigned char* lds) {
    const int TID = opaque_tid(), BID = opaque_bid(); (void)TID; (void)BID;
    const bf16_t* P = (const bf16_t*)(a.ws + WS_PROJ); float* OH = (float*)(a.ws + WS_OH);
    LAS float* sQ = (LAS float*)lds; LAS float* sF = sQ + 4096; LAS float* sV = sF + 4096; LAS float* sO = sV + 2048;
    const int tid = TID, wave = tid >> 6, lane = tid & 63;
    const int tt = tid >> 3, cg = tid & 7;
    const float* lbp = (const float*)a.in[32];
    for (int job = BID; job < 256; job += gridDim.x) {
        const int b = job >> 4, h = (job >> 1) & 7, half = job & 1;
        const int c0 = 64 * h + 8 * cg;
        float lb[8];
#pragma unroll
        for (int j = 0; j < 8; ++j) lb[j] = (l == 0) ? 0.f : sigmoidf_(lbp[512 + c0 + j] - lbp[c0 + j]);
        f32x2 stA = (f32x2){0.f, 0.f}, stB = stA;
        const int cloc = 4 * wave + (lane >> 4), dq = lane & 15;
        for (int ch = 0; ch < SEQ / 64; ++ch) {
            __syncthreads();
            {
                const int s = ch * 64 + tt; const size_t t = (size_t)b * SEQ + s;
                float q[8], f[8];
                unpack8(*(const u32x4*)(P + t * DIN + C_HG + c0), q); unpack8(*(const u32x4*)(P + t * DIN + C_HG + 512 + c0), f);
#pragma unroll
                for (int j = 0; j < 8; ++j) { q[j] = siluf_(q[j]) * 0.125f; f[j] = lb[j] + (1.0f - lb[j]) * sigmoidf_(f[j]); }
                LAS float* d;
                d = sQ + tt * 64 + 8 * cg; *(LAS f32x4*)d = (f32x4){q[0], q[1], q[2], q[3]}; *(LAS f32x4*)(d + 4) = (f32x4){q[4], q[5], q[6], q[7]};
                d = sF + tt * 64 + 8 * cg; *(LAS f32x4*)d = (f32x4){f[0], f[1], f[2], f[3]}; *(LAS f32x4*)(d + 4) = (f32x4){f[4], f[5], f[6], f[7]};
                const u32x2 vv = *(const u32x2*)(P + t * DIN + C_HG + 1024 + 64 * h + 32 * half + 4 * cg);
                *(LAS f32x4*)(sV + tt * 32 + 4 * cg) = (f32x4){bflo(vv.x), bfhi(vv.x), bflo(vv.y), bfhi(vv.y)};
            }
            __syncthreads();
            {
                f32x4 f4 = *(const LAS f32x4*)(sF + 4 * dq), q4 = *(const LAS f32x4*)(sQ + 4 * dq);
                float vi = sV[cloc];
                float ykeep = 0.f;
#pragma unroll 1
                for (int s16 = 0; s16 < 64; s16 += 16) {
#pragma unroll
                    for (int u = 0; u < 16; ++u) {
                        const int sn = (s16 + u + 1) & 63;
                        const f32x4 nf4 = *(const LAS f32x4*)(sF + sn * 64 + 4 * dq), nq4 = *(const LAS f32x4*)(sQ + sn * 64 + 4 * dq);
                        const float nvi = sV[sn * 32 + cloc];
                        const f32x2 vi2 = (f32x2){vi, vi};
                        stA = pfma((f32x2){f4.x, f4.y}, stA - vi2, vi2); stB = pfma((f32x2){f4.z, f4.w}, stB - vi2, vi2);
                        const f32x2 py = pfma(stB, (f32x2){q4.z, q4.w}, stA * (f32x2){q4.x, q4.y});
                        const float y = red16(py.x + py.y);
                        ykeep = (dq == u) ? y : ykeep;
                        f4 = nf4; q4 = nq4; vi = nvi;
                    }
                    sO[(s16 + dq) * 32 + cloc] = ykeep;
                }
            }
            __syncthreads();
            {
                const int s = ch * 64 + tt; const size_t t = (size_t)b * SEQ + s;
                *(f32x4*)(OH + t * 512 + 64 * h + 32 * half + 4 * cg) = *(const LAS f32x4*)(sO + tt * 32 + 4 * cg);
            }
        }
    }
    __syncthreads();
}

__device__ __forceinline__ void post_phase(ArgsRef a, int l) {
    const int TID = opaque_tid(), BID = opaque_bid(); (void)TID; (void)BID;
    const bf16_t* P = (const bf16_t*)(a.ws + WS_PROJ); const bf16_t* LR = (const bf16_t*)(a.ws + WS_LRO);
    const float* OR = (const float*)(a.ws + WS_OR); const float* OH = (const float*)(a.ws + WS_OH); const float* BON = (const float*)(a.ws + WS_BON);
    bf16_t* Y = (bf16_t*)(a.ws + WS_YC);
    const float* muv = (const float*)a.in[8] + (size_t)l * 1792 + 1024;
    const float* lnw = (const float*)a.in[17] + (size_t)l * 512; const float* lnb = (const float*)a.in[18] + (size_t)l * 512;
    const float* gn = (const float*)a.in[33] + (size_t)l * 64;
    const int gt = BID * NTHREADS + TID, NGT = gridDim.x * NTHREADS;
    for (int it = gt; it < T * 128; it += NGT) {
        const int cg = it & 7, hh = (it >> 3) & 15; const size_t t = (size_t)(it >> 7);
        float o[8], y[8];
        if (hh < 8) {
            const int c0 = 64 * hh + 8 * cg;
            const f32x4 o0 = *(const f32x4*)(OR + t * 512 + c0), o1 = *(const f32x4*)(OR + t * 512 + c0 + 4);
            o[0] = o0.x; o[1] = o0.y; o[2] = o0.z; o[3] = o0.w; o[4] = o1.x; o[5] = o1.y; o[6] = o1.z; o[7] = o1.w;
            float s = 0.f;
#pragma unroll
            for (int j = 0; j < 8; ++j) s += o[j];
            const float mean = red8(s) * (1.0f / 64.0f);
            float q = 0.f;
#pragma unroll
            for (int j = 0; j < 8; ++j) { o[j] -= mean; q += o[j] * o[j]; }
            const float rstd = 1.0f / sqrtf(red8(q) * (1.0f / 64.0f) + 64e-5f);
            float v[8], pv[8], g[8];
            unpack8(*(const u32x4*)(P + t * DIN + 1024 + c0), v);
            if ((t & (SEQ - 1)) != 0) unpack8(*(const u32x4*)(P + (t - 1) * DIN + 1024 + c0), pv);
            else {
#pragma unroll
                for (int j = 0; j < 8; ++j) pv[j] = 0.f; }
            unpack8(*(const u32x4*)(LR + t * 1536 + 1024 + c0), g);
            const float bon = BON[t * 8 + hh];
#pragma unroll
            for (int j = 0; j < 8; ++j) { const float vl = v[j] + (pv[j] - v[j]) * muv[c0 + j];
                y[j] = (o[j] * rstd * lnw[c0 + j] + lnb[c0 + j] + bon * vl) * g[j]; }
            *(u32x4*)(Y + t * D + c0) = pack8(y);
        } else {
            const int h = hh - 8, c0 = 64 * h + 8 * cg;
            const f32x4 o0 = *(const f32x4*)(OH + t * 512 + c0), o1 = *(const f32x4*)(OH + t * 512 + c0 + 4);
            o[0] = o0.x; o[1] = o0.y; o[2] = o0.z; o[3] = o0.w; o[4] = o1.x; o[5] = o1.y; o[6] = o1.z; o[7] = o1.w;
            float q = 0.f;
#pragma unroll
            for (int j = 0; j < 8; ++j) q += o[j] * o[j];
            const float rs = 1.0f / sqrtf(red8(q) * (1.0f / 64.0f) + 1e-6f);
            float g[8];
            unpack8(*(const u32x4*)(P + t * DIN + C_HG + 1536 + c0), g);
#pragma unroll
            for (int j = 0; j < 8; ++j) y[j] = o[j] * rs * gn[8 * cg + j] * siluf_(g[j]);
            *(u32x4*)(Y + t * D + 1536 + c0) = pack8(y);
        }
    }
}

__device__ __forceinline__ void attn_phase(ArgsRef a, int l, LAS unsigned char* lds) {
    const int TID = opaque_tid(), BID = opaque_bid();
    const bf16_t* P = (const bf16_t*)(a.ws + WS_PROJ); bf16_t* Y = (bf16_t*)(a.ws + WS_YC);
    const int* pos = (const int*)a.in[1];
    const float* qn = (const float*)a.in[19] + (size_t)l * 64; const float* kn = (const float*)a.in[20] + (size_t)l * 64; const float* sinks = (const float*)a.in[21] + (size_t)l * 8;
    constexpr int KST = 144, VST = 528;
    LAS unsigned char* sK = lds; LAS unsigned char* sVt = sK + 256 * KST; LAS unsigned char* sQ = sVt + 64 * VST; LAS float* sM = (LAS float*)(sQ + 512 * KST);
    const int tid = TID, cg = tid & 7, wave = tid >> 6, lane = tid & 63;
    float kmaxg = 0.f;
    for (int j = 0; j < 64; ++j) kmaxg = fmaxf(kmaxg, fabsf(kn[j]));
    const float kbound = 8.0f * kmaxg;
    float gk[8], gq[8], invf[8];
#pragma unroll
    for (int j = 0; j < 8; ++j) { gk[j] = kn[8 * cg + j]; gq[j] = qn[8 * cg + j]; invf[j] = exp2f(-(float)j * (18.931568569324174f / 8.0f)); }
    for (int job = BID; job < 512; job += gridDim.x) {
        const int b = job >> 5, nb = (job >> 1) & 15, kvh = job & 1;
        __syncthreads();
#pragma unroll 1
        for (int r = 0; r < 4; ++r) {
            const int kj = (tid >> 3) + 64 * r, s = (nb - 1) * 128 + kj;
            float k[8], v[8];
            if (s >= 0) {
                const size_t t = (size_t)b * SEQ + s;
                unpack8(*(const u32x4*)(P + t * DIN + C_ATT + 512 + 64 * kvh + 8 * cg), k); unpack8(*(const u32x4*)(P + t * DIN + C_ATT + 640 + 64 * kvh + 8 * cg), v);
            } else {
#pragma unroll
                for (int j = 0; j < 8; ++j) { k[j] = 0.f; v[j] = 0.f; } }
            float ss = 0.f;
#pragma unroll
            for (int j = 0; j < 8; ++j) ss += k[j] * k[j];
            ss = red8(ss);
            const float rs = 1.0f / sqrtf(ss * (1.0f / 64.0f) + 1e-6f);
#pragma unroll
            for (int j = 0; j < 8; ++j) k[j] = k[j] * rs * gk[j];
            const float pf = (float)pos[b * SEQ + (s >= 0 ? s : 0)];
#pragma unroll
            for (int j = 0; j < 8; ++j) {
                const float other = dpp<XOR1>(k[j]);
                if (cg < 2) { float sn, cs; sincos_big(pf * invf[j], sn, cs); k[j] = (cg == 0) ? (k[j] * cs - other * sn) : (k[j] * cs + other * sn); }
            }
            *(LAS u32x4*)(sK + kj * KST + 16 * cg) = pack8(k);
#pragma unroll
            for (int j = 0; j < 8; j += 2) { const unsigned w = pk2(v[j], v[j + 1]);
                *(LAS unsigned short*)(sVt + (8 * cg + j) * VST + 2 * kj) = (unsigned short)(w & 0xffffu); *(LAS unsigned short*)(sVt + (8 * cg + j + 1) * VST + 2 * kj) = (unsigned short)(w >> 16); }
        }
#pragma unroll 1
        for (int r = 0; r < 8; ++r) {
            const int row = (tid >> 3) + 64 * r, g = row >> 7, qi = row & 127, hq = 4 * kvh + g;
            const size_t tq = (size_t)b * SEQ + nb * 128 + qi;
            float q[8];
            unpack8(*(const u32x4*)(P + tq * DIN + C_ATT + 64 * hq + 8 * cg), q);
            float ss = 0.f;
#pragma unroll
            for (int j = 0; j < 8; ++j) ss += q[j] * q[j];
            ss = red8(ss);
            const float rs = 0.125f / sqrtf(ss * (1.0f / 64.0f) + 1e-6f);
#pragma unroll
            for (int j = 0; j < 8; ++j) q[j] = q[j] * rs * gq[j];
            const float pf = (float)pos[b * SEQ + nb * 128 + qi];
            float qq = 0.f;
#pragma unroll
            for (int j = 0; j < 8; ++j) {
                const float other = dpp<XOR1>(q[j]);
                if (cg < 2) { float sn, cs; sincos_big(pf * invf[j], sn, cs); q[j] = (cg == 0) ? (q[j] * cs - other * sn) : (q[j] * cs + other * sn); }
                qq += q[j] * q[j];
            }
            qq = red8(qq);
            if (cg == 0) sM[row] = sqrtf(qq) * kbound;
            *(LAS u32x4*)(sQ + row * KST + 16 * cg) = pack8(q);
        }
        __syncthreads();
        const int g = wave >> 1, qh = wave & 1, hq = 4 * kvh + g, fr = lane & 15, fq = lane >> 4;
        const float sinkv = sinks[hq];
#pragma unroll 1
        for (int qt = 0; qt < 4; ++qt) {
            const int qi0 = 64 * qh + 16 * qt, R0 = g * 128 + qi0, kt0 = qi0 >> 4;
            const bf16x8 qf0 = *(const LAS bf16x8*)(sQ + (R0 + fr) * KST + 16 * fq), qf1 = *(const LAS bf16x8*)(sQ + (R0 + fr) * KST + 16 * fq + 64);
            const float msh = sM[R0 + fr];
            const int ql = qi0 + fr;
            f32x4 oacc[4];
#pragma unroll
            for (int dt = 0; dt < 4; ++dt) oacc[dt] = (f32x4){0.f, 0.f, 0.f, 0.f};
            float lsum = 0.f;
#pragma unroll
            for (int ks = 0; ks < 5; ++ks) {
                unsigned pw[4];
#pragma unroll
                for (int h2 = 0; h2 < 2; ++h2) {
                    const int ti = 2 * ks + h2, kt = (kt0 + ti) < 15 ? (kt0 + ti) : 15;
                    const bf16x8 kf0 = *(const LAS bf16x8*)(sK + (16 * kt + fr) * KST + 16 * fq), kf1 = *(const LAS bf16x8*)(sK + (16 * kt + fr) * KST + 16 * fq + 64);
                    f32x4 sc = (f32x4){0.f, 0.f, 0.f, 0.f};
                    sc = __builtin_amdgcn_mfma_f32_16x16x32_bf16(kf0, qf0, sc, 0, 0, 0);
                    sc = __builtin_amdgcn_mfma_f32_16x16x32_bf16(kf1, qf1, sc, 0, 0, 0);
                    float p[4];
#pragma unroll
                    for (int j = 0; j < 4; ++j) { const int kj = 16 * (kt0 + ti) + 4 * fq + j;
                        const bool valid = (kj > ql) && (kj <= ql + 128) && (nb > 0 || kj >= 128);
                        p[j] = valid ? __expf(sc[j] - msh) : 0.f; lsum += p[j]; }
                    pw[2 * h2] = pk2(p[0], p[1]); pw[2 * h2 + 1] = pk2(p[2], p[3]);
                }
                const u32x4 pq = (u32x4){pw[0], pw[1], pw[2], pw[3]};
                const bf16x8 pf = __builtin_bit_cast(bf16x8, pq);
                const int kta = (kt0 + 2 * ks) < 15 ? (kt0 + 2 * ks) : 15, ktb = (kt0 + 2 * ks + 1) < 15 ? (kt0 + 2 * ks + 1) : 15;
#pragma unroll
                for (int dt = 0; dt < 4; ++dt) {
                    const u32x2 va = *(const LAS u32x2*)(sVt + (16 * dt + fr) * VST + (16 * kta + 4 * fq) * 2), vb = *(const LAS u32x2*)(sVt + (16 * dt + fr) * VST + (16 * ktb + 4 * fq) * 2);
                    const u32x4 vq = (u32x4){va.x, va.y, vb.x, vb.y};
                    oacc[dt] = __builtin_amdgcn_mfma_f32_16x16x32_bf16(__builtin_bit_cast(bf16x8, vq), pf, oacc[dt], 0, 0, 0);
                }
            }
            lsum += __shfl_xor(lsum, 16); lsum += __shfl_xor(lsum, 32);
            const float inv = 1.0f / (lsum + __expf(sinkv - msh));
            const size_t tq = (size_t)b * SEQ + nb * 128 + ql;
#pragma unroll
            for (int dt = 0; dt < 4; ++dt) { u32x2 w; w.x = pk2(oacc[dt][0] * inv, oacc[dt][1] * inv); w.y = pk2(oacc[dt][2] * inv, oacc[dt][3] * inv);
                *(u32x2*)(Y + tq * D + 512 + 64 * hq + 16 * dt + 4 * fq) = w; }
        }
    }
    __syncthreads();
}

__device__ __forceinline__ void s5_phase(ArgsRef a, int l, LAS unsigned char* lds) {
    const int TID = opaque_tid(), BID = opaque_bid(); (void)TID; (void)BID;
    const bf16_t* P = (const bf16_t*)(a.ws + WS_PROJ); bf16_t* Z = (bf16_t*)(a.ws + WS_Z);
    const int tid = TID, wave = tid >> 6, lane = tid & 63;
    LAS float* sU = (LAS float*)lds + wave * 1024;
    LAS float* sX = (LAS float*)lds + 8192 + wave * (16 * 130);
    LAS float* sE = (LAS float*)lds + 8192 + 8 * 16 * 130;
    for (int job = BID; job < 512; job += gridDim.x) {
        const int b = job >> 5, g = job & 31;
        const float lre = ((const float*)a.in[22])[(size_t)l * 2048 + g * 64 + lane], lim = ((const float*)a.in[23])[(size_t)l * 2048 + g * 64 + lane];
        const float dt = expf(((const float*)a.in[24])[l * 32 + g]);
        float sn, cs; sincos_big(lim * dt, sn, cs);
        const float er = expf(lre * dt), lbr = er * cs, lbi = er * sn;
        const float den = 1.0f / (lre * lre + lim * lim);
        const float fr = ((lbr - 1.0f) * lre + lbi * lim) * den, fi = (lbi * lre - (lbr - 1.0f) * lim) * den;
        f32x2 bb[16];
        {
            const f32x4* br = (const f32x4*)((const float*)a.in[25] + ((size_t)l * 2048 + g * 64 + lane) * 16); const f32x4* bi = (const f32x4*)((const float*)a.in[26] + ((size_t)l * 2048 + g * 64 + lane) * 16);
#pragma unroll
            for (int q = 0; q < 4; ++q) { const f32x4 r4 = br[q], i4 = bi[q];
                bb[4 * q] = (f32x2){fr * r4.x - fi * i4.x, fr * i4.x + fi * r4.x}; bb[4 * q + 1] = (f32x2){fr * r4.y - fi * i4.y, fr * i4.y + fi * r4.y};
                bb[4 * q + 2] = (f32x2){fr * r4.z - fi * i4.z, fr * i4.z + fi * r4.z}; bb[4 * q + 3] = (f32x2){fr * r4.w - fi * i4.w, fr * i4.w + fi * r4.w}; }
        }
        float creg[32];
        {
            const float* cre = (const float*)a.in[27] + ((size_t)l * 32 + g) * 1024 + (lane & 15) * 64 + (lane >> 4);
            const float* cim = (const float*)a.in[28] + ((size_t)l * 32 + g) * 1024 + (lane & 15) * 64 + (lane >> 4);
#pragma unroll
            for (int kk = 0; kk < 16; ++kk) { creg[kk] = cre[4 * kk]; creg[16 + kk] = -cim[4 * kk]; }
        }
        f32x4 dsk;
        { const float* dp = (const float*)a.in[29] + (size_t)l * 512 + 16 * g + 4 * (lane >> 4); dsk = (f32x4){dp[0], dp[1], dp[2], dp[3]}; }
        const size_t tbase = (size_t)b * SEQ + wave * 256;
        f32x2 xs = (f32x2){0.f, 0.f}; const f32x2 lbr2 = (f32x2){lbr, lbr}, lbi2 = (f32x2){lbi, lbi};
        for (int c = 0; c < 4; ++c) {
            { const size_t t = tbase + c * 64 + lane; float u[16]; unpack8(*(const u32x4*)(P + t * DIN + C_S5 + 16 * g), u); unpack8(*(const u32x4*)(P + t * DIN + C_S5 + 16 * g + 8), u + 8);
              LAS f32x4* d = (LAS f32x4*)(sU + lane * 16); d[0] = (f32x4){u[0], u[1], u[2], u[3]}; d[1] = (f32x4){u[4], u[5], u[6], u[7]}; d[2] = (f32x4){u[8], u[9], u[10], u[11]}; d[3] = (f32x4){u[12], u[13], u[14], u[15]}; }
            LDS_FENCE();
#pragma unroll 2
            for (int s = 0; s < 64; ++s) {
                const LAS f32x4* up = (const LAS f32x4*)(sU + s * 16);
                f32x2 bu0 = (f32x2){0.f, 0.f}, bu1 = bu0;
#pragma unroll
                for (int q = 0; q < 4; ++q) { const f32x4 u4 = up[q];
                    bu0 = pfma(bb[4 * q], (f32x2){u4.x, u4.x}, bu0); bu1 = pfma(bb[4 * q + 1], (f32x2){u4.y, u4.y}, bu1);
                    bu0 = pfma(bb[4 * q + 2], (f32x2){u4.z, u4.z}, bu0); bu1 = pfma(bb[4 * q + 3], (f32x2){u4.w, u4.w}, bu1); }
                { const f32x2 nx = pfma(lbr2, xs, bu0 + bu1); xs = pfma(lbi2, (f32x2){-xs.y, xs.x}, nx); }
            }
            LDS_FENCE();
        }
        sE[wave * 128 + lane] = xs.x; sE[wave * 128 + 64 + lane] = xs.y;
        float pr = lbr, pi = lbi;
#pragma unroll
        for (int i = 0; i < 8; ++i) { const float nr = pr * pr - pi * pi, ni = 2.0f * pr * pi; pr = nr; pi = ni; }
        __syncthreads();
        xs = (f32x2){0.f, 0.f};
        for (int w = 0; w < wave; ++w) { const float er_ = sE[w * 128 + lane], ei_ = sE[w * 128 + 64 + lane];
            const float nr = pr * xs.x - pi * xs.y + er_, ni = pr * xs.y + pi * xs.x + ei_; xs.x = nr; xs.y = ni; }
        for (int c = 0; c < 4; ++c) {
            { const size_t t = tbase + c * 64 + lane; float u[16]; unpack8(*(const u32x4*)(P + t * DIN + C_S5 + 16 * g), u); unpack8(*(const u32x4*)(P + t * DIN + C_S5 + 16 * g + 8), u + 8);
              LAS f32x4* d = (LAS f32x4*)(sU + lane * 16); d[0] = (f32x4){u[0], u[1], u[2], u[3]}; d[1] = (f32x4){u[4], u[5], u[6], u[7]}; d[2] = (f32x4){u[8], u[9], u[10], u[11]}; d[3] = (f32x4){u[12], u[13], u[14], u[15]}; }
            LDS_FENCE();
#pragma unroll 1
            for (int s16 = 0; s16 < 4; ++s16) {
#pragma unroll 2
                for (int s = 0; s < 16; ++s) {
                    const LAS f32x4* up = (const LAS f32x4*)(sU + (s16 * 16 + s) * 16);
                    f32x2 bu0 = (f32x2){0.f, 0.f}, bu1 = bu0;
#pragma unroll
                    for (int q = 0; q < 4; ++q) { const f32x4 u4 = up[q];
                        bu0 = pfma(bb[4 * q], (f32x2){u4.x, u4.x}, bu0); bu1 = pfma(bb[4 * q + 1], (f32x2){u4.y, u4.y}, bu1);
                        bu0 = pfma(bb[4 * q + 2], (f32x2){u4.z, u4.z}, bu0); bu1 = pfma(bb[4 * q + 3], (f32x2){u4.w, u4.w}, bu1); }
                    { const f32x2 nx = pfma(lbr2, xs, bu0 + bu1); xs = pfma(lbi2, (f32x2){-xs.y, xs.x}, nx); }
                    sX[s * 130 + lane] = xs.x; sX[s * 130 + 64 + lane] = xs.y;
                }
                LDS_FENCE();
                f32x4 yacc = (f32x4){0.f, 0.f, 0.f, 0.f}, yacc1 = yacc, yacc2 = yacc, yacc3 = yacc;
                const LAS float* xp = sX + (lane & 15) * 130 + (lane >> 4);
#pragma unroll
                for (int kk = 0; kk < 32; kk += 4) {
                    yacc = __builtin_amdgcn_mfma_f32_16x16x4f32(creg[kk], xp[4 * kk], yacc, 0, 0, 0);
                    yacc1 = __builtin_amdgcn_mfma_f32_16x16x4f32(creg[kk + 1], xp[4 * kk + 4], yacc1, 0, 0, 0);
                    yacc2 = __builtin_amdgcn_mfma_f32_16x16x4f32(creg[kk + 2], xp[4 * kk + 8], yacc2, 0, 0, 0);
                    yacc3 = __builtin_amdgcn_mfma_f32_16x16x4f32(creg[kk + 3], xp[4 * kk + 12], yacc3, 0, 0, 0);
                }
                yacc = (yacc + yacc1) + (yacc2 + yacc3);
                const int tok = s16 * 16 + (lane & 15);
                const f32x4 u4 = *(const LAS f32x4*)(sU + tok * 16 + 4 * (lane >> 4));
                float z[4];
#pragma unroll
                for (int j = 0; j < 4; ++j) { const float y = yacc[j] + dsk[j] * u4[j]; z[j] = 0.5f * y * (1.0f + erff(y * 0.70710678118654752f)); }
                u32x2 w; w.x = pk2(z[0], z[1]); w.y = pk2(z[2], z[3]);
                *(u32x2*)(Z + (tbase + c * 64 + tok) * 512 + 16 * g + 4 * (lane >> 4)) = w;
                LDS_FENCE();
            }
        }
        __syncthreads();
    }
}

#define XB_TMO      128
#define XB_XCNT(j)  (256  + 64 * (j))
#define XB_XSUB(j)  (1280 + 64 * (j))
#define XB_XGEN(j)  (2304 + 64 * (j))
#define XB_TOP      3328
#define XB_TOPGEN   3392
#define XCD_BAR_WORDS 3456
#define XB_SPIN_CAP (1u << 18)

__device__ __forceinline__ unsigned xb_ld(unsigned* p)              { return __hip_atomic_load(p, __ATOMIC_RELAXED, __HIP_MEMORY_SCOPE_AGENT); }
__device__ __forceinline__ unsigned xb_add(unsigned* p, unsigned v) { return __hip_atomic_fetch_add(p, v, __ATOMIC_RELAXED, __HIP_MEMORY_SCOPE_AGENT); }
__device__ __forceinline__ unsigned xb_xcc_id() { return (unsigned)__builtin_amdgcn_s_getreg((3 << 11) | 20) & 0xFu; }
#define XB_SPIN(cond, bar) do { unsigned _sp = 0; while (cond) { __builtin_amdgcn_s_sleep(1); \
    if ((++_sp & 255u) == 0u) { if (xb_ld(&(bar)[XB_TMO])) break; if (_sp > XB_SPIN_CAP) { atomicAdd(&(bar)[XB_TMO], 1u); break; } } } } while (0)

struct XcdBarrier {
    unsigned* bar; unsigned x;
    volatile LAS unsigned* st;
};

__device__ __forceinline__ XcdBarrier xcd_barrier_post(unsigned* bar, volatile LAS unsigned* st) {
    XcdBarrier b; b.bar = bar; b.x = xb_xcc_id(); b.st = st;
    if (threadIdx.x == 0) (void)xb_add(&bar[XB_XCNT(b.x)], 1u);
    return b;
}
__device__ __forceinline__ void xcd_barrier_complete(unsigned* bar, unsigned x, unsigned& nloc, unsigned& nx) {
    const unsigned G = gridDim.x * gridDim.y * gridDim.z;
    unsigned sum, cnt, mine, sp = 0u;
    for (;;) {
        sum = 0u; cnt = 0u; mine = 0u;
#pragma unroll
        for (unsigned j = 0; j < 16; ++j) { const unsigned c = xb_ld(&bar[XB_XCNT(j)]); sum += c; cnt += (c > 0u) ? 1u : 0u; mine = (j == x) ? c : mine; }
        if (sum == G) break;
        __builtin_amdgcn_s_sleep(1);
        if ((++sp & 255u) == 0u) { if (xb_ld(&bar[XB_TMO])) break; if (sp > XB_SPIN_CAP) { atomicAdd(&bar[XB_TMO], 1u); break; } }
    }
    nloc = mine > 0u ? mine : 1u; nx = cnt > 0u ? cnt : 1u;
}

__device__ __forceinline__ void xcd_barrier(const XcdBarrier& b) {
    asm volatile("s_waitcnt vmcnt(0)" ::: "memory");
    __syncthreads();
    if (threadIdx.x == 0) {
        unsigned* bar = b.bar;
        __builtin_amdgcn_s_waitcnt(0);
        unsigned nloc = b.st[0], nx = b.st[1];
        if (nloc == 0u) { xcd_barrier_complete(bar, b.x, nloc, nx); b.st[0] = nloc; b.st[1] = nx; }
        const unsigned old = xb_add(&bar[XB_XSUB(b.x)], 1u);
        const unsigned gen = old / nloc;
        if (old + 1u == (gen + 1u) * nloc) {
            __builtin_amdgcn_fence(__ATOMIC_RELEASE, "agent");
            asm volatile("s_waitcnt vmcnt(0)" ::: "memory");
            const unsigned og = xb_add(&bar[XB_TOP], 1u);
            const unsigned tg = og / nx;
            if (og + 1u == (tg + 1u) * nx) xb_add(&bar[XB_TOPGEN], 1u);
            else XB_SPIN(xb_ld(&bar[XB_TOPGEN]) == tg, bar);
            __builtin_amdgcn_fence(__ATOMIC_ACQUIRE, "agent");
            xb_add(&bar[XB_XGEN(b.x)], 1u);
            asm volatile("s_waitcnt vmcnt(0)" ::: "memory");
        } else {
            XB_SPIN(xb_ld(&bar[XB_XGEN(b.x)]) == gen, bar);
            __builtin_amdgcn_fence(__ATOMIC_ACQUIRE, "agent");
            asm volatile("s_waitcnt vmcnt(0)" ::: "memory");
        }
    }
    __syncthreads();
}


constexpr int NPH = 11;
#ifndef DUPMASK
#define DUPMASK 0
#endif
__global__ void __launch_bounds__(NTHREADS, 2) mega(Args a_, int lo, int hi) {
    extern __shared__ __attribute__((aligned(16))) unsigned char lds_raw[];
    LAS unsigned char* lds = (LAS unsigned char*)lds_raw;
#ifdef EXTRA_SYNCS
    for (int i = 0; i < EXTRA_SYNCS; ++i) { __syncthreads(); cg::this_grid().sync(); }
#endif
    LAS unsigned* xst = (LAS unsigned*)(lds + LDS_BYTES - 16);
    if (hi - lo > 1) {
        if (threadIdx.x == 0) { xst[0] = 0u; xst[1] = 0u; }
        __syncthreads();
        const __attribute__((address_space(4))) Args* ap0 = (const __attribute__((address_space(4))) Args*)__builtin_amdgcn_kernarg_segment_ptr();
        (void)xcd_barrier_post((unsigned*)(ap0->ws + WS_BAR), (volatile LAS unsigned*)xst);
    }
#pragma unroll 1
    for (int step2 = 2 * lo; step2 < 2 * hi; ++step2) {
        const int step = step2 >> 1;
        if ((step2 & 1) && !((DUPMASK >> (step % NPH)) & 1)) continue;
        const __attribute__((address_space(4))) Args* ap = (const __attribute__((address_space(4))) Args*)__builtin_amdgcn_kernarg_segment_ptr();
        asm volatile("" : "+s"(ap));
        ArgsRef a = *ap;
        unsigned char* ws = a.ws;
        float* SSa = (float*)(ws + WS_SS); float* SSb = SSa + T; float* SSc = SSb + T;
        const int l = step / NPH, ph = step % NPH;
        const float* xin = (l == 0) ? (const float*)a.in[0] : (const float*)a.out;
#ifndef PHMASK
#define PHMASK 0x7ff
#endif
        switch (ph) {
        case 0: if (PHMASK & (1 << 0)) { conv_phase(a, l, lds); if (l == 0) norm_phase(xin, (bf16_t*)(ws + WS_XN), SSa); zero_phase(SSb, T); } break;
        case 1: if (PHMASK & (1 << 1)) { pg8::EpiSwiGLU E; E.H = (bf16_t*)(ws + WS_HID); E.SS = SSa; run_gemm(lds, (const bf16_t*)(ws + WS_XN), (const bf16_t*)(ws + W_UP1), 2 * FF, D, E); } break;
        case 2: if (PHMASK & (1 << 2)) { pg8::EpiResidual<true> E; E.base = xin; E.out = a.out; E.XN = (bf16_t*)(ws + WS_XN); E.SS = SSb; run_gemm(lds, (const bf16_t*)(ws + WS_HID), (const bf16_t*)(ws + W_DN1), D, FF, E); } break;
        case 3: if (PHMASK & (1 << 3)) { pg8::EpiBf16 E; E.O = (bf16_t*)(ws + WS_PROJ); E.ldc = DIN; E.SS = SSb; run_gemm(lds, (const bf16_t*)(ws + WS_XN), (const bf16_t*)(ws + W_IN), DIN, D, E); } break;
        case 4: if (PHMASK & (1 << 4)) { zero_phase(SSa, T); zero_phase(SSc, T); alr_phase(a, l); attn_phase(a, l, lds); s5_phase(a, l, lds); hgrn_phase(a, l, lds); } break;
        case 5: if (PHMASK & (1 << 5)) { pg8::EpiLR E; E.O = (bf16_t*)(ws + WS_LRO); E.w0 = (const float*)a.in[9] + (size_t)l * 512; E.a0 = (const float*)a.in[11] + (size_t)l * 512;
                  run_gemm(lds, (const bf16_t*)(ws + WS_ALR), (const bf16_t*)(ws + W_LR), 1536, 256, E);
                  pg8::EpiGLU G; G.Z = (const bf16_t*)(ws + WS_Z); G.Y = (bf16_t*)(ws + WS_YC); G.b = (const float*)a.in[31] + (size_t)l * 512;
                  run_gemm(lds, (const bf16_t*)(ws + WS_Z), (const bf16_t*)(ws + W_GLU), 512, 512, G); } break;
        case 6: if (PHMASK & (1 << 6)) rwkv_phase(a, l, lds); break;
        case 7: if (PHMASK & (1 << 7)) post_phase(a, l); break;
        case 8: if (PHMASK & (1 << 8)) { pg8::EpiResidual<false> E; E.base = a.out; E.out = a.out; E.XN = (bf16_t*)(ws + WS_XN); E.SS = SSc; run_gemm(lds, (const bf16_t*)(ws + WS_YC), (const bf16_t*)(ws + W_OUT), D, D, E); } break;
        case 9: if (PHMASK & (1 << 9)) { pg8::EpiSwiGLU E; E.H = (bf16_t*)(ws + WS_HID); E.SS = SSc; run_gemm(lds, (const bf16_t*)(ws + WS_XN), (const bf16_t*)(ws + W_UP2), 2 * FF, D, E); } break;
        case 10: if (PHMASK & (1 << 10)) { pg8::EpiResidual<true> E; E.base = a.out; E.out = a.out; E.XN = (l + 1 < NL) ? (bf16_t*)(ws + WS_XN) : nullptr; E.SS = SSa; run_gemm(lds, (const bf16_t*)(ws + WS_HID), (const bf16_t*)(ws + W_DN2), D, FF, E); } break;
        }
        if (step2 + 1 < 2 * hi) {
            if (step2 == 2 * lo) { __syncthreads(); cg::this_grid().sync(); }
            else { XcdBarrier xb; xb.bar = (unsigned*)(ws + WS_BAR); xb.x = xb_xcc_id(); xb.st = (volatile LAS unsigned*)xst; xcd_barrier(xb); }
        }
    }
}

extern "C" void kernel_launch(void* const* d_in, const int* in_sizes, int n_in, void* d_out, int out_size, void* d_ws, size_t ws_size, hipStream_t stream) {
    static int grid = 0;
    if (!grid) {
        int dev = 0, cus = 0, per_cu = 0;
        hipGetDevice(&dev);
        hipDeviceGetAttribute(&cus, hipDeviceAttributeMultiprocessorCount, dev);
        hipFuncSetAttribute((const void*)mega, hipFuncAttributeMaxDynamicSharedMemorySize, LDS_BYTES);
        hipOccupancyMaxActiveBlocksPerMultiprocessor(&per_cu, (const void*)mega, NTHREADS, LDS_BYTES);
        if (per_cu < 1) per_cu = 1;
        grid = cus * 1;
        if (grid != 256) fprintf(stderr, "kernel_launch: grid %d (cus %d, per_cu %d)\n", grid, cus, per_cu);
    }
    Args a{};
    for (int i = 0; i < 39; ++i) a.in[i] = d_in[i];
    a.out = (float*)d_out; a.ws = (unsigned char*)d_ws;
#if ONE_LAUNCH
    (void)hipMemsetAsync((unsigned char*)d_ws + WS_BAR, 0, 16384, stream);
    int lo = 0, hi = NL * NPH;
    void* args[] = {&a, &lo, &hi};
    hipError_t e = hipLaunchCooperativeKernel((void*)mega, dim3(grid), dim3(NTHREADS), args, LDS_BYTES, stream);
    if (e != hipSuccess) fprintf(stderr, "cooperative launch failed: %s (grid %d)\n", hipGetErrorString(e), grid);
#else
    for (int s = 0; s < NL * NPH; ++s) hipLaunchKernelGGL(mega, dim3(grid), dim3(NTHREADS), LDS_BYTES, stream, a, s, s + 1);
#endif
}
```

```cpp
#include <hip/hip_runtime.h>
#include <hip/hip_cooperative_groups.h>
#include <cstdio>
#include <cstdint>
namespace cg = cooperative_groups;

#ifndef ONE_LAUNCH
#define ONE_LAUNCH 1
#endif

#define LAS __attribute__((address_space(3)))
typedef unsigned short bf16_t;
typedef short bf16x8 __attribute__((ext_vector_type(8)));
typedef float f32x4 __attribute__((ext_vector_type(4)));
typedef float f32x2 __attribute__((ext_vector_type(2)));
typedef unsigned u32x4 __attribute__((ext_vector_type(4)));
typedef unsigned u32x2 __attribute__((ext_vector_type(2)));

constexpr int T = 32768, SEQ = 2048, NB = 16, D = 2048, FF = 5632, DIN = 5120, NL = 2;
constexpr int C_RWKV = 0, C_ATT = 1792, C_S5 = 2560, C_HG = 3072;
constexpr int NTHREADS = 512, NWAVES = 8;

constexpr size_t SZ_UP = (size_t)2 * FF * D * 2, SZ_DN = (size_t)D * FF * 2, SZ_IN = (size_t)DIN * D * 2, SZ_LR = (size_t)1536 * 256 * 2,
                 SZ_GLU = (size_t)512 * 512 * 2, SZ_OUT = (size_t)D * D * 2;
constexpr size_t W_UP1 = 0, W_DN1 = W_UP1 + SZ_UP, W_IN = W_DN1 + SZ_DN, W_LR = W_IN + SZ_IN, W_GLU = W_LR + SZ_LR, W_OUT = W_GLU + SZ_GLU,
                 W_UP2 = W_OUT + SZ_OUT, W_DN2 = W_UP2 + SZ_UP, W_END = W_DN2 + SZ_DN;
constexpr size_t WS_XN = W_END, WS_BIG = WS_XN + (size_t)T * D * 2;
constexpr size_t WS_HID = WS_BIG;
constexpr size_t WS_PROJ = WS_BIG, WS_LRO = WS_PROJ + (size_t)T * DIN * 2, WS_ALR = WS_LRO + (size_t)T * 1536 * 2, WS_Z = WS_ALR + (size_t)T * 256 * 2,
                 WS_OR = WS_Z + (size_t)T * 512 * 2, WS_OH = WS_OR + (size_t)T * 512 * 4, WS_BON = WS_OH + (size_t)T * 512 * 4, WS_YC = WS_BON + (size_t)T * 8 * 4, WS_SS = WS_YC + (size_t)T * D * 2, WS_BAR = WS_SS + (size_t)3 * T * 4, WS_END = WS_BAR + 16384;
static_assert(WS_END <= (size_t)1 << 30, "workspace");
static_assert(WS_HID + (size_t)T * FF * 2 <= (size_t)1 << 30, "workspace");

constexpr int LDS_BYTES = 147456;

struct Args { const void* in[39]; float* out; unsigned char* ws; };
typedef const __attribute__((address_space(4))) Args& ArgsRef;

typedef __bf16 bf16x2_t __attribute__((ext_vector_type(2)));
__device__ __forceinline__ unsigned pk2(float lo, float hi) { const f32x2 v = (f32x2){lo, hi}; return __builtin_bit_cast(unsigned, __builtin_convertvector(v, bf16x2_t)); }
__device__ __forceinline__ float bflo(unsigned w) { return __uint_as_float(w << 16); }
__device__ __forceinline__ float bfhi(unsigned w) { return __uint_as_float(w & 0xffff0000u); }
__device__ __forceinline__ void unpack8(u32x4 q, float* f) { f[0] = bflo(q.x); f[1] = bfhi(q.x); f[2] = bflo(q.y); f[3] = bfhi(q.y); f[4] = bflo(q.z); f[5] = bfhi(q.z); f[6] = bflo(q.w); f[7] = bfhi(q.w); }
__device__ __forceinline__ u32x4 pack8(const float* f) { u32x4 o; o.x = pk2(f[0], f[1]); o.y = pk2(f[2], f[3]); o.z = pk2(f[4], f[5]); o.w = pk2(f[6], f[7]); return o; }
template <int CTRL> __device__ __forceinline__ float dpp(float x) { return __builtin_bit_cast(float, __builtin_amdgcn_mov_dpp(__builtin_bit_cast(int, x), CTRL, 0xf, 0xf, true)); }
constexpr int XOR1 = 0xB1, XOR2 = 0x4E, XOR7 = 0x141, XOR8 = 0x128;
__device__ __forceinline__ float red8(float v) { v += dpp<XOR1>(v); v += dpp<XOR2>(v); v += dpp<XOR7>(v); return v; }
__device__ __forceinline__ float red16(float v) { v = red8(v); v += dpp<XOR8>(v); return v; }
__device__ __forceinline__ float wave_sum(float v) {
#pragma unroll
    for (int o = 1; o < 64; o <<= 1) v += __shfl_xor(v, o);
    return v;
}
__device__ __forceinline__ float sigmoidf_(float x) { return __builtin_amdgcn_rcpf(1.0f + __expf(-x)); }
__device__ __forceinline__ float siluf_(float x) { return x * __builtin_amdgcn_rcpf(1.0f + __expf(-x)); }
__device__ __forceinline__ int opaque_tid() { int t = threadIdx.x; asm volatile("" : "+v"(t)); return t; }
__device__ __forceinline__ int opaque_bid() { int t = blockIdx.x; asm volatile("" : "+s"(t)); return t; }
__device__ __forceinline__ f32x2 pfma(f32x2 a, f32x2 b, f32x2 c) { return __builtin_elementwise_fma(a, b, c); }
#define LDS_FENCE() asm volatile("s_waitcnt lgkmcnt(0)" ::: "memory")
__device__ __forceinline__ void sincos_big(float x, float& sn, float& cs) {
    const float n = rintf(x * 0.15915494309189535f);
    float r = fmaf(-n, 6.28318548202514648f, x); r = fmaf(-n, -1.7484555e-7f, r);
    sn = __sinf(r); cs = __cosf(r);
}

namespace pg8 {
constexpr int BM = 256, BK = 64, HALF = 128, HTB = HALF * BK * 2, STAGE_BYTES = 8 * HTB, NXCD = 8, WGM = 8;
__host__ __device__ __forceinline__ int lds_byte(int r, int c) { const int st = (r >> 4) * 2 + (c >> 5), rr = r & 15, cc = c & 31, ob = rr * 64 + cc * 2; return st * 1024 + (ob ^ (((ob >> 9) & 1) << 5)); }
__host__ __device__ __forceinline__ void stage_rc(int b, int& R, int& C) { const int st = b / 1024, sb = b % 1024, swz = sb ^ (((sb >> 9) & 1) << 5); R = (st >> 1) * 16 + swz / 64; C = (st & 1) * 32 + (swz % 64) / 2; }
__host__ __device__ __forceinline__ int perm32(int rho) { const int n = rho >> 4, i = rho & 15; return 8 * (i >> 2) + 4 * n + (i & 3); }
struct Unit { int pm, pn; };
struct Gemm { const bf16_t* A; const bf16_t* Bt; int M, N, K; };
struct StaticOrder {
    int nM, nN, nwg, G, c;
    __device__ void init(int M, int N, int G_, int c_) { nM = M / BM; nN = N / BM; nwg = nM * nN; G = G_; c = c_; }
    __device__ bool next(int i, Unit& u) const {
        const long L = (long)i * G + c; if (L >= nwg) return false;
        int wgid = (int)L; { const int q = nwg / NXCD, r = nwg % NXCD, xcd = wgid % NXCD, off = wgid / NXCD; wgid = (xcd < r ? xcd * (q + 1) : r * (q + 1) + (xcd - r) * q) + off; }
        const int nig = WGM * nN, gid = wgid / nig, fm = gid * WGM, gsz = (nM - fm) < WGM ? (nM - fm) : WGM;
        u.pm = fm + ((wgid % nig) % gsz); u.pn = (wgid % nig) / gsz; return true;
    }
};
template <class Epi>
__device__ __forceinline__ void gemm_phase(LAS unsigned char* lds, const Gemm g, const StaticOrder S, const Epi E) {
    const int TID = opaque_tid(), BID = opaque_bid(); (void)TID; (void)BID;
    const int tid = TID, wid = __builtin_amdgcn_readfirstlane(tid >> 6), lane = tid & 63, wr = wid >> 2, wc = wid & 3, fr = lane & 15, fq = lane >> 4;
    const int K = g.K, nt = K / BK;
    unsigned voffA[2], voffB[2];
#pragma unroll
    for (int i = 0; i < 2; ++i) { int R, C; stage_rc(tid * 16 + i * 8192, R, C); const int Rb = Epi::PERM ? ((R & ~31) + perm32(R & 31)) : R;
        voffA[i] = (unsigned)(R * K + C) * 2u; voffB[i] = (unsigned)(Rb * K + C) * 2u; }
    const size_t kstep = (size_t)(BK * 2);
    const size_t hstep = (size_t)HALF * K * 2;
    const size_t tstep = 2 * hstep;
    const unsigned ldsw = (unsigned)wid * 1024u;
    const int aoff = lds_byte(wr * 64 + fr, fq * 8), boff = lds_byte(wc * 32 + fr, fq * 8);
#define PG8_SA(b, h) (((b) * 2 + (h)) * HTB)
#define PG8_SB(b, h) ((4 + (b) * 2 + (h)) * HTB)
#define PG8_STAGE(bufoff, gbase, voff) do { _Pragma("unroll") for (int _i = 0; _i < 2; ++_i) \
        __builtin_amdgcn_global_load_lds((const unsigned*)((const char*)(gbase) + (voff)[_i]), (LAS unsigned*)(lds + (bufoff) + ldsw + _i * 8192), 16, 0, 0); } while (0)
#define PG8_LDA(dst, b, h) do { _Pragma("unroll") for (int m = 0; m < 4; ++m) _Pragma("unroll") for (int k = 0; k < 2; ++k) dst[m][k] = *(const LAS bf16x8*)(lds + PG8_SA(b, h) + aoff + m * 2048 + k * 1024); } while (0)
#define PG8_LDB(dst, b, h) do { _Pragma("unroll") for (int n = 0; n < 2; ++n) _Pragma("unroll") for (int k = 0; k < 2; ++k) dst[n][k] = *(const LAS bf16x8*)(lds + PG8_SB(b, h) + boff + n * 2048 + k * 1024); } while (0)
#define PG8_MMA(ai, bj, At, Bt) do { __builtin_amdgcn_s_setprio(1); _Pragma("unroll") for (int m = 0; m < 4; ++m) _Pragma("unroll") for (int n = 0; n < 2; ++n) _Pragma("unroll") for (int k = 0; k < 2; ++k) \
        acc[ai][bj][m][n] = __builtin_amdgcn_mfma_f32_16x16x32_bf16(Bt[n][k], At[m][k], acc[ai][bj][m][n], 0, 0, 0); __builtin_amdgcn_s_setprio(0); } while (0)
#define PG8_WAIT_V(n) asm volatile("s_waitcnt vmcnt(" #n ")" ::: "memory")
#define PG8_WAIT_L(n) asm volatile("s_waitcnt lgkmcnt(" #n ")" ::: "memory")
#define PG8_BAR __builtin_amdgcn_s_barrier()
#define PG8_SCHED __builtin_amdgcn_sched_barrier(0)
    Unit cur, nxt; int ui = 0;
    if (!S.next(0, cur)) return;
    f32x4 acc[2][2][4][2];
#pragma unroll
    for (int a = 0; a < 2; ++a)
#pragma unroll
        for (int b = 0; b < 2; ++b)
#pragma unroll
            for (int m = 0; m < 4; ++m)
#pragma unroll
                for (int n = 0; n < 2; ++n) acc[a][b][m][n] = (f32x4){0.f, 0.f, 0.f, 0.f};
    bf16x8 At[4][2], B0[2][2], B1[2][2];
    const char* cA = (const char*)g.A + (size_t)cur.pm * tstep; const char* cB = (const char*)g.Bt + (size_t)cur.pn * tstep;
    PG8_STAGE(PG8_SB(0, 0), cB, voffB); PG8_STAGE(PG8_SA(0, 0), cA, voffA); PG8_STAGE(PG8_SB(0, 1), cB + hstep, voffB); PG8_STAGE(PG8_SA(0, 1), cA + hstep, voffA);
    if (wr == 1) PG8_BAR;
    PG8_WAIT_V(4); PG8_BAR;
    PG8_STAGE(PG8_SB(1, 0), cB + kstep, voffB); PG8_STAGE(PG8_SA(1, 0), cA + kstep, voffA); PG8_STAGE(PG8_SB(1, 1), cB + hstep + kstep, voffB);
    PG8_WAIT_V(6); PG8_BAR;
    for (;;) {
        const bool has_next = S.next(ui + 1, nxt);
        const char* nA = has_next ? (const char*)g.A + (size_t)nxt.pm * tstep : cA; const char* nB = has_next ? (const char*)g.Bt + (size_t)nxt.pn * tstep : cB;
#pragma unroll 1
        for (int t = 0; t < nt; t += 2) {
            const bool last = (t == nt - 2);
            const char* a1 = cA + (size_t)(t + 1) * kstep;
            const char* a2 = last ? nA : cA + (size_t)(t + 2) * kstep; const char* b2 = last ? nB : cB + (size_t)(t + 2) * kstep;
            const char* a3 = a2 + kstep; const char* b3 = b2 + kstep;
            PG8_LDB(B0, 0, 0); PG8_SCHED; PG8_LDA(At, 0, 0); PG8_STAGE(PG8_SA(1, 1), a1 + hstep, voffA);
            PG8_WAIT_L(8); PG8_BAR; PG8_WAIT_L(0); PG8_MMA(0, 0, At, B0); PG8_BAR; PG8_SCHED;
            PG8_LDB(B1, 0, 1); PG8_STAGE(PG8_SB(0, 0), b2, voffB);
            PG8_BAR; PG8_WAIT_L(0); PG8_MMA(0, 1, At, B1); PG8_BAR;
            PG8_LDA(At, 0, 1); PG8_STAGE(PG8_SA(0, 0), a2, voffA);
            PG8_BAR; PG8_WAIT_L(0); PG8_MMA(1, 0, At, B0); PG8_BAR; PG8_SCHED;
            PG8_STAGE(PG8_SB(0, 1), b2 + hstep, voffB);
            PG8_WAIT_V(6); PG8_BAR; PG8_MMA(1, 1, At, B1); PG8_BAR;
            PG8_LDB(B0, 1, 0); PG8_SCHED; PG8_LDA(At, 1, 0); PG8_STAGE(PG8_SA(0, 1), a2 + hstep, voffA);
            PG8_WAIT_L(8); PG8_BAR; PG8_WAIT_L(0); PG8_MMA(0, 0, At, B0); PG8_BAR; PG8_SCHED;
            PG8_LDB(B1, 1, 1); PG8_STAGE(PG8_SB(1, 0), b3, voffB);
            PG8_BAR; PG8_WAIT_L(0); PG8_MMA(0, 1, At, B1); PG8_BAR;
            PG8_LDA(At, 1, 1); PG8_STAGE(PG8_SA(1, 0), a3, voffA);
            PG8_BAR; PG8_WAIT_L(0); PG8_MMA(1, 0, At, B0); PG8_BAR; PG8_SCHED;
            PG8_STAGE(PG8_SB(1, 1), b3 + hstep, voffB);
            PG8_WAIT_V(6); PG8_BAR; PG8_MMA(1, 1, At, B1); PG8_BAR;
        }
        E(acc, cur, wr, wc, fr, fq);
        if (!has_next) break;
#pragma unroll
        for (int a = 0; a < 2; ++a)
#pragma unroll
            for (int b = 0; b < 2; ++b)
#pragma unroll
                for (int m = 0; m < 4; ++m)
#pragma unroll
                    for (int n = 0; n < 2; ++n) acc[a][b][m][n] = (f32x4){0.f, 0.f, 0.f, 0.f};
        cur = nxt; cA = nA; cB = nB; ++ui;
    }
    PG8_WAIT_V(0);
    if (wr == 0) PG8_BAR;
    PG8_BAR;
#undef PG8_SA
#undef PG8_SB
#undef PG8_STAGE
#undef PG8_LDA
#undef PG8_LDB
#undef PG8_MMA
#undef PG8_WAIT_V
#undef PG8_WAIT_L
#undef PG8_BAR
#undef PG8_SCHED
}

struct EpiSwiGLU {
    static constexpr bool PERM = true;
    bf16_t* H; const float* SS;
    __device__ __forceinline__ void operator()(const f32x4 (&acc)[2][2][4][2], const Unit& u, int wr, int wc, int fr, int fq) const {
        const int row0 = u.pm * BM + wr * 64 + fr, col0 = u.pn * 128 + wc * 32 + 8 * fq;
#pragma unroll
        for (int ai = 0; ai < 2; ++ai)
#pragma unroll
            for (int m = 0; m < 4; ++m) {
                const float rs = __builtin_amdgcn_rsqf(SS[row0 + ai * HALF + m * 16] * (1.0f / D) + 1e-6f);
                float v[8];
#pragma unroll
                for (int n = 0; n < 2; ++n)
#pragma unroll
                    for (int j = 0; j < 4; ++j) { const float gt = acc[ai][0][m][n][j] * rs, up = acc[ai][1][m][n][j] * rs; v[4 * n + j] = siluf_(gt) * up; }
                *(u32x4*)(H + (size_t)(row0 + ai * HALF + m * 16) * FF + col0) = pack8(v);
            }
    }
};
template <bool HALFSTEP> struct EpiResidual {
    static constexpr bool PERM = false;
    static constexpr float scale = HALFSTEP ? 0.5f : 1.0f;
    const float* base; float* out; bf16_t* XN; float* SS;
    __device__ __forceinline__ void operator()(const f32x4 (&acc)[2][2][4][2], const Unit& u, int wr, int wc, int fr, int fq) const {
        const int row0 = u.pm * BM + wr * 64 + fr, col0 = u.pn * BM + wc * 32 + 4 * fq;
#pragma unroll
        for (int ai = 0; ai < 2; ++ai)
#pragma unroll
            for (int m = 0; m < 4; ++m) { const int row = row0 + ai * HALF + m * 16; const size_t ro = (size_t)row * D + col0; float ss = 0.f;
#pragma unroll
                for (int bj = 0; bj < 2; ++bj)
#pragma unroll
                    for (int n = 0; n < 2; ++n) { const f32x4 b = *(const f32x4*)(base + ro + bj * HALF + n * 16); const f32x4 r = b + acc[ai][bj][m][n] * scale; *(f32x4*)(out + ro + bj * HALF + n * 16) = r;
                        if (XN) { u32x2 w; w.x = pk2(r.x, r.y); w.y = pk2(r.z, r.w); *(u32x2*)(XN + ro + bj * HALF + n * 16) = w; ss += (r.x * r.x + r.y * r.y) + (r.z * r.z + r.w * r.w); } }
                if (XN) { ss += __shfl_xor(ss, 16); ss += __shfl_xor(ss, 32); if (fq == 0) atomicAdd(SS + row, ss); } }
    }
};
struct EpiBf16 {
    static constexpr bool PERM = true;
    bf16_t* O; int ldc; const float* SS;
    __device__ __forceinline__ void operator()(const f32x4 (&acc)[2][2][4][2], const Unit& u, int wr, int wc, int fr, int fq) const {
        const int row0 = u.pm * BM + wr * 64 + fr, col0 = u.pn * BM + wc * 32 + 8 * fq;
#pragma unroll
        for (int ai = 0; ai < 2; ++ai)
#pragma unroll
            for (int m = 0; m < 4; ++m) { bf16_t* rowp = O + (size_t)(row0 + ai * HALF + m * 16) * ldc + col0;
                const float rs = __builtin_amdgcn_rsqf(SS[row0 + ai * HALF + m * 16] * (1.0f / D) + 1e-6f);
#pragma unroll
                for (int bj = 0; bj < 2; ++bj) { const f32x4 v0 = acc[ai][bj][m][0] * rs, v1 = acc[ai][bj][m][1] * rs;
                    u32x4 w; w.x = pk2(v0[0], v0[1]); w.y = pk2(v0[2], v0[3]); w.z = pk2(v1[0], v1[1]); w.w = pk2(v1[2], v1[3]);
                    *(u32x4*)(rowp + bj * HALF) = w; } }
    }
};
struct EpiLR {
    static constexpr bool PERM = true;
    bf16_t* O; const float* w0; const float* a0;
    template <int KIND> __device__ __forceinline__ void body(const f32x4 (&acc)[2][2][4][2], const float* bp, int row0, int col0) const {
#pragma unroll
        for (int bj = 0; bj < 2; ++bj) {
            f32x4 b0 = (f32x4){0.f, 0.f, 0.f, 0.f}, b1 = b0;
            if (KIND < 2) { b0 = *(const f32x4*)(bp + bj * HALF); b1 = *(const f32x4*)(bp + bj * HALF + 4); }
#pragma unroll
            for (int ai = 0; ai < 2; ++ai)
#pragma unroll
                for (int m = 0; m < 4; ++m) {
                    u32x4 w;
#pragma unroll
                    for (int n = 0; n < 2; ++n) {
                        float r[4];
#pragma unroll
                        for (int j = 0; j < 4; ++j) { const float x = acc[ai][bj][m][n][j] + (n == 0 ? b0[j] : b1[j]);
                            if (KIND == 0) { const float e = __expf(-x); r[j] = -0.60653065971f * __builtin_amdgcn_rcpf(1.0f + e); }
                            else if (KIND == 1) r[j] = __builtin_amdgcn_rcpf(1.0f + __expf(-x)); else r[j] = x; }
                        if (n == 0) { w.x = pk2(r[0], r[1]); w.y = pk2(r[2], r[3]); } else { w.z = pk2(r[0], r[1]); w.w = pk2(r[2], r[3]); }
                    }
                    *(u32x4*)(O + (size_t)(row0 + ai * HALF + m * 16) * 1536 + col0 + bj * HALF) = w;
                }
        }
    }
    __device__ __forceinline__ void operator()(const f32x4 (&acc)[2][2][4][2], const Unit& u, int wr, int wc, int fr, int fq) const {
        const int row0 = u.pm * BM + wr * 64 + fr, col0 = u.pn * BM + wc * 32 + 8 * fq, kind = u.pn >> 1, f0 = col0 - 512 * kind;
        if (kind == 0) body<0>(acc, w0 + f0, row0, col0); else if (kind == 1) body<1>(acc, a0 + f0, row0, col0); else body<2>(acc, nullptr, row0, col0);
    }
};
struct EpiGLU {
    static constexpr bool PERM = true;
    const bf16_t* Z; bf16_t* Y; const float* b;
    __device__ __forceinline__ void operator()(const f32x4 (&acc)[2][2][4][2], const Unit& u, int wr, int wc, int fr, int fq) const {
        const int row0 = u.pm * BM + wr * 64 + fr, col0 = u.pn * BM + wc * 32 + 8 * fq;
#pragma unroll
        for (int bj = 0; bj < 2; ++bj) {
            const f32x4 bias0 = *(const f32x4*)(b + col0 + bj * HALF), bias1 = *(const f32x4*)(b + col0 + bj * HALF + 4);
#pragma unroll
            for (int ai = 0; ai < 2; ++ai)
#pragma unroll
                for (int m = 0; m < 4; ++m) { const size_t r = (size_t)(row0 + ai * HALF + m * 16);
                    float z[8], v[8]; unpack8(*(const u32x4*)(Z + r * 512 + col0 + bj * HALF), z);
#pragma unroll
                    for (int n = 0; n < 2; ++n)
#pragma unroll
                        for (int j = 0; j < 4; ++j) v[4 * n + j] = z[4 * n + j] * sigmoidf_(acc[ai][bj][m][n][j] + (n == 0 ? bias0[j] : bias1[j]));
                    *(u32x4*)(Y + r * D + 1024 + col0 + bj * HALF) = pack8(v); }
        }
    }
};
}

template <class Epi> __device__ __forceinline__ void run_gemm(LAS unsigned char* lds, const bf16_t* A, const bf16_t* Bt, int N, int K, const Epi E) {
    pg8::Gemm g; g.A = A; g.Bt = Bt; g.M = T; g.N = N; g.K = K;
    pg8::StaticOrder S; S.init(T, N, gridDim.x, opaque_bid());
    pg8::gemm_phase<Epi>(lds, g, S, E);
}

__device__ __forceinline__ void tr_item(const float* W, int ldw, int k0, int n0, const float* gs, bf16_t* Dst, int ldd, int drow0, int dk0, LAS float* scr, int lane) {
    if (W) {
        f32x4 v[8];
#pragma unroll
        for (int i = 0; i < 8; ++i) { const int kk = 8 * i + (lane >> 3); v[i] = *(const f32x4*)(W + (size_t)(k0 + kk) * ldw + n0 + 4 * (lane & 7)); }
#pragma unroll
        for (int i = 0; i < 8; ++i) { const int kk = 8 * i + (lane >> 3); f32x4 x = v[i]; if (gs) x = x * gs[k0 + kk];
            LAS float* d = scr + kk * 33 + 4 * (lane & 7); d[0] = x.x; d[1] = x.y; d[2] = x.z; d[3] = x.w; }
    } else {
#pragma unroll 8
        for (int i = 0; i < 32; ++i) { const int kk = 2 * i + (lane >> 5); scr[kk * 33 + (lane & 31)] = 0.f; }
    }
    LDS_FENCE();
    const int c = lane & 7;
#pragma unroll
    for (int j = 0; j < 4; ++j) { const int n = (lane >> 3) + 8 * j; const LAS float* s = scr + (8 * c) * 33 + n;
        u32x4 o; o.x = pk2(s[0 * 33], s[1 * 33]); o.y = pk2(s[2 * 33], s[3 * 33]); o.z = pk2(s[4 * 33], s[5 * 33]); o.w = pk2(s[6 * 33], s[7 * 33]);
        *(u32x4*)(Dst + (size_t)(drow0 + n) * ldd + dk0 + k0 - 0 + 8 * c - 0) = o; }
    LDS_FENCE();
}

__device__ __forceinline__ void conv_phase(ArgsRef a, int l, LAS unsigned char* lds) {
    const int TID = opaque_tid(), BID = opaque_bid(); (void)TID; (void)BID;
    const int wave = TID >> 6, lane = TID & 63;
    LAS float* scr = (LAS float*)(lds + wave * 8704);
    const int gw = BID * NWAVES + wave, NGW = gridDim.x * NWAVES;
    unsigned char* ws = a.ws;
    constexpr int I_GU = (D / 64) * (FF / 32), I_DN = (FF / 64) * (D / 32), I_IN = (D / 64) * (DIN / 32), I_OUT = (D / 64) * (D / 32), I_GLU = 8 * 16, I_LR = 48 * 4;
    constexpr int NITEMS = 6 * I_GU + I_IN + I_OUT + I_GLU + I_LR;
    static_assert(I_GU == I_DN, "items");
    for (int it = gw; it < NITEMS; it += NGW) {
        int r = it;
        if (r < 6 * I_GU) {
            const int which = r / I_GU; r -= which * I_GU;
            const int f = which >= 3, m = which % 3;
            if (m < 2) {
                const float* W = (const float*)a.in[(f ? 36 : 3) + m] + (size_t)l * D * FF;
                const float* gs = (const float*)a.in[f ? 35 : 2] + (size_t)l * D;
                bf16_t* dst = (bf16_t*)(ws + (f ? W_UP2 : W_UP1));
                const int nblk = FF / 32, kb = r / nblk, nb = r % nblk, n0 = 32 * nb;
                tr_item(W, FF, 64 * kb, n0, gs, dst, D, (n0 >> 7) * 256 + (n0 & 127) + 128 * m, 0, scr, lane);
            } else {
                const float* W = (const float*)a.in[f ? 38 : 5] + (size_t)l * FF * D;
                bf16_t* dst = (bf16_t*)(ws + (f ? W_DN2 : W_DN1));
                const int nblk = D / 32, kb = r / nblk, nb = r % nblk;
                tr_item(W, D, 64 * kb, 32 * nb, nullptr, dst, FF, 32 * nb, 0, scr, lane);
            }
            continue;
        }
        r -= 6 * I_GU;
        if (r < I_IN) { const int nblk = DIN / 32, kb = r / nblk, nb = r % nblk;
            tr_item((const float*)a.in[7] + (size_t)l * D * DIN, DIN, 64 * kb, 32 * nb, (const float*)a.in[6] + (size_t)l * D, (bf16_t*)(ws + W_IN), D, 32 * nb, 0, scr, lane); continue; }
        r -= I_IN;
        if (r < I_OUT) { const int nblk = D / 32, kb = r / nblk, nb = r % nblk;
            tr_item((const float*)a.in[34] + (size_t)l * D * D, D, 64 * kb, 32 * nb, nullptr, (bf16_t*)(ws + W_OUT), D, 32 * nb, 0, scr, lane); continue; }
        r -= I_OUT;
        if (r < I_GLU) { const int kb = r / 16, nb = r % 16;
            tr_item((const float*)a.in[30] + (size_t)l * 512 * 512, 512, 64 * kb, 32 * nb, nullptr, (bf16_t*)(ws + W_GLU), 512, 32 * nb, 0, scr, lane); continue; }
        r -= I_GLU;
        {
            const int nb = r >> 2, kb = r & 3, kind = nb >> 4, nn0 = 32 * (nb & 15);
            const float* W = nullptr; int k0 = 0;
            if (kind == 0 && kb == 0) { W = (const float*)a.in[10] + (size_t)l * 64 * 512; k0 = 0; }
            else if (kind == 1 && kb == 1) { W = (const float*)a.in[12] + (size_t)l * 64 * 512; k0 = 0; }
            else if (kind == 2 && kb >= 2) { W = (const float*)a.in[13] + (size_t)l * 128 * 512; k0 = 64 * (kb - 2); }
            tr_item(W, 512, k0, nn0, nullptr, (bf16_t*)(ws + W_LR), 256, 32 * nb, 64 * kb - k0, scr, lane);
        }
    }
}

__device__ __forceinline__ void norm_phase(const float* x, bf16_t* XN, float* SS) {
    const int TID = opaque_tid(), BID = opaque_bid(); (void)TID; (void)BID;
    const int wave = TID >> 6, lane = TID & 63;
    const int gw = BID * NWAVES + wave, NGW = gridDim.x * NWAVES;
    for (int m = gw; m < T; m += NGW) {
        const f32x4* xr = (const f32x4*)(x + (size_t)m * D) + lane;
        f32x4 v[8]; float s = 0.f;
#pragma unroll
        for (int j = 0; j < 8; ++j) { v[j] = xr[64 * j]; s += (v[j].x * v[j].x + v[j].y * v[j].y) + (v[j].z * v[j].z + v[j].w * v[j].w); }
        s = wave_sum(s); if (lane == 0) SS[m] = s;
        u32x2* o = (u32x2*)(XN + (size_t)m * D) + lane;
#pragma unroll
        for (int j = 0; j < 8; ++j) { u32x2 w; w.x = pk2(v[j].x, v[j].y); w.y = pk2(v[j].z, v[j].w); o[64 * j] = w; }
    }
}

__device__ __forceinline__ void zero_phase(float* p, int n) {
    const int TID = opaque_tid(), BID = opaque_bid();
    for (int i = BID * NTHREADS + TID; i < n; i += gridDim.x * NTHREADS) p[i] = 0.f;
}
__device__ __forceinline__ void alr_phase(ArgsRef a, int l) {
    const int TID = opaque_tid(), BID = opaque_bid(); (void)TID; (void)BID;
    const bf16_t* P = (const bf16_t*)(a.ws + WS_PROJ); bf16_t* ALR = (bf16_t*)(a.ws + WS_ALR);
    const float* mu = (const float*)a.in[8] + (size_t)l * 1792 + 1536;
    const int gt = BID * NTHREADS + TID, NGT = gridDim.x * NTHREADS;
    for (int it = gt; it < T * 32; it += NGT) {
        const int t = it >> 5, cg = it & 31, c0 = 8 * cg;
        float cur[8], prv[8], o[8];
        unpack8(*(const u32x4*)(P + (size_t)t * DIN + 1536 + c0), cur);
        if ((t & (SEQ - 1)) != 0) unpack8(*(const u32x4*)(P + (size_t)(t - 1) * DIN + 1536 + c0), prv);
        else {
#pragma unroll
            for (int j = 0; j < 8; ++j) prv[j] = 0.f; }
#pragma unroll
        for (int j = 0; j < 8; ++j) { const float v = cur[j] + (prv[j] - cur[j]) * mu[c0 + j];
            o[j] = c0 < 64 ? tanhf(v) : (c0 < 128 ? v : sigmoidf_(v)); }
        *(u32x4*)(ALR + (size_t)t * 256 + c0) = pack8(o);
    }
}

__device__ __forceinline__ void rwkv_phase(ArgsRef a, int l, LAS unsigned char* lds) {
    const int TID = opaque_tid(), BID = opaque_bid(); (void)TID; (void)BID;
    const bf16_t* P = (const bf16_t*)(a.ws + WS_PROJ); const bf16_t* LR = (const bf16_t*)(a.ws + WS_LRO);
    float* OR = (float*)(a.ws + WS_OR); float* BON = (float*)(a.ws + WS_BON);
    LAS float* sR = (LAS float*)lds; LAS float* sW = sR + 4096; LAS float* sK = sW + 4096; LAS float* sKK = sK + 4096; LAS float* sB = sKK + 4096;
    LAS float* sV = sB + 4096; LAS float* sO = sV + 2048;
    const int tid = TID, wave = tid >> 6, lane = tid & 63;
    const int tt = tid >> 3, cg = tid & 7;
    for (int job = BID; job < 256; job += gridDim.x) {
        const int b = job >> 4, h = (job >> 1) & 7, half = job & 1;
        const int c0 = 64 * h + 8 * cg;
        float mur[8], muk[8], muv[8], kkw[8], kaw[8], rkw[8];
#pragma unroll
        for (int j = 0; j < 8; ++j) {
            mur[j] = ((const float*)a.in[8])[(size_t)l * 1792 + c0 + j]; muk[j] = ((const float*)a.in[8])[(size_t)l * 1792 + 512 + c0 + j]; muv[j] = ((const float*)a.in[8])[(size_t)l * 1792 + 1024 + c0 + j];
            kkw[j] = ((const float*)a.in[14])[(size_t)l * 512 + c0 + j]; kaw[j] = ((const float*)a.in[15])[(size_t)l * 512 + c0 + j]; rkw[j] = ((const float*)a.in[16])[(size_t)l * 512 + c0 + j]; }
        f32x2 stA = (f32x2){0.f, 0.f}, stB = stA;
        const int rloc = 4 * wave + (lane >> 4), jq = lane & 15;
        for (int ch = 0; ch < SEQ / 64; ++ch) {
            __syncthreads();
            {
                const int s = ch * 64 + tt; const size_t t = (size_t)b * SEQ + s;
                float r[8], k[8], v[8], pr[8], ld[8], av[8];
                unpack8(*(const u32x4*)(P + t * DIN + c0), r); unpack8(*(const u32x4*)(P + t * DIN + 512 + c0), k); unpack8(*(const u32x4*)(P + t * DIN + 1024 + c0), v);
                if (s != 0) {
                    unpack8(*(const u32x4*)(P + (t - 1) * DIN + c0), pr);
#pragma unroll
                    for (int j = 0; j < 8; ++j) r[j] += (pr[j] - r[j]) * mur[j];
                    unpack8(*(const u32x4*)(P + (t - 1) * DIN + 512 + c0), pr);
#pragma unroll
                    for (int j = 0; j < 8; ++j) k[j] += (pr[j] - k[j]) * muk[j];
                    unpack8(*(const u32x4*)(P + (t - 1) * DIN + 1024 + c0), pr);
#pragma unroll
                    for (int j = 0; j < 8; ++j) v[j] += (pr[j] - v[j]) * muv[j];
                } else {
#pragma unroll
                    for (int j = 0; j < 8; ++j) { r[j] -= r[j] * mur[j]; k[j] -= k[j] * muk[j]; v[j] -= v[j] * muv[j]; }
                }
                unpack8(*(const u32x4*)(LR + t * 1536 + c0), ld); unpack8(*(const u32x4*)(LR + t * 1536 + 512 + c0), av);
                float kk[8], ss = 0.f, bp = 0.f;
#pragma unroll
                for (int j = 0; j < 8; ++j) { kk[j] = k[j] * kkw[j]; ss += kk[j] * kk[j]; }
                ss = red8(ss);
                const float inv = __builtin_amdgcn_rsqf(fmaxf(ss, 1e-24f));
                float w8[8], k8[8], b8[8];
#pragma unroll
                for (int j = 0; j < 8; ++j) { kk[j] *= inv; k8[j] = k[j] * (1.0f + (av[j] - 1.0f) * kaw[j]); b8[j] = kk[j] * av[j]; w8[j] = __expf(ld[j]); bp += r[j] * k8[j] * rkw[j]; }
                bp = red8(bp);
                if (half == 0 && cg == 0) BON[t * 8 + h] = bp;
                LAS float* d;
                d = sR + tt * 64 + 8 * cg; *(LAS f32x4*)d = (f32x4){r[0], r[1], r[2], r[3]}; *(LAS f32x4*)(d + 4) = (f32x4){r[4], r[5], r[6], r[7]};
                d = sW + tt * 64 + 8 * cg; *(LAS f32x4*)d = (f32x4){w8[0], w8[1], w8[2], w8[3]}; *(LAS f32x4*)(d + 4) = (f32x4){w8[4], w8[5], w8[6], w8[7]};
                d = sK + tt * 64 + 8 * cg; *(LAS f32x4*)d = (f32x4){k8[0], k8[1], k8[2], k8[3]}; *(LAS f32x4*)(d + 4) = (f32x4){k8[4], k8[5], k8[6], k8[7]};
                d = sKK + tt * 64 + 8 * cg; *(LAS f32x4*)d = (f32x4){kk[0], kk[1], kk[2], kk[3]}; *(LAS f32x4*)(d + 4) = (f32x4){kk[4], kk[5], kk[6], kk[7]};
                d = sB + tt * 64 + 8 * cg; *(LAS f32x4*)d = (f32x4){b8[0], b8[1], b8[2], b8[3]}; *(LAS f32x4*)(d + 4) = (f32x4){b8[4], b8[5], b8[6], b8[7]};
                if ((cg >> 2) == half) { d = sV + tt * 32 + 8 * (cg & 3); *(LAS f32x4*)d = (f32x4){v[0], v[1], v[2], v[3]}; *(LAS f32x4*)(d + 4) = (f32x4){v[4], v[5], v[6], v[7]}; }
            }
            __syncthreads();
            {
                f32x4 w4 = *(const LAS f32x4*)(sW + 4 * jq), kk4 = *(const LAS f32x4*)(sKK + 4 * jq), b4 = *(const LAS f32x4*)(sB + 4 * jq),
                      k4 = *(const LAS f32x4*)(sK + 4 * jq), r4 = *(const LAS f32x4*)(sR + 4 * jq);
                float vi = sV[rloc];
                f32x2 pyp = (f32x2){0.f, 0.f}; float ykeep = 0.f;
#pragma unroll 1
                for (int s16 = 0; s16 < 64; s16 += 16) {
#pragma unroll
                    for (int u = 0; u < 16; ++u) {
                        const int sn = (s16 + u + 1) & 63;
                        const f32x4 nw4 = *(const LAS f32x4*)(sW + sn * 64 + 4 * jq), nkk4 = *(const LAS f32x4*)(sKK + sn * 64 + 4 * jq), nb4 = *(const LAS f32x4*)(sB + sn * 64 + 4 * jq),
                                    nk4 = *(const LAS f32x4*)(sK + sn * 64 + 4 * jq), nr4 = *(const LAS f32x4*)(sR + sn * 64 + 4 * jq);
                        const float nvi = sV[sn * 32 + rloc];
                        const f32x2 pa = pfma(stB, (f32x2){kk4.z, kk4.w}, stA * (f32x2){kk4.x, kk4.y});
                        float av = pa.x + pa.y, yv = pyp.x + pyp.y;
                        av += dpp<XOR1>(av); yv += dpp<XOR1>(yv); av += dpp<XOR2>(av); yv += dpp<XOR2>(yv);
                        av += dpp<XOR7>(av); yv += dpp<XOR7>(yv); av += dpp<XOR8>(av); yv += dpp<XOR8>(yv);
                        if (u > 0) ykeep = (jq == u - 1) ? yv : ykeep;
                        else if (s16 > 0) { ykeep = (jq == 15) ? yv : ykeep; sO[(s16 - 16 + jq) * 32 + rloc] = ykeep; }
                        const float sa = -av;
                        const f32x2 sa2 = (f32x2){sa, sa}, vi2 = (f32x2){vi, vi};
                        const f32x2 tA = pfma(vi2, (f32x2){k4.x, k4.y}, sa2 * (f32x2){b4.x, b4.y}), tB = pfma(vi2, (f32x2){k4.z, k4.w}, sa2 * (f32x2){b4.z, b4.w});
                        stA = pfma(stA, (f32x2){w4.x, w4.y}, tA); stB = pfma(stB, (f32x2){w4.z, w4.w}, tB);
                        pyp = pfma(stB, (f32x2){r4.z, r4.w}, stA * (f32x2){r4.x, r4.y});
                        w4 = nw4; kk4 = nkk4; b4 = nb4; k4 = nk4; r4 = nr4; vi = nvi;
                    }
                }
                float yv = red16(pyp.x + pyp.y);
                ykeep = (jq == 15) ? yv : ykeep; sO[(48 + jq) * 32 + rloc] = ykeep;
            }
            __syncthreads();
            {
                const int s = ch * 64 + tt; const size_t t = (size_t)b * SEQ + s;
                *(f32x4*)(OR + t * 512 + 64 * h + 32 * half + 4 * cg) = *(const LAS f32x4*)(sO + tt * 32 + 4 * cg);
            }
        }
    }
    __syncthreads();
}

__device__ __forceinline__ void hgrn_phase(ArgsRef a, int l, LAS unsigned char* lds) {
    const int TID = opaque_tid(), BID = opaque_bid(); (void)TID; (void)BID;
    const bf16_t* P = (const bf16_t*)(a.ws + WS_PROJ); float* OH = (float*)(a.ws + WS_OH);
    LAS float* sQ = (LAS float*)lds; LAS float* sF = sQ + 4096; LAS float* sV = sF + 4096; LAS float* sO = sV + 2048;
    const int tid = TID, wave = tid >> 6, lane = tid & 63;
    const int tt = tid >> 3, cg = tid & 7;
    const float* lbp = (const float*)a.in[32];
    for (int job = BID; job < 256; job += gridDim.x) {
        const int b = job >> 4, h = (job >> 1) & 7, half = job & 1;
        const int c0 = 64 * h + 8 * cg;
        float lb[8];
#pragma unroll
        for (int j = 0; j < 8; ++j) lb[j] = (l == 0) ? 0.f : sigmoidf_(lbp[512 + c0 + j] - lbp[c0 + j]);
        f32x2 stA = (f32x2){0.f, 0.f}, stB = stA;
        const int cloc = 4 * wave + (lane >> 4), dq = lane & 15;
        for (int ch = 0; ch < SEQ / 64; ++ch) {
            __syncthreads();
            {
                const int s = ch * 64 + tt; const size_t t = (size_t)b * SEQ + s;
                float q[8], f[8];
                unpack8(*(const u32x4*)(P + t * DIN + C_HG + c0), q); unpack8(*(const u32x4*)(P + t * DIN + C_HG + 512 + c0), f);
#pragma unroll
                for (int j = 0; j < 8; ++j) { q[j] = siluf_(q[j]) * 0.125f; f[j] = lb[j] + (1.0f - lb[j]) * sigmoidf_(f[j]); }
                LAS float* d;
                d = sQ + tt * 64 + 8 * cg; *(LAS f32x4*)d = (f32x4){q[0], q[1], q[2], q[3]}; *(LAS f32x4*)(d + 4) = (f32x4){q[4], q[5], q[6], q[7]};
                d = sF + tt * 64 + 8 * cg; *(LAS f32x4*)d = (f32x4){f[0], f[1], f[2], f[3]}; *(LAS f32x4*)(d + 4) = (f32x4){f[4], f[5], f[6], f[7]};
                const u32x2 vv = *(const u32x2*)(P + t * DIN + C_HG + 1024 + 64 * h + 32 * half + 4 * cg);
                *(LAS f32x4*)(sV + tt * 32 + 4 * cg) = (f32x4){bflo(vv.x), bfhi(vv.x), bflo(vv.y), bfhi(vv.y)};
            }
            __syncthreads();
            {
                f32x4 f4 = *(const LAS f32x4*)(sF + 4 * dq), q4 = *(const LAS f32x4*)(sQ + 4 * dq);
                float vi = sV[cloc];
                float ykeep = 0.f;
#pragma unroll 1
                for (int s16 = 0; s16 < 64; s16 += 16) {
#pragma unroll
                    for (int u = 0; u < 16; ++u) {
                        const int sn = (s16 + u + 1) & 63;
                        const f32x4 nf4 = *(const LAS f32x4*)(sF + sn * 64 + 4 * dq), nq4 = *(const LAS f32x4*)(sQ + sn * 64 + 4 * dq);
                        const float nvi = sV[sn * 32 + cloc];
                        const f32x2 vi2 = (f32x2){vi, vi};
                        stA = pfma((f32x2){f4.x, f4.y}, stA - vi2, vi2); stB = pfma((f32x2){f4.z, f4.w}, stB - vi2, vi2);
                        const f32x2 py = pfma(stB, (f32x2){q4.z, q4.w}, stA * (f32x2){q4.x, q4.y});
                        const float y = red16(py.x + py.y);
                        ykeep = (dq == u) ? y : ykeep;
                        f4 = nf4; q4 = nq4; vi = nvi;
                    }
                    sO[(s16 + dq) * 32 + cloc] = ykeep;
                }
            }
            __syncthreads();
            {
                const int s = ch * 64 + tt; const size_t t = (size_t)b * SEQ + s;
                *(f32x4*)(OH + t * 512 + 64 * h + 32 * half + 4 * cg) = *(const LAS f32x4*)(sO + tt * 32 + 4 * cg);
            }
        }
    }
    __syncthreads();
}

__device__ __forceinline__ void post_phase(ArgsRef a, int l) {
    const int TID = opaque_tid(), BID = opaque_bid(); (void)TID; (void)BID;
    const bf16_t* P = (const bf16_t*)(a.ws + WS_PROJ); const bf16_t* LR = (const bf16_t*)(a.ws + WS_LRO);
    const float* OR = (const float*)(a.ws + WS_OR); const float* OH = (const float*)(a.ws + WS_OH); const float* BON = (const float*)(a.ws + WS_BON);
    bf16_t* Y = (bf16_t*)(a.ws + WS_YC);
    const float* muv = (const float*)a.in[8] + (size_t)l * 1792 + 1024;
    const float* lnw = (const float*)a.in[17] + (size_t)l * 512; const float* lnb = (const float*)a.in[18] + (size_t)l * 512;
    const float* gn = (const float*)a.in[33] + (size_t)l * 64;
    const int gt = BID * NTHREADS + TID, NGT = gridDim.x * NTHREADS;
    for (int it = gt; it < T * 128; it += NGT) {
        const int cg = it & 7, hh = (it >> 3) & 15; const size_t t = (size_t)(it >> 7);
        float o[8], y[8];
        if (hh < 8) {
            const int c0 = 64 * hh + 8 * cg;
            const f32x4 o0 = *(const f32x4*)(OR + t * 512 + c0), o1 = *(const f32x4*)(OR + t * 512 + c0 + 4);
            o[0] = o0.x; o[1] = o0.y; o[2] = o0.z; o[3] = o0.w; o[4] = o1.x; o[5] = o1.y; o[6] = o1.z; o[7] = o1.w;
            float s = 0.f;
#pragma unroll
            for (int j = 0; j < 8; ++j) s += o[j];
            const float mean = red8(s) * (1.0f / 64.0f);
            float q = 0.f;
#pragma unroll
            for (int j = 0; j < 8; ++j) { o[j] -= mean; q += o[j] * o[j]; }
            const float rstd = __builtin_amdgcn_rsqf(red8(q) * (1.0f / 64.0f) + 64e-5f);
            float v[8], pv[8], g[8];
            unpack8(*(const u32x4*)(P + t * DIN + 1024 + c0), v);
            if ((t & (SEQ - 1)) != 0) unpack8(*(const u32x4*)(P + (t - 1) * DIN + 1024 + c0), pv);
            else {
#pragma unroll
                for (int j = 0; j < 8; ++j) pv[j] = 0.f; }
            unpack8(*(const u32x4*)(LR + t * 1536 + 1024 + c0), g);
            const float bon = BON[t * 8 + hh];
#pragma unroll
            for (int j = 0; j < 8; ++j) { const float vl = v[j] + (pv[j] - v[j]) * muv[c0 + j];
                y[j] = (o[j] * rstd * lnw[c0 + j] + lnb[c0 + j] + bon * vl) * g[j]; }
            *(u32x4*)(Y + t * D + c0) = pack8(y);
        } else {
            const int h = hh - 8, c0 = 64 * h + 8 * cg;
            const f32x4 o0 = *(const f32x4*)(OH + t * 512 + c0), o1 = *(const f32x4*)(OH + t * 512 + c0 + 4);
            o[0] = o0.x; o[1] = o0.y; o[2] = o0.z; o[3] = o0.w; o[4] = o1.x; o[5] = o1.y; o[6] = o1.z; o[7] = o1.w;
            float q = 0.f;
#pragma unroll
            for (int j = 0; j < 8; ++j) q += o[j] * o[j];
            const float rs = __builtin_amdgcn_rsqf(red8(q) * (1.0f / 64.0f) + 1e-6f);
            float g[8];
            unpack8(*(const u32x4*)(P + t * DIN + C_HG + 1536 + c0), g);
#pragma unroll
            for (int j = 0; j < 8; ++j) y[j] = o[j] * rs * gn[8 * cg + j] * siluf_(g[j]);
            *(u32x4*)(Y + t * D + 1536 + c0) = pack8(y);
        }
    }
}

__device__ __forceinline__ void attn_phase(ArgsRef a, int l, LAS unsigned char* lds) {
    const int TID = opaque_tid(), BID = opaque_bid();
    const bf16_t* P = (const bf16_t*)(a.ws + WS_PROJ); bf16_t* Y = (bf16_t*)(a.ws + WS_YC);
    const int* pos = (const int*)a.in[1];
    const float* qn = (const float*)a.in[19] + (size_t)l * 64; const float* kn = (const float*)a.in[20] + (size_t)l * 64; const float* sinks = (const float*)a.in[21] + (size_t)l * 8;
    constexpr int KST = 144, VST = 528;
    LAS unsigned char* sK = lds; LAS unsigned char* sVt = sK + 256 * KST; LAS unsigned char* sQ = sVt + 64 * VST; LAS float* sM = (LAS float*)(sQ + 512 * KST);
    const int tid = TID, cg = tid & 7, wave = tid >> 6, lane = tid & 63;
    float kmaxg = 0.f;
    for (int j = 0; j < 64; ++j) kmaxg = fmaxf(kmaxg, fabsf(kn[j]));
    const float kbound = 8.0f * kmaxg;
    float gk[8], gq[8], invf[8];
#pragma unroll
    for (int j = 0; j < 8; ++j) { gk[j] = kn[8 * cg + j]; gq[j] = qn[8 * cg + j]; invf[j] = exp2f(-(float)j * (18.931568569324174f / 8.0f)); }
    for (int job = BID; job < 512; job += gridDim.x) {
        const int b = job >> 5, nb = (job >> 1) & 15, kvh = job & 1;
        __syncthreads();
#pragma unroll 1
        for (int r = 0; r < 4; ++r) {
            const int kj = (tid >> 3) + 64 * r, s = (nb - 1) * 128 + kj;
            float k[8], v[8];
            if (s >= 0) {
                const size_t t = (size_t)b * SEQ + s;
                unpack8(*(const u32x4*)(P + t * DIN + C_ATT + 512 + 64 * kvh + 8 * cg), k); unpack8(*(const u32x4*)(P + t * DIN + C_ATT + 640 + 64 * kvh + 8 * cg), v);
            } else {
#pragma unroll
                for (int j = 0; j < 8; ++j) { k[j] = 0.f; v[j] = 0.f; } }
            float ss = 0.f;
#pragma unroll
            for (int j = 0; j < 8; ++j) ss += k[j] * k[j];
            ss = red8(ss);
            const float rs = __builtin_amdgcn_rsqf(ss * (1.0f / 64.0f) + 1e-6f);
#pragma unroll
            for (int j = 0; j < 8; ++j) k[j] = k[j] * rs * gk[j];
            const float pf = (float)pos[b * SEQ + (s >= 0 ? s : 0)];
#pragma unroll
            for (int j = 0; j < 8; ++j) {
                const float other = dpp<XOR1>(k[j]);
                if (cg < 2) { float sn, cs; sincos_big(pf * invf[j], sn, cs); k[j] = (cg == 0) ? (k[j] * cs - other * sn) : (k[j] * cs + other * sn); }
            }
            *(LAS u32x4*)(sK + kj * KST + 16 * cg) = pack8(k);
#pragma unroll
            for (int j = 0; j < 8; j += 2) { const unsigned w = pk2(v[j], v[j + 1]);
                *(LAS unsigned short*)(sVt + (8 * cg + j) * VST + 2 * kj) = (unsigned short)(w & 0xffffu); *(LAS unsigned short*)(sVt + (8 * cg + j + 1) * VST + 2 * kj) = (unsigned short)(w >> 16); }
        }
#pragma unroll 1
        for (int r = 0; r < 8; ++r) {
            const int row = (tid >> 3) + 64 * r, g = row >> 7, qi = row & 127, hq = 4 * kvh + g;
            const size_t tq = (size_t)b * SEQ + nb * 128 + qi;
            float q[8];
            unpack8(*(const u32x4*)(P + tq * DIN + C_ATT + 64 * hq + 8 * cg), q);
            float ss = 0.f;
#pragma unroll
            for (int j = 0; j < 8; ++j) ss += q[j] * q[j];
            ss = red8(ss);
            const float rs = 0.125f * __builtin_amdgcn_rsqf(ss * (1.0f / 64.0f) + 1e-6f);
#pragma unroll
            for (int j = 0; j < 8; ++j) q[j] = q[j] * rs * gq[j];
            const float pf = (float)pos[b * SEQ + nb * 128 + qi];
            float qq = 0.f;
#pragma unroll
            for (int j = 0; j < 8; ++j) {
                const float other = dpp<XOR1>(q[j]);
                if (cg < 2) { float sn, cs; sincos_big(pf * invf[j], sn, cs); q[j] = (cg == 0) ? (q[j] * cs - other * sn) : (q[j] * cs + other * sn); }
                qq += q[j] * q[j];
            }
            qq = red8(qq);
            if (cg == 0) sM[row] = sqrtf(qq) * kbound;
            *(LAS u32x4*)(sQ + row * KST + 16 * cg) = pack8(q);
        }
        __syncthreads();
        const int g = wave >> 1, qh = wave & 1, hq = 4 * kvh + g, fr = lane & 15, fq = lane >> 4;
        const float sinkv = sinks[hq];
#pragma unroll 1
        for (int qt = 0; qt < 4; ++qt) {
            const int qi0 = 64 * qh + 16 * qt, R0 = g * 128 + qi0, kt0 = qi0 >> 4;
            const bf16x8 qf0 = *(const LAS bf16x8*)(sQ + (R0 + fr) * KST + 16 * fq), qf1 = *(const LAS bf16x8*)(sQ + (R0 + fr) * KST + 16 * fq + 64);
            const float msh = sM[R0 + fr];
            const int ql = qi0 + fr;
            f32x4 oacc[4];
#pragma unroll
            for (int dt = 0; dt < 4; ++dt) oacc[dt] = (f32x4){0.f, 0.f, 0.f, 0.f};
            float lsum = 0.f;
#pragma unroll
            for (int ks = 0; ks < 5; ++ks) {
                unsigned pw[4];
#pragma unroll
                for (int h2 = 0; h2 < 2; ++h2) {
                    const int ti = 2 * ks + h2, kt = (kt0 + ti) < 15 ? (kt0 + ti) : 15;
                    const bf16x8 kf0 = *(const LAS bf16x8*)(sK + (16 * kt + fr) * KST + 16 * fq), kf1 = *(const LAS bf16x8*)(sK + (16 * kt + fr) * KST + 16 * fq + 64);
                    f32x4 sc = (f32x4){0.f, 0.f, 0.f, 0.f};
                    sc = __builtin_amdgcn_mfma_f32_16x16x32_bf16(kf0, qf0, sc, 0, 0, 0);
                    sc = __builtin_amdgcn_mfma_f32_16x16x32_bf16(kf1, qf1, sc, 0, 0, 0);
                    float p[4];
#pragma unroll
                    for (int j = 0; j < 4; ++j) { const int kj = 16 * (kt0 + ti) + 4 * fq + j;
                        const bool valid = (kj > ql) && (kj <= ql + 128) && (nb > 0 || kj >= 128);
                        p[j] = valid ? __expf(sc[j] - msh) : 0.f; lsum += p[j]; }
                    pw[2 * h2] = pk2(p[0], p[1]); pw[2 * h2 + 1] = pk2(p[2], p[3]);
                }
                const u32x4 pq = (u32x4){pw[0], pw[1], pw[2], pw[3]};
                const bf16x8 pf = __builtin_bit_cast(bf16x8, pq);
                const int kta = (kt0 + 2 * ks) < 15 ? (kt0 + 2 * ks) : 15, ktb = (kt0 + 2 * ks + 1) < 15 ? (kt0 + 2 * ks + 1) : 15;
#pragma unroll
                for (int dt = 0; dt < 4; ++dt) {
                    const u32x2 va = *(const LAS u32x2*)(sVt + (16 * dt + fr) * VST + (16 * kta + 4 * fq) * 2), vb = *(const LAS u32x2*)(sVt + (16 * dt + fr) * VST + (16 * ktb + 4 * fq) * 2);
                    const u32x4 vq = (u32x4){va.x, va.y, vb.x, vb.y};
                    oacc[dt] = __builtin_amdgcn_mfma_f32_16x16x32_bf16(__builtin_bit_cast(bf16x8, vq), pf, oacc[dt], 0, 0, 0);
                }
            }
            lsum += __shfl_xor(lsum, 16); lsum += __shfl_xor(lsum, 32);
            const float inv = __builtin_amdgcn_rcpf(lsum + __expf(sinkv - msh));
            const size_t tq = (size_t)b * SEQ + nb * 128 + ql;
#pragma unroll
            for (int dt = 0; dt < 4; ++dt) { u32x2 w; w.x = pk2(oacc[dt][0] * inv, oacc[dt][1] * inv); w.y = pk2(oacc[dt][2] * inv, oacc[dt][3] * inv);
                *(u32x2*)(Y + tq * D + 512 + 64 * hq + 16 * dt + 4 * fq) = w; }
        }
    }
    __syncthreads();
}

__device__ __forceinline__ void s5_phase(ArgsRef a, int l, LAS unsigned char* lds) {
    const int TID = opaque_tid(), BID = opaque_bid(); (void)TID; (void)BID;
    const bf16_t* P = (const bf16_t*)(a.ws + WS_PROJ); bf16_t* Z = (bf16_t*)(a.ws + WS_Z);
    const int tid = TID, wave = tid >> 6, lane = tid & 63;
    LAS float* sU = (LAS float*)lds + wave * 1024;
    LAS float* sX = (LAS float*)lds + 8192 + wave * (16 * 130);
    LAS float* sE = (LAS float*)lds + 8192 + 8 * 16 * 130;
    for (int job = BID; job < 512; job += gridDim.x) {
        const int b = job >> 5, g = job & 31;
        const float lre = ((const float*)a.in[22])[(size_t)l * 2048 + g * 64 + lane], lim = ((const float*)a.in[23])[(size_t)l * 2048 + g * 64 + lane];
        const float dt = expf(((const float*)a.in[24])[l * 32 + g]);
        float sn, cs; sincos_big(lim * dt, sn, cs);
        const float er = expf(lre * dt), lbr = er * cs, lbi = er * sn;
        const float den = 1.0f / (lre * lre + lim * lim);
        const float fr = ((lbr - 1.0f) * lre + lbi * lim) * den, fi = (lbi * lre - (lbr - 1.0f) * lim) * den;
        f32x2 bb[16];
        {
            const f32x4* br = (const f32x4*)((const float*)a.in[25] + ((size_t)l * 2048 + g * 64 + lane) * 16); const f32x4* bi = (const f32x4*)((const float*)a.in[26] + ((size_t)l * 2048 + g * 64 + lane) * 16);
#pragma unroll
            for (int q = 0; q < 4; ++q) { const f32x4 r4 = br[q], i4 = bi[q];
                bb[4 * q] = (f32x2){fr * r4.x - fi * i4.x, fr * i4.x + fi * r4.x}; bb[4 * q + 1] = (f32x2){fr * r4.y - fi * i4.y, fr * i4.y + fi * r4.y};
                bb[4 * q + 2] = (f32x2){fr * r4.z - fi * i4.z, fr * i4.z + fi * r4.z}; bb[4 * q + 3] = (f32x2){fr * r4.w - fi * i4.w, fr * i4.w + fi * r4.w}; }
        }
        float creg[32];
        {
            const float* cre = (const float*)a.in[27] + ((size_t)l * 32 + g) * 1024 + (lane & 15) * 64 + (lane >> 4);
            const float* cim = (const float*)a.in[28] + ((size_t)l * 32 + g) * 1024 + (lane & 15) * 64 + (lane >> 4);
#pragma unroll
            for (int kk = 0; kk < 16; ++kk) { creg[kk] = cre[4 * kk]; creg[16 + kk] = -cim[4 * kk]; }
        }
        f32x4 dsk;
        { const float* dp = (const float*)a.in[29] + (size_t)l * 512 + 16 * g + 4 * (lane >> 4); dsk = (f32x4){dp[0], dp[1], dp[2], dp[3]}; }
        const size_t tbase = (size_t)b * SEQ + wave * 256;
        f32x2 xs = (f32x2){0.f, 0.f}; const f32x2 lbr2 = (f32x2){lbr, lbr}, lbi2 = (f32x2){lbi, lbi};
        for (int c = 0; c < 4; ++c) {
            { const size_t t = tbase + c * 64 + lane; float u[16]; unpack8(*(const u32x4*)(P + t * DIN + C_S5 + 16 * g), u); unpack8(*(const u32x4*)(P + t * DIN + C_S5 + 16 * g + 8), u + 8);
              LAS f32x4* d = (LAS f32x4*)(sU + lane * 16); d[0] = (f32x4){u[0], u[1], u[2], u[3]}; d[1] = (f32x4){u[4], u[5], u[6], u[7]}; d[2] = (f32x4){u[8], u[9], u[10], u[11]}; d[3] = (f32x4){u[12], u[13], u[14], u[15]}; }
            LDS_FENCE();
#pragma unroll 2
            for (int s = 0; s < 64; ++s) {
                const LAS f32x4* up = (const LAS f32x4*)(sU + s * 16);
                f32x2 bu0 = (f32x2){0.f, 0.f}, bu1 = bu0;
#pragma unroll
                for (int q = 0; q < 4; ++q) { const f32x4 u4 = up[q];
                    bu0 = pfma(bb[4 * q], (f32x2){u4.x, u4.x}, bu0); bu1 = pfma(bb[4 * q + 1], (f32x2){u4.y, u4.y}, bu1);
                    bu0 = pfma(bb[4 * q + 2], (f32x2){u4.z, u4.z}, bu0); bu1 = pfma(bb[4 * q + 3], (f32x2){u4.w, u4.w}, bu1); }
                { const f32x2 nx = pfma(lbr2, xs, bu0 + bu1); xs = pfma(lbi2, (f32x2){-xs.y, xs.x}, nx); }
            }
            LDS_FENCE();
        }
        sE[wave * 128 + lane] = xs.x; sE[wave * 128 + 64 + lane] = xs.y;
        float pr = lbr, pi = lbi;
#pragma unroll
        for (int i = 0; i < 8; ++i) { const float nr = pr * pr - pi * pi, ni = 2.0f * pr * pi; pr = nr; pi = ni; }
        __syncthreads();
        xs = (f32x2){0.f, 0.f};
        for (int w = 0; w < wave; ++w) { const float er_ = sE[w * 128 + lane], ei_ = sE[w * 128 + 64 + lane];
            const float nr = pr * xs.x - pi * xs.y + er_, ni = pr * xs.y + pi * xs.x + ei_; xs.x = nr; xs.y = ni; }
        for (int c = 0; c < 4; ++c) {
            { const size_t t = tbase + c * 64 + lane; float u[16]; unpack8(*(const u32x4*)(P + t * DIN + C_S5 + 16 * g), u); unpack8(*(const u32x4*)(P + t * DIN + C_S5 + 16 * g + 8), u + 8);
              LAS f32x4* d = (LAS f32x4*)(sU + lane * 16); d[0] = (f32x4){u[0], u[1], u[2], u[3]}; d[1] = (f32x4){u[4], u[5], u[6], u[7]}; d[2] = (f32x4){u[8], u[9], u[10], u[11]}; d[3] = (f32x4){u[12], u[13], u[14], u[15]}; }
            LDS_FENCE();
#pragma unroll 1
            for (int s16 = 0; s16 < 4; ++s16) {
#pragma unroll 2
                for (int s = 0; s < 16; ++s) {
                    const LAS f32x4* up = (const LAS f32x4*)(sU + (s16 * 16 + s) * 16);
                    f32x2 bu0 = (f32x2){0.f, 0.f}, bu1 = bu0;
#pragma unroll
                    for (int q = 0; q < 4; ++q) { const f32x4 u4 = up[q];
                        bu0 = pfma(bb[4 * q], (f32x2){u4.x, u4.x}, bu0); bu1 = pfma(bb[4 * q + 1], (f32x2){u4.y, u4.y}, bu1);
                        bu0 = pfma(bb[4 * q + 2], (f32x2){u4.z, u4.z}, bu0); bu1 = pfma(bb[4 * q + 3], (f32x2){u4.w, u4.w}, bu1); }
                    { const f32x2 nx = pfma(lbr2, xs, bu0 + bu1); xs = pfma(lbi2, (f32x2){-xs.y, xs.x}, nx); }
                    sX[s * 130 + lane] = xs.x; sX[s * 130 + 64 + lane] = xs.y;
                }
                LDS_FENCE();
                f32x4 yacc = (f32x4){0.f, 0.f, 0.f, 0.f}, yacc1 = yacc, yacc2 = yacc, yacc3 = yacc;
                const LAS float* xp = sX + (lane & 15) * 130 + (lane >> 4);
#pragma unroll
                for (int kk = 0; kk < 32; kk += 4) {
                    yacc = __builtin_amdgcn_mfma_f32_16x16x4f32(creg[kk], xp[4 * kk], yacc, 0, 0, 0);
                    yacc1 = __builtin_amdgcn_mfma_f32_16x16x4f32(creg[kk + 1], xp[4 * kk + 4], yacc1, 0, 0, 0);
                    yacc2 = __builtin_amdgcn_mfma_f32_16x16x4f32(creg[kk + 2], xp[4 * kk + 8], yacc2, 0, 0, 0);
                    yacc3 = __builtin_amdgcn_mfma_f32_16x16x4f32(creg[kk + 3], xp[4 * kk + 12], yacc3, 0, 0, 0);
                }
                yacc = (yacc + yacc1) + (yacc2 + yacc3);
                const int tok = s16 * 16 + (lane & 15);
                const f32x4 u4 = *(const LAS f32x4*)(sU + tok * 16 + 4 * (lane >> 4));
                float z[4];
#pragma unroll
                for (int j = 0; j < 4; ++j) { const float y = yacc[j] + dsk[j] * u4[j]; z[j] = 0.5f * y * (1.0f + erff(y * 0.70710678118654752f)); }
                u32x2 w; w.x = pk2(z[0], z[1]); w.y = pk2(z[2], z[3]);
                *(u32x2*)(Z + (tbase + c * 64 + tok) * 512 + 16 * g + 4 * (lane >> 4)) = w;
                LDS_FENCE();
            }
        }
        __syncthreads();
    }
}

#define XB_TMO      128
#define XB_XCNT(j)  (256  + 64 * (j))
#define XB_XSUB(j)  (1280 + 64 * (j))
#define XB_XGEN(j)  (2304 + 64 * (j))
#define XB_TOP      3328
#define XB_TOPGEN   3392
#define XCD_BAR_WORDS 3456
#define XB_SPIN_CAP (1u << 18)

__device__ __forceinline__ unsigned xb_ld(unsigned* p)              { return __hip_atomic_load(p, __ATOMIC_RELAXED, __HIP_MEMORY_SCOPE_AGENT); }
__device__ __forceinline__ unsigned xb_add(unsigned* p, unsigned v) { return __hip_atomic_fetch_add(p, v, __ATOMIC_RELAXED, __HIP_MEMORY_SCOPE_AGENT); }
__device__ __forceinline__ unsigned xb_xcc_id() { return (unsigned)__builtin_amdgcn_s_getreg((3 << 11) | 20) & 0xFu; }
#define XB_SPIN(cond, bar) do { unsigned _sp = 0; while (cond) { __builtin_amdgcn_s_sleep(1); \
    if ((++_sp & 255u) == 0u) { if (xb_ld(&(bar)[XB_TMO])) break; if (_sp > XB_SPIN_CAP) { atomicAdd(&(bar)[XB_TMO], 1u); break; } } } } while (0)

struct XcdBarrier {
    unsigned* bar; unsigned x;
    volatile LAS unsigned* st;
};

__device__ __forceinline__ XcdBarrier xcd_barrier_post(unsigned* bar, volatile LAS unsigned* st) {
    XcdBarrier b; b.bar = bar; b.x = xb_xcc_id(); b.st = st;
    if (threadIdx.x == 0) (void)xb_add(&bar[XB_XCNT(b.x)], 1u);
    return b;
}
__device__ __forceinline__ void xcd_barrier_complete(unsigned* bar, unsigned x, unsigned& nloc, unsigned& nx) {
    const unsigned G = gridDim.x * gridDim.y * gridDim.z;
    unsigned sum, cnt, mine, sp = 0u;
    for (;;) {
        sum = 0u; cnt = 0u; mine = 0u;
#pragma unroll
        for (unsigned j = 0; j < 16; ++j) { const unsigned c = xb_ld(&bar[XB_XCNT(j)]); sum += c; cnt += (c > 0u) ? 1u : 0u; mine = (j == x) ? c : mine; }
        if (sum == G) break;
        __builtin_amdgcn_s_sleep(1);
        if ((++sp & 255u) == 0u) { if (xb_ld(&bar[XB_TMO])) break; if (sp > XB_SPIN_CAP) { atomicAdd(&bar[XB_TMO], 1u); break; } }
    }
    nloc = mine > 0u ? mine : 1u; nx = cnt > 0u ? cnt : 1u;
}

__device__ __forceinline__ void xcd_barrier(const XcdBarrier& b) {
    asm volatile("s_waitcnt vmcnt(0)" ::: "memory");
    __syncthreads();
    if (threadIdx.x == 0) {
        unsigned* bar = b.bar;
        __builtin_amdgcn_s_waitcnt(0);
        unsigned nloc = b.st[0], nx = b.st[1];
        if (nloc == 0u) { xcd_barrier_complete(bar, b.x, nloc, nx); b.st[0] = nloc; b.st[1] = nx; }
        const unsigned old = xb_add(&bar[XB_XSUB(b.x)], 1u);
        const unsigned gen = old / nloc;
        if (old + 1u == (gen + 1u) * nloc) {
            __builtin_amdgcn_fence(__ATOMIC_RELEASE, "agent");
            asm volatile("s_waitcnt vmcnt(0)" ::: "memory");
            const unsigned og = xb_add(&bar[XB_TOP], 1u);
            const unsigned tg = og / nx;
            if (og + 1u == (tg + 1u) * nx) xb_add(&bar[XB_TOPGEN], 1u);
            else XB_SPIN(xb_ld(&bar[XB_TOPGEN]) == tg, bar);
            __builtin_amdgcn_fence(__ATOMIC_ACQUIRE, "agent");
            xb_add(&bar[XB_XGEN(b.x)], 1u);
            asm volatile("s_waitcnt vmcnt(0)" ::: "memory");
        } else {
            XB_SPIN(xb_ld(&bar[XB_XGEN(b.x)]) == gen, bar);
            __builtin_amdgcn_fence(__ATOMIC_ACQUIRE, "agent");
            asm volatile("s_waitcnt vmcnt(0)" ::: "memory");
        }
    }
    __syncthreads();
}


constexpr int NPH = 11;
#ifndef DUPMASK
#define DUPMASK 0
#endif
__global__ void __launch_bounds__(NTHREADS, 2) mega(Args a_, int lo, int hi) {
    extern __shared__ __attribute__((aligned(16))) unsigned char lds_raw[];
    LAS unsigned char* lds = (LAS unsigned char*)lds_raw;
#ifdef EXTRA_SYNCS
    for (int i = 0; i < EXTRA_SYNCS; ++i) { __syncthreads(); cg::this_grid().sync(); }
#endif
    LAS unsigned* xst = (LAS unsigned*)(lds + LDS_BYTES - 16);
    if (hi - lo > 1) {
        if (threadIdx.x == 0) { xst[0] = 0u; xst[1] = 0u; }
        __syncthreads();
        const __attribute__((address_space(4))) Args* ap0 = (const __attribute__((address_space(4))) Args*)__builtin_amdgcn_kernarg_segment_ptr();
        (void)xcd_barrier_post((unsigned*)(ap0->ws + WS_BAR), (volatile LAS unsigned*)xst);
    }
#pragma unroll 1
    for (int step2 = 2 * lo; step2 < 2 * hi; ++step2) {
        const int step = step2 >> 1;
        if ((step2 & 1) && !((DUPMASK >> (step % NPH)) & 1)) continue;
        const __attribute__((address_space(4))) Args* ap = (const __attribute__((address_space(4))) Args*)__builtin_amdgcn_kernarg_segment_ptr();
        asm volatile("" : "+s"(ap));
        ArgsRef a = *ap;
        unsigned char* ws = a.ws;
        float* SSa = (float*)(ws + WS_SS); float* SSb = SSa + T; float* SSc = SSb + T;
        const int l = step / NPH, ph = step % NPH;
        const float* xin = (l == 0) ? (const float*)a.in[0] : (const float*)a.out;
#ifndef PHMASK
#define PHMASK 0x7ff
#endif
        switch (ph) {
        case 0: if (PHMASK & (1 << 0)) { conv_phase(a, l, lds); if (l == 0) norm_phase(xin, (bf16_t*)(ws + WS_XN), SSa); zero_phase(SSb, T); } break;
        case 1: if (PHMASK & (1 << 1)) { pg8::EpiSwiGLU E; E.H = (bf16_t*)(ws + WS_HID); E.SS = SSa; run_gemm(lds, (const bf16_t*)(ws + WS_XN), (const bf16_t*)(ws + W_UP1), 2 * FF, D, E); } break;
        case 2: if (PHMASK & (1 << 2)) { pg8::EpiResidual<true> E; E.base = xin; E.out = a.out; E.XN = (bf16_t*)(ws + WS_XN); E.SS = SSb; run_gemm(lds, (const bf16_t*)(ws + WS_HID), (const bf16_t*)(ws + W_DN1), D, FF, E); } break;
        case 3: if (PHMASK & (1 << 3)) { pg8::EpiBf16 E; E.O = (bf16_t*)(ws + WS_PROJ); E.ldc = DIN; E.SS = SSb; run_gemm(lds, (const bf16_t*)(ws + WS_XN), (const bf16_t*)(ws + W_IN), DIN, D, E); } break;
        case 4: if (PHMASK & (1 << 4)) { zero_phase(SSa, T); zero_phase(SSc, T); alr_phase(a, l); attn_phase(a, l, lds); s5_phase(a, l, lds); hgrn_phase(a, l, lds); } break;
        case 5: if (PHMASK & (1 << 5)) { pg8::EpiLR E; E.O = (bf16_t*)(ws + WS_LRO); E.w0 = (const float*)a.in[9] + (size_t)l * 512; E.a0 = (const float*)a.in[11] + (size_t)l * 512;
                  run_gemm(lds, (const bf16_t*)(ws + WS_ALR), (const bf16_t*)(ws + W_LR), 1536, 256, E);
                  pg8::EpiGLU G; G.Z = (const bf16_t*)(ws + WS_Z); G.Y = (bf16_t*)(ws + WS_YC); G.b = (const float*)a.in[31] + (size_t)l * 512;
                  run_gemm(lds, (const bf16_t*)(ws + WS_Z), (const bf16_t*)(ws + W_GLU), 512, 512, G); } break;
        case 6: if (PHMASK & (1 << 6)) rwkv_phase(a, l, lds); break;
        case 7: if (PHMASK & (1 << 7)) post_phase(a, l); break;
        case 8: if (PHMASK & (1 << 8)) { pg8::EpiResidual<false> E; E.base = a.out; E.out = a.out; E.XN = (bf16_t*)(ws + WS_XN); E.SS = SSc; run_gemm(lds, (const bf16_t*)(ws + WS_YC), (const bf16_t*)(ws + W_OUT), D, D, E); } break;
        case 9: if (PHMASK & (1 << 9)) { pg8::EpiSwiGLU E; E.H = (bf16_t*)(ws + WS_HID); E.SS = SSc; run_gemm(lds, (const bf16_t*)(ws + WS_XN), (const bf16_t*)(ws + W_UP2), 2 * FF, D, E); } break;
        case 10: if (PHMASK & (1 << 10)) { pg8::EpiResidual<true> E; E.base = a.out; E.out = a.out; E.XN = (l + 1 < NL) ? (bf16_t*)(ws + WS_XN) : nullptr; E.SS = SSa; run_gemm(lds, (const bf16_t*)(ws + WS_HID), (const bf16_t*)(ws + W_DN2), D, FF, E); } break;
        }
        if (step2 + 1 < 2 * hi) {
            if (step2 == 2 * lo) { __syncthreads(); cg::this_grid().sync(); }
            else { XcdBarrier xb; xb.bar = (unsigned*)(ws + WS_BAR); xb.x = xb_xcc_id(); xb.st = (volatile LAS unsigned*)xst; xcd_barrier(xb); }
        }
    }
}

extern "C" void kernel_launch(void* const* d_in, const int* in_sizes, int n_in, void* d_out, int out_size, void* d_ws, size_t ws_size, hipStream_t stream) {
    static int grid = 0;
    if (!grid) {
        int dev = 0, cus = 0, per_cu = 0;
        hipGetDevice(&dev);
        hipDeviceGetAttribute(&cus, hipDeviceAttributeMultiprocessorCount, dev);
        hipFuncSetAttribute((const void*)mega, hipFuncAttributeMaxDynamicSharedMemorySize, LDS_BYTES);
        hipOccupancyMaxActiveBlocksPerMultiprocessor(&per_cu, (const void*)mega, NTHREADS, LDS_BYTES);
        if (per_cu < 1) per_cu = 1;
        grid = cus * 1;
        if (grid != 256) fprintf(stderr, "kernel_launch: grid %d (cus %d, per_cu %d)\n", grid, cus, per_cu);
    }
    Args a{};
    for (int i = 0; i < 39; ++i) a.in[i] = d_in[i];
    a.out = (float*)d_out; a.ws = (unsigned char*)d_ws;
#if ONE_LAUNCH
    (void)hipMemsetAsync((unsigned char*)d_ws + WS_BAR, 0, 16384, stream);
    int lo = 0, hi = NL * NPH;
    void* args[] = {&a, &lo, &hi};
    hipError_t e = hipLaunchCooperativeKernel((void*)mega, dim3(grid), dim3(NTHREADS), args, LDS_BYTES, stream);
    if (e != hipSuccess) fprintf(stderr, "cooperative launch failed: %s (grid %d)\n", hipGetErrorString(e), grid);
#else
    for (int s = 0; s < NL * NPH; ++s) hipLaunchKernelGGL(mega, dim3(grid), dim3(NTHREADS), LDS_BYTES, stream, a, s, s + 1);
#endif
}
```

```cpp
#include <hip/hip_runtime.h>
#include <hip/hip_cooperative_groups.h>
#include <cstdio>
#include <cstdint>
namespace cg = cooperative_groups;

#ifndef ONE_LAUNCH
#define ONE_LAUNCH 1
#endif

#define LAS __attribute__((address_space(3)))
typedef unsigned short bf16_t;
typedef short bf16x8 __attribute__((ext_vector_type(8)));
typedef float f32x4 __attribute__((ext_vector_type(4)));
typedef float f32x2 __attribute__((ext_vector_type(2)));
typedef unsigned u32x4 __attribute__((ext_vector_type(4)));
typedef unsigned u32x2 __attribute__((ext_vector_type(2)));

constexpr int T = 32768, SEQ = 2048, NB = 16, D = 2048, FF = 5632, DIN = 5120, NL = 2;
constexpr int C_RWKV = 0, C_ATT = 1792, C_S5 = 2560, C_HG = 3072;
constexpr int NTHREADS = 512, NWAVES = 8;

constexpr size_t SZ_UP = (size_t)2 * FF * D * 2, SZ_DN = (size_t)D * FF * 2, SZ_IN = (size_t)DIN * D * 2, SZ_LR = (size_t)1536 * 256 * 2,
                 SZ_GLU = (size_t)512 * 512 * 2, SZ_OUT = (size_t)D * D * 2;
constexpr size_t W_UP1 = 0, W_DN1 = W_UP1 + SZ_UP, W_IN = W_DN1 + SZ_DN, W_LR = W_IN + SZ_IN, W_GLU = W_LR + SZ_LR, W_OUT = W_GLU + SZ_GLU,
                 W_UP2 = W_OUT + SZ_OUT, W_DN2 = W_UP2 + SZ_UP, W_END = W_DN2 + SZ_DN;
constexpr size_t WS_XN = W_END, WS_BIG = WS_XN + (size_t)T * D * 2;
constexpr size_t WS_HID = WS_BIG;
constexpr size_t WS_PROJ = WS_BIG, WS_LRO = WS_PROJ + (size_t)T * DIN * 2, WS_ALR = WS_LRO + (size_t)T * 1536 * 2, WS_Z = WS_ALR + (size_t)T * 256 * 2,
                 WS_OR = WS_Z + (size_t)T * 512 * 2, WS_OH = WS_OR + (size_t)T * 512 * 4, WS_BON = WS_OH + (size_t)T * 512 * 4, WS_YC = WS_BON + (size_t)T * 8 * 4, WS_SS = WS_YC + (size_t)T * D * 2, WS_BAR = WS_SS + (size_t)3 * T * 4, WS_END = WS_BAR + 16384;
static_assert(WS_END <= (size_t)1 << 30, "workspace");
static_assert(WS_HID + (size_t)T * FF * 2 <= (size_t)1 << 30, "workspace");

constexpr int LDS_BYTES = 147456;

struct Args { const void* in[39]; float* out; unsigned char* ws; };
typedef const __attribute__((address_space(4))) Args& ArgsRef;

typedef __bf16 bf16x2_t __attribute__((ext_vector_type(2)));
__device__ __forceinline__ unsigned pk2(float lo, float hi) { const f32x2 v = (f32x2){lo, hi}; return __builtin_bit_cast(unsigned, __builtin_convertvector(v, bf16x2_t)); }
__device__ __forceinline__ float bflo(unsigned w) { return __uint_as_float(w << 16); }
__device__ __forceinline__ float bfhi(unsigned w) { return __uint_as_float(w & 0xffff0000u); }
__device__ __forceinline__ void unpack8(u32x4 q, float* f) { f[0] = bflo(q.x); f[1] = bfhi(q.x); f[2] = bflo(q.y); f[3] = bfhi(q.y); f[4] = bflo(q.z); f[5] = bfhi(q.z); f[6] = bflo(q.w); f[7] = bfhi(q.w); }
__device__ __forceinline__ u32x4 pack8(const float* f) { u32x4 o; o.x = pk2(f[0], f[1]); o.y = pk2(f[2], f[3]); o.z = pk2(f[4], f[5]); o.w = pk2(f[6], f[7]); return o; }
template <int CTRL> __device__ __forceinline__ float dpp(float x) { return __builtin_bit_cast(float, __builtin_amdgcn_mov_dpp(__builtin_bit_cast(int, x), CTRL, 0xf, 0xf, true)); }
constexpr int XOR1 = 0xB1, XOR2 = 0x4E, XOR7 = 0x141, XOR8 = 0x128;
__device__ __forceinline__ float red8(float v) { v += dpp<XOR1>(v); v += dpp<XOR2>(v); v += dpp<XOR7>(v); return v; }
__device__ __forceinline__ float red16(float v) { v = red8(v); v += dpp<XOR8>(v); return v; }
__device__ __forceinline__ float wave_sum(float v) {
#pragma unroll
    for (int o = 1; o < 64; o <<= 1) v += __shfl_xor(v, o);
    return v;
}
__device__ __forceinline__ float sigmoidf_(float x) { return __builtin_amdgcn_rcpf(1.0f + __expf(-x)); }
__device__ __forceinline__ float siluf_(float x) { return x * __builtin_amdgcn_rcpf(1.0f + __expf(-x)); }
__device__ __forceinline__ int opaque_tid() { int t = threadIdx.x; asm volatile("" : "+v"(t)); return t; }
__device__ __forceinline__ int opaque_bid() { int t = blockIdx.x; asm volatile("" : "+s"(t)); return t; }
__device__ __forceinline__ f32x2 pfma(f32x2 a, f32x2 b, f32x2 c) { return __builtin_elementwise_fma(a, b, c); }
#define LDS_FENCE() asm volatile("s_waitcnt lgkmcnt(0)" ::: "memory")
__device__ __forceinline__ void sincos_big(float x, float& sn, float& cs) {
    const float n = rintf(x * 0.15915494309189535f);
    float r = fmaf(-n, 6.28318548202514648f, x); r = fmaf(-n, -1.7484555e-7f, r);
    sn = __sinf(r); cs = __cosf(r);
}

namespace pg8 {
constexpr int BM = 256, BK = 64, HALF = 128, HTB = HALF * BK * 2, STAGE_BYTES = 8 * HTB, NXCD = 8, WGM = 8;
__host__ __device__ __forceinline__ int lds_byte(int r, int c) { const int st = (r >> 4) * 2 + (c >> 5), rr = r & 15, cc = c & 31, ob = rr * 64 + cc * 2; return st * 1024 + (ob ^ (((ob >> 9) & 1) << 5)); }
__host__ __device__ __forceinline__ void stage_rc(int b, int& R, int& C) { const int st = b / 1024, sb = b % 1024, swz = sb ^ (((sb >> 9) & 1) << 5); R = (st >> 1) * 16 + swz / 64; C = (st & 1) * 32 + (swz % 64) / 2; }
__host__ __device__ __forceinline__ int perm32(int rho) { const int n = rho >> 4, i = rho & 15; return 8 * (i >> 2) + 4 * n + (i & 3); }
struct Unit { int pm, pn; };
struct Gemm { const bf16_t* A; const bf16_t* Bt; int M, N, K; };
struct StaticOrder {
    int nM, nN, nwg, G, c;
    __device__ void init(int M, int N, int G_, int c_) { nM = M / BM; nN = N / BM; nwg = nM * nN; G = G_; c = c_; }
    __device__ bool next(int i, Unit& u) const {
        const long L = (long)i * G + c; if (L >= nwg) return false;
        int wgid = (int)L; { const int q = nwg / NXCD, r = nwg % NXCD, xcd = wgid % NXCD, off = wgid / NXCD; wgid = (xcd < r ? xcd * (q + 1) : r * (q + 1) + (xcd - r) * q) + off; }
        const int nig = WGM * nN, gid = wgid / nig, fm = gid * WGM, gsz = (nM - fm) < WGM ? (nM - fm) : WGM;
        u.pm = fm + ((wgid % nig) % gsz); u.pn = (wgid % nig) / gsz; return true;
    }
};
template <class Epi>
__device__ __forceinline__ void gemm_phase(LAS unsigned char* lds, const Gemm g, const StaticOrder S, const Epi E) {
    const int TID = opaque_tid(), BID = opaque_bid(); (void)TID; (void)BID;
    const int tid = TID, wid = __builtin_amdgcn_readfirstlane(tid >> 6), lane = tid & 63, wr = wid >> 2, wc = wid & 3, fr = lane & 15, fq = lane >> 4;
    const int K = g.K, nt = K / BK;
    unsigned voffA[2], voffB[2];
#pragma unroll
    for (int i = 0; i < 2; ++i) { int R, C; stage_rc(tid * 16 + i * 8192, R, C); const int Rb = Epi::PERM ? ((R & ~31) + perm32(R & 31)) : R;
        voffA[i] = (unsigned)(R * K + C) * 2u; voffB[i] = (unsigned)(Rb * K + C) * 2u; }
    const size_t kstep = (size_t)(BK * 2);
    const size_t hstep = (size_t)HALF * K * 2;
    const size_t tstep = 2 * hstep;
    const unsigned ldsw = (unsigned)wid * 1024u;
    const int aoff = lds_byte(wr * 64 + fr, fq * 8), boff = lds_byte(wc * 32 + fr, fq * 8);
#define PG8_SA(b, h) (((b) * 2 + (h)) * HTB)
#define PG8_SB(b, h) ((4 + (b) * 2 + (h)) * HTB)
#define PG8_STAGE(bufoff, gbase, voff) do { _Pragma("unroll") for (int _i = 0; _i < 2; ++_i) \
        __builtin_amdgcn_global_load_lds((const unsigned*)((const char*)(gbase) + (voff)[_i]), (LAS unsigned*)(lds + (bufoff) + ldsw + _i * 8192), 16, 0, 0); } while (0)
#define PG8_LDA(dst, b, h) do { _Pragma("unroll") for (int m = 0; m < 4; ++m) _Pragma("unroll") for (int k = 0; k < 2; ++k) dst[m][k] = *(const LAS bf16x8*)(lds + PG8_SA(b, h) + aoff + m * 2048 + k * 1024); } while (0)
#define PG8_LDB(dst, b, h) do { _Pragma("unroll") for (int n = 0; n < 2; ++n) _Pragma("unroll") for (int k = 0; k < 2; ++k) dst[n][k] = *(const LAS bf16x8*)(lds + PG8_SB(b, h) + boff + n * 2048 + k * 1024); } while (0)
#define PG8_MMA(ai, bj, At, Bt) do { __builtin_amdgcn_s_setprio(1); _Pragma("unroll") for (int m = 0; m < 4; ++m) _Pragma("unroll") for (int n = 0; n < 2; ++n) _Pragma("unroll") for (int k = 0; k < 2; ++k) \
        acc[ai][bj][m][n] = __builtin_amdgcn_mfma_f32_16x16x32_bf16(Bt[n][k], At[m][k], acc[ai][bj][m][n], 0, 0, 0); __builtin_amdgcn_s_setprio(0); } while (0)
#define PG8_WAIT_V(n) asm volatile("s_waitcnt vmcnt(" #n ")" ::: "memory")
#define PG8_WAIT_L(n) asm volatile("s_waitcnt lgkmcnt(" #n ")" ::: "memory")
#define PG8_BAR __builtin_amdgcn_s_barrier()
#define PG8_SCHED __builtin_amdgcn_sched_barrier(0)
    Unit cur, nxt; int ui = 0;
    if (!S.next(0, cur)) return;
    f32x4 acc[2][2][4][2];
#pragma unroll
    for (int a = 0; a < 2; ++a)
#pragma unroll
        for (int b = 0; b < 2; ++b)
#pragma unroll
            for (int m = 0; m < 4; ++m)
#pragma unroll
                for (int n = 0; n < 2; ++n) acc[a][b][m][n] = (f32x4){0.f, 0.f, 0.f, 0.f};
    bf16x8 At[4][2], B0[2][2], B1[2][2];
    const char* cA = (const char*)g.A + (size_t)cur.pm * tstep; const char* cB = (const char*)g.Bt + (size_t)cur.pn * tstep;
    PG8_STAGE(PG8_SB(0, 0), cB, voffB); PG8_STAGE(PG8_SA(0, 0), cA, voffA); PG8_STAGE(PG8_SB(0, 1), cB + hstep, voffB); PG8_STAGE(PG8_SA(0, 1), cA + hstep, voffA);
    if (wr == 1) PG8_BAR;
    PG8_WAIT_V(4); PG8_BAR;
    PG8_STAGE(PG8_SB(1, 0), cB + kstep, voffB); PG8_STAGE(PG8_SA(1, 0), cA + kstep, voffA); PG8_STAGE(PG8_SB(1, 1), cB + hstep + kstep, voffB);
    PG8_WAIT_V(6); PG8_BAR;
    for (;;) {
        const bool has_next = S.next(ui + 1, nxt);
        const char* nA = has_next ? (const char*)g.A + (size_t)nxt.pm * tstep : cA; const char* nB = has_next ? (const char*)g.Bt + (size_t)nxt.pn * tstep : cB;
#pragma unroll 1
        for (int t = 0; t < nt; t += 2) {
            const bool last = (t == nt - 2);
            const char* a1 = cA + (size_t)(t + 1) * kstep;
            const char* a2 = last ? nA : cA + (size_t)(t + 2) * kstep; const char* b2 = last ? nB : cB + (size_t)(t + 2) * kstep;
            const char* a3 = a2 + kstep; const char* b3 = b2 + kstep;
            PG8_LDB(B0, 0, 0); PG8_SCHED; PG8_LDA(At, 0, 0); PG8_STAGE(PG8_SA(1, 1), a1 + hstep, voffA);
            PG8_WAIT_L(8); PG8_BAR; PG8_WAIT_L(0); PG8_MMA(0, 0, At, B0); PG8_BAR; PG8_SCHED;
            PG8_LDB(B1, 0, 1); PG8_STAGE(PG8_SB(0, 0), b2, voffB);
            PG8_BAR; PG8_WAIT_L(0); PG8_MMA(0, 1, At, B1); PG8_BAR;
            PG8_LDA(At, 0, 1); PG8_STAGE(PG8_SA(0, 0), a2, voffA);
            PG8_BAR; PG8_WAIT_L(0); PG8_MMA(1, 0, At, B0); PG8_BAR; PG8_SCHED;
            PG8_STAGE(PG8_SB(0, 1), b2 + hstep, voffB);
            PG8_WAIT_V(6); PG8_BAR; PG8_MMA(1, 1, At, B1); PG8_BAR;
            PG8_LDB(B0, 1, 0); PG8_SCHED; PG8_LDA(At, 1, 0); PG8_STAGE(PG8_SA(0, 1), a2 + hstep, voffA);
            PG8_WAIT_L(8); PG8_BAR; PG8_WAIT_L(0); PG8_MMA(0, 0, At, B0); PG8_BAR; PG8_SCHED;
            PG8_LDB(B1, 1, 1); PG8_STAGE(PG8_SB(1, 0), b3, voffB);
            PG8_BAR; PG8_WAIT_L(0); PG8_MMA(0, 1, At, B1); PG8_BAR;
            PG8_LDA(At, 1, 1); PG8_STAGE(PG8_SA(1, 0), a3, voffA);
            PG8_BAR; PG8_WAIT_L(0); PG8_MMA(1, 0, At, B0); PG8_BAR; PG8_SCHED;
            PG8_STAGE(PG8_SB(1, 1), b3 + hstep, voffB);
            PG8_WAIT_V(6); PG8_BAR; PG8_MMA(1, 1, At, B1); PG8_BAR;
        }
        E(acc, cur, wr, wc, fr, fq);
        if (!has_next) break;
#pragma unroll
        for (int a = 0; a < 2; ++a)
#pragma unroll
            for (int b = 0; b < 2; ++b)
#pragma unroll
                for (int m = 0; m < 4; ++m)
#pragma unroll
                    for (int n = 0; n < 2; ++n) acc[a][b][m][n] = (f32x4){0.f, 0.f, 0.f, 0.f};
        cur = nxt; cA = nA; cB = nB; ++ui;
    }
    PG8_WAIT_V(0);
    if (wr == 0) PG8_BAR;
    PG8_BAR;
#undef PG8_SA
#undef PG8_SB
#undef PG8_STAGE
#undef PG8_LDA
#undef PG8_LDB
#undef PG8_MMA
#undef PG8_WAIT_V
#undef PG8_WAIT_L
#undef PG8_BAR
#undef PG8_SCHED
}

struct EpiSwiGLU {
    static constexpr bool PERM = true;
    bf16_t* H; const float* SS;
    __device__ __forceinline__ void operator()(const f32x4 (&acc)[2][2][4][2], const Unit& u, int wr, int wc, int fr, int fq) const {
        const int row0 = u.pm * BM + wr * 64 + fr, col0 = u.pn * 128 + wc * 32 + 8 * fq;
#pragma unroll
        for (int ai = 0; ai < 2; ++ai)
#pragma unroll
            for (int m = 0; m < 4; ++m) {
                const float rs = __builtin_amdgcn_rsqf(SS[row0 + ai * HALF + m * 16] * (1.0f / D) + 1e-6f);
                float v[8];
#pragma unroll
                for (int n = 0; n < 2; ++n)
#pragma unroll
                    for (int j = 0; j < 4; ++j) { const float gt = acc[ai][0][m][n][j] * rs, up = acc[ai][1][m][n][j] * rs; v[4 * n + j] = siluf_(gt) * up; }
                *(u32x4*)(H + (size_t)(row0 + ai * HALF + m * 16) * FF + col0) = pack8(v);
            }
    }
};
template <bool HALFSTEP> struct EpiResidual {
    static constexpr bool PERM = false;
    static constexpr float scale = HALFSTEP ? 0.5f : 1.0f;
    const float* base; float* out; bf16_t* XN; float* SS;
    __device__ __forceinline__ void operator()(const f32x4 (&acc)[2][2][4][2], const Unit& u, int wr, int wc, int fr, int fq) const {
        const int row0 = u.pm * BM + wr * 64 + fr, col0 = u.pn * BM + wc * 32 + 4 * fq;
#pragma unroll
        for (int ai = 0; ai < 2; ++ai)
#pragma unroll
            for (int m = 0; m < 4; ++m) { const int row = row0 + ai * HALF + m * 16; const size_t ro = (size_t)row * D + col0; float ss = 0.f;
#pragma unroll
                for (int bj = 0; bj < 2; ++bj)
#pragma unroll
                    for (int n = 0; n < 2; ++n) { const f32x4 b = *(const f32x4*)(base + ro + bj * HALF + n * 16); const f32x4 r = b + acc[ai][bj][m][n] * scale; *(f32x4*)(out + ro + bj * HALF + n * 16) = r;
                        if (XN) { u32x2 w; w.x = pk2(r.x, r.y); w.y = pk2(r.z, r.w); *(u32x2*)(XN + ro + bj * HALF + n * 16) = w; ss += (r.x * r.x + r.y * r.y) + (r.z * r.z + r.w * r.w); } }
                if (XN) { ss += __shfl_xor(ss, 16); ss += __shfl_xor(ss, 32); if (fq == 0) atomicAdd(SS + row, ss); } }
    }
};
struct EpiBf16 {
    static constexpr bool PERM = true;
    bf16_t* O; int ldc; const float* SS;
    __device__ __forceinline__ void operator()(const f32x4 (&acc)[2][2][4][2], const Unit& u, int wr, int wc, int fr, int fq) const {
        const int row0 = u.pm * BM + wr * 64 + fr, col0 = u.pn * BM + wc * 32 + 8 * fq;
#pragma unroll
        for (int ai = 0; ai < 2; ++ai)
#pragma unroll
            for (int m = 0; m < 4; ++m) { bf16_t* rowp = O + (size_t)(row0 + ai * HALF + m * 16) * ldc + col0;
                const float rs = __builtin_amdgcn_rsqf(SS[row0 + ai * HALF + m * 16] * (1.0f / D) + 1e-6f);
#pragma unroll
                for (int bj = 0; bj < 2; ++bj) { const f32x4 v0 = acc[ai][bj][m][0] * rs, v1 = acc[ai][bj][m][1] * rs;
                    u32x4 w; w.x = pk2(v0[0], v0[1]); w.y = pk2(v0[2], v0[3]); w.z = pk2(v1[0], v1[1]); w.w = pk2(v1[2], v1[3]);
                    *(u32x4*)(rowp + bj * HALF) = w; } }
    }
};
struct EpiLR {
    static constexpr bool PERM = true;
    bf16_t* O; const float* w0; const float* a0;
    template <int KIND> __device__ __forceinline__ void body(const f32x4 (&acc)[2][2][4][2], const float* bp, int row0, int col0) const {
#pragma unroll
        for (int bj = 0; bj < 2; ++bj) {
            f32x4 b0 = (f32x4){0.f, 0.f, 0.f, 0.f}, b1 = b0;
            if (KIND < 2) { b0 = *(const f32x4*)(bp + bj * HALF); b1 = *(const f32x4*)(bp + bj * HALF + 4); }
#pragma unroll
            for (int ai = 0; ai < 2; ++ai)
#pragma unroll
                for (int m = 0; m < 4; ++m) {
                    u32x4 w;
#pragma unroll
                    for (int n = 0; n < 2; ++n) {
                        float r[4];
#pragma unroll
                        for (int j = 0; j < 4; ++j) { const float x = acc[ai][bj][m][n][j] + (n == 0 ? b0[j] : b1[j]);
                            if (KIND == 0) { const float e = __expf(-x); r[j] = -0.60653065971f * __builtin_amdgcn_rcpf(1.0f + e); }
                            else if (KIND == 1) r[j] = __builtin_amdgcn_rcpf(1.0f + __expf(-x)); else r[j] = x; }
                        if (n == 0) { w.x = pk2(r[0], r[1]); w.y = pk2(r[2], r[3]); } else { w.z = pk2(r[0], r[1]); w.w = pk2(r[2], r[3]); }
                    }
                    *(u32x4*)(O + (size_t)(row0 + ai * HALF + m * 16) * 1536 + col0 + bj * HALF) = w;
                }
        }
    }
    __device__ __forceinline__ void operator()(const f32x4 (&acc)[2][2][4][2], const Unit& u, int wr, int wc, int fr, int fq) const {
        const int row0 = u.pm * BM + wr * 64 + fr, col0 = u.pn * BM + wc * 32 + 8 * fq, kind = u.pn >> 1, f0 = col0 - 512 * kind;
        if (kind == 0) body<0>(acc, w0 + f0, row0, col0); else if (kind == 1) body<1>(acc, a0 + f0, row0, col0); else body<2>(acc, nullptr, row0, col0);
    }
};
struct EpiGLU {
    static constexpr bool PERM = true;
    const bf16_t* Z; bf16_t* Y; const float* b;
    __device__ __forceinline__ void operator()(const f32x4 (&acc)[2][2][4][2], const Unit& u, int wr, int wc, int fr, int fq) const {
        const int row0 = u.pm * BM + wr * 64 + fr, col0 = u.pn * BM + wc * 32 + 8 * fq;
#pragma unroll
        for (int bj = 0; bj < 2; ++bj) {
            const f32x4 bias0 = *(const f32x4*)(b + col0 + bj * HALF), bias1 = *(const f32x4*)(b + col0 + bj * HALF + 4);
#pragma unroll
            for (int ai = 0; ai < 2; ++ai)
#pragma unroll
                for (int m = 0; m < 4; ++m) { const size_t r = (size_t)(row0 + ai * HALF + m * 16);
                    float z[8], v[8]; unpack8(*(const u32x4*)(Z + r * 512 + col0 + bj * HALF), z);
#pragma unroll
                    for (int n = 0; n < 2; ++n)
#pragma unroll
                        for (int j = 0; j < 4; ++j) v[4 * n + j] = z[4 * n + j] * sigmoidf_(acc[ai][bj][m][n][j] + (n == 0 ? bias0[j] : bias1[j]));
                    *(u32x4*)(Y + r * D + 1024 + col0 + bj * HALF) = pack8(v); }
        }
    }
};
}

template <class Epi> __device__ __forceinline__ void run_gemm(LAS unsigned char* lds, const bf16_t* A, const bf16_t* Bt, int N, int K, const Epi E) {
    pg8::Gemm g; g.A = A; g.Bt = Bt; g.M = T; g.N = N; g.K = K;
    pg8::StaticOrder S; S.init(T, N, gridDim.x, opaque_bid());
    pg8::gemm_phase<Epi>(lds, g, S, E);
}

__device__ __forceinline__ void tr_item(const float* W, int ldw, int k0, int n0, const float* gs, bf16_t* Dst, int ldd, int drow0, int dk0, LAS float* scr, int lane) {
    if (W) {
        f32x4 v[8];
#pragma unroll
        for (int i = 0; i < 8; ++i) { const int kk = 8 * i + (lane >> 3); v[i] = *(const f32x4*)(W + (size_t)(k0 + kk) * ldw + n0 + 4 * (lane & 7)); }
#pragma unroll
        for (int i = 0; i < 8; ++i) { const int kk = 8 * i + (lane >> 3); f32x4 x = v[i]; if (gs) x = x * gs[k0 + kk];
            LAS float* d = scr + kk * 33 + 4 * (lane & 7); d[0] = x.x; d[1] = x.y; d[2] = x.z; d[3] = x.w; }
    } else {
#pragma unroll 8
        for (int i = 0; i < 32; ++i) { const int kk = 2 * i + (lane >> 5); scr[kk * 33 + (lane & 31)] = 0.f; }
    }
    LDS_FENCE();
    const int c = lane & 7;
#pragma unroll
    for (int j = 0; j < 4; ++j) { const int n = (lane >> 3) + 8 * j; const LAS float* s = scr + (8 * c) * 33 + n;
        u32x4 o; o.x = pk2(s[0 * 33], s[1 * 33]); o.y = pk2(s[2 * 33], s[3 * 33]); o.z = pk2(s[4 * 33], s[5 * 33]); o.w = pk2(s[6 * 33], s[7 * 33]);
        *(u32x4*)(Dst + (size_t)(drow0 + n) * ldd + dk0 + k0 - 0 + 8 * c - 0) = o; }
    LDS_FENCE();
}

__device__ __forceinline__ void conv_phase(ArgsRef a, int l, LAS unsigned char* lds) {
    const int TID = opaque_tid(), BID = opaque_bid(); (void)TID; (void)BID;
    const int wave = TID >> 6, lane = TID & 63;
    LAS float* scr = (LAS float*)(lds + wave * 8704);
    const int gw = BID * NWAVES + wave, NGW = gridDim.x * NWAVES;
    unsigned char* ws = a.ws;
    constexpr int I_GU = (D / 64) * (FF / 32), I_DN = (FF / 64) * (D / 32), I_IN = (D / 64) * (DIN / 32), I_OUT = (D / 64) * (D / 32), I_GLU = 8 * 16, I_LR = 48 * 4;
    constexpr int NITEMS = 6 * I_GU + I_IN + I_OUT + I_GLU + I_LR;
    static_assert(I_GU == I_DN, "items");
    for (int it = gw; it < NITEMS; it += NGW) {
        int r = it;
        if (r < 6 * I_GU) {
            const int which = r / I_GU; r -= which * I_GU;
            const int f = which >= 3, m = which % 3;
            if (m < 2) {
                const float* W = (const float*)a.in[(f ? 36 : 3) + m] + (size_t)l * D * FF;
                const float* gs = (const float*)a.in[f ? 35 : 2] + (size_t)l * D;
                bf16_t* dst = (bf16_t*)(ws + (f ? W_UP2 : W_UP1));
                const int nblk = FF / 32, kb = r / nblk, nb = r % nblk, n0 = 32 * nb;
                tr_item(W, FF, 64 * kb, n0, gs, dst, D, (n0 >> 7) * 256 + (n0 & 127) + 128 * m, 0, scr, lane);
            } else {
                const float* W = (const float*)a.in[f ? 38 : 5] + (size_t)l * FF * D;
                bf16_t* dst = (bf16_t*)(ws + (f ? W_DN2 : W_DN1));
                const int nblk = D / 32, kb = r / nblk, nb = r % nblk;
                tr_item(W, D, 64 * kb, 32 * nb, nullptr, dst, FF, 32 * nb, 0, scr, lane);
            }
            continue;
        }
        r -= 6 * I_GU;
        if (r < I_IN) { const int nblk = DIN / 32, kb = r / nblk, nb = r % nblk;
            tr_item((const float*)a.in[7] + (size_t)l * D * DIN, DIN, 64 * kb, 32 * nb, (const float*)a.in[6] + (size_t)l * D, (bf16_t*)(ws + W_IN), D, 32 * nb, 0, scr, lane); continue; }
        r -= I_IN;
        if (r < I_OUT) { const int nblk = D / 32, kb = r / nblk, nb = r % nblk;
            tr_item((const float*)a.in[34] + (size_t)l * D * D, D, 64 * kb, 32 * nb, nullptr, (bf16_t*)(ws + W_OUT), D, 32 * nb, 0, scr, lane); continue; }
        r -= I_OUT;
        if (r < I_GLU) { const int kb = r / 16, nb = r % 16;
            tr_item((const float*)a.in[30] + (size_t)l * 512 * 512, 512, 64 * kb, 32 * nb, nullptr, (bf16_t*)(ws + W_GLU), 512, 32 * nb, 0, scr, lane); continue; }
        r -= I_GLU;
        {
            const int nb = r >> 2, kb = r & 3, kind = nb >> 4, nn0 = 32 * (nb & 15);
            const float* W = nullptr; int k0 = 0;
            if (kind == 0 && kb == 0) { W = (const float*)a.in[10] + (size_t)l * 64 * 512; k0 = 0; }
            else if (kind == 1 && kb == 1) { W = (const float*)a.in[12] + (size_t)l * 64 * 512; k0 = 0; }
            else if (kind == 2 && kb >= 2) { W = (const float*)a.in[13] + (size_t)l * 128 * 512; k0 = 64 * (kb - 2); }
            tr_item(W, 512, k0, nn0, nullptr, (bf16_t*)(ws + W_LR), 256, 32 * nb, 64 * kb - k0, scr, lane);
        }
    }
}

__device__ __forceinline__ void norm_phase(const float* x, bf16_t* XN, float* SS) {
    const int TID = opaque_tid(), BID = opaque_bid(); (void)TID; (void)BID;
    const int wave = TID >> 6, lane = TID & 63;
    const int gw = BID * NWAVES + wave, NGW = gridDim.x * NWAVES;
    for (int m = gw; m < T; m += NGW) {
        const f32x4* xr = (const f32x4*)(x + (size_t)m * D) + lane;
        f32x4 v[8]; float s = 0.f;
#pragma unroll
        for (int j = 0; j < 8; ++j) { v[j] = xr[64 * j]; s += (v[j].x * v[j].x + v[j].y * v[j].y) + (v[j].z * v[j].z + v[j].w * v[j].w); }
        s = wave_sum(s); if (lane == 0) SS[m] = s;
        u32x2* o = (u32x2*)(XN + (size_t)m * D) + lane;
#pragma unroll
        for (int j = 0; j < 8; ++j) { u32x2 w; w.x = pk2(v[j].x, v[j].y); w.y = pk2(v[j].z, v[j].w); o[64 * j] = w; }
    }
}

__device__ __forceinline__ void zero_phase(float* p, int n) {
    const int TID = opaque_tid(), BID = opaque_bid();
    for (int i = BID * NTHREADS + TID; i < n; i += gridDim.x * NTHREADS) p[i] = 0.f;
}
__device__ __forceinline__ void alr_phase(ArgsRef a, int l) {
    const int TID = opaque_tid(), BID = opaque_bid(); (void)TID; (void)BID;
    const bf16_t* P = (const bf16_t*)(a.ws + WS_PROJ); bf16_t* ALR = (bf16_t*)(a.ws + WS_ALR);
    const float* mu = (const float*)a.in[8] + (size_t)l * 1792 + 1536;
    const int gt = BID * NTHREADS + TID, NGT = gridDim.x * NTHREADS;
    for (int it = gt; it < T * 32; it += NGT) {
        const int t = it >> 5, cg = it & 31, c0 = 8 * cg;
        float cur[8], prv[8], o[8];
        unpack8(*(const u32x4*)(P + (size_t)t * DIN + 1536 + c0), cur);
        if ((t & (SEQ - 1)) != 0) unpack8(*(const u32x4*)(P + (size_t)(t - 1) * DIN + 1536 + c0), prv);
        else {
#pragma unroll
            for (int j = 0; j < 8; ++j) prv[j] = 0.f; }
#pragma unroll
        for (int j = 0; j < 8; ++j) { const float v = cur[j] + (prv[j] - cur[j]) * mu[c0 + j];
            o[j] = c0 < 64 ? tanhf(v) : (c0 < 128 ? v : sigmoidf_(v)); }
        *(u32x4*)(ALR + (size_t)t * 256 + c0) = pack8(o);
    }
}

__device__ __forceinline__ void rwkv_phase(ArgsRef a, int l, LAS unsigned char* lds) {
    const int TID = opaque_tid(), BID = opaque_bid(); (void)TID; (void)BID;
    const bf16_t* P = (const bf16_t*)(a.ws + WS_PROJ); const bf16_t* LR = (const bf16_t*)(a.ws + WS_LRO);
    float* OR = (float*)(a.ws + WS_OR); float* BON = (float*)(a.ws + WS_BON);
    LAS float* sR = (LAS float*)lds; LAS float* sW = sR + 4096; LAS float* sK = sW + 4096; LAS float* sKK = sK + 4096; LAS float* sB = sKK + 4096;
    LAS float* sV = sB + 4096; LAS float* sO = sV + 2048;
    const int tid = TID, wave = tid >> 6, lane = tid & 63;
    const int tt = tid >> 3, cg = tid & 7;
    for (int job = BID; job < 256; job += gridDim.x) {
        const int b = job >> 4, h = (job >> 1) & 7, half = job & 1;
        const int c0 = 64 * h + 8 * cg;
        float mur[8], muk[8], muv[8], kkw[8], kaw[8], rkw[8];
#pragma unroll
        for (int j = 0; j < 8; ++j) {
            mur[j] = ((const float*)a.in[8])[(size_t)l * 1792 + c0 + j]; muk[j] = ((const float*)a.in[8])[(size_t)l * 1792 + 512 + c0 + j]; muv[j] = ((const float*)a.in[8])[(size_t)l * 1792 + 1024 + c0 + j];
            kkw[j] = ((const float*)a.in[14])[(size_t)l * 512 + c0 + j]; kaw[j] = ((const float*)a.in[15])[(size_t)l * 512 + c0 + j]; rkw[j] = ((const float*)a.in[16])[(size_t)l * 512 + c0 + j]; }
        f32x2 stA = (f32x2){0.f, 0.f}, stB = stA;
        const int rloc = 4 * wave + (lane >> 4), jq = lane & 15;
        u32x4 graw[8];
        const u32x4 zero4 = (u32x4){0u, 0u, 0u, 0u};
#define RWKV_ISSUE(ch_) do { const int s_ = (ch_) * 64 + tt; const size_t t_ = (size_t)b * SEQ + s_; \
            graw[0] = *(const u32x4*)(P + t_ * DIN + c0); graw[1] = *(const u32x4*)(P + t_ * DIN + 512 + c0); graw[2] = *(const u32x4*)(P + t_ * DIN + 1024 + c0); \
            if (s_ != 0) { graw[3] = *(const u32x4*)(P + (t_ - 1) * DIN + c0); graw[4] = *(const u32x4*)(P + (t_ - 1) * DIN + 512 + c0); graw[5] = *(const u32x4*)(P + (t_ - 1) * DIN + 1024 + c0); } \
            else { graw[3] = zero4; graw[4] = zero4; graw[5] = zero4; } \
            graw[6] = *(const u32x4*)(LR + t_ * 1536 + c0); graw[7] = *(const u32x4*)(LR + t_ * 1536 + 512 + c0); } while (0)
        RWKV_ISSUE(0);
        for (int ch = 0; ch < SEQ / 64; ++ch) {
            __syncthreads();
            {
                const int s = ch * 64 + tt; const size_t t = (size_t)b * SEQ + s;
                float r[8], k[8], v[8], pr[8], ld[8], av[8];
                unpack8(graw[0], r); unpack8(graw[1], k); unpack8(graw[2], v);
                unpack8(graw[3], pr);
#pragma unroll
                for (int j = 0; j < 8; ++j) r[j] += (pr[j] - r[j]) * mur[j];
                unpack8(graw[4], pr);
#pragma unroll
                for (int j = 0; j < 8; ++j) k[j] += (pr[j] - k[j]) * muk[j];
                unpack8(graw[5], pr);
#pragma unroll
                for (int j = 0; j < 8; ++j) v[j] += (pr[j] - v[j]) * muv[j];
                unpack8(graw[6], ld); unpack8(graw[7], av);
                if (ch + 1 < SEQ / 64) RWKV_ISSUE(ch + 1);
                float kk[8], ss = 0.f, bp = 0.f;
#pragma unroll
                for (int j = 0; j < 8; ++j) { kk[j] = k[j] * kkw[j]; ss += kk[j] * kk[j]; }
                ss = red8(ss);
                const float inv = __builtin_amdgcn_rsqf(fmaxf(ss, 1e-24f));
                float w8[8], k8[8], b8[8];
#pragma unroll
                for (int j = 0; j < 8; ++j) { kk[j] *= inv; k8[j] = k[j] * (1.0f + (av[j] - 1.0f) * kaw[j]); b8[j] = kk[j] * av[j]; w8[j] = __expf(ld[j]); bp += r[j] * k8[j] * rkw[j]; }
                bp = red8(bp);
                if (half == 0 && cg == 0) BON[t * 8 + h] = bp;
                LAS float* d;
                d = sR + tt * 64 + 8 * cg; *(LAS f32x4*)d = (f32x4){r[0], r[1], r[2], r[3]}; *(LAS f32x4*)(d + 4) = (f32x4){r[4], r[5], r[6], r[7]};
                d = sW + tt * 64 + 8 * cg; *(LAS f32x4*)d = (f32x4){w8[0], w8[1], w8[2], w8[3]}; *(LAS f32x4*)(d + 4) = (f32x4){w8[4], w8[5], w8[6], w8[7]};
                d = sK + tt * 64 + 8 * cg; *(LAS f32x4*)d = (f32x4){k8[0], k8[1], k8[2], k8[3]}; *(LAS f32x4*)(d + 4) = (f32x4){k8[4], k8[5], k8[6], k8[7]};
                d = sKK + tt * 64 + 8 * cg; *(LAS f32x4*)d = (f32x4){kk[0], kk[1], kk[2], kk[3]}; *(LAS f32x4*)(d + 4) = (f32x4){kk[4], kk[5], kk[6], kk[7]};
                d = sB + tt * 64 + 8 * cg; *(LAS f32x4*)d = (f32x4){b8[0], b8[1], b8[2], b8[3]}; *(LAS f32x4*)(d + 4) = (f32x4){b8[4], b8[5], b8[6], b8[7]};
                if ((cg >> 2) == half) { d = sV + tt * 32 + 8 * (cg & 3); *(LAS f32x4*)d = (f32x4){v[0], v[1], v[2], v[3]}; *(LAS f32x4*)(d + 4) = (f32x4){v[4], v[5], v[6], v[7]}; }
            }
            __syncthreads();
            {
                f32x4 w4 = *(const LAS f32x4*)(sW + 4 * jq), kk4 = *(const LAS f32x4*)(sKK + 4 * jq), b4 = *(const LAS f32x4*)(sB + 4 * jq),
                      k4 = *(const LAS f32x4*)(sK + 4 * jq), r4 = *(const LAS f32x4*)(sR + 4 * jq);
                float vi = sV[rloc];
                f32x2 pyp = (f32x2){0.f, 0.f}; float ykeep = 0.f;
#pragma unroll 1
                for (int s16 = 0; s16 < 64; s16 += 16) {
#pragma unroll
                    for (int u = 0; u < 16; ++u) {
                        const int sn = (s16 + u + 1) & 63;
                        const f32x4 nw4 = *(const LAS f32x4*)(sW + sn * 64 + 4 * jq), nkk4 = *(const LAS f32x4*)(sKK + sn * 64 + 4 * jq), nb4 = *(const LAS f32x4*)(sB + sn * 64 + 4 * jq),
                                    nk4 = *(const LAS f32x4*)(sK + sn * 64 + 4 * jq), nr4 = *(const LAS f32x4*)(sR + sn * 64 + 4 * jq);
                        const float nvi = sV[sn * 32 + rloc];
                        const f32x2 pa = pfma(stB, (f32x2){kk4.z, kk4.w}, stA * (f32x2){kk4.x, kk4.y});
                        float av = pa.x + pa.y, yv = pyp.x + pyp.y;
                        av += dpp<XOR1>(av); yv += dpp<XOR1>(yv); av += dpp<XOR2>(av); yv += dpp<XOR2>(yv);
                        av += dpp<XOR7>(av); yv += dpp<XOR7>(yv); av += dpp<XOR8>(av); yv += dpp<XOR8>(yv);
                        if (u > 0) ykeep = (jq == u - 1) ? yv : ykeep;
                        else if (s16 > 0) { ykeep = (jq == 15) ? yv : ykeep; sO[(s16 - 16 + jq) * 32 + rloc] = ykeep; }
                        const float sa = -av;
                        const f32x2 sa2 = (f32x2){sa, sa}, vi2 = (f32x2){vi, vi};
                        const f32x2 tA = pfma(vi2, (f32x2){k4.x, k4.y}, sa2 * (f32x2){b4.x, b4.y}), tB = pfma(vi2, (f32x2){k4.z, k4.w}, sa2 * (f32x2){b4.z, b4.w});
                        stA = pfma(stA, (f32x2){w4.x, w4.y}, tA); stB = pfma(stB, (f32x2){w4.z, w4.w}, tB);
                        pyp = pfma(stB, (f32x2){r4.z, r4.w}, stA * (f32x2){r4.x, r4.y});
                        w4 = nw4; kk4 = nkk4; b4 = nb4; k4 = nk4; r4 = nr4; vi = nvi;
                    }
                }
                float yv = red16(pyp.x + pyp.y);
                ykeep = (jq == 15) ? yv : ykeep; sO[(48 + jq) * 32 + rloc] = ykeep;
            }
            __syncthreads();
            {
                const int s = ch * 64 + tt; const size_t t = (size_t)b * SEQ + s;
                *(f32x4*)(OR + t * 512 + 64 * h + 32 * half + 4 * cg) = *(const LAS f32x4*)(sO + tt * 32 + 4 * cg);
            }
        }
    }
    __syncthreads();
}

__device__ __forceinline__ void hgrn_phase(ArgsRef a, int l, LAS unsigned char* lds) {
    const int TID = opaque_tid(), BID = opaque_bid(); (void)TID; (void)BID;
    const bf16_t* P = (const bf16_t*)(a.ws + WS_PROJ); float* OH = (float*)(a.ws + WS_OH);
    LAS float* sQ = (LAS float*)lds; LAS float* sF = sQ + 4096; LAS float* sV = sF + 4096; LAS float* sO = sV + 2048;
    const int tid = TID, wave = tid >> 6, lane = tid & 63;
    const int tt = tid >> 3, cg = tid & 7;
    const float* lbp = (const float*)a.in[32];
    for (int job = BID; job < 256; job += gridDim.x) {
        const int b = job >> 4, h = (job >> 1) & 7, half = job & 1;
        const int c0 = 64 * h + 8 * cg;
        float lb[8];
#pragma unroll
        for (int j = 0; j < 8; ++j) lb[j] = (l == 0) ? 0.f : sigmoidf_(lbp[512 + c0 + j] - lbp[c0 + j]);
        f32x2 stA = (f32x2){0.f, 0.f}, stB = stA;
        const int cloc = 4 * wave + (lane >> 4), dq = lane & 15;
        u32x4 gq, gf; u32x2 gv;
#define HGRN_ISSUE(ch_) do { const size_t t_ = (size_t)b * SEQ + (ch_) * 64 + tt; gq = *(const u32x4*)(P + t_ * DIN + C_HG + c0); gf = *(const u32x4*)(P + t_ * DIN + C_HG + 512 + c0); \
            gv = *(const u32x2*)(P + t_ * DIN + C_HG + 1024 + 64 * h + 32 * half + 4 * cg); } while (0)
        HGRN_ISSUE(0);
        for (int ch = 0; ch < SEQ / 64; ++ch) {
            __syncthreads();
            {
                float q[8], f[8];
                unpack8(gq, q); unpack8(gf, f);
#pragma unroll
                for (int j = 0; j < 8; ++j) { q[j] = siluf_(q[j]) * 0.125f; f[j] = lb[j] + (1.0f - lb[j]) * sigmoidf_(f[j]); }
                LAS float* d;
                d = sQ + tt * 64 + 8 * cg; *(LAS f32x4*)d = (f32x4){q[0], q[1], q[2], q[3]}; *(LAS f32x4*)(d + 4) = (f32x4){q[4], q[5], q[6], q[7]};
                d = sF + tt * 64 + 8 * cg; *(LAS f32x4*)d = (f32x4){f[0], f[1], f[2], f[3]}; *(LAS f32x4*)(d + 4) = (f32x4){f[4], f[5], f[6], f[7]};
                const u32x2 vv = gv;
                *(LAS f32x4*)(sV + tt * 32 + 4 * cg) = (f32x4){bflo(vv.x), bfhi(vv.x), bflo(vv.y), bfhi(vv.y)};
                if (ch + 1 < SEQ / 64) HGRN_ISSUE(ch + 1);
            }
            __syncthreads();
            {
                f32x4 f4 = *(const LAS f32x4*)(sF + 4 * dq), q4 = *(const LAS f32x4*)(sQ + 4 * dq);
                float vi = sV[cloc];
                float ykeep = 0.f;
#pragma unroll 1
                for (int s16 = 0; s16 < 64; s16 += 16) {
#pragma unroll
                    for (int u = 0; u < 16; ++u) {
                        const int sn = (s16 + u + 1) & 63;
                        const f32x4 nf4 = *(const LAS f32x4*)(sF + sn * 64 + 4 * dq), nq4 = *(const LAS f32x4*)(sQ + sn * 64 + 4 * dq);
                        const float nvi = sV[sn * 32 + cloc];
                        const f32x2 vi2 = (f32x2){vi, vi};
                        stA = pfma((f32x2){f4.x, f4.y}, stA - vi2, vi2); stB = pfma((f32x2){f4.z, f4.w}, stB - vi2, vi2);
                        const f32x2 py = pfma(stB, (f32x2){q4.z, q4.w}, stA * (f32x2){q4.x, q4.y});
                        const float y = red16(py.x + py.y);
                        ykeep = (dq == u) ? y : ykeep;
                        f4 = nf4; q4 = nq4; vi = nvi;
                    }
                    sO[(s16 + dq) * 32 + cloc] = ykeep;
                }
            }
            __syncthreads();
            {
                const int s = ch * 64 + tt; const size_t t = (size_t)b * SEQ + s;
                *(f32x4*)(OH + t * 512 + 64 * h + 32 * half + 4 * cg) = *(const LAS f32x4*)(sO + tt * 32 + 4 * cg);
            }
        }
    }
    __syncthreads();
}

__device__ __forceinline__ void post_phase(ArgsRef a, int l) {
    const int TID = opaque_tid(), BID = opaque_bid(); (void)TID; (void)BID;
    const bf16_t* P = (const bf16_t*)(a.ws + WS_PROJ); const bf16_t* LR = (const bf16_t*)(a.ws + WS_LRO);
    const float* OR = (const float*)(a.ws + WS_OR); const float* OH = (const float*)(a.ws + WS_OH); const float* BON = (const float*)(a.ws + WS_BON);
    bf16_t* Y = (bf16_t*)(a.ws + WS_YC);
    const float* muv = (const float*)a.in[8] + (size_t)l * 1792 + 1024;
    const float* lnw = (const float*)a.in[17] + (size_t)l * 512; const float* lnb = (const float*)a.in[18] + (size_t)l * 512;
    const float* gn = (const float*)a.in[33] + (size_t)l * 64;
    const int gt = BID * NTHREADS + TID, NGT = gridDim.x * NTHREADS;
    for (int it = gt; it < T * 128; it += NGT) {
        const int cg = it & 7, hh = (it >> 3) & 15; const size_t t = (size_t)(it >> 7);
        float o[8], y[8];
        if (hh < 8) {
            const int c0 = 64 * hh + 8 * cg;
            const f32x4 o0 = *(const f32x4*)(OR + t * 512 + c0), o1 = *(const f32x4*)(OR + t * 512 + c0 + 4);
            o[0] = o0.x; o[1] = o0.y; o[2] = o0.z; o[3] = o0.w; o[4] = o1.x; o[5] = o1.y; o[6] = o1.z; o[7] = o1.w;
            float s = 0.f;
#pragma unroll
            for (int j = 0; j < 8; ++j) s += o[j];
            const float mean = red8(s) * (1.0f / 64.0f);
            float q = 0.f;
#pragma unroll
            for (int j = 0; j < 8; ++j) { o[j] -= mean; q += o[j] * o[j]; }
            const float rstd = __builtin_amdgcn_rsqf(red8(q) * (1.0f / 64.0f) + 64e-5f);
            float v[8], pv[8], g[8];
            unpack8(*(const u32x4*)(P + t * DIN + 1024 + c0), v);
            if ((t & (SEQ - 1)) != 0) unpack8(*(const u32x4*)(P + (t - 1) * DIN + 1024 + c0), pv);
            else {
#pragma unroll
                for (int j = 0; j < 8; ++j) pv[j] = 0.f; }
            unpack8(*(const u32x4*)(LR + t * 1536 + 1024 + c0), g);
            const float bon = BON[t * 8 + hh];
#pragma unroll
            for (int j = 0; j < 8; ++j) { const float vl = v[j] + (pv[j] - v[j]) * muv[c0 + j];
                y[j] = (o[j] * rstd * lnw[c0 + j] + lnb[c0 + j] + bon * vl) * g[j]; }
            *(u32x4*)(Y + t * D + c0) = pack8(y);
        } else {
            const int h = hh - 8, c0 = 64 * h + 8 * cg;
            const f32x4 o0 = *(const f32x4*)(OH + t * 512 + c0), o1 = *(const f32x4*)(OH + t * 512 + c0 + 4);
            o[0] = o0.x; o[1] = o0.y; o[2] = o0.z; o[3] = o0.w; o[4] = o1.x; o[5] = o1.y; o[6] = o1.z; o[7] = o1.w;
            float q = 0.f;
#pragma unroll
            for (int j = 0; j < 8; ++j) q += o[j] * o[j];
            const float rs = __builtin_amdgcn_rsqf(red8(q) * (1.0f / 64.0f) + 1e-6f);
            float g[8];
            unpack8(*(const u32x4*)(P + t * DIN + C_HG + 1536 + c0), g);
#pragma unroll
            for (int j = 0; j < 8; ++j) y[j] = o[j] * rs * gn[8 * cg + j] * siluf_(g[j]);
            *(u32x4*)(Y + t * D + 1536 + c0) = pack8(y);
        }
    }
}

__device__ __forceinline__ void attn_phase(ArgsRef a, int l, LAS unsigned char* lds) {
    const int TID = opaque_tid(), BID = opaque_bid();
    const bf16_t* P = (const bf16_t*)(a.ws + WS_PROJ); bf16_t* Y = (bf16_t*)(a.ws + WS_YC);
    const int* pos = (const int*)a.in[1];
    const float* qn = (const float*)a.in[19] + (size_t)l * 64; const float* kn = (const float*)a.in[20] + (size_t)l * 64; const float* sinks = (const float*)a.in[21] + (size_t)l * 8;
    constexpr int KST = 144, VST = 528;
    LAS unsigned char* sK = lds; LAS unsigned char* sVt = sK + 256 * KST; LAS unsigned char* sQ = sVt + 64 * VST; LAS float* sM = (LAS float*)(sQ + 512 * KST);
    const int tid = TID, cg = tid & 7, wave = tid >> 6, lane = tid & 63;
    float kmaxg = 0.f;
    for (int j = 0; j < 64; ++j) kmaxg = fmaxf(kmaxg, fabsf(kn[j]));
    const float kbound = 8.0f * kmaxg;
    float gk[8], gq[8], invf[8];
#pragma unroll
    for (int j = 0; j < 8; ++j) { gk[j] = kn[8 * cg + j]; gq[j] = qn[8 * cg + j]; invf[j] = exp2f(-(float)j * (18.931568569324174f / 8.0f)); }
    for (int job = BID; job < 512; job += gridDim.x) {
        const int b = job >> 5, nb = (job >> 1) & 15, kvh = job & 1;
        __syncthreads();
#pragma unroll 1
        for (int r = 0; r < 4; ++r) {
            const int kj = (tid >> 3) + 64 * r, s = (nb - 1) * 128 + kj;
            float k[8], v[8];
            if (s >= 0) {
                const size_t t = (size_t)b * SEQ + s;
                unpack8(*(const u32x4*)(P + t * DIN + C_ATT + 512 + 64 * kvh + 8 * cg), k); unpack8(*(const u32x4*)(P + t * DIN + C_ATT + 640 + 64 * kvh + 8 * cg), v);
            } else {
#pragma unroll
                for (int j = 0; j < 8; ++j) { k[j] = 0.f; v[j] = 0.f; } }
            float ss = 0.f;
#pragma unroll
            for (int j = 0; j < 8; ++j) ss += k[j] * k[j];
            ss = red8(ss);
            const float rs = __builtin_amdgcn_rsqf(ss * (1.0f / 64.0f) + 1e-6f);
#pragma unroll
            for (int j = 0; j < 8; ++j) k[j] = k[j] * rs * gk[j];
            const float pf = (float)pos[b * SEQ + (s >= 0 ? s : 0)];
#pragma unroll
            for (int j = 0; j < 8; ++j) {
                const float other = dpp<XOR1>(k[j]);
                if (cg < 2) { float sn, cs; sincos_big(pf * invf[j], sn, cs); k[j] = (cg == 0) ? (k[j] * cs - other * sn) : (k[j] * cs + other * sn); }
            }
            *(LAS u32x4*)(sK + kj * KST + 16 * cg) = pack8(k);
#pragma unroll
            for (int j = 0; j < 8; j += 2) { const unsigned w = pk2(v[j], v[j + 1]);
                *(LAS unsigned short*)(sVt + (8 * cg + j) * VST + 2 * kj) = (unsigned short)(w & 0xffffu); *(LAS unsigned short*)(sVt + (8 * cg + j + 1) * VST + 2 * kj) = (unsigned short)(w >> 16); }
        }
#pragma unroll 1
        for (int r = 0; r < 8; ++r) {
            const int row = (tid >> 3) + 64 * r, g = row >> 7, qi = row & 127, hq = 4 * kvh + g;
            const size_t tq = (size_t)b * SEQ + nb * 128 + qi;
            float q[8];
            unpack8(*(const u32x4*)(P + tq * DIN + C_ATT + 64 * hq + 8 * cg), q);
            float ss = 0.f;
#pragma unroll
            for (int j = 0; j < 8; ++j) ss += q[j] * q[j];
            ss = red8(ss);
            const float rs = 0.125f * __builtin_amdgcn_rsqf(ss * (1.0f / 64.0f) + 1e-6f);
#pragma unroll
            for (int j = 0; j < 8; ++j) q[j] = q[j] * rs * gq[j];
            const float pf = (float)pos[b * SEQ + nb * 128 + qi];
            float qq = 0.f;
#pragma unroll
            for (int j = 0; j < 8; ++j) {
                const float other = dpp<XOR1>(q[j]);
                if (cg < 2) { float sn, cs; sincos_big(pf * invf[j], sn, cs); q[j] = (cg == 0) ? (q[j] * cs - other * sn) : (q[j] * cs + other * sn); }
                qq += q[j] * q[j];
            }
            qq = red8(qq);
            if (cg == 0) sM[row] = sqrtf(qq) * kbound;
            *(LAS u32x4*)(sQ + row * KST + 16 * cg) = pack8(q);
        }
        __syncthreads();
        const int g = wave >> 1, qh = wave & 1, hq = 4 * kvh + g, fr = lane & 15, fq = lane >> 4;
        const float sinkv = sinks[hq];
#pragma unroll 1
        for (int qt = 0; qt < 4; ++qt) {
            const int qi0 = 64 * qh + 16 * qt, R0 = g * 128 + qi0, kt0 = qi0 >> 4;
            const bf16x8 qf0 = *(const LAS bf16x8*)(sQ + (R0 + fr) * KST + 16 * fq), qf1 = *(const LAS bf16x8*)(sQ + (R0 + fr) * KST + 16 * fq + 64);
            const float msh = sM[R0 + fr];
            const int ql = qi0 + fr;
            f32x4 oacc[4];
#pragma unroll
            for (int dt = 0; dt < 4; ++dt) oacc[dt] = (f32x4){0.f, 0.f, 0.f, 0.f};
            float lsum = 0.f;
#pragma unroll
            for (int ks = 0; ks < 5; ++ks) {
                unsigned pw[4];
#pragma unroll
                for (int h2 = 0; h2 < 2; ++h2) {
                    const int ti = 2 * ks + h2, kt = (kt0 + ti) < 15 ? (kt0 + ti) : 15;
                    const bf16x8 kf0 = *(const LAS bf16x8*)(sK + (16 * kt + fr) * KST + 16 * fq), kf1 = *(const LAS bf16x8*)(sK + (16 * kt + fr) * KST + 16 * fq + 64);
                    f32x4 sc = (f32x4){0.f, 0.f, 0.f, 0.f};
                    sc = __builtin_amdgcn_mfma_f32_16x16x32_bf16(kf0, qf0, sc, 0, 0, 0);
                    sc = __builtin_amdgcn_mfma_f32_16x16x32_bf16(kf1, qf1, sc, 0, 0, 0);
                    float p[4];
#pragma unroll
                    for (int j = 0; j < 4; ++j) { const int kj = 16 * (kt0 + ti) + 4 * fq + j;
                        const bool valid = (kj > ql) && (kj <= ql + 128) && (nb > 0 || kj >= 128);
                        p[j] = valid ? __expf(sc[j] - msh) : 0.f; lsum += p[j]; }
                    pw[2 * h2] = pk2(p[0], p[1]); pw[2 * h2 + 1] = pk2(p[2], p[3]);
                }
                const u32x4 pq = (u32x4){pw[0], pw[1], pw[2], pw[3]};
                const bf16x8 pf = __builtin_bit_cast(bf16x8, pq);
                const int kta = (kt0 + 2 * ks) < 15 ? (kt0 + 2 * ks) : 15, ktb = (kt0 + 2 * ks + 1) < 15 ? (kt0 + 2 * ks + 1) : 15;
#pragma unroll
                for (int dt = 0; dt < 4; ++dt) {
                    const u32x2 va = *(const LAS u32x2*)(sVt + (16 * dt + fr) * VST + (16 * kta + 4 * fq) * 2), vb = *(const LAS u32x2*)(sVt + (16 * dt + fr) * VST + (16 * ktb + 4 * fq) * 2);
                    const u32x4 vq = (u32x4){va.x, va.y, vb.x, vb.y};
                    oacc[dt] = __builtin_amdgcn_mfma_f32_16x16x32_bf16(__builtin_bit_cast(bf16x8, vq), pf, oacc[dt], 0, 0, 0);
                }
            }
            lsum += __shfl_xor(lsum, 16); lsum += __shfl_xor(lsum, 32);
            const float inv = __builtin_amdgcn_rcpf(lsum + __expf(sinkv - msh));
            const size_t tq = (size_t)b * SEQ + nb * 128 + ql;
#pragma unroll
            for (int dt = 0; dt < 4; ++dt) { u32x2 w; w.x = pk2(oacc[dt][0] * inv, oacc[dt][1] * inv); w.y = pk2(oacc[dt][2] * inv, oacc[dt][3] * inv);
                *(u32x2*)(Y + tq * D + 512 + 64 * hq + 16 * dt + 4 * fq) = w; }
        }
    }
    __syncthreads();
}

__device__ __forceinline__ float gelu_erf(float v) {
    const float t = __builtin_amdgcn_rcpf(fabsf(v) * 0.2316418882f + 1.0f);
    float q = t * 0.5307027145f + (-0.7265760135f); q = q * t + 0.7107068705f; q = q * t + (-0.142248368f); q = q * t + 0.127414796f; q = q * t;
    const float e = __builtin_amdgcn_exp2f(v * v * (-0.72134752044f));
    const float m = v * (q * e);
    return v < 0.f ? m : v - m;
}
__device__ __forceinline__ void s5_phase(ArgsRef a, int l, LAS unsigned char* lds) {
    const int TID = opaque_tid(), BID = opaque_bid();
    const bf16_t* P = (const bf16_t*)(a.ws + WS_PROJ); bf16_t* Z = (bf16_t*)(a.ws + WS_Z);
    const int tid = TID, wave = tid >> 6, lane = tid & 63, fr16 = lane & 15, fq = lane >> 4;
    LAS float* sX = (LAS float*)lds + wave * (16 * 130);
    LAS float* sE = (LAS float*)lds + 8 * 16 * 130;
    for (int job = BID; job < 512; job += gridDim.x) {
        const int b = job >> 5, g = job & 31;
        const float dt = expf(((const float*)a.in[24])[l * 32 + g]);
        float lbr, lbi;
        { const float lre = ((const float*)a.in[22])[(size_t)l * 2048 + g * 64 + lane], lim = ((const float*)a.in[23])[(size_t)l * 2048 + g * 64 + lane];
          float sn, cs; sincos_big(lim * dt, sn, cs); const float er = expf(lre * dt); lbr = er * cs; lbi = er * sn; }
        bf16x8 bfrag[8];
#pragma unroll
        for (int k = 0; k < 4; ++k) {
            const int p = fr16 + 16 * k;
            const float lre = ((const float*)a.in[22])[(size_t)l * 2048 + g * 64 + p], lim = ((const float*)a.in[23])[(size_t)l * 2048 + g * 64 + p];
            float sn, cs; sincos_big(lim * dt, sn, cs); const float er = expf(lre * dt), pbr = er * cs, pbi = er * sn;
            const float den = __builtin_amdgcn_rcpf(lre * lre + lim * lim);
            const float fr = ((pbr - 1.0f) * lre + pbi * lim) * den, fi = (pbi * lre - (pbr - 1.0f) * lim) * den;
            const float* brp = (const float*)a.in[25] + ((size_t)l * 2048 + g * 64 + p) * 16 + 8 * (fq & 1);
            const float* bip = (const float*)a.in[26] + ((size_t)l * 2048 + g * 64 + p) * 16 + 8 * (fq & 1);
            float vr[8], vi[8];
#pragma unroll
            for (int i = 0; i < 8; ++i) { const float br = brp[i], bi = bip[i]; float xr = fr * br - fi * bi, xi = fr * bi + fi * br;
                const unsigned hw = pk2(xr, xi);
                if (fq >= 2) { xr -= bflo(hw); xi -= bfhi(hw); }
                vr[i] = xr; vi[i] = xi; }
            bfrag[k] = __builtin_bit_cast(bf16x8, pack8(vr)); bfrag[4 + k] = __builtin_bit_cast(bf16x8, pack8(vi));
        }
        float creg[32];
        {
            const float* cre = (const float*)a.in[27] + ((size_t)l * 32 + g) * 1024 + fr16 * 64 + fq;
            const float* cim = (const float*)a.in[28] + ((size_t)l * 32 + g) * 1024 + fr16 * 64 + fq;
#pragma unroll
            for (int kk = 0; kk < 16; ++kk) { creg[kk] = cre[4 * kk]; creg[16 + kk] = -cim[4 * kk]; }
        }
        f32x4 dsk;
        { const float* dp = (const float*)a.in[29] + (size_t)l * 512 + 16 * g + 4 * fq; dsk = (f32x4){dp[0], dp[1], dp[2], dp[3]}; }
        const size_t tbase = (size_t)b * SEQ + wave * 256;
        const bf16_t* ua = P + (tbase + fr16) * DIN + C_S5 + 16 * g + 8 * (fq & 1);
        const bf16_t* ue = P + (tbase + fr16) * DIN + C_S5 + 16 * g + 4 * fq;
        f32x2 xs = (f32x2){0.f, 0.f}; const f32x2 lbr2 = (f32x2){lbr, lbr}, lbi2 = (f32x2){lbi, lbi};
        {
            u32x4 au = *(const u32x4*)ua;
#pragma unroll 1
            for (int gi = 0; gi < 16; ++gi) {
                const bf16x8 af = __builtin_bit_cast(bf16x8, au);
                if (gi + 1 < 16) au = *(const u32x4*)(ua + (size_t)(gi + 1) * 16 * DIN);
#pragma unroll
                for (int nt = 0; nt < 8; ++nt) { const f32x4 d = __builtin_amdgcn_mfma_f32_16x16x32_bf16(af, bfrag[nt], (f32x4){0.f, 0.f, 0.f, 0.f}, 0, 0, 0);
#pragma unroll
                    for (int j = 0; j < 4; ++j) sX[(4 * fq + j) * 130 + fr16 + 16 * nt] = d[j]; }
                LDS_FENCE();
#pragma unroll
                for (int s = 0; s < 16; ++s) { const f32x2 bu = (f32x2){sX[s * 130 + lane], sX[s * 130 + 64 + lane]};
                    const f32x2 nx = pfma(lbr2, xs, bu); xs = pfma(lbi2, (f32x2){-xs.y, xs.x}, nx); }
                LDS_FENCE();
            }
        }
        sE[wave * 128 + lane] = xs.x; sE[wave * 128 + 64 + lane] = xs.y;
        float pr = lbr, pi = lbi;
#pragma unroll
        for (int i = 0; i < 8; ++i) { const float nr = pr * pr - pi * pi, ni = 2.0f * pr * pi; pr = nr; pi = ni; }
        __syncthreads();
        xs = (f32x2){0.f, 0.f};
        for (int w = 0; w < wave; ++w) { const float er_ = sE[w * 128 + lane], ei_ = sE[w * 128 + 64 + lane];
            const float nr = pr * xs.x - pi * xs.y + er_, ni = pr * xs.y + pi * xs.x + ei_; xs.x = nr; xs.y = ni; }
        {
            u32x4 au = *(const u32x4*)ua; u32x2 eu = *(const u32x2*)ue;
#pragma unroll 1
            for (int gi = 0; gi < 16; ++gi) {
                const bf16x8 af = __builtin_bit_cast(bf16x8, au); const u32x2 eun = eu;
                if (gi + 1 < 16) { au = *(const u32x4*)(ua + (size_t)(gi + 1) * 16 * DIN); eu = *(const u32x2*)(ue + (size_t)(gi + 1) * 16 * DIN); }
#pragma unroll
                for (int nt = 0; nt < 8; ++nt) { const f32x4 d = __builtin_amdgcn_mfma_f32_16x16x32_bf16(af, bfrag[nt], (f32x4){0.f, 0.f, 0.f, 0.f}, 0, 0, 0);
#pragma unroll
                    for (int j = 0; j < 4; ++j) sX[(4 * fq + j) * 130 + fr16 + 16 * nt] = d[j]; }
                LDS_FENCE();
#pragma unroll
                for (int s = 0; s < 16; ++s) { const f32x2 bu = (f32x2){sX[s * 130 + lane], sX[s * 130 + 64 + lane]};
                    const f32x2 nx = pfma(lbr2, xs, bu); xs = pfma(lbi2, (f32x2){-xs.y, xs.x}, nx);
                    sX[s * 130 + lane] = xs.x; sX[s * 130 + 64 + lane] = xs.y; }
                LDS_FENCE();
                f32x4 yacc = (f32x4){0.f, 0.f, 0.f, 0.f}, yacc1 = yacc, yacc2 = yacc, yacc3 = yacc;
                const LAS float* xp = sX + fr16 * 130 + fq;
#pragma unroll
                for (int kk = 0; kk < 32; kk += 4) {
                    yacc = __builtin_amdgcn_mfma_f32_16x16x4f32(creg[kk], xp[4 * kk], yacc, 0, 0, 0);
                    yacc1 = __builtin_amdgcn_mfma_f32_16x16x4f32(creg[kk + 1], xp[4 * kk + 4], yacc1, 0, 0, 0);
                    yacc2 = __builtin_amdgcn_mfma_f32_16x16x4f32(creg[kk + 2], xp[4 * kk + 8], yacc2, 0, 0, 0);
                    yacc3 = __builtin_amdgcn_mfma_f32_16x16x4f32(creg[kk + 3], xp[4 * kk + 12], yacc3, 0, 0, 0);
                }
                yacc = (yacc + yacc1) + (yacc2 + yacc3);
                const float u0 = bflo(eun.x), u1 = bfhi(eun.x), u2 = bflo(eun.y), u3 = bfhi(eun.y);
                const float z0 = gelu_erf(yacc[0] + dsk[0] * u0), z1 = gelu_erf(yacc[1] + dsk[1] * u1), z2 = gelu_erf(yacc[2] + dsk[2] * u2), z3 = gelu_erf(yacc[3] + dsk[3] * u3);
                u32x2 w; w.x = pk2(z0, z1); w.y = pk2(z2, z3);
                *(u32x2*)(Z + (tbase + gi * 16 + fr16) * 512 + 16 * g + 4 * fq) = w;
                LDS_FENCE();
            }
        }
        __syncthreads();
    }
}

#define XB_TMO      128
#define XB_XCNT(j)  (256  + 64 * (j))
#define XB_XSUB(j)  (1280 + 64 * (j))
#define XB_XGEN(j)  (2304 + 64 * (j))
#define XB_TOP      3328
#define XB_TOPGEN   3392
#define XCD_BAR_WORDS 3456
#define XB_SPIN_CAP (1u << 18)

__device__ __forceinline__ unsigned xb_ld(unsigned* p)              { return __hip_atomic_load(p, __ATOMIC_RELAXED, __HIP_MEMORY_SCOPE_AGENT); }
__device__ __forceinline__ unsigned xb_add(unsigned* p, unsigned v) { return __hip_atomic_fetch_add(p, v, __ATOMIC_RELAXED, __HIP_MEMORY_SCOPE_AGENT); }
__device__ __forceinline__ unsigned xb_xcc_id() { return (unsigned)__builtin_amdgcn_s_getreg((3 << 11) | 20) & 0xFu; }
#define XB_SPIN(cond, bar) do { unsigned _sp = 0; while (cond) { __builtin_amdgcn_s_sleep(1); \
    if ((++_sp & 255u) == 0u) { if (xb_ld(&(bar)[XB_TMO])) break; if (_sp > XB_SPIN_CAP) { atomicAdd(&(bar)[XB_TMO], 1u); break; } } } } while (0)

struct XcdBarrier {
    unsigned* bar; unsigned x;
    volatile LAS unsigned* st;
};

__device__ __forceinline__ XcdBarrier xcd_barrier_post(unsigned* bar, volatile LAS unsigned* st) {
    XcdBarrier b; b.bar = bar; b.x = xb_xcc_id(); b.st = st;
    if (threadIdx.x == 0) (void)xb_add(&bar[XB_XCNT(b.x)], 1u);
    return b;
}
__device__ __forceinline__ void xcd_barrier_complete(unsigned* bar, unsigned x, unsigned& nloc, unsigned& nx) {
    const unsigned G = gridDim.x * gridDim.y * gridDim.z;
    unsigned sum, cnt, mine, sp = 0u;
    for (;;) {
        sum = 0u; cnt = 0u; mine = 0u;
#pragma unroll
        for (unsigned j = 0; j < 16; ++j) { const unsigned c = xb_ld(&bar[XB_XCNT(j)]); sum += c; cnt += (c > 0u) ? 1u : 0u; mine = (j == x) ? c : mine; }
        if (sum == G) break;
        __builtin_amdgcn_s_sleep(1);
        if ((++sp & 255u) == 0u) { if (xb_ld(&bar[XB_TMO])) break; if (sp > XB_SPIN_CAP) { atomicAdd(&bar[XB_TMO], 1u); break; } }
    }
    nloc = mine > 0u ? mine : 1u; nx = cnt > 0u ? cnt : 1u;
}

__device__ __forceinline__ void xcd_barrier(const XcdBarrier& b) {
    asm volatile("s_waitcnt vmcnt(0)" ::: "memory");
    __syncthreads();
    if (threadIdx.x == 0) {
        unsigned* bar = b.bar;
        __builtin_amdgcn_s_waitcnt(0);
        unsigned nloc = b.st[0], nx = b.st[1];
        if (nloc == 0u) { xcd_barrier_complete(bar, b.x, nloc, nx); b.st[0] = nloc; b.st[1] = nx; }
        const unsigned old = xb_add(&bar[XB_XSUB(b.x)], 1u);
        const unsigned gen = old / nloc;
        if (old + 1u == (gen + 1u) * nloc) {
            __builtin_amdgcn_fence(__ATOMIC_RELEASE, "agent");
            asm volatile("s_waitcnt vmcnt(0)" ::: "memory");
            const unsigned og = xb_add(&bar[XB_TOP], 1u);
            const unsigned tg = og / nx;
            if (og + 1u == (tg + 1u) * nx) xb_add(&bar[XB_TOPGEN], 1u);
            else XB_SPIN(xb_ld(&bar[XB_TOPGEN]) == tg, bar);
            __builtin_amdgcn_fence(__ATOMIC_ACQUIRE, "agent");
            xb_add(&bar[XB_XGEN(b.x)], 1u);
            asm volatile("s_waitcnt vmcnt(0)" ::: "memory");
        } else {
            XB_SPIN(xb_ld(&bar[XB_XGEN(b.x)]) == gen, bar);
            __builtin_amdgcn_fence(__ATOMIC_ACQUIRE, "agent");
            asm volatile("s_waitcnt vmcnt(0)" ::: "memory");
        }
    }
    __syncthreads();
}


constexpr int NPH = 11;
#ifndef DUPMASK
#define DUPMASK 0
#endif
__global__ void __launch_bounds__(NTHREADS, 2) mega(Args a_, int lo, int hi) {
    extern __shared__ __attribute__((aligned(16))) unsigned char lds_raw[];
    LAS unsigned char* lds = (LAS unsigned char*)lds_raw;
#ifdef EXTRA_SYNCS
    for (int i = 0; i < EXTRA_SYNCS; ++i) { __syncthreads(); cg::this_grid().sync(); }
#endif
    LAS unsigned* xst = (LAS unsigned*)(lds + LDS_BYTES - 16);
    if (hi - lo > 1) {
        if (threadIdx.x == 0) { xst[0] = 0u; xst[1] = 0u; }
        __syncthreads();
        const __attribute__((address_space(4))) Args* ap0 = (const __attribute__((address_space(4))) Args*)__builtin_amdgcn_kernarg_segment_ptr();
        (void)xcd_barrier_post((unsigned*)(ap0->ws + WS_BAR), (volatile LAS unsigned*)xst);
    }
#pragma unroll 1
    for (int step2 = 2 * lo; step2 < 2 * hi; ++step2) {
        const int step = step2 >> 1;
        if ((step2 & 1) && !((DUPMASK >> (step % NPH)) & 1)) continue;
        const __attribute__((address_space(4))) Args* ap = (const __attribute__((address_space(4))) Args*)__builtin_amdgcn_kernarg_segment_ptr();
        asm volatile("" : "+s"(ap));
        ArgsRef a = *ap;
        unsigned char* ws = a.ws;
        float* SSa = (float*)(ws + WS_SS); float* SSb = SSa + T; float* SSc = SSb + T;
        const int l = step / NPH, ph = step % NPH;
        const float* xin = (l == 0) ? (const float*)a.in[0] : (const float*)a.out;
#ifndef PHMASK
#define PHMASK 0x7ff
#endif
        switch (ph) {
        case 0: if (PHMASK & (1 << 0)) { conv_phase(a, l, lds); if (l == 0) norm_phase(xin, (bf16_t*)(ws + WS_XN), SSa); zero_phase(SSb, T); } break;
        case 1: if (PHMASK & (1 << 1)) { pg8::EpiSwiGLU E; E.H = (bf16_t*)(ws + WS_HID); E.SS = SSa; run_gemm(lds, (const bf16_t*)(ws + WS_XN), (const bf16_t*)(ws + W_UP1), 2 * FF, D, E); } break;
        case 2: if (PHMASK & (1 << 2)) { pg8::EpiResidual<true> E; E.base = xin; E.out = a.out; E.XN = (bf16_t*)(ws + WS_XN); E.SS = SSb; run_gemm(lds, (const bf16_t*)(ws + WS_HID), (const bf16_t*)(ws + W_DN1), D, FF, E); } break;
        case 3: if (PHMASK & (1 << 3)) { pg8::EpiBf16 E; E.O = (bf16_t*)(ws + WS_PROJ); E.ldc = DIN; E.SS = SSb; run_gemm(lds, (const bf16_t*)(ws + WS_XN), (const bf16_t*)(ws + W_IN), DIN, D, E); } break;
        case 4: if (PHMASK & (1 << 4)) { zero_phase(SSa, T); zero_phase(SSc, T); alr_phase(a, l); attn_phase(a, l, lds); s5_phase(a, l, lds);
#ifdef DUP_S5
            s5_phase(a, l, lds);
#endif
#ifdef DUP_HG
            hgrn_phase(a, l, lds);
#endif
            hgrn_phase(a, l, lds); } break;
        case 5: if (PHMASK & (1 << 5)) { pg8::EpiLR E; E.O = (bf16_t*)(ws + WS_LRO); E.w0 = (const float*)a.in[9] + (size_t)l * 512; E.a0 = (const float*)a.in[11] + (size_t)l * 512;
                  run_gemm(lds, (const bf16_t*)(ws + WS_ALR), (const bf16_t*)(ws + W_LR), 1536, 256, E);
                  pg8::EpiGLU G; G.Z = (const bf16_t*)(ws + WS_Z); G.Y = (bf16_t*)(ws + WS_YC); G.b = (const float*)a.in[31] + (size_t)l * 512;
                  run_gemm(lds, (const bf16_t*)(ws + WS_Z), (const bf16_t*)(ws + W_GLU), 512, 512, G); } break;
        case 6: if (PHMASK & (1 << 6)) rwkv_phase(a, l, lds); break;
        case 7: if (PHMASK & (1 << 7)) post_phase(a, l); break;
        case 8: if (PHMASK & (1 << 8)) { pg8::EpiResidual<false> E; E.base = a.out; E.out = a.out; E.XN = (bf16_t*)(ws + WS_XN); E.SS = SSc; run_gemm(lds, (const bf16_t*)(ws + WS_YC), (const bf16_t*)(ws + W_OUT), D, D, E); } break;
        case 9: if (PHMASK & (1 << 9)) { pg8::EpiSwiGLU E; E.H = (bf16_t*)(ws + WS_HID); E.SS = SSc; run_gemm(lds, (const bf16_t*)(ws + WS_XN), (const bf16_t*)(ws + W_UP2), 2 * FF, D, E); } break;
        case 10: if (PHMASK & (1 << 10)) { pg8::EpiResidual<true> E; E.base = a.out; E.out = a.out; E.XN = (l + 1 < NL) ? (bf16_t*)(ws + WS_XN) : nullptr; E.SS = SSa; run_gemm(lds, (const bf16_t*)(ws + WS_HID), (const bf16_t*)(ws + W_DN2), D, FF, E); } break;
        }
        if (step2 + 1 < 2 * hi) {
            if (step2 == 2 * lo) { __syncthreads(); cg::this_grid().sync(); }
            else { XcdBarrier xb; xb.bar = (unsigned*)(ws + WS_BAR); xb.x = xb_xcc_id(); xb.st = (volatile LAS unsigned*)xst; xcd_barrier(xb); }
        }
    }
}

extern "C" void kernel_launch(void* const* d_in, const int* in_sizes, int n_in, void* d_out, int out_size, void* d_ws, size_t ws_size, hipStream_t stream) {
    static int grid = 0;
    if (!grid) {
        int dev = 0, cus = 0, per_cu = 0;
        hipGetDevice(&dev);
        hipDeviceGetAttribute(&cus, hipDeviceAttributeMultiprocessorCount, dev);
        hipFuncSetAttribute((const void*)mega, hipFuncAttributeMaxDynamicSharedMemorySize, LDS_BYTES);
        hipOccupancyMaxActiveBlocksPerMultiprocessor(&per_cu, (const void*)mega, NTHREADS, LDS_BYTES);
        if (per_cu < 1) per_cu = 1;
        grid = cus * 1;
        if (grid != 256) fprintf(stderr, "kernel_launch: grid %d (cus %d, per_cu %d)\n", grid, cus, per_cu);
    }
    Args a{};
    for (int i = 0; i < 39; ++i) a.in[i] = d_in[i];
    a.out = (float*)d_out; a.ws = (unsigned char*)d_ws;
#if ONE_LAUNCH
    (void)hipMemsetAsync((unsigned char*)d_ws + WS_BAR, 0, 16384, stream);
    int lo = 0, hi = NL * NPH;
    void* args[] = {&a, &lo, &hi};
    hipError_t e = hipLaunchCooperativeKernel((void*)mega, dim3(grid), dim3(NTHREADS), args, LDS_BYTES, stream);
    if (e != hipSuccess) fprintf(stderr, "cooperative launch failed: %s (grid %d)\n", hipGetErrorString(e), grid);
#else
    for (int s = 0; s < NL * NPH; ++s) hipLaunchKernelGGL(mega, dim3(grid), dim3(NTHREADS), LDS_BYTES, stream, a, s, s + 1);
#endif
}
```

```cpp
#include <hip/hip_runtime.h>
#include <hip/hip_cooperative_groups.h>
#include <cstdio>
#include <cstdint>
namespace cg = cooperative_groups;

#ifndef ONE_LAUNCH
#define ONE_LAUNCH 1
#endif

#define LAS __attribute__((address_space(3)))
typedef unsigned short bf16_t;
typedef short bf16x8 __attribute__((ext_vector_type(8)));
typedef float f32x4 __attribute__((ext_vector_type(4)));
typedef float f32x2 __attribute__((ext_vector_type(2)));
typedef unsigned u32x4 __attribute__((ext_vector_type(4)));
typedef unsigned u32x2 __attribute__((ext_vector_type(2)));

constexpr int T = 32768, SEQ = 2048, NB = 16, D = 2048, FF = 5632, DIN = 5120, NL = 2;
constexpr int C_RWKV = 0, C_ATT = 1792, C_S5 = 2560, C_HG = 3072;
constexpr int NTHREADS = 512, NWAVES = 8;

constexpr size_t SZ_UP = (size_t)2 * FF * D * 2, SZ_DN = (size_t)D * FF * 2, SZ_IN = (size_t)DIN * D * 2, SZ_LR = (size_t)1536 * 256 * 2,
                 SZ_GLU = (size_t)512 * 512 * 2, SZ_OUT = (size_t)D * D * 2;
constexpr size_t W_UP1 = 0, W_DN1 = W_UP1 + SZ_UP, W_IN = W_DN1 + SZ_DN, W_LR = W_IN + SZ_IN, W_GLU = W_LR + SZ_LR, W_OUT = W_GLU + SZ_GLU,
                 W_UP2 = W_OUT + SZ_OUT, W_DN2 = W_UP2 + SZ_UP, W_END = W_DN2 + SZ_DN;
constexpr size_t WS_XN = W_END, WS_BIG = WS_XN + (size_t)T * D * 2;
constexpr size_t WS_HID = WS_BIG;
constexpr size_t WS_PROJ = WS_BIG, WS_LRO = WS_PROJ + (size_t)T * DIN * 2, WS_ALR = WS_LRO + (size_t)T * 1536 * 2, WS_Z = WS_ALR + (size_t)T * 256 * 2,
                 WS_OR = WS_Z + (size_t)T * 512 * 2, WS_OH = WS_OR + (size_t)T * 512 * 4, WS_BON = WS_OH + (size_t)T * 512 * 4, WS_YC = WS_BON + (size_t)T * 8 * 4, WS_SS = WS_YC + (size_t)T * D * 2, WS_BAR = WS_SS + (size_t)3 * T * 4, WS_END = WS_BAR + 16384;
static_assert(WS_END <= (size_t)1 << 30, "workspace");
static_assert(WS_HID + (size_t)T * FF * 2 <= (size_t)1 << 30, "workspace");

constexpr int LDS_BYTES = 147456;

struct Args { const void* in[39]; float* out; unsigned char* ws; };
typedef const __attribute__((address_space(4))) Args& ArgsRef;

typedef __bf16 bf16x2_t __attribute__((ext_vector_type(2)));
__device__ __forceinline__ unsigned pk2(float lo, float hi) { const f32x2 v = (f32x2){lo, hi}; return __builtin_bit_cast(unsigned, __builtin_convertvector(v, bf16x2_t)); }
__device__ __forceinline__ float bflo(unsigned w) { return __uint_as_float(w << 16); }
__device__ __forceinline__ float bfhi(unsigned w) { return __uint_as_float(w & 0xffff0000u); }
__device__ __forceinline__ void unpack8(u32x4 q, float* f) { f[0] = bflo(q.x); f[1] = bfhi(q.x); f[2] = bflo(q.y); f[3] = bfhi(q.y); f[4] = bflo(q.z); f[5] = bfhi(q.z); f[6] = bflo(q.w); f[7] = bfhi(q.w); }
__device__ __forceinline__ u32x4 pack8(const float* f) { u32x4 o; o.x = pk2(f[0], f[1]); o.y = pk2(f[2], f[3]); o.z = pk2(f[4], f[5]); o.w = pk2(f[6], f[7]); return o; }
template <int CTRL> __device__ __forceinline__ float dpp(float x) { return __builtin_bit_cast(float, __builtin_amdgcn_mov_dpp(__builtin_bit_cast(int, x), CTRL, 0xf, 0xf, true)); }
constexpr int XOR1 = 0xB1, XOR2 = 0x4E, XOR7 = 0x141, XOR8 = 0x128;
__device__ __forceinline__ float red8(float v) { v += dpp<XOR1>(v); v += dpp<XOR2>(v); v += dpp<XOR7>(v); return v; }
__device__ __forceinline__ float red16(float v) { v = red8(v); v += dpp<XOR8>(v); return v; }
__device__ __forceinline__ float wave_sum(float v) {
#pragma unroll
    for (int o = 1; o < 64; o <<= 1) v += __shfl_xor(v, o);
    return v;
}
__device__ __forceinline__ float sigmoidf_(float x) { return __builtin_amdgcn_rcpf(1.0f + __expf(-x)); }
__device__ __forceinline__ float siluf_(float x) { return x * __builtin_amdgcn_rcpf(1.0f + __expf(-x)); }
__device__ __forceinline__ int opaque_tid() { int t = threadIdx.x; asm volatile("" : "+v"(t)); return t; }
__device__ __forceinline__ int opaque_bid() { int t = blockIdx.x; asm volatile("" : "+s"(t)); return t; }
__device__ __forceinline__ f32x2 pfma(f32x2 a, f32x2 b, f32x2 c) { return __builtin_elementwise_fma(a, b, c); }
#define LDS_FENCE() asm volatile("s_waitcnt lgkmcnt(0)" ::: "memory")
__device__ __forceinline__ void sincos_big(float x, float& sn, float& cs) {
    const float n = rintf(x * 0.15915494309189535f);
    float r = fmaf(-n, 6.28318548202514648f, x); r = fmaf(-n, -1.7484555e-7f, r);
    sn = __sinf(r); cs = __cosf(r);
}

namespace pg8 {
constexpr int BM = 256, BK = 64, HALF = 128, HTB = HALF * BK * 2, STAGE_BYTES = 8 * HTB, NXCD = 8, WGM = 8;
__host__ __device__ __forceinline__ int lds_byte(int r, int c) { const int st = (r >> 4) * 2 + (c >> 5), rr = r & 15, cc = c & 31, ob = rr * 64 + cc * 2; return st * 1024 + (ob ^ (((ob >> 9) & 1) << 5)); }
__host__ __device__ __forceinline__ void stage_rc(int b, int& R, int& C) { const int st = b / 1024, sb = b % 1024, swz = sb ^ (((sb >> 9) & 1) << 5); R = (st >> 1) * 16 + swz / 64; C = (st & 1) * 32 + (swz % 64) / 2; }
__host__ __device__ __forceinline__ int perm32(int rho) { const int n = rho >> 4, i = rho & 15; return 8 * (i >> 2) + 4 * n + (i & 3); }
struct Unit { int pm, pn; };
struct Gemm { const bf16_t* A; const bf16_t* Bt; int M, N, K; };
struct StaticOrder {
    int nM, nN, nwg, G, c;
    __device__ void init(int M, int N, int G_, int c_) { nM = M / BM; nN = N / BM; nwg = nM * nN; G = G_; c = c_; }
    __device__ bool next(int i, Unit& u) const {
        const long L = (long)i * G + c; if (L >= nwg) return false;
        int wgid = (int)L; { const int q = nwg / NXCD, r = nwg % NXCD, xcd = wgid % NXCD, off = wgid / NXCD; wgid = (xcd < r ? xcd * (q + 1) : r * (q + 1) + (xcd - r) * q) + off; }
        const int nig = WGM * nN, gid = wgid / nig, fm = gid * WGM, gsz = (nM - fm) < WGM ? (nM - fm) : WGM;
        u.pm = fm + ((wgid % nig) % gsz); u.pn = (wgid % nig) / gsz; return true;
    }
};
template <class Epi>
__device__ __forceinline__ void gemm_phase(LAS unsigned char* lds, const Gemm g, const StaticOrder S, const Epi E) {
    const int TID = opaque_tid(), BID = opaque_bid(); (void)TID; (void)BID;
    const int tid = TID, wid = __builtin_amdgcn_readfirstlane(tid >> 6), lane = tid & 63, wr = wid >> 2, wc = wid & 3, fr = lane & 15, fq = lane >> 4;
    const int K = g.K, nt = K / BK;
    unsigned voffA[2], voffB[2];
#pragma unroll
    for (int i = 0; i < 2; ++i) { int R, C; stage_rc(tid * 16 + i * 8192, R, C); const int Rb = Epi::PERM ? ((R & ~31) + perm32(R & 31)) : R;
        voffA[i] = (unsigned)(R * K + C) * 2u; voffB[i] = (unsigned)(Rb * K + C) * 2u; }
    const size_t kstep = (size_t)(BK * 2);
    const size_t hstep = (size_t)HALF * K * 2;
    const size_t tstep = 2 * hstep;
    const unsigned ldsw = (unsigned)wid * 1024u;
    const int aoff = lds_byte(wr * 64 + fr, fq * 8), boff = lds_byte(wc * 32 + fr, fq * 8);
#define PG8_SA(b, h) (((b) * 2 + (h)) * HTB)
#define PG8_SB(b, h) ((4 + (b) * 2 + (h)) * HTB)
#define PG8_STAGE(bufoff, gbase, voff) do { _Pragma("unroll") for (int _i = 0; _i < 2; ++_i) \
        __builtin_amdgcn_global_load_lds((const unsigned*)((const char*)(gbase) + (voff)[_i]), (LAS unsigned*)(lds + (bufoff) + ldsw + _i * 8192), 16, 0, 0); } while (0)
#define PG8_LDA(dst, b, h) do { _Pragma("unroll") for (int m = 0; m < 4; ++m) _Pragma("unroll") for (int k = 0; k < 2; ++k) dst[m][k] = *(const LAS bf16x8*)(lds + PG8_SA(b, h) + aoff + m * 2048 + k * 1024); } while (0)
#define PG8_LDB(dst, b, h) do { _Pragma("unroll") for (int n = 0; n < 2; ++n) _Pragma("unroll") for (int k = 0; k < 2; ++k) dst[n][k] = *(const LAS bf16x8*)(lds + PG8_SB(b, h) + boff + n * 2048 + k * 1024); } while (0)
#define PG8_MMA(ai, bj, At, Bt) do { __builtin_amdgcn_s_setprio(1); _Pragma("unroll") for (int m = 0; m < 4; ++m) _Pragma("unroll") for (int n = 0; n < 2; ++n) _Pragma("unroll") for (int k = 0; k < 2; ++k) \
        acc[ai][bj][m][n] = __builtin_amdgcn_mfma_f32_16x16x32_bf16(Bt[n][k], At[m][k], acc[ai][bj][m][n], 0, 0, 0); __builtin_amdgcn_s_setprio(0); } while (0)
#define PG8_WAIT_V(n) asm volatile("s_waitcnt vmcnt(" #n ")" ::: "memory")
#define PG8_WAIT_L(n) asm volatile("s_waitcnt lgkmcnt(" #n ")" ::: "memory")
#define PG8_BAR __builtin_amdgcn_s_barrier()
#define PG8_SCHED __builtin_amdgcn_sched_barrier(0)
    Unit cur, nxt; int ui = 0;
    if (!S.next(0, cur)) return;
    f32x4 acc[2][2][4][2];
#pragma unroll
    for (int a = 0; a < 2; ++a)
#pragma unroll
        for (int b = 0; b < 2; ++b)
#pragma unroll
            for (int m = 0; m < 4; ++m)
#pragma unroll
                for (int n = 0; n < 2; ++n) acc[a][b][m][n] = (f32x4){0.f, 0.f, 0.f, 0.f};
    bf16x8 At[4][2], B0[2][2], B1[2][2];
    const char* cA = (const char*)g.A + (size_t)cur.pm * tstep; const char* cB = (const char*)g.Bt + (size_t)cur.pn * tstep;
    PG8_STAGE(PG8_SB(0, 0), cB, voffB); PG8_STAGE(PG8_SA(0, 0), cA, voffA); PG8_STAGE(PG8_SB(0, 1), cB + hstep, voffB); PG8_STAGE(PG8_SA(0, 1), cA + hstep, voffA);
    if (wr == 1) PG8_BAR;
    PG8_WAIT_V(4); PG8_BAR;
    PG8_STAGE(PG8_SB(1, 0), cB + kstep, voffB); PG8_STAGE(PG8_SA(1, 0), cA + kstep, voffA); PG8_STAGE(PG8_SB(1, 1), cB + hstep + kstep, voffB);
    PG8_WAIT_V(6); PG8_BAR;
    for (;;) {
        const bool has_next = S.next(ui + 1, nxt);
        const char* nA = has_next ? (const char*)g.A + (size_t)nxt.pm * tstep : cA; const char* nB = has_next ? (const char*)g.Bt + (size_t)nxt.pn * tstep : cB;
#pragma unroll 1
        for (int t = 0; t < nt; t += 2) {
            const bool last = (t == nt - 2);
            const char* a1 = cA + (size_t)(t + 1) * kstep;
            const char* a2 = last ? nA : cA + (size_t)(t + 2) * kstep; const char* b2 = last ? nB : cB + (size_t)(t + 2) * kstep;
            const char* a3 = a2 + kstep; const char* b3 = b2 + kstep;
            PG8_LDB(B0, 0, 0); PG8_SCHED; PG8_LDA(At, 0, 0); PG8_STAGE(PG8_SA(1, 1), a1 + hstep, voffA);
            PG8_WAIT_L(8); PG8_BAR; PG8_WAIT_L(0); PG8_MMA(0, 0, At, B0); PG8_BAR; PG8_SCHED;
            PG8_LDB(B1, 0, 1); PG8_STAGE(PG8_SB(0, 0), b2, voffB);
            PG8_BAR; PG8_WAIT_L(0); PG8_MMA(0, 1, At, B1); PG8_BAR;
            PG8_LDA(At, 0, 1); PG8_STAGE(PG8_SA(0, 0), a2, voffA);
            PG8_BAR; PG8_WAIT_L(0); PG8_MMA(1, 0, At, B0); PG8_BAR; PG8_SCHED;
            PG8_STAGE(PG8_SB(0, 1), b2 + hstep, voffB);
            PG8_WAIT_V(6); PG8_BAR; PG8_MMA(1, 1, At, B1); PG8_BAR;
            PG8_LDB(B0, 1, 0); PG8_SCHED; PG8_LDA(At, 1, 0); PG8_STAGE(PG8_SA(0, 1), a2 + hstep, voffA);
            PG8_WAIT_L(8); PG8_BAR; PG8_WAIT_L(0); PG8_MMA(0, 0, At, B0); PG8_BAR; PG8_SCHED;
            PG8_LDB(B1, 1, 1); PG8_STAGE(PG8_SB(1, 0), b3, voffB);
            PG8_BAR; PG8_WAIT_L(0); PG8_MMA(0, 1, At, B1); PG8_BAR;
            PG8_LDA(At, 1, 1); PG8_STAGE(PG8_SA(1, 0), a3, voffA);
            PG8_BAR; PG8_WAIT_L(0); PG8_MMA(1, 0, At, B0); PG8_BAR; PG8_SCHED;
            PG8_STAGE(PG8_SB(1, 1), b3 + hstep, voffB);
            PG8_WAIT_V(6); PG8_BAR; PG8_MMA(1, 1, At, B1); PG8_BAR;
        }
        E(acc, cur, wr, wc, fr, fq);
        if (!has_next) break;
#pragma unroll
        for (int a = 0; a < 2; ++a)
#pragma unroll
            for (int b = 0; b < 2; ++b)
#pragma unroll
                for (int m = 0; m < 4; ++m)
#pragma unroll
                    for (int n = 0; n < 2; ++n) acc[a][b][m][n] = (f32x4){0.f, 0.f, 0.f, 0.f};
        cur = nxt; cA = nA; cB = nB; ++ui;
    }
    PG8_WAIT_V(0);
    if (wr == 0) PG8_BAR;
    PG8_BAR;
#undef PG8_SA
#undef PG8_SB
#undef PG8_STAGE
#undef PG8_LDA
#undef PG8_LDB
#undef PG8_MMA
#undef PG8_WAIT_V
#undef PG8_WAIT_L
#undef PG8_BAR
#undef PG8_SCHED
}

struct EpiSwiGLU {
    static constexpr bool PERM = true;
    bf16_t* H; const float* SS;
    __device__ __forceinline__ void operator()(const f32x4 (&acc)[2][2][4][2], const Unit& u, int wr, int wc, int fr, int fq) const {
        const int row0 = u.pm * BM + wr * 64 + fr, col0 = u.pn * 128 + wc * 32 + 8 * fq;
#pragma unroll
        for (int ai = 0; ai < 2; ++ai)
#pragma unroll
            for (int m = 0; m < 4; ++m) {
                const float rs = __builtin_amdgcn_rsqf(SS[row0 + ai * HALF + m * 16] * (1.0f / D) + 1e-6f);
                float v[8];
#pragma unroll
                for (int n = 0; n < 2; ++n)
#pragma unroll
                    for (int j = 0; j < 4; ++j) { const float gt = acc[ai][0][m][n][j] * rs, up = acc[ai][1][m][n][j] * rs; v[4 * n + j] = siluf_(gt) * up; }
                *(u32x4*)(H + (size_t)(row0 + ai * HALF + m * 16) * FF + col0) = pack8(v);
            }
    }
};
template <bool HALFSTEP> struct EpiResidual {
    static constexpr bool PERM = false;
    static constexpr float scale = HALFSTEP ? 0.5f : 1.0f;
    const float* base; float* out; bf16_t* XN; float* SS;
    __device__ __forceinline__ void operator()(const f32x4 (&acc)[2][2][4][2], const Unit& u, int wr, int wc, int fr, int fq) const {
        const int row0 = u.pm * BM + wr * 64 + fr, col0 = u.pn * BM + wc * 32 + 4 * fq;
#pragma unroll
        for (int ai = 0; ai < 2; ++ai)
#pragma unroll
            for (int m = 0; m < 4; ++m) { const int row = row0 + ai * HALF + m * 16; const size_t ro = (size_t)row * D + col0; float ss = 0.f;
#pragma unroll
                for (int bj = 0; bj < 2; ++bj)
#pragma unroll
                    for (int n = 0; n < 2; ++n) { const f32x4 b = *(const f32x4*)(base + ro + bj * HALF + n * 16); const f32x4 r = b + acc[ai][bj][m][n] * scale; *(f32x4*)(out + ro + bj * HALF + n * 16) = r;
                        if (XN) { u32x2 w; w.x = pk2(r.x, r.y); w.y = pk2(r.z, r.w); *(u32x2*)(XN + ro + bj * HALF + n * 16) = w; ss += (r.x * r.x + r.y * r.y) + (r.z * r.z + r.w * r.w); } }
                if (XN) { ss += __shfl_xor(ss, 16); ss += __shfl_xor(ss, 32); if (fq == 0) atomicAdd(SS + row, ss); } }
    }
};
struct EpiBf16 {
    static constexpr bool PERM = true;
    bf16_t* O; int ldc; const float* SS;
    __device__ __forceinline__ void operator()(const f32x4 (&acc)[2][2][4][2], const Unit& u, int wr, int wc, int fr, int fq) const {
        const int row0 = u.pm * BM + wr * 64 + fr, col0 = u.pn * BM + wc * 32 + 8 * fq;
#pragma unroll
        for (int ai = 0; ai < 2; ++ai)
#pragma unroll
            for (int m = 0; m < 4; ++m) { bf16_t* rowp = O + (size_t)(row0 + ai * HALF + m * 16) * ldc + col0;
                const float rs = __builtin_amdgcn_rsqf(SS[row0 + ai * HALF + m * 16] * (1.0f / D) + 1e-6f);
#pragma unroll
                for (int bj = 0; bj < 2; ++bj) { const f32x4 v0 = acc[ai][bj][m][0] * rs, v1 = acc[ai][bj][m][1] * rs;
                    u32x4 w; w.x = pk2(v0[0], v0[1]); w.y = pk2(v0[2], v0[3]); w.z = pk2(v1[0], v1[1]); w.w = pk2(v1[2], v1[3]);
                    *(u32x4*)(rowp + bj * HALF) = w; } }
    }
};
struct EpiLR {
    static constexpr bool PERM = true;
    bf16_t* O; const float* w0; const float* a0;
    template <int KIND> __device__ __forceinline__ void body(const f32x4 (&acc)[2][2][4][2], const float* bp, int row0, int col0) const {
#pragma unroll
        for (int bj = 0; bj < 2; ++bj) {
            f32x4 b0 = (f32x4){0.f, 0.f, 0.f, 0.f}, b1 = b0;
            if (KIND < 2) { b0 = *(const f32x4*)(bp + bj * HALF); b1 = *(const f32x4*)(bp + bj * HALF + 4); }
#pragma unroll
            for (int ai = 0; ai < 2; ++ai)
#pragma unroll
                for (int m = 0; m < 4; ++m) {
                    u32x4 w;
#pragma unroll
                    for (int n = 0; n < 2; ++n) {
                        float r[4];
#pragma unroll
                        for (int j = 0; j < 4; ++j) { const float x = acc[ai][bj][m][n][j] + (n == 0 ? b0[j] : b1[j]);
                            if (KIND == 0) { const float e = __expf(-x); r[j] = -0.60653065971f * __builtin_amdgcn_rcpf(1.0f + e); }
                            else if (KIND == 1) r[j] = __builtin_amdgcn_rcpf(1.0f + __expf(-x)); else r[j] = x; }
                        if (n == 0) { w.x = pk2(r[0], r[1]); w.y = pk2(r[2], r[3]); } else { w.z = pk2(r[0], r[1]); w.w = pk2(r[2], r[3]); }
                    }
                    *(u32x4*)(O + (size_t)(row0 + ai * HALF + m * 16) * 1536 + col0 + bj * HALF) = w;
                }
        }
    }
    __device__ __forceinline__ void operator()(const f32x4 (&acc)[2][2][4][2], const Unit& u, int wr, int wc, int fr, int fq) const {
        const int row0 = u.pm * BM + wr * 64 + fr, col0 = u.pn * BM + wc * 32 + 8 * fq, kind = u.pn >> 1, f0 = col0 - 512 * kind;
        if (kind == 0) body<0>(acc, w0 + f0, row0, col0); else if (kind == 1) body<1>(acc, a0 + f0, row0, col0); else body<2>(acc, nullptr, row0, col0);
    }
};
struct EpiGLU {
    static constexpr bool PERM = true;
    const bf16_t* Z; bf16_t* Y; const float* b;
    __device__ __forceinline__ void operator()(const f32x4 (&acc)[2][2][4][2], const Unit& u, int wr, int wc, int fr, int fq) const {
        const int row0 = u.pm * BM + wr * 64 + fr, col0 = u.pn * BM + wc * 32 + 8 * fq;
#pragma unroll
        for (int bj = 0; bj < 2; ++bj) {
            const f32x4 bias0 = *(const f32x4*)(b + col0 + bj * HALF), bias1 = *(const f32x4*)(b + col0 + bj * HALF + 4);
#pragma unroll
            for (int ai = 0; ai < 2; ++ai)
#pragma unroll
                for (int m = 0; m < 4; ++m) { const size_t r = (size_t)(row0 + ai * HALF + m * 16);
                    float z[8], v[8]; unpack8(*(const u32x4*)(Z + r * 512 + col0 + bj * HALF), z);
#pragma unroll
                    for (int n = 0; n < 2; ++n)
#pragma unroll
                        for (int j = 0; j < 4; ++j) v[4 * n + j] = z[4 * n + j] * sigmoidf_(acc[ai][bj][m][n][j] + (n == 0 ? bias0[j] : bias1[j]));
                    *(u32x4*)(Y + r * D + 1024 + col0 + bj * HALF) = pack8(v); }
        }
    }
};
}

template <class Epi> __device__ __forceinline__ void run_gemm(LAS unsigned char* lds, const bf16_t* A, const bf16_t* Bt, int N, int K, const Epi E) {
    pg8::Gemm g; g.A = A; g.Bt = Bt; g.M = T; g.N = N; g.K = K;
    pg8::StaticOrder S; S.init(T, N, gridDim.x, opaque_bid());
    pg8::gemm_phase<Epi>(lds, g, S, E);
}

__device__ __forceinline__ void tr_item(const float* W, int ldw, int k0, int n0, const float* gs, bf16_t* Dst, int ldd, int drow0, int dk0, LAS float* scr, int lane) {
    if (W) {
        f32x4 v[8];
#pragma unroll
        for (int i = 0; i < 8; ++i) { const int kk = 8 * i + (lane >> 3); v[i] = *(const f32x4*)(W + (size_t)(k0 + kk) * ldw + n0 + 4 * (lane & 7)); }
#pragma unroll
        for (int i = 0; i < 8; ++i) { const int kk = 8 * i + (lane >> 3); f32x4 x = v[i]; if (gs) x = x * gs[k0 + kk];
            LAS float* d = scr + kk * 33 + 4 * (lane & 7); d[0] = x.x; d[1] = x.y; d[2] = x.z; d[3] = x.w; }
    } else {
#pragma unroll 8
        for (int i = 0; i < 32; ++i) { const int kk = 2 * i + (lane >> 5); scr[kk * 33 + (lane & 31)] = 0.f; }
    }
    LDS_FENCE();
    const int c = lane & 7;
#pragma unroll
    for (int j = 0; j < 4; ++j) { const int n = (lane >> 3) + 8 * j; const LAS float* s = scr + (8 * c) * 33 + n;
        u32x4 o; o.x = pk2(s[0 * 33], s[1 * 33]); o.y = pk2(s[2 * 33], s[3 * 33]); o.z = pk2(s[4 * 33], s[5 * 33]); o.w = pk2(s[6 * 33], s[7 * 33]);
        *(u32x4*)(Dst + (size_t)(drow0 + n) * ldd + dk0 + k0 - 0 + 8 * c - 0) = o; }
    LDS_FENCE();
}

__device__ __forceinline__ void conv_phase(ArgsRef a, int l, LAS unsigned char* lds) {
    const int TID = opaque_tid(), BID = opaque_bid(); (void)TID; (void)BID;
    const int wave = TID >> 6, lane = TID & 63;
    LAS float* scr = (LAS float*)(lds + wave * 8704);
    const int gw = BID * NWAVES + wave, NGW = gridDim.x * NWAVES;
    unsigned char* ws = a.ws;
    constexpr int I_GU = (D / 64) * (FF / 32), I_DN = (FF / 64) * (D / 32), I_IN = (D / 64) * (DIN / 32), I_OUT = (D / 64) * (D / 32), I_GLU = 8 * 16, I_LR = 48 * 4;
    constexpr int NITEMS = 6 * I_GU + I_IN + I_OUT + I_GLU + I_LR;
    static_assert(I_GU == I_DN, "items");
    for (int it = gw; it < NITEMS; it += NGW) {
        int r = it;
        if (r < 6 * I_GU) {
            const int which = r / I_GU; r -= which * I_GU;
            const int f = which >= 3, m = which % 3;
            if (m < 2) {
                const float* W = (const float*)a.in[(f ? 36 : 3) + m] + (size_t)l * D * FF;
                const float* gs = (const float*)a.in[f ? 35 : 2] + (size_t)l * D;
                bf16_t* dst = (bf16_t*)(ws + (f ? W_UP2 : W_UP1));
                const int nblk = FF / 32, kb = r / nblk, nb = r % nblk, n0 = 32 * nb;
                tr_item(W, FF, 64 * kb, n0, gs, dst, D, (n0 >> 7) * 256 + (n0 & 127) + 128 * m, 0, scr, lane);
            } else {
                const float* W = (const float*)a.in[f ? 38 : 5] + (size_t)l * FF * D;
                bf16_t* dst = (bf16_t*)(ws + (f ? W_DN2 : W_DN1));
                const int nblk = D / 32, kb = r / nblk, nb = r % nblk;
                tr_item(W, D, 64 * kb, 32 * nb, nullptr, dst, FF, 32 * nb, 0, scr, lane);
            }
            continue;
        }
        r -= 6 * I_GU;
        if (r < I_IN) { const int nblk = DIN / 32, kb = r / nblk, nb = r % nblk;
            tr_item((const float*)a.in[7] + (size_t)l * D * DIN, DIN, 64 * kb, 32 * nb, (const float*)a.in[6] + (size_t)l * D, (bf16_t*)(ws + W_IN), D, 32 * nb, 0, scr, lane); continue; }
        r -= I_IN;
        if (r < I_OUT) { const int nblk = D / 32, kb = r / nblk, nb = r % nblk;
            tr_item((const float*)a.in[34] + (size_t)l * D * D, D, 64 * kb, 32 * nb, nullptr, (bf16_t*)(ws + W_OUT), D, 32 * nb, 0, scr, lane); continue; }
        r -= I_OUT;
        if (r < I_GLU) { const int kb = r / 16, nb = r % 16;
            tr_item((const float*)a.in[30] + (size_t)l * 512 * 512, 512, 64 * kb, 32 * nb, nullptr, (bf16_t*)(ws + W_GLU), 512, 32 * nb, 0, scr, lane); continue; }
        r -= I_GLU;
        {
            const int nb = r >> 2, kb = r & 3, kind = nb >> 4, nn0 = 32 * (nb & 15);
            const float* W = nullptr; int k0 = 0;
            if (kind == 0 && kb == 0) { W = (const float*)a.in[10] + (size_t)l * 64 * 512; k0 = 0; }
            else if (kind == 1 && kb == 1) { W = (const float*)a.in[12] + (size_t)l * 64 * 512; k0 = 0; }
            else if (kind == 2 && kb >= 2) { W = (const float*)a.in[13] + (size_t)l * 128 * 512; k0 = 64 * (kb - 2); }
            tr_item(W, 512, k0, nn0, nullptr, (bf16_t*)(ws + W_LR), 256, 32 * nb, 64 * kb - k0, scr, lane);
        }
    }
}

__device__ __forceinline__ void norm_phase(const float* x, bf16_t* XN, float* SS) {
    const int TID = opaque_tid(), BID = opaque_bid(); (void)TID; (void)BID;
    const int wave = TID >> 6, lane = TID & 63;
    const int gw = BID * NWAVES + wave, NGW = gridDim.x * NWAVES;
    for (int m = gw; m < T; m += NGW) {
        const f32x4* xr = (const f32x4*)(x + (size_t)m * D) + lane;
        f32x4 v[8]; float s = 0.f;
#pragma unroll
        for (int j = 0; j < 8; ++j) { v[j] = xr[64 * j]; s += (v[j].x * v[j].x + v[j].y * v[j].y) + (v[j].z * v[j].z + v[j].w * v[j].w); }
        s = wave_sum(s); if (lane == 0) SS[m] = s;
        u32x2* o = (u32x2*)(XN + (size_t)m * D) + lane;
#pragma unroll
        for (int j = 0; j < 8; ++j) { u32x2 w; w.x = pk2(v[j].x, v[j].y); w.y = pk2(v[j].z, v[j].w); o[64 * j] = w; }
    }
}

__device__ __forceinline__ void zero_phase(float* p, int n) {
    const int TID = opaque_tid(), BID = opaque_bid();
    for (int i = BID * NTHREADS + TID; i < n; i += gridDim.x * NTHREADS) p[i] = 0.f;
}
__device__ __forceinline__ void alr_phase(ArgsRef a, int l) {
    const int TID = opaque_tid(), BID = opaque_bid(); (void)TID; (void)BID;
    const bf16_t* P = (const bf16_t*)(a.ws + WS_PROJ); bf16_t* ALR = (bf16_t*)(a.ws + WS_ALR);
    const float* mu = (const float*)a.in[8] + (size_t)l * 1792 + 1536;
    const int gt = BID * NTHREADS + TID, NGT = gridDim.x * NTHREADS;
    for (int it = gt; it < T * 32; it += NGT) {
        const int t = it >> 5, cg = it & 31, c0 = 8 * cg;
        float cur[8], prv[8], o[8];
        unpack8(*(const u32x4*)(P + (size_t)t * DIN + 1536 + c0), cur);
        if ((t & (SEQ - 1)) != 0) unpack8(*(const u32x4*)(P + (size_t)(t - 1) * DIN + 1536 + c0), prv);
        else {
#pragma unroll
            for (int j = 0; j < 8; ++j) prv[j] = 0.f; }
#pragma unroll
        for (int j = 0; j < 8; ++j) { const float v = cur[j] + (prv[j] - cur[j]) * mu[c0 + j];
            o[j] = c0 < 64 ? tanhf(v) : (c0 < 128 ? v : sigmoidf_(v)); }
        *(u32x4*)(ALR + (size_t)t * 256 + c0) = pack8(o);
    }
}

__device__ __forceinline__ void rwkv_full(ArgsRef a, int l, LAS unsigned char* lds, int job, int tid) {
    const bf16_t* P = (const bf16_t*)(a.ws + WS_PROJ); const bf16_t* LR = (const bf16_t*)(a.ws + WS_LRO); bf16_t* Y = (bf16_t*)(a.ws + WS_YC);
    LAS float* sR = (LAS float*)lds; LAS float* sW = sR + 4096; LAS float* sK = sW + 4096; LAS float* sKK = sK + 4096; LAS float* sB = sKK + 4096;
    LAS float* sV = sB + 4096; LAS float* sO = sV + 4096; LAS float* sBon = sO + 4096;
    const int wave = tid >> 6, lane = tid & 63, tt = tid >> 3, cg = tid & 7;
    const int b = job >> 3, h = job & 7, c0 = 64 * h + 8 * cg;
    float mur[8], muk[8], muv[8], kkw[8], kaw[8], rkw[8], lnw[8], lnb[8];
#pragma unroll
    for (int j = 0; j < 8; ++j) {
        mur[j] = ((const float*)a.in[8])[(size_t)l * 1792 + c0 + j]; muk[j] = ((const float*)a.in[8])[(size_t)l * 1792 + 512 + c0 + j]; muv[j] = ((const float*)a.in[8])[(size_t)l * 1792 + 1024 + c0 + j];
        kkw[j] = ((const float*)a.in[14])[(size_t)l * 512 + c0 + j]; kaw[j] = ((const float*)a.in[15])[(size_t)l * 512 + c0 + j]; rkw[j] = ((const float*)a.in[16])[(size_t)l * 512 + c0 + j];
        lnw[j] = ((const float*)a.in[17])[(size_t)l * 512 + c0 + j]; lnb[j] = ((const float*)a.in[18])[(size_t)l * 512 + c0 + j]; }
    f32x2 st0 = (f32x2){0.f, 0.f}, st1 = st0, st2 = st0, st3 = st0;
    const int row = 8 * wave + (lane >> 3), jq = lane & 7;
    u32x4 graw[9];
    const u32x4 zero4 = (u32x4){0u, 0u, 0u, 0u};
#define RWF_ISSUE(ch_) do { const int s_ = (ch_) * 64 + tt; const size_t t_ = (size_t)b * SEQ + s_; \
        graw[0] = *(const u32x4*)(P + t_ * DIN + c0); graw[1] = *(const u32x4*)(P + t_ * DIN + 512 + c0); graw[2] = *(const u32x4*)(P + t_ * DIN + 1024 + c0); \
        if (s_ != 0) { graw[3] = *(const u32x4*)(P + (t_ - 1) * DIN + c0); graw[4] = *(const u32x4*)(P + (t_ - 1) * DIN + 512 + c0); graw[5] = *(const u32x4*)(P + (t_ - 1) * DIN + 1024 + c0); } \
        else { graw[3] = zero4; graw[4] = zero4; graw[5] = zero4; } \
        graw[6] = *(const u32x4*)(LR + t_ * 1536 + c0); graw[7] = *(const u32x4*)(LR + t_ * 1536 + 512 + c0); graw[8] = *(const u32x4*)(LR + t_ * 1536 + 1024 + c0); } while (0)
    RWF_ISSUE(0);
    for (int ch = 0; ch < SEQ / 64; ++ch) {
        __syncthreads();
        float gate[8];
        {
            float r[8], k[8], v[8], pr[8], ld[8], av[8];
            unpack8(graw[0], r); unpack8(graw[1], k); unpack8(graw[2], v);
            unpack8(graw[3], pr);
#pragma unroll
            for (int j = 0; j < 8; ++j) r[j] += (pr[j] - r[j]) * mur[j];
            unpack8(graw[4], pr);
#pragma unroll
            for (int j = 0; j < 8; ++j) k[j] += (pr[j] - k[j]) * muk[j];
            unpack8(graw[5], pr);
#pragma unroll
            for (int j = 0; j < 8; ++j) v[j] += (pr[j] - v[j]) * muv[j];
            unpack8(graw[6], ld); unpack8(graw[7], av); unpack8(graw[8], gate);
            if (ch + 1 < SEQ / 64) RWF_ISSUE(ch + 1);
            float kk[8], ss = 0.f, bp = 0.f;
#pragma unroll
            for (int j = 0; j < 8; ++j) { kk[j] = k[j] * kkw[j]; ss += kk[j] * kk[j]; }
            ss = red8(ss);
            const float inv = __builtin_amdgcn_rsqf(fmaxf(ss, 1e-24f));
            float w8[8], k8[8], b8[8];
#pragma unroll
            for (int j = 0; j < 8; ++j) { kk[j] *= inv; k8[j] = k[j] * (1.0f + (av[j] - 1.0f) * kaw[j]); b8[j] = kk[j] * av[j]; w8[j] = __expf(ld[j]); bp += r[j] * k8[j] * rkw[j]; }
            bp = red8(bp);
            if (cg == 0) sBon[tt] = bp;
            LAS float* d;
            d = sR + tt * 64 + 8 * cg; *(LAS f32x4*)d = (f32x4){r[0], r[1], r[2], r[3]}; *(LAS f32x4*)(d + 4) = (f32x4){r[4], r[5], r[6], r[7]};
            d = sW + tt * 64 + 8 * cg; *(LAS f32x4*)d = (f32x4){w8[0], w8[1], w8[2], w8[3]}; *(LAS f32x4*)(d + 4) = (f32x4){w8[4], w8[5], w8[6], w8[7]};
            d = sK + tt * 64 + 8 * cg; *(LAS f32x4*)d = (f32x4){k8[0], k8[1], k8[2], k8[3]}; *(LAS f32x4*)(d + 4) = (f32x4){k8[4], k8[5], k8[6], k8[7]};
            d = sKK + tt * 64 + 8 * cg; *(LAS f32x4*)d = (f32x4){kk[0], kk[1], kk[2], kk[3]}; *(LAS f32x4*)(d + 4) = (f32x4){kk[4], kk[5], kk[6], kk[7]};
            d = sB + tt * 64 + 8 * cg; *(LAS f32x4*)d = (f32x4){b8[0], b8[1], b8[2], b8[3]}; *(LAS f32x4*)(d + 4) = (f32x4){b8[4], b8[5], b8[6], b8[7]};
            d = sV + tt * 64 + 8 * cg; *(LAS f32x4*)d = (f32x4){v[0], v[1], v[2], v[3]}; *(LAS f32x4*)(d + 4) = (f32x4){v[4], v[5], v[6], v[7]};
        }
        __syncthreads();
        {
#define RWF_LD(arr, s_) const f32x4 arr##a = *(const LAS f32x4*)(arr + (s_) * 64 + 8 * jq), arr##b = *(const LAS f32x4*)(arr + (s_) * 64 + 8 * jq + 4)
            f32x4 w_a = *(const LAS f32x4*)(sW + 8 * jq), w_b = *(const LAS f32x4*)(sW + 8 * jq + 4), kk_a = *(const LAS f32x4*)(sKK + 8 * jq), kk_b = *(const LAS f32x4*)(sKK + 8 * jq + 4),
                  b_a = *(const LAS f32x4*)(sB + 8 * jq), b_b = *(const LAS f32x4*)(sB + 8 * jq + 4), k_a = *(const LAS f32x4*)(sK + 8 * jq), k_b = *(const LAS f32x4*)(sK + 8 * jq + 4),
                  r_a = *(const LAS f32x4*)(sR + 8 * jq), r_b = *(const LAS f32x4*)(sR + 8 * jq + 4);
            float vi = sV[row];
            f32x2 pyp = (f32x2){0.f, 0.f}; float ykeep = 0.f;
#pragma unroll 1
            for (int s8 = 0; s8 < 64; s8 += 8) {
#pragma unroll
                for (int u = 0; u < 8; ++u) {
                    const int sn = (s8 + u + 1) & 63;
                    RWF_LD(sW, sn); RWF_LD(sKK, sn); RWF_LD(sB, sn); RWF_LD(sK, sn); RWF_LD(sR, sn);
                    const float nvi = sV[sn * 64 + row];
                    f32x2 pa = st0 * (f32x2){kk_a.x, kk_a.y}; pa = pfma(st1, (f32x2){kk_a.z, kk_a.w}, pa); pa = pfma(st2, (f32x2){kk_b.x, kk_b.y}, pa); pa = pfma(st3, (f32x2){kk_b.z, kk_b.w}, pa);
                    float av = pa.x + pa.y, yv = pyp.x + pyp.y;
                    av += dpp<XOR1>(av); yv += dpp<XOR1>(yv); av += dpp<XOR2>(av); yv += dpp<XOR2>(yv); av += dpp<XOR7>(av); yv += dpp<XOR7>(yv);
                    if (u > 0) ykeep = (jq == u - 1) ? yv : ykeep;
                    else if (s8 > 0) { ykeep = (jq == 7) ? yv : ykeep; sO[(s8 - 8 + jq) * 64 + row] = ykeep; }
                    const float sa = -av;
                    const f32x2 sa2 = (f32x2){sa, sa}, vi2 = (f32x2){vi, vi};
                    st0 = pfma(st0, (f32x2){w_a.x, w_a.y}, pfma(vi2, (f32x2){k_a.x, k_a.y}, sa2 * (f32x2){b_a.x, b_a.y}));
                    st1 = pfma(st1, (f32x2){w_a.z, w_a.w}, pfma(vi2, (f32x2){k_a.z, k_a.w}, sa2 * (f32x2){b_a.z, b_a.w}));
                    st2 = pfma(st2, (f32x2){w_b.x, w_b.y}, pfma(vi2, (f32x2){k_b.x, k_b.y}, sa2 * (f32x2){b_b.x, b_b.y}));
                    st3 = pfma(st3, (f32x2){w_b.z, w_b.w}, pfma(vi2, (f32x2){k_b.z, k_b.w}, sa2 * (f32x2){b_b.z, b_b.w}));
                    pyp = st0 * (f32x2){r_a.x, r_a.y}; pyp = pfma(st1, (f32x2){r_a.z, r_a.w}, pyp); pyp = pfma(st2, (f32x2){r_b.x, r_b.y}, pyp); pyp = pfma(st3, (f32x2){r_b.z, r_b.w}, pyp);
                    w_a = sWa; w_b = sWb; kk_a = sKKa; kk_b = sKKb; b_a = sBa; b_b = sBb; k_a = sKa; k_b = sKb; r_a = sRa; r_b = sRb; vi = nvi;
                }
            }
            const float yv = red8(pyp.x + pyp.y);
            ykeep = (jq == 7) ? yv : ykeep; sO[(56 + jq) * 64 + row] = ykeep;
#undef RWF_LD
        }
        __syncthreads();
        {
            const size_t t = (size_t)b * SEQ + ch * 64 + tt;
            const f32x4 o0 = *(const LAS f32x4*)(sO + tt * 64 + 8 * cg), o1 = *(const LAS f32x4*)(sO + tt * 64 + 8 * cg + 4);
            const f32x4 v0 = *(const LAS f32x4*)(sV + tt * 64 + 8 * cg), v1 = *(const LAS f32x4*)(sV + tt * 64 + 8 * cg + 4);
            float o[8] = {o0.x, o0.y, o0.z, o0.w, o1.x, o1.y, o1.z, o1.w}; const float vv[8] = {v0.x, v0.y, v0.z, v0.w, v1.x, v1.y, v1.z, v1.w};
            float sm = 0.f;
#pragma unroll
            for (int j = 0; j < 8; ++j) sm += o[j];
            const float mean = red8(sm) * (1.0f / 64.0f);
            float q = 0.f;
#pragma unroll
            for (int j = 0; j < 8; ++j) { o[j] -= mean; q += o[j] * o[j]; }
            const float rstd = __builtin_amdgcn_rsqf(red8(q) * (1.0f / 64.0f) + 64e-5f);
            const float bon = sBon[tt];
            float y[8];
#pragma unroll
            for (int j = 0; j < 8; ++j) y[j] = (o[j] * rstd * lnw[j] + lnb[j] + bon * vv[j]) * gate[j];
            *(u32x4*)(Y + t * D + c0) = pack8(y);
        }
    }
#undef RWF_ISSUE
}

__device__ __forceinline__ void hgrn_full(ArgsRef a, int l, LAS unsigned char* lds, int job, int tid) {
    const bf16_t* P = (const bf16_t*)(a.ws + WS_PROJ); bf16_t* Y = (bf16_t*)(a.ws + WS_YC);
    LAS float* sQ = (LAS float*)lds; LAS float* sF = sQ + 4096; LAS float* sV = sF + 4096; LAS float* sO = sV + 4096;
    const int wave = tid >> 6, lane = tid & 63, tt = tid >> 3, cg = tid & 7;
    const float* lbp = (const float*)a.in[32];
    const int b = job >> 3, h = job & 7, c0 = 64 * h + 8 * cg;
    float lb[8], gn[8];
#pragma unroll
    for (int j = 0; j < 8; ++j) { lb[j] = (l == 0) ? 0.f : sigmoidf_(lbp[512 + c0 + j] - lbp[c0 + j]); gn[j] = ((const float*)a.in[33])[(size_t)l * 64 + 8 * cg + j]; }
    f32x2 st0 = (f32x2){0.f, 0.f}, st1 = st0, st2 = st0, st3 = st0;
    const int col = 8 * wave + (lane >> 3), dq = lane & 7;
    u32x4 gq, gf, gv, gg;
#define HGF_ISSUE(ch_) do { const size_t t_ = (size_t)b * SEQ + (ch_) * 64 + tt; gq = *(const u32x4*)(P + t_ * DIN + C_HG + c0); gf = *(const u32x4*)(P + t_ * DIN + C_HG + 512 + c0); \
        gv = *(const u32x4*)(P + t_ * DIN + C_HG + 1024 + c0); gg = *(const u32x4*)(P + t_ * DIN + C_HG + 1536 + c0); } while (0)
    HGF_ISSUE(0);
    for (int ch = 0; ch < SEQ / 64; ++ch) {
        __syncthreads();
        float gate[8];
        {
            float q[8], f[8], v[8];
            unpack8(gq, q); unpack8(gf, f); unpack8(gv, v); unpack8(gg, gate);
            if (ch + 1 < SEQ / 64) HGF_ISSUE(ch + 1);
#pragma unroll
            for (int j = 0; j < 8; ++j) { q[j] = siluf_(q[j]) * 0.125f; f[j] = lb[j] + (1.0f - lb[j]) * sigmoidf_(f[j]); }
            LAS float* d;
            d = sQ + tt * 64 + 8 * cg; *(LAS f32x4*)d = (f32x4){q[0], q[1], q[2], q[3]}; *(LAS f32x4*)(d + 4) = (f32x4){q[4], q[5], q[6], q[7]};
            d = sF + tt * 64 + 8 * cg; *(LAS f32x4*)d = (f32x4){f[0], f[1], f[2], f[3]}; *(LAS f32x4*)(d + 4) = (f32x4){f[4], f[5], f[6], f[7]};
            d = sV + tt * 64 + 8 * cg; *(LAS f32x4*)d = (f32x4){v[0], v[1], v[2], v[3]}; *(LAS f32x4*)(d + 4) = (f32x4){v[4], v[5], v[6], v[7]};
        }
        __syncthreads();
        {
            f32x4 f_a = *(const LAS f32x4*)(sF + 8 * dq), f_b = *(const LAS f32x4*)(sF + 8 * dq + 4), q_a = *(const LAS f32x4*)(sQ + 8 * dq), q_b = *(const LAS f32x4*)(sQ + 8 * dq + 4);
            float vi = sV[col];
            float ykeep = 0.f;
#pragma unroll 1
            for (int s8 = 0; s8 < 64; s8 += 8) {
#pragma unroll
                for (int u = 0; u < 8; ++u) {
                    const int sn = (s8 + u + 1) & 63;
                    const f32x4 nf_a = *(const LAS f32x4*)(sF + sn * 64 + 8 * dq), nf_b = *(const LAS f32x4*)(sF + sn * 64 + 8 * dq + 4),
                                nq_a = *(const LAS f32x4*)(sQ + sn * 64 + 8 * dq), nq_b = *(const LAS f32x4*)(sQ + sn * 64 + 8 * dq + 4);
                    const float nvi = sV[sn * 64 + col];
                    const f32x2 vi2 = (f32x2){vi, vi};
                    st0 = pfma((f32x2){f_a.x, f_a.y}, st0 - vi2, vi2); st1 = pfma((f32x2){f_a.z, f_a.w}, st1 - vi2, vi2);
                    st2 = pfma((f32x2){f_b.x, f_b.y}, st2 - vi2, vi2); st3 = pfma((f32x2){f_b.z, f_b.w}, st3 - vi2, vi2);
                    f32x2 py = st0 * (f32x2){q_a.x, q_a.y}; py = pfma(st1, (f32x2){q_a.z, q_a.w}, py); py = pfma(st2, (f32x2){q_b.x, q_b.y}, py); py = pfma(st3, (f32x2){q_b.z, q_b.w}, py);
                    const float y = red8(py.x + py.y);
                    ykeep = (dq == u) ? y : ykeep;
                    f_a = nf_a; f_b = nf_b; q_a = nq_a; q_b = nq_b; vi = nvi;
                }
                sO[(s8 + dq) * 64 + col] = ykeep;
            }
        }
        __syncthreads();
        {
            const size_t t = (size_t)b * SEQ + ch * 64 + tt;
            const f32x4 o0 = *(const LAS f32x4*)(sO + tt * 64 + 8 * cg), o1 = *(const LAS f32x4*)(sO + tt * 64 + 8 * cg + 4);
            const float o[8] = {o0.x, o0.y, o0.z, o0.w, o1.x, o1.y, o1.z, o1.w};
            float q = 0.f;
#pragma unroll
            for (int j = 0; j < 8; ++j) q += o[j] * o[j];
            const float rs = __builtin_amdgcn_rsqf(red8(q) * (1.0f / 64.0f) + 1e-6f);
            float y[8];
#pragma unroll
            for (int j = 0; j < 8; ++j) y[j] = o[j] * rs * gn[j] * siluf_(gate[j]);
            *(u32x4*)(Y + t * D + 1536 + c0) = pack8(y);
        }
    }
#undef HGF_ISSUE
}

__device__ __forceinline__ void scan_phase(ArgsRef a, int l, LAS unsigned char* lds) {
    const int TID = opaque_tid(), BID = opaque_bid();
    for (int job = BID; job < 256; job += gridDim.x) {
        if (job < 128) rwkv_full(a, l, lds, job, TID); else hgrn_full(a, l, lds, job - 128, TID);
        __syncthreads();
    }
}

__device__ __forceinline__ void attn_phase(ArgsRef a, int l, LAS unsigned char* lds) {
    const int TID = opaque_tid(), BID = opaque_bid();
    const bf16_t* P = (const bf16_t*)(a.ws + WS_PROJ); bf16_t* Y = (bf16_t*)(a.ws + WS_YC);
    const int* pos = (const int*)a.in[1];
    const float* qn = (const float*)a.in[19] + (size_t)l * 64; const float* kn = (const float*)a.in[20] + (size_t)l * 64; const float* sinks = (const float*)a.in[21] + (size_t)l * 8;
    constexpr int KST = 144, VST = 528;
    LAS unsigned char* sK = lds; LAS unsigned char* sVt = sK + 256 * KST; LAS unsigned char* sQ = sVt + 64 * VST; LAS float* sM = (LAS float*)(sQ + 512 * KST);
    const int tid = TID, cg = tid & 7, wave = tid >> 6, lane = tid & 63;
    float kmaxg = 0.f;
    for (int j = 0; j < 64; ++j) kmaxg = fmaxf(kmaxg, fabsf(kn[j]));
    const float kbound = 8.0f * kmaxg;
    float gk[8], gq[8], invf[8];
#pragma unroll
    for (int j = 0; j < 8; ++j) { gk[j] = kn[8 * cg + j]; gq[j] = qn[8 * cg + j]; invf[j] = exp2f(-(float)j * (18.931568569324174f / 8.0f)); }
    for (int job = BID; job < 512; job += gridDim.x) {
        const int b = job >> 5, nb = (job >> 1) & 15, kvh = job & 1;
        __syncthreads();
#pragma unroll 1
        for (int r = 0; r < 4; ++r) {
            const int kj = (tid >> 3) + 64 * r, s = (nb - 1) * 128 + kj;
            float k[8], v[8];
            if (s >= 0) {
                const size_t t = (size_t)b * SEQ + s;
                unpack8(*(const u32x4*)(P + t * DIN + C_ATT + 512 + 64 * kvh + 8 * cg), k); unpack8(*(const u32x4*)(P + t * DIN + C_ATT + 640 + 64 * kvh + 8 * cg), v);
            } else {
#pragma unroll
                for (int j = 0; j < 8; ++j) { k[j] = 0.f; v[j] = 0.f; } }
            float ss = 0.f;
#pragma unroll
            for (int j = 0; j < 8; ++j) ss += k[j] * k[j];
            ss = red8(ss);
            const float rs = __builtin_amdgcn_rsqf(ss * (1.0f / 64.0f) + 1e-6f);
#pragma unroll
            for (int j = 0; j < 8; ++j) k[j] = k[j] * rs * gk[j];
            const float pf = (float)pos[b * SEQ + (s >= 0 ? s : 0)];
#pragma unroll
            for (int j = 0; j < 8; ++j) {
                const float other = dpp<XOR1>(k[j]);
                if (cg < 2) { float sn, cs; sincos_big(pf * invf[j], sn, cs); k[j] = (cg == 0) ? (k[j] * cs - other * sn) : (k[j] * cs + other * sn); }
            }
            *(LAS u32x4*)(sK + kj * KST + 16 * cg) = pack8(k);
#pragma unroll
            for (int j = 0; j < 8; j += 2) { const unsigned w = pk2(v[j], v[j + 1]);
                *(LAS unsigned short*)(sVt + (8 * cg + j) * VST + 2 * kj) = (unsigned short)(w & 0xffffu); *(LAS unsigned short*)(sVt + (8 * cg + j + 1) * VST + 2 * kj) = (unsigned short)(w >> 16); }
        }
#pragma unroll 1
        for (int r = 0; r < 8; ++r) {
            const int row = (tid >> 3) + 64 * r, g = row >> 7, qi = row & 127, hq = 4 * kvh + g;
            const size_t tq = (size_t)b * SEQ + nb * 128 + qi;
            float q[8];
            unpack8(*(const u32x4*)(P + tq * DIN + C_ATT + 64 * hq + 8 * cg), q);
            float ss = 0.f;
#pragma unroll
            for (int j = 0; j < 8; ++j) ss += q[j] * q[j];
            ss = red8(ss);
            const float rs = 0.125f * __builtin_amdgcn_rsqf(ss * (1.0f / 64.0f) + 1e-6f);
#pragma unroll
            for (int j = 0; j < 8; ++j) q[j] = q[j] * rs * gq[j];
            const float pf = (float)pos[b * SEQ + nb * 128 + qi];
            float qq = 0.f;
#pragma unroll
            for (int j = 0; j < 8; ++j) {
                const float other = dpp<XOR1>(q[j]);
                if (cg < 2) { float sn, cs; sincos_big(pf * invf[j], sn, cs); q[j] = (cg == 0) ? (q[j] * cs - other * sn) : (q[j] * cs + other * sn); }
                qq += q[j] * q[j];
            }
            qq = red8(qq);
            if (cg == 0) sM[row] = sqrtf(qq) * kbound;
            *(LAS u32x4*)(sQ + row * KST + 16 * cg) = pack8(q);
        }
        __syncthreads();
        const int g = wave >> 1, qh = wave & 1, hq = 4 * kvh + g, fr = lane & 15, fq = lane >> 4;
        const float sinkv = sinks[hq];
#pragma unroll 1
        for (int qt = 0; qt < 4; ++qt) {
            const int qi0 = 64 * qh + 16 * qt, R0 = g * 128 + qi0, kt0 = qi0 >> 4;
            const bf16x8 qf0 = *(const LAS bf16x8*)(sQ + (R0 + fr) * KST + 16 * fq), qf1 = *(const LAS bf16x8*)(sQ + (R0 + fr) * KST + 16 * fq + 64);
            const float msh = sM[R0 + fr];
            const int ql = qi0 + fr;
            f32x4 oacc[4];
#pragma unroll
            for (int dt = 0; dt < 4; ++dt) oacc[dt] = (f32x4){0.f, 0.f, 0.f, 0.f};
            float lsum = 0.f;
#pragma unroll
            for (int ks = 0; ks < 5; ++ks) {
                unsigned pw[4];
#pragma unroll
                for (int h2 = 0; h2 < 2; ++h2) {
                    const int ti = 2 * ks + h2, kt = (kt0 + ti) < 15 ? (kt0 + ti) : 15;
                    const bf16x8 kf0 = *(const LAS bf16x8*)(sK + (16 * kt + fr) * KST + 16 * fq), kf1 = *(const LAS bf16x8*)(sK + (16 * kt + fr) * KST + 16 * fq + 64);
                    f32x4 sc = (f32x4){0.f, 0.f, 0.f, 0.f};
                    sc = __builtin_amdgcn_mfma_f32_16x16x32_bf16(kf0, qf0, sc, 0, 0, 0);
                    sc = __builtin_amdgcn_mfma_f32_16x16x32_bf16(kf1, qf1, sc, 0, 0, 0);
                    float p[4];
#pragma unroll
                    for (int j = 0; j < 4; ++j) { const int kj = 16 * (kt0 + ti) + 4 * fq + j;
                        const bool valid = (kj > ql) && (kj <= ql + 128) && (nb > 0 || kj >= 128);
                        p[j] = valid ? __expf(sc[j] - msh) : 0.f; lsum += p[j]; }
                    pw[2 * h2] = pk2(p[0], p[1]); pw[2 * h2 + 1] = pk2(p[2], p[3]);
                }
                const u32x4 pq = (u32x4){pw[0], pw[1], pw[2], pw[3]};
                const bf16x8 pf = __builtin_bit_cast(bf16x8, pq);
                const int kta = (kt0 + 2 * ks) < 15 ? (kt0 + 2 * ks) : 15, ktb = (kt0 + 2 * ks + 1) < 15 ? (kt0 + 2 * ks + 1) : 15;
#pragma unroll
                for (int dt = 0; dt < 4; ++dt) {
                    const u32x2 va = *(const LAS u32x2*)(sVt + (16 * dt + fr) * VST + (16 * kta + 4 * fq) * 2), vb = *(const LAS u32x2*)(sVt + (16 * dt + fr) * VST + (16 * ktb + 4 * fq) * 2);
                    const u32x4 vq = (u32x4){va.x, va.y, vb.x, vb.y};
                    oacc[dt] = __builtin_amdgcn_mfma_f32_16x16x32_bf16(__builtin_bit_cast(bf16x8, vq), pf, oacc[dt], 0, 0, 0);
                }
            }
            lsum += __shfl_xor(lsum, 16); lsum += __shfl_xor(lsum, 32);
            const float inv = __builtin_amdgcn_rcpf(lsum + __expf(sinkv - msh));
            const size_t tq = (size_t)b * SEQ + nb * 128 + ql;
#pragma unroll
            for (int dt = 0; dt < 4; ++dt) { u32x2 w; w.x = pk2(oacc[dt][0] * inv, oacc[dt][1] * inv); w.y = pk2(oacc[dt][2] * inv, oacc[dt][3] * inv);
                *(u32x2*)(Y + tq * D + 512 + 64 * hq + 16 * dt + 4 * fq) = w; }
        }
    }
    __syncthreads();
}

__device__ __forceinline__ float gelu_erf(float v) {
    const float t = __builtin_amdgcn_rcpf(fabsf(v) * 0.2316418882f + 1.0f);
    float q = t * 0.5307027145f + (-0.7265760135f); q = q * t + 0.7107068705f; q = q * t + (-0.142248368f); q = q * t + 0.127414796f; q = q * t;
    const float e = __builtin_amdgcn_exp2f(v * v * (-0.72134752044f));
    const float m = v * (q * e);
    return v < 0.f ? m : v - m;
}
__device__ __forceinline__ void s5_phase(ArgsRef a, int l, LAS unsigned char* lds) {
    const int TID = opaque_tid(), BID = opaque_bid();
    const bf16_t* P = (const bf16_t*)(a.ws + WS_PROJ); bf16_t* Z = (bf16_t*)(a.ws + WS_Z);
    const int tid = TID, wave = tid >> 6, lane = tid & 63, fr16 = lane & 15, fq = lane >> 4;
    LAS float* sX = (LAS float*)lds + wave * (16 * 130);
    LAS float* sE = (LAS float*)lds + 8 * 16 * 130;
    for (int job = BID; job < 512; job += gridDim.x) {
        const int b = job >> 5, g = job & 31;
        const float dt = expf(((const float*)a.in[24])[l * 32 + g]);
        float lbr, lbi;
        { const float lre = ((const float*)a.in[22])[(size_t)l * 2048 + g * 64 + lane], lim = ((const float*)a.in[23])[(size_t)l * 2048 + g * 64 + lane];
          float sn, cs; sincos_big(lim * dt, sn, cs); const float er = expf(lre * dt); lbr = er * cs; lbi = er * sn; }
        bf16x8 bfrag[8];
#pragma unroll
        for (int k = 0; k < 4; ++k) {
            const int p = fr16 + 16 * k;
            const float lre = ((const float*)a.in[22])[(size_t)l * 2048 + g * 64 + p], lim = ((const float*)a.in[23])[(size_t)l * 2048 + g * 64 + p];
            float sn, cs; sincos_big(lim * dt, sn, cs); const float er = expf(lre * dt), pbr = er * cs, pbi = er * sn;
            const float den = __builtin_amdgcn_rcpf(lre * lre + lim * lim);
            const float fr = ((pbr - 1.0f) * lre + pbi * lim) * den, fi = (pbi * lre - (pbr - 1.0f) * lim) * den;
            const float* brp = (const float*)a.in[25] + ((size_t)l * 2048 + g * 64 + p) * 16 + 8 * (fq & 1);
            const float* bip = (const float*)a.in[26] + ((size_t)l * 2048 + g * 64 + p) * 16 + 8 * (fq & 1);
            float vr[8], vi[8];
#pragma unroll
            for (int i = 0; i < 8; ++i) { const float br = brp[i], bi = bip[i]; float xr = fr * br - fi * bi, xi = fr * bi + fi * br;
                const unsigned hw = pk2(xr, xi);
                if (fq >= 2) { xr -= bflo(hw); xi -= bfhi(hw); }
                vr[i] = xr; vi[i] = xi; }
            bfrag[k] = __builtin_bit_cast(bf16x8, pack8(vr)); bfrag[4 + k] = __builtin_bit_cast(bf16x8, pack8(vi));
        }
        float creg[32];
        {
            const float* cre = (const float*)a.in[27] + ((size_t)l * 32 + g) * 1024 + fr16 * 64 + fq;
            const float* cim = (const float*)a.in[28] + ((size_t)l * 32 + g) * 1024 + fr16 * 64 + fq;
#pragma unroll
            for (int kk = 0; kk < 16; ++kk) { creg[kk] = cre[4 * kk]; creg[16 + kk] = -cim[4 * kk]; }
        }
        f32x4 dsk;
        { const float* dp = (const float*)a.in[29] + (size_t)l * 512 + 16 * g + 4 * fq; dsk = (f32x4){dp[0], dp[1], dp[2], dp[3]}; }
        const size_t tbase = (size_t)b * SEQ + wave * 256;
        const bf16_t* ua = P + (tbase + fr16) * DIN + C_S5 + 16 * g + 8 * (fq & 1);
        const bf16_t* ue = P + (tbase + fr16) * DIN + C_S5 + 16 * g + 4 * fq;
        f32x2 xs = (f32x2){0.f, 0.f}; const f32x2 lbr2 = (f32x2){lbr, lbr}, lbi2 = (f32x2){lbi, lbi};
        {
            u32x4 au = *(const u32x4*)ua;
#pragma unroll 1
            for (int gi = 0; gi < 16; ++gi) {
                const bf16x8 af = __builtin_bit_cast(bf16x8, au);
                if (gi + 1 < 16) au = *(const u32x4*)(ua + (size_t)(gi + 1) * 16 * DIN);
#pragma unroll
                for (int nt = 0; nt < 8; ++nt) { const f32x4 d = __builtin_amdgcn_mfma_f32_16x16x32_bf16(af, bfrag[nt], (f32x4){0.f, 0.f, 0.f, 0.f}, 0, 0, 0);
#pragma unroll
                    for (int j = 0; j < 4; ++j) sX[(4 * fq + j) * 130 + fr16 + 16 * nt] = d[j]; }
                LDS_FENCE();
#pragma unroll
                for (int s = 0; s < 16; ++s) { const f32x2 bu = (f32x2){sX[s * 130 + lane], sX[s * 130 + 64 + lane]};
                    const f32x2 nx = pfma(lbr2, xs, bu); xs = pfma(lbi2, (f32x2){-xs.y, xs.x}, nx); }
                LDS_FENCE();
            }
        }
        sE[wave * 128 + lane] = xs.x; sE[wave * 128 + 64 + lane] = xs.y;
        float pr = lbr, pi = lbi;
#pragma unroll
        for (int i = 0; i < 8; ++i) { const float nr = pr * pr - pi * pi, ni = 2.0f * pr * pi; pr = nr; pi = ni; }
        __syncthreads();
        xs = (f32x2){0.f, 0.f};
        for (int w = 0; w < wave; ++w) { const float er_ = sE[w * 128 + lane], ei_ = sE[w * 128 + 64 + lane];
            const float nr = pr * xs.x - pi * xs.y + er_, ni = pr * xs.y + pi * xs.x + ei_; xs.x = nr; xs.y = ni; }
        {
            u32x4 au = *(const u32x4*)ua; u32x2 eu = *(const u32x2*)ue;
#pragma unroll 1
            for (int gi = 0; gi < 16; ++gi) {
                const bf16x8 af = __builtin_bit_cast(bf16x8, au); const u32x2 eun = eu;
                if (gi + 1 < 16) { au = *(const u32x4*)(ua + (size_t)(gi + 1) * 16 * DIN); eu = *(const u32x2*)(ue + (size_t)(gi + 1) * 16 * DIN); }
#pragma unroll
                for (int nt = 0; nt < 8; ++nt) { const f32x4 d = __builtin_amdgcn_mfma_f32_16x16x32_bf16(af, bfrag[nt], (f32x4){0.f, 0.f, 0.f, 0.f}, 0, 0, 0);
#pragma unroll
                    for (int j = 0; j < 4; ++j) sX[(4 * fq + j) * 130 + fr16 + 16 * nt] = d[j]; }
                LDS_FENCE();
#pragma unroll
                for (int s = 0; s < 16; ++s) { const f32x2 bu = (f32x2){sX[s * 130 + lane], sX[s * 130 + 64 + lane]};
                    const f32x2 nx = pfma(lbr2, xs, bu); xs = pfma(lbi2, (f32x2){-xs.y, xs.x}, nx);
                    sX[s * 130 + lane] = xs.x; sX[s * 130 + 64 + lane] = xs.y; }
                LDS_FENCE();
                f32x4 yacc = (f32x4){0.f, 0.f, 0.f, 0.f}, yacc1 = yacc, yacc2 = yacc, yacc3 = yacc;
                const LAS float* xp = sX + fr16 * 130 + fq;
#pragma unroll
                for (int kk = 0; kk < 32; kk += 4) {
                    yacc = __builtin_amdgcn_mfma_f32_16x16x4f32(creg[kk], xp[4 * kk], yacc, 0, 0, 0);
                    yacc1 = __builtin_amdgcn_mfma_f32_16x16x4f32(creg[kk + 1], xp[4 * kk + 4], yacc1, 0, 0, 0);
                    yacc2 = __builtin_amdgcn_mfma_f32_16x16x4f32(creg[kk + 2], xp[4 * kk + 8], yacc2, 0, 0, 0);
                    yacc3 = __builtin_amdgcn_mfma_f32_16x16x4f32(creg[kk + 3], xp[4 * kk + 12], yacc3, 0, 0, 0);
                }
                yacc = (yacc + yacc1) + (yacc2 + yacc3);
                const float u0 = bflo(eun.x), u1 = bfhi(eun.x), u2 = bflo(eun.y), u3 = bfhi(eun.y);
                const float z0 = gelu_erf(yacc[0] + dsk[0] * u0), z1 = gelu_erf(yacc[1] + dsk[1] * u1), z2 = gelu_erf(yacc[2] + dsk[2] * u2), z3 = gelu_erf(yacc[3] + dsk[3] * u3);
                u32x2 w; w.x = pk2(z0, z1); w.y = pk2(z2, z3);
                *(u32x2*)(Z + (tbase + gi * 16 + fr16) * 512 + 16 * g + 4 * fq) = w;
                LDS_FENCE();
            }
        }
        __syncthreads();
    }
}

#define XB_TMO      128
#define XB_XCNT(j)  (256  + 64 * (j))
#define XB_XSUB(j)  (1280 + 64 * (j))
#define XB_XGEN(j)  (2304 + 64 * (j))
#define XB_TOP      3328
#define XB_TOPGEN   3392
#define XCD_BAR_WORDS 3456
#define XB_SPIN_CAP (1u << 18)

__device__ __forceinline__ unsigned xb_ld(unsigned* p)              { return __hip_atomic_load(p, __ATOMIC_RELAXED, __HIP_MEMORY_SCOPE_AGENT); }
__device__ __forceinline__ unsigned xb_add(unsigned* p, unsigned v) { return __hip_atomic_fetch_add(p, v, __ATOMIC_RELAXED, __HIP_MEMORY_SCOPE_AGENT); }
__device__ __forceinline__ unsigned xb_xcc_id() { return (unsigned)__builtin_amdgcn_s_getreg((3 << 11) | 20) & 0xFu; }
#define XB_SPIN(cond, bar) do { unsigned _sp = 0; while (cond) { __builtin_amdgcn_s_sleep(1); \
    if ((++_sp & 255u) == 0u) { if (xb_ld(&(bar)[XB_TMO])) break; if (_sp > XB_SPIN_CAP) { atomicAdd(&(bar)[XB_TMO], 1u); break; } } } } while (0)

struct XcdBarrier {
    unsigned* bar; unsigned x;
    volatile LAS unsigned* st;
};

__device__ __forceinline__ XcdBarrier xcd_barrier_post(unsigned* bar, volatile LAS unsigned* st) {
    XcdBarrier b; b.bar = bar; b.x = xb_xcc_id(); b.st = st;
    if (threadIdx.x == 0) (void)xb_add(&bar[XB_XCNT(b.x)], 1u);
    return b;
}
__device__ __forceinline__ void xcd_barrier_complete(unsigned* bar, unsigned x, unsigned& nloc, unsigned& nx) {
    const unsigned G = gridDim.x * gridDim.y * gridDim.z;
    unsigned sum, cnt, mine, sp = 0u;
    for (;;) {
        sum = 0u; cnt = 0u; mine = 0u;
#pragma unroll
        for (unsigned j = 0; j < 16; ++j) { const unsigned c = xb_ld(&bar[XB_XCNT(j)]); sum += c; cnt += (c > 0u) ? 1u : 0u; mine = (j == x) ? c : mine; }
        if (sum == G) break;
        __builtin_amdgcn_s_sleep(1);
        if ((++sp & 255u) == 0u) { if (xb_ld(&bar[XB_TMO])) break; if (sp > XB_SPIN_CAP) { atomicAdd(&bar[XB_TMO], 1u); break; } }
    }
    nloc = mine > 0u ? mine : 1u; nx = cnt > 0u ? cnt : 1u;
}

__device__ __forceinline__ void xcd_barrier(const XcdBarrier& b) {
    asm volatile("s_waitcnt vmcnt(0)" ::: "memory");
    __syncthreads();
    if (threadIdx.x == 0) {
        unsigned* bar = b.bar;
        __builtin_amdgcn_s_waitcnt(0);
        unsigned nloc = b.st[0], nx = b.st[1];
        if (nloc == 0u) { xcd_barrier_complete(bar, b.x, nloc, nx); b.st[0] = nloc; b.st[1] = nx; }
        const unsigned old = xb_add(&bar[XB_XSUB(b.x)], 1u);
        const unsigned gen = old / nloc;
        if (old + 1u == (gen + 1u) * nloc) {
            __builtin_amdgcn_fence(__ATOMIC_RELEASE, "agent");
            asm volatile("s_waitcnt vmcnt(0)" ::: "memory");
            const unsigned og = xb_add(&bar[XB_TOP], 1u);
            const unsigned tg = og / nx;
            if (og + 1u == (tg + 1u) * nx) xb_add(&bar[XB_TOPGEN], 1u);
            else XB_SPIN(xb_ld(&bar[XB_TOPGEN]) == tg, bar);
            __builtin_amdgcn_fence(__ATOMIC_ACQUIRE, "agent");
            xb_add(&bar[XB_XGEN(b.x)], 1u);
            asm volatile("s_waitcnt vmcnt(0)" ::: "memory");
        } else {
            XB_SPIN(xb_ld(&bar[XB_XGEN(b.x)]) == gen, bar);
            __builtin_amdgcn_fence(__ATOMIC_ACQUIRE, "agent");
            asm volatile("s_waitcnt vmcnt(0)" ::: "memory");
        }
    }
    __syncthreads();
}


constexpr int NPH = 10;
#ifndef DUPMASK
#define DUPMASK 0
#endif
__global__ void __launch_bounds__(NTHREADS, 2) mega(Args a_, int lo, int hi) {
    extern __shared__ __attribute__((aligned(16))) unsigned char lds_raw[];
    LAS unsigned char* lds = (LAS unsigned char*)lds_raw;
#ifdef EXTRA_SYNCS
    for (int i = 0; i < EXTRA_SYNCS; ++i) { __syncthreads(); cg::this_grid().sync(); }
#endif
    LAS unsigned* xst = (LAS unsigned*)(lds + LDS_BYTES - 16);
    if (hi - lo > 1) {
        if (threadIdx.x == 0) { xst[0] = 0u; xst[1] = 0u; }
        __syncthreads();
        const __attribute__((address_space(4))) Args* ap0 = (const __attribute__((address_space(4))) Args*)__builtin_amdgcn_kernarg_segment_ptr();
        (void)xcd_barrier_post((unsigned*)(ap0->ws + WS_BAR), (volatile LAS unsigned*)xst);
    }
#pragma unroll 1
    for (int step2 = 2 * lo; step2 < 2 * hi; ++step2) {
        const int step = step2 >> 1;
        if ((step2 & 1) && !((DUPMASK >> (step % NPH)) & 1)) continue;
        const __attribute__((address_space(4))) Args* ap = (const __attribute__((address_space(4))) Args*)__builtin_amdgcn_kernarg_segment_ptr();
        asm volatile("" : "+s"(ap));
        ArgsRef a = *ap;
        unsigned char* ws = a.ws;
        float* SSa = (float*)(ws + WS_SS); float* SSb = SSa + T; float* SSc = SSb + T;
        const int l = step / NPH, ph = step % NPH;
        const float* xin = (l == 0) ? (const float*)a.in[0] : (const float*)a.out;
#ifndef PHMASK
#define PHMASK 0x7ff
#endif
        switch (ph) {
        case 0: if (PHMASK & (1 << 0)) { conv_phase(a, l, lds); if (l == 0) norm_phase(xin, (bf16_t*)(ws + WS_XN), SSa); zero_phase(SSb, T); } break;
        case 1: if (PHMASK & (1 << 1)) { pg8::EpiSwiGLU E; E.H = (bf16_t*)(ws + WS_HID); E.SS = SSa; run_gemm(lds, (const bf16_t*)(ws + WS_XN), (const bf16_t*)(ws + W_UP1), 2 * FF, D, E); } break;
        case 2: if (PHMASK & (1 << 2)) { pg8::EpiResidual<true> E; E.base = xin; E.out = a.out; E.XN = (bf16_t*)(ws + WS_XN); E.SS = SSb; run_gemm(lds, (const bf16_t*)(ws + WS_HID), (const bf16_t*)(ws + W_DN1), D, FF, E); } break;
        case 3: if (PHMASK & (1 << 3)) { pg8::EpiBf16 E; E.O = (bf16_t*)(ws + WS_PROJ); E.ldc = DIN; E.SS = SSb; run_gemm(lds, (const bf16_t*)(ws + WS_XN), (const bf16_t*)(ws + W_IN), DIN, D, E); } break;
        case 4: if (PHMASK & (1 << 4)) { zero_phase(SSa, T); zero_phase(SSc, T); alr_phase(a, l); attn_phase(a, l, lds); s5_phase(a, l, lds); } break;
        case 5: if (PHMASK & (1 << 5)) { pg8::EpiLR E; E.O = (bf16_t*)(ws + WS_LRO); E.w0 = (const float*)a.in[9] + (size_t)l * 512; E.a0 = (const float*)a.in[11] + (size_t)l * 512;
                  run_gemm(lds, (const bf16_t*)(ws + WS_ALR), (const bf16_t*)(ws + W_LR), 1536, 256, E);
                  pg8::EpiGLU G; G.Z = (const bf16_t*)(ws + WS_Z); G.Y = (bf16_t*)(ws + WS_YC); G.b = (const float*)a.in[31] + (size_t)l * 512;
                  run_gemm(lds, (const bf16_t*)(ws + WS_Z), (const bf16_t*)(ws + W_GLU), 512, 512, G); } break;
        case 6: if (PHMASK & (1 << 6)) scan_phase(a, l, lds); break;
        case 7: if (PHMASK & (1 << 7)) { pg8::EpiResidual<false> E; E.base = a.out; E.out = a.out; E.XN = (bf16_t*)(ws + WS_XN); E.SS = SSc; run_gemm(lds, (const bf16_t*)(ws + WS_YC), (const bf16_t*)(ws + W_OUT), D, D, E); } break;
        case 8: if (PHMASK & (1 << 8)) { pg8::EpiSwiGLU E; E.H = (bf16_t*)(ws + WS_HID); E.SS = SSc; run_gemm(lds, (const bf16_t*)(ws + WS_XN), (const bf16_t*)(ws + W_UP2), 2 * FF, D, E); } break;
        case 9: if (PHMASK & (1 << 9)) { pg8::EpiResidual<true> E; E.base = a.out; E.out = a.out; E.XN = (l + 1 < NL) ? (bf16_t*)(ws + WS_XN) : nullptr; E.SS = SSa; run_gemm(lds, (const bf16_t*)(ws + WS_HID), (const bf16_t*)(ws + W_DN2), D, FF, E); } break;
        }
        if (step2 + 1 < 2 * hi) {
            if (step2 == 2 * lo) { __syncthreads(); cg::this_grid().sync(); }
            else { XcdBarrier xb; xb.bar = (unsigned*)(ws + WS_BAR); xb.x = xb_xcc_id(); xb.st = (volatile LAS unsigned*)xst; xcd_barrier(xb); }
        }
    }
}

extern "C" void kernel_launch(void* const* d_in, const int* in_sizes, int n_in, void* d_out, int out_size, void* d_ws, size_t ws_size, hipStream_t stream) {
    static int grid = 0;
    if (!grid) {
        int dev = 0, cus = 0, per_cu = 0;
        hipGetDevice(&dev);
        hipDeviceGetAttribute(&cus, hipDeviceAttributeMultiprocessorCount, dev);
        hipFuncSetAttribute((const void*)mega, hipFuncAttributeMaxDynamicSharedMemorySize, LDS_BYTES);
        hipOccupancyMaxActiveBlocksPerMultiprocessor(&per_cu, (const void*)mega, NTHREADS, LDS_BYTES);
        if (per_cu < 1) per_cu = 1;
        grid = cus * 1;
        if (grid != 256) fprintf(stderr, "kernel_launch: grid %d (cus %d, per_cu %d)\n", grid, cus, per_cu);
    }
    Args a{};
    for (int i = 0; i < 39; ++i) a.in[i] = d_in[i];
    a.out = (float*)d_out; a.ws = (unsigned char*)d_ws;
#if ONE_LAUNCH
    (void)hipMemsetAsync((unsigned char*)d_ws + WS_BAR, 0, 16384, stream);
    int lo = 0, hi = NL * NPH;
    void* args[] = {&a, &lo, &hi};
    hipError_t e = hipLaunchCooperativeKernel((void*)mega, dim3(grid), dim3(NTHREADS), args, LDS_BYTES, stream);
    if (e != hipSuccess) fprintf(stderr, "cooperative launch failed: %s (grid %d)\n", hipGetErrorString(e), grid);
#else
    for (int s = 0; s < NL * NPH; ++s) hipLaunchKernelGGL(mega, dim3(grid), dim3(NTHREADS), LDS_BYTES, stream, a, s, s + 1);
#endif
}
```

```cpp
#include <hip/hip_runtime.h>
#include <hip/hip_cooperative_groups.h>
#include <cstdio>
#include <cstdint>
namespace cg = cooperative_groups;

#ifndef ONE_LAUNCH
#define ONE_LAUNCH 1
#endif

#define LAS __attribute__((address_space(3)))
typedef unsigned short bf16_t;
typedef short bf16x8 __attribute__((ext_vector_type(8)));
typedef float f32x4 __attribute__((ext_vector_type(4)));
typedef float f32x2 __attribute__((ext_vector_type(2)));
typedef unsigned u32x4 __attribute__((ext_vector_type(4)));
typedef unsigned u32x2 __attribute__((ext_vector_type(2)));

constexpr int T = 32768, SEQ = 2048, NB = 16, D = 2048, FF = 5632, DIN = 5120, NL = 2;
constexpr int C_RWKV = 0, C_ATT = 1792, C_S5 = 2560, C_HG = 3072;
constexpr int NTHREADS = 512, NWAVES = 8;

constexpr size_t SZ_UP = (size_t)2 * FF * D * 2, SZ_DN = (size_t)D * FF * 2, SZ_IN = (size_t)DIN * D * 2, SZ_LR = (size_t)1536 * 256 * 2,
                 SZ_GLU = (size_t)512 * 512 * 2, SZ_OUT = (size_t)D * D * 2;
constexpr size_t W_UP1 = 0, W_DN1 = W_UP1 + SZ_UP, W_IN = W_DN1 + SZ_DN, W_LR = W_IN + SZ_IN, W_GLU = W_LR + SZ_LR, W_OUT = W_GLU + SZ_GLU,
                 W_UP2 = W_OUT + SZ_OUT, W_DN2 = W_UP2 + SZ_UP, W_END = W_DN2 + SZ_DN;
constexpr size_t WS_XN = W_END, WS_BIG = WS_XN + (size_t)T * D * 2;
constexpr size_t WS_HID = WS_BIG;
constexpr size_t WS_PROJ = WS_BIG, WS_LRO = WS_PROJ + (size_t)T * DIN * 2, WS_ALR = WS_LRO + (size_t)T * 1536 * 2, WS_Z = WS_ALR + (size_t)T * 256 * 2,
                 WS_OR = WS_Z + (size_t)T * 512 * 2, WS_OH = WS_OR + (size_t)T * 512 * 4, WS_BON = WS_OH + (size_t)T * 512 * 4, WS_YC = WS_BON + (size_t)T * 8 * 4, WS_SS = WS_YC + (size_t)T * D * 2, WS_BAR = WS_SS + (size_t)3 * T * 4, WS_END = WS_BAR + 16384;
static_assert(WS_END <= (size_t)1 << 30, "workspace");
static_assert(WS_HID + (size_t)T * FF * 2 <= (size_t)1 << 30, "workspace");

constexpr int LDS_BYTES = 147456;

struct Args { const void* in[39]; float* out; unsigned char* ws; };
typedef const __attribute__((address_space(4))) Args& ArgsRef;

typedef __bf16 bf16x2_t __attribute__((ext_vector_type(2)));
__device__ __forceinline__ unsigned pk2(float lo, float hi) { const f32x2 v = (f32x2){lo, hi}; return __builtin_bit_cast(unsigned, __builtin_convertvector(v, bf16x2_t)); }
__device__ __forceinline__ float bflo(unsigned w) { return __uint_as_float(w << 16); }
__device__ __forceinline__ float bfhi(unsigned w) { return __uint_as_float(w & 0xffff0000u); }
__device__ __forceinline__ void unpack8(u32x4 q, float* f) { f[0] = bflo(q.x); f[1] = bfhi(q.x); f[2] = bflo(q.y); f[3] = bfhi(q.y); f[4] = bflo(q.z); f[5] = bfhi(q.z); f[6] = bflo(q.w); f[7] = bfhi(q.w); }
__device__ __forceinline__ u32x4 pack8(const float* f) { u32x4 o; o.x = pk2(f[0], f[1]); o.y = pk2(f[2], f[3]); o.z = pk2(f[4], f[5]); o.w = pk2(f[6], f[7]); return o; }
template <int CTRL> __device__ __forceinline__ float dpp(float x) { return __builtin_bit_cast(float, __builtin_amdgcn_mov_dpp(__builtin_bit_cast(int, x), CTRL, 0xf, 0xf, true)); }
constexpr int XOR1 = 0xB1, XOR2 = 0x4E, XOR7 = 0x141, XOR8 = 0x128;
__device__ __forceinline__ float red8(float v) { v += dpp<XOR1>(v); v += dpp<XOR2>(v); v += dpp<XOR7>(v); return v; }
__device__ __forceinline__ float red16(float v) { v = red8(v); v += dpp<XOR8>(v); return v; }
__device__ __forceinline__ float wave_sum(float v) {
#pragma unroll
    for (int o = 1; o < 64; o <<= 1) v += __shfl_xor(v, o);
    return v;
}
__device__ __forceinline__ float sigmoidf_(float x) { return __builtin_amdgcn_rcpf(1.0f + __expf(-x)); }
__device__ __forceinline__ float siluf_(float x) { return x * __builtin_amdgcn_rcpf(1.0f + __expf(-x)); }
__device__ __forceinline__ int opaque_tid() { int t = threadIdx.x; asm volatile("" : "+v"(t)); return t; }
__device__ __forceinline__ int opaque_bid() { int t = blockIdx.x; asm volatile("" : "+s"(t)); return t; }
__device__ __forceinline__ f32x2 pfma(f32x2 a, f32x2 b, f32x2 c) { return __builtin_elementwise_fma(a, b, c); }
#define LDS_FENCE() asm volatile("s_waitcnt lgkmcnt(0)" ::: "memory")
__device__ __forceinline__ void sincos_big(float x, float& sn, float& cs) {
    const float n = rintf(x * 0.15915494309189535f);
    float r = fmaf(-n, 6.28318548202514648f, x); r = fmaf(-n, -1.7484555e-7f, r);
    sn = __sinf(r); cs = __cosf(r);
}

namespace pg8 {
constexpr int BM = 256, BK = 64, HALF = 128, HTB = HALF * BK * 2, STAGE_BYTES = 8 * HTB, NXCD = 8, WGM = 8;
__host__ __device__ __forceinline__ int lds_byte(int r, int c) { const int st = (r >> 4) * 2 + (c >> 5), rr = r & 15, cc = c & 31, ob = rr * 64 + cc * 2; return st * 1024 + (ob ^ (((ob >> 9) & 1) << 5)); }
__host__ __device__ __forceinline__ void stage_rc(int b, int& R, int& C) { const int st = b / 1024, sb = b % 1024, swz = sb ^ (((sb >> 9) & 1) << 5); R = (st >> 1) * 16 + swz / 64; C = (st & 1) * 32 + (swz % 64) / 2; }
__host__ __device__ __forceinline__ int perm32(int rho) { const int n = rho >> 4, i = rho & 15; return 8 * (i >> 2) + 4 * n + (i & 3); }
struct Unit { int pm, pn; };
struct Gemm { const bf16_t* A; const bf16_t* Bt; int M, N, K; };
struct StaticOrder {
    int nM, nN, nwg, G, c;
    __device__ void init(int M, int N, int G_, int c_) { nM = M / BM; nN = N / BM; nwg = nM * nN; G = G_; c = c_; }
    __device__ bool next(int i, Unit& u) const {
        const long L = (long)i * G + c; if (L >= nwg) return false;
        int wgid = (int)L; { const int q = nwg / NXCD, r = nwg % NXCD, xcd = wgid % NXCD, off = wgid / NXCD; wgid = (xcd < r ? xcd * (q + 1) : r * (q + 1) + (xcd - r) * q) + off; }
        const int nig = WGM * nN, gid = wgid / nig, fm = gid * WGM, gsz = (nM - fm) < WGM ? (nM - fm) : WGM;
        u.pm = fm + ((wgid % nig) % gsz); u.pn = (wgid % nig) / gsz; return true;
    }
};
template <class Epi>
__device__ __forceinline__ void gemm_phase(LAS unsigned char* lds, const Gemm g, const StaticOrder S, const Epi E) {
    const int TID = opaque_tid(), BID = opaque_bid(); (void)TID; (void)BID;
    const int tid = TID, wid = __builtin_amdgcn_readfirstlane(tid >> 6), lane = tid & 63, wr = wid >> 2, wc = wid & 3, fr = lane & 15, fq = lane >> 4;
    const int K = g.K, nt = K / BK;
    unsigned voffA[2], voffB[2];
#pragma unroll
    for (int i = 0; i < 2; ++i) { int R, C; stage_rc(tid * 16 + i * 8192, R, C); const int Rb = Epi::PERM ? ((R & ~31) + perm32(R & 31)) : R;
        voffA[i] = (unsigned)(R * K + C) * 2u; voffB[i] = (unsigned)(Rb * K + C) * 2u; }
    const size_t kstep = (size_t)(BK * 2);
    const size_t hstep = (size_t)HALF * K * 2;
    const size_t tstep = 2 * hstep;
    const unsigned ldsw = (unsigned)wid * 1024u;
    const int aoff = lds_byte(wr * 64 + fr, fq * 8), boff = lds_byte(wc * 32 + fr, fq * 8);
#define PG8_SA(b, h) (((b) * 2 + (h)) * HTB)
#define PG8_SB(b, h) ((4 + (b) * 2 + (h)) * HTB)
#define PG8_STAGE(bufoff, gbase, voff) do { _Pragma("unroll") for (int _i = 0; _i < 2; ++_i) \
        __builtin_amdgcn_global_load_lds((const unsigned*)((const char*)(gbase) + (voff)[_i]), (LAS unsigned*)(lds + (bufoff) + ldsw + _i * 8192), 16, 0, 0); } while (0)
#define PG8_LDA(dst, b, h) do { _Pragma("unroll") for (int m = 0; m < 4; ++m) _Pragma("unroll") for (int k = 0; k < 2; ++k) dst[m][k] = *(const LAS bf16x8*)(lds + PG8_SA(b, h) + aoff + m * 2048 + k * 1024); } while (0)
#define PG8_LDB(dst, b, h) do { _Pragma("unroll") for (int n = 0; n < 2; ++n) _Pragma("unroll") for (int k = 0; k < 2; ++k) dst[n][k] = *(const LAS bf16x8*)(lds + PG8_SB(b, h) + boff + n * 2048 + k * 1024); } while (0)
#define PG8_MMA(ai, bj, At, Bt) do { __builtin_amdgcn_s_setprio(1); _Pragma("unroll") for (int m = 0; m < 4; ++m) _Pragma("unroll") for (int n = 0; n < 2; ++n) _Pragma("unroll") for (int k = 0; k < 2; ++k) \
        acc[ai][bj][m][n] = __builtin_amdgcn_mfma_f32_16x16x32_bf16(Bt[n][k], At[m][k], acc[ai][bj][m][n], 0, 0, 0); __builtin_amdgcn_s_setprio(0); } while (0)
#define PG8_WAIT_V(n) asm volatile("s_waitcnt vmcnt(" #n ")" ::: "memory")
#define PG8_WAIT_L(n) asm volatile("s_waitcnt lgkmcnt(" #n ")" ::: "memory")
#define PG8_BAR __builtin_amdgcn_s_barrier()
#define PG8_SCHED __builtin_amdgcn_sched_barrier(0)
    Unit cur, nxt; int ui = 0;
    if (!S.next(0, cur)) return;
    f32x4 acc[2][2][4][2];
#pragma unroll
    for (int a = 0; a < 2; ++a)
#pragma unroll
        for (int b = 0; b < 2; ++b)
#pragma unroll
            for (int m = 0; m < 4; ++m)
#pragma unroll
                for (int n = 0; n < 2; ++n) acc[a][b][m][n] = (f32x4){0.f, 0.f, 0.f, 0.f};
    bf16x8 At[4][2], B0[2][2], B1[2][2];
    const char* cA = (const char*)g.A + (size_t)cur.pm * tstep; const char* cB = (const char*)g.Bt + (size_t)cur.pn * tstep;
    PG8_STAGE(PG8_SB(0, 0), cB, voffB); PG8_STAGE(PG8_SA(0, 0), cA, voffA); PG8_STAGE(PG8_SB(0, 1), cB + hstep, voffB); PG8_STAGE(PG8_SA(0, 1), cA + hstep, voffA);
    if (wr == 1) PG8_BAR;
    PG8_WAIT_V(4); PG8_BAR;
    PG8_STAGE(PG8_SB(1, 0), cB + kstep, voffB); PG8_STAGE(PG8_SA(1, 0), cA + kstep, voffA); PG8_STAGE(PG8_SB(1, 1), cB + hstep + kstep, voffB);
    PG8_WAIT_V(6); PG8_BAR;
    for (;;) {
        const bool has_next = S.next(ui + 1, nxt);
        const char* nA = has_next ? (const char*)g.A + (size_t)nxt.pm * tstep : cA; const char* nB = has_next ? (const char*)g.Bt + (size_t)nxt.pn * tstep : cB;
#pragma unroll 1
        for (int t = 0; t < nt; t += 2) {
            const bool last = (t == nt - 2);
            const char* a1 = cA + (size_t)(t + 1) * kstep;
            const char* a2 = last ? nA : cA + (size_t)(t + 2) * kstep; const char* b2 = last ? nB : cB + (size_t)(t + 2) * kstep;
            const char* a3 = a2 + kstep; const char* b3 = b2 + kstep;
            PG8_LDB(B0, 0, 0); PG8_SCHED; PG8_LDA(At, 0, 0); PG8_STAGE(PG8_SA(1, 1), a1 + hstep, voffA);
            PG8_WAIT_L(8); PG8_BAR; PG8_WAIT_L(0); PG8_MMA(0, 0, At, B0); PG8_BAR; PG8_SCHED;
            PG8_LDB(B1, 0, 1); PG8_STAGE(PG8_SB(0, 0), b2, voffB);
            PG8_BAR; PG8_WAIT_L(0); PG8_MMA(0, 1, At, B1); PG8_BAR;
            PG8_LDA(At, 0, 1); PG8_STAGE(PG8_SA(0, 0), a2, voffA);
            PG8_BAR; PG8_WAIT_L(0); PG8_MMA(1, 0, At, B0); PG8_BAR; PG8_SCHED;
            PG8_STAGE(PG8_SB(0, 1), b2 + hstep, voffB);
            PG8_WAIT_V(6); PG8_BAR; PG8_MMA(1, 1, At, B1); PG8_BAR;
            PG8_LDB(B0, 1, 0); PG8_SCHED; PG8_LDA(At, 1, 0); PG8_STAGE(PG8_SA(0, 1), a2 + hstep, voffA);
            PG8_WAIT_L(8); PG8_BAR; PG8_WAIT_L(0); PG8_MMA(0, 0, At, B0); PG8_BAR; PG8_SCHED;
            PG8_LDB(B1, 1, 1); PG8_STAGE(PG8_SB(1, 0), b3, voffB);
            PG8_BAR; PG8_WAIT_L(0); PG8_MMA(0, 1, At, B1); PG8_BAR;
            PG8_LDA(At, 1, 1); PG8_STAGE(PG8_SA(1, 0), a3, voffA);
            PG8_BAR; PG8_WAIT_L(0); PG8_MMA(1, 0, At, B0); PG8_BAR; PG8_SCHED;
            PG8_STAGE(PG8_SB(1, 1), b3 + hstep, voffB);
            PG8_WAIT_V(6); PG8_BAR; PG8_MMA(1, 1, At, B1); PG8_BAR;
        }
        E(acc, cur, wr, wc, fr, fq);
        if (!has_next) break;
#pragma unroll
        for (int a = 0; a < 2; ++a)
#pragma unroll
            for (int b = 0; b < 2; ++b)
#pragma unroll
                for (int m = 0; m < 4; ++m)
#pragma unroll
                    for (int n = 0; n < 2; ++n) acc[a][b][m][n] = (f32x4){0.f, 0.f, 0.f, 0.f};
        cur = nxt; cA = nA; cB = nB; ++ui;
    }
    PG8_WAIT_V(0);
    if (wr == 0) PG8_BAR;
    PG8_BAR;
#undef PG8_SA
#undef PG8_SB
#undef PG8_STAGE
#undef PG8_LDA
#undef PG8_LDB
#undef PG8_MMA
#undef PG8_WAIT_V
#undef PG8_WAIT_L
#undef PG8_BAR
#undef PG8_SCHED
}

struct EpiSwiGLU {
    static constexpr bool PERM = true;
    bf16_t* H; const float* SS;
    __device__ __forceinline__ void operator()(const f32x4 (&acc)[2][2][4][2], const Unit& u, int wr, int wc, int fr, int fq) const {
        const int row0 = u.pm * BM + wr * 64 + fr, col0 = u.pn * 128 + wc * 32 + 8 * fq;
#pragma unroll
        for (int ai = 0; ai < 2; ++ai)
#pragma unroll
            for (int m = 0; m < 4; ++m) {
                const float rs = __builtin_amdgcn_rsqf(SS[row0 + ai * HALF + m * 16] * (1.0f / D) + 1e-6f);
                float v[8];
#pragma unroll
                for (int n = 0; n < 2; ++n)
#pragma unroll
                    for (int j = 0; j < 4; ++j) { const float gt = acc[ai][0][m][n][j] * rs, up = acc[ai][1][m][n][j] * rs; v[4 * n + j] = siluf_(gt) * up; }
                *(u32x4*)(H + (size_t)(row0 + ai * HALF + m * 16) * FF + col0) = pack8(v);
            }
    }
};
template <bool HALFSTEP> struct EpiResidual {
    static constexpr bool PERM = false;
    static constexpr float scale = HALFSTEP ? 0.5f : 1.0f;
    const float* base; float* out; bf16_t* XN; float* SS;
    __device__ __forceinline__ void operator()(const f32x4 (&acc)[2][2][4][2], const Unit& u, int wr, int wc, int fr, int fq) const {
        const int row0 = u.pm * BM + wr * 64 + fr, col0 = u.pn * BM + wc * 32 + 4 * fq;
#pragma unroll
        for (int ai = 0; ai < 2; ++ai)
#pragma unroll
            for (int m = 0; m < 4; ++m) { const int row = row0 + ai * HALF + m * 16; const size_t ro = (size_t)row * D + col0; float ss = 0.f;
#pragma unroll
                for (int bj = 0; bj < 2; ++bj)
#pragma unroll
                    for (int n = 0; n < 2; ++n) { const f32x4 b = *(const f32x4*)(base + ro + bj * HALF + n * 16); const f32x4 r = b + acc[ai][bj][m][n] * scale; *(f32x4*)(out + ro + bj * HALF + n * 16) = r;
                        if (XN) { u32x2 w; w.x = pk2(r.x, r.y); w.y = pk2(r.z, r.w); *(u32x2*)(XN + ro + bj * HALF + n * 16) = w; ss += (r.x * r.x + r.y * r.y) + (r.z * r.z + r.w * r.w); } }
                if (XN) { ss += __shfl_xor(ss, 16); ss += __shfl_xor(ss, 32); if (fq == 0) atomicAdd(SS + row, ss); } }
    }
};
struct EpiBf16 {
    static constexpr bool PERM = true;
    bf16_t* O; int ldc; const float* SS;
    __device__ __forceinline__ void operator()(const f32x4 (&acc)[2][2][4][2], const Unit& u, int wr, int wc, int fr, int fq) const {
        const int row0 = u.pm * BM + wr * 64 + fr, col0 = u.pn * BM + wc * 32 + 8 * fq;
#pragma unroll
        for (int ai = 0; ai < 2; ++ai)
#pragma unroll
            for (int m = 0; m < 4; ++m) { bf16_t* rowp = O + (size_t)(row0 + ai * HALF + m * 16) * ldc + col0;
                const float rs = __builtin_amdgcn_rsqf(SS[row0 + ai * HALF + m * 16] * (1.0f / D) + 1e-6f);
#pragma unroll
                for (int bj = 0; bj < 2; ++bj) { const f32x4 v0 = acc[ai][bj][m][0] * rs, v1 = acc[ai][bj][m][1] * rs;
                    u32x4 w; w.x = pk2(v0[0], v0[1]); w.y = pk2(v0[2], v0[3]); w.z = pk2(v1[0], v1[1]); w.w = pk2(v1[2], v1[3]);
                    *(u32x4*)(rowp + bj * HALF) = w; } }
    }
};
struct EpiLR {
    static constexpr bool PERM = true;
    bf16_t* O; const float* w0; const float* a0;
    template <int KIND> __device__ __forceinline__ void body(const f32x4 (&acc)[2][2][4][2], const float* bp, int row0, int col0) const {
#pragma unroll
        for (int bj = 0; bj < 2; ++bj) {
            f32x4 b0 = (f32x4){0.f, 0.f, 0.f, 0.f}, b1 = b0;
            if (KIND < 2) { b0 = *(const f32x4*)(bp + bj * HALF); b1 = *(const f32x4*)(bp + bj * HALF + 4); }
#pragma unroll
            for (int ai = 0; ai < 2; ++ai)
#pragma unroll
                for (int m = 0; m < 4; ++m) {
                    u32x4 w;
#pragma unroll
                    for (int n = 0; n < 2; ++n) {
                        float r[4];
#pragma unroll
                        for (int j = 0; j < 4; ++j) { const float x = acc[ai][bj][m][n][j] + (n == 0 ? b0[j] : b1[j]);
                            if (KIND == 0) { const float e = __expf(-x); r[j] = -0.60653065971f * __builtin_amdgcn_rcpf(1.0f + e); }
                            else if (KIND == 1) r[j] = __builtin_amdgcn_rcpf(1.0f + __expf(-x)); else r[j] = x; }
                        if (n == 0) { w.x = pk2(r[0], r[1]); w.y = pk2(r[2], r[3]); } else { w.z = pk2(r[0], r[1]); w.w = pk2(r[2], r[3]); }
                    }
                    *(u32x4*)(O + (size_t)(row0 + ai * HALF + m * 16) * 1536 + col0 + bj * HALF) = w;
                }
        }
    }
    __device__ __forceinline__ void operator()(const f32x4 (&acc)[2][2][4][2], const Unit& u, int wr, int wc, int fr, int fq) const {
        const int row0 = u.pm * BM + wr * 64 + fr, col0 = u.pn * BM + wc * 32 + 8 * fq, kind = u.pn >> 1, f0 = col0 - 512 * kind;
        if (kind == 0) body<0>(acc, w0 + f0, row0, col0); else if (kind == 1) body<1>(acc, a0 + f0, row0, col0); else body<2>(acc, nullptr, row0, col0);
    }
};
struct EpiGLU {
    static constexpr bool PERM = true;
    const bf16_t* Z; bf16_t* Y; const float* b;
    __device__ __forceinline__ void operator()(const f32x4 (&acc)[2][2][4][2], const Unit& u, int wr, int wc, int fr, int fq) const {
        const int row0 = u.pm * BM + wr * 64 + fr, col0 = u.pn * BM + wc * 32 + 8 * fq;
#pragma unroll
        for (int bj = 0; bj < 2; ++bj) {
            const f32x4 bias0 = *(const f32x4*)(b + col0 + bj * HALF), bias1 = *(const f32x4*)(b + col0 + bj * HALF + 4);
#pragma unroll
            for (int ai = 0; ai < 2; ++ai)
#pragma unroll
                for (int m = 0; m < 4; ++m) { const size_t r = (size_t)(row0 + ai * HALF + m * 16);
                    float z[8], v[8]; unpack8(*(const u32x4*)(Z + r * 512 + col0 + bj * HALF), z);
#pragma unroll
                    for (int n = 0; n < 2; ++n)
#pragma unroll
                        for (int j = 0; j < 4; ++j) v[4 * n + j] = z[4 * n + j] * sigmoidf_(acc[ai][bj][m][n][j] + (n == 0 ? bias0[j] : bias1[j]));
                    *(u32x4*)(Y + r * D + 1024 + col0 + bj * HALF) = pack8(v); }
        }
    }
};
}

template <class Epi> __device__ __forceinline__ void run_gemm(LAS unsigned char* lds, const bf16_t* A, const bf16_t* Bt, int N, int K, const Epi E) {
    pg8::Gemm g; g.A = A; g.Bt = Bt; g.M = T; g.N = N; g.K = K;
    pg8::StaticOrder S; S.init(T, N, gridDim.x, opaque_bid());
    pg8::gemm_phase<Epi>(lds, g, S, E);
}

__device__ __forceinline__ void tr_item(const float* W, int ldw, int k0, int n0, const float* gs, bf16_t* Dst, int ldd, int drow0, int dk0, LAS float* scr, int lane) {
    if (W) {
        f32x4 v[8];
#pragma unroll
        for (int i = 0; i < 8; ++i) { const int kk = 8 * i + (lane >> 3); v[i] = *(const f32x4*)(W + (size_t)(k0 + kk) * ldw + n0 + 4 * (lane & 7)); }
#pragma unroll
        for (int i = 0; i < 8; ++i) { const int kk = 8 * i + (lane >> 3); f32x4 x = v[i]; if (gs) x = x * gs[k0 + kk];
            LAS float* d = scr + kk * 33 + 4 * (lane & 7); d[0] = x.x; d[1] = x.y; d[2] = x.z; d[3] = x.w; }
    } else {
#pragma unroll 8
        for (int i = 0; i < 32; ++i) { const int kk = 2 * i + (lane >> 5); scr[kk * 33 + (lane & 31)] = 0.f; }
    }
    LDS_FENCE();
    const int c = lane & 7;
#pragma unroll
    for (int j = 0; j < 4; ++j) { const int n = (lane >> 3) + 8 * j; const LAS float* s = scr + (8 * c) * 33 + n;
        u32x4 o; o.x = pk2(s[0 * 33], s[1 * 33]); o.y = pk2(s[2 * 33], s[3 * 33]); o.z = pk2(s[4 * 33], s[5 * 33]); o.w = pk2(s[6 * 33], s[7 * 33]);
        *(u32x4*)(Dst + (size_t)(drow0 + n) * ldd + dk0 + k0 - 0 + 8 * c - 0) = o; }
    LDS_FENCE();
}

__device__ __forceinline__ void conv_phase(ArgsRef a, int l, LAS unsigned char* lds) {
    const int TID = opaque_tid(), BID = opaque_bid(); (void)TID; (void)BID;
    const int wave = TID >> 6, lane = TID & 63;
    LAS float* scr = (LAS float*)(lds + wave * 8704);
    const int gw = BID * NWAVES + wave, NGW = gridDim.x * NWAVES;
    unsigned char* ws = a.ws;
    constexpr int I_GU = (D / 64) * (FF / 32), I_DN = (FF / 64) * (D / 32), I_IN = (D / 64) * (DIN / 32), I_OUT = (D / 64) * (D / 32), I_GLU = 8 * 16, I_LR = 48 * 4;
    constexpr int NITEMS = 6 * I_GU + I_IN + I_OUT + I_GLU + I_LR;
    static_assert(I_GU == I_DN, "items");
    for (int it = gw; it < NITEMS; it += NGW) {
        int r = it;
        if (r < 6 * I_GU) {
            const int which = r / I_GU; r -= which * I_GU;
            const int f = which >= 3, m = which % 3;
            if (m < 2) {
                const float* W = (const float*)a.in[(f ? 36 : 3) + m] + (size_t)l * D * FF;
                const float* gs = (const float*)a.in[f ? 35 : 2] + (size_t)l * D;
                bf16_t* dst = (bf16_t*)(ws + (f ? W_UP2 : W_UP1));
                const int nblk = FF / 32, kb = r / nblk, nb = r % nblk, n0 = 32 * nb;
                tr_item(W, FF, 64 * kb, n0, gs, dst, D, (n0 >> 7) * 256 + (n0 & 127) + 128 * m, 0, scr, lane);
            } else {
                const float* W = (const float*)a.in[f ? 38 : 5] + (size_t)l * FF * D;
                bf16_t* dst = (bf16_t*)(ws + (f ? W_DN2 : W_DN1));
                const int nblk = D / 32, kb = r / nblk, nb = r % nblk;
                tr_item(W, D, 64 * kb, 32 * nb, nullptr, dst, FF, 32 * nb, 0, scr, lane);
            }
            continue;
        }
        r -= 6 * I_GU;
        if (r < I_IN) { const int nblk = DIN / 32, kb = r / nblk, nb = r % nblk;
            tr_item((const float*)a.in[7] + (size_t)l * D * DIN, DIN, 64 * kb, 32 * nb, (const float*)a.in[6] + (size_t)l * D, (bf16_t*)(ws + W_IN), D, 32 * nb, 0, scr, lane); continue; }
        r -= I_IN;
        if (r < I_OUT) { const int nblk = D / 32, kb = r / nblk, nb = r % nblk;
            tr_item((const float*)a.in[34] + (size_t)l * D * D, D, 64 * kb, 32 * nb, nullptr, (bf16_t*)(ws + W_OUT), D, 32 * nb, 0, scr, lane); continue; }
        r -= I_OUT;
        if (r < I_GLU) { const int kb = r / 16, nb = r % 16;
            tr_item((const float*)a.in[30] + (size_t)l * 512 * 512, 512, 64 * kb, 32 * nb, nullptr, (bf16_t*)(ws + W_GLU), 512, 32 * nb, 0, scr, lane); continue; }
        r -= I_GLU;
        {
            const int nb = r >> 2, kb = r & 3, kind = nb >> 4, nn0 = 32 * (nb & 15);
            const float* W = nullptr; int k0 = 0;
            if (kind == 0 && kb == 0) { W = (const float*)a.in[10] + (size_t)l * 64 * 512; k0 = 0; }
            else if (kind == 1 && kb == 1) { W = (const float*)a.in[12] + (size_t)l * 64 * 512; k0 = 0; }
            else if (kind == 2 && kb >= 2) { W = (const float*)a.in[13] + (size_t)l * 128 * 512; k0 = 64 * (kb - 2); }
            tr_item(W, 512, k0, nn0, nullptr, (bf16_t*)(ws + W_LR), 256, 32 * nb, 64 * kb - k0, scr, lane);
        }
    }
}

__device__ __forceinline__ void norm_phase(const float* x, bf16_t* XN, float* SS) {
    const int TID = opaque_tid(), BID = opaque_bid(); (void)TID; (void)BID;
    const int wave = TID >> 6, lane = TID & 63;
    const int gw = BID * NWAVES + wave, NGW = gridDim.x * NWAVES;
    for (int m = gw; m < T; m += NGW) {
        const f32x4* xr = (const f32x4*)(x + (size_t)m * D) + lane;
        f32x4 v[8]; float s = 0.f;
#pragma unroll
        for (int j = 0; j < 8; ++j) { v[j] = xr[64 * j]; s += (v[j].x * v[j].x + v[j].y * v[j].y) + (v[j].z * v[j].z + v[j].w * v[j].w); }
        s = wave_sum(s); if (lane == 0) SS[m] = s;
        u32x2* o = (u32x2*)(XN + (size_t)m * D) + lane;
#pragma unroll
        for (int j = 0; j < 8; ++j) { u32x2 w; w.x = pk2(v[j].x, v[j].y); w.y = pk2(v[j].z, v[j].w); o[64 * j] = w; }
    }
}

__device__ __forceinline__ void zero_phase(float* p, int n) {
    const int TID = opaque_tid(), BID = opaque_bid();
    for (int i = BID * NTHREADS + TID; i < n; i += gridDim.x * NTHREADS) p[i] = 0.f;
}
__device__ __forceinline__ void alr_phase(ArgsRef a, int l) {
    const int TID = opaque_tid(), BID = opaque_bid(); (void)TID; (void)BID;
    const bf16_t* P = (const bf16_t*)(a.ws + WS_PROJ); bf16_t* ALR = (bf16_t*)(a.ws + WS_ALR);
    const float* mu = (const float*)a.in[8] + (size_t)l * 1792 + 1536;
    const int gt = BID * NTHREADS + TID, NGT = gridDim.x * NTHREADS;
    for (int it = gt; it < T * 32; it += NGT) {
        const int t = it >> 5, cg = it & 31, c0 = 8 * cg;
        float cur[8], prv[8], o[8];
        unpack8(*(const u32x4*)(P + (size_t)t * DIN + 1536 + c0), cur);
        if ((t & (SEQ - 1)) != 0) unpack8(*(const u32x4*)(P + (size_t)(t - 1) * DIN + 1536 + c0), prv);
        else {
#pragma unroll
            for (int j = 0; j < 8; ++j) prv[j] = 0.f; }
#pragma unroll
        for (int j = 0; j < 8; ++j) { const float v = cur[j] + (prv[j] - cur[j]) * mu[c0 + j];
            o[j] = c0 < 64 ? tanhf(v) : (c0 < 128 ? v : sigmoidf_(v)); }
        *(u32x4*)(ALR + (size_t)t * 256 + c0) = pack8(o);
    }
}

__device__ __forceinline__ void rwkv_full(ArgsRef a, int l, LAS unsigned char* lds, int job, int tid) {
    const bf16_t* P = (const bf16_t*)(a.ws + WS_PROJ); const bf16_t* LR = (const bf16_t*)(a.ws + WS_LRO); bf16_t* Y = (bf16_t*)(a.ws + WS_YC);
    LAS float* sR = (LAS float*)lds; LAS float* sW = sR + 4096; LAS float* sK = sW + 4096; LAS float* sKK = sK + 4096; LAS float* sB = sKK + 4096;
    LAS float* sV = sB + 4096; LAS float* sO = sV + 4096; LAS float* sBon = sO + 4096;
    const int wave = tid >> 6, lane = tid & 63, tt = tid >> 3, cg = tid & 7;
    const int b = job >> 3, h = job & 7, c0 = 64 * h + 8 * cg;
    float mur[8], muk[8], muv[8], kkw[8], kaw[8], rkw[8], lnw[8], lnb[8];
#pragma unroll
    for (int j = 0; j < 8; ++j) {
        mur[j] = ((const float*)a.in[8])[(size_t)l * 1792 + c0 + j]; muk[j] = ((const float*)a.in[8])[(size_t)l * 1792 + 512 + c0 + j]; muv[j] = ((const float*)a.in[8])[(size_t)l * 1792 + 1024 + c0 + j];
        kkw[j] = ((const float*)a.in[14])[(size_t)l * 512 + c0 + j]; kaw[j] = ((const float*)a.in[15])[(size_t)l * 512 + c0 + j]; rkw[j] = ((const float*)a.in[16])[(size_t)l * 512 + c0 + j];
        lnw[j] = ((const float*)a.in[17])[(size_t)l * 512 + c0 + j]; lnb[j] = ((const float*)a.in[18])[(size_t)l * 512 + c0 + j]; }
    f32x2 st0 = (f32x2){0.f, 0.f}, st1 = st0, st2 = st0, st3 = st0;
    const int row = 8 * wave + (lane >> 3), jq = lane & 7;
    u32x4 graw[9];
    const u32x4 zero4 = (u32x4){0u, 0u, 0u, 0u};
#define RWF_ISSUE(ch_) do { const int s_ = (ch_) * 64 + tt; const size_t t_ = (size_t)b * SEQ + s_; \
        graw[0] = *(const u32x4*)(P + t_ * DIN + c0); graw[1] = *(const u32x4*)(P + t_ * DIN + 512 + c0); graw[2] = *(const u32x4*)(P + t_ * DIN + 1024 + c0); \
        if (s_ != 0) { graw[3] = *(const u32x4*)(P + (t_ - 1) * DIN + c0); graw[4] = *(const u32x4*)(P + (t_ - 1) * DIN + 512 + c0); graw[5] = *(const u32x4*)(P + (t_ - 1) * DIN + 1024 + c0); } \
        else { graw[3] = zero4; graw[4] = zero4; graw[5] = zero4; } \
        graw[6] = *(const u32x4*)(LR + t_ * 1536 + c0); graw[7] = *(const u32x4*)(LR + t_ * 1536 + 512 + c0); graw[8] = *(const u32x4*)(LR + t_ * 1536 + 1024 + c0); } while (0)
    RWF_ISSUE(0);
    for (int ch = 0; ch < SEQ / 64; ++ch) {
        __syncthreads();
        float gate[8];
        {
            float r[8], k[8], v[8], pr[8], ld[8], av[8];
            unpack8(graw[0], r); unpack8(graw[1], k); unpack8(graw[2], v);
            unpack8(graw[3], pr);
#pragma unroll
            for (int j = 0; j < 8; ++j) r[j] += (pr[j] - r[j]) * mur[j];
            unpack8(graw[4], pr);
#pragma unroll
            for (int j = 0; j < 8; ++j) k[j] += (pr[j] - k[j]) * muk[j];
            unpack8(graw[5], pr);
#pragma unroll
            for (int j = 0; j < 8; ++j) v[j] += (pr[j] - v[j]) * muv[j];
            unpack8(graw[6], ld); unpack8(graw[7], av); unpack8(graw[8], gate);
            if (ch + 1 < SEQ / 64) RWF_ISSUE(ch + 1);
            float kk[8], ss = 0.f, bp = 0.f;
#pragma unroll
            for (int j = 0; j < 8; ++j) { kk[j] = k[j] * kkw[j]; ss += kk[j] * kk[j]; }
            ss = red8(ss);
            const float inv = __builtin_amdgcn_rsqf(fmaxf(ss, 1e-24f));
            float w8[8], k8[8], b8[8];
#pragma unroll
            for (int j = 0; j < 8; ++j) { kk[j] *= inv; k8[j] = k[j] * (1.0f + (av[j] - 1.0f) * kaw[j]); b8[j] = kk[j] * av[j]; w8[j] = __expf(ld[j]); bp += r[j] * k8[j] * rkw[j]; }
            bp = red8(bp);
            if (cg == 0) sBon[tt] = bp;
            LAS float* d;
            d = sR + tt * 64 + 8 * cg; *(LAS f32x4*)d = (f32x4){r[0], r[1], r[2], r[3]}; *(LAS f32x4*)(d + 4) = (f32x4){r[4], r[5], r[6], r[7]};
            d = sW + tt * 64 + 8 * cg; *(LAS f32x4*)d = (f32x4){w8[0], w8[1], w8[2], w8[3]}; *(LAS f32x4*)(d + 4) = (f32x4){w8[4], w8[5], w8[6], w8[7]};
            d = sK + tt * 64 + 8 * cg; *(LAS f32x4*)d = (f32x4){k8[0], k8[1], k8[2], k8[3]}; *(LAS f32x4*)(d + 4) = (f32x4){k8[4], k8[5], k8[6], k8[7]};
            d = sKK + tt * 64 + 8 * cg; *(LAS f32x4*)d = (f32x4){kk[0], kk[1], kk[2], kk[3]}; *(LAS f32x4*)(d + 4) = (f32x4){kk[4], kk[5], kk[6], kk[7]};
            d = sB + tt * 64 + 8 * cg; *(LAS f32x4*)d = (f32x4){b8[0], b8[1], b8[2], b8[3]}; *(LAS f32x4*)(d + 4) = (f32x4){b8[4], b8[5], b8[6], b8[7]};
            d = sV + tt * 64 + 8 * cg; *(LAS f32x4*)d = (f32x4){v[0], v[1], v[2], v[3]}; *(LAS f32x4*)(d + 4) = (f32x4){v[4], v[5], v[6], v[7]};
        }
        __syncthreads();
        {
#define RWF_LD(arr, s_) const f32x4 arr##a = *(const LAS f32x4*)(arr + (s_) * 64 + 8 * jq), arr##b = *(const LAS f32x4*)(arr + (s_) * 64 + 8 * jq + 4)
            f32x4 w_a = *(const LAS f32x4*)(sW + 8 * jq), w_b = *(const LAS f32x4*)(sW + 8 * jq + 4), kk_a = *(const LAS f32x4*)(sKK + 8 * jq), kk_b = *(const LAS f32x4*)(sKK + 8 * jq + 4),
                  b_a = *(const LAS f32x4*)(sB + 8 * jq), b_b = *(const LAS f32x4*)(sB + 8 * jq + 4), k_a = *(const LAS f32x4*)(sK + 8 * jq), k_b = *(const LAS f32x4*)(sK + 8 * jq + 4),
                  r_a = *(const LAS f32x4*)(sR + 8 * jq), r_b = *(const LAS f32x4*)(sR + 8 * jq + 4);
            float vi = sV[row];
            f32x2 pyp = (f32x2){0.f, 0.f}; float ykeep = 0.f;
#pragma unroll 1
            for (int s8 = 0; s8 < 64; s8 += 8) {
#pragma unroll
                for (int u = 0; u < 8; ++u) {
                    const int sn = (s8 + u + 1) & 63;
                    RWF_LD(sW, sn); RWF_LD(sKK, sn); RWF_LD(sB, sn); RWF_LD(sK, sn); RWF_LD(sR, sn);
                    const float nvi = sV[sn * 64 + row];
                    f32x2 pa = st0 * (f32x2){kk_a.x, kk_a.y}; pa = pfma(st1, (f32x2){kk_a.z, kk_a.w}, pa); pa = pfma(st2, (f32x2){kk_b.x, kk_b.y}, pa); pa = pfma(st3, (f32x2){kk_b.z, kk_b.w}, pa);
                    float av = pa.x + pa.y, yv = pyp.x + pyp.y;
                    av += dpp<XOR1>(av); yv += dpp<XOR1>(yv); av += dpp<XOR2>(av); yv += dpp<XOR2>(yv); av += dpp<XOR7>(av); yv += dpp<XOR7>(yv);
                    if (u > 0) ykeep = (jq == u - 1) ? yv : ykeep;
                    else if (s8 > 0) { ykeep = (jq == 7) ? yv : ykeep; sO[(s8 - 8 + jq) * 64 + row] = ykeep; }
                    const float sa = -av;
                    const f32x2 sa2 = (f32x2){sa, sa}, vi2 = (f32x2){vi, vi};
                    st0 = pfma(st0, (f32x2){w_a.x, w_a.y}, pfma(vi2, (f32x2){k_a.x, k_a.y}, sa2 * (f32x2){b_a.x, b_a.y}));
                    st1 = pfma(st1, (f32x2){w_a.z, w_a.w}, pfma(vi2, (f32x2){k_a.z, k_a.w}, sa2 * (f32x2){b_a.z, b_a.w}));
                    st2 = pfma(st2, (f32x2){w_b.x, w_b.y}, pfma(vi2, (f32x2){k_b.x, k_b.y}, sa2 * (f32x2){b_b.x, b_b.y}));
                    st3 = pfma(st3, (f32x2){w_b.z, w_b.w}, pfma(vi2, (f32x2){k_b.z, k_b.w}, sa2 * (f32x2){b_b.z, b_b.w}));
                    pyp = st0 * (f32x2){r_a.x, r_a.y}; pyp = pfma(st1, (f32x2){r_a.z, r_a.w}, pyp); pyp = pfma(st2, (f32x2){r_b.x, r_b.y}, pyp); pyp = pfma(st3, (f32x2){r_b.z, r_b.w}, pyp);
                    w_a = sWa; w_b = sWb; kk_a = sKKa; kk_b = sKKb; b_a = sBa; b_b = sBb; k_a = sKa; k_b = sKb; r_a = sRa; r_b = sRb; vi = nvi;
                }
            }
            const float yv = red8(pyp.x + pyp.y);
            ykeep = (jq == 7) ? yv : ykeep; sO[(56 + jq) * 64 + row] = ykeep;
#undef RWF_LD
        }
        __syncthreads();
        {
            const size_t t = (size_t)b * SEQ + ch * 64 + tt;
            const f32x4 o0 = *(const LAS f32x4*)(sO + tt * 64 + 8 * cg), o1 = *(const LAS f32x4*)(sO + tt * 64 + 8 * cg + 4);
            const f32x4 v0 = *(const LAS f32x4*)(sV + tt * 64 + 8 * cg), v1 = *(const LAS f32x4*)(sV + tt * 64 + 8 * cg + 4);
            float o[8] = {o0.x, o0.y, o0.z, o0.w, o1.x, o1.y, o1.z, o1.w}; const float vv[8] = {v0.x, v0.y, v0.z, v0.w, v1.x, v1.y, v1.z, v1.w};
            float sm = 0.f;
#pragma unroll
            for (int j = 0; j < 8; ++j) sm += o[j];
            const float mean = red8(sm) * (1.0f / 64.0f);
            float q = 0.f;
#pragma unroll
            for (int j = 0; j < 8; ++j) { o[j] -= mean; q += o[j] * o[j]; }
            const float rstd = __builtin_amdgcn_rsqf(red8(q) * (1.0f / 64.0f) + 64e-5f);
            const float bon = sBon[tt];
            float y[8];
#pragma unroll
            for (int j = 0; j < 8; ++j) y[j] = (o[j] * rstd * lnw[j] + lnb[j] + bon * vv[j]) * gate[j];
            *(u32x4*)(Y + t * D + c0) = pack8(y);
        }
    }
#undef RWF_ISSUE
}

__device__ __forceinline__ void hgrn_full(ArgsRef a, int l, LAS unsigned char* lds, int job, int tid) {
    const bf16_t* P = (const bf16_t*)(a.ws + WS_PROJ); bf16_t* Y = (bf16_t*)(a.ws + WS_YC);
    LAS float* sQ = (LAS float*)lds; LAS float* sF = sQ + 4096; LAS float* sV = sF + 4096; LAS float* sO = sV + 4096;
    const int wave = tid >> 6, lane = tid & 63, tt = tid >> 3, cg = tid & 7;
    const float* lbp = (const float*)a.in[32];
    const int b = job >> 3, h = job & 7, c0 = 64 * h + 8 * cg;
    float lb[8], gn[8];
#pragma unroll
    for (int j = 0; j < 8; ++j) { lb[j] = (l == 0) ? 0.f : sigmoidf_(lbp[512 + c0 + j] - lbp[c0 + j]); gn[j] = ((const float*)a.in[33])[(size_t)l * 64 + 8 * cg + j]; }
    f32x2 st0 = (f32x2){0.f, 0.f}, st1 = st0, st2 = st0, st3 = st0;
    const int col = 8 * wave + (lane >> 3), dq = lane & 7;
    u32x4 gq, gf, gv, gg;
#define HGF_ISSUE(ch_) do { const size_t t_ = (size_t)b * SEQ + (ch_) * 64 + tt; gq = *(const u32x4*)(P + t_ * DIN + C_HG + c0); gf = *(const u32x4*)(P + t_ * DIN + C_HG + 512 + c0); \
        gv = *(const u32x4*)(P + t_ * DIN + C_HG + 1024 + c0); gg = *(const u32x4*)(P + t_ * DIN + C_HG + 1536 + c0); } while (0)
    HGF_ISSUE(0);
    for (int ch = 0; ch < SEQ / 64; ++ch) {
        __syncthreads();
        float gate[8];
        {
            float q[8], f[8], v[8];
            unpack8(gq, q); unpack8(gf, f); unpack8(gv, v); unpack8(gg, gate);
            if (ch + 1 < SEQ / 64) HGF_ISSUE(ch + 1);
#pragma unroll
            for (int j = 0; j < 8; ++j) { q[j] = siluf_(q[j]) * 0.125f; f[j] = lb[j] + (1.0f - lb[j]) * sigmoidf_(f[j]); }
            LAS float* d;
            d = sQ + tt * 64 + 8 * cg; *(LAS f32x4*)d = (f32x4){q[0], q[1], q[2], q[3]}; *(LAS f32x4*)(d + 4) = (f32x4){q[4], q[5], q[6], q[7]};
            d = sF + tt * 64 + 8 * cg; *(LAS f32x4*)d = (f32x4){f[0], f[1], f[2], f[3]}; *(LAS f32x4*)(d + 4) = (f32x4){f[4], f[5], f[6], f[7]};
            d = sV + tt * 64 + 8 * cg; *(LAS f32x4*)d = (f32x4){v[0], v[1], v[2], v[3]}; *(LAS f32x4*)(d + 4) = (f32x4){v[4], v[5], v[6], v[7]};
        }
        __syncthreads();
        {
            f32x4 f_a = *(const LAS f32x4*)(sF + 8 * dq), f_b = *(const LAS f32x4*)(sF + 8 * dq + 4), q_a = *(const LAS f32x4*)(sQ + 8 * dq), q_b = *(const LAS f32x4*)(sQ + 8 * dq + 4);
            float vi = sV[col];
            float ykeep = 0.f;
#pragma unroll 1
            for (int s8 = 0; s8 < 64; s8 += 8) {
#pragma unroll
                for (int u = 0; u < 8; ++u) {
                    const int sn = (s8 + u + 1) & 63;
                    const f32x4 nf_a = *(const LAS f32x4*)(sF + sn * 64 + 8 * dq), nf_b = *(const LAS f32x4*)(sF + sn * 64 + 8 * dq + 4),
                                nq_a = *(const LAS f32x4*)(sQ + sn * 64 + 8 * dq), nq_b = *(const LAS f32x4*)(sQ + sn * 64 + 8 * dq + 4);
                    const float nvi = sV[sn * 64 + col];
                    const f32x2 vi2 = (f32x2){vi, vi};
                    st0 = pfma((f32x2){f_a.x, f_a.y}, st0 - vi2, vi2); st1 = pfma((f32x2){f_a.z, f_a.w}, st1 - vi2, vi2);
                    st2 = pfma((f32x2){f_b.x, f_b.y}, st2 - vi2, vi2); st3 = pfma((f32x2){f_b.z, f_b.w}, st3 - vi2, vi2);
                    f32x2 py = st0 * (f32x2){q_a.x, q_a.y}; py = pfma(st1, (f32x2){q_a.z, q_a.w}, py); py = pfma(st2, (f32x2){q_b.x, q_b.y}, py); py = pfma(st3, (f32x2){q_b.z, q_b.w}, py);
                    const float y = red8(py.x + py.y);
                    ykeep = (dq == u) ? y : ykeep;
                    f_a = nf_a; f_b = nf_b; q_a = nq_a; q_b = nq_b; vi = nvi;
                }
                sO[(s8 + dq) * 64 + col] = ykeep;
            }
        }
        __syncthreads();
        {
            const size_t t = (size_t)b * SEQ + ch * 64 + tt;
            const f32x4 o0 = *(const LAS f32x4*)(sO + tt * 64 + 8 * cg), o1 = *(const LAS f32x4*)(sO + tt * 64 + 8 * cg + 4);
            const float o[8] = {o0.x, o0.y, o0.z, o0.w, o1.x, o1.y, o1.z, o1.w};
            float q = 0.f;
#pragma unroll
            for (int j = 0; j < 8; ++j) q += o[j] * o[j];
            const float rs = __builtin_amdgcn_rsqf(red8(q) * (1.0f / 64.0f) + 1e-6f);
            float y[8];
#pragma unroll
            for (int j = 0; j < 8; ++j) y[j] = o[j] * rs * gn[j] * siluf_(gate[j]);
            *(u32x4*)(Y + t * D + 1536 + c0) = pack8(y);
        }
    }
#undef HGF_ISSUE
}

__device__ __forceinline__ void attn_phase(ArgsRef a, int l, LAS unsigned char* lds) {
    const int TID = opaque_tid(), BID = opaque_bid();
    const bf16_t* P = (const bf16_t*)(a.ws + WS_PROJ); bf16_t* Y = (bf16_t*)(a.ws + WS_YC);
    const int* pos = (const int*)a.in[1];
    const float* qn = (const float*)a.in[19] + (size_t)l * 64; const float* kn = (const float*)a.in[20] + (size_t)l * 64; const float* sinks = (const float*)a.in[21] + (size_t)l * 8;
    constexpr int KST = 144, VST = 528;
    LAS unsigned char* sK = lds; LAS unsigned char* sVt = sK + 256 * KST; LAS unsigned char* sQ = sVt + 64 * VST; LAS float* sM = (LAS float*)(sQ + 512 * KST);
    const int tid = TID, cg = tid & 7, wave = tid >> 6, lane = tid & 63;
    float kmaxg = 0.f;
    for (int j = 0; j < 64; ++j) kmaxg = fmaxf(kmaxg, fabsf(kn[j]));
    const float kbound = 8.0f * kmaxg;
    float gk[8], gq[8], invf[8];
#pragma unroll
    for (int j = 0; j < 8; ++j) { gk[j] = kn[8 * cg + j]; gq[j] = qn[8 * cg + j]; invf[j] = exp2f(-(float)j * (18.931568569324174f / 8.0f)); }
    for (int job = BID; job < 512; job += gridDim.x) {
        const int b = job >> 5, nb = (job >> 1) & 15, kvh = job & 1;
        __syncthreads();
#pragma unroll 1
        for (int r = 0; r < 4; ++r) {
            const int kj = (tid >> 3) + 64 * r, s = (nb - 1) * 128 + kj;
            float k[8], v[8];
            if (s >= 0) {
                const size_t t = (size_t)b * SEQ + s;
                unpack8(*(const u32x4*)(P + t * DIN + C_ATT + 512 + 64 * kvh + 8 * cg), k); unpack8(*(const u32x4*)(P + t * DIN + C_ATT + 640 + 64 * kvh + 8 * cg), v);
            } else {
#pragma unroll
                for (int j = 0; j < 8; ++j) { k[j] = 0.f; v[j] = 0.f; } }
            float ss = 0.f;
#pragma unroll
            for (int j = 0; j < 8; ++j) ss += k[j] * k[j];
            ss = red8(ss);
            const float rs = __builtin_amdgcn_rsqf(ss * (1.0f / 64.0f) + 1e-6f);
#pragma unroll
            for (int j = 0; j < 8; ++j) k[j] = k[j] * rs * gk[j];
            const float pf = (float)pos[b * SEQ + (s >= 0 ? s : 0)];
#pragma unroll
            for (int j = 0; j < 8; ++j) {
                const float other = dpp<XOR1>(k[j]);
                if (cg < 2) { float sn, cs; sincos_big(pf * invf[j], sn, cs); k[j] = (cg == 0) ? (k[j] * cs - other * sn) : (k[j] * cs + other * sn); }
            }
            *(LAS u32x4*)(sK + kj * KST + 16 * cg) = pack8(k);
#pragma unroll
            for (int j = 0; j < 8; j += 2) { const unsigned w = pk2(v[j], v[j + 1]);
                *(LAS unsigned short*)(sVt + (8 * cg + j) * VST + 2 * kj) = (unsigned short)(w & 0xffffu); *(LAS unsigned short*)(sVt + (8 * cg + j + 1) * VST + 2 * kj) = (unsigned short)(w >> 16); }
        }
#pragma unroll 1
        for (int r = 0; r < 8; ++r) {
            const int row = (tid >> 3) + 64 * r, g = row >> 7, qi = row & 127, hq = 4 * kvh + g;
            const size_t tq = (size_t)b * SEQ + nb * 128 + qi;
            float q[8];
            unpack8(*(const u32x4*)(P + tq * DIN + C_ATT + 64 * hq + 8 * cg), q);
            float ss = 0.f;
#pragma unroll
            for (int j = 0; j < 8; ++j) ss += q[j] * q[j];
            ss = red8(ss);
            const float rs = 0.125f * __builtin_amdgcn_rsqf(ss * (1.0f / 64.0f) + 1e-6f);
#pragma unroll
            for (int j = 0; j < 8; ++j) q[j] = q[j] * rs * gq[j];
            const float pf = (float)pos[b * SEQ + nb * 128 + qi];
            float qq = 0.f;
#pragma unroll
            for (int j = 0; j < 8; ++j) {
                const float other = dpp<XOR1>(q[j]);
                if (cg < 2) { float sn, cs; sincos_big(pf * invf[j], sn, cs); q[j] = (cg == 0) ? (q[j] * cs - other * sn) : (q[j] * cs + other * sn); }
                qq += q[j] * q[j];
            }
            qq = red8(qq);
            if (cg == 0) sM[row] = sqrtf(qq) * kbound;
            *(LAS u32x4*)(sQ + row * KST + 16 * cg) = pack8(q);
        }
        __syncthreads();
        const int g = wave >> 1, qh = wave & 1, hq = 4 * kvh + g, fr = lane & 15, fq = lane >> 4;
        const float sinkv = sinks[hq];
#pragma unroll 1
        for (int qt = 0; qt < 4; ++qt) {
            const int qi0 = 64 * qh + 16 * qt, R0 = g * 128 + qi0, kt0 = qi0 >> 4;
            const bf16x8 qf0 = *(const LAS bf16x8*)(sQ + (R0 + fr) * KST + 16 * fq), qf1 = *(const LAS bf16x8*)(sQ + (R0 + fr) * KST + 16 * fq + 64);
            const float msh = sM[R0 + fr];
            const int ql = qi0 + fr;
            f32x4 oacc[4];
#pragma unroll
            for (int dt = 0; dt < 4; ++dt) oacc[dt] = (f32x4){0.f, 0.f, 0.f, 0.f};
            float lsum = 0.f;
#pragma unroll
            for (int ks = 0; ks < 5; ++ks) {
                unsigned pw[4];
#pragma unroll
                for (int h2 = 0; h2 < 2; ++h2) {
                    const int ti = 2 * ks + h2, kt = (kt0 + ti) < 15 ? (kt0 + ti) : 15;
                    const bf16x8 kf0 = *(const LAS bf16x8*)(sK + (16 * kt + fr) * KST + 16 * fq), kf1 = *(const LAS bf16x8*)(sK + (16 * kt + fr) * KST + 16 * fq + 64);
                    f32x4 sc = (f32x4){0.f, 0.f, 0.f, 0.f};
                    sc = __builtin_amdgcn_mfma_f32_16x16x32_bf16(kf0, qf0, sc, 0, 0, 0);
                    sc = __builtin_amdgcn_mfma_f32_16x16x32_bf16(kf1, qf1, sc, 0, 0, 0);
                    float p[4];
#pragma unroll
                    for (int j = 0; j < 4; ++j) { const int kj = 16 * (kt0 + ti) + 4 * fq + j;
                        const bool valid = (kj > ql) && (kj <= ql + 128) && (nb > 0 || kj >= 128);
                        p[j] = valid ? __expf(sc[j] - msh) : 0.f; lsum += p[j]; }
                    pw[2 * h2] = pk2(p[0], p[1]); pw[2 * h2 + 1] = pk2(p[2], p[3]);
                }
                const u32x4 pq = (u32x4){pw[0], pw[1], pw[2], pw[3]};
                const bf16x8 pf = __builtin_bit_cast(bf16x8, pq);
                const int kta = (kt0 + 2 * ks) < 15 ? (kt0 + 2 * ks) : 15, ktb = (kt0 + 2 * ks + 1) < 15 ? (kt0 + 2 * ks + 1) : 15;
#pragma unroll
                for (int dt = 0; dt < 4; ++dt) {
                    const u32x2 va = *(const LAS u32x2*)(sVt + (16 * dt + fr) * VST + (16 * kta + 4 * fq) * 2), vb = *(const LAS u32x2*)(sVt + (16 * dt + fr) * VST + (16 * ktb + 4 * fq) * 2);
                    const u32x4 vq = (u32x4){va.x, va.y, vb.x, vb.y};
                    oacc[dt] = __builtin_amdgcn_mfma_f32_16x16x32_bf16(__builtin_bit_cast(bf16x8, vq), pf, oacc[dt], 0, 0, 0);
                }
            }
            lsum += __shfl_xor(lsum, 16); lsum += __shfl_xor(lsum, 32);
            const float inv = __builtin_amdgcn_rcpf(lsum + __expf(sinkv - msh));
            const size_t tq = (size_t)b * SEQ + nb * 128 + ql;
#pragma unroll
            for (int dt = 0; dt < 4; ++dt) { u32x2 w; w.x = pk2(oacc[dt][0] * inv, oacc[dt][1] * inv); w.y = pk2(oacc[dt][2] * inv, oacc[dt][3] * inv);
                *(u32x2*)(Y + tq * D + 512 + 64 * hq + 16 * dt + 4 * fq) = w; }
        }
    }
    __syncthreads();
}

__device__ __forceinline__ float gelu_erf(float v) {
    const float t = __builtin_amdgcn_rcpf(fabsf(v) * 0.2316418882f + 1.0f);
    float q = t * 0.5307027145f + (-0.7265760135f); q = q * t + 0.7107068705f; q = q * t + (-0.142248368f); q = q * t + 0.127414796f; q = q * t;
    const float e = __builtin_amdgcn_exp2f(v * v * (-0.72134752044f));
    const float m = v * (q * e);
    return v < 0.f ? m : v - m;
}
__device__ __forceinline__ void s5_jobs(ArgsRef a, int l, LAS unsigned char* lds, unsigned* qctr) {
    const int TID = opaque_tid();
    LAS int* sJob = (LAS int*)(lds + 8 * 16 * 130 * 4 + 4096);
    const bf16_t* P = (const bf16_t*)(a.ws + WS_PROJ); bf16_t* Z = (bf16_t*)(a.ws + WS_Z);
    const int tid = TID, wave = tid >> 6, lane = tid & 63, fr16 = lane & 15, fq = lane >> 4;
    LAS float* sX = (LAS float*)lds + wave * (16 * 130);
    LAS float* sE = (LAS float*)lds + 8 * 16 * 130;
    for (;;) {
        if (TID == 0) *sJob = (int)__hip_atomic_fetch_add(qctr, 1u, __ATOMIC_RELAXED, __HIP_MEMORY_SCOPE_AGENT);
        __syncthreads();
        const int job = *sJob;
        if (job >= 512) break;
        const int b = job >> 5, g = job & 31;
        const float dt = expf(((const float*)a.in[24])[l * 32 + g]);
        float lbr, lbi;
        { const float lre = ((const float*)a.in[22])[(size_t)l * 2048 + g * 64 + lane], lim = ((const float*)a.in[23])[(size_t)l * 2048 + g * 64 + lane];
          float sn, cs; sincos_big(lim * dt, sn, cs); const float er = expf(lre * dt); lbr = er * cs; lbi = er * sn; }
        bf16x8 bfrag[8];
#pragma unroll
        for (int k = 0; k < 4; ++k) {
            const int p = fr16 + 16 * k;
            const float lre = ((const float*)a.in[22])[(size_t)l * 2048 + g * 64 + p], lim = ((const float*)a.in[23])[(size_t)l * 2048 + g * 64 + p];
            float sn, cs; sincos_big(lim * dt, sn, cs); const float er = expf(lre * dt), pbr = er * cs, pbi = er * sn;
            const float den = __builtin_amdgcn_rcpf(lre * lre + lim * lim);
            const float fr = ((pbr - 1.0f) * lre + pbi * lim) * den, fi = (pbi * lre - (pbr - 1.0f) * lim) * den;
            const float* brp = (const float*)a.in[25] + ((size_t)l * 2048 + g * 64 + p) * 16 + 8 * (fq & 1);
            const float* bip = (const float*)a.in[26] + ((size_t)l * 2048 + g * 64 + p) * 16 + 8 * (fq & 1);
            float vr[8], vi[8];
#pragma unroll
            for (int i = 0; i < 8; ++i) { const float br = brp[i], bi = bip[i]; float xr = fr * br - fi * bi, xi = fr * bi + fi * br;
                const unsigned hw = pk2(xr, xi);
                if (fq >= 2) { xr -= bflo(hw); xi -= bfhi(hw); }
                vr[i] = xr; vi[i] = xi; }
            bfrag[k] = __builtin_bit_cast(bf16x8, pack8(vr)); bfrag[4 + k] = __builtin_bit_cast(bf16x8, pack8(vi));
        }
        float creg[32];
        {
            const float* cre = (const float*)a.in[27] + ((size_t)l * 32 + g) * 1024 + fr16 * 64 + fq;
            const float* cim = (const float*)a.in[28] + ((size_t)l * 32 + g) * 1024 + fr16 * 64 + fq;
#pragma unroll
            for (int kk = 0; kk < 16; ++kk) { creg[kk] = cre[4 * kk]; creg[16 + kk] = -cim[4 * kk]; }
        }
        f32x4 dsk;
        { const float* dp = (const float*)a.in[29] + (size_t)l * 512 + 16 * g + 4 * fq; dsk = (f32x4){dp[0], dp[1], dp[2], dp[3]}; }
        const size_t tbase = (size_t)b * SEQ + wave * 256;
        const bf16_t* ua = P + (tbase + fr16) * DIN + C_S5 + 16 * g + 8 * (fq & 1);
        const bf16_t* ue = P + (tbase + fr16) * DIN + C_S5 + 16 * g + 4 * fq;
        f32x2 xs = (f32x2){0.f, 0.f}; const f32x2 lbr2 = (f32x2){lbr, lbr}, lbi2 = (f32x2){lbi, lbi};
        {
            u32x4 au = *(const u32x4*)ua;
#pragma unroll 1
            for (int gi = 0; gi < 16; ++gi) {
                const bf16x8 af = __builtin_bit_cast(bf16x8, au);
                if (gi + 1 < 16) au = *(const u32x4*)(ua + (size_t)(gi + 1) * 16 * DIN);
#pragma unroll
                for (int nt = 0; nt < 8; ++nt) { const f32x4 d = __builtin_amdgcn_mfma_f32_16x16x32_bf16(af, bfrag[nt], (f32x4){0.f, 0.f, 0.f, 0.f}, 0, 0, 0);
#pragma unroll
                    for (int j = 0; j < 4; ++j) sX[(4 * fq + j) * 130 + fr16 + 16 * nt] = d[j]; }
                LDS_FENCE();
#pragma unroll
                for (int s = 0; s < 16; ++s) { const f32x2 bu = (f32x2){sX[s * 130 + lane], sX[s * 130 + 64 + lane]};
                    const f32x2 nx = pfma(lbr2, xs, bu); xs = pfma(lbi2, (f32x2){-xs.y, xs.x}, nx); }
                LDS_FENCE();
            }
        }
        sE[wave * 128 + lane] = xs.x; sE[wave * 128 + 64 + lane] = xs.y;
        float pr = lbr, pi = lbi;
#pragma unroll
        for (int i = 0; i < 8; ++i) { const float nr = pr * pr - pi * pi, ni = 2.0f * pr * pi; pr = nr; pi = ni; }
        __syncthreads();
        xs = (f32x2){0.f, 0.f};
        for (int w = 0; w < wave; ++w) { const float er_ = sE[w * 128 + lane], ei_ = sE[w * 128 + 64 + lane];
            const float nr = pr * xs.x - pi * xs.y + er_, ni = pr * xs.y + pi * xs.x + ei_; xs.x = nr; xs.y = ni; }
        {
            u32x4 au = *(const u32x4*)ua; u32x2 eu = *(const u32x2*)ue;
#pragma unroll 1
            for (int gi = 0; gi < 16; ++gi) {
                const bf16x8 af = __builtin_bit_cast(bf16x8, au); const u32x2 eun = eu;
                if (gi + 1 < 16) { au = *(const u32x4*)(ua + (size_t)(gi + 1) * 16 * DIN); eu = *(const u32x2*)(ue + (size_t)(gi + 1) * 16 * DIN); }
#pragma unroll
                for (int nt = 0; nt < 8; ++nt) { const f32x4 d = __builtin_amdgcn_mfma_f32_16x16x32_bf16(af, bfrag[nt], (f32x4){0.f, 0.f, 0.f, 0.f}, 0, 0, 0);
#pragma unroll
                    for (int j = 0; j < 4; ++j) sX[(4 * fq + j) * 130 + fr16 + 16 * nt] = d[j]; }
                LDS_FENCE();
#pragma unroll
                for (int s = 0; s < 16; ++s) { const f32x2 bu = (f32x2){sX[s * 130 + lane], sX[s * 130 + 64 + lane]};
                    const f32x2 nx = pfma(lbr2, xs, bu); xs = pfma(lbi2, (f32x2){-xs.y, xs.x}, nx);
                    sX[s * 130 + lane] = xs.x; sX[s * 130 + 64 + lane] = xs.y; }
                LDS_FENCE();
                f32x4 yacc = (f32x4){0.f, 0.f, 0.f, 0.f}, yacc1 = yacc, yacc2 = yacc, yacc3 = yacc;
                const LAS float* xp = sX + fr16 * 130 + fq;
#pragma unroll
                for (int kk = 0; kk < 32; kk += 4) {
                    yacc = __builtin_amdgcn_mfma_f32_16x16x4f32(creg[kk], xp[4 * kk], yacc, 0, 0, 0);
                    yacc1 = __builtin_amdgcn_mfma_f32_16x16x4f32(creg[kk + 1], xp[4 * kk + 4], yacc1, 0, 0, 0);
                    yacc2 = __builtin_amdgcn_mfma_f32_16x16x4f32(creg[kk + 2], xp[4 * kk + 8], yacc2, 0, 0, 0);
                    yacc3 = __builtin_amdgcn_mfma_f32_16x16x4f32(creg[kk + 3], xp[4 * kk + 12], yacc3, 0, 0, 0);
                }
                yacc = (yacc + yacc1) + (yacc2 + yacc3);
                const float u0 = bflo(eun.x), u1 = bfhi(eun.x), u2 = bflo(eun.y), u3 = bfhi(eun.y);
                const float z0 = gelu_erf(yacc[0] + dsk[0] * u0), z1 = gelu_erf(yacc[1] + dsk[1] * u1), z2 = gelu_erf(yacc[2] + dsk[2] * u2), z3 = gelu_erf(yacc[3] + dsk[3] * u3);
                u32x2 w; w.x = pk2(z0, z1); w.y = pk2(z2, z3);
                *(u32x2*)(Z + (tbase + gi * 16 + fr16) * 512 + 16 * g + 4 * fq) = w;
                LDS_FENCE();
            }
        }
        __syncthreads();
    }
}

__device__ __forceinline__ void scan_phase(ArgsRef a, int l, LAS unsigned char* lds) {
    const int TID = opaque_tid(), BID = opaque_bid();
    if (gridDim.x == 256) {
        if (BID < 128) rwkv_full(a, l, lds, BID, TID); else hgrn_full(a, l, lds, BID - 128, TID);
    } else {
        for (int job = BID; job < 256; job += gridDim.x) { if (job < 128) rwkv_full(a, l, lds, job, TID); else hgrn_full(a, l, lds, job - 128, TID); __syncthreads(); }
    }
    __syncthreads();
    s5_jobs(a, l, lds, (unsigned*)(a.ws + WS_BAR) + 3584 + 64 * l);
    __syncthreads();
}

#define XB_TMO      128
#define XB_XCNT(j)  (256  + 64 * (j))
#define XB_XSUB(j)  (1280 + 64 * (j))
#define XB_XGEN(j)  (2304 + 64 * (j))
#define XB_TOP      3328
#define XB_TOPGEN   3392
#define XCD_BAR_WORDS 3456
#define XB_SPIN_CAP (1u << 18)

__device__ __forceinline__ unsigned xb_ld(unsigned* p)              { return __hip_atomic_load(p, __ATOMIC_RELAXED, __HIP_MEMORY_SCOPE_AGENT); }
__device__ __forceinline__ unsigned xb_add(unsigned* p, unsigned v) { return __hip_atomic_fetch_add(p, v, __ATOMIC_RELAXED, __HIP_MEMORY_SCOPE_AGENT); }
__device__ __forceinline__ unsigned xb_xcc_id() { return (unsigned)__builtin_amdgcn_s_getreg((3 << 11) | 20) & 0xFu; }
#define XB_SPIN(cond, bar) do { unsigned _sp = 0; while (cond) { __builtin_amdgcn_s_sleep(1); \
    if ((++_sp & 255u) == 0u) { if (xb_ld(&(bar)[XB_TMO])) break; if (_sp > XB_SPIN_CAP) { atomicAdd(&(bar)[XB_TMO], 1u); break; } } } } while (0)

struct XcdBarrier {
    unsigned* bar; unsigned x;
    volatile LAS unsigned* st;
};

__device__ __forceinline__ XcdBarrier xcd_barrier_post(unsigned* bar, volatile LAS unsigned* st) {
    XcdBarrier b; b.bar = bar; b.x = xb_xcc_id(); b.st = st;
    if (threadIdx.x == 0) (void)xb_add(&bar[XB_XCNT(b.x)], 1u);
    return b;
}
__device__ __forceinline__ void xcd_barrier_complete(unsigned* bar, unsigned x, unsigned& nloc, unsigned& nx) {
    const unsigned G = gridDim.x * gridDim.y * gridDim.z;
    unsigned sum, cnt, mine, sp = 0u;
    for (;;) {
        sum = 0u; cnt = 0u; mine = 0u;
#pragma unroll
        for (unsigned j = 0; j < 16; ++j) { const unsigned c = xb_ld(&bar[XB_XCNT(j)]); sum += c; cnt += (c > 0u) ? 1u : 0u; mine = (j == x) ? c : mine; }
        if (sum == G) break;
        __builtin_amdgcn_s_sleep(1);
        if ((++sp & 255u) == 0u) { if (xb_ld(&bar[XB_TMO])) break; if (sp > XB_SPIN_CAP) { atomicAdd(&bar[XB_TMO], 1u); break; } }
    }
    nloc = mine > 0u ? mine : 1u; nx = cnt > 0u ? cnt : 1u;
}

__device__ __forceinline__ void xcd_barrier(const XcdBarrier& b) {
    asm volatile("s_waitcnt vmcnt(0)" ::: "memory");
    __syncthreads();
    if (threadIdx.x == 0) {
        unsigned* bar = b.bar;
        __builtin_amdgcn_s_waitcnt(0);
        unsigned nloc = b.st[0], nx = b.st[1];
        if (nloc == 0u) { xcd_barrier_complete(bar, b.x, nloc, nx); b.st[0] = nloc; b.st[1] = nx; }
        const unsigned old = xb_add(&bar[XB_XSUB(b.x)], 1u);
        const unsigned gen = old / nloc;
        if (old + 1u == (gen + 1u) * nloc) {
            __builtin_amdgcn_fence(__ATOMIC_RELEASE, "agent");
            asm volatile("s_waitcnt vmcnt(0)" ::: "memory");
            const unsigned og = xb_add(&bar[XB_TOP], 1u);
            const unsigned tg = og / nx;
            if (og + 1u == (tg + 1u) * nx) xb_add(&bar[XB_TOPGEN], 1u);
            else XB_SPIN(xb_ld(&bar[XB_TOPGEN]) == tg, bar);
            __builtin_amdgcn_fence(__ATOMIC_ACQUIRE, "agent");
            xb_add(&bar[XB_XGEN(b.x)], 1u);
            asm volatile("s_waitcnt vmcnt(0)" ::: "memory");
        } else {
            XB_SPIN(xb_ld(&bar[XB_XGEN(b.x)]) == gen, bar);
            __builtin_amdgcn_fence(__ATOMIC_ACQUIRE, "agent");
            asm volatile("s_waitcnt vmcnt(0)" ::: "memory");
        }
    }
    __syncthreads();
}


constexpr int NPH = 11;
#ifndef DUPMASK
#define DUPMASK 0
#endif
__global__ void __launch_bounds__(NTHREADS, 2) mega(Args a_, int lo, int hi) {
    extern __shared__ __attribute__((aligned(16))) unsigned char lds_raw[];
    LAS unsigned char* lds = (LAS unsigned char*)lds_raw;
#ifdef EXTRA_SYNCS
    for (int i = 0; i < EXTRA_SYNCS; ++i) { __syncthreads(); cg::this_grid().sync(); }
#endif
    LAS unsigned* xst = (LAS unsigned*)(lds + LDS_BYTES - 16);
    if (hi - lo > 1) {
        if (threadIdx.x == 0) { xst[0] = 0u; xst[1] = 0u; }
        __syncthreads();
        const __attribute__((address_space(4))) Args* ap0 = (const __attribute__((address_space(4))) Args*)__builtin_amdgcn_kernarg_segment_ptr();
        (void)xcd_barrier_post((unsigned*)(ap0->ws + WS_BAR), (volatile LAS unsigned*)xst);
    }
#pragma unroll 1
    for (int step2 = 2 * lo; step2 < 2 * hi; ++step2) {
        const int step = step2 >> 1;
        if ((step2 & 1) && !((DUPMASK >> (step % NPH)) & 1)) continue;
        const __attribute__((address_space(4))) Args* ap = (const __attribute__((address_space(4))) Args*)__builtin_amdgcn_kernarg_segment_ptr();
        asm volatile("" : "+s"(ap));
        ArgsRef a = *ap;
        unsigned char* ws = a.ws;
        float* SSa = (float*)(ws + WS_SS); float* SSb = SSa + T; float* SSc = SSb + T;
        const int l = step / NPH, ph = step % NPH;
        const float* xin = (l == 0) ? (const float*)a.in[0] : (const float*)a.out;
#ifndef PHMASK
#define PHMASK 0x7ff
#endif
        switch (ph) {
        case 0: if (PHMASK & (1 << 0)) { conv_phase(a, l, lds); if (l == 0) norm_phase(xin, (bf16_t*)(ws + WS_XN), SSa); zero_phase(SSb, T); } break;
        case 1: if (PHMASK & (1 << 1)) { pg8::EpiSwiGLU E; E.H = (bf16_t*)(ws + WS_HID); E.SS = SSa; run_gemm(lds, (const bf16_t*)(ws + WS_XN), (const bf16_t*)(ws + W_UP1), 2 * FF, D, E); } break;
        case 2: if (PHMASK & (1 << 2)) { pg8::EpiResidual<true> E; E.base = xin; E.out = a.out; E.XN = (bf16_t*)(ws + WS_XN); E.SS = SSb; run_gemm(lds, (const bf16_t*)(ws + WS_HID), (const bf16_t*)(ws + W_DN1), D, FF, E); } break;
        case 3: if (PHMASK & (1 << 3)) { pg8::EpiBf16 E; E.O = (bf16_t*)(ws + WS_PROJ); E.ldc = DIN; E.SS = SSb; run_gemm(lds, (const bf16_t*)(ws + WS_XN), (const bf16_t*)(ws + W_IN), DIN, D, E); } break;
        case 4: if (PHMASK & (1 << 4)) { zero_phase(SSa, T); zero_phase(SSc, T); alr_phase(a, l); attn_phase(a, l, lds); } break;
        case 5: if (PHMASK & (1 << 5)) { pg8::EpiLR E; E.O = (bf16_t*)(ws + WS_LRO); E.w0 = (const float*)a.in[9] + (size_t)l * 512; E.a0 = (const float*)a.in[11] + (size_t)l * 512;
                  run_gemm(lds, (const bf16_t*)(ws + WS_ALR), (const bf16_t*)(ws + W_LR), 1536, 256, E); } break;
        case 6: if (PHMASK & (1 << 6)) scan_phase(a, l, lds); break;
        case 7: if (PHMASK & (1 << 7)) { pg8::EpiGLU G; G.Z = (const bf16_t*)(ws + WS_Z); G.Y = (bf16_t*)(ws + WS_YC); G.b = (const float*)a.in[31] + (size_t)l * 512;
                  run_gemm(lds, (const bf16_t*)(ws + WS_Z), (const bf16_t*)(ws + W_GLU), 512, 512, G); } break;
        case 8: if (PHMASK & (1 << 8)) { pg8::EpiResidual<false> E; E.base = a.out; E.out = a.out; E.XN = (bf16_t*)(ws + WS_XN); E.SS = SSc; run_gemm(lds, (const bf16_t*)(ws + WS_YC), (const bf16_t*)(ws + W_OUT), D, D, E); } break;
        case 9: if (PHMASK & (1 << 9)) { pg8::EpiSwiGLU E; E.H = (bf16_t*)(ws + WS_HID); E.SS = SSc; run_gemm(lds, (const bf16_t*)(ws + WS_XN), (const bf16_t*)(ws + W_UP2), 2 * FF, D, E); } break;
        case 10: if (PHMASK & (1 << 10)) { pg8::EpiResidual<true> E; E.base = a.out; E.out = a.out; E.XN = (l + 1 < NL) ? (bf16_t*)(ws + WS_XN) : nullptr; E.SS = SSa; run_gemm(lds, (const bf16_t*)(ws + WS_HID), (const bf16_t*)(ws + W_DN2), D, FF, E); } break;
        }
        if (step2 + 1 < 2 * hi) {
            if (step2 == 2 * lo) { __syncthreads(); cg::this_grid().sync(); }
            else { XcdBarrier xb; xb.bar = (unsigned*)(ws + WS_BAR); xb.x = xb_xcc_id(); xb.st = (volatile LAS unsigned*)xst; xcd_barrier(xb); }
        }
    }
}

extern "C" void kernel_launch(void* const* d_in, const int* in_sizes, int n_in, void* d_out, int out_size, void* d_ws, size_t ws_size, hipStream_t stream) {
    static int grid = 0;
    if (!grid) {
        int dev = 0, cus = 0, per_cu = 0;
        hipGetDevice(&dev);
        hipDeviceGetAttribute(&cus, hipDeviceAttributeMultiprocessorCount, dev);
        hipFuncSetAttribute((const void*)mega, hipFuncAttributeMaxDynamicSharedMemorySize, LDS_BYTES);
        hipOccupancyMaxActiveBlocksPerMultiprocessor(&per_cu, (const void*)mega, NTHREADS, LDS_BYTES);
        if (per_cu < 1) per_cu = 1;
        grid = cus * 1;
        if (grid != 256) fprintf(stderr, "kernel_launch: grid %d (cus %d, per_cu %d)\n", grid, cus, per_cu);
    }
    Args a{};
    for (int i = 0; i < 39; ++i) a.in[i] = d_in[i];
    a.out = (float*)d_out; a.ws = (unsigned char*)d_ws;
    (void)hipMemsetAsync((unsigned char*)d_ws + WS_BAR, 0, 16384, stream);
#if ONE_LAUNCH
    int lo = 0, hi = NL * NPH;
    void* args[] = {&a, &lo, &hi};
    hipError_t e = hipLaunchCooperativeKernel((void*)mega, dim3(grid), dim3(NTHREADS), args, LDS_BYTES, stream);
    if (e != hipSuccess) fprintf(stderr, "cooperative launch failed: %s (grid %d)\n", hipGetErrorString(e), grid);
#else
    for (int s = 0; s < NL * NPH; ++s) hipLaunchKernelGGL(mega, dim3(grid), dim3(NTHREADS), LDS_BYTES, stream, a, s, s + 1);
#endif
}
```

```cpp
#include <hip/hip_runtime.h>
#include <hip/hip_cooperative_groups.h>
#include <cstdio>
#include <cstdint>
namespace cg = cooperative_groups;

#ifndef ONE_LAUNCH
#define ONE_LAUNCH 1
#endif

#define LAS __attribute__((address_space(3)))
typedef unsigned short bf16_t;
typedef short bf16x8 __attribute__((ext_vector_type(8)));
typedef float f32x4 __attribute__((ext_vector_type(4)));
typedef float f32x2 __attribute__((ext_vector_type(2)));
typedef unsigned u32x4 __attribute__((ext_vector_type(4)));
typedef unsigned u32x2 __attribute__((ext_vector_type(2)));

constexpr int T = 32768, SEQ = 2048, NB = 16, D = 2048, FF = 5632, DIN = 5120, NL = 2;
constexpr int C_RWKV = 0, C_ATT = 1792, C_S5 = 2560, C_HG = 3072;
constexpr int NTHREADS = 512, NWAVES = 8;

constexpr size_t SZ_UP = (size_t)2 * FF * D * 2, SZ_DN = (size_t)D * FF * 2, SZ_IN = (size_t)DIN * D * 2, SZ_LR = (size_t)1536 * 256 * 2,
                 SZ_GLU = (size_t)512 * 512 * 2, SZ_OUT = (size_t)D * D * 2;
constexpr size_t W_UP1 = 0, W_DN1 = W_UP1 + SZ_UP, W_IN = W_DN1 + SZ_DN, W_LR = W_IN + SZ_IN, W_GLU = W_LR + SZ_LR, W_OUT = W_GLU + SZ_GLU,
                 W_UP2 = W_OUT + SZ_OUT, W_DN2 = W_UP2 + SZ_UP, W_END = W_DN2 + SZ_DN;
constexpr size_t WS_XN = W_END, WS_BIG = WS_XN + (size_t)T * D * 2;
constexpr size_t WS_HID = WS_BIG;
constexpr size_t WS_PROJ = WS_BIG, WS_LRO = WS_PROJ + (size_t)T * DIN * 2, WS_ALR = WS_LRO + (size_t)T * 1536 * 2, WS_Z = WS_ALR + (size_t)T * 256 * 2,
                 WS_OR = WS_Z + (size_t)T * 512 * 2, WS_OH = WS_OR + (size_t)T * 512 * 4, WS_BON = WS_OH + (size_t)T * 512 * 4, WS_YC = WS_BON + (size_t)T * 8 * 4, WS_SS = WS_YC + (size_t)T * D * 2, WS_BAR = WS_SS + (size_t)3 * T * 4, WS_END = WS_BAR + 16384;
static_assert(WS_END <= (size_t)1 << 30, "workspace");
static_assert(WS_HID + (size_t)T * FF * 2 <= (size_t)1 << 30, "workspace");

constexpr int LDS_BYTES = 147456;

struct Args { const void* in[39]; float* out; unsigned char* ws; };
typedef const __attribute__((address_space(4))) Args& ArgsRef;

typedef __bf16 bf16x2_t __attribute__((ext_vector_type(2)));
__device__ __forceinline__ unsigned pk2(float lo, float hi) { const f32x2 v = (f32x2){lo, hi}; return __builtin_bit_cast(unsigned, __builtin_convertvector(v, bf16x2_t)); }
__device__ __forceinline__ float bflo(unsigned w) { return __uint_as_float(w << 16); }
__device__ __forceinline__ float bfhi(unsigned w) { return __uint_as_float(w & 0xffff0000u); }
__device__ __forceinline__ void unpack8(u32x4 q, float* f) { f[0] = bflo(q.x); f[1] = bfhi(q.x); f[2] = bflo(q.y); f[3] = bfhi(q.y); f[4] = bflo(q.z); f[5] = bfhi(q.z); f[6] = bflo(q.w); f[7] = bfhi(q.w); }
__device__ __forceinline__ u32x4 pack8(const float* f) { u32x4 o; o.x = pk2(f[0], f[1]); o.y = pk2(f[2], f[3]); o.z = pk2(f[4], f[5]); o.w = pk2(f[6], f[7]); return o; }
template <int CTRL> __device__ __forceinline__ float dpp(float x) { return __builtin_bit_cast(float, __builtin_amdgcn_mov_dpp(__builtin_bit_cast(int, x), CTRL, 0xf, 0xf, true)); }
constexpr int XOR1 = 0xB1, XOR2 = 0x4E, XOR7 = 0x141, XOR8 = 0x128;
__device__ __forceinline__ float red8(float v) { v += dpp<XOR1>(v); v += dpp<XOR2>(v); v += dpp<XOR7>(v); return v; }
__device__ __forceinline__ float red16(float v) { v = red8(v); v += dpp<XOR8>(v); return v; }
__device__ __forceinline__ float wave_sum(float v) {
#pragma unroll
    for (int o = 1; o < 64; o <<= 1) v += __shfl_xor(v, o);
    return v;
}
__device__ __forceinline__ float sigmoidf_(float x) { return __builtin_amdgcn_rcpf(1.0f + __expf(-x)); }
__device__ __forceinline__ float siluf_(float x) { return x * __builtin_amdgcn_rcpf(1.0f + __expf(-x)); }
__device__ __forceinline__ int opaque_tid() { int t = threadIdx.x; asm volatile("" : "+v"(t)); return t; }
__device__ __forceinline__ int opaque_bid() { int t = blockIdx.x; asm volatile("" : "+s"(t)); return t; }
__device__ __forceinline__ f32x2 pfma(f32x2 a, f32x2 b, f32x2 c) { return __builtin_elementwise_fma(a, b, c); }
#define LDS_FENCE() asm volatile("s_waitcnt lgkmcnt(0)" ::: "memory")
__device__ __forceinline__ void sincos_big(float x, float& sn, float& cs) {
    const float n = rintf(x * 0.15915494309189535f);
    float r = fmaf(-n, 6.28318548202514648f, x); r = fmaf(-n, -1.7484555e-7f, r);
    sn = __sinf(r); cs = __cosf(r);
}

namespace pg8 {
constexpr int BM = 256, BK = 64, HALF = 128, HTB = HALF * BK * 2, STAGE_BYTES = 8 * HTB, NXCD = 8, WGM = 8;
__host__ __device__ __forceinline__ int lds_byte(int r, int c) { const int st = (r >> 4) * 2 + (c >> 5), rr = r & 15, cc = c & 31, ob = rr * 64 + cc * 2; return st * 1024 + (ob ^ (((ob >> 9) & 1) << 5)); }
__host__ __device__ __forceinline__ void stage_rc(int b, int& R, int& C) { const int st = b / 1024, sb = b % 1024, swz = sb ^ (((sb >> 9) & 1) << 5); R = (st >> 1) * 16 + swz / 64; C = (st & 1) * 32 + (swz % 64) / 2; }
__host__ __device__ __forceinline__ int perm32(int rho) { const int n = rho >> 4, i = rho & 15; return 8 * (i >> 2) + 4 * n + (i & 3); }
struct Unit { int pm, pn; };
struct Gemm { const bf16_t* A; const bf16_t* Bt; int M, N, K; };
struct StaticOrder {
    int nM, nN, nwg, G, c;
    __device__ void init(int M, int N, int G_, int c_) { nM = M / BM; nN = N / BM; nwg = nM * nN; G = G_; c = c_; }
    __device__ bool next(int i, Unit& u) const {
        const long L = (long)i * G + c; if (L >= nwg) return false;
        int wgid = (int)L; { const int q = nwg / NXCD, r = nwg % NXCD, xcd = wgid % NXCD, off = wgid / NXCD; wgid = (xcd < r ? xcd * (q + 1) : r * (q + 1) + (xcd - r) * q) + off; }
        const int nig = WGM * nN, gid = wgid / nig, fm = gid * WGM, gsz = (nM - fm) < WGM ? (nM - fm) : WGM;
        u.pm = fm + ((wgid % nig) % gsz); u.pn = (wgid % nig) / gsz; return true;
    }
};
template <class Epi>
__device__ __forceinline__ void gemm_phase(LAS unsigned char* lds, const Gemm g, const StaticOrder S, const Epi E) {
    const int TID = opaque_tid(), BID = opaque_bid(); (void)TID; (void)BID;
    const int tid = TID, wid = __builtin_amdgcn_readfirstlane(tid >> 6), lane = tid & 63, wr = wid >> 2, wc = wid & 3, fr = lane & 15, fq = lane >> 4;
    const int K = g.K, nt = K / BK;
    unsigned voffA[2], voffB[2];
#pragma unroll
    for (int i = 0; i < 2; ++i) { int R, C; stage_rc(tid * 16 + i * 8192, R, C); const int Rb = Epi::PERM ? ((R & ~31) + perm32(R & 31)) : R;
        voffA[i] = (unsigned)(R * K + C) * 2u; voffB[i] = (unsigned)(Rb * K + C) * 2u; }
    const size_t kstep = (size_t)(BK * 2);
    const size_t hstep = (size_t)HALF * K * 2;
    const size_t tstep = 2 * hstep;
    const unsigned ldsw = (unsigned)wid * 1024u;
    const int aoff = lds_byte(wr * 64 + fr, fq * 8), boff = lds_byte(wc * 32 + fr, fq * 8);
#define PG8_SA(b, h) (((b) * 2 + (h)) * HTB)
#define PG8_SB(b, h) ((4 + (b) * 2 + (h)) * HTB)
#define PG8_STAGE(bufoff, gbase, voff) do { _Pragma("unroll") for (int _i = 0; _i < 2; ++_i) \
        __builtin_amdgcn_global_load_lds((const unsigned*)((const char*)(gbase) + (voff)[_i]), (LAS unsigned*)(lds + (bufoff) + ldsw + _i * 8192), 16, 0, 0); } while (0)
#define PG8_LDA(dst, b, h) do { _Pragma("unroll") for (int m = 0; m < 4; ++m) _Pragma("unroll") for (int k = 0; k < 2; ++k) dst[m][k] = *(const LAS bf16x8*)(lds + PG8_SA(b, h) + aoff + m * 2048 + k * 1024); } while (0)
#define PG8_LDB(dst, b, h) do { _Pragma("unroll") for (int n = 0; n < 2; ++n) _Pragma("unroll") for (int k = 0; k < 2; ++k) dst[n][k] = *(const LAS bf16x8*)(lds + PG8_SB(b, h) + boff + n * 2048 + k * 1024); } while (0)
#define PG8_MMA(ai, bj, At, Bt) do { __builtin_amdgcn_s_setprio(1); _Pragma("unroll") for (int m = 0; m < 4; ++m) _Pragma("unroll") for (int n = 0; n < 2; ++n) _Pragma("unroll") for (int k = 0; k < 2; ++k) \
        acc[ai][bj][m][n] = __builtin_amdgcn_mfma_f32_16x16x32_bf16(Bt[n][k], At[m][k], acc[ai][bj][m][n], 0, 0, 0); __builtin_amdgcn_s_setprio(0); } while (0)
#define PG8_WAIT_V(n) asm volatile("s_waitcnt vmcnt(" #n ")" ::: "memory")
#define PG8_WAIT_L(n) asm volatile("s_waitcnt lgkmcnt(" #n ")" ::: "memory")
#define PG8_BAR __builtin_amdgcn_s_barrier()
#define PG8_SCHED __builtin_amdgcn_sched_barrier(0)
    Unit cur, nxt; int ui = 0;
    if (!S.next(0, cur)) return;
    f32x4 acc[2][2][4][2];
#pragma unroll
    for (int a = 0; a < 2; ++a)
#pragma unroll
        for (int b = 0; b < 2; ++b)
#pragma unroll
            for (int m = 0; m < 4; ++m)
#pragma unroll
                for (int n = 0; n < 2; ++n) acc[a][b][m][n] = (f32x4){0.f, 0.f, 0.f, 0.f};
    bf16x8 At[4][2], B0[2][2], B1[2][2];
    const char* cA = (const char*)g.A + (size_t)cur.pm * tstep; const char* cB = (const char*)g.Bt + (size_t)cur.pn * tstep;
    PG8_STAGE(PG8_SB(0, 0), cB, voffB); PG8_STAGE(PG8_SA(0, 0), cA, voffA); PG8_STAGE(PG8_SB(0, 1), cB + hstep, voffB); PG8_STAGE(PG8_SA(0, 1), cA + hstep, voffA);
    if (wr == 1) PG8_BAR;
    PG8_WAIT_V(4); PG8_BAR;
    PG8_STAGE(PG8_SB(1, 0), cB + kstep, voffB); PG8_STAGE(PG8_SA(1, 0), cA + kstep, voffA); PG8_STAGE(PG8_SB(1, 1), cB + hstep + kstep, voffB);
    PG8_WAIT_V(6); PG8_BAR;
    for (;;) {
        const bool has_next = S.next(ui + 1, nxt);
        const char* nA = has_next ? (const char*)g.A + (size_t)nxt.pm * tstep : cA; const char* nB = has_next ? (const char*)g.Bt + (size_t)nxt.pn * tstep : cB;
#pragma unroll 1
        for (int t = 0; t < nt; t += 2) {
            const bool last = (t == nt - 2);
            const char* a1 = cA + (size_t)(t + 1) * kstep;
            const char* a2 = last ? nA : cA + (size_t)(t + 2) * kstep; const char* b2 = last ? nB : cB + (size_t)(t + 2) * kstep;
            const char* a3 = a2 + kstep; const char* b3 = b2 + kstep;
            PG8_LDB(B0, 0, 0); PG8_SCHED; PG8_LDA(At, 0, 0); PG8_STAGE(PG8_SA(1, 1), a1 + hstep, voffA);
            PG8_WAIT_L(8); PG8_BAR; PG8_WAIT_L(0); PG8_MMA(0, 0, At, B0); PG8_BAR; PG8_SCHED;
            PG8_LDB(B1, 0, 1); PG8_STAGE(PG8_SB(0, 0), b2, voffB);
            PG8_BAR; PG8_WAIT_L(0); PG8_MMA(0, 1, At, B1); PG8_BAR;
            PG8_LDA(At, 0, 1); PG8_STAGE(PG8_SA(0, 0), a2, voffA);
            PG8_BAR; PG8_WAIT_L(0); PG8_MMA(1, 0, At, B0); PG8_BAR; PG8_SCHED;
            PG8_STAGE(PG8_SB(0, 1), b2 + hstep, voffB);
            PG8_WAIT_V(6); PG8_BAR; PG8_MMA(1, 1, At, B1); PG8_BAR;
            PG8_LDB(B0, 1, 0); PG8_SCHED; PG8_LDA(At, 1, 0); PG8_STAGE(PG8_SA(0, 1), a2 + hstep, voffA);
            PG8_WAIT_L(8); PG8_BAR; PG8_WAIT_L(0); PG8_MMA(0, 0, At, B0); PG8_BAR; PG8_SCHED;
            PG8_LDB(B1, 1, 1); PG8_STAGE(PG8_SB(1, 0), b3, voffB);
            PG8_BAR; PG8_WAIT_L(0); PG8_MMA(0, 1, At, B1); PG8_BAR;
            PG8_LDA(At, 1, 1); PG8_STAGE(PG8_SA(1, 0), a3, voffA);
            PG8_BAR; PG8_WAIT_L(0); PG8_MMA(1, 0, At, B0); PG8_BAR; PG8_SCHED;
            PG8_STAGE(PG8_SB(1, 1), b3 + hstep, voffB);
            PG8_WAIT_V(6); PG8_BAR; PG8_MMA(1, 1, At, B1); PG8_BAR;
        }
        E(acc, cur, wr, wc, fr, fq);
        if (!has_next) break;
#pragma unroll
        for (int a = 0; a < 2; ++a)
#pragma unroll
            for (int b = 0; b < 2; ++b)
#pragma unroll
                for (int m = 0; m < 4; ++m)
#pragma unroll
                    for (int n = 0; n < 2; ++n) acc[a][b][m][n] = (f32x4){0.f, 0.f, 0.f, 0.f};
        cur = nxt; cA = nA; cB = nB; ++ui;
    }
    PG8_WAIT_V(0);
    if (wr == 0) PG8_BAR;
    PG8_BAR;
#undef PG8_SA
#undef PG8_SB
#undef PG8_STAGE
#undef PG8_LDA
#undef PG8_LDB
#undef PG8_MMA
#undef PG8_WAIT_V
#undef PG8_WAIT_L
#undef PG8_BAR
#undef PG8_SCHED
}

struct EpiSwiGLU {
    static constexpr bool PERM = true;
    bf16_t* H; const float* SS;
    __device__ __forceinline__ void operator()(const f32x4 (&acc)[2][2][4][2], const Unit& u, int wr, int wc, int fr, int fq) const {
        const int row0 = u.pm * BM + wr * 64 + fr, col0 = u.pn * 128 + wc * 32 + 8 * fq;
#pragma unroll
        for (int ai = 0; ai < 2; ++ai)
#pragma unroll
            for (int m = 0; m < 4; ++m) {
                const float rs = __builtin_amdgcn_rsqf(SS[row0 + ai * HALF + m * 16] * (1.0f / D) + 1e-6f);
                float v[8];
#pragma unroll
                for (int n = 0; n < 2; ++n)
#pragma unroll
                    for (int j = 0; j < 4; ++j) { const float gt = acc[ai][0][m][n][j] * rs, up = acc[ai][1][m][n][j] * rs; v[4 * n + j] = siluf_(gt) * up; }
                *(u32x4*)(H + (size_t)(row0 + ai * HALF + m * 16) * FF + col0) = pack8(v);
            }
    }
};
template <bool HALFSTEP> struct EpiResidual {
    static constexpr bool PERM = false;
    static constexpr float scale = HALFSTEP ? 0.5f : 1.0f;
    const float* base; float* out; bf16_t* XN; float* SS;
    __device__ __forceinline__ void operator()(const f32x4 (&acc)[2][2][4][2], const Unit& u, int wr, int wc, int fr, int fq) const {
        const int row0 = u.pm * BM + wr * 64 + fr, col0 = u.pn * BM + wc * 32 + 4 * fq;
#pragma unroll
        for (int ai = 0; ai < 2; ++ai)
#pragma unroll
            for (int m = 0; m < 4; ++m) { const int row = row0 + ai * HALF + m * 16; const size_t ro = (size_t)row * D + col0; float ss = 0.f;
#pragma unroll
                for (int bj = 0; bj < 2; ++bj)
#pragma unroll
                    for (int n = 0; n < 2; ++n) { const f32x4 b = *(const f32x4*)(base + ro + bj * HALF + n * 16); const f32x4 r = b + acc[ai][bj][m][n] * scale; *(f32x4*)(out + ro + bj * HALF + n * 16) = r;
                        if (XN) { u32x2 w; w.x = pk2(r.x, r.y); w.y = pk2(r.z, r.w); *(u32x2*)(XN + ro + bj * HALF + n * 16) = w; ss += (r.x * r.x + r.y * r.y) + (r.z * r.z + r.w * r.w); } }
                if (XN) { ss += __shfl_xor(ss, 16); ss += __shfl_xor(ss, 32); if (fq == 0) atomicAdd(SS + row, ss); } }
    }
};
struct EpiBf16 {
    static constexpr bool PERM = true;
    bf16_t* O; int ldc; const float* SS;
    __device__ __forceinline__ void operator()(const f32x4 (&acc)[2][2][4][2], const Unit& u, int wr, int wc, int fr, int fq) const {
        const int row0 = u.pm * BM + wr * 64 + fr, col0 = u.pn * BM + wc * 32 + 8 * fq;
#pragma unroll
        for (int ai = 0; ai < 2; ++ai)
#pragma unroll
            for (int m = 0; m < 4; ++m) { bf16_t* rowp = O + (size_t)(row0 + ai * HALF + m * 16) * ldc + col0;
                const float rs = __builtin_amdgcn_rsqf(SS[row0 + ai * HALF + m * 16] * (1.0f / D) + 1e-6f);
#pragma unroll
                for (int bj = 0; bj < 2; ++bj) { const f32x4 v0 = acc[ai][bj][m][0] * rs, v1 = acc[ai][bj][m][1] * rs;
                    u32x4 w; w.x = pk2(v0[0], v0[1]); w.y = pk2(v0[2], v0[3]); w.z = pk2(v1[0], v1[1]); w.w = pk2(v1[2], v1[3]);
                    *(u32x4*)(rowp + bj * HALF) = w; } }
    }
};
struct EpiLR {
    static constexpr bool PERM = true;
    bf16_t* O; const float* w0; const float* a0;
    template <int KIND> __device__ __forceinline__ void body(const f32x4 (&acc)[2][2][4][2], const float* bp, int row0, int col0) const {
#pragma unroll
        for (int bj = 0; bj < 2; ++bj) {
            f32x4 b0 = (f32x4){0.f, 0.f, 0.f, 0.f}, b1 = b0;
            if (KIND < 2) { b0 = *(const f32x4*)(bp + bj * HALF); b1 = *(const f32x4*)(bp + bj * HALF + 4); }
#pragma unroll
            for (int ai = 0; ai < 2; ++ai)
#pragma unroll
                for (int m = 0; m < 4; ++m) {
                    u32x4 w;
#pragma unroll
                    for (int n = 0; n < 2; ++n) {
                        float r[4];
#pragma unroll
                        for (int j = 0; j < 4; ++j) { const float x = acc[ai][bj][m][n][j] + (n == 0 ? b0[j] : b1[j]);
                            if (KIND == 0) { const float e = __expf(-x); r[j] = -0.60653065971f * __builtin_amdgcn_rcpf(1.0f + e); }
                            else if (KIND == 1) r[j] = __builtin_amdgcn_rcpf(1.0f + __expf(-x)); else r[j] = x; }
                        if (n == 0) { w.x = pk2(r[0], r[1]); w.y = pk2(r[2], r[3]); } else { w.z = pk2(r[0], r[1]); w.w = pk2(r[2], r[3]); }
                    }
                    *(u32x4*)(O + (size_t)(row0 + ai * HALF + m * 16) * 1536 + col0 + bj * HALF) = w;
                }
        }
    }
    __device__ __forceinline__ void operator()(const f32x4 (&acc)[2][2][4][2], const Unit& u, int wr, int wc, int fr, int fq) const {
        const int row0 = u.pm * BM + wr * 64 + fr, col0 = u.pn * BM + wc * 32 + 8 * fq, kind = u.pn >> 1, f0 = col0 - 512 * kind;
        if (kind == 0) body<0>(acc, w0 + f0, row0, col0); else if (kind == 1) body<1>(acc, a0 + f0, row0, col0); else body<2>(acc, nullptr, row0, col0);
    }
};
struct EpiGLU {
    static constexpr bool PERM = true;
    const bf16_t* Z; bf16_t* Y; const float* b;
    __device__ __forceinline__ void operator()(const f32x4 (&acc)[2][2][4][2], const Unit& u, int wr, int wc, int fr, int fq) const {
        const int row0 = u.pm * BM + wr * 64 + fr, col0 = u.pn * BM + wc * 32 + 8 * fq;
#pragma unroll
        for (int bj = 0; bj < 2; ++bj) {
            const f32x4 bias0 = *(const f32x4*)(b + col0 + bj * HALF), bias1 = *(const f32x4*)(b + col0 + bj * HALF + 4);
#pragma unroll
            for (int ai = 0; ai < 2; ++ai)
#pragma unroll
                for (int m = 0; m < 4; ++m) { const size_t r = (size_t)(row0 + ai * HALF + m * 16);
                    float z[8], v[8]; unpack8(*(const u32x4*)(Z + r * 512 + col0 + bj * HALF), z);
#pragma unroll
                    for (int n = 0; n < 2; ++n)
#pragma unroll
                        for (int j = 0; j < 4; ++j) v[4 * n + j] = z[4 * n + j] * sigmoidf_(acc[ai][bj][m][n][j] + (n == 0 ? bias0[j] : bias1[j]));
                    *(u32x4*)(Y + r * D + 1024 + col0 + bj * HALF) = pack8(v); }
        }
    }
};
}

template <class Epi> __device__ __forceinline__ void run_gemm(LAS unsigned char* lds, const bf16_t* A, const bf16_t* Bt, int N, int K, const Epi E) {
    pg8::Gemm g; g.A = A; g.Bt = Bt; g.M = T; g.N = N; g.K = K;
    pg8::StaticOrder S; S.init(T, N, gridDim.x, opaque_bid());
    pg8::gemm_phase<Epi>(lds, g, S, E);
}

__device__ __forceinline__ void tr_item(const float* W, int ldw, int k0, int n0, const float* gs, bf16_t* Dst, int ldd, int drow0, int dk0, LAS float* scr, int lane) {
    if (W) {
        f32x4 v[8];
#pragma unroll
        for (int i = 0; i < 8; ++i) { const int kk = 8 * i + (lane >> 3); v[i] = *(const f32x4*)(W + (size_t)(k0 + kk) * ldw + n0 + 4 * (lane & 7)); }
#pragma unroll
        for (int i = 0; i < 8; ++i) { const int kk = 8 * i + (lane >> 3); f32x4 x = v[i]; if (gs) x = x * gs[k0 + kk];
            LAS float* d = scr + kk * 33 + 4 * (lane & 7); d[0] = x.x; d[1] = x.y; d[2] = x.z; d[3] = x.w; }
    } else {
#pragma unroll 8
        for (int i = 0; i < 32; ++i) { const int kk = 2 * i + (lane >> 5); scr[kk * 33 + (lane & 31)] = 0.f; }
    }
    LDS_FENCE();
    const int c = lane & 7;
#pragma unroll
    for (int j = 0; j < 4; ++j) { const int n = (lane >> 3) + 8 * j; const LAS float* s = scr + (8 * c) * 33 + n;
        u32x4 o; o.x = pk2(s[0 * 33], s[1 * 33]); o.y = pk2(s[2 * 33], s[3 * 33]); o.z = pk2(s[4 * 33], s[5 * 33]); o.w = pk2(s[6 * 33], s[7 * 33]);
        *(u32x4*)(Dst + (size_t)(drow0 + n) * ldd + dk0 + k0 - 0 + 8 * c - 0) = o; }
    LDS_FENCE();
}

__device__ __forceinline__ void conv_phase(ArgsRef a, int l, LAS unsigned char* lds) {
    const int TID = opaque_tid(), BID = opaque_bid(); (void)TID; (void)BID;
    const int wave = TID >> 6, lane = TID & 63;
    LAS float* scr = (LAS float*)(lds + wave * 8704);
    const int gw = BID * NWAVES + wave, NGW = gridDim.x * NWAVES;
    unsigned char* ws = a.ws;
    constexpr int I_GU = (D / 64) * (FF / 32), I_DN = (FF / 64) * (D / 32), I_IN = (D / 64) * (DIN / 32), I_OUT = (D / 64) * (D / 32), I_GLU = 8 * 16, I_LR = 48 * 4;
    constexpr int NITEMS = 6 * I_GU + I_IN + I_OUT + I_GLU + I_LR;
    static_assert(I_GU == I_DN, "items");
    for (int it = gw; it < NITEMS; it += NGW) {
        int r = it;
        if (r < 6 * I_GU) {
            const int which = r / I_GU; r -= which * I_GU;
            const int f = which >= 3, m = which % 3;
            if (m < 2) {
                const float* W = (const float*)a.in[(f ? 36 : 3) + m] + (size_t)l * D * FF;
                const float* gs = (const float*)a.in[f ? 35 : 2] + (size_t)l * D;
                bf16_t* dst = (bf16_t*)(ws + (f ? W_UP2 : W_UP1));
                const int nblk = FF / 32, kb = r / nblk, nb = r % nblk, n0 = 32 * nb;
                tr_item(W, FF, 64 * kb, n0, gs, dst, D, (n0 >> 7) * 256 + (n0 & 127) + 128 * m, 0, scr, lane);
            } else {
                const float* W = (const float*)a.in[f ? 38 : 5] + (size_t)l * FF * D;
                bf16_t* dst = (bf16_t*)(ws + (f ? W_DN2 : W_DN1));
                const int nblk = D / 32, kb = r / nblk, nb = r % nblk;
                tr_item(W, D, 64 * kb, 32 * nb, nullptr, dst, FF, 32 * nb, 0, scr, lane);
            }
            continue;
        }
        r -= 6 * I_GU;
        if (r < I_IN) { const int nblk = DIN / 32, kb = r / nblk, nb = r % nblk;
            tr_item((const float*)a.in[7] + (size_t)l * D * DIN, DIN, 64 * kb, 32 * nb, (const float*)a.in[6] + (size_t)l * D, (bf16_t*)(ws + W_IN), D, 32 * nb, 0, scr, lane); continue; }
        r -= I_IN;
        if (r < I_OUT) { const int nblk = D / 32, kb = r / nblk, nb = r % nblk;
            tr_item((const float*)a.in[34] + (size_t)l * D * D, D, 64 * kb, 32 * nb, nullptr, (bf16_t*)(ws + W_OUT), D, 32 * nb, 0, scr, lane); continue; }
        r -= I_OUT;
        if (r < I_GLU) { const int kb = r / 16, nb = r % 16;
            tr_item((const float*)a.in[30] + (size_t)l * 512 * 512, 512, 64 * kb, 32 * nb, nullptr, (bf16_t*)(ws + W_GLU), 512, 32 * nb, 0, scr, lane); continue; }
        r -= I_GLU;
        {
            const int nb = r >> 2, kb = r & 3, kind = nb >> 4, nn0 = 32 * (nb & 15);
            const float* W = nullptr; int k0 = 0;
            if (kind == 0 && kb == 0) { W = (const float*)a.in[10] + (size_t)l * 64 * 512; k0 = 0; }
            else if (kind == 1 && kb == 1) { W = (const float*)a.in[12] + (size_t)l * 64 * 512; k0 = 0; }
            else if (kind == 2 && kb >= 2) { W = (const float*)a.in[13] + (size_t)l * 128 * 512; k0 = 64 * (kb - 2); }
            tr_item(W, 512, k0, nn0, nullptr, (bf16_t*)(ws + W_LR), 256, 32 * nb, 64 * kb - k0, scr, lane);
        }
    }
}

__device__ __forceinline__ void norm_phase(const float* x, bf16_t* XN, float* SS) {
    const int TID = opaque_tid(), BID = opaque_bid(); (void)TID; (void)BID;
    const int wave = TID >> 6, lane = TID & 63;
    const int gw = BID * NWAVES + wave, NGW = gridDim.x * NWAVES;
    for (int m = gw; m < T; m += NGW) {
        const f32x4* xr = (const f32x4*)(x + (size_t)m * D) + lane;
        f32x4 v[8]; float s = 0.f;
#pragma unroll
        for (int j = 0; j < 8; ++j) { v[j] = xr[64 * j]; s += (v[j].x * v[j].x + v[j].y * v[j].y) + (v[j].z * v[j].z + v[j].w * v[j].w); }
        s = wave_sum(s); if (lane == 0) SS[m] = s;
        u32x2* o = (u32x2*)(XN + (size_t)m * D) + lane;
#pragma unroll
        for (int j = 0; j < 8; ++j) { u32x2 w; w.x = pk2(v[j].x, v[j].y); w.y = pk2(v[j].z, v[j].w); o[64 * j] = w; }
    }
}

__device__ __forceinline__ void zero_phase(float* p, int n) {
    const int TID = opaque_tid(), BID = opaque_bid();
    for (int i = BID * NTHREADS + TID; i < n; i += gridDim.x * NTHREADS) p[i] = 0.f;
}
__device__ __forceinline__ void alr_phase(ArgsRef a, int l) {
    const int TID = opaque_tid(), BID = opaque_bid(); (void)TID; (void)BID;
    const bf16_t* P = (const bf16_t*)(a.ws + WS_PROJ); bf16_t* ALR = (bf16_t*)(a.ws + WS_ALR);
    const float* mu = (const float*)a.in[8] + (size_t)l * 1792 + 1536;
    const int gt = BID * NTHREADS + TID, NGT = gridDim.x * NTHREADS;
    for (int it = gt; it < T * 32; it += NGT) {
        const int t = it >> 5, cg = it & 31, c0 = 8 * cg;
        float cur[8], prv[8], o[8];
        unpack8(*(const u32x4*)(P + (size_t)t * DIN + 1536 + c0), cur);
        if ((t & (SEQ - 1)) != 0) unpack8(*(const u32x4*)(P + (size_t)(t - 1) * DIN + 1536 + c0), prv);
        else {
#pragma unroll
            for (int j = 0; j < 8; ++j) prv[j] = 0.f; }
#pragma unroll
        for (int j = 0; j < 8; ++j) { const float v = cur[j] + (prv[j] - cur[j]) * mu[c0 + j];
            o[j] = c0 < 64 ? tanhf(v) : (c0 < 128 ? v : sigmoidf_(v)); }
        *(u32x4*)(ALR + (size_t)t * 256 + c0) = pack8(o);
    }
}

__device__ __forceinline__ void rwkv_full(ArgsRef a, int l, LAS unsigned char* lds, int job, int tid) {
    const bf16_t* P = (const bf16_t*)(a.ws + WS_PROJ); const bf16_t* LR = (const bf16_t*)(a.ws + WS_LRO); bf16_t* Y = (bf16_t*)(a.ws + WS_YC);
    LAS float* sR = (LAS float*)lds; LAS float* sW = sR + 4096; LAS float* sK = sW + 4096; LAS float* sKK = sK + 4096; LAS float* sB = sKK + 4096;
    LAS float* sV = sB + 4096; LAS float* sO = sV + 4096; LAS float* sBon = sO + 4096;
    const int wave = tid >> 6, lane = tid & 63, tt = tid >> 3, cg = tid & 7;
    const int b = job >> 3, h = job & 7, c0 = 64 * h + 8 * cg;
    float mur[8], muk[8], muv[8], kkw[8], kaw[8], rkw[8], lnw[8], lnb[8];
#pragma unroll
    for (int j = 0; j < 8; ++j) {
        mur[j] = ((const float*)a.in[8])[(size_t)l * 1792 + c0 + j]; muk[j] = ((const float*)a.in[8])[(size_t)l * 1792 + 512 + c0 + j]; muv[j] = ((const float*)a.in[8])[(size_t)l * 1792 + 1024 + c0 + j];
        kkw[j] = ((const float*)a.in[14])[(size_t)l * 512 + c0 + j]; kaw[j] = ((const float*)a.in[15])[(size_t)l * 512 + c0 + j]; rkw[j] = ((const float*)a.in[16])[(size_t)l * 512 + c0 + j];
        lnw[j] = ((const float*)a.in[17])[(size_t)l * 512 + c0 + j]; lnb[j] = ((const float*)a.in[18])[(size_t)l * 512 + c0 + j]; }
    f32x2 st0 = (f32x2){0.f, 0.f}, st1 = st0, st2 = st0, st3 = st0;
    const int row = 8 * wave + (lane >> 3), jq = lane & 7;
    u32x4 graw[9];
    const u32x4 zero4 = (u32x4){0u, 0u, 0u, 0u};
#define RWF_ISSUE(ch_) do { const int s_ = (ch_) * 64 + tt; const size_t t_ = (size_t)b * SEQ + s_; \
        graw[0] = *(const u32x4*)(P + t_ * DIN + c0); graw[1] = *(const u32x4*)(P + t_ * DIN + 512 + c0); graw[2] = *(const u32x4*)(P + t_ * DIN + 1024 + c0); \
        if (s_ != 0) { graw[3] = *(const u32x4*)(P + (t_ - 1) * DIN + c0); graw[4] = *(const u32x4*)(P + (t_ - 1) * DIN + 512 + c0); graw[5] = *(const u32x4*)(P + (t_ - 1) * DIN + 1024 + c0); } \
        else { graw[3] = zero4; graw[4] = zero4; graw[5] = zero4; } \
        graw[6] = *(const u32x4*)(LR + t_ * 1536 + c0); graw[7] = *(const u32x4*)(LR + t_ * 1536 + 512 + c0); graw[8] = *(const u32x4*)(LR + t_ * 1536 + 1024 + c0); } while (0)
    RWF_ISSUE(0);
    for (int ch = 0; ch < SEQ / 64; ++ch) {
        __syncthreads();
        float gate[8];
        {
            float r[8], k[8], v[8], pr[8], ld[8], av[8];
            unpack8(graw[0], r); unpack8(graw[1], k); unpack8(graw[2], v);
            unpack8(graw[3], pr);
#pragma unroll
            for (int j = 0; j < 8; ++j) r[j] += (pr[j] - r[j]) * mur[j];
            unpack8(graw[4], pr);
#pragma unroll
            for (int j = 0; j < 8; ++j) k[j] += (pr[j] - k[j]) * muk[j];
            unpack8(graw[5], pr);
#pragma unroll
            for (int j = 0; j < 8; ++j) v[j] += (pr[j] - v[j]) * muv[j];
            unpack8(graw[6], ld); unpack8(graw[7], av); unpack8(graw[8], gate);
            if (ch + 1 < SEQ / 64) RWF_ISSUE(ch + 1);
            float kk[8], ss = 0.f, bp = 0.f;
#pragma unroll
            for (int j = 0; j < 8; ++j) { kk[j] = k[j] * kkw[j]; ss += kk[j] * kk[j]; }
            ss = red8(ss);
            const float inv = __builtin_amdgcn_rsqf(fmaxf(ss, 1e-24f));
            float w8[8], k8[8], b8[8];
#pragma unroll
            for (int j = 0; j < 8; ++j) { kk[j] *= inv; k8[j] = k[j] * (1.0f + (av[j] - 1.0f) * kaw[j]); b8[j] = kk[j] * av[j]; w8[j] = __expf(ld[j]); bp += r[j] * k8[j] * rkw[j]; }
            bp = red8(bp);
            if (cg == 0) sBon[tt] = bp;
            LAS float* d;
            d = sR + tt * 64 + 8 * cg; *(LAS f32x4*)d = (f32x4){r[0], r[1], r[2], r[3]}; *(LAS f32x4*)(d + 4) = (f32x4){r[4], r[5], r[6], r[7]};
            d = sW + tt * 64 + 8 * cg; *(LAS f32x4*)d = (f32x4){w8[0], w8[1], w8[2], w8[3]}; *(LAS f32x4*)(d + 4) = (f32x4){w8[4], w8[5], w8[6], w8[7]};
            d = sK + tt * 64 + 8 * cg; *(LAS f32x4*)d = (f32x4){k8[0], k8[1], k8[2], k8[3]}; *(LAS f32x4*)(d + 4) = (f32x4){k8[4], k8[5], k8[6], k8[7]};
            d = sKK + tt * 64 + 8 * cg; *(LAS f32x4*)d = (f32x4){kk[0], kk[1], kk[2], kk[3]}; *(LAS f32x4*)(d + 4) = (f32x4){kk[4], kk[5], kk[6], kk[7]};
            d = sB + tt * 64 + 8 * cg; *(LAS f32x4*)d = (f32x4){b8[0], b8[1], b8[2], b8[3]}; *(LAS f32x4*)(d + 4) = (f32x4){b8[4], b8[5], b8[6], b8[7]};
            d = sV + tt * 64 + 8 * cg; *(LAS f32x4*)d = (f32x4){v[0], v[1], v[2], v[3]}; *(LAS f32x4*)(d + 4) = (f32x4){v[4], v[5], v[6], v[7]};
        }
        __syncthreads();
        {
#define RWF_LD(arr, s_) const f32x4 arr##a = *(const LAS f32x4*)(arr + (s_) * 64 + 8 * jq), arr##b = *(const LAS f32x4*)(arr + (s_) * 64 + 8 * jq + 4)
            f32x4 w_a = *(const LAS f32x4*)(sW + 8 * jq), w_b = *(const LAS f32x4*)(sW + 8 * jq + 4), kk_a = *(const LAS f32x4*)(sKK + 8 * jq), kk_b = *(const LAS f32x4*)(sKK + 8 * jq + 4),
                  b_a = *(const LAS f32x4*)(sB + 8 * jq), b_b = *(const LAS f32x4*)(sB + 8 * jq + 4), k_a = *(const LAS f32x4*)(sK + 8 * jq), k_b = *(const LAS f32x4*)(sK + 8 * jq + 4),
                  r_a = *(const LAS f32x4*)(sR + 8 * jq), r_b = *(const LAS f32x4*)(sR + 8 * jq + 4);
            float vi = sV[row];
            f32x2 pyp = (f32x2){0.f, 0.f}; float ykeep = 0.f;
#pragma unroll 1
            for (int s8 = 0; s8 < 64; s8 += 8) {
#pragma unroll
                for (int u = 0; u < 8; ++u) {
                    const int sn = (s8 + u + 1) & 63;
                    RWF_LD(sW, sn); RWF_LD(sKK, sn); RWF_LD(sB, sn); RWF_LD(sK, sn); RWF_LD(sR, sn);
                    const float nvi = sV[sn * 64 + row];
                    f32x2 pa = st0 * (f32x2){kk_a.x, kk_a.y}; pa = pfma(st1, (f32x2){kk_a.z, kk_a.w}, pa); pa = pfma(st2, (f32x2){kk_b.x, kk_b.y}, pa); pa = pfma(st3, (f32x2){kk_b.z, kk_b.w}, pa);
                    float av = pa.x + pa.y, yv = pyp.x + pyp.y;
                    av += dpp<XOR1>(av); yv += dpp<XOR1>(yv); av += dpp<XOR2>(av); yv += dpp<XOR2>(yv); av += dpp<XOR7>(av); yv += dpp<XOR7>(yv);
                    if (u > 0) ykeep = (jq == u - 1) ? yv : ykeep;
                    else if (s8 > 0) { ykeep = (jq == 7) ? yv : ykeep; sO[(s8 - 8 + jq) * 64 + row] = ykeep; }
                    const float sa = -av;
                    const f32x2 sa2 = (f32x2){sa, sa}, vi2 = (f32x2){vi, vi};
                    st0 = pfma(st0, (f32x2){w_a.x, w_a.y}, pfma(vi2, (f32x2){k_a.x, k_a.y}, sa2 * (f32x2){b_a.x, b_a.y}));
                    st1 = pfma(st1, (f32x2){w_a.z, w_a.w}, pfma(vi2, (f32x2){k_a.z, k_a.w}, sa2 * (f32x2){b_a.z, b_a.w}));
                    st2 = pfma(st2, (f32x2){w_b.x, w_b.y}, pfma(vi2, (f32x2){k_b.x, k_b.y}, sa2 * (f32x2){b_b.x, b_b.y}));
                    st3 = pfma(st3, (f32x2){w_b.z, w_b.w}, pfma(vi2, (f32x2){k_b.z, k_b.w}, sa2 * (f32x2){b_b.z, b_b.w}));
                    pyp = st0 * (f32x2){r_a.x, r_a.y}; pyp = pfma(st1, (f32x2){r_a.z, r_a.w}, pyp); pyp = pfma(st2, (f32x2){r_b.x, r_b.y}, pyp); pyp = pfma(st3, (f32x2){r_b.z, r_b.w}, pyp);
                    w_a = sWa; w_b = sWb; kk_a = sKKa; kk_b = sKKb; b_a = sBa; b_b = sBb; k_a = sKa; k_b = sKb; r_a = sRa; r_b = sRb; vi = nvi;
                }
            }
            const float yv = red8(pyp.x + pyp.y);
            ykeep = (jq == 7) ? yv : ykeep; sO[(56 + jq) * 64 + row] = ykeep;
#undef RWF_LD
        }
        __syncthreads();
        {
            const size_t t = (size_t)b * SEQ + ch * 64 + tt;
            const f32x4 o0 = *(const LAS f32x4*)(sO + tt * 64 + 8 * cg), o1 = *(const LAS f32x4*)(sO + tt * 64 + 8 * cg + 4);
            const f32x4 v0 = *(const LAS f32x4*)(sV + tt * 64 + 8 * cg), v1 = *(const LAS f32x4*)(sV + tt * 64 + 8 * cg + 4);
            float o[8] = {o0.x, o0.y, o0.z, o0.w, o1.x, o1.y, o1.z, o1.w}; const float vv[8] = {v0.x, v0.y, v0.z, v0.w, v1.x, v1.y, v1.z, v1.w};
            float sm = 0.f;
#pragma unroll
            for (int j = 0; j < 8; ++j) sm += o[j];
            const float mean = red8(sm) * (1.0f / 64.0f);
            float q = 0.f;
#pragma unroll
            for (int j = 0; j < 8; ++j) { o[j] -= mean; q += o[j] * o[j]; }
            const float rstd = __builtin_amdgcn_rsqf(red8(q) * (1.0f / 64.0f) + 64e-5f);
            const float bon = sBon[tt];
            float y[8];
#pragma unroll
            for (int j = 0; j < 8; ++j) y[j] = (o[j] * rstd * lnw[j] + lnb[j] + bon * vv[j]) * gate[j];
            *(u32x4*)(Y + t * D + c0) = pack8(y);
        }
    }
#undef RWF_ISSUE
}

__device__ __forceinline__ void hgrn_full(ArgsRef a, int l, LAS unsigned char* lds, int job, int tid) {
    const bf16_t* P = (const bf16_t*)(a.ws + WS_PROJ); bf16_t* Y = (bf16_t*)(a.ws + WS_YC);
    LAS float* sQ = (LAS float*)lds; LAS float* sF = sQ + 4096; LAS float* sV = sF + 4096; LAS float* sO = sV + 4096;
    const int wave = tid >> 6, lane = tid & 63, tt = tid >> 3, cg = tid & 7;
    const float* lbp = (const float*)a.in[32];
    const int b = job >> 3, h = job & 7, c0 = 64 * h + 8 * cg;
    float lb[8], gn[8];
#pragma unroll
    for (int j = 0; j < 8; ++j) { lb[j] = (l == 0) ? 0.f : sigmoidf_(lbp[512 + c0 + j] - lbp[c0 + j]); gn[j] = ((const float*)a.in[33])[(size_t)l * 64 + 8 * cg + j]; }
    f32x2 st0 = (f32x2){0.f, 0.f}, st1 = st0, st2 = st0, st3 = st0;
    const int col = 8 * wave + (lane >> 3), dq = lane & 7;
    u32x4 gq, gf, gv, gg;
#define HGF_ISSUE(ch_) do { const size_t t_ = (size_t)b * SEQ + (ch_) * 64 + tt; gq = *(const u32x4*)(P + t_ * DIN + C_HG + c0); gf = *(const u32x4*)(P + t_ * DIN + C_HG + 512 + c0); \
        gv = *(const u32x4*)(P + t_ * DIN + C_HG + 1024 + c0); gg = *(const u32x4*)(P + t_ * DIN + C_HG + 1536 + c0); } while (0)
    HGF_ISSUE(0);
    for (int ch = 0; ch < SEQ / 64; ++ch) {
        __syncthreads();
        float gate[8];
        {
            float q[8], f[8], v[8];
            unpack8(gq, q); unpack8(gf, f); unpack8(gv, v); unpack8(gg, gate);
            if (ch + 1 < SEQ / 64) HGF_ISSUE(ch + 1);
#pragma unroll
            for (int j = 0; j < 8; ++j) { q[j] = siluf_(q[j]) * 0.125f; f[j] = lb[j] + (1.0f - lb[j]) * sigmoidf_(f[j]); }
            LAS float* d;
            d = sQ + tt * 64 + 8 * cg; *(LAS f32x4*)d = (f32x4){q[0], q[1], q[2], q[3]}; *(LAS f32x4*)(d + 4) = (f32x4){q[4], q[5], q[6], q[7]};
            d = sF + tt * 64 + 8 * cg; *(LAS f32x4*)d = (f32x4){f[0], f[1], f[2], f[3]}; *(LAS f32x4*)(d + 4) = (f32x4){f[4], f[5], f[6], f[7]};
            d = sV + tt * 64 + 8 * cg; *(LAS f32x4*)d = (f32x4){v[0], v[1], v[2], v[3]}; *(LAS f32x4*)(d + 4) = (f32x4){v[4], v[5], v[6], v[7]};
        }
        __syncthreads();
        {
            f32x4 f_a = *(const LAS f32x4*)(sF + 8 * dq), f_b = *(const LAS f32x4*)(sF + 8 * dq + 4), q_a = *(const LAS f32x4*)(sQ + 8 * dq), q_b = *(const LAS f32x4*)(sQ + 8 * dq + 4);
            float vi = sV[col];
            float ykeep = 0.f;
#pragma unroll 1
            for (int s8 = 0; s8 < 64; s8 += 8) {
#pragma unroll
                for (int u = 0; u < 8; ++u) {
                    const int sn = (s8 + u + 1) & 63;
                    const f32x4 nf_a = *(const LAS f32x4*)(sF + sn * 64 + 8 * dq), nf_b = *(const LAS f32x4*)(sF + sn * 64 + 8 * dq + 4),
                                nq_a = *(const LAS f32x4*)(sQ + sn * 64 + 8 * dq), nq_b = *(const LAS f32x4*)(sQ + sn * 64 + 8 * dq + 4);
                    const float nvi = sV[sn * 64 + col];
                    const f32x2 vi2 = (f32x2){vi, vi};
                    st0 = pfma((f32x2){f_a.x, f_a.y}, st0 - vi2, vi2); st1 = pfma((f32x2){f_a.z, f_a.w}, st1 - vi2, vi2);
                    st2 = pfma((f32x2){f_b.x, f_b.y}, st2 - vi2, vi2); st3 = pfma((f32x2){f_b.z, f_b.w}, st3 - vi2, vi2);
                    f32x2 py = st0 * (f32x2){q_a.x, q_a.y}; py = pfma(st1, (f32x2){q_a.z, q_a.w}, py); py = pfma(st2, (f32x2){q_b.x, q_b.y}, py); py = pfma(st3, (f32x2){q_b.z, q_b.w}, py);
                    const float y = red8(py.x + py.y);
                    ykeep = (dq == u) ? y : ykeep;
                    f_a = nf_a; f_b = nf_b; q_a = nq_a; q_b = nq_b; vi = nvi;
                }
                sO[(s8 + dq) * 64 + col] = ykeep;
            }
        }
        __syncthreads();
        {
            const size_t t = (size_t)b * SEQ + ch * 64 + tt;
            const f32x4 o0 = *(const LAS f32x4*)(sO + tt * 64 + 8 * cg), o1 = *(const LAS f32x4*)(sO + tt * 64 + 8 * cg + 4);
            const float o[8] = {o0.x, o0.y, o0.z, o0.w, o1.x, o1.y, o1.z, o1.w};
            float q = 0.f;
#pragma unroll
            for (int j = 0; j < 8; ++j) q += o[j] * o[j];
            const float rs = __builtin_amdgcn_rsqf(red8(q) * (1.0f / 64.0f) + 1e-6f);
            float y[8];
#pragma unroll
            for (int j = 0; j < 8; ++j) y[j] = o[j] * rs * gn[j] * siluf_(gate[j]);
            *(u32x4*)(Y + t * D + 1536 + c0) = pack8(y);
        }
    }
#undef HGF_ISSUE
}

__device__ __forceinline__ void attn_phase(ArgsRef a, int l, LAS unsigned char* lds) {
    const int TID = opaque_tid(), BID = opaque_bid();
    const bf16_t* P = (const bf16_t*)(a.ws + WS_PROJ); bf16_t* Y = (bf16_t*)(a.ws + WS_YC);
    const int* pos = (const int*)a.in[1];
    const float* qn = (const float*)a.in[19] + (size_t)l * 64; const float* kn = (const float*)a.in[20] + (size_t)l * 64; const float* sinks = (const float*)a.in[21] + (size_t)l * 8;
    constexpr int KST = 144, VST = 528;
    LAS unsigned char* sK = lds; LAS unsigned char* sVt = sK + 256 * KST; LAS unsigned char* sQ = sVt + 64 * VST; LAS float* sM = (LAS float*)(sQ + 512 * KST);
    const int tid = TID, cg = tid & 7, wave = tid >> 6, lane = tid & 63;
    float kmaxg = 0.f;
    for (int j = 0; j < 64; ++j) kmaxg = fmaxf(kmaxg, fabsf(kn[j]));
    const float kbound = 8.0f * kmaxg;
    float gk[8], gq[8], invf[8];
#pragma unroll
    for (int j = 0; j < 8; ++j) { gk[j] = kn[8 * cg + j]; gq[j] = qn[8 * cg + j]; invf[j] = exp2f(-(float)j * (18.931568569324174f / 8.0f)); }
    for (int job = BID; job < 512; job += gridDim.x) {
        const int b = job >> 5, nb = (job >> 1) & 15, kvh = job & 1;
        __syncthreads();
#pragma unroll 1
        for (int r = 0; r < 4; ++r) {
            const int kj = (tid >> 3) + 64 * r, s = (nb - 1) * 128 + kj;
            float k[8], v[8];
            if (s >= 0) {
                const size_t t = (size_t)b * SEQ + s;
                unpack8(*(const u32x4*)(P + t * DIN + C_ATT + 512 + 64 * kvh + 8 * cg), k); unpack8(*(const u32x4*)(P + t * DIN + C_ATT + 640 + 64 * kvh + 8 * cg), v);
            } else {
#pragma unroll
                for (int j = 0; j < 8; ++j) { k[j] = 0.f; v[j] = 0.f; } }
            float ss = 0.f;
#pragma unroll
            for (int j = 0; j < 8; ++j) ss += k[j] * k[j];
            ss = red8(ss);
            const float rs = __builtin_amdgcn_rsqf(ss * (1.0f / 64.0f) + 1e-6f);
#pragma unroll
            for (int j = 0; j < 8; ++j) k[j] = k[j] * rs * gk[j];
            const float pf = (float)pos[b * SEQ + (s >= 0 ? s : 0)];
#pragma unroll
            for (int j = 0; j < 8; ++j) {
                const float other = dpp<XOR1>(k[j]);
                if (cg < 2) { float sn, cs; sincos_big(pf * invf[j], sn, cs); k[j] = (cg == 0) ? (k[j] * cs - other * sn) : (k[j] * cs + other * sn); }
            }
            *(LAS u32x4*)(sK + kj * KST + 16 * cg) = pack8(k);
#pragma unroll
            for (int j = 0; j < 8; j += 2) { const unsigned w = pk2(v[j], v[j + 1]);
                *(LAS unsigned short*)(sVt + (8 * cg + j) * VST + 2 * kj) = (unsigned short)(w & 0xffffu); *(LAS unsigned short*)(sVt + (8 * cg + j + 1) * VST + 2 * kj) = (unsigned short)(w >> 16); }
        }
#pragma unroll 1
        for (int r = 0; r < 8; ++r) {
            const int row = (tid >> 3) + 64 * r, g = row >> 7, qi = row & 127, hq = 4 * kvh + g;
            const size_t tq = (size_t)b * SEQ + nb * 128 + qi;
            float q[8];
            unpack8(*(const u32x4*)(P + tq * DIN + C_ATT + 64 * hq + 8 * cg), q);
            float ss = 0.f;
#pragma unroll
            for (int j = 0; j < 8; ++j) ss += q[j] * q[j];
            ss = red8(ss);
            const float rs = 0.125f * __builtin_amdgcn_rsqf(ss * (1.0f / 64.0f) + 1e-6f);
#pragma unroll
            for (int j = 0; j < 8; ++j) q[j] = q[j] * rs * gq[j];
            const float pf = (float)pos[b * SEQ + nb * 128 + qi];
            float qq = 0.f;
#pragma unroll
            for (int j = 0; j < 8; ++j) {
                const float other = dpp<XOR1>(q[j]);
                if (cg < 2) { float sn, cs; sincos_big(pf * invf[j], sn, cs); q[j] = (cg == 0) ? (q[j] * cs - other * sn) : (q[j] * cs + other * sn); }
                qq += q[j] * q[j];
            }
            qq = red8(qq);
            if (cg == 0) sM[row] = sqrtf(qq) * kbound;
            *(LAS u32x4*)(sQ + row * KST + 16 * cg) = pack8(q);
        }
        __syncthreads();
        const int g = wave >> 1, qh = wave & 1, hq = 4 * kvh + g, fr = lane & 15, fq = lane >> 4;
        const float sinkv = sinks[hq];
#pragma unroll 1
        for (int qt = 0; qt < 4; ++qt) {
            const int qi0 = 64 * qh + 16 * qt, R0 = g * 128 + qi0, kt0 = qi0 >> 4;
            const bf16x8 qf0 = *(const LAS bf16x8*)(sQ + (R0 + fr) * KST + 16 * fq), qf1 = *(const LAS bf16x8*)(sQ + (R0 + fr) * KST + 16 * fq + 64);
            const float msh = sM[R0 + fr];
            const int ql = qi0 + fr;
            f32x4 oacc[4];
#pragma unroll
            for (int dt = 0; dt < 4; ++dt) oacc[dt] = (f32x4){0.f, 0.f, 0.f, 0.f};
            float lsum = 0.f;
#pragma unroll
            for (int ks = 0; ks < 5; ++ks) {
                unsigned pw[4];
#pragma unroll
                for (int h2 = 0; h2 < 2; ++h2) {
                    const int ti = 2 * ks + h2, kt = (kt0 + ti) < 15 ? (kt0 + ti) : 15;
                    const bf16x8 kf0 = *(const LAS bf16x8*)(sK + (16 * kt + fr) * KST + 16 * fq), kf1 = *(const LAS bf16x8*)(sK + (16 * kt + fr) * KST + 16 * fq + 64);
                    f32x4 sc = (f32x4){0.f, 0.f, 0.f, 0.f};
                    sc = __builtin_amdgcn_mfma_f32_16x16x32_bf16(kf0, qf0, sc, 0, 0, 0);
                    sc = __builtin_amdgcn_mfma_f32_16x16x32_bf16(kf1, qf1, sc, 0, 0, 0);
                    float p[4];
#pragma unroll
                    for (int j = 0; j < 4; ++j) { const int kj = 16 * (kt0 + ti) + 4 * fq + j;
                        const bool valid = (kj > ql) && (kj <= ql + 128) && (nb > 0 || kj >= 128);
                        p[j] = valid ? __expf(sc[j] - msh) : 0.f; lsum += p[j]; }
                    pw[2 * h2] = pk2(p[0], p[1]); pw[2 * h2 + 1] = pk2(p[2], p[3]);
                }
                const u32x4 pq = (u32x4){pw[0], pw[1], pw[2], pw[3]};
                const bf16x8 pf = __builtin_bit_cast(bf16x8, pq);
                const int kta = (kt0 + 2 * ks) < 15 ? (kt0 + 2 * ks) : 15, ktb = (kt0 + 2 * ks + 1) < 15 ? (kt0 + 2 * ks + 1) : 15;
#pragma unroll
                for (int dt = 0; dt < 4; ++dt) {
                    const u32x2 va = *(const LAS u32x2*)(sVt + (16 * dt + fr) * VST + (16 * kta + 4 * fq) * 2), vb = *(const LAS u32x2*)(sVt + (16 * dt + fr) * VST + (16 * ktb + 4 * fq) * 2);
                    const u32x4 vq = (u32x4){va.x, va.y, vb.x, vb.y};
                    oacc[dt] = __builtin_amdgcn_mfma_f32_16x16x32_bf16(__builtin_bit_cast(bf16x8, vq), pf, oacc[dt], 0, 0, 0);
                }
            }
            lsum += __shfl_xor(lsum, 16); lsum += __shfl_xor(lsum, 32);
            const float inv = __builtin_amdgcn_rcpf(lsum + __expf(sinkv - msh));
            const size_t tq = (size_t)b * SEQ + nb * 128 + ql;
#pragma unroll
            for (int dt = 0; dt < 4; ++dt) { u32x2 w; w.x = pk2(oacc[dt][0] * inv, oacc[dt][1] * inv); w.y = pk2(oacc[dt][2] * inv, oacc[dt][3] * inv);
                *(u32x2*)(Y + tq * D + 512 + 64 * hq + 16 * dt + 4 * fq) = w; }
        }
    }
    __syncthreads();
}

__device__ __forceinline__ float gelu_erf(float v) {
    const float t = __builtin_amdgcn_rcpf(fabsf(v) * 0.2316418882f + 1.0f);
    float q = t * 0.5307027145f + (-0.7265760135f); q = q * t + 0.7107068705f; q = q * t + (-0.142248368f); q = q * t + 0.127414796f; q = q * t;
    const float e = __builtin_amdgcn_exp2f(v * v * (-0.72134752044f));
    const float m = v * (q * e);
    return v < 0.f ? m : v - m;
}
__device__ __forceinline__ void s5_jobs(ArgsRef a, int l, LAS unsigned char* lds, unsigned* qctr) {
    const int TID = opaque_tid();
    LAS int* sJob = (LAS int*)(lds + 8 * 16 * 130 * 4 + 4096);
    const bf16_t* P = (const bf16_t*)(a.ws + WS_PROJ); bf16_t* Z = (bf16_t*)(a.ws + WS_Z);
    const int tid = TID, wave = tid >> 6, lane = tid & 63, fr16 = lane & 15, fq = lane >> 4;
    LAS float* sX = (LAS float*)lds + wave * (16 * 130);
    LAS float* sE = (LAS float*)lds + 8 * 16 * 130;
    for (;;) {
        if (TID == 0) *sJob = (int)__hip_atomic_fetch_add(qctr, 1u, __ATOMIC_RELAXED, __HIP_MEMORY_SCOPE_AGENT);
        __syncthreads();
        const int job = *sJob;
        if (job >= 512) break;
        const int b = job >> 5, g = job & 31;
        const float dt = expf(((const float*)a.in[24])[l * 32 + g]);
        float lbr, lbi;
        { const float lre = ((const float*)a.in[22])[(size_t)l * 2048 + g * 64 + lane], lim = ((const float*)a.in[23])[(size_t)l * 2048 + g * 64 + lane];
          float sn, cs; sincos_big(lim * dt, sn, cs); const float er = expf(lre * dt); lbr = er * cs; lbi = er * sn; }
        bf16x8 bfrag[8];
#pragma unroll
        for (int k = 0; k < 4; ++k) {
            const int p = fr16 + 16 * k;
            const float lre = ((const float*)a.in[22])[(size_t)l * 2048 + g * 64 + p], lim = ((const float*)a.in[23])[(size_t)l * 2048 + g * 64 + p];
            float sn, cs; sincos_big(lim * dt, sn, cs); const float er = expf(lre * dt), pbr = er * cs, pbi = er * sn;
            const float den = __builtin_amdgcn_rcpf(lre * lre + lim * lim);
            const float fr = ((pbr - 1.0f) * lre + pbi * lim) * den, fi = (pbi * lre - (pbr - 1.0f) * lim) * den;
            const float* brp = (const float*)a.in[25] + ((size_t)l * 2048 + g * 64 + p) * 16 + 8 * (fq & 1);
            const float* bip = (const float*)a.in[26] + ((size_t)l * 2048 + g * 64 + p) * 16 + 8 * (fq & 1);
            float vr[8], vi[8];
#pragma unroll
            for (int i = 0; i < 8; ++i) { const float br = brp[i], bi = bip[i]; float xr = fr * br - fi * bi, xi = fr * bi + fi * br;
                const unsigned hw = pk2(xr, xi);
                if (fq >= 2) { xr -= bflo(hw); xi -= bfhi(hw); }
                vr[i] = xr; vi[i] = xi; }
            bfrag[k] = __builtin_bit_cast(bf16x8, pack8(vr)); bfrag[4 + k] = __builtin_bit_cast(bf16x8, pack8(vi));
        }
        float creg[32];
        {
            const float* cre = (const float*)a.in[27] + ((size_t)l * 32 + g) * 1024 + fr16 * 64 + fq;
            const float* cim = (const float*)a.in[28] + ((size_t)l * 32 + g) * 1024 + fr16 * 64 + fq;
#pragma unroll
            for (int kk = 0; kk < 16; ++kk) { creg[kk] = cre[4 * kk]; creg[16 + kk] = -cim[4 * kk]; }
        }
        f32x4 dsk;
        { const float* dp = (const float*)a.in[29] + (size_t)l * 512 + 16 * g + 4 * fq; dsk = (f32x4){dp[0], dp[1], dp[2], dp[3]}; }
        const size_t tbase = (size_t)b * SEQ + wave * 256;
        const bf16_t* ua = P + (tbase + fr16) * DIN + C_S5 + 16 * g + 8 * (fq & 1);
        const bf16_t* ue = P + (tbase + fr16) * DIN + C_S5 + 16 * g + 4 * fq;
        f32x2 xs = (f32x2){0.f, 0.f}; const f32x2 lbr2 = (f32x2){lbr, lbr}, lbi2 = (f32x2){lbi, lbi};
        {
            u32x4 au = *(const u32x4*)ua;
#pragma unroll 1
            for (int gi = 0; gi < 16; ++gi) {
                const bf16x8 af = __builtin_bit_cast(bf16x8, au);
                if (gi + 1 < 16) au = *(const u32x4*)(ua + (size_t)(gi + 1) * 16 * DIN);
#pragma unroll
                for (int nt = 0; nt < 8; ++nt) { const f32x4 d = __builtin_amdgcn_mfma_f32_16x16x32_bf16(af, bfrag[nt], (f32x4){0.f, 0.f, 0.f, 0.f}, 0, 0, 0);
#pragma unroll
                    for (int j = 0; j < 4; ++j) sX[(4 * fq + j) * 130 + fr16 + 16 * nt] = d[j]; }
                LDS_FENCE();
#pragma unroll
                for (int s = 0; s < 16; ++s) { const f32x2 bu = (f32x2){sX[s * 130 + lane], sX[s * 130 + 64 + lane]};
                    const f32x2 nx = pfma(lbr2, xs, bu); xs = pfma(lbi2, (f32x2){-xs.y, xs.x}, nx); }
                LDS_FENCE();
            }
        }
        sE[wave * 128 + lane] = xs.x; sE[wave * 128 + 64 + lane] = xs.y;
        float pr = lbr, pi = lbi;
#pragma unroll
        for (int i = 0; i < 8; ++i) { const float nr = pr * pr - pi * pi, ni = 2.0f * pr * pi; pr = nr; pi = ni; }
        __syncthreads();
        xs = (f32x2){0.f, 0.f};
        for (int w = 0; w < wave; ++w) { const float er_ = sE[w * 128 + lane], ei_ = sE[w * 128 + 64 + lane];
            const float nr = pr * xs.x - pi * xs.y + er_, ni = pr * xs.y + pi * xs.x + ei_; xs.x = nr; xs.y = ni; }
        {
            u32x4 au = *(const u32x4*)ua; u32x2 eu = *(const u32x2*)ue;
#pragma unroll 1
            for (int gi = 0; gi < 16; ++gi) {
                const bf16x8 af = __builtin_bit_cast(bf16x8, au); const u32x2 eun = eu;
                if (gi + 1 < 16) { au = *(const u32x4*)(ua + (size_t)(gi + 1) * 16 * DIN); eu = *(const u32x2*)(ue + (size_t)(gi + 1) * 16 * DIN); }
#pragma unroll
                for (int nt = 0; nt < 8; ++nt) { const f32x4 d = __builtin_amdgcn_mfma_f32_16x16x32_bf16(af, bfrag[nt], (f32x4){0.f, 0.f, 0.f, 0.f}, 0, 0, 0);
#pragma unroll
                    for (int j = 0; j < 4; ++j) sX[(4 * fq + j) * 130 + fr16 + 16 * nt] = d[j]; }
                LDS_FENCE();
#pragma unroll
                for (int s = 0; s < 16; ++s) { const f32x2 bu = (f32x2){sX[s * 130 + lane], sX[s * 130 + 64 + lane]};
                    const f32x2 nx = pfma(lbr2, xs, bu); xs = pfma(lbi2, (f32x2){-xs.y, xs.x}, nx);
                    sX[s * 130 + lane] = xs.x; sX[s * 130 + 64 + lane] = xs.y; }
                LDS_FENCE();
                f32x4 yacc = (f32x4){0.f, 0.f, 0.f, 0.f}, yacc1 = yacc, yacc2 = yacc, yacc3 = yacc;
                const LAS float* xp = sX + fr16 * 130 + fq;
#pragma unroll
                for (int kk = 0; kk < 32; kk += 4) {
                    yacc = __builtin_amdgcn_mfma_f32_16x16x4f32(creg[kk], xp[4 * kk], yacc, 0, 0, 0);
                    yacc1 = __builtin_amdgcn_mfma_f32_16x16x4f32(creg[kk + 1], xp[4 * kk + 4], yacc1, 0, 0, 0);
                    yacc2 = __builtin_amdgcn_mfma_f32_16x16x4f32(creg[kk + 2], xp[4 * kk + 8], yacc2, 0, 0, 0);
                    yacc3 = __builtin_amdgcn_mfma_f32_16x16x4f32(creg[kk + 3], xp[4 * kk + 12], yacc3, 0, 0, 0);
                }
                yacc = (yacc + yacc1) + (yacc2 + yacc3);
                const float u0 = bflo(eun.x), u1 = bfhi(eun.x), u2 = bflo(eun.y), u3 = bfhi(eun.y);
                const float z0 = gelu_erf(yacc[0] + dsk[0] * u0), z1 = gelu_erf(yacc[1] + dsk[1] * u1), z2 = gelu_erf(yacc[2] + dsk[2] * u2), z3 = gelu_erf(yacc[3] + dsk[3] * u3);
                u32x2 w; w.x = pk2(z0, z1); w.y = pk2(z2, z3);
                *(u32x2*)(Z + (tbase + gi * 16 + fr16) * 512 + 16 * g + 4 * fq) = w;
                LDS_FENCE();
            }
        }
        __syncthreads();
    }
}

__device__ __forceinline__ void scan_phase(ArgsRef a, int l, LAS unsigned char* lds) {
    const int TID = opaque_tid(), BID = opaque_bid();
    if (gridDim.x == 256) {
        if (BID < 128) rwkv_full(a, l, lds, BID, TID); else hgrn_full(a, l, lds, BID - 128, TID);
    } else {
        for (int job = BID; job < 256; job += gridDim.x) { if (job < 128) rwkv_full(a, l, lds, job, TID); else hgrn_full(a, l, lds, job - 128, TID); __syncthreads(); }
    }
    __syncthreads();
    s5_jobs(a, l, lds, (unsigned*)(a.ws + WS_BAR) + 3584 + 64 * l);
    __syncthreads();
}

#define XB_TMO      128
#define XB_XCNT(j)  (256  + 64 * (j))
#define XB_XSUB(j)  (1280 + 64 * (j))
#define XB_XGEN(j)  (2304 + 64 * (j))
#define XB_TOP      3328
#define XB_TOPGEN   3392
#define XCD_BAR_WORDS 3456
#define XB_SPIN_CAP (1u << 18)

__device__ __forceinline__ unsigned xb_ld(unsigned* p)              { return __hip_atomic_load(p, __ATOMIC_RELAXED, __HIP_MEMORY_SCOPE_AGENT); }
__device__ __forceinline__ unsigned xb_add(unsigned* p, unsigned v) { return __hip_atomic_fetch_add(p, v, __ATOMIC_RELAXED, __HIP_MEMORY_SCOPE_AGENT); }
__device__ __forceinline__ unsigned xb_xcc_id() { return (unsigned)__builtin_amdgcn_s_getreg((3 << 11) | 20) & 0xFu; }
#define XB_SPIN(cond, bar) do { unsigned _sp = 0; while (cond) { __builtin_amdgcn_s_sleep(1); \
    if ((++_sp & 255u) == 0u) { if (xb_ld(&(bar)[XB_TMO])) break; if (_sp > XB_SPIN_CAP) { atomicAdd(&(bar)[XB_TMO], 1u); break; } } } } while (0)

struct XcdBarrier {
    unsigned* bar; unsigned x;
    volatile LAS unsigned* st;
};

__device__ __forceinline__ XcdBarrier xcd_barrier_post(unsigned* bar, volatile LAS unsigned* st) {
    XcdBarrier b; b.bar = bar; b.x = xb_xcc_id(); b.st = st;
    if (threadIdx.x == 0) (void)xb_add(&bar[XB_XCNT(b.x)], 1u);
    return b;
}
__device__ __forceinline__ void xcd_barrier_complete(unsigned* bar, unsigned x, unsigned& nloc, unsigned& nx) {
    const unsigned G = gridDim.x * gridDim.y * gridDim.z;
    unsigned sum, cnt, mine, sp = 0u;
    for (;;) {
        sum = 0u; cnt = 0u; mine = 0u;
#pragma unroll
        for (unsigned j = 0; j < 16; ++j) { const unsigned c = xb_ld(&bar[XB_XCNT(j)]); sum += c; cnt += (c > 0u) ? 1u : 0u; mine = (j == x) ? c : mine; }
        if (sum == G) break;
        __builtin_amdgcn_s_sleep(1);
        if ((++sp & 255u) == 0u) { if (xb_ld(&bar[XB_TMO])) break; if (sp > XB_SPIN_CAP) { atomicAdd(&bar[XB_TMO], 1u); break; } }
    }
    nloc = mine > 0u ? mine : 1u; nx = cnt > 0u ? cnt : 1u;
}

__device__ __forceinline__ void xcd_barrier(const XcdBarrier& b) {
    asm volatile("s_waitcnt vmcnt(0)" ::: "memory");
    __syncthreads();
    if (threadIdx.x == 0) {
        unsigned* bar = b.bar;
        __builtin_amdgcn_s_waitcnt(0);
        unsigned nloc = b.st[0], nx = b.st[1];
        if (nloc == 0u) { xcd_barrier_complete(bar, b.x, nloc, nx); b.st[0] = nloc; b.st[1] = nx; }
        const unsigned old = xb_add(&bar[XB_XSUB(b.x)], 1u);
        const unsigned gen = old / nloc;
        if (old + 1u == (gen + 1u) * nloc) {
            __builtin_amdgcn_fence(__ATOMIC_RELEASE, "agent");
            asm volatile("s_waitcnt vmcnt(0)" ::: "memory");
            const unsigned og = xb_add(&bar[XB_TOP], 1u);
            const unsigned tg = og / nx;
            if (og + 1u == (tg + 1u) * nx) xb_add(&bar[XB_TOPGEN], 1u);
            else XB_SPIN(xb_ld(&bar[XB_TOPGEN]) == tg, bar);
            __builtin_amdgcn_fence(__ATOMIC_ACQUIRE, "agent");
            xb_add(&bar[XB_XGEN(b.x)], 1u);
            asm volatile("s_waitcnt vmcnt(0)" ::: "memory");
        } else {
            XB_SPIN(xb_ld(&bar[XB_XGEN(b.x)]) == gen, bar);
            __builtin_amdgcn_fence(__ATOMIC_ACQUIRE, "agent");
            asm volatile("s_waitcnt vmcnt(0)" ::: "memory");
        }
    }
    __syncthreads();
}


constexpr int NPH = 11;
#ifndef DUPMASK
#define DUPMASK 0
#endif
__global__ void __launch_bounds__(NTHREADS, 2) mega(Args a_, int lo, int hi) {
    extern __shared__ __attribute__((aligned(16))) unsigned char lds_raw[];
    LAS unsigned char* lds = (LAS unsigned char*)lds_raw;
#ifdef EXTRA_SYNCS
    for (int i = 0; i < EXTRA_SYNCS; ++i) { __syncthreads(); cg::this_grid().sync(); }
#endif
    LAS unsigned* xst = (LAS unsigned*)(lds + LDS_BYTES - 16);
    if (hi - lo > 1) {
        if (threadIdx.x == 0) { xst[0] = 0u; xst[1] = 0u; }
        __syncthreads();
        if (blockIdx.x == 0) {
            const __attribute__((address_space(4))) Args* ap0 = (const __attribute__((address_space(4))) Args*)__builtin_amdgcn_kernarg_segment_ptr();
            unsigned* bw = (unsigned*)(ap0->ws + WS_BAR);
            for (int i = threadIdx.x; i < 4096; i += NTHREADS) bw[i] = 0u;
        }
    }
#pragma unroll 1
    for (int step2 = 2 * lo; step2 < 2 * hi; ++step2) {
        const int step = step2 >> 1;
        if ((step2 & 1) && !((DUPMASK >> (step % NPH)) & 1)) continue;
        const __attribute__((address_space(4))) Args* ap = (const __attribute__((address_space(4))) Args*)__builtin_amdgcn_kernarg_segment_ptr();
        asm volatile("" : "+s"(ap));
        ArgsRef a = *ap;
        unsigned char* ws = a.ws;
        float* SSa = (float*)(ws + WS_SS); float* SSb = SSa + T; float* SSc = SSb + T;
        const int l = step / NPH, ph = step % NPH;
        const float* xin = (l == 0) ? (const float*)a.in[0] : (const float*)a.out;
#ifndef PHMASK
#define PHMASK 0x7ff
#endif
        switch (ph) {
        case 0: if (PHMASK & (1 << 0)) { conv_phase(a, l, lds); if (l == 0) norm_phase(xin, (bf16_t*)(ws + WS_XN), SSa); zero_phase(SSb, T); } break;
        case 1: if (PHMASK & (1 << 1)) { pg8::EpiSwiGLU E; E.H = (bf16_t*)(ws + WS_HID); E.SS = SSa; run_gemm(lds, (const bf16_t*)(ws + WS_XN), (const bf16_t*)(ws + W_UP1), 2 * FF, D, E); } break;
        case 2: if (PHMASK & (1 << 2)) { pg8::EpiResidual<true> E; E.base = xin; E.out = a.out; E.XN = (bf16_t*)(ws + WS_XN); E.SS = SSb; run_gemm(lds, (const bf16_t*)(ws + WS_HID), (const bf16_t*)(ws + W_DN1), D, FF, E); } break;
        case 3: if (PHMASK & (1 << 3)) { pg8::EpiBf16 E; E.O = (bf16_t*)(ws + WS_PROJ); E.ldc = DIN; E.SS = SSb; run_gemm(lds, (const bf16_t*)(ws + WS_XN), (const bf16_t*)(ws + W_IN), DIN, D, E); } break;
        case 4: if (PHMASK & (1 << 4)) { zero_phase(SSa, T); zero_phase(SSc, T); alr_phase(a, l); attn_phase(a, l, lds); } break;
        case 5: if (PHMASK & (1 << 5)) { pg8::EpiLR E; E.O = (bf16_t*)(ws + WS_LRO); E.w0 = (const float*)a.in[9] + (size_t)l * 512; E.a0 = (const float*)a.in[11] + (size_t)l * 512;
                  run_gemm(lds, (const bf16_t*)(ws + WS_ALR), (const bf16_t*)(ws + W_LR), 1536, 256, E); } break;
        case 6: if (PHMASK & (1 << 6)) scan_phase(a, l, lds); break;
        case 7: if (PHMASK & (1 << 7)) { pg8::EpiGLU G; G.Z = (const bf16_t*)(ws + WS_Z); G.Y = (bf16_t*)(ws + WS_YC); G.b = (const float*)a.in[31] + (size_t)l * 512;
                  run_gemm(lds, (const bf16_t*)(ws + WS_Z), (const bf16_t*)(ws + W_GLU), 512, 512, G); } break;
        case 8: if (PHMASK & (1 << 8)) { pg8::EpiResidual<false> E; E.base = a.out; E.out = a.out; E.XN = (bf16_t*)(ws + WS_XN); E.SS = SSc; run_gemm(lds, (const bf16_t*)(ws + WS_YC), (const bf16_t*)(ws + W_OUT), D, D, E); } break;
        case 9: if (PHMASK & (1 << 9)) { pg8::EpiSwiGLU E; E.H = (bf16_t*)(ws + WS_HID); E.SS = SSc; run_gemm(lds, (const bf16_t*)(ws + WS_XN), (const bf16_t*)(ws + W_UP2), 2 * FF, D, E); } break;
        case 10: if (PHMASK & (1 << 10)) { pg8::EpiResidual<true> E; E.base = a.out; E.out = a.out; E.XN = (l + 1 < NL) ? (bf16_t*)(ws + WS_XN) : nullptr; E.SS = SSa; run_gemm(lds, (const bf16_t*)(ws + WS_HID), (const bf16_t*)(ws + W_DN2), D, FF, E); } break;
        }
        if (step2 + 1 < 2 * hi) {
            if (step2 == 2 * lo) { __syncthreads(); cg::this_grid().sync(); (void)xcd_barrier_post((unsigned*)(ws + WS_BAR), (volatile LAS unsigned*)xst); }
            else { XcdBarrier xb; xb.bar = (unsigned*)(ws + WS_BAR); xb.x = xb_xcc_id(); xb.st = (volatile LAS unsigned*)xst; xcd_barrier(xb); }
        }
    }
}

extern "C" void kernel_launch(void* const* d_in, const int* in_sizes, int n_in, void* d_out, int out_size, void* d_ws, size_t ws_size, hipStream_t stream) {
    static int grid = 0;
    if (!grid) {
        int dev = 0, cus = 0, per_cu = 0;
        hipGetDevice(&dev);
        hipDeviceGetAttribute(&cus, hipDeviceAttributeMultiprocessorCount, dev);
        hipFuncSetAttribute((const void*)mega, hipFuncAttributeMaxDynamicSharedMemorySize, LDS_BYTES);
        hipOccupancyMaxActiveBlocksPerMultiprocessor(&per_cu, (const void*)mega, NTHREADS, LDS_BYTES);
        if (per_cu < 1) per_cu = 1;
        grid = cus * 1;
        if (grid != 256) fprintf(stderr, "kernel_launch: grid %d (cus %d, per_cu %d)\n", grid, cus, per_cu);
    }
    Args a{};
    for (int i = 0; i < 39; ++i) a.in[i] = d_in[i];
    a.out = (float*)d_out; a.ws = (unsigned char*)d_ws;
#if ONE_LAUNCH
    int lo = 0, hi = NL * NPH;
    void* args[] = {&a, &lo, &hi};
    hipError_t e = hipLaunchCooperativeKernel((void*)mega, dim3(grid), dim3(NTHREADS), args, LDS_BYTES, stream);
    if (e != hipSuccess) fprintf(stderr, "cooperative launch failed: %s (grid %d)\n", hipGetErrorString(e), grid);
#else
    for (int s = 0; s < NL * NPH; ++s) hipLaunchKernelGGL(mega, dim3(grid), dim3(NTHREADS), LDS_BYTES, stream, a, s, s + 1);
#endif
}
```

```cpp
#include <hip/hip_runtime.h>
#include <hip/hip_cooperative_groups.h>
#include <cstdio>
#include <cstdint>
namespace cg = cooperative_groups;

#ifndef ONE_LAUNCH
#define ONE_LAUNCH 1
#endif

#define LAS __attribute__((address_space(3)))
typedef unsigned short bf16_t;
typedef short bf16x8 __attribute__((ext_vector_type(8)));
typedef float f32x4 __attribute__((ext_vector_type(4)));
typedef float f32x2 __attribute__((ext_vector_type(2)));
typedef unsigned u32x4 __attribute__((ext_vector_type(4)));
typedef unsigned u32x2 __attribute__((ext_vector_type(2)));

constexpr int T = 32768, SEQ = 2048, NB = 16, D = 2048, FF = 5632, DIN = 5120, NL = 2;
constexpr int C_RWKV = 0, C_ATT = 1792, C_S5 = 2560, C_HG = 3072;
constexpr int NTHREADS = 512, NWAVES = 8;

constexpr size_t SZ_UP = (size_t)2 * FF * D * 2, SZ_DN = (size_t)D * FF * 2, SZ_IN = (size_t)DIN * D * 2, SZ_LR = (size_t)1536 * 256 * 2,
                 SZ_GLU = (size_t)512 * 512 * 2, SZ_OUT = (size_t)D * D * 2;
constexpr size_t W_UP1 = 0, W_DN1 = W_UP1 + SZ_UP, W_IN = W_DN1 + SZ_DN, W_LR = W_IN + SZ_IN, W_GLU = W_LR + SZ_LR, W_OUT = W_GLU + SZ_GLU,
                 W_UP2 = W_OUT + SZ_OUT, W_DN2 = W_UP2 + SZ_UP, W_END = W_DN2 + SZ_DN;
constexpr size_t WS_XN = W_END, WS_BIG = WS_XN + (size_t)T * D * 2;
constexpr size_t WS_HID = WS_BIG;
constexpr size_t WS_PROJ = WS_BIG, WS_LRO = WS_PROJ + (size_t)T * DIN * 2, WS_ALR = WS_LRO + (size_t)T * 1536 * 2, WS_Z = WS_ALR + (size_t)T * 256 * 2,
                 WS_OR = WS_Z + (size_t)T * 512 * 2, WS_OH = WS_OR + (size_t)T * 512 * 4, WS_BON = WS_OH + (size_t)T * 512 * 4, WS_YC = WS_BON + (size_t)T * 8 * 4, WS_SS = WS_YC + (size_t)T * D * 2, WS_BAR = WS_SS + (size_t)3 * T * 4, WS_END = WS_BAR + 16384;
static_assert(WS_END <= (size_t)1 << 30, "workspace");
static_assert(WS_HID + (size_t)T * FF * 2 <= (size_t)1 << 30, "workspace");

constexpr int LDS_BYTES = 147456;

struct Args { const void* in[39]; float* out; unsigned char* ws; };
typedef const __attribute__((address_space(4))) Args& ArgsRef;

typedef __bf16 bf16x2_t __attribute__((ext_vector_type(2)));
__device__ __forceinline__ unsigned pk2(float lo, float hi) { const f32x2 v = (f32x2){lo, hi}; return __builtin_bit_cast(unsigned, __builtin_convertvector(v, bf16x2_t)); }
__device__ __forceinline__ float bflo(unsigned w) { return __uint_as_float(w << 16); }
__device__ __forceinline__ float bfhi(unsigned w) { return __uint_as_float(w & 0xffff0000u); }
__device__ __forceinline__ void unpack8(u32x4 q, float* f) { f[0] = bflo(q.x); f[1] = bfhi(q.x); f[2] = bflo(q.y); f[3] = bfhi(q.y); f[4] = bflo(q.z); f[5] = bfhi(q.z); f[6] = bflo(q.w); f[7] = bfhi(q.w); }
__device__ __forceinline__ u32x4 pack8(const float* f) { u32x4 o; o.x = pk2(f[0], f[1]); o.y = pk2(f[2], f[3]); o.z = pk2(f[4], f[5]); o.w = pk2(f[6], f[7]); return o; }
template <int CTRL> __device__ __forceinline__ float dpp(float x) { return __builtin_bit_cast(float, __builtin_amdgcn_mov_dpp(__builtin_bit_cast(int, x), CTRL, 0xf, 0xf, true)); }
constexpr int XOR1 = 0xB1, XOR2 = 0x4E, XOR7 = 0x141, XOR8 = 0x128;
__device__ __forceinline__ float red8(float v) { v += dpp<XOR1>(v); v += dpp<XOR2>(v); v += dpp<XOR7>(v); return v; }
__device__ __forceinline__ float red16(float v) { v = red8(v); v += dpp<XOR8>(v); return v; }
__device__ __forceinline__ float wave_sum(float v) {
#pragma unroll
    for (int o = 1; o < 64; o <<= 1) v += __shfl_xor(v, o);
    return v;
}
__device__ __forceinline__ float sigmoidf_(float x) { return __builtin_amdgcn_rcpf(1.0f + __expf(-x)); }
__device__ __forceinline__ float siluf_(float x) { return x * __builtin_amdgcn_rcpf(1.0f + __expf(-x)); }
__device__ __forceinline__ int opaque_tid() { int t = threadIdx.x; asm volatile("" : "+v"(t)); return t; }
__device__ __forceinline__ int opaque_bid() { int t = blockIdx.x; asm volatile("" : "+s"(t)); return t; }
__device__ __forceinline__ f32x2 pfma(f32x2 a, f32x2 b, f32x2 c) { return __builtin_elementwise_fma(a, b, c); }
#define LDS_FENCE() asm volatile("s_waitcnt lgkmcnt(0)" ::: "memory")
__device__ __forceinline__ void sincos_big(float x, float& sn, float& cs) {
    const float n = rintf(x * 0.15915494309189535f);
    float r = fmaf(-n, 6.28318548202514648f, x); r = fmaf(-n, -1.7484555e-7f, r);
    sn = __sinf(r); cs = __cosf(r);
}

namespace pg8 {
constexpr int BM = 256, BK = 64, HALF = 128, HTB = HALF * BK * 2, STAGE_BYTES = 8 * HTB, NXCD = 8, WGM = 8;
__host__ __device__ __forceinline__ int lds_byte(int r, int c) { const int st = (r >> 4) * 2 + (c >> 5), rr = r & 15, cc = c & 31, ob = rr * 64 + cc * 2; return st * 1024 + (ob ^ (((ob >> 9) & 1) << 5)); }
__host__ __device__ __forceinline__ void stage_rc(int b, int& R, int& C) { const int st = b / 1024, sb = b % 1024, swz = sb ^ (((sb >> 9) & 1) << 5); R = (st >> 1) * 16 + swz / 64; C = (st & 1) * 32 + (swz % 64) / 2; }
__host__ __device__ __forceinline__ int perm32(int rho) { const int n = rho >> 4, i = rho & 15; return 8 * (i >> 2) + 4 * n + (i & 3); }
struct Unit { int pm, pn; };
struct Gemm { const bf16_t* A; const bf16_t* Bt; int M, N, K; };
struct StaticOrder {
    int nM, nN, nwg, G, c;
    __device__ void init(int M, int N, int G_, int c_) { nM = M / BM; nN = N / BM; nwg = nM * nN; G = G_; c = c_; }
    __device__ bool next(int i, Unit& u) const {
        const long L = (long)i * G + c; if (L >= nwg) return false;
        int wgid = (int)L; { const int q = nwg / NXCD, r = nwg % NXCD, xcd = wgid % NXCD, off = wgid / NXCD; wgid = (xcd < r ? xcd * (q + 1) : r * (q + 1) + (xcd - r) * q) + off; }
        const int nig = WGM * nN, gid = wgid / nig, fm = gid * WGM, gsz = (nM - fm) < WGM ? (nM - fm) : WGM;
        u.pm = fm + ((wgid % nig) % gsz); u.pn = (wgid % nig) / gsz; return true;
    }
};
template <class Epi>
__device__ __forceinline__ void gemm_phase(LAS unsigned char* lds, const Gemm g, const StaticOrder S, const Epi E) {
    const int TID = opaque_tid(), BID = opaque_bid(); (void)TID; (void)BID;
    const int tid = TID, wid = __builtin_amdgcn_readfirstlane(tid >> 6), lane = tid & 63, wr = wid >> 2, wc = wid & 3, fr = lane & 15, fq = lane >> 4;
    const int K = g.K, nt = K / BK;
    unsigned voffA[2], voffB[2];
#pragma unroll
    for (int i = 0; i < 2; ++i) { int R, C; stage_rc(tid * 16 + i * 8192, R, C); const int Rb = Epi::PERM ? ((R & ~31) + perm32(R & 31)) : R;
        voffA[i] = (unsigned)(R * K + C) * 2u; voffB[i] = (unsigned)(Rb * K + C) * 2u; }
    const size_t kstep = (size_t)(BK * 2);
    const size_t hstep = (size_t)HALF * K * 2;
    const size_t tstep = 2 * hstep;
    const unsigned ldsw = (unsigned)wid * 1024u;
    const int aoff = lds_byte(wr * 64 + fr, fq * 8), boff = lds_byte(wc * 32 + fr, fq * 8);
#define PG8_SA(b, h) (((b) * 2 + (h)) * HTB)
#define PG8_SB(b, h) ((4 + (b) * 2 + (h)) * HTB)
#define PG8_STAGE(bufoff, gbase, voff) do { _Pragma("unroll") for (int _i = 0; _i < 2; ++_i) \
        __builtin_amdgcn_global_load_lds((const unsigned*)((const char*)(gbase) + (voff)[_i]), (LAS unsigned*)(lds + (bufoff) + ldsw + _i * 8192), 16, 0, 0); } while (0)
#define PG8_LDA(dst, b, h) do { _Pragma("unroll") for (int m = 0; m < 4; ++m) _Pragma("unroll") for (int k = 0; k < 2; ++k) dst[m][k] = *(const LAS bf16x8*)(lds + PG8_SA(b, h) + aoff + m * 2048 + k * 1024); } while (0)
#define PG8_LDB(dst, b, h) do { _Pragma("unroll") for (int n = 0; n < 2; ++n) _Pragma("unroll") for (int k = 0; k < 2; ++k) dst[n][k] = *(const LAS bf16x8*)(lds + PG8_SB(b, h) + boff + n * 2048 + k * 1024); } while (0)
#define PG8_MMA(ai, bj, At, Bt) do { __builtin_amdgcn_s_setprio(1); _Pragma("unroll") for (int m = 0; m < 4; ++m) _Pragma("unroll") for (int n = 0; n < 2; ++n) _Pragma("unroll") for (int k = 0; k < 2; ++k) \
        acc[ai][bj][m][n] = __builtin_amdgcn_mfma_f32_16x16x32_bf16(Bt[n][k], At[m][k], acc[ai][bj][m][n], 0, 0, 0); __builtin_amdgcn_s_setprio(0); } while (0)
#define PG8_WAIT_V(n) asm volatile("s_waitcnt vmcnt(" #n ")" ::: "memory")
#define PG8_WAIT_L(n) asm volatile("s_waitcnt lgkmcnt(" #n ")" ::: "memory")
#define PG8_BAR __builtin_amdgcn_s_barrier()
#define PG8_SCHED __builtin_amdgcn_sched_barrier(0)
    Unit cur, nxt; int ui = 0;
    if (!S.next(0, cur)) return;
    f32x4 acc[2][2][4][2];
#pragma unroll
    for (int a = 0; a < 2; ++a)
#pragma unroll
        for (int b = 0; b < 2; ++b)
#pragma unroll
            for (int m = 0; m < 4; ++m)
#pragma unroll
                for (int n = 0; n < 2; ++n) acc[a][b][m][n] = (f32x4){0.f, 0.f, 0.f, 0.f};
    bf16x8 At[4][2], B0[2][2], B1[2][2];
    const char* cA = (const char*)g.A + (size_t)cur.pm * tstep; const char* cB = (const char*)g.Bt + (size_t)cur.pn * tstep;
    PG8_STAGE(PG8_SB(0, 0), cB, voffB); PG8_STAGE(PG8_SA(0, 0), cA, voffA); PG8_STAGE(PG8_SB(0, 1), cB + hstep, voffB); PG8_STAGE(PG8_SA(0, 1), cA + hstep, voffA);
    if (wr == 1) PG8_BAR;
    PG8_WAIT_V(4); PG8_BAR;
    PG8_STAGE(PG8_SB(1, 0), cB + kstep, voffB); PG8_STAGE(PG8_SA(1, 0), cA + kstep, voffA); PG8_STAGE(PG8_SB(1, 1), cB + hstep + kstep, voffB);
    PG8_WAIT_V(6); PG8_BAR;
    for (;;) {
        const bool has_next = S.next(ui + 1, nxt);
        const char* nA = has_next ? (const char*)g.A + (size_t)nxt.pm * tstep : cA; const char* nB = has_next ? (const char*)g.Bt + (size_t)nxt.pn * tstep : cB;
#pragma unroll 1
        for (int t = 0; t < nt; t += 2) {
            const bool last = (t == nt - 2);
            const char* a1 = cA + (size_t)(t + 1) * kstep;
            const char* a2 = last ? nA : cA + (size_t)(t + 2) * kstep; const char* b2 = last ? nB : cB + (size_t)(t + 2) * kstep;
            const char* a3 = a2 + kstep; const char* b3 = b2 + kstep;
            PG8_LDB(B0, 0, 0); PG8_SCHED; PG8_LDA(At, 0, 0); PG8_STAGE(PG8_SA(1, 1), a1 + hstep, voffA);
            PG8_WAIT_L(8); PG8_BAR; PG8_WAIT_L(0); PG8_MMA(0, 0, At, B0); PG8_BAR; PG8_SCHED;
            PG8_LDB(B1, 0, 1); PG8_STAGE(PG8_SB(0, 0), b2, voffB);
            PG8_BAR; PG8_WAIT_L(0); PG8_MMA(0, 1, At, B1); PG8_BAR;
            PG8_LDA(At, 0, 1); PG8_STAGE(PG8_SA(0, 0), a2, voffA);
            PG8_BAR; PG8_WAIT_L(0); PG8_MMA(1, 0, At, B0); PG8_BAR; PG8_SCHED;
            PG8_STAGE(PG8_SB(0, 1), b2 + hstep, voffB);
            PG8_WAIT_V(6); PG8_BAR; PG8_MMA(1, 1, At, B1); PG8_BAR;
            PG8_LDB(B0, 1, 0); PG8_SCHED; PG8_LDA(At, 1, 0); PG8_STAGE(PG8_SA(0, 1), a2 + hstep, voffA);
            PG8_WAIT_L(8); PG8_BAR; PG8_WAIT_L(0); PG8_MMA(0, 0, At, B0); PG8_BAR; PG8_SCHED;
            PG8_LDB(B1, 1, 1); PG8_STAGE(PG8_SB(1, 0), b3, voffB);
            PG8_BAR; PG8_WAIT_L(0); PG8_MMA(0, 1, At, B1); PG8_BAR;
            PG8_LDA(At, 1, 1); PG8_STAGE(PG8_SA(1, 0), a3, voffA);
            PG8_BAR; PG8_WAIT_L(0); PG8_MMA(1, 0, At, B0); PG8_BAR; PG8_SCHED;
            PG8_STAGE(PG8_SB(1, 1), b3 + hstep, voffB);
            PG8_WAIT_V(6); PG8_BAR; PG8_MMA(1, 1, At, B1); PG8_BAR;
        }
        E(acc, cur, wr, wc, fr, fq);
        if (!has_next) break;
#pragma unroll
        for (int a = 0; a < 2; ++a)
#pragma unroll
            for (int b = 0; b < 2; ++b)
#pragma unroll
                for (int m = 0; m < 4; ++m)
#pragma unroll
                    for (int n = 0; n < 2; ++n) acc[a][b][m][n] = (f32x4){0.f, 0.f, 0.f, 0.f};
        cur = nxt; cA = nA; cB = nB; ++ui;
    }
    PG8_WAIT_V(0);
    if (wr == 0) PG8_BAR;
    PG8_BAR;
#undef PG8_SA
#undef PG8_SB
#undef PG8_STAGE
#undef PG8_LDA
#undef PG8_LDB
#undef PG8_MMA
#undef PG8_WAIT_V
#undef PG8_WAIT_L
#undef PG8_BAR
#undef PG8_SCHED
}

struct EpiSwiGLU {
    static constexpr bool PERM = true;
    bf16_t* H; const float* SS;
    __device__ __forceinline__ void operator()(const f32x4 (&acc)[2][2][4][2], const Unit& u, int wr, int wc, int fr, int fq) const {
        const int row0 = u.pm * BM + wr * 64 + fr, col0 = u.pn * 128 + wc * 32 + 8 * fq;
        float rsv[2][4];
#pragma unroll
        for (int ai = 0; ai < 2; ++ai)
#pragma unroll
            for (int m = 0; m < 4; ++m) rsv[ai][m] = SS[row0 + ai * HALF + m * 16];
#pragma unroll
        for (int ai = 0; ai < 2; ++ai)
#pragma unroll
            for (int m = 0; m < 4; ++m) {
                const float rs = __builtin_amdgcn_rsqf(rsv[ai][m] * (1.0f / D) + 1e-6f);
                float v[8];
#pragma unroll
                for (int n = 0; n < 2; ++n)
#pragma unroll
                    for (int j = 0; j < 4; ++j) { const float gt = acc[ai][0][m][n][j] * rs, up = acc[ai][1][m][n][j] * rs; v[4 * n + j] = siluf_(gt) * up; }
                *(u32x4*)(H + (size_t)(row0 + ai * HALF + m * 16) * FF + col0) = pack8(v);
            }
    }
};
template <bool HALFSTEP> struct EpiResidual {
    static constexpr bool PERM = false;
    static constexpr float scale = HALFSTEP ? 0.5f : 1.0f;
    const float* base; float* out; bf16_t* XN; float* SS;
    __device__ __forceinline__ void operator()(const f32x4 (&acc)[2][2][4][2], const Unit& u, int wr, int wc, int fr, int fq) const {
        const int row0 = u.pm * BM + wr * 64 + fr, col0 = u.pn * BM + wc * 32 + 4 * fq;
#pragma unroll
        for (int ai = 0; ai < 2; ++ai) {
            f32x4 bv[4][2][2];
#pragma unroll
            for (int m = 0; m < 4; ++m)
#pragma unroll
                for (int bj = 0; bj < 2; ++bj)
#pragma unroll
                    for (int n = 0; n < 2; ++n) bv[m][bj][n] = *(const f32x4*)(base + (size_t)(row0 + ai * HALF + m * 16) * D + col0 + bj * HALF + n * 16);
#pragma unroll
            for (int m = 0; m < 4; ++m) { const int row = row0 + ai * HALF + m * 16; const size_t ro = (size_t)row * D + col0; float ss = 0.f;
#pragma unroll
                for (int bj = 0; bj < 2; ++bj)
#pragma unroll
                    for (int n = 0; n < 2; ++n) { const f32x4 r = bv[m][bj][n] + acc[ai][bj][m][n] * scale; *(f32x4*)(out + ro + bj * HALF + n * 16) = r;
                        if (XN) { u32x2 w; w.x = pk2(r.x, r.y); w.y = pk2(r.z, r.w); *(u32x2*)(XN + ro + bj * HALF + n * 16) = w; ss += (r.x * r.x + r.y * r.y) + (r.z * r.z + r.w * r.w); } }
                if (XN) { ss += __shfl_xor(ss, 16); ss += __shfl_xor(ss, 32); if (fq == 0) atomicAdd(SS + row, ss); } }
        }
    }
};
struct EpiBf16 {
    static constexpr bool PERM = true;
    bf16_t* O; int ldc; const float* SS;
    __device__ __forceinline__ void operator()(const f32x4 (&acc)[2][2][4][2], const Unit& u, int wr, int wc, int fr, int fq) const {
        const int row0 = u.pm * BM + wr * 64 + fr, col0 = u.pn * BM + wc * 32 + 8 * fq;
        float rsv[2][4];
#pragma unroll
        for (int ai = 0; ai < 2; ++ai)
#pragma unroll
            for (int m = 0; m < 4; ++m) rsv[ai][m] = SS[row0 + ai * HALF + m * 16];
#pragma unroll
        for (int ai = 0; ai < 2; ++ai)
#pragma unroll
            for (int m = 0; m < 4; ++m) { bf16_t* rowp = O + (size_t)(row0 + ai * HALF + m * 16) * ldc + col0;
                const float rs = __builtin_amdgcn_rsqf(rsv[ai][m] * (1.0f / D) + 1e-6f);
#pragma unroll
                for (int bj = 0; bj < 2; ++bj) { const f32x4 v0 = acc[ai][bj][m][0] * rs, v1 = acc[ai][bj][m][1] * rs;
                    u32x4 w; w.x = pk2(v0[0], v0[1]); w.y = pk2(v0[2], v0[3]); w.z = pk2(v1[0], v1[1]); w.w = pk2(v1[2], v1[3]);
                    *(u32x4*)(rowp + bj * HALF) = w; } }
    }
};
struct EpiLR {
    static constexpr bool PERM = true;
    bf16_t* O; const float* w0; const float* a0;
    template <int KIND> __device__ __forceinline__ void body(const f32x4 (&acc)[2][2][4][2], const float* bp, int row0, int col0) const {
#pragma unroll
        for (int bj = 0; bj < 2; ++bj) {
            f32x4 b0 = (f32x4){0.f, 0.f, 0.f, 0.f}, b1 = b0;
            if (KIND < 2) { b0 = *(const f32x4*)(bp + bj * HALF); b1 = *(const f32x4*)(bp + bj * HALF + 4); }
#pragma unroll
            for (int ai = 0; ai < 2; ++ai)
#pragma unroll
                for (int m = 0; m < 4; ++m) {
                    u32x4 w;
#pragma unroll
                    for (int n = 0; n < 2; ++n) {
                        float r[4];
#pragma unroll
                        for (int j = 0; j < 4; ++j) { const float x = acc[ai][bj][m][n][j] + (n == 0 ? b0[j] : b1[j]);
                            if (KIND == 0) { const float e = __expf(-x); r[j] = -0.60653065971f * __builtin_amdgcn_rcpf(1.0f + e); }
                            else if (KIND == 1) r[j] = __builtin_amdgcn_rcpf(1.0f + __expf(-x)); else r[j] = x; }
                        if (n == 0) { w.x = pk2(r[0], r[1]); w.y = pk2(r[2], r[3]); } else { w.z = pk2(r[0], r[1]); w.w = pk2(r[2], r[3]); }
                    }
                    *(u32x4*)(O + (size_t)(row0 + ai * HALF + m * 16) * 1536 + col0 + bj * HALF) = w;
                }
        }
    }
    __device__ __forceinline__ void operator()(const f32x4 (&acc)[2][2][4][2], const Unit& u, int wr, int wc, int fr, int fq) const {
        const int row0 = u.pm * BM + wr * 64 + fr, col0 = u.pn * BM + wc * 32 + 8 * fq, kind = u.pn >> 1, f0 = col0 - 512 * kind;
        if (kind == 0) body<0>(acc, w0 + f0, row0, col0); else if (kind == 1) body<1>(acc, a0 + f0, row0, col0); else body<2>(acc, nullptr, row0, col0);
    }
};
struct EpiGLU {
    static constexpr bool PERM = true;
    const bf16_t* Z; bf16_t* Y; const float* b;
    __device__ __forceinline__ void operator()(const f32x4 (&acc)[2][2][4][2], const Unit& u, int wr, int wc, int fr, int fq) const {
        const int row0 = u.pm * BM + wr * 64 + fr, col0 = u.pn * BM + wc * 32 + 8 * fq;
#pragma unroll
        for (int bj = 0; bj < 2; ++bj) {
            const f32x4 bias0 = *(const f32x4*)(b + col0 + bj * HALF), bias1 = *(const f32x4*)(b + col0 + bj * HALF + 4);
            u32x4 zr[2][4];
#pragma unroll
            for (int ai = 0; ai < 2; ++ai)
#pragma unroll
                for (int m = 0; m < 4; ++m) zr[ai][m] = *(const u32x4*)(Z + (size_t)(row0 + ai * HALF + m * 16) * 512 + col0 + bj * HALF);
#pragma unroll
            for (int ai = 0; ai < 2; ++ai)
#pragma unroll
                for (int m = 0; m < 4; ++m) { const size_t r = (size_t)(row0 + ai * HALF + m * 16);
                    float z[8], v[8]; unpack8(zr[ai][m], z);
#pragma unroll
                    for (int n = 0; n < 2; ++n)
#pragma unroll
                        for (int j = 0; j < 4; ++j) v[4 * n + j] = z[4 * n + j] * sigmoidf_(acc[ai][bj][m][n][j] + (n == 0 ? bias0[j] : bias1[j]));
                    *(u32x4*)(Y + r * D + 1024 + col0 + bj * HALF) = pack8(v); }
        }
    }
};
}

template <class Epi> __device__ __forceinline__ void run_gemm(LAS unsigned char* lds, const bf16_t* A, const bf16_t* Bt, int N, int K, const Epi E) {
    pg8::Gemm g; g.A = A; g.Bt = Bt; g.M = T; g.N = N; g.K = K;
    pg8::StaticOrder S; S.init(T, N, gridDim.x, opaque_bid());
    pg8::gemm_phase<Epi>(lds, g, S, E);
}

struct TrItem { const float* W; int ldw, k0, n0; const float* gs; bf16_t* Dst; int ldd, drow0, dk0; };
__device__ __forceinline__ void tr_load(const TrItem& it, f32x4 (&v)[8], int lane) {
    if (it.W) {
#pragma unroll
        for (int i = 0; i < 8; ++i) { const int kk = 8 * i + (lane >> 3); v[i] = *(const f32x4*)(it.W + (size_t)(it.k0 + kk) * it.ldw + it.n0 + 4 * (lane & 7)); }
    } else {
#pragma unroll
        for (int i = 0; i < 8; ++i) v[i] = (f32x4){0.f, 0.f, 0.f, 0.f};
    }
}
__device__ __forceinline__ void tr_finish(const TrItem& it, const f32x4 (&v)[8], LAS float* scr, int lane) {
#pragma unroll
    for (int i = 0; i < 8; ++i) { const int kk = 8 * i + (lane >> 3); f32x4 x = v[i]; if (it.gs) x = x * it.gs[it.k0 + kk];
        LAS float* d = scr + kk * 33 + 4 * (lane & 7); d[0] = x.x; d[1] = x.y; d[2] = x.z; d[3] = x.w; }
    LDS_FENCE();
    const int c = lane & 7;
#pragma unroll
    for (int j = 0; j < 4; ++j) { const int n = (lane >> 3) + 8 * j; const LAS float* s = scr + (8 * c) * 33 + n;
        u32x4 o; o.x = pk2(s[0 * 33], s[1 * 33]); o.y = pk2(s[2 * 33], s[3 * 33]); o.z = pk2(s[4 * 33], s[5 * 33]); o.w = pk2(s[6 * 33], s[7 * 33]);
        *(u32x4*)(it.Dst + (size_t)(it.drow0 + n) * it.ldd + it.dk0 + it.k0 + 8 * c) = o; }
    LDS_FENCE();
}
__device__ __forceinline__ TrItem conv_item(ArgsRef a, int l, int it) {
    unsigned char* ws = a.ws;
    constexpr int I_GU = (D / 64) * (FF / 32), I_DN = (FF / 64) * (D / 32), I_IN = (D / 64) * (DIN / 32), I_OUT = (D / 64) * (D / 32), I_GLU = 8 * 16;
    static_assert(I_GU == I_DN, "items");
    TrItem t; t.gs = nullptr; t.dk0 = 0;
    int r = it;
    if (r < 6 * I_GU) {
        const int which = r / I_GU; r -= which * I_GU;
        const int f = which >= 3, m = which % 3;
        if (m < 2) {
            const int nblk = FF / 32, kb = r / nblk, nb = r % nblk, n0 = 32 * nb;
            t.W = (const float*)a.in[(f ? 36 : 3) + m] + (size_t)l * D * FF; t.ldw = FF; t.k0 = 64 * kb; t.n0 = n0; t.gs = (const float*)a.in[f ? 35 : 2] + (size_t)l * D;
            t.Dst = (bf16_t*)(ws + (f ? W_UP2 : W_UP1)); t.ldd = D; t.drow0 = (n0 >> 7) * 256 + (n0 & 127) + 128 * m;
        } else {
            const int nblk = D / 32, kb = r / nblk, nb = r % nblk;
            t.W = (const float*)a.in[f ? 38 : 5] + (size_t)l * FF * D; t.ldw = D; t.k0 = 64 * kb; t.n0 = 32 * nb; t.Dst = (bf16_t*)(ws + (f ? W_DN2 : W_DN1)); t.ldd = FF; t.drow0 = 32 * nb;
        }
        return t;
    }
    r -= 6 * I_GU;
    if (r < I_IN) { const int nblk = DIN / 32, kb = r / nblk, nb = r % nblk;
        t.W = (const float*)a.in[7] + (size_t)l * D * DIN; t.ldw = DIN; t.k0 = 64 * kb; t.n0 = 32 * nb; t.gs = (const float*)a.in[6] + (size_t)l * D; t.Dst = (bf16_t*)(ws + W_IN); t.ldd = D; t.drow0 = 32 * nb; return t; }
    r -= I_IN;
    if (r < I_OUT) { const int nblk = D / 32, kb = r / nblk, nb = r % nblk;
        t.W = (const float*)a.in[34] + (size_t)l * D * D; t.ldw = D; t.k0 = 64 * kb; t.n0 = 32 * nb; t.Dst = (bf16_t*)(ws + W_OUT); t.ldd = D; t.drow0 = 32 * nb; return t; }
    r -= I_OUT;
    if (r < I_GLU) { const int kb = r / 16, nb = r % 16;
        t.W = (const float*)a.in[30] + (size_t)l * 512 * 512; t.ldw = 512; t.k0 = 64 * kb; t.n0 = 32 * nb; t.Dst = (bf16_t*)(ws + W_GLU); t.ldd = 512; t.drow0 = 32 * nb; return t; }
    r -= I_GLU;
    {
        const int nb = r >> 2, kb = r & 3, kind = nb >> 4, nn0 = 32 * (nb & 15);
        const float* W = nullptr; int k0 = 0;
        if (kind == 0 && kb == 0) { W = (const float*)a.in[10] + (size_t)l * 64 * 512; k0 = 0; }
        else if (kind == 1 && kb == 1) { W = (const float*)a.in[12] + (size_t)l * 64 * 512; k0 = 0; }
        else if (kind == 2 && kb >= 2) { W = (const float*)a.in[13] + (size_t)l * 128 * 512; k0 = 64 * (kb - 2); }
        t.W = W; t.ldw = 512; t.k0 = k0; t.n0 = nn0; t.Dst = (bf16_t*)(ws + W_LR); t.ldd = 256; t.drow0 = 32 * nb; t.dk0 = 64 * kb - k0;
    }
    return t;
}
__device__ __forceinline__ void conv_phase(ArgsRef a, int l, LAS unsigned char* lds) {
    const int TID = opaque_tid(), BID = opaque_bid();
    const int wave = TID >> 6, lane = TID & 63;
    LAS float* scr = (LAS float*)(lds + wave * 8704);
    const int gw = BID * NWAVES + wave, NGW = gridDim.x * NWAVES;
    constexpr int NITEMS = 6 * (D / 64) * (FF / 32) + (D / 64) * (DIN / 32) + (D / 64) * (D / 32) + 8 * 16 + 48 * 4;
    if (gw >= NITEMS) return;
    TrItem cur = conv_item(a, l, gw);
    f32x4 v[8]; tr_load(cur, v, lane);
    for (int it = gw; it < NITEMS; it += NGW) {
        f32x4 w[8];
#pragma unroll
        for (int i = 0; i < 8; ++i) w[i] = v[i];
        const TrItem me = cur;
        if (it + NGW < NITEMS) { cur = conv_item(a, l, it + NGW); tr_load(cur, v, lane); }
        tr_finish(me, w, scr, lane);
    }
}

__device__ __forceinline__ void norm_phase(const float* x, bf16_t* XN, float* SS) {
    const int TID = opaque_tid(), BID = opaque_bid(); (void)TID; (void)BID;
    const int wave = TID >> 6, lane = TID & 63;
    const int gw = BID * NWAVES + wave, NGW = gridDim.x * NWAVES;
    for (int m = gw; m < T; m += NGW) {
        const f32x4* xr = (const f32x4*)(x + (size_t)m * D) + lane;
        f32x4 v[8]; float s = 0.f;
#pragma unroll
        for (int j = 0; j < 8; ++j) { v[j] = xr[64 * j]; s += (v[j].x * v[j].x + v[j].y * v[j].y) + (v[j].z * v[j].z + v[j].w * v[j].w); }
        s = wave_sum(s); if (lane == 0) SS[m] = s;
        u32x2* o = (u32x2*)(XN + (size_t)m * D) + lane;
#pragma unroll
        for (int j = 0; j < 8; ++j) { u32x2 w; w.x = pk2(v[j].x, v[j].y); w.y = pk2(v[j].z, v[j].w); o[64 * j] = w; }
    }
}

__device__ __forceinline__ void zero_phase(float* p, int n) {
    const int TID = opaque_tid(), BID = opaque_bid();
    for (int i = BID * NTHREADS + TID; i < n; i += gridDim.x * NTHREADS) p[i] = 0.f;
}
__device__ __forceinline__ void alr_phase(ArgsRef a, int l) {
    const int TID = opaque_tid(), BID = opaque_bid(); (void)TID; (void)BID;
    const bf16_t* P = (const bf16_t*)(a.ws + WS_PROJ); bf16_t* ALR = (bf16_t*)(a.ws + WS_ALR);
    const float* mu = (const float*)a.in[8] + (size_t)l * 1792 + 1536;
    const int gt = BID * NTHREADS + TID, NGT = gridDim.x * NTHREADS;
    for (int it = gt; it < T * 32; it += NGT) {
        const int t = it >> 5, cg = it & 31, c0 = 8 * cg;
        float cur[8], prv[8], o[8];
        unpack8(*(const u32x4*)(P + (size_t)t * DIN + 1536 + c0), cur);
        if ((t & (SEQ - 1)) != 0) unpack8(*(const u32x4*)(P + (size_t)(t - 1) * DIN + 1536 + c0), prv);
        else {
#pragma unroll
            for (int j = 0; j < 8; ++j) prv[j] = 0.f; }
#pragma unroll
        for (int j = 0; j < 8; ++j) { const float v = cur[j] + (prv[j] - cur[j]) * mu[c0 + j];
            o[j] = c0 < 64 ? tanhf(v) : (c0 < 128 ? v : sigmoidf_(v)); }
        *(u32x4*)(ALR + (size_t)t * 256 + c0) = pack8(o);
    }
}

__device__ __forceinline__ void rwkv_full(ArgsRef a, int l, LAS unsigned char* lds, int job, int tid) {
    const bf16_t* P = (const bf16_t*)(a.ws + WS_PROJ); const bf16_t* LR = (const bf16_t*)(a.ws + WS_LRO); bf16_t* Y = (bf16_t*)(a.ws + WS_YC);
    LAS float* sR = (LAS float*)lds; LAS float* sW = sR + 4096; LAS float* sK = sW + 4096; LAS float* sKK = sK + 4096; LAS float* sB = sKK + 4096;
    LAS float* sV = sB + 4096; LAS float* sO = sV + 4096; LAS float* sBon = sO + 4096;
    const int wave = tid >> 6, lane = tid & 63, tt = tid >> 3, cg = tid & 7;
    const int b = job >> 3, h = job & 7, c0 = 64 * h + 8 * cg;
    float mur[8], muk[8], muv[8], kkw[8], kaw[8], rkw[8], lnw[8], lnb[8];
#pragma unroll
    for (int j = 0; j < 8; ++j) {
        mur[j] = ((const float*)a.in[8])[(size_t)l * 1792 + c0 + j]; muk[j] = ((const float*)a.in[8])[(size_t)l * 1792 + 512 + c0 + j]; muv[j] = ((const float*)a.in[8])[(size_t)l * 1792 + 1024 + c0 + j];
        kkw[j] = ((const float*)a.in[14])[(size_t)l * 512 + c0 + j]; kaw[j] = ((const float*)a.in[15])[(size_t)l * 512 + c0 + j]; rkw[j] = ((const float*)a.in[16])[(size_t)l * 512 + c0 + j];
        lnw[j] = ((const float*)a.in[17])[(size_t)l * 512 + c0 + j]; lnb[j] = ((const float*)a.in[18])[(size_t)l * 512 + c0 + j]; }
    f32x2 st0 = (f32x2){0.f, 0.f}, st1 = st0, st2 = st0, st3 = st0;
    const int row = 8 * wave + (lane >> 3), jq = lane & 7;
    u32x4 graw[9];
    const u32x4 zero4 = (u32x4){0u, 0u, 0u, 0u};
#define RWF_ISSUE(ch_) do { const int s_ = (ch_) * 64 + tt; const size_t t_ = (size_t)b * SEQ + s_; \
        graw[0] = *(const u32x4*)(P + t_ * DIN + c0); graw[1] = *(const u32x4*)(P + t_ * DIN + 512 + c0); graw[2] = *(const u32x4*)(P + t_ * DIN + 1024 + c0); \
        if (s_ != 0) { graw[3] = *(const u32x4*)(P + (t_ - 1) * DIN + c0); graw[4] = *(const u32x4*)(P + (t_ - 1) * DIN + 512 + c0); graw[5] = *(const u32x4*)(P + (t_ - 1) * DIN + 1024 + c0); } \
        else { graw[3] = zero4; graw[4] = zero4; graw[5] = zero4; } \
        graw[6] = *(const u32x4*)(LR + t_ * 1536 + c0); graw[7] = *(const u32x4*)(LR + t_ * 1536 + 512 + c0); graw[8] = *(const u32x4*)(LR + t_ * 1536 + 1024 + c0); } while (0)
    RWF_ISSUE(0);
    for (int ch = 0; ch < SEQ / 64; ++ch) {
        __syncthreads();
        float gate[8];
        {
            float r[8], k[8], v[8], pr[8], ld[8], av[8];
            unpack8(graw[0], r); unpack8(graw[1], k); unpack8(graw[2], v);
            unpack8(graw[3], pr);
#pragma unroll
            for (int j = 0; j < 8; ++j) r[j] += (pr[j] - r[j]) * mur[j];
            unpack8(graw[4], pr);
#pragma unroll
            for (int j = 0; j < 8; ++j) k[j] += (pr[j] - k[j]) * muk[j];
            unpack8(graw[5], pr);
#pragma unroll
            for (int j = 0; j < 8; ++j) v[j] += (pr[j] - v[j]) * muv[j];
            unpack8(graw[6], ld); unpack8(graw[7], av); unpack8(graw[8], gate);
            if (ch + 1 < SEQ / 64) RWF_ISSUE(ch + 1);
            float kk[8], ss = 0.f, bp = 0.f;
#pragma unroll
            for (int j = 0; j < 8; ++j) { kk[j] = k[j] * kkw[j]; ss += kk[j] * kk[j]; }
            ss = red8(ss);
            const float inv = __builtin_amdgcn_rsqf(fmaxf(ss, 1e-24f));
            float w8[8], k8[8], b8[8];
#pragma unroll
            for (int j = 0; j < 8; ++j) { kk[j] *= inv; k8[j] = k[j] * (1.0f + (av[j] - 1.0f) * kaw[j]); b8[j] = kk[j] * av[j]; w8[j] = __expf(ld[j]); bp += r[j] * k8[j] * rkw[j]; }
            bp = red8(bp);
            if (cg == 0) sBon[tt] = bp;
            LAS float* d;
            d = sR + tt * 64 + 8 * cg; *(LAS f32x4*)d = (f32x4){r[0], r[1], r[2], r[3]}; *(LAS f32x4*)(d + 4) = (f32x4){r[4], r[5], r[6], r[7]};
            d = sW + tt * 64 + 8 * cg; *(LAS f32x4*)d = (f32x4){w8[0], w8[1], w8[2], w8[3]}; *(LAS f32x4*)(d + 4) = (f32x4){w8[4], w8[5], w8[6], w8[7]};
            d = sK + tt * 64 + 8 * cg; *(LAS f32x4*)d = (f32x4){k8[0], k8[1], k8[2], k8[3]}; *(LAS f32x4*)(d + 4) = (f32x4){k8[4], k8[5], k8[6], k8[7]};
            d = sKK + tt * 64 + 8 * cg; *(LAS f32x4*)d = (f32x4){kk[0], kk[1], kk[2], kk[3]}; *(LAS f32x4*)(d + 4) = (f32x4){kk[4], kk[5], kk[6], kk[7]};
            d = sB + tt * 64 + 8 * cg; *(LAS f32x4*)d = (f32x4){b8[0], b8[1], b8[2], b8[3]}; *(LAS f32x4*)(d + 4) = (f32x4){b8[4], b8[5], b8[6], b8[7]};
            d = sV + tt * 64 + 8 * cg; *(LAS f32x4*)d = (f32x4){v[0], v[1], v[2], v[3]}; *(LAS f32x4*)(d + 4) = (f32x4){v[4], v[5], v[6], v[7]};
        }
        __syncthreads();
        {
#define RWF_LD(arr, s_) const f32x4 arr##a = *(const LAS f32x4*)(arr + (s_) * 64 + 8 * jq), arr##b = *(const LAS f32x4*)(arr + (s_) * 64 + 8 * jq + 4)
            f32x4 w_a = *(const LAS f32x4*)(sW + 8 * jq), w_b = *(const LAS f32x4*)(sW + 8 * jq + 4), kk_a = *(const LAS f32x4*)(sKK + 8 * jq), kk_b = *(const LAS f32x4*)(sKK + 8 * jq + 4),
                  b_a = *(const LAS f32x4*)(sB + 8 * jq), b_b = *(const LAS f32x4*)(sB + 8 * jq + 4), k_a = *(const LAS f32x4*)(sK + 8 * jq), k_b = *(const LAS f32x4*)(sK + 8 * jq + 4),
                  r_a = *(const LAS f32x4*)(sR + 8 * jq), r_b = *(const LAS f32x4*)(sR + 8 * jq + 4);
            float vi = sV[row];
            f32x2 pyp = (f32x2){0.f, 0.f}; float ykeep = 0.f;
#pragma unroll 1
            for (int s8 = 0; s8 < 64; s8 += 8) {
#pragma unroll
                for (int u = 0; u < 8; ++u) {
                    const int sn = (s8 + u + 1) & 63;
                    RWF_LD(sW, sn); RWF_LD(sKK, sn); RWF_LD(sB, sn); RWF_LD(sK, sn); RWF_LD(sR, sn);
                    const float nvi = sV[sn * 64 + row];
                    f32x2 pa = st0 * (f32x2){kk_a.x, kk_a.y}; pa = pfma(st1, (f32x2){kk_a.z, kk_a.w}, pa); pa = pfma(st2, (f32x2){kk_b.x, kk_b.y}, pa); pa = pfma(st3, (f32x2){kk_b.z, kk_b.w}, pa);
                    float av = pa.x + pa.y, yv = pyp.x + pyp.y;
                    av += dpp<XOR1>(av); yv += dpp<XOR1>(yv); av += dpp<XOR2>(av); yv += dpp<XOR2>(yv); av += dpp<XOR7>(av); yv += dpp<XOR7>(yv);
                    if (u > 0) ykeep = (jq == u - 1) ? yv : ykeep;
                    else if (s8 > 0) { ykeep = (jq == 7) ? yv : ykeep; sO[(s8 - 8 + jq) * 64 + row] = ykeep; }
                    const float sa = -av;
                    const f32x2 sa2 = (f32x2){sa, sa}, vi2 = (f32x2){vi, vi};
                    st0 = pfma(st0, (f32x2){w_a.x, w_a.y}, pfma(vi2, (f32x2){k_a.x, k_a.y}, sa2 * (f32x2){b_a.x, b_a.y}));
                    st1 = pfma(st1, (f32x2){w_a.z, w_a.w}, pfma(vi2, (f32x2){k_a.z, k_a.w}, sa2 * (f32x2){b_a.z, b_a.w}));
                    st2 = pfma(st2, (f32x2){w_b.x, w_b.y}, pfma(vi2, (f32x2){k_b.x, k_b.y}, sa2 * (f32x2){b_b.x, b_b.y}));
                    st3 = pfma(st3, (f32x2){w_b.z, w_b.w}, pfma(vi2, (f32x2){k_b.z, k_b.w}, sa2 * (f32x2){b_b.z, b_b.w}));
                    pyp = st0 * (f32x2){r_a.x, r_a.y}; pyp = pfma(st1, (f32x2){r_a.z, r_a.w}, pyp); pyp = pfma(st2, (f32x2){r_b.x, r_b.y}, pyp); pyp = pfma(st3, (f32x2){r_b.z, r_b.w}, pyp);
                    w_a = sWa; w_b = sWb; kk_a = sKKa; kk_b = sKKb; b_a = sBa; b_b = sBb; k_a = sKa; k_b = sKb; r_a = sRa; r_b = sRb; vi = nvi;
                }
            }
            const float yv = red8(pyp.x + pyp.y);
            ykeep = (jq == 7) ? yv : ykeep; sO[(56 + jq) * 64 + row] = ykeep;
#undef RWF_LD
        }
        __syncthreads();
        {
            const size_t t = (size_t)b * SEQ + ch * 64 + tt;
            const f32x4 o0 = *(const LAS f32x4*)(sO + tt * 64 + 8 * cg), o1 = *(const LAS f32x4*)(sO + tt * 64 + 8 * cg + 4);
            const f32x4 v0 = *(const LAS f32x4*)(sV + tt * 64 + 8 * cg), v1 = *(const LAS f32x4*)(sV + tt * 64 + 8 * cg + 4);
            float o[8] = {o0.x, o0.y, o0.z, o0.w, o1.x, o1.y, o1.z, o1.w}; const float vv[8] = {v0.x, v0.y, v0.z, v0.w, v1.x, v1.y, v1.z, v1.w};
            float sm = 0.f;
#pragma unroll
            for (int j = 0; j < 8; ++j) sm += o[j];
            const float mean = red8(sm) * (1.0f / 64.0f);
            float q = 0.f;
#pragma unroll
            for (int j = 0; j < 8; ++j) { o[j] -= mean; q += o[j] * o[j]; }
            const float rstd = __builtin_amdgcn_rsqf(red8(q) * (1.0f / 64.0f) + 64e-5f);
            const float bon = sBon[tt];
            float y[8];
#pragma unroll
            for (int j = 0; j < 8; ++j) y[j] = (o[j] * rstd * lnw[j] + lnb[j] + bon * vv[j]) * gate[j];
            *(u32x4*)(Y + t * D + c0) = pack8(y);
        }
    }
#undef RWF_ISSUE
}

__device__ __forceinline__ void hgrn_full(ArgsRef a, int l, LAS unsigned char* lds, int job, int tid) {
    const bf16_t* P = (const bf16_t*)(a.ws + WS_PROJ); bf16_t* Y = (bf16_t*)(a.ws + WS_YC);
    LAS float* sQ = (LAS float*)lds; LAS float* sF = sQ + 4096; LAS float* sV = sF + 4096; LAS float* sO = sV + 4096;
    const int wave = tid >> 6, lane = tid & 63, tt = tid >> 3, cg = tid & 7;
    const float* lbp = (const float*)a.in[32];
    const int b = job >> 3, h = job & 7, c0 = 64 * h + 8 * cg;
    float lb[8], gn[8];
#pragma unroll
    for (int j = 0; j < 8; ++j) { lb[j] = (l == 0) ? 0.f : sigmoidf_(lbp[512 + c0 + j] - lbp[c0 + j]); gn[j] = ((const float*)a.in[33])[(size_t)l * 64 + 8 * cg + j]; }
    f32x2 st0 = (f32x2){0.f, 0.f}, st1 = st0, st2 = st0, st3 = st0;
    const int col = 8 * wave + (lane >> 3), dq = lane & 7;
    u32x4 gq, gf, gv, gg;
#define HGF_ISSUE(ch_) do { const size_t t_ = (size_t)b * SEQ + (ch_) * 64 + tt; gq = *(const u32x4*)(P + t_ * DIN + C_HG + c0); gf = *(const u32x4*)(P + t_ * DIN + C_HG + 512 + c0); \
        gv = *(const u32x4*)(P + t_ * DIN + C_HG + 1024 + c0); gg = *(const u32x4*)(P + t_ * DIN + C_HG + 1536 + c0); } while (0)
    HGF_ISSUE(0);
    for (int ch = 0; ch < SEQ / 64; ++ch) {
        __syncthreads();
        float gate[8];
        {
            float q[8], f[8], v[8];
            unpack8(gq, q); unpack8(gf, f); unpack8(gv, v); unpack8(gg, gate);
            if (ch + 1 < SEQ / 64) HGF_ISSUE(ch + 1);
#pragma unroll
            for (int j = 0; j < 8; ++j) { q[j] = siluf_(q[j]) * 0.125f; f[j] = lb[j] + (1.0f - lb[j]) * sigmoidf_(f[j]); }
            LAS float* d;
            d = sQ + tt * 64 + 8 * cg; *(LAS f32x4*)d = (f32x4){q[0], q[1], q[2], q[3]}; *(LAS f32x4*)(d + 4) = (f32x4){q[4], q[5], q[6], q[7]};
            d = sF + tt * 64 + 8 * cg; *(LAS f32x4*)d = (f32x4){f[0], f[1], f[2], f[3]}; *(LAS f32x4*)(d + 4) = (f32x4){f[4], f[5], f[6], f[7]};
            d = sV + tt * 64 + 8 * cg; *(LAS f32x4*)d = (f32x4){v[0], v[1], v[2], v[3]}; *(LAS f32x4*)(d + 4) = (f32x4){v[4], v[5], v[6], v[7]};
        }
        __syncthreads();
        {
            f32x4 f_a = *(const LAS f32x4*)(sF + 8 * dq), f_b = *(const LAS f32x4*)(sF + 8 * dq + 4), q_a = *(const LAS f32x4*)(sQ + 8 * dq), q_b = *(const LAS f32x4*)(sQ + 8 * dq + 4);
            float vi = sV[col];
            float ykeep = 0.f;
#pragma unroll 1
            for (int s8 = 0; s8 < 64; s8 += 8) {
#pragma unroll
                for (int u = 0; u < 8; ++u) {
                    const int sn = (s8 + u + 1) & 63;
                    const f32x4 nf_a = *(const LAS f32x4*)(sF + sn * 64 + 8 * dq), nf_b = *(const LAS f32x4*)(sF + sn * 64 + 8 * dq + 4),
                                nq_a = *(const LAS f32x4*)(sQ + sn * 64 + 8 * dq), nq_b = *(const LAS f32x4*)(sQ + sn * 64 + 8 * dq + 4);
                    const float nvi = sV[sn * 64 + col];
                    const f32x2 vi2 = (f32x2){vi, vi};
                    st0 = pfma((f32x2){f_a.x, f_a.y}, st0 - vi2, vi2); st1 = pfma((f32x2){f_a.z, f_a.w}, st1 - vi2, vi2);
                    st2 = pfma((f32x2){f_b.x, f_b.y}, st2 - vi2, vi2); st3 = pfma((f32x2){f_b.z, f_b.w}, st3 - vi2, vi2);
                    f32x2 py = st0 * (f32x2){q_a.x, q_a.y}; py = pfma(st1, (f32x2){q_a.z, q_a.w}, py); py = pfma(st2, (f32x2){q_b.x, q_b.y}, py); py = pfma(st3, (f32x2){q_b.z, q_b.w}, py);
                    const float y = red8(py.x + py.y);
                    ykeep = (dq == u) ? y : ykeep;
                    f_a = nf_a; f_b = nf_b; q_a = nq_a; q_b = nq_b; vi = nvi;
                }
                sO[(s8 + dq) * 64 + col] = ykeep;
            }
        }
        __syncthreads();
        {
            const size_t t = (size_t)b * SEQ + ch * 64 + tt;
            const f32x4 o0 = *(const LAS f32x4*)(sO + tt * 64 + 8 * cg), o1 = *(const LAS f32x4*)(sO + tt * 64 + 8 * cg + 4);
            const float o[8] = {o0.x, o0.y, o0.z, o0.w, o1.x, o1.y, o1.z, o1.w};
            float q = 0.f;
#pragma unroll
            for (int j = 0; j < 8; ++j) q += o[j] * o[j];
            const float rs = __builtin_amdgcn_rsqf(red8(q) * (1.0f / 64.0f) + 1e-6f);
            float y[8];
#pragma unroll
            for (int j = 0; j < 8; ++j) y[j] = o[j] * rs * gn[j] * siluf_(gate[j]);
            *(u32x4*)(Y + t * D + 1536 + c0) = pack8(y);
        }
    }
#undef HGF_ISSUE
}

__device__ __forceinline__ void attn_phase(ArgsRef a, int l, LAS unsigned char* lds) {
    const int TID = opaque_tid(), BID = opaque_bid();
    const bf16_t* P = (const bf16_t*)(a.ws + WS_PROJ); bf16_t* Y = (bf16_t*)(a.ws + WS_YC);
    const int* pos = (const int*)a.in[1];
    const float* qn = (const float*)a.in[19] + (size_t)l * 64; const float* kn = (const float*)a.in[20] + (size_t)l * 64; const float* sinks = (const float*)a.in[21] + (size_t)l * 8;
    constexpr int KST = 144, VST = 528;
    LAS unsigned char* sK = lds; LAS unsigned char* sVt = sK + 256 * KST; LAS unsigned char* sQ = sVt + 64 * VST; LAS float* sM = (LAS float*)(sQ + 512 * KST);
    const int tid = TID, cg = tid & 7, wave = tid >> 6, lane = tid & 63;
    float kmaxg = 0.f;
    for (int j = 0; j < 64; ++j) kmaxg = fmaxf(kmaxg, fabsf(kn[j]));
    const float kbound = 8.0f * kmaxg;
    float gk[8], gq[8], invf[8];
#pragma unroll
    for (int j = 0; j < 8; ++j) { gk[j] = kn[8 * cg + j]; gq[j] = qn[8 * cg + j]; invf[j] = exp2f(-(float)j * (18.931568569324174f / 8.0f)); }
    for (int job = BID; job < 512; job += gridDim.x) {
        const int b = job >> 5, nb = (job >> 1) & 15, kvh = job & 1;
        __syncthreads();
#pragma unroll 1
        for (int r = 0; r < 4; ++r) {
            const int kj = (tid >> 3) + 64 * r, s = (nb - 1) * 128 + kj;
            float k[8], v[8];
            if (s >= 0) {
                const size_t t = (size_t)b * SEQ + s;
                unpack8(*(const u32x4*)(P + t * DIN + C_ATT + 512 + 64 * kvh + 8 * cg), k); unpack8(*(const u32x4*)(P + t * DIN + C_ATT + 640 + 64 * kvh + 8 * cg), v);
            } else {
#pragma unroll
                for (int j = 0; j < 8; ++j) { k[j] = 0.f; v[j] = 0.f; } }
            float ss = 0.f;
#pragma unroll
            for (int j = 0; j < 8; ++j) ss += k[j] * k[j];
            ss = red8(ss);
            const float rs = __builtin_amdgcn_rsqf(ss * (1.0f / 64.0f) + 1e-6f);
#pragma unroll
            for (int j = 0; j < 8; ++j) k[j] = k[j] * rs * gk[j];
            const float pf = (float)pos[b * SEQ + (s >= 0 ? s : 0)];
#pragma unroll
            for (int j = 0; j < 8; ++j) {
                const float other = dpp<XOR1>(k[j]);
                if (cg < 2) { float sn, cs; sincos_big(pf * invf[j], sn, cs); k[j] = (cg == 0) ? (k[j] * cs - other * sn) : (k[j] * cs + other * sn); }
            }
            *(LAS u32x4*)(sK + kj * KST + 16 * cg) = pack8(k);
#pragma unroll
            for (int j = 0; j < 8; j += 2) { const unsigned w = pk2(v[j], v[j + 1]);
                *(LAS unsigned short*)(sVt + (8 * cg + j) * VST + 2 * kj) = (unsigned short)(w & 0xffffu); *(LAS unsigned short*)(sVt + (8 * cg + j + 1) * VST + 2 * kj) = (unsigned short)(w >> 16); }
        }
#pragma unroll 1
        for (int r = 0; r < 8; ++r) {
            const int row = (tid >> 3) + 64 * r, g = row >> 7, qi = row & 127, hq = 4 * kvh + g;
            const size_t tq = (size_t)b * SEQ + nb * 128 + qi;
            float q[8];
            unpack8(*(const u32x4*)(P + tq * DIN + C_ATT + 64 * hq + 8 * cg), q);
            float ss = 0.f;
#pragma unroll
            for (int j = 0; j < 8; ++j) ss += q[j] * q[j];
            ss = red8(ss);
            const float rs = 0.125f * __builtin_amdgcn_rsqf(ss * (1.0f / 64.0f) + 1e-6f);
#pragma unroll
            for (int j = 0; j < 8; ++j) q[j] = q[j] * rs * gq[j];
            const float pf = (float)pos[b * SEQ + nb * 128 + qi];
            float qq = 0.f;
#pragma unroll
            for (int j = 0; j < 8; ++j) {
                const float other = dpp<XOR1>(q[j]);
                if (cg < 2) { float sn, cs; sincos_big(pf * invf[j], sn, cs); q[j] = (cg == 0) ? (q[j] * cs - other * sn) : (q[j] * cs + other * sn); }
                qq += q[j] * q[j];
            }
            qq = red8(qq);
            if (cg == 0) sM[row] = sqrtf(qq) * kbound;
            *(LAS u32x4*)(sQ + row * KST + 16 * cg) = pack8(q);
        }
        __syncthreads();
        const int g = wave >> 1, qh = wave & 1, hq = 4 * kvh + g, fr = lane & 15, fq = lane >> 4;
        const float sinkv = sinks[hq];
#pragma unroll 1
        for (int qt = 0; qt < 4; ++qt) {
            const int qi0 = 64 * qh + 16 * qt, R0 = g * 128 + qi0, kt0 = qi0 >> 4;
            const bf16x8 qf0 = *(const LAS bf16x8*)(sQ + (R0 + fr) * KST + 16 * fq), qf1 = *(const LAS bf16x8*)(sQ + (R0 + fr) * KST + 16 * fq + 64);
            const float msh = sM[R0 + fr];
            const int ql = qi0 + fr;
            f32x4 oacc[4];
#pragma unroll
            for (int dt = 0; dt < 4; ++dt) oacc[dt] = (f32x4){0.f, 0.f, 0.f, 0.f};
            float lsum = 0.f;
#pragma unroll
            for (int ks = 0; ks < 5; ++ks) {
                unsigned pw[4];
#pragma unroll
                for (int h2 = 0; h2 < 2; ++h2) {
                    const int ti = 2 * ks + h2, kt = (kt0 + ti) < 15 ? (kt0 + ti) : 15;
                    const bf16x8 kf0 = *(const LAS bf16x8*)(sK + (16 * kt + fr) * KST + 16 * fq), kf1 = *(const LAS bf16x8*)(sK + (16 * kt + fr) * KST + 16 * fq + 64);
                    f32x4 sc = (f32x4){0.f, 0.f, 0.f, 0.f};
                    sc = __builtin_amdgcn_mfma_f32_16x16x32_bf16(kf0, qf0, sc, 0, 0, 0);
                    sc = __builtin_amdgcn_mfma_f32_16x16x32_bf16(kf1, qf1, sc, 0, 0, 0);
                    float p[4];
#pragma unroll
                    for (int j = 0; j < 4; ++j) { const int kj = 16 * (kt0 + ti) + 4 * fq + j;
                        const bool valid = (kj > ql) && (kj <= ql + 128) && (nb > 0 || kj >= 128);
                        p[j] = valid ? __expf(sc[j] - msh) : 0.f; lsum += p[j]; }
                    pw[2 * h2] = pk2(p[0], p[1]); pw[2 * h2 + 1] = pk2(p[2], p[3]);
                }
                const u32x4 pq = (u32x4){pw[0], pw[1], pw[2], pw[3]};
                const bf16x8 pf = __builtin_bit_cast(bf16x8, pq);
                const int kta = (kt0 + 2 * ks) < 15 ? (kt0 + 2 * ks) : 15, ktb = (kt0 + 2 * ks + 1) < 15 ? (kt0 + 2 * ks + 1) : 15;
#pragma unroll
                for (int dt = 0; dt < 4; ++dt) {
                    const u32x2 va = *(const LAS u32x2*)(sVt + (16 * dt + fr) * VST + (16 * kta + 4 * fq) * 2), vb = *(const LAS u32x2*)(sVt + (16 * dt + fr) * VST + (16 * ktb + 4 * fq) * 2);
                    const u32x4 vq = (u32x4){va.x, va.y, vb.x, vb.y};
                    oacc[dt] = __builtin_amdgcn_mfma_f32_16x16x32_bf16(__builtin_bit_cast(bf16x8, vq), pf, oacc[dt], 0, 0, 0);
                }
            }
            lsum += __shfl_xor(lsum, 16); lsum += __shfl_xor(lsum, 32);
            const float inv = __builtin_amdgcn_rcpf(lsum + __expf(sinkv - msh));
            const size_t tq = (size_t)b * SEQ + nb * 128 + ql;
#pragma unroll
            for (int dt = 0; dt < 4; ++dt) { u32x2 w; w.x = pk2(oacc[dt][0] * inv, oacc[dt][1] * inv); w.y = pk2(oacc[dt][2] * inv, oacc[dt][3] * inv);
                *(u32x2*)(Y + tq * D + 512 + 64 * hq + 16 * dt + 4 * fq) = w; }
        }
    }
    __syncthreads();
}

__device__ __forceinline__ float gelu_erf(float v) {
    const float t = __builtin_amdgcn_rcpf(fabsf(v) * 0.2316418882f + 1.0f);
    float q = t * 0.5307027145f + (-0.7265760135f); q = q * t + 0.7107068705f; q = q * t + (-0.142248368f); q = q * t + 0.127414796f; q = q * t;
    const float e = __builtin_amdgcn_exp2f(v * v * (-0.72134752044f));
    const float m = v * (q * e);
    return v < 0.f ? m : v - m;
}
__device__ __forceinline__ void s5_jobs(ArgsRef a, int l, LAS unsigned char* lds, unsigned* qctr) {
    const int TID = opaque_tid();
    LAS int* sJob = (LAS int*)(lds + 8 * 16 * 130 * 4 + 4096);
    const bf16_t* P = (const bf16_t*)(a.ws + WS_PROJ); bf16_t* Z = (bf16_t*)(a.ws + WS_Z);
    const int tid = TID, wave = tid >> 6, lane = tid & 63, fr16 = lane & 15, fq = lane >> 4;
    LAS float* sX = (LAS float*)lds + wave * (16 * 130);
    LAS float* sE = (LAS float*)lds + 8 * 16 * 130;
    for (;;) {
        if (TID == 0) *sJob = (int)__hip_atomic_fetch_add(qctr, 1u, __ATOMIC_RELAXED, __HIP_MEMORY_SCOPE_AGENT);
        __syncthreads();
        const int job = *sJob;
        if (job >= 512) break;
        const int b = job >> 5, g = job & 31;
        const float dt = expf(((const float*)a.in[24])[l * 32 + g]);
        float lbr, lbi;
        { const float lre = ((const float*)a.in[22])[(size_t)l * 2048 + g * 64 + lane], lim = ((const float*)a.in[23])[(size_t)l * 2048 + g * 64 + lane];
          float sn, cs; sincos_big(lim * dt, sn, cs); const float er = expf(lre * dt); lbr = er * cs; lbi = er * sn; }
        bf16x8 bfrag[8];
#pragma unroll
        for (int k = 0; k < 4; ++k) {
            const int p = fr16 + 16 * k;
            const float lre = ((const float*)a.in[22])[(size_t)l * 2048 + g * 64 + p], lim = ((const float*)a.in[23])[(size_t)l * 2048 + g * 64 + p];
            float sn, cs; sincos_big(lim * dt, sn, cs); const float er = expf(lre * dt), pbr = er * cs, pbi = er * sn;
            const float den = __builtin_amdgcn_rcpf(lre * lre + lim * lim);
            const float fr = ((pbr - 1.0f) * lre + pbi * lim) * den, fi = (pbi * lre - (pbr - 1.0f) * lim) * den;
            const float* brp = (const float*)a.in[25] + ((size_t)l * 2048 + g * 64 + p) * 16 + 8 * (fq & 1);
            const float* bip = (const float*)a.in[26] + ((size_t)l * 2048 + g * 64 + p) * 16 + 8 * (fq & 1);
            float vr[8], vi[8];
#pragma unroll
            for (int i = 0; i < 8; ++i) { const float br = brp[i], bi = bip[i]; float xr = fr * br - fi * bi, xi = fr * bi + fi * br;
                const unsigned hw = pk2(xr, xi);
                if (fq >= 2) { xr -= bflo(hw); xi -= bfhi(hw); }
                vr[i] = xr; vi[i] = xi; }
            bfrag[k] = __builtin_bit_cast(bf16x8, pack8(vr)); bfrag[4 + k] = __builtin_bit_cast(bf16x8, pack8(vi));
        }
        float creg[32];
        {
            const float* cre = (const float*)a.in[27] + ((size_t)l * 32 + g) * 1024 + fr16 * 64 + fq;
            const float* cim = (const float*)a.in[28] + ((size_t)l * 32 + g) * 1024 + fr16 * 64 + fq;
#pragma unroll
            for (int kk = 0; kk < 16; ++kk) { creg[kk] = cre[4 * kk]; creg[16 + kk] = -cim[4 * kk]; }
        }
        f32x4 dsk;
        { const float* dp = (const float*)a.in[29] + (size_t)l * 512 + 16 * g + 4 * fq; dsk = (f32x4){dp[0], dp[1], dp[2], dp[3]}; }
        const size_t tbase = (size_t)b * SEQ + wave * 256;
        const bf16_t* ua = P + (tbase + fr16) * DIN + C_S5 + 16 * g + 8 * (fq & 1);
        const bf16_t* ue = P + (tbase + fr16) * DIN + C_S5 + 16 * g + 4 * fq;
        f32x2 xs = (f32x2){0.f, 0.f}; const f32x2 lbr2 = (f32x2){lbr, lbr}, lbi2 = (f32x2){lbi, lbi};
        {
            u32x4 au = *(const u32x4*)ua;
#pragma unroll 1
            for (int gi = 0; gi < 16; ++gi) {
                const bf16x8 af = __builtin_bit_cast(bf16x8, au);
                if (gi + 1 < 16) au = *(const u32x4*)(ua + (size_t)(gi + 1) * 16 * DIN);
#pragma unroll
                for (int nt = 0; nt < 8; ++nt) { const f32x4 d = __builtin_amdgcn_mfma_f32_16x16x32_bf16(af, bfrag[nt], (f32x4){0.f, 0.f, 0.f, 0.f}, 0, 0, 0);
#pragma unroll
                    for (int j = 0; j < 4; ++j) sX[(4 * fq + j) * 130 + fr16 + 16 * nt] = d[j]; }
                LDS_FENCE();
#pragma unroll
                for (int s = 0; s < 16; ++s) { const f32x2 bu = (f32x2){sX[s * 130 + lane], sX[s * 130 + 64 + lane]};
                    const f32x2 nx = pfma(lbr2, xs, bu); xs = pfma(lbi2, (f32x2){-xs.y, xs.x}, nx); }
                LDS_FENCE();
            }
        }
        sE[wave * 128 + lane] = xs.x; sE[wave * 128 + 64 + lane] = xs.y;
        float pr = lbr, pi = lbi;
#pragma unroll
        for (int i = 0; i < 8; ++i) { const float nr = pr * pr - pi * pi, ni = 2.0f * pr * pi; pr = nr; pi = ni; }
        __syncthreads();
        xs = (f32x2){0.f, 0.f};
        for (int w = 0; w < wave; ++w) { const float er_ = sE[w * 128 + lane], ei_ = sE[w * 128 + 64 + lane];
            const float nr = pr * xs.x - pi * xs.y + er_, ni = pr * xs.y + pi * xs.x + ei_; xs.x = nr; xs.y = ni; }
        {
            u32x4 au = *(const u32x4*)ua; u32x2 eu = *(const u32x2*)ue;
#pragma unroll 1
            for (int gi = 0; gi < 16; ++gi) {
                const bf16x8 af = __builtin_bit_cast(bf16x8, au); const u32x2 eun = eu;
                if (gi + 1 < 16) { au = *(const u32x4*)(ua + (size_t)(gi + 1) * 16 * DIN); eu = *(const u32x2*)(ue + (size_t)(gi + 1) * 16 * DIN); }
#pragma unroll
                for (int nt = 0; nt < 8; ++nt) { const f32x4 d = __builtin_amdgcn_mfma_f32_16x16x32_bf16(af, bfrag[nt], (f32x4){0.f, 0.f, 0.f, 0.f}, 0, 0, 0);
#pragma unroll
                    for (int j = 0; j < 4; ++j) sX[(4 * fq + j) * 130 + fr16 + 16 * nt] = d[j]; }
                LDS_FENCE();
#pragma unroll
                for (int s = 0; s < 16; ++s) { const f32x2 bu = (f32x2){sX[s * 130 + lane], sX[s * 130 + 64 + lane]};
                    const f32x2 nx = pfma(lbr2, xs, bu); xs = pfma(lbi2, (f32x2){-xs.y, xs.x}, nx);
                    sX[s * 130 + lane] = xs.x; sX[s * 130 + 64 + lane] = xs.y; }
                LDS_FENCE();
                f32x4 yacc = (f32x4){0.f, 0.f, 0.f, 0.f}, yacc1 = yacc, yacc2 = yacc, yacc3 = yacc;
                const LAS float* xp = sX + fr16 * 130 + fq;
#pragma unroll
                for (int kk = 0; kk < 32; kk += 4) {
                    yacc = __builtin_amdgcn_mfma_f32_16x16x4f32(creg[kk], xp[4 * kk], yacc, 0, 0, 0);
                    yacc1 = __builtin_amdgcn_mfma_f32_16x16x4f32(creg[kk + 1], xp[4 * kk + 4], yacc1, 0, 0, 0);
                    yacc2 = __builtin_amdgcn_mfma_f32_16x16x4f32(creg[kk + 2], xp[4 * kk + 8], yacc2, 0, 0, 0);
                    yacc3 = __builtin_amdgcn_mfma_f32_16x16x4f32(creg[kk + 3], xp[4 * kk + 12], yacc3, 0, 0, 0);
                }
                yacc = (yacc + yacc1) + (yacc2 + yacc3);
                const float u0 = bflo(eun.x), u1 = bfhi(eun.x), u2 = bflo(eun.y), u3 = bfhi(eun.y);
                const float z0 = gelu_erf(yacc[0] + dsk[0] * u0), z1 = gelu_erf(yacc[1] + dsk[1] * u1), z2 = gelu_erf(yacc[2] + dsk[2] * u2), z3 = gelu_erf(yacc[3] + dsk[3] * u3);
                u32x2 w; w.x = pk2(z0, z1); w.y = pk2(z2, z3);
                *(u32x2*)(Z + (tbase + gi * 16 + fr16) * 512 + 16 * g + 4 * fq) = w;
                LDS_FENCE();
            }
        }
        __syncthreads();
    }
}

__device__ __forceinline__ void scan_phase(ArgsRef a, int l, LAS unsigned char* lds) {
    const int TID = opaque_tid(), BID = opaque_bid();
    if (gridDim.x == 256) {
        if (BID < 128) rwkv_full(a, l, lds, BID, TID); else hgrn_full(a, l, lds, BID - 128, TID);
    } else {
        for (int job = BID; job < 256; job += gridDim.x) { if (job < 128) rwkv_full(a, l, lds, job, TID); else hgrn_full(a, l, lds, job - 128, TID); __syncthreads(); }
    }
    __syncthreads();
    s5_jobs(a, l, lds, (unsigned*)(a.ws + WS_BAR) + 3584 + 64 * l);
    __syncthreads();
}

#define XB_TMO      128
#define XB_XCNT(j)  (256  + 64 * (j))
#define XB_XSUB(j)  (1280 + 64 * (j))
#define XB_XGEN(j)  (2304 + 64 * (j))
#define XB_TOP      3328
#define XB_TOPGEN   3392
#define XCD_BAR_WORDS 3456
#define XB_SPIN_CAP (1u << 18)

__device__ __forceinline__ unsigned xb_ld(unsigned* p)              { return __hip_atomic_load(p, __ATOMIC_RELAXED, __HIP_MEMORY_SCOPE_AGENT); }
__device__ __forceinline__ unsigned xb_add(unsigned* p, unsigned v) { return __hip_atomic_fetch_add(p, v, __ATOMIC_RELAXED, __HIP_MEMORY_SCOPE_AGENT); }
__device__ __forceinline__ unsigned xb_xcc_id() { return (unsigned)__builtin_amdgcn_s_getreg((3 << 11) | 20) & 0xFu; }
#define XB_SPIN(cond, bar) do { unsigned _sp = 0; while (cond) { __builtin_amdgcn_s_sleep(1); \
    if ((++_sp & 255u) == 0u) { if (xb_ld(&(bar)[XB_TMO])) break; if (_sp > XB_SPIN_CAP) { atomicAdd(&(bar)[XB_TMO], 1u); break; } } } } while (0)

struct XcdBarrier {
    unsigned* bar; unsigned x;
    volatile LAS unsigned* st;
};

__device__ __forceinline__ XcdBarrier xcd_barrier_post(unsigned* bar, volatile LAS unsigned* st) {
    XcdBarrier b; b.bar = bar; b.x = xb_xcc_id(); b.st = st;
    if (threadIdx.x == 0) (void)xb_add(&bar[XB_XCNT(b.x)], 1u);
    return b;
}
__device__ __forceinline__ void xcd_barrier_complete(unsigned* bar, unsigned x, unsigned& nloc, unsigned& nx) {
    const unsigned G = gridDim.x * gridDim.y * gridDim.z;
    unsigned sum, cnt, mine, sp = 0u;
    for (;;) {
        sum = 0u; cnt = 0u; mine = 0u;
#pragma unroll
        for (unsigned j = 0; j < 16; ++j) { const unsigned c = xb_ld(&bar[XB_XCNT(j)]); sum += c; cnt += (c > 0u) ? 1u : 0u; mine = (j == x) ? c : mine; }
        if (sum == G) break;
        __builtin_amdgcn_s_sleep(1);
        if ((++sp & 255u) == 0u) { if (xb_ld(&bar[XB_TMO])) break; if (sp > XB_SPIN_CAP) { atomicAdd(&bar[XB_TMO], 1u); break; } }
    }
    nloc = mine > 0u ? mine : 1u; nx = cnt > 0u ? cnt : 1u;
}

__device__ __forceinline__ void xcd_barrier(const XcdBarrier& b) {
    asm volatile("s_waitcnt vmcnt(0)" ::: "memory");
    __syncthreads();
    if (threadIdx.x == 0) {
        unsigned* bar = b.bar;
        __builtin_amdgcn_s_waitcnt(0);
        unsigned nloc = b.st[0], nx = b.st[1];
        if (nloc == 0u) { xcd_barrier_complete(bar, b.x, nloc, nx); b.st[0] = nloc; b.st[1] = nx; }
        const unsigned old = xb_add(&bar[XB_XSUB(b.x)], 1u);
        const unsigned gen = old / nloc;
        if (old + 1u == (gen + 1u) * nloc) {
            __builtin_amdgcn_fence(__ATOMIC_RELEASE, "agent");
            asm volatile("s_waitcnt vmcnt(0)" ::: "memory");
            const unsigned og = xb_add(&bar[XB_TOP], 1u);
            const unsigned tg = og / nx;
            if (og + 1u == (tg + 1u) * nx) xb_add(&bar[XB_TOPGEN], 1u);
            else XB_SPIN(xb_ld(&bar[XB_TOPGEN]) == tg, bar);
            __builtin_amdgcn_fence(__ATOMIC_ACQUIRE, "agent");
            xb_add(&bar[XB_XGEN(b.x)], 1u);
            asm volatile("s_waitcnt vmcnt(0)" ::: "memory");
        } else {
            XB_SPIN(xb_ld(&bar[XB_XGEN(b.x)]) == gen, bar);
            __builtin_amdgcn_fence(__ATOMIC_ACQUIRE, "agent");
            asm volatile("s_waitcnt vmcnt(0)" ::: "memory");
        }
    }
    __syncthreads();
}


constexpr int NPH = 11;
#ifndef DUPMASK
#define DUPMASK 0
#endif
__global__ void __launch_bounds__(NTHREADS, 2) mega(Args a_, int lo, int hi) {
    extern __shared__ __attribute__((aligned(16))) unsigned char lds_raw[];
    LAS unsigned char* lds = (LAS unsigned char*)lds_raw;
#ifdef EXTRA_SYNCS
    for (int i = 0; i < EXTRA_SYNCS; ++i) { __syncthreads(); cg::this_grid().sync(); }
#endif
    LAS unsigned* xst = (LAS unsigned*)(lds + LDS_BYTES - 16);
    if (hi - lo > 1) {
        if (threadIdx.x == 0) { xst[0] = 0u; xst[1] = 0u; }
        __syncthreads();
        if (blockIdx.x == 0) {
            const __attribute__((address_space(4))) Args* ap0 = (const __attribute__((address_space(4))) Args*)__builtin_amdgcn_kernarg_segment_ptr();
            unsigned* bw = (unsigned*)(ap0->ws + WS_BAR);
            for (int i = threadIdx.x; i < 4096; i += NTHREADS) bw[i] = 0u;
        }
    }
#pragma unroll 1
    for (int step2 = 2 * lo; step2 < 2 * hi; ++step2) {
        const int step = step2 >> 1;
        if ((step2 & 1) && !((DUPMASK >> (step % NPH)) & 1)) continue;
        const __attribute__((address_space(4))) Args* ap = (const __attribute__((address_space(4))) Args*)__builtin_amdgcn_kernarg_segment_ptr();
        asm volatile("" : "+s"(ap));
        ArgsRef a = *ap;
        unsigned char* ws = a.ws;
        float* SSa = (float*)(ws + WS_SS); float* SSb = SSa + T; float* SSc = SSb + T;
        const int l = step / NPH, ph = step % NPH;
        const float* xin = (l == 0) ? (const float*)a.in[0] : (const float*)a.out;
#ifndef PHMASK
#define PHMASK 0x7ff
#endif
        switch (ph) {
        case 0: if (PHMASK & (1 << 0)) { conv_phase(a, l, lds); if (l == 0) norm_phase(xin, (bf16_t*)(ws + WS_XN), SSa); zero_phase(SSb, T); } break;
        case 1: if (PHMASK & (1 << 1)) { pg8::EpiSwiGLU E; E.H = (bf16_t*)(ws + WS_HID); E.SS = SSa; run_gemm(lds, (const bf16_t*)(ws + WS_XN), (const bf16_t*)(ws + W_UP1), 2 * FF, D, E); } break;
        case 2: if (PHMASK & (1 << 2)) { pg8::EpiResidual<true> E; E.base = xin; E.out = a.out; E.XN = (bf16_t*)(ws + WS_XN); E.SS = SSb; run_gemm(lds, (const bf16_t*)(ws + WS_HID), (const bf16_t*)(ws + W_DN1), D, FF, E); } break;
        case 3: if (PHMASK & (1 << 3)) { pg8::EpiBf16 E; E.O = (bf16_t*)(ws + WS_PROJ); E.ldc = DIN; E.SS = SSb; run_gemm(lds, (const bf16_t*)(ws + WS_XN), (const bf16_t*)(ws + W_IN), DIN, D, E); } break;
        case 4: if (PHMASK & (1 << 4)) { zero_phase(SSa, T); zero_phase(SSc, T); alr_phase(a, l); attn_phase(a, l, lds); } break;
        case 5: if (PHMASK & (1 << 5)) { pg8::EpiLR E; E.O = (bf16_t*)(ws + WS_LRO); E.w0 = (const float*)a.in[9] + (size_t)l * 512; E.a0 = (const float*)a.in[11] + (size_t)l * 512;
                  run_gemm(lds, (const bf16_t*)(ws + WS_ALR), (const bf16_t*)(ws + W_LR), 1536, 256, E); } break;
        case 6: if (PHMASK & (1 << 6)) scan_phase(a, l, lds); break;
        case 7: if (PHMASK & (1 << 7)) { pg8::EpiGLU G; G.Z = (const bf16_t*)(ws + WS_Z); G.Y = (bf16_t*)(ws + WS_YC); G.b = (const float*)a.in[31] + (size_t)l * 512;
                  run_gemm(lds, (const bf16_t*)(ws + WS_Z), (const bf16_t*)(ws + W_GLU), 512, 512, G); } break;
        case 8: if (PHMASK & (1 << 8)) { pg8::EpiResidual<false> E; E.base = a.out; E.out = a.out; E.XN = (bf16_t*)(ws + WS_XN); E.SS = SSc; run_gemm(lds, (const bf16_t*)(ws + WS_YC), (const bf16_t*)(ws + W_OUT), D, D, E); } break;
        case 9: if (PHMASK & (1 << 9)) { pg8::EpiSwiGLU E; E.H = (bf16_t*)(ws + WS_HID); E.SS = SSc; run_gemm(lds, (const bf16_t*)(ws + WS_XN), (const bf16_t*)(ws + W_UP2), 2 * FF, D, E); } break;
        case 10: if (PHMASK & (1 << 10)) { pg8::EpiResidual<true> E; E.base = a.out; E.out = a.out; E.XN = (l + 1 < NL) ? (bf16_t*)(ws + WS_XN) : nullptr; E.SS = SSa; run_gemm(lds, (const bf16_t*)(ws + WS_HID), (const bf16_t*)(ws + W_DN2), D, FF, E); } break;
        }
        if (step2 + 1 < 2 * hi) {
            if (step2 == 2 * lo) { __syncthreads(); cg::this_grid().sync(); (void)xcd_barrier_post((unsigned*)(ws + WS_BAR), (volatile LAS unsigned*)xst); }
            else { XcdBarrier xb; xb.bar = (unsigned*)(ws + WS_BAR); xb.x = xb_xcc_id(); xb.st = (volatile LAS unsigned*)xst; xcd_barrier(xb); }
        }
    }
}

extern "C" void kernel_launch(void* const* d_in, const int* in_sizes, int n_in, void* d_out, int out_size, void* d_ws, size_t ws_size, hipStream_t stream) {
    static int grid = 0;
    if (!grid) {
        int dev = 0, cus = 0, per_cu = 0;
        hipGetDevice(&dev);
        hipDeviceGetAttribute(&cus, hipDeviceAttributeMultiprocessorCount, dev);
        hipFuncSetAttribute((const void*)mega, hipFuncAttributeMaxDynamicSharedMemorySize, LDS_BYTES);
        hipOccupancyMaxActiveBlocksPerMultiprocessor(&per_cu, (const void*)mega, NTHREADS, LDS_BYTES);
        if (per_cu < 1) per_cu = 1;
        grid = cus * 1;
        if (grid != 256) fprintf(stderr, "kernel_launch: grid %d (cus %d, per_cu %d)\n", grid, cus, per_cu);
    }
    Args a{};
    for (int i = 0; i < 39; ++i) a.in[i] = d_in[i];
    a.out = (float*)d_out; a.ws = (unsigned char*)d_ws;
#if ONE_LAUNCH
    int lo = 0, hi = NL * NPH;
    void* args[] = {&a, &lo, &hi};
    hipError_t e = hipLaunchCooperativeKernel((void*)mega, dim3(grid), dim3(NTHREADS), args, LDS_BYTES, stream);
    if (e != hipSuccess) fprintf(stderr, "cooperative launch failed: %s (grid %d)\n", hipGetErrorString(e), grid);
#else
    for (int s = 0; s < NL * NPH; ++s) hipLaunchKernelGGL(mega, dim3(grid), dim3(NTHREADS), LDS_BYTES, stream, a, s, s + 1);
#endif
}
```

```cpp
#include <hip/hip_runtime.h>
#include <hip/hip_cooperative_groups.h>
#include <cstdio>
#include <cstdint>
namespace cg = cooperative_groups;

#ifndef ONE_LAUNCH
#define ONE_LAUNCH 1
#endif

#define LAS __attribute__((address_space(3)))
typedef unsigned short bf16_t;
typedef short bf16x8 __attribute__((ext_vector_type(8)));
typedef float f32x4 __attribute__((ext_vector_type(4)));
typedef float f32x2 __attribute__((ext_vector_type(2)));
typedef unsigned u32x4 __attribute__((ext_vector_type(4)));
typedef unsigned u32x2 __attribute__((ext_vector_type(2)));

constexpr int T = 32768, SEQ = 2048, NB = 16, D = 2048, FF = 5632, DIN = 5120, NL = 2;
constexpr int C_RWKV = 0, C_ATT = 1792, C_S5 = 2560, C_HG = 3072;
constexpr int NTHREADS = 512, NWAVES = 8;

constexpr size_t SZ_UP = (size_t)2 * FF * D * 2, SZ_DN = (size_t)D * FF * 2, SZ_IN = (size_t)DIN * D * 2, SZ_LR = (size_t)1536 * 256 * 2,
                 SZ_GLU = (size_t)512 * 512 * 2, SZ_OUT = (size_t)D * D * 2;
constexpr size_t W_UP1 = 0, W_DN1 = W_UP1 + SZ_UP, W_IN = W_DN1 + SZ_DN, W_LR = W_IN + SZ_IN, W_GLU = W_LR + SZ_LR, W_OUT = W_GLU + SZ_GLU,
                 W_UP2 = W_OUT + SZ_OUT, W_DN2 = W_UP2 + SZ_UP, W_END = W_DN2 + SZ_DN;
constexpr size_t WS_XN = W_END, WS_BIG = WS_XN + (size_t)T * D * 2;
constexpr size_t WS_HID = WS_BIG;
constexpr size_t WS_PROJ = WS_BIG, WS_LRO = WS_PROJ + (size_t)T * DIN * 2, WS_ALR = WS_LRO + (size_t)T * 1536 * 2, WS_Z = WS_ALR + (size_t)T * 256 * 2,
                 WS_OR = WS_Z + (size_t)T * 512 * 2, WS_OH = WS_OR + (size_t)T * 512 * 4, WS_BON = WS_OH + (size_t)T * 512 * 4, WS_YC = WS_BON + (size_t)T * 8 * 4, WS_SS = WS_YC + (size_t)T * D * 2, WS_BAR = WS_SS + (size_t)3 * T * 4, WS_END = WS_BAR + 16384;
static_assert(WS_END <= (size_t)1 << 30, "workspace");
static_assert(WS_HID + (size_t)T * FF * 2 <= (size_t)1 << 30, "workspace");

constexpr int LDS_BYTES = 147456;

struct Args { const void* in[39]; float* out; unsigned char* ws; };
typedef const __attribute__((address_space(4))) Args& ArgsRef;

typedef __bf16 bf16x2_t __attribute__((ext_vector_type(2)));
__device__ __forceinline__ unsigned pk2(float lo, float hi) { const f32x2 v = (f32x2){lo, hi}; return __builtin_bit_cast(unsigned, __builtin_convertvector(v, bf16x2_t)); }
__device__ __forceinline__ float bflo(unsigned w) { return __uint_as_float(w << 16); }
__device__ __forceinline__ float bfhi(unsigned w) { return __uint_as_float(w & 0xffff0000u); }
__device__ __forceinline__ void unpack8(u32x4 q, float* f) { f[0] = bflo(q.x); f[1] = bfhi(q.x); f[2] = bflo(q.y); f[3] = bfhi(q.y); f[4] = bflo(q.z); f[5] = bfhi(q.z); f[6] = bflo(q.w); f[7] = bfhi(q.w); }
__device__ __forceinline__ u32x4 pack8(const float* f) { u32x4 o; o.x = pk2(f[0], f[1]); o.y = pk2(f[2], f[3]); o.z = pk2(f[4], f[5]); o.w = pk2(f[6], f[7]); return o; }
template <int CTRL> __device__ __forceinline__ float dpp(float x) { return __builtin_bit_cast(float, __builtin_amdgcn_mov_dpp(__builtin_bit_cast(int, x), CTRL, 0xf, 0xf, true)); }
constexpr int XOR1 = 0xB1, XOR2 = 0x4E, XOR7 = 0x141, XOR8 = 0x128;
__device__ __forceinline__ float red8(float v) { v += dpp<XOR1>(v); v += dpp<XOR2>(v); v += dpp<XOR7>(v); return v; }
__device__ __forceinline__ float red16(float v) { v = red8(v); v += dpp<XOR8>(v); return v; }
__device__ __forceinline__ float wave_sum(float v) {
#pragma unroll
    for (int o = 1; o < 64; o <<= 1) v += __shfl_xor(v, o);
    return v;
}
__device__ __forceinline__ float sigmoidf_(float x) { return __builtin_amdgcn_rcpf(1.0f + __expf(-x)); }
__device__ __forceinline__ float siluf_(float x) { return x * __builtin_amdgcn_rcpf(1.0f + __expf(-x)); }
__device__ __forceinline__ int opaque_tid() { int t = threadIdx.x; asm volatile("" : "+v"(t)); return t; }
__device__ __forceinline__ int opaque_bid() { int t = blockIdx.x; asm volatile("" : "+s"(t)); return t; }
__device__ __forceinline__ f32x2 pfma(f32x2 a, f32x2 b, f32x2 c) { return __builtin_elementwise_fma(a, b, c); }
#define LDS_FENCE() asm volatile("s_waitcnt lgkmcnt(0)" ::: "memory")
__device__ __forceinline__ void sincos_big(float x, float& sn, float& cs) {
    const float n = rintf(x * 0.15915494309189535f);
    float r = fmaf(-n, 6.28318548202514648f, x); r = fmaf(-n, -1.7484555e-7f, r);
    sn = __sinf(r); cs = __cosf(r);
}

namespace pg8 {
constexpr int BM = 256, BK = 64, HALF = 128, HTB = HALF * BK * 2, STAGE_BYTES = 8 * HTB, NXCD = 8, WGM = 8;
__host__ __device__ __forceinline__ int lds_byte(int r, int c) { const int st = (r >> 4) * 2 + (c >> 5), rr = r & 15, cc = c & 31, ob = rr * 64 + cc * 2; return st * 1024 + (ob ^ (((ob >> 9) & 1) << 5)); }
__host__ __device__ __forceinline__ void stage_rc(int b, int& R, int& C) { const int st = b / 1024, sb = b % 1024, swz = sb ^ (((sb >> 9) & 1) << 5); R = (st >> 1) * 16 + swz / 64; C = (st & 1) * 32 + (swz % 64) / 2; }
__host__ __device__ __forceinline__ int perm32(int rho) { const int n = rho >> 4, i = rho & 15; return 8 * (i >> 2) + 4 * n + (i & 3); }
struct Unit { int pm, pn; };
struct Gemm { const bf16_t* A; const bf16_t* Bt; int M, N, K; };
struct StaticOrder {
    int nM, nN, nwg, G, c;
    __device__ void init(int M, int N, int G_, int c_) { nM = M / BM; nN = N / BM; nwg = nM * nN; G = G_; c = c_; }
    __device__ bool next(int i, Unit& u) const {
        const long L = (long)i * G + c; if (L >= nwg) return false;
        int wgid = (int)L; { const int q = nwg / NXCD, r = nwg % NXCD, xcd = wgid % NXCD, off = wgid / NXCD; wgid = (xcd < r ? xcd * (q + 1) : r * (q + 1) + (xcd - r) * q) + off; }
        const int nig = WGM * nN, gid = wgid / nig, fm = gid * WGM, gsz = (nM - fm) < WGM ? (nM - fm) : WGM;
        u.pm = fm + ((wgid % nig) % gsz); u.pn = (wgid % nig) / gsz; return true;
    }
};
template <class Epi>
__device__ __forceinline__ void gemm_phase(LAS unsigned char* lds, const Gemm g, const StaticOrder S, const Epi E) {
    const int TID = opaque_tid(), BID = opaque_bid(); (void)TID; (void)BID;
    const int tid = TID, wid = __builtin_amdgcn_readfirstlane(tid >> 6), lane = tid & 63, wr = wid >> 2, wc = wid & 3, fr = lane & 15, fq = lane >> 4;
    const int K = g.K, nt = K / BK;
    unsigned voffA[2], voffB[2];
#pragma unroll
    for (int i = 0; i < 2; ++i) { int R, C; stage_rc(tid * 16 + i * 8192, R, C); const int Rb = Epi::PERM ? ((R & ~31) + perm32(R & 31)) : R;
        voffA[i] = (unsigned)(R * K + C) * 2u; voffB[i] = (unsigned)(Rb * K + C) * 2u; }
    const size_t kstep = (size_t)(BK * 2);
    const size_t hstep = (size_t)HALF * K * 2;
    const size_t tstep = 2 * hstep;
    const unsigned ldsw = (unsigned)wid * 1024u;
    const int aoff = lds_byte(wr * 64 + fr, fq * 8), boff = lds_byte(wc * 32 + fr, fq * 8);
#define PG8_SA(b, h) (((b) * 2 + (h)) * HTB)
#define PG8_SB(b, h) ((4 + (b) * 2 + (h)) * HTB)
#define PG8_STAGE(bufoff, gbase, voff) do { _Pragma("unroll") for (int _i = 0; _i < 2; ++_i) \
        __builtin_amdgcn_global_load_lds((const unsigned*)((const char*)(gbase) + (voff)[_i]), (LAS unsigned*)(lds + (bufoff) + ldsw + _i * 8192), 16, 0, 0); } while (0)
#define PG8_LDA(dst, b, h) do { _Pragma("unroll") for (int m = 0; m < 4; ++m) _Pragma("unroll") for (int k = 0; k < 2; ++k) dst[m][k] = *(const LAS bf16x8*)(lds + PG8_SA(b, h) + aoff + m * 2048 + k * 1024); } while (0)
#define PG8_LDB(dst, b, h) do { _Pragma("unroll") for (int n = 0; n < 2; ++n) _Pragma("unroll") for (int k = 0; k < 2; ++k) dst[n][k] = *(const LAS bf16x8*)(lds + PG8_SB(b, h) + boff + n * 2048 + k * 1024); } while (0)
#define PG8_MMA(ai, bj, At, Bt) do { __builtin_amdgcn_s_setprio(1); _Pragma("unroll") for (int m = 0; m < 4; ++m) _Pragma("unroll") for (int n = 0; n < 2; ++n) _Pragma("unroll") for (int k = 0; k < 2; ++k) \
        acc[ai][bj][m][n] = __builtin_amdgcn_mfma_f32_16x16x32_bf16(Bt[n][k], At[m][k], acc[ai][bj][m][n], 0, 0, 0); __builtin_amdgcn_s_setprio(0); } while (0)
#define PG8_WAIT_V(n) asm volatile("s_waitcnt vmcnt(" #n ")" ::: "memory")
#define PG8_WAIT_L(n) asm volatile("s_waitcnt lgkmcnt(" #n ")" ::: "memory")
#define PG8_BAR __builtin_amdgcn_s_barrier()
#define PG8_SCHED __builtin_amdgcn_sched_barrier(0)
    Unit cur, nxt; int ui = 0;
    if (!S.next(0, cur)) return;
    f32x4 acc[2][2][4][2];
#pragma unroll
    for (int a = 0; a < 2; ++a)
#pragma unroll
        for (int b = 0; b < 2; ++b)
#pragma unroll
            for (int m = 0; m < 4; ++m)
#pragma unroll
                for (int n = 0; n < 2; ++n) acc[a][b][m][n] = (f32x4){0.f, 0.f, 0.f, 0.f};
    bf16x8 At[4][2], B0[2][2], B1[2][2];
    const char* cA = (const char*)g.A + (size_t)cur.pm * tstep; const char* cB = (const char*)g.Bt + (size_t)cur.pn * tstep;
    PG8_STAGE(PG8_SB(0, 0), cB, voffB); PG8_STAGE(PG8_SA(0, 0), cA, voffA); PG8_STAGE(PG8_SB(0, 1), cB + hstep, voffB); PG8_STAGE(PG8_SA(0, 1), cA + hstep, voffA);
    if (wr == 1) PG8_BAR;
    PG8_WAIT_V(4); PG8_BAR;
    PG8_STAGE(PG8_SB(1, 0), cB + kstep, voffB); PG8_STAGE(PG8_SA(1, 0), cA + kstep, voffA); PG8_STAGE(PG8_SB(1, 1), cB + hstep + kstep, voffB);
    PG8_WAIT_V(6); PG8_BAR;
    for (;;) {
        const bool has_next = S.next(ui + 1, nxt);
        const char* nA = has_next ? (const char*)g.A + (size_t)nxt.pm * tstep : cA; const char* nB = has_next ? (const char*)g.Bt + (size_t)nxt.pn * tstep : cB;
#pragma unroll 1
        for (int t = 0; t < nt; t += 2) {
            const bool last = (t == nt - 2);
            const char* a1 = cA + (size_t)(t + 1) * kstep;
            const char* a2 = last ? nA : cA + (size_t)(t + 2) * kstep; const char* b2 = last ? nB : cB + (size_t)(t + 2) * kstep;
            const char* a3 = a2 + kstep; const char* b3 = b2 + kstep;
            PG8_LDB(B0, 0, 0); PG8_SCHED; PG8_LDA(At, 0, 0); PG8_STAGE(PG8_SA(1, 1), a1 + hstep, voffA);
            PG8_WAIT_L(8); PG8_BAR; PG8_WAIT_L(0); PG8_MMA(0, 0, At, B0); PG8_BAR; PG8_SCHED;
            PG8_LDB(B1, 0, 1); PG8_STAGE(PG8_SB(0, 0), b2, voffB);
            PG8_BAR; PG8_WAIT_L(0); PG8_MMA(0, 1, At, B1); PG8_BAR;
            PG8_LDA(At, 0, 1); PG8_STAGE(PG8_SA(0, 0), a2, voffA);
            PG8_BAR; PG8_WAIT_L(0); PG8_MMA(1, 0, At, B0); PG8_BAR; PG8_SCHED;
            PG8_STAGE(PG8_SB(0, 1), b2 + hstep, voffB);
            PG8_WAIT_V(6); PG8_BAR; PG8_MMA(1, 1, At, B1); PG8_BAR;
            PG8_LDB(B0, 1, 0); PG8_SCHED; PG8_LDA(At, 1, 0); PG8_STAGE(PG8_SA(0, 1), a2 + hstep, voffA);
            PG8_WAIT_L(8); PG8_BAR; PG8_WAIT_L(0); PG8_MMA(0, 0, At, B0); PG8_BAR; PG8_SCHED;
            PG8_LDB(B1, 1, 1); PG8_STAGE(PG8_SB(1, 0), b3, voffB);
            PG8_BAR; PG8_WAIT_L(0); PG8_MMA(0, 1, At, B1); PG8_BAR;
            PG8_LDA(At, 1, 1); PG8_STAGE(PG8_SA(1, 0), a3, voffA);
            PG8_BAR; PG8_WAIT_L(0); PG8_MMA(1, 0, At, B0); PG8_BAR; PG8_SCHED;
            PG8_STAGE(PG8_SB(1, 1), b3 + hstep, voffB);
            PG8_WAIT_V(6); PG8_BAR; PG8_MMA(1, 1, At, B1); PG8_BAR;
        }
        E(acc, cur, wr, wc, fr, fq);
        if (!has_next) break;
#pragma unroll
        for (int a = 0; a < 2; ++a)
#pragma unroll
            for (int b = 0; b < 2; ++b)
#pragma unroll
                for (int m = 0; m < 4; ++m)
#pragma unroll
                    for (int n = 0; n < 2; ++n) acc[a][b][m][n] = (f32x4){0.f, 0.f, 0.f, 0.f};
        cur = nxt; cA = nA; cB = nB; ++ui;
    }
    PG8_WAIT_V(0);
    if (wr == 0) PG8_BAR;
    PG8_BAR;
#undef PG8_SA
#undef PG8_SB
#undef PG8_STAGE
#undef PG8_LDA
#undef PG8_LDB
#undef PG8_MMA
#undef PG8_WAIT_V
#undef PG8_WAIT_L
#undef PG8_BAR
#undef PG8_SCHED
}

struct EpiSwiGLU {
    static constexpr bool PERM = true;
    bf16_t* H; const float* SS;
    __device__ __forceinline__ void operator()(const f32x4 (&acc)[2][2][4][2], const Unit& u, int wr, int wc, int fr, int fq) const {
        const int row0 = u.pm * BM + wr * 64 + fr, col0 = u.pn * 128 + wc * 32 + 8 * fq;
        float rsv[2][4];
#pragma unroll
        for (int ai = 0; ai < 2; ++ai)
#pragma unroll
            for (int m = 0; m < 4; ++m) rsv[ai][m] = SS[row0 + ai * HALF + m * 16];
#pragma unroll
        for (int ai = 0; ai < 2; ++ai)
#pragma unroll
            for (int m = 0; m < 4; ++m) {
                const float rs = __builtin_amdgcn_rsqf(rsv[ai][m] * (1.0f / D) + 1e-6f);
                float v[8];
#pragma unroll
                for (int n = 0; n < 2; ++n)
#pragma unroll
                    for (int j = 0; j < 4; ++j) { const float gt = acc[ai][0][m][n][j] * rs, up = acc[ai][1][m][n][j] * rs; v[4 * n + j] = siluf_(gt) * up; }
                *(u32x4*)(H + (size_t)(row0 + ai * HALF + m * 16) * FF + col0) = pack8(v);
            }
    }
};
template <bool HALFSTEP> struct EpiResidual {
    static constexpr bool PERM = false;
    static constexpr float scale = HALFSTEP ? 0.5f : 1.0f;
    const float* base; float* out; bf16_t* XN; float* SS;
    __device__ __forceinline__ void operator()(const f32x4 (&acc)[2][2][4][2], const Unit& u, int wr, int wc, int fr, int fq) const {
        const int row0 = u.pm * BM + wr * 64 + fr, col0 = u.pn * BM + wc * 32 + 4 * fq;
#pragma unroll
        for (int ai = 0; ai < 2; ++ai) {
            f32x4 bv[4][2][2];
#pragma unroll
            for (int m = 0; m < 4; ++m)
#pragma unroll
                for (int bj = 0; bj < 2; ++bj)
#pragma unroll
                    for (int n = 0; n < 2; ++n) bv[m][bj][n] = *(const f32x4*)(base + (size_t)(row0 + ai * HALF + m * 16) * D + col0 + bj * HALF + n * 16);
#pragma unroll
            for (int m = 0; m < 4; ++m) { const int row = row0 + ai * HALF + m * 16; const size_t ro = (size_t)row * D + col0; float ss = 0.f;
#pragma unroll
                for (int bj = 0; bj < 2; ++bj)
#pragma unroll
                    for (int n = 0; n < 2; ++n) { const f32x4 r = bv[m][bj][n] + acc[ai][bj][m][n] * scale; *(f32x4*)(out + ro + bj * HALF + n * 16) = r;
                        if (XN) { u32x2 w; w.x = pk2(r.x, r.y); w.y = pk2(r.z, r.w); *(u32x2*)(XN + ro + bj * HALF + n * 16) = w; ss += (r.x * r.x + r.y * r.y) + (r.z * r.z + r.w * r.w); } }
                if (XN) { ss += __shfl_xor(ss, 16); ss += __shfl_xor(ss, 32); if (fq == 0) atomicAdd(SS + row, ss); } }
        }
    }
};
struct EpiBf16 {
    static constexpr bool PERM = true;
    bf16_t* O; int ldc; const float* SS;
    __device__ __forceinline__ void operator()(const f32x4 (&acc)[2][2][4][2], const Unit& u, int wr, int wc, int fr, int fq) const {
        const int row0 = u.pm * BM + wr * 64 + fr, col0 = u.pn * BM + wc * 32 + 8 * fq;
        float rsv[2][4];
#pragma unroll
        for (int ai = 0; ai < 2; ++ai)
#pragma unroll
            for (int m = 0; m < 4; ++m) rsv[ai][m] = SS[row0 + ai * HALF + m * 16];
#pragma unroll
        for (int ai = 0; ai < 2; ++ai)
#pragma unroll
            for (int m = 0; m < 4; ++m) { bf16_t* rowp = O + (size_t)(row0 + ai * HALF + m * 16) * ldc + col0;
                const float rs = __builtin_amdgcn_rsqf(rsv[ai][m] * (1.0f / D) + 1e-6f);
#pragma unroll
                for (int bj = 0; bj < 2; ++bj) { const f32x4 v0 = acc[ai][bj][m][0] * rs, v1 = acc[ai][bj][m][1] * rs;
                    u32x4 w; w.x = pk2(v0[0], v0[1]); w.y = pk2(v0[2], v0[3]); w.z = pk2(v1[0], v1[1]); w.w = pk2(v1[2], v1[3]);
                    *(u32x4*)(rowp + bj * HALF) = w; } }
    }
};
struct EpiLR {
    static constexpr bool PERM = true;
    bf16_t* O; const float* w0; const float* a0;
    template <int KIND> __device__ __forceinline__ void body(const f32x4 (&acc)[2][2][4][2], const float* bp, int row0, int col0) const {
#pragma unroll
        for (int bj = 0; bj < 2; ++bj) {
            f32x4 b0 = (f32x4){0.f, 0.f, 0.f, 0.f}, b1 = b0;
            if (KIND < 2) { b0 = *(const f32x4*)(bp + bj * HALF); b1 = *(const f32x4*)(bp + bj * HALF + 4); }
#pragma unroll
            for (int ai = 0; ai < 2; ++ai)
#pragma unroll
                for (int m = 0; m < 4; ++m) {
                    u32x4 w;
#pragma unroll
                    for (int n = 0; n < 2; ++n) {
                        float r[4];
#pragma unroll
                        for (int j = 0; j < 4; ++j) { const float x = acc[ai][bj][m][n][j] + (n == 0 ? b0[j] : b1[j]);
                            if (KIND == 0) { const float e = __expf(-x); r[j] = -0.60653065971f * __builtin_amdgcn_rcpf(1.0f + e); }
                            else if (KIND == 1) r[j] = __builtin_amdgcn_rcpf(1.0f + __expf(-x)); else r[j] = x; }
                        if (n == 0) { w.x = pk2(r[0], r[1]); w.y = pk2(r[2], r[3]); } else { w.z = pk2(r[0], r[1]); w.w = pk2(r[2], r[3]); }
                    }
                    *(u32x4*)(O + (size_t)(row0 + ai * HALF + m * 16) * 1536 + col0 + bj * HALF) = w;
                }
        }
    }
    __device__ __forceinline__ void operator()(const f32x4 (&acc)[2][2][4][2], const Unit& u, int wr, int wc, int fr, int fq) const {
        const int row0 = u.pm * BM + wr * 64 + fr, col0 = u.pn * BM + wc * 32 + 8 * fq, kind = u.pn >> 1, f0 = col0 - 512 * kind;
        if (kind == 0) body<0>(acc, w0 + f0, row0, col0); else if (kind == 1) body<1>(acc, a0 + f0, row0, col0); else body<2>(acc, nullptr, row0, col0);
    }
};
struct EpiGLU {
    static constexpr bool PERM = true;
    const bf16_t* Z; bf16_t* Y; const float* b;
    __device__ __forceinline__ void operator()(const f32x4 (&acc)[2][2][4][2], const Unit& u, int wr, int wc, int fr, int fq) const {
        const int row0 = u.pm * BM + wr * 64 + fr, col0 = u.pn * BM + wc * 32 + 8 * fq;
#pragma unroll
        for (int bj = 0; bj < 2; ++bj) {
            const f32x4 bias0 = *(const f32x4*)(b + col0 + bj * HALF), bias1 = *(const f32x4*)(b + col0 + bj * HALF + 4);
            u32x4 zr[2][4];
#pragma unroll
            for (int ai = 0; ai < 2; ++ai)
#pragma unroll
                for (int m = 0; m < 4; ++m) zr[ai][m] = *(const u32x4*)(Z + (size_t)(row0 + ai * HALF + m * 16) * 512 + col0 + bj * HALF);
#pragma unroll
            for (int ai = 0; ai < 2; ++ai)
#pragma unroll
                for (int m = 0; m < 4; ++m) { const size_t r = (size_t)(row0 + ai * HALF + m * 16);
                    float z[8], v[8]; unpack8(zr[ai][m], z);
#pragma unroll
                    for (int n = 0; n < 2; ++n)
#pragma unroll
                        for (int j = 0; j < 4; ++j) v[4 * n + j] = z[4 * n + j] * sigmoidf_(acc[ai][bj][m][n][j] + (n == 0 ? bias0[j] : bias1[j]));
                    *(u32x4*)(Y + r * D + 1024 + col0 + bj * HALF) = pack8(v); }
        }
    }
};
}

template <class Epi> __device__ __forceinline__ void run_gemm(LAS unsigned char* lds, const bf16_t* A, const bf16_t* Bt, int N, int K, const Epi E) {
    pg8::Gemm g; g.A = A; g.Bt = Bt; g.M = T; g.N = N; g.K = K;
    pg8::StaticOrder S; S.init(T, N, gridDim.x, opaque_bid());
    pg8::gemm_phase<Epi>(lds, g, S, E);
}

struct TrItem { const float* W; int ldw, k0, n0; const float* gs; bf16_t* Dst; int ldd, drow0, dk0; };
__device__ __forceinline__ void tr_load(const TrItem& it, f32x4 (&v)[8], int lane) {
    if (it.W) {
#pragma unroll
        for (int i = 0; i < 8; ++i) { const int kk = 8 * i + (lane >> 3); v[i] = *(const f32x4*)(it.W + (size_t)(it.k0 + kk) * it.ldw + it.n0 + 4 * (lane & 7)); }
    } else {
#pragma unroll
        for (int i = 0; i < 8; ++i) v[i] = (f32x4){0.f, 0.f, 0.f, 0.f};
    }
}
__device__ __forceinline__ void tr_finish(const TrItem& it, const f32x4 (&v)[8], LAS float* scr, int lane) {
#pragma unroll
    for (int i = 0; i < 8; ++i) { const int kk = 8 * i + (lane >> 3); f32x4 x = v[i]; if (it.gs) x = x * it.gs[it.k0 + kk];
        LAS float* d = scr + kk * 33 + 4 * (lane & 7); d[0] = x.x; d[1] = x.y; d[2] = x.z; d[3] = x.w; }
    LDS_FENCE();
    const int c = lane & 7;
#pragma unroll
    for (int j = 0; j < 4; ++j) { const int n = (lane >> 3) + 8 * j; const LAS float* s = scr + (8 * c) * 33 + n;
        u32x4 o; o.x = pk2(s[0 * 33], s[1 * 33]); o.y = pk2(s[2 * 33], s[3 * 33]); o.z = pk2(s[4 * 33], s[5 * 33]); o.w = pk2(s[6 * 33], s[7 * 33]);
        *(u32x4*)(it.Dst + (size_t)(it.drow0 + n) * it.ldd + it.dk0 + it.k0 + 8 * c) = o; }
    LDS_FENCE();
}
__device__ __forceinline__ TrItem conv_item(ArgsRef a, int l, int it) {
    unsigned char* ws = a.ws;
    constexpr int I_GU = (D / 64) * (FF / 32), I_DN = (FF / 64) * (D / 32), I_IN = (D / 64) * (DIN / 32), I_OUT = (D / 64) * (D / 32), I_GLU = 8 * 16;
    static_assert(I_GU == I_DN, "items");
    TrItem t; t.gs = nullptr; t.dk0 = 0;
    int r = it;
    if (r < 6 * I_GU) {
        const int which = r / I_GU; r -= which * I_GU;
        const int f = which >= 3, m = which % 3;
        if (m < 2) {
            const int nblk = FF / 32, kb = r / nblk, nb = r % nblk, n0 = 32 * nb;
            t.W = (const float*)a.in[(f ? 36 : 3) + m] + (size_t)l * D * FF; t.ldw = FF; t.k0 = 64 * kb; t.n0 = n0; t.gs = (const float*)a.in[f ? 35 : 2] + (size_t)l * D;
            t.Dst = (bf16_t*)(ws + (f ? W_UP2 : W_UP1)); t.ldd = D; t.drow0 = (n0 >> 7) * 256 + (n0 & 127) + 128 * m;
        } else {
            const int nblk = D / 32, kb = r / nblk, nb = r % nblk;
            t.W = (const float*)a.in[f ? 38 : 5] + (size_t)l * FF * D; t.ldw = D; t.k0 = 64 * kb; t.n0 = 32 * nb; t.Dst = (bf16_t*)(ws + (f ? W_DN2 : W_DN1)); t.ldd = FF; t.drow0 = 32 * nb;
        }
        return t;
    }
    r -= 6 * I_GU;
    if (r < I_IN) { const int nblk = DIN / 32, kb = r / nblk, nb = r % nblk;
        t.W = (const float*)a.in[7] + (size_t)l * D * DIN; t.ldw = DIN; t.k0 = 64 * kb; t.n0 = 32 * nb; t.gs = (const float*)a.in[6] + (size_t)l * D; t.Dst = (bf16_t*)(ws + W_IN); t.ldd = D; t.drow0 = 32 * nb; return t; }
    r -= I_IN;
    if (r < I_OUT) { const int nblk = D / 32, kb = r / nblk, nb = r % nblk;
        t.W = (const float*)a.in[34] + (size_t)l * D * D; t.ldw = D; t.k0 = 64 * kb; t.n0 = 32 * nb; t.Dst = (bf16_t*)(ws + W_OUT); t.ldd = D; t.drow0 = 32 * nb; return t; }
    r -= I_OUT;
    if (r < I_GLU) { const int kb = r / 16, nb = r % 16;
        t.W = (const float*)a.in[30] + (size_t)l * 512 * 512; t.ldw = 512; t.k0 = 64 * kb; t.n0 = 32 * nb; t.Dst = (bf16_t*)(ws + W_GLU); t.ldd = 512; t.drow0 = 32 * nb; return t; }
    r -= I_GLU;
    {
        const int nb = r >> 2, kb = r & 3, kind = nb >> 4, nn0 = 32 * (nb & 15);
        const float* W = nullptr; int k0 = 0;
        if (kind == 0 && kb == 0) { W = (const float*)a.in[10] + (size_t)l * 64 * 512; k0 = 0; }
        else if (kind == 1 && kb == 1) { W = (const float*)a.in[12] + (size_t)l * 64 * 512; k0 = 0; }
        else if (kind == 2 && kb >= 2) { W = (const float*)a.in[13] + (size_t)l * 128 * 512; k0 = 64 * (kb - 2); }
        t.W = W; t.ldw = 512; t.k0 = k0; t.n0 = nn0; t.Dst = (bf16_t*)(ws + W_LR); t.ldd = 256; t.drow0 = 32 * nb; t.dk0 = 64 * kb - k0;
    }
    return t;
}
__device__ __forceinline__ void conv_phase(ArgsRef a, int l, LAS unsigned char* lds) {
    const int TID = opaque_tid(), BID = opaque_bid();
    const int wave = TID >> 6, lane = TID & 63;
    LAS float* scr = (LAS float*)(lds + wave * 8704);
    const int gw = BID * NWAVES + wave, NGW = gridDim.x * NWAVES;
    constexpr int NITEMS = 6 * (D / 64) * (FF / 32) + (D / 64) * (DIN / 32) + (D / 64) * (D / 32) + 8 * 16 + 48 * 4;
    if (gw >= NITEMS) return;
    TrItem cur = conv_item(a, l, gw);
    f32x4 v[8]; tr_load(cur, v, lane);
    for (int it = gw; it < NITEMS; it += NGW) {
        f32x4 w[8];
#pragma unroll
        for (int i = 0; i < 8; ++i) w[i] = v[i];
        const TrItem me = cur;
        if (it + NGW < NITEMS) { cur = conv_item(a, l, it + NGW); tr_load(cur, v, lane); }
        tr_finish(me, w, scr, lane);
    }
}

__device__ __forceinline__ void norm_phase(const float* x, bf16_t* XN, float* SS) {
    const int TID = opaque_tid(), BID = opaque_bid(); (void)TID; (void)BID;
    const int wave = TID >> 6, lane = TID & 63;
    const int gw = BID * NWAVES + wave, NGW = gridDim.x * NWAVES;
    for (int m = gw; m < T; m += NGW) {
        const f32x4* xr = (const f32x4*)(x + (size_t)m * D) + lane;
        f32x4 v[8]; float s = 0.f;
#pragma unroll
        for (int j = 0; j < 8; ++j) { v[j] = xr[64 * j]; s += (v[j].x * v[j].x + v[j].y * v[j].y) + (v[j].z * v[j].z + v[j].w * v[j].w); }
        s = wave_sum(s); if (lane == 0) SS[m] = s;
        u32x2* o = (u32x2*)(XN + (size_t)m * D) + lane;
#pragma unroll
        for (int j = 0; j < 8; ++j) { u32x2 w; w.x = pk2(v[j].x, v[j].y); w.y = pk2(v[j].z, v[j].w); o[64 * j] = w; }
    }
}

__device__ __forceinline__ void zero_phase(float* p, int n) {
    const int TID = opaque_tid(), BID = opaque_bid();
    for (int i = BID * NTHREADS + TID; i < n; i += gridDim.x * NTHREADS) p[i] = 0.f;
}
__device__ __forceinline__ void alr_phase(ArgsRef a, int l) {
    const int TID = opaque_tid(), BID = opaque_bid(); (void)TID; (void)BID;
    const bf16_t* P = (const bf16_t*)(a.ws + WS_PROJ); bf16_t* ALR = (bf16_t*)(a.ws + WS_ALR);
    const float* mu = (const float*)a.in[8] + (size_t)l * 1792 + 1536;
    const int gt = BID * NTHREADS + TID, NGT = gridDim.x * NTHREADS;
    for (int it = gt; it < T * 32; it += NGT) {
        const int t = it >> 5, cg = it & 31, c0 = 8 * cg;
        float cur[8], prv[8], o[8];
        unpack8(*(const u32x4*)(P + (size_t)t * DIN + 1536 + c0), cur);
        if ((t & (SEQ - 1)) != 0) unpack8(*(const u32x4*)(P + (size_t)(t - 1) * DIN + 1536 + c0), prv);
        else {
#pragma unroll
            for (int j = 0; j < 8; ++j) prv[j] = 0.f; }
#pragma unroll
        for (int j = 0; j < 8; ++j) { const float v = cur[j] + (prv[j] - cur[j]) * mu[c0 + j];
            o[j] = c0 < 64 ? tanhf(v) : (c0 < 128 ? v : sigmoidf_(v)); }
        *(u32x4*)(ALR + (size_t)t * 256 + c0) = pack8(o);
    }
}

__device__ __forceinline__ void rwkv_full(ArgsRef a, int l, LAS unsigned char* lds, int job, int tid) {
    const bf16_t* P = (const bf16_t*)(a.ws + WS_PROJ); const bf16_t* LR = (const bf16_t*)(a.ws + WS_LRO); bf16_t* Y = (bf16_t*)(a.ws + WS_YC);
    LAS float* sR = (LAS float*)lds; LAS float* sW = sR + 4096; LAS float* sK = sW + 4096; LAS float* sKK = sK + 4096; LAS float* sB = sKK + 4096;
    LAS float* sV = sB + 4096; LAS float* sO = sV + 4096; LAS float* sBon = sO + 4096;
    const int wave = tid >> 6, lane = tid & 63, tt = tid >> 3, cg = tid & 7;
    const int b = job >> 3, h = job & 7, c0 = 64 * h + 8 * cg;
    float mur[8], muk[8], muv[8], kkw[8], kaw[8], rkw[8], lnw[8], lnb[8];
#pragma unroll
    for (int j = 0; j < 8; ++j) {
        mur[j] = ((const float*)a.in[8])[(size_t)l * 1792 + c0 + j]; muk[j] = ((const float*)a.in[8])[(size_t)l * 1792 + 512 + c0 + j]; muv[j] = ((const float*)a.in[8])[(size_t)l * 1792 + 1024 + c0 + j];
        kkw[j] = ((const float*)a.in[14])[(size_t)l * 512 + c0 + j]; kaw[j] = ((const float*)a.in[15])[(size_t)l * 512 + c0 + j]; rkw[j] = ((const float*)a.in[16])[(size_t)l * 512 + c0 + j];
        lnw[j] = ((const float*)a.in[17])[(size_t)l * 512 + c0 + j]; lnb[j] = ((const float*)a.in[18])[(size_t)l * 512 + c0 + j]; }
    f32x2 st0 = (f32x2){0.f, 0.f}, st1 = st0, st2 = st0, st3 = st0;
    const int row = 8 * wave + (lane >> 3), jq = lane & 7;
    u32x4 graw[9];
    const u32x4 zero4 = (u32x4){0u, 0u, 0u, 0u};
#define RWF_ISSUE(ch_) do { const int s_ = (ch_) * 64 + tt; const size_t t_ = (size_t)b * SEQ + s_; \
        graw[0] = *(const u32x4*)(P + t_ * DIN + c0); graw[1] = *(const u32x4*)(P + t_ * DIN + 512 + c0); graw[2] = *(const u32x4*)(P + t_ * DIN + 1024 + c0); \
        if (s_ != 0) { graw[3] = *(const u32x4*)(P + (t_ - 1) * DIN + c0); graw[4] = *(const u32x4*)(P + (t_ - 1) * DIN + 512 + c0); graw[5] = *(const u32x4*)(P + (t_ - 1) * DIN + 1024 + c0); } \
        else { graw[3] = zero4; graw[4] = zero4; graw[5] = zero4; } \
        graw[6] = *(const u32x4*)(LR + t_ * 1536 + c0); graw[7] = *(const u32x4*)(LR + t_ * 1536 + 512 + c0); graw[8] = *(const u32x4*)(LR + t_ * 1536 + 1024 + c0); } while (0)
    RWF_ISSUE(0);
    for (int ch = 0; ch < SEQ / 64; ++ch) {
        __syncthreads();
        float gate[8];
        {
            float r[8], k[8], v[8], pr[8], ld[8], av[8];
            unpack8(graw[0], r); unpack8(graw[1], k); unpack8(graw[2], v);
            unpack8(graw[3], pr);
#pragma unroll
            for (int j = 0; j < 8; ++j) r[j] += (pr[j] - r[j]) * mur[j];
            unpack8(graw[4], pr);
#pragma unroll
            for (int j = 0; j < 8; ++j) k[j] += (pr[j] - k[j]) * muk[j];
            unpack8(graw[5], pr);
#pragma unroll
            for (int j = 0; j < 8; ++j) v[j] += (pr[j] - v[j]) * muv[j];
            unpack8(graw[6], ld); unpack8(graw[7], av); unpack8(graw[8], gate);
            if (ch + 1 < SEQ / 64) RWF_ISSUE(ch + 1);
            float kk[8], ss = 0.f, bp = 0.f;
#pragma unroll
            for (int j = 0; j < 8; ++j) { kk[j] = k[j] * kkw[j]; ss += kk[j] * kk[j]; }
            ss = red8(ss);
            const float inv = __builtin_amdgcn_rsqf(fmaxf(ss, 1e-24f));
            float w8[8], k8[8], b8[8];
#pragma unroll
            for (int j = 0; j < 8; ++j) { kk[j] *= inv; k8[j] = k[j] * (1.0f + (av[j] - 1.0f) * kaw[j]); b8[j] = kk[j] * av[j]; w8[j] = __expf(ld[j]); bp += r[j] * k8[j] * rkw[j]; }
            bp = red8(bp);
            if (cg == 0) sBon[tt] = bp;
            LAS float* d;
            d = sR + tt * 64 + 8 * cg; *(LAS f32x4*)d = (f32x4){r[0], r[1], r[2], r[3]}; *(LAS f32x4*)(d + 4) = (f32x4){r[4], r[5], r[6], r[7]};
            d = sW + tt * 64 + 8 * cg; *(LAS f32x4*)d = (f32x4){w8[0], w8[1], w8[2], w8[3]}; *(LAS f32x4*)(d + 4) = (f32x4){w8[4], w8[5], w8[6], w8[7]};
            d = sK + tt * 64 + 8 * cg; *(LAS f32x4*)d = (f32x4){k8[0], k8[1], k8[2], k8[3]}; *(LAS f32x4*)(d + 4) = (f32x4){k8[4], k8[5], k8[6], k8[7]};
            d = sKK + tt * 64 + 8 * cg; *(LAS f32x4*)d = (f32x4){kk[0], kk[1], kk[2], kk[3]}; *(LAS f32x4*)(d + 4) = (f32x4){kk[4], kk[5], kk[6], kk[7]};
            d = sB + tt * 64 + 8 * cg; *(LAS f32x4*)d = (f32x4){b8[0], b8[1], b8[2], b8[3]}; *(LAS f32x4*)(d + 4) = (f32x4){b8[4], b8[5], b8[6], b8[7]};
            d = sV + tt * 64 + 8 * cg; *(LAS f32x4*)d = (f32x4){v[0], v[1], v[2], v[3]}; *(LAS f32x4*)(d + 4) = (f32x4){v[4], v[5], v[6], v[7]};
        }
        __syncthreads();
        {
#define RWF_LD(arr, s_) const f32x4 arr##a = *(const LAS f32x4*)(arr + (s_) * 64 + 8 * jq), arr##b = *(const LAS f32x4*)(arr + (s_) * 64 + 8 * jq + 4)
            f32x4 w_a = *(const LAS f32x4*)(sW + 8 * jq), w_b = *(const LAS f32x4*)(sW + 8 * jq + 4), kk_a = *(const LAS f32x4*)(sKK + 8 * jq), kk_b = *(const LAS f32x4*)(sKK + 8 * jq + 4),
                  b_a = *(const LAS f32x4*)(sB + 8 * jq), b_b = *(const LAS f32x4*)(sB + 8 * jq + 4), k_a = *(const LAS f32x4*)(sK + 8 * jq), k_b = *(const LAS f32x4*)(sK + 8 * jq + 4),
                  r_a = *(const LAS f32x4*)(sR + 8 * jq), r_b = *(const LAS f32x4*)(sR + 8 * jq + 4);
            float vi = sV[row];
            f32x2 pyp = (f32x2){0.f, 0.f}; float ykeep = 0.f;
#pragma unroll 1
            for (int s8 = 0; s8 < 64; s8 += 8) {
#pragma unroll
                for (int u = 0; u < 8; ++u) {
                    const int sn = (s8 + u + 1) & 63;
                    RWF_LD(sW, sn); RWF_LD(sKK, sn); RWF_LD(sB, sn); RWF_LD(sK, sn); RWF_LD(sR, sn);
                    const float nvi = sV[sn * 64 + row];
                    f32x2 pa = st0 * (f32x2){kk_a.x, kk_a.y}; pa = pfma(st1, (f32x2){kk_a.z, kk_a.w}, pa); pa = pfma(st2, (f32x2){kk_b.x, kk_b.y}, pa); pa = pfma(st3, (f32x2){kk_b.z, kk_b.w}, pa);
                    float av = pa.x + pa.y, yv = pyp.x + pyp.y;
                    av += dpp<XOR1>(av); yv += dpp<XOR1>(yv); av += dpp<XOR2>(av); yv += dpp<XOR2>(yv); av += dpp<XOR7>(av); yv += dpp<XOR7>(yv);
                    if (u > 0) ykeep = (jq == u - 1) ? yv : ykeep;
                    else if (s8 > 0) { ykeep = (jq == 7) ? yv : ykeep; sO[(s8 - 8 + jq) * 64 + row] = ykeep; }
                    const float sa = -av;
                    const f32x2 sa2 = (f32x2){sa, sa}, vi2 = (f32x2){vi, vi};
                    st0 = pfma(st0, (f32x2){w_a.x, w_a.y}, pfma(vi2, (f32x2){k_a.x, k_a.y}, sa2 * (f32x2){b_a.x, b_a.y}));
                    st1 = pfma(st1, (f32x2){w_a.z, w_a.w}, pfma(vi2, (f32x2){k_a.z, k_a.w}, sa2 * (f32x2){b_a.z, b_a.w}));
                    st2 = pfma(st2, (f32x2){w_b.x, w_b.y}, pfma(vi2, (f32x2){k_b.x, k_b.y}, sa2 * (f32x2){b_b.x, b_b.y}));
                    st3 = pfma(st3, (f32x2){w_b.z, w_b.w}, pfma(vi2, (f32x2){k_b.z, k_b.w}, sa2 * (f32x2){b_b.z, b_b.w}));
                    pyp = st0 * (f32x2){r_a.x, r_a.y}; pyp = pfma(st1, (f32x2){r_a.z, r_a.w}, pyp); pyp = pfma(st2, (f32x2){r_b.x, r_b.y}, pyp); pyp = pfma(st3, (f32x2){r_b.z, r_b.w}, pyp);
                    w_a = sWa; w_b = sWb; kk_a = sKKa; kk_b = sKKb; b_a = sBa; b_b = sBb; k_a = sKa; k_b = sKb; r_a = sRa; r_b = sRb; vi = nvi;
                }
            }
            const float yv = red8(pyp.x + pyp.y);
            ykeep = (jq == 7) ? yv : ykeep; sO[(56 + jq) * 64 + row] = ykeep;
#undef RWF_LD
        }
        __syncthreads();
        {
            const size_t t = (size_t)b * SEQ + ch * 64 + tt;
            const f32x4 o0 = *(const LAS f32x4*)(sO + tt * 64 + 8 * cg), o1 = *(const LAS f32x4*)(sO + tt * 64 + 8 * cg + 4);
            const f32x4 v0 = *(const LAS f32x4*)(sV + tt * 64 + 8 * cg), v1 = *(const LAS f32x4*)(sV + tt * 64 + 8 * cg + 4);
            float o[8] = {o0.x, o0.y, o0.z, o0.w, o1.x, o1.y, o1.z, o1.w}; const float vv[8] = {v0.x, v0.y, v0.z, v0.w, v1.x, v1.y, v1.z, v1.w};
            float sm = 0.f;
#pragma unroll
            for (int j = 0; j < 8; ++j) sm += o[j];
            const float mean = red8(sm) * (1.0f / 64.0f);
            float q = 0.f;
#pragma unroll
            for (int j = 0; j < 8; ++j) { o[j] -= mean; q += o[j] * o[j]; }
            const float rstd = __builtin_amdgcn_rsqf(red8(q) * (1.0f / 64.0f) + 64e-5f);
            const float bon = sBon[tt];
            float y[8];
#pragma unroll
            for (int j = 0; j < 8; ++j) y[j] = (o[j] * rstd * lnw[j] + lnb[j] + bon * vv[j]) * gate[j];
            *(u32x4*)(Y + t * D + c0) = pack8(y);
        }
    }
#undef RWF_ISSUE
}

__device__ __forceinline__ void hgrn_full(ArgsRef a, int l, LAS unsigned char* lds, int job, int tid) {
    const bf16_t* P = (const bf16_t*)(a.ws + WS_PROJ); bf16_t* Y = (bf16_t*)(a.ws + WS_YC);
    LAS float* sQ = (LAS float*)lds; LAS float* sF = sQ + 4096; LAS float* sV = sF + 4096; LAS float* sO = sV + 4096;
    const int wave = tid >> 6, lane = tid & 63, tt = tid >> 3, cg = tid & 7;
    const float* lbp = (const float*)a.in[32];
    const int b = job >> 3, h = job & 7, c0 = 64 * h + 8 * cg;
    float lb[8], gn[8];
#pragma unroll
    for (int j = 0; j < 8; ++j) { lb[j] = (l == 0) ? 0.f : sigmoidf_(lbp[512 + c0 + j] - lbp[c0 + j]); gn[j] = ((const float*)a.in[33])[(size_t)l * 64 + 8 * cg + j]; }
    f32x2 st0 = (f32x2){0.f, 0.f}, st1 = st0, st2 = st0, st3 = st0;
    const int col = 8 * wave + (lane >> 3), dq = lane & 7;
    u32x4 gq, gf, gv, gg;
#define HGF_ISSUE(ch_) do { const size_t t_ = (size_t)b * SEQ + (ch_) * 64 + tt; gq = *(const u32x4*)(P + t_ * DIN + C_HG + c0); gf = *(const u32x4*)(P + t_ * DIN + C_HG + 512 + c0); \
        gv = *(const u32x4*)(P + t_ * DIN + C_HG + 1024 + c0); gg = *(const u32x4*)(P + t_ * DIN + C_HG + 1536 + c0); } while (0)
    HGF_ISSUE(0);
    for (int ch = 0; ch < SEQ / 64; ++ch) {
        __syncthreads();
        float gate[8];
        {
            float q[8], f[8], v[8];
            unpack8(gq, q); unpack8(gf, f); unpack8(gv, v); unpack8(gg, gate);
            if (ch + 1 < SEQ / 64) HGF_ISSUE(ch + 1);
#pragma unroll
            for (int j = 0; j < 8; ++j) { q[j] = siluf_(q[j]) * 0.125f; f[j] = lb[j] + (1.0f - lb[j]) * sigmoidf_(f[j]); }
            LAS float* d;
            d = sQ + tt * 64 + 8 * cg; *(LAS f32x4*)d = (f32x4){q[0], q[1], q[2], q[3]}; *(LAS f32x4*)(d + 4) = (f32x4){q[4], q[5], q[6], q[7]};
            d = sF + tt * 64 + 8 * cg; *(LAS f32x4*)d = (f32x4){f[0], f[1], f[2], f[3]}; *(LAS f32x4*)(d + 4) = (f32x4){f[4], f[5], f[6], f[7]};
            d = sV + tt * 64 + 8 * cg; *(LAS f32x4*)d = (f32x4){v[0], v[1], v[2], v[3]}; *(LAS f32x4*)(d + 4) = (f32x4){v[4], v[5], v[6], v[7]};
        }
        __syncthreads();
        {
            f32x4 f_a = *(const LAS f32x4*)(sF + 8 * dq), f_b = *(const LAS f32x4*)(sF + 8 * dq + 4), q_a = *(const LAS f32x4*)(sQ + 8 * dq), q_b = *(const LAS f32x4*)(sQ + 8 * dq + 4);
            float vi = sV[col];
            float ykeep = 0.f;
#pragma unroll 1
            for (int s8 = 0; s8 < 64; s8 += 8) {
#pragma unroll
                for (int u = 0; u < 8; ++u) {
                    const int sn = (s8 + u + 1) & 63;
                    const f32x4 nf_a = *(const LAS f32x4*)(sF + sn * 64 + 8 * dq), nf_b = *(const LAS f32x4*)(sF + sn * 64 + 8 * dq + 4),
                                nq_a = *(const LAS f32x4*)(sQ + sn * 64 + 8 * dq), nq_b = *(const LAS f32x4*)(sQ + sn * 64 + 8 * dq + 4);
                    const float nvi = sV[sn * 64 + col];
                    const f32x2 vi2 = (f32x2){vi, vi};
                    st0 = pfma((f32x2){f_a.x, f_a.y}, st0 - vi2, vi2); st1 = pfma((f32x2){f_a.z, f_a.w}, st1 - vi2, vi2);
                    st2 = pfma((f32x2){f_b.x, f_b.y}, st2 - vi2, vi2); st3 = pfma((f32x2){f_b.z, f_b.w}, st3 - vi2, vi2);
                    f32x2 py = st0 * (f32x2){q_a.x, q_a.y}; py = pfma(st1, (f32x2){q_a.z, q_a.w}, py); py = pfma(st2, (f32x2){q_b.x, q_b.y}, py); py = pfma(st3, (f32x2){q_b.z, q_b.w}, py);
                    const float y = red8(py.x + py.y);
                    ykeep = (dq == u) ? y : ykeep;
                    f_a = nf_a; f_b = nf_b; q_a = nq_a; q_b = nq_b; vi = nvi;
                }
                sO[(s8 + dq) * 64 + col] = ykeep;
            }
        }
        __syncthreads();
        {
            const size_t t = (size_t)b * SEQ + ch * 64 + tt;
            const f32x4 o0 = *(const LAS f32x4*)(sO + tt * 64 + 8 * cg), o1 = *(const LAS f32x4*)(sO + tt * 64 + 8 * cg + 4);
            const float o[8] = {o0.x, o0.y, o0.z, o0.w, o1.x, o1.y, o1.z, o1.w};
            float q = 0.f;
#pragma unroll
            for (int j = 0; j < 8; ++j) q += o[j] * o[j];
            const float rs = __builtin_amdgcn_rsqf(red8(q) * (1.0f / 64.0f) + 1e-6f);
            float y[8];
#pragma unroll
            for (int j = 0; j < 8; ++j) y[j] = o[j] * rs * gn[j] * siluf_(gate[j]);
            *(u32x4*)(Y + t * D + 1536 + c0) = pack8(y);
        }
    }
#undef HGF_ISSUE
}

__device__ __forceinline__ void attn_phase(ArgsRef a, int l, LAS unsigned char* lds) {
    const int TID = opaque_tid(), BID = opaque_bid();
    const bf16_t* P = (const bf16_t*)(a.ws + WS_PROJ); bf16_t* Y = (bf16_t*)(a.ws + WS_YC);
    const int* pos = (const int*)a.in[1];
    const float* qn = (const float*)a.in[19] + (size_t)l * 64; const float* kn = (const float*)a.in[20] + (size_t)l * 64; const float* sinks = (const float*)a.in[21] + (size_t)l * 8;
    constexpr int KST = 144, VST = 528;
    LAS unsigned char* sK = lds; LAS unsigned char* sVt = sK + 256 * KST; LAS unsigned char* sQ = sVt + 64 * VST; LAS float* sM = (LAS float*)(sQ + 512 * KST);
    const int tid = TID, cg = tid & 7, wave = tid >> 6, lane = tid & 63;
    float kmaxg = 0.f;
    for (int j = 0; j < 64; ++j) kmaxg = fmaxf(kmaxg, fabsf(kn[j]));
    const float kbound = 8.0f * kmaxg;
    float gk[8], gq[8], invf[8];
#pragma unroll
    for (int j = 0; j < 8; ++j) { gk[j] = kn[8 * cg + j]; gq[j] = qn[8 * cg + j]; invf[j] = exp2f(-(float)j * (18.931568569324174f / 8.0f)); }
    for (int job = BID; job < 512; job += gridDim.x) {
        const int b = job >> 5, nb = (job >> 1) & 15, kvh = job & 1;
        __syncthreads();
#pragma unroll 1
        for (int r = 0; r < 4; ++r) {
            const int kj = (tid >> 3) + 64 * r, s = (nb - 1) * 128 + kj;
            float k[8], v[8];
            if (s >= 0) {
                const size_t t = (size_t)b * SEQ + s;
                unpack8(*(const u32x4*)(P + t * DIN + C_ATT + 512 + 64 * kvh + 8 * cg), k); unpack8(*(const u32x4*)(P + t * DIN + C_ATT + 640 + 64 * kvh + 8 * cg), v);
            } else {
#pragma unroll
                for (int j = 0; j < 8; ++j) { k[j] = 0.f; v[j] = 0.f; } }
            float ss = 0.f;
#pragma unroll
            for (int j = 0; j < 8; ++j) ss += k[j] * k[j];
            ss = red8(ss);
            const float rs = __builtin_amdgcn_rsqf(ss * (1.0f / 64.0f) + 1e-6f);
#pragma unroll
            for (int j = 0; j < 8; ++j) k[j] = k[j] * rs * gk[j];
            const float pf = (float)pos[b * SEQ + (s >= 0 ? s : 0)];
#pragma unroll
            for (int j = 0; j < 8; ++j) {
                const float other = dpp<XOR1>(k[j]);
                if (cg < 2) { float sn, cs; sincos_big(pf * invf[j], sn, cs); k[j] = (cg == 0) ? (k[j] * cs - other * sn) : (k[j] * cs + other * sn); }
            }
            *(LAS u32x4*)(sK + kj * KST + 16 * cg) = pack8(k);
#pragma unroll
            for (int j = 0; j < 8; j += 2) { const unsigned w = pk2(v[j], v[j + 1]);
                *(LAS unsigned short*)(sVt + (8 * cg + j) * VST + 2 * kj) = (unsigned short)(w & 0xffffu); *(LAS unsigned short*)(sVt + (8 * cg + j + 1) * VST + 2 * kj) = (unsigned short)(w >> 16); }
        }
#pragma unroll 1
        for (int r = 0; r < 8; ++r) {
            const int row = (tid >> 3) + 64 * r, g = row >> 7, qi = row & 127, hq = 4 * kvh + g;
            const size_t tq = (size_t)b * SEQ + nb * 128 + qi;
            float q[8];
            unpack8(*(const u32x4*)(P + tq * DIN + C_ATT + 64 * hq + 8 * cg), q);
            float ss = 0.f;
#pragma unroll
            for (int j = 0; j < 8; ++j) ss += q[j] * q[j];
            ss = red8(ss);
            const float rs = 0.125f * __builtin_amdgcn_rsqf(ss * (1.0f / 64.0f) + 1e-6f);
#pragma unroll
            for (int j = 0; j < 8; ++j) q[j] = q[j] * rs * gq[j];
            const float pf = (float)pos[b * SEQ + nb * 128 + qi];
            float qq = 0.f;
#pragma unroll
            for (int j = 0; j < 8; ++j) {
                const float other = dpp<XOR1>(q[j]);
                if (cg < 2) { float sn, cs; sincos_big(pf * invf[j], sn, cs); q[j] = (cg == 0) ? (q[j] * cs - other * sn) : (q[j] * cs + other * sn); }
                qq += q[j] * q[j];
            }
            qq = red8(qq);
            if (cg == 0) sM[row] = sqrtf(qq) * kbound;
            *(LAS u32x4*)(sQ + row * KST + 16 * cg) = pack8(q);
        }
        __syncthreads();
        const int g = wave >> 1, qh = wave & 1, hq = 4 * kvh + g, fr = lane & 15, fq = lane >> 4;
        const float sinkv = sinks[hq];
#pragma unroll 1
        for (int qt = 0; qt < 4; ++qt) {
            const int qi0 = 64 * qh + 16 * qt, R0 = g * 128 + qi0, kt0 = qi0 >> 4;
            const bf16x8 qf0 = *(const LAS bf16x8*)(sQ + (R0 + fr) * KST + 16 * fq), qf1 = *(const LAS bf16x8*)(sQ + (R0 + fr) * KST + 16 * fq + 64);
            const float msh = sM[R0 + fr];
            const int ql = qi0 + fr;
            f32x4 oacc[4];
#pragma unroll
            for (int dt = 0; dt < 4; ++dt) oacc[dt] = (f32x4){0.f, 0.f, 0.f, 0.f};
            float lsum = 0.f;
#pragma unroll
            for (int ks = 0; ks < 5; ++ks) {
                unsigned pw[4];
#pragma unroll
                for (int h2 = 0; h2 < 2; ++h2) {
                    const int ti = 2 * ks + h2, kt = (kt0 + ti) < 15 ? (kt0 + ti) : 15;
                    const bf16x8 kf0 = *(const LAS bf16x8*)(sK + (16 * kt + fr) * KST + 16 * fq), kf1 = *(const LAS bf16x8*)(sK + (16 * kt + fr) * KST + 16 * fq + 64);
                    f32x4 sc = (f32x4){0.f, 0.f, 0.f, 0.f};
                    sc = __builtin_amdgcn_mfma_f32_16x16x32_bf16(kf0, qf0, sc, 0, 0, 0);
                    sc = __builtin_amdgcn_mfma_f32_16x16x32_bf16(kf1, qf1, sc, 0, 0, 0);
                    float p[4];
#pragma unroll
                    for (int j = 0; j < 4; ++j) { const int kj = 16 * (kt0 + ti) + 4 * fq + j;
                        const bool valid = (kj > ql) && (kj <= ql + 128) && (nb > 0 || kj >= 128);
                        p[j] = valid ? __expf(sc[j] - msh) : 0.f; lsum += p[j]; }
                    pw[2 * h2] = pk2(p[0], p[1]); pw[2 * h2 + 1] = pk2(p[2], p[3]);
                }
                const u32x4 pq = (u32x4){pw[0], pw[1], pw[2], pw[3]};
                const bf16x8 pf = __builtin_bit_cast(bf16x8, pq);
                const int kta = (kt0 + 2 * ks) < 15 ? (kt0 + 2 * ks) : 15, ktb = (kt0 + 2 * ks + 1) < 15 ? (kt0 + 2 * ks + 1) : 15;
#pragma unroll
                for (int dt = 0; dt < 4; ++dt) {
                    const u32x2 va = *(const LAS u32x2*)(sVt + (16 * dt + fr) * VST + (16 * kta + 4 * fq) * 2), vb = *(const LAS u32x2*)(sVt + (16 * dt + fr) * VST + (16 * ktb + 4 * fq) * 2);
                    const u32x4 vq = (u32x4){va.x, va.y, vb.x, vb.y};
                    oacc[dt] = __builtin_amdgcn_mfma_f32_16x16x32_bf16(__builtin_bit_cast(bf16x8, vq), pf, oacc[dt], 0, 0, 0);
                }
            }
            lsum += __shfl_xor(lsum, 16); lsum += __shfl_xor(lsum, 32);
            const float inv = __builtin_amdgcn_rcpf(lsum + __expf(sinkv - msh));
            const size_t tq = (size_t)b * SEQ + nb * 128 + ql;
#pragma unroll
            for (int dt = 0; dt < 4; ++dt) { u32x2 w; w.x = pk2(oacc[dt][0] * inv, oacc[dt][1] * inv); w.y = pk2(oacc[dt][2] * inv, oacc[dt][3] * inv);
                *(u32x2*)(Y + tq * D + 512 + 64 * hq + 16 * dt + 4 * fq) = w; }
        }
    }
    __syncthreads();
}

__device__ __forceinline__ float gelu_erf(float v) {
    const float t = __builtin_amdgcn_rcpf(fabsf(v) * 0.2316418882f + 1.0f);
    float q = t * 0.5307027145f + (-0.7265760135f); q = q * t + 0.7107068705f; q = q * t + (-0.142248368f); q = q * t + 0.127414796f; q = q * t;
    const float e = __builtin_amdgcn_exp2f(v * v * (-0.72134752044f));
    const float m = v * (q * e);
    return v < 0.f ? m : v - m;
}
__device__ __forceinline__ void s5_jobs(ArgsRef a, int l, LAS unsigned char* lds, unsigned* qctr) {
    const int TID = opaque_tid();
    LAS int* sJob = (LAS int*)(lds + 8 * 16 * 130 * 4 + 4096);
    const bf16_t* P = (const bf16_t*)(a.ws + WS_PROJ); bf16_t* Z = (bf16_t*)(a.ws + WS_Z);
    const int tid = TID, wave = tid >> 6, lane = tid & 63, fr16 = lane & 15, fq = lane >> 4;
    LAS float* sX = (LAS float*)lds + wave * (16 * 130);
    LAS float* sE = (LAS float*)lds + 8 * 16 * 130;
    for (;;) {
        if (TID == 0) *sJob = (int)__hip_atomic_fetch_add(qctr, 1u, __ATOMIC_RELAXED, __HIP_MEMORY_SCOPE_AGENT);
        __syncthreads();
        const int job = *sJob;
        if (job >= 512) break;
        const int b = job >> 5, g = job & 31;
        const float dt = expf(((const float*)a.in[24])[l * 32 + g]);
        float lbr, lbi;
        { const float lre = ((const float*)a.in[22])[(size_t)l * 2048 + g * 64 + lane], lim = ((const float*)a.in[23])[(size_t)l * 2048 + g * 64 + lane];
          float sn, cs; sincos_big(lim * dt, sn, cs); const float er = expf(lre * dt); lbr = er * cs; lbi = er * sn; }
        bf16x8 bfrag[8];
#pragma unroll
        for (int k = 0; k < 4; ++k) {
            const int p = fr16 + 16 * k;
            const float lre = ((const float*)a.in[22])[(size_t)l * 2048 + g * 64 + p], lim = ((const float*)a.in[23])[(size_t)l * 2048 + g * 64 + p];
            float sn, cs; sincos_big(lim * dt, sn, cs); const float er = expf(lre * dt), pbr = er * cs, pbi = er * sn;
            const float den = __builtin_amdgcn_rcpf(lre * lre + lim * lim);
            const float fr = ((pbr - 1.0f) * lre + pbi * lim) * den, fi = (pbi * lre - (pbr - 1.0f) * lim) * den;
            const float* brp = (const float*)a.in[25] + ((size_t)l * 2048 + g * 64 + p) * 16 + 8 * (fq & 1);
            const float* bip = (const float*)a.in[26] + ((size_t)l * 2048 + g * 64 + p) * 16 + 8 * (fq & 1);
            float vr[8], vi[8];
#pragma unroll
            for (int i = 0; i < 8; ++i) { const float br = brp[i], bi = bip[i]; float xr = fr * br - fi * bi, xi = fr * bi + fi * br;
                const unsigned hw = pk2(xr, xi);
                if (fq >= 2) { xr -= bflo(hw); xi -= bfhi(hw); }
                vr[i] = xr; vi[i] = xi; }
            bfrag[k] = __builtin_bit_cast(bf16x8, pack8(vr)); bfrag[4 + k] = __builtin_bit_cast(bf16x8, pack8(vi));
        }
        float creg[32];
        {
            const float* cre = (const float*)a.in[27] + ((size_t)l * 32 + g) * 1024 + fr16 * 64 + fq;
            const float* cim = (const float*)a.in[28] + ((size_t)l * 32 + g) * 1024 + fr16 * 64 + fq;
#pragma unroll
            for (int kk = 0; kk < 16; ++kk) { creg[kk] = cre[4 * kk]; creg[16 + kk] = -cim[4 * kk]; }
        }
        f32x4 dsk;
        { const float* dp = (const float*)a.in[29] + (size_t)l * 512 + 16 * g + 4 * fq; dsk = (f32x4){dp[0], dp[1], dp[2], dp[3]}; }
        const size_t tbase = (size_t)b * SEQ + wave * 256;
        const bf16_t* ua = P + (tbase + fr16) * DIN + C_S5 + 16 * g + 8 * (fq & 1);
        const bf16_t* ue = P + (tbase + fr16) * DIN + C_S5 + 16 * g + 4 * fq;
        f32x2 xs = (f32x2){0.f, 0.f}; const f32x2 lbr2 = (f32x2){lbr, lbr}, lbi2 = (f32x2){lbi, lbi};
        {
            u32x4 au = *(const u32x4*)ua;
#pragma unroll 1
            for (int gi = 0; gi < 16; ++gi) {
                const bf16x8 af = __builtin_bit_cast(bf16x8, au);
                if (gi + 1 < 16) au = *(const u32x4*)(ua + (size_t)(gi + 1) * 16 * DIN);
#pragma unroll
                for (int nt = 0; nt < 8; ++nt) { const f32x4 d = __builtin_amdgcn_mfma_f32_16x16x32_bf16(af, bfrag[nt], (f32x4){0.f, 0.f, 0.f, 0.f}, 0, 0, 0);
#pragma unroll
                    for (int j = 0; j < 4; ++j) sX[(4 * fq + j) * 130 + fr16 + 16 * nt] = d[j]; }
                LDS_FENCE();
#pragma unroll
                for (int s = 0; s < 16; ++s) { const f32x2 bu = (f32x2){sX[s * 130 + lane], sX[s * 130 + 64 + lane]};
                    const f32x2 nx = pfma(lbr2, xs, bu); xs = pfma(lbi2, (f32x2){-xs.y, xs.x}, nx); }
                LDS_FENCE();
            }
        }
        sE[wave * 128 + lane] = xs.x; sE[wave * 128 + 64 + lane] = xs.y;
        float pr = lbr, pi = lbi;
#pragma unroll
        for (int i = 0; i < 8; ++i) { const float nr = pr * pr - pi * pi, ni = 2.0f * pr * pi; pr = nr; pi = ni; }
        __syncthreads();
        xs = (f32x2){0.f, 0.f};
        for (int w = 0; w < wave; ++w) { const float er_ = sE[w * 128 + lane], ei_ = sE[w * 128 + 64 + lane];
            const float nr = pr * xs.x - pi * xs.y + er_, ni = pr * xs.y + pi * xs.x + ei_; xs.x = nr; xs.y = ni; }
        {
            u32x4 au = *(const u32x4*)ua; u32x2 eu = *(const u32x2*)ue;
#pragma unroll 1
            for (int gi = 0; gi < 16; ++gi) {
                const bf16x8 af = __builtin_bit_cast(bf16x8, au); const u32x2 eun = eu;
                if (gi + 1 < 16) { au = *(const u32x4*)(ua + (size_t)(gi + 1) * 16 * DIN); eu = *(const u32x2*)(ue + (size_t)(gi + 1) * 16 * DIN); }
#pragma unroll
                for (int nt = 0; nt < 8; ++nt) { const f32x4 d = __builtin_amdgcn_mfma_f32_16x16x32_bf16(af, bfrag[nt], (f32x4){0.f, 0.f, 0.f, 0.f}, 0, 0, 0);
#pragma unroll
                    for (int j = 0; j < 4; ++j) sX[(4 * fq + j) * 130 + fr16 + 16 * nt] = d[j]; }
                LDS_FENCE();
#pragma unroll
                for (int s = 0; s < 16; ++s) { const f32x2 bu = (f32x2){sX[s * 130 + lane], sX[s * 130 + 64 + lane]};
                    const f32x2 nx = pfma(lbr2, xs, bu); xs = pfma(lbi2, (f32x2){-xs.y, xs.x}, nx);
                    sX[s * 130 + lane] = xs.x; sX[s * 130 + 64 + lane] = xs.y; }
                LDS_FENCE();
                f32x4 yacc = (f32x4){0.f, 0.f, 0.f, 0.f}, yacc1 = yacc, yacc2 = yacc, yacc3 = yacc;
                const LAS float* xp = sX + fr16 * 130 + fq;
#pragma unroll
                for (int kk = 0; kk < 32; kk += 4) {
                    yacc = __builtin_amdgcn_mfma_f32_16x16x4f32(creg[kk], xp[4 * kk], yacc, 0, 0, 0);
                    yacc1 = __builtin_amdgcn_mfma_f32_16x16x4f32(creg[kk + 1], xp[4 * kk + 4], yacc1, 0, 0, 0);
                    yacc2 = __builtin_amdgcn_mfma_f32_16x16x4f32(creg[kk + 2], xp[4 * kk + 8], yacc2, 0, 0, 0);
                    yacc3 = __builtin_amdgcn_mfma_f32_16x16x4f32(creg[kk + 3], xp[4 * kk + 12], yacc3, 0, 0, 0);
                }
                yacc = (yacc + yacc1) + (yacc2 + yacc3);
                const float u0 = bflo(eun.x), u1 = bfhi(eun.x), u2 = bflo(eun.y), u3 = bfhi(eun.y);
                const float z0 = gelu_erf(yacc[0] + dsk[0] * u0), z1 = gelu_erf(yacc[1] + dsk[1] * u1), z2 = gelu_erf(yacc[2] + dsk[2] * u2), z3 = gelu_erf(yacc[3] + dsk[3] * u3);
                u32x2 w; w.x = pk2(z0, z1); w.y = pk2(z2, z3);
                *(u32x2*)(Z + (tbase + gi * 16 + fr16) * 512 + 16 * g + 4 * fq) = w;
                LDS_FENCE();
            }
        }
        __syncthreads();
    }
}

__device__ __forceinline__ void scan_phase(ArgsRef a, int l, LAS unsigned char* lds) {
    const int TID = opaque_tid(), BID = opaque_bid();
    if (gridDim.x == 256) {
        if (BID < 128) rwkv_full(a, l, lds, BID, TID); else hgrn_full(a, l, lds, BID - 128, TID);
    } else {
        for (int job = BID; job < 256; job += gridDim.x) { if (job < 128) rwkv_full(a, l, lds, job, TID); else hgrn_full(a, l, lds, job - 128, TID); __syncthreads(); }
    }
    __syncthreads();
    s5_jobs(a, l, lds, (unsigned*)(a.ws + WS_BAR) + 3584 + 64 * l);
    __syncthreads();
}

#define XB_TMO      128
#define XB_XCNT(j)  (256  + 64 * (j))
#define XB_XSUB(j)  (1280 + 64 * (j))
#define XB_XGEN(j)  (2304 + 64 * (j))
#define XB_TOP      3328
#define XB_TOPGEN   3392
#define XCD_BAR_WORDS 3456
#define XB_SPIN_CAP (1u << 18)

__device__ __forceinline__ unsigned xb_ld(unsigned* p)              { return __hip_atomic_load(p, __ATOMIC_RELAXED, __HIP_MEMORY_SCOPE_AGENT); }
__device__ __forceinline__ unsigned xb_add(unsigned* p, unsigned v) { return __hip_atomic_fetch_add(p, v, __ATOMIC_RELAXED, __HIP_MEMORY_SCOPE_AGENT); }
__device__ __forceinline__ unsigned xb_xcc_id() { return (unsigned)__builtin_amdgcn_s_getreg((3 << 11) | 20) & 0xFu; }
#define XB_SPIN(cond, bar) do { unsigned _sp = 0; while (cond) { __builtin_amdgcn_s_sleep(1); \
    if ((++_sp & 255u) == 0u) { if (xb_ld(&(bar)[XB_TMO])) break; if (_sp > XB_SPIN_CAP) { atomicAdd(&(bar)[XB_TMO], 1u); break; } } } } while (0)

struct XcdBarrier {
    unsigned* bar; unsigned x;
    volatile LAS unsigned* st;
};

__device__ __forceinline__ XcdBarrier xcd_barrier_post(unsigned* bar, volatile LAS unsigned* st) {
    XcdBarrier b; b.bar = bar; b.x = xb_xcc_id(); b.st = st;
    if (threadIdx.x == 0) (void)xb_add(&bar[XB_XCNT(b.x)], 1u);
    return b;
}
__device__ __forceinline__ void xcd_barrier_complete(unsigned* bar, unsigned x, unsigned& nloc, unsigned& nx) {
    const unsigned G = gridDim.x * gridDim.y * gridDim.z;
    unsigned sum, cnt, mine, sp = 0u;
    for (;;) {
        sum = 0u; cnt = 0u; mine = 0u;
#pragma unroll
        for (unsigned j = 0; j < 16; ++j) { const unsigned c = xb_ld(&bar[XB_XCNT(j)]); sum += c; cnt += (c > 0u) ? 1u : 0u; mine = (j == x) ? c : mine; }
        if (sum == G) break;
        __builtin_amdgcn_s_sleep(1);
        if ((++sp & 255u) == 0u) { if (xb_ld(&bar[XB_TMO])) break; if (sp > XB_SPIN_CAP) { atomicAdd(&bar[XB_TMO], 1u); break; } }
    }
    nloc = mine > 0u ? mine : 1u; nx = cnt > 0u ? cnt : 1u;
}

__device__ __forceinline__ void xcd_barrier(const XcdBarrier& b) {
    asm volatile("s_waitcnt vmcnt(0)" ::: "memory");
    __syncthreads();
    if (threadIdx.x == 0) {
        unsigned* bar = b.bar;
        __builtin_amdgcn_s_waitcnt(0);
        unsigned nloc = b.st[0], nx = b.st[1];
        if (nloc == 0u) { xcd_barrier_complete(bar, b.x, nloc, nx); b.st[0] = nloc; b.st[1] = nx; }
        const unsigned old = xb_add(&bar[XB_XSUB(b.x)], 1u);
        const unsigned gen = old / nloc;
        if (old + 1u == (gen + 1u) * nloc) {
            __builtin_amdgcn_fence(__ATOMIC_RELEASE, "agent");
            asm volatile("s_waitcnt vmcnt(0)" ::: "memory");
            const unsigned og = xb_add(&bar[XB_TOP], 1u);
            const unsigned tg = og / nx;
            if (og + 1u == (tg + 1u) * nx) xb_add(&bar[XB_TOPGEN], 1u);
            else XB_SPIN(xb_ld(&bar[XB_TOPGEN]) == tg, bar);
            __builtin_amdgcn_fence(__ATOMIC_ACQUIRE, "agent");
            xb_add(&bar[XB_XGEN(b.x)], 1u);
            asm volatile("s_waitcnt vmcnt(0)" ::: "memory");
        } else {
            XB_SPIN(xb_ld(&bar[XB_XGEN(b.x)]) == gen, bar);
            __builtin_amdgcn_fence(__ATOMIC_ACQUIRE, "agent");
            asm volatile("s_waitcnt vmcnt(0)" ::: "memory");
        }
    }
    __syncthreads();
}


constexpr int NPH = 11;
#ifndef DUPMASK
#define DUPMASK 0
#endif
__global__ void __launch_bounds__(NTHREADS, 2) mega(Args a_, int lo, int hi) {
    extern __shared__ __attribute__((aligned(16))) unsigned char lds_raw[];
    LAS unsigned char* lds = (LAS unsigned char*)lds_raw;
#ifdef EXTRA_SYNCS
    for (int i = 0; i < EXTRA_SYNCS; ++i) { __syncthreads(); cg::this_grid().sync(); }
#endif
    LAS unsigned* xst = (LAS unsigned*)(lds + LDS_BYTES - 16);
    if (hi - lo > 1) {
        if (threadIdx.x == 0) { xst[0] = 0u; xst[1] = 0u; }
        __syncthreads();
        if (blockIdx.x == 0) {
            const __attribute__((address_space(4))) Args* ap0 = (const __attribute__((address_space(4))) Args*)__builtin_amdgcn_kernarg_segment_ptr();
            unsigned* bw = (unsigned*)(ap0->ws + WS_BAR);
            for (int i = threadIdx.x; i < 4096; i += NTHREADS) bw[i] = 0u;
        }
    }
#pragma unroll 1
    for (int step2 = 2 * lo; step2 < 2 * hi; ++step2) {
        const int step = step2 >> 1;
        if ((step2 & 1) && !((DUPMASK >> (step % NPH)) & 1)) continue;
        const __attribute__((address_space(4))) Args* ap = (const __attribute__((address_space(4))) Args*)__builtin_amdgcn_kernarg_segment_ptr();
        asm volatile("" : "+s"(ap));
        ArgsRef a = *ap;
        unsigned char* ws = a.ws;
        float* SSa = (float*)(ws + WS_SS); float* SSb = SSa + T; float* SSc = SSb + T;
        const int l = step / NPH, ph = step % NPH;
        const float* xin = (l == 0) ? (const float*)a.in[0] : (const float*)a.out;
#ifndef PHMASK
#define PHMASK 0x7ff
#endif
        switch (ph) {
        case 0: if (PHMASK & (1 << 0)) { conv_phase(a, l, lds); if (l == 0) norm_phase(xin, (bf16_t*)(ws + WS_XN), SSa); zero_phase(SSb, T); } break;
        case 1: if (PHMASK & (1 << 1)) { pg8::EpiSwiGLU E; E.H = (bf16_t*)(ws + WS_HID); E.SS = SSa; run_gemm(lds, (const bf16_t*)(ws + WS_XN), (const bf16_t*)(ws + W_UP1), 2 * FF, D, E); } break;
        case 2: if (PHMASK & (1 << 2)) { pg8::EpiResidual<true> E; E.base = xin; E.out = a.out; E.XN = (bf16_t*)(ws + WS_XN); E.SS = SSb; run_gemm(lds, (const bf16_t*)(ws + WS_HID), (const bf16_t*)(ws + W_DN1), D, FF, E); } break;
        case 3: if (PHMASK & (1 << 3)) { pg8::EpiBf16 E; E.O = (bf16_t*)(ws + WS_PROJ); E.ldc = DIN; E.SS = SSb; run_gemm(lds, (const bf16_t*)(ws + WS_XN), (const bf16_t*)(ws + W_IN), DIN, D, E); } break;
        case 4: if (PHMASK & (1 << 4)) { zero_phase(SSa, T); zero_phase(SSc, T); alr_phase(a, l); attn_phase(a, l, lds); } break;
        case 5: if (PHMASK & (1 << 5)) { pg8::EpiLR E; E.O = (bf16_t*)(ws + WS_LRO); E.w0 = (const float*)a.in[9] + (size_t)l * 512; E.a0 = (const float*)a.in[11] + (size_t)l * 512;
                  run_gemm(lds, (const bf16_t*)(ws + WS_ALR), (const bf16_t*)(ws + W_LR), 1536, 256, E); } break;
        case 6: if (PHMASK & (1 << 6)) scan_phase(a, l, lds); break;
        case 7: if (PHMASK & (1 << 7)) { pg8::EpiGLU G; G.Z = (const bf16_t*)(ws + WS_Z); G.Y = (bf16_t*)(ws + WS_YC); G.b = (const float*)a.in[31] + (size_t)l * 512;
                  run_gemm(lds, (const bf16_t*)(ws + WS_Z), (const bf16_t*)(ws + W_GLU), 512, 512, G); } break;
        case 8: if (PHMASK & (1 << 8)) { pg8::EpiResidual<false> E; E.base = a.out; E.out = a.out; E.XN = (bf16_t*)(ws + WS_XN); E.SS = SSc; run_gemm(lds, (const bf16_t*)(ws + WS_YC), (const bf16_t*)(ws + W_OUT), D, D, E); } break;
        case 9: if (PHMASK & (1 << 9)) { pg8::EpiSwiGLU E; E.H = (bf16_t*)(ws + WS_HID); E.SS = SSc; run_gemm(lds, (const bf16_t*)(ws + WS_XN), (const bf16_t*)(ws + W_UP2), 2 * FF, D, E); } break;
        case 10: if (PHMASK & (1 << 10)) { pg8::EpiResidual<true> E; E.base = a.out; E.out = a.out; E.XN = (l + 1 < NL) ? (bf16_t*)(ws + WS_XN) : nullptr; E.SS = SSa; run_gemm(lds, (const bf16_t*)(ws + WS_HID), (const bf16_t*)(ws + W_DN2), D, FF, E); } break;
        }
        if ((step2 + 2 < 2 * hi) || (((step2 & 1) == 0) && ((DUPMASK >> ((step2 >> 1) % NPH)) & 1))) {
            if (step2 == 2 * lo) { __syncthreads(); cg::this_grid().sync(); (void)xcd_barrier_post((unsigned*)(ws + WS_BAR), (volatile LAS unsigned*)xst); }
            else { XcdBarrier xb; xb.bar = (unsigned*)(ws + WS_BAR); xb.x = xb_xcc_id(); xb.st = (volatile LAS unsigned*)xst; xcd_barrier(xb); }
        }
    }
}

extern "C" void kernel_launch(void* const* d_in, const int* in_sizes, int n_in, void* d_out, int out_size, void* d_ws, size_t ws_size, hipStream_t stream) {
    static int grid = 0;
    if (!grid) {
        int dev = 0, cus = 0, per_cu = 0;
        hipGetDevice(&dev);
        hipDeviceGetAttribute(&cus, hipDeviceAttributeMultiprocessorCount, dev);
        hipFuncSetAttribute((const void*)mega, hipFuncAttributeMaxDynamicSharedMemorySize, LDS_BYTES);
        hipOccupancyMaxActiveBlocksPerMultiprocessor(&per_cu, (const void*)mega, NTHREADS, LDS_BYTES);
        if (per_cu < 1) per_cu = 1;
        grid = cus * 1;
        if (grid != 256) fprintf(stderr, "kernel_launch: grid %d (cus %d, per_cu %d)\n", grid, cus, per_cu);
    }
    Args a{};
    for (int i = 0; i < 39; ++i) a.in[i] = d_in[i];
    a.out = (float*)d_out; a.ws = (unsigned char*)d_ws;
#if ONE_LAUNCH
    int lo = 0, hi = NL * NPH;
    void* args[] = {&a, &lo, &hi};
    hipError_t e = hipLaunchCooperativeKernel((void*)mega, dim3(grid), dim3(NTHREADS), args, LDS_BYTES, stream);
    if (e != hipSuccess) fprintf(stderr, "cooperative launch failed: %s (grid %d)\n", hipGetErrorString(e), grid);
#else
    for (int s = 0; s < NL * NPH; ++s) hipLaunchKernelGGL(mega, dim3(grid), dim3(NTHREADS), LDS_BYTES, stream, a, s, s + 1);
#endif
}
```

```cpp
#include <hip/hip_runtime.h>
#include <hip/hip_cooperative_groups.h>
#include <cstdio>
#include <cstdint>
namespace cg = cooperative_groups;

#ifndef ONE_LAUNCH
#define ONE_LAUNCH 1
#endif

#define LAS __attribute__((address_space(3)))
typedef unsigned short bf16_t;
typedef short bf16x8 __attribute__((ext_vector_type(8)));
typedef float f32x4 __attribute__((ext_vector_type(4)));
typedef float f32x2 __attribute__((ext_vector_type(2)));
typedef unsigned u32x4 __attribute__((ext_vector_type(4)));
typedef unsigned u32x2 __attribute__((ext_vector_type(2)));

constexpr int T = 32768, SEQ = 2048, NB = 16, D = 2048, FF = 5632, DIN = 5120, NL = 2;
constexpr int C_RWKV = 0, C_ATT = 1792, C_S5 = 2560, C_HG = 3072;
constexpr int NTHREADS = 512, NWAVES = 8;

constexpr size_t SZ_UP = (size_t)2 * FF * D * 2, SZ_DN = (size_t)D * FF * 2, SZ_IN = (size_t)DIN * D * 2, SZ_LR = (size_t)1536 * 256 * 2,
                 SZ_GLU = (size_t)512 * 512 * 2, SZ_OUT = (size_t)D * D * 2;
constexpr size_t W_UP1 = 0, W_DN1 = W_UP1 + SZ_UP, W_IN = W_DN1 + SZ_DN, W_LR = W_IN + SZ_IN, W_GLU = W_LR + SZ_LR, W_OUT = W_GLU + SZ_GLU,
                 W_UP2 = W_OUT + SZ_OUT, W_DN2 = W_UP2 + SZ_UP, W_END = W_DN2 + SZ_DN;
constexpr size_t WS_XN = W_END, WS_BIG = WS_XN + (size_t)T * D * 2;
constexpr size_t WS_HID = WS_BIG;
constexpr size_t WS_PROJ = WS_BIG, WS_LRO = WS_PROJ + (size_t)T * DIN * 2, WS_ALR = WS_LRO + (size_t)T * 1536 * 2, WS_Z = WS_ALR + (size_t)T * 256 * 2,
                 WS_OR = WS_Z + (size_t)T * 512 * 2, WS_OH = WS_OR + (size_t)T * 512 * 4, WS_BON = WS_OH + (size_t)T * 512 * 4, WS_YC = WS_BON + (size_t)T * 8 * 4, WS_SS = WS_YC + (size_t)T * D * 2, WS_BAR = WS_SS + (size_t)3 * T * 4, WS_END = WS_BAR + 16384;
static_assert(WS_END <= (size_t)1 << 30, "workspace");
static_assert(WS_HID + (size_t)T * FF * 2 <= (size_t)1 << 30, "workspace");

constexpr int LDS_BYTES = 147456;

struct Args { const void* in[39]; float* out; unsigned char* ws; };
typedef const __attribute__((address_space(4))) Args& ArgsRef;

typedef __bf16 bf16x2_t __attribute__((ext_vector_type(2)));
__device__ __forceinline__ unsigned pk2(float lo, float hi) { const f32x2 v = (f32x2){lo, hi}; return __builtin_bit_cast(unsigned, __builtin_convertvector(v, bf16x2_t)); }
__device__ __forceinline__ float bflo(unsigned w) { return __uint_as_float(w << 16); }
__device__ __forceinline__ float bfhi(unsigned w) { return __uint_as_float(w & 0xffff0000u); }
__device__ __forceinline__ void unpack8(u32x4 q, float* f) { f[0] = bflo(q.x); f[1] = bfhi(q.x); f[2] = bflo(q.y); f[3] = bfhi(q.y); f[4] = bflo(q.z); f[5] = bfhi(q.z); f[6] = bflo(q.w); f[7] = bfhi(q.w); }
__device__ __forceinline__ u32x4 pack8(const float* f) { u32x4 o; o.x = pk2(f[0], f[1]); o.y = pk2(f[2], f[3]); o.z = pk2(f[4], f[5]); o.w = pk2(f[6], f[7]); return o; }
template <int CTRL> __device__ __forceinline__ float dpp(float x) { return __builtin_bit_cast(float, __builtin_amdgcn_mov_dpp(__builtin_bit_cast(int, x), CTRL, 0xf, 0xf, true)); }
constexpr int XOR1 = 0xB1, XOR2 = 0x4E, XOR7 = 0x141, XOR8 = 0x128;
__device__ __forceinline__ float red8(float v) { v += dpp<XOR1>(v); v += dpp<XOR2>(v); v += dpp<XOR7>(v); return v; }
__device__ __forceinline__ float red16(float v) { v = red8(v); v += dpp<XOR8>(v); return v; }
__device__ __forceinline__ float wave_sum(float v) {
#pragma unroll
    for (int o = 1; o < 64; o <<= 1) v += __shfl_xor(v, o);
    return v;
}
__device__ __forceinline__ float sigmoidf_(float x) { return __builtin_amdgcn_rcpf(1.0f + __expf(-x)); }
__device__ __forceinline__ float siluf_(float x) { return x * __builtin_amdgcn_rcpf(1.0f + __expf(-x)); }
__device__ __forceinline__ int opaque_tid() { int t = threadIdx.x; asm volatile("" : "+v"(t)); return t; }
__device__ __forceinline__ int opaque_bid() { int t = blockIdx.x; asm volatile("" : "+s"(t)); return t; }
__device__ __forceinline__ f32x2 pfma(f32x2 a, f32x2 b, f32x2 c) { return __builtin_elementwise_fma(a, b, c); }
#define LDS_FENCE() asm volatile("s_waitcnt lgkmcnt(0)" ::: "memory")
__device__ __forceinline__ void sincos_big(float x, float& sn, float& cs) {
    const float n = rintf(x * 0.15915494309189535f);
    float r = fmaf(-n, 6.28318548202514648f, x); r = fmaf(-n, -1.7484555e-7f, r);
    sn = __sinf(r); cs = __cosf(r);
}

namespace pg8 {
constexpr int BM = 256, BK = 64, HALF = 128, HTB = HALF * BK * 2, STAGE_BYTES = 8 * HTB, NXCD = 8, WGM = 8;
__host__ __device__ __forceinline__ int lds_byte(int r, int c) { const int st = (r >> 4) * 2 + (c >> 5), rr = r & 15, cc = c & 31, ob = rr * 64 + cc * 2; return st * 1024 + (ob ^ (((ob >> 9) & 1) << 5)); }
__host__ __device__ __forceinline__ void stage_rc(int b, int& R, int& C) { const int st = b / 1024, sb = b % 1024, swz = sb ^ (((sb >> 9) & 1) << 5); R = (st >> 1) * 16 + swz / 64; C = (st & 1) * 32 + (swz % 64) / 2; }
__host__ __device__ __forceinline__ int perm32(int rho) { const int n = rho >> 4, i = rho & 15; return 8 * (i >> 2) + 4 * n + (i & 3); }
struct Unit { int pm, pn; };
struct Gemm { const bf16_t* A; const bf16_t* Bt; int M, N, K; };
struct StaticOrder {
    int nM, nN, nwg, G, c;
    __device__ void init(int M, int N, int G_, int c_) { nM = M / BM; nN = N / BM; nwg = nM * nN; G = G_; c = c_; }
    __device__ bool next(int i, Unit& u) const {
        const long L = (long)i * G + c; if (L >= nwg) return false;
        int wgid = (int)L; { const int q = nwg / NXCD, r = nwg % NXCD, xcd = wgid % NXCD, off = wgid / NXCD; wgid = (xcd < r ? xcd * (q + 1) : r * (q + 1) + (xcd - r) * q) + off; }
        const int nig = WGM * nN, gid = wgid / nig, fm = gid * WGM, gsz = (nM - fm) < WGM ? (nM - fm) : WGM;
        u.pm = fm + ((wgid % nig) % gsz); u.pn = (wgid % nig) / gsz; return true;
    }
};
#ifndef GEMM_SP2
#define GEMM_SP2 true
#endif
#ifndef GEMM_ALIGN
#define GEMM_ALIGN true
#endif
template <class Epi, bool ALIGN_EPI = GEMM_ALIGN, bool SP2 = GEMM_SP2>
__device__ __forceinline__ void gemm_phase(LAS unsigned char* lds, const Gemm g, const StaticOrder S, const Epi E) {
    const int TID = opaque_tid(), BID = opaque_bid(); (void)TID; (void)BID;
    const int tid = TID, wid = __builtin_amdgcn_readfirstlane(tid >> 6), lane = tid & 63, wr = wid >> 2, wc = wid & 3, fr = lane & 15, fq = lane >> 4;
    const int K = g.K, nt = K / BK;
    unsigned voffA[2], voffB[2];
#pragma unroll
    for (int i = 0; i < 2; ++i) { int R, C; stage_rc(tid * 16 + i * 8192, R, C); const int Rb = Epi::PERM ? ((R & ~31) + perm32(R & 31)) : R;
        voffA[i] = (unsigned)(R * K + C) * 2u; voffB[i] = (unsigned)(Rb * K + C) * 2u; }
    const size_t kstep = (size_t)(BK * 2);
    const size_t hstep = (size_t)HALF * K * 2;
    const size_t tstep = 2 * hstep;
    const unsigned ldsw = (unsigned)wid * 1024u;
    const int aoff = lds_byte(wr * 64 + fr, fq * 8), boff = lds_byte(wc * 32 + fr, fq * 8);
#define PG8_SA(b, h) (((b) * 2 + (h)) * HTB)
#define PG8_SB(b, h) ((4 + (b) * 2 + (h)) * HTB)
#define PG8_STAGE(bufoff, gbase, voff) do { _Pragma("unroll") for (int _i = 0; _i < 2; ++_i) \
        __builtin_amdgcn_global_load_lds((const unsigned*)((const char*)(gbase) + (voff)[_i]), (LAS unsigned*)(lds + (bufoff) + ldsw + _i * 8192), 16, 0, 0); } while (0)
#define PG8_LDA(dst, b, h) do { _Pragma("unroll") for (int m = 0; m < 4; ++m) _Pragma("unroll") for (int k = 0; k < 2; ++k) dst[m][k] = *(const LAS bf16x8*)(lds + PG8_SA(b, h) + aoff + m * 2048 + k * 1024); } while (0)
#define PG8_LDB(dst, b, h) do { _Pragma("unroll") for (int n = 0; n < 2; ++n) _Pragma("unroll") for (int k = 0; k < 2; ++k) dst[n][k] = *(const LAS bf16x8*)(lds + PG8_SB(b, h) + boff + n * 2048 + k * 1024); } while (0)
#define PG8_MMA(ai, bj, At, Bt) do { __builtin_amdgcn_s_setprio(1); _Pragma("unroll") for (int m = 0; m < 4; ++m) _Pragma("unroll") for (int n = 0; n < 2; ++n) _Pragma("unroll") for (int k = 0; k < 2; ++k) \
        acc[ai][bj][m][n] = __builtin_amdgcn_mfma_f32_16x16x32_bf16(Bt[n][k], At[m][k], acc[ai][bj][m][n], 0, 0, 0); __builtin_amdgcn_s_setprio(0); } while (0)
#define PG8_WAIT_V(n) asm volatile("s_waitcnt vmcnt(" #n ")" ::: "memory")
#define PG8_WAIT_L(n) asm volatile("s_waitcnt lgkmcnt(" #n ")" ::: "memory")
#define PG8_BAR __builtin_amdgcn_s_barrier()
#define PG8_SCHED __builtin_amdgcn_sched_barrier(0)
    Unit cur, nxt; int ui = 0;
    if (!S.next(0, cur)) return;
    f32x4 acc[2][2][4][2];
#pragma unroll
    for (int a = 0; a < 2; ++a)
#pragma unroll
        for (int b = 0; b < 2; ++b)
#pragma unroll
            for (int m = 0; m < 4; ++m)
#pragma unroll
                for (int n = 0; n < 2; ++n) acc[a][b][m][n] = (f32x4){0.f, 0.f, 0.f, 0.f};
    bf16x8 At[4][2], B0[2][2], B1[2][2];
    const char* cA = (const char*)g.A + (size_t)cur.pm * tstep; const char* cB = (const char*)g.Bt + (size_t)cur.pn * tstep;
    if constexpr (SP2) {
        PG8_STAGE(PG8_SB(0, 0), cB, voffB); PG8_STAGE(PG8_SB(0, 1), cB + hstep, voffB); PG8_STAGE(PG8_SA(0, 0), cA, voffA); PG8_STAGE(PG8_SA(0, 1), cA + hstep, voffA);
        if (wr == 1) PG8_BAR;
        PG8_WAIT_V(2); PG8_BAR;
        PG8_STAGE(PG8_SB(1, 0), cB + kstep, voffB); PG8_STAGE(PG8_SA(1, 0), cA + kstep, voffA); PG8_STAGE(PG8_SB(1, 1), cB + hstep + kstep, voffB);
        PG8_WAIT_V(6); PG8_BAR;
    } else {
        PG8_STAGE(PG8_SB(0, 0), cB, voffB); PG8_STAGE(PG8_SA(0, 0), cA, voffA); PG8_STAGE(PG8_SB(0, 1), cB + hstep, voffB); PG8_STAGE(PG8_SA(0, 1), cA + hstep, voffA);
        if (wr == 1) PG8_BAR;
        PG8_WAIT_V(4); PG8_BAR;
        PG8_STAGE(PG8_SB(1, 0), cB + kstep, voffB); PG8_STAGE(PG8_SA(1, 0), cA + kstep, voffA); PG8_STAGE(PG8_SB(1, 1), cB + hstep + kstep, voffB);
        PG8_WAIT_V(6); PG8_BAR;
    }
    for (;;) {
        const bool has_next = S.next(ui + 1, nxt);
        const char* nA = has_next ? (const char*)g.A + (size_t)nxt.pm * tstep : cA; const char* nB = has_next ? (const char*)g.Bt + (size_t)nxt.pn * tstep : cB;
#pragma unroll 1
        for (int t = 0; t < nt; t += 2) {
            const bool last = (t == nt - 2);
            const char* a1 = cA + (size_t)(t + 1) * kstep;
            const char* a2 = last ? nA : cA + (size_t)(t + 2) * kstep; const char* b2 = last ? nB : cB + (size_t)(t + 2) * kstep;
            const char* a3 = a2 + kstep; const char* b3 = b2 + kstep;
            if constexpr (SP2) {
            PG8_LDB(B0, 0, 0); PG8_LDB(B1, 0, 1); PG8_SCHED; PG8_LDA(At, 0, 0); PG8_STAGE(PG8_SA(1, 1), a1 + hstep, voffA);
            PG8_WAIT_V(8); PG8_WAIT_L(0); PG8_BAR; PG8_MMA(0, 0, At, B0); PG8_MMA(0, 1, At, B1); PG8_BAR; PG8_SCHED;
            PG8_LDA(At, 0, 1); PG8_STAGE(PG8_SB(0, 0), b2, voffB); PG8_STAGE(PG8_SB(0, 1), b2 + hstep, voffB); PG8_STAGE(PG8_SA(0, 0), a2, voffA);
            PG8_WAIT_V(8); PG8_WAIT_L(0); PG8_BAR; PG8_MMA(1, 0, At, B0); PG8_MMA(1, 1, At, B1); PG8_BAR; PG8_SCHED;
            PG8_LDB(B0, 1, 0); PG8_LDB(B1, 1, 1); PG8_SCHED; PG8_LDA(At, 1, 0); PG8_STAGE(PG8_SA(0, 1), a2 + hstep, voffA);
            PG8_WAIT_V(8); PG8_WAIT_L(0); PG8_BAR; PG8_MMA(0, 0, At, B0); PG8_MMA(0, 1, At, B1); PG8_BAR; PG8_SCHED;
            PG8_LDA(At, 1, 1); PG8_STAGE(PG8_SB(1, 0), b3, voffB); PG8_STAGE(PG8_SB(1, 1), b3 + hstep, voffB); PG8_STAGE(PG8_SA(1, 0), a3, voffA);
            PG8_WAIT_V(8); PG8_WAIT_L(0); PG8_BAR; PG8_MMA(1, 0, At, B0); PG8_MMA(1, 1, At, B1); PG8_BAR; PG8_SCHED;
            } else {
            PG8_LDB(B0, 0, 0); PG8_SCHED; PG8_LDA(At, 0, 0); PG8_STAGE(PG8_SA(1, 1), a1 + hstep, voffA);
            PG8_WAIT_L(8); PG8_BAR; PG8_WAIT_L(0); PG8_MMA(0, 0, At, B0); PG8_BAR; PG8_SCHED;
            PG8_LDB(B1, 0, 1); PG8_STAGE(PG8_SB(0, 0), b2, voffB);
            PG8_BAR; PG8_WAIT_L(0); PG8_MMA(0, 1, At, B1); PG8_BAR;
            PG8_LDA(At, 0, 1); PG8_STAGE(PG8_SA(0, 0), a2, voffA);
            PG8_BAR; PG8_WAIT_L(0); PG8_MMA(1, 0, At, B0); PG8_BAR; PG8_SCHED;
            PG8_STAGE(PG8_SB(0, 1), b2 + hstep, voffB);
            PG8_WAIT_V(6); PG8_BAR; PG8_MMA(1, 1, At, B1); PG8_BAR;
            PG8_LDB(B0, 1, 0); PG8_SCHED; PG8_LDA(At, 1, 0); PG8_STAGE(PG8_SA(0, 1), a2 + hstep, voffA);
            PG8_WAIT_L(8); PG8_BAR; PG8_WAIT_L(0); PG8_MMA(0, 0, At, B0); PG8_BAR; PG8_SCHED;
            PG8_LDB(B1, 1, 1); PG8_STAGE(PG8_SB(1, 0), b3, voffB);
            PG8_BAR; PG8_WAIT_L(0); PG8_MMA(0, 1, At, B1); PG8_BAR;
            PG8_LDA(At, 1, 1); PG8_STAGE(PG8_SA(1, 0), a3, voffA);
            PG8_BAR; PG8_WAIT_L(0); PG8_MMA(1, 0, At, B0); PG8_BAR; PG8_SCHED;
            PG8_STAGE(PG8_SB(1, 1), b3 + hstep, voffB);
            PG8_WAIT_V(6); PG8_BAR; PG8_MMA(1, 1, At, B1); PG8_BAR;
            }
        }
        if constexpr (ALIGN_EPI) { if (wr == 0) PG8_BAR; }
        E(acc, cur, wr, wc, fr, fq);
        if (!has_next) break;
#pragma unroll
        for (int a = 0; a < 2; ++a)
#pragma unroll
            for (int b = 0; b < 2; ++b)
#pragma unroll
                for (int m = 0; m < 4; ++m)
#pragma unroll
                    for (int n = 0; n < 2; ++n) acc[a][b][m][n] = (f32x4){0.f, 0.f, 0.f, 0.f};
        cur = nxt; cA = nA; cB = nB; ++ui;
        if constexpr (ALIGN_EPI) { if (wr == 1) PG8_BAR; }
    }
    PG8_WAIT_V(0);
    if constexpr (!ALIGN_EPI) { if (wr == 0) PG8_BAR; }
    PG8_BAR;
#undef PG8_SA
#undef PG8_SB
#undef PG8_STAGE
#undef PG8_LDA
#undef PG8_LDB
#undef PG8_MMA
#undef PG8_WAIT_V
#undef PG8_WAIT_L
#undef PG8_BAR
#undef PG8_SCHED
}

struct EpiSwiGLU {
    static constexpr bool PERM = true;
    bf16_t* H; const float* SS;
    __device__ __forceinline__ void operator()(const f32x4 (&acc)[2][2][4][2], const Unit& u, int wr, int wc, int fr, int fq) const {
        const int row0 = u.pm * BM + wr * 64 + fr, col0 = u.pn * 128 + wc * 32 + 8 * fq;
        float rsv[2][4];
#pragma unroll
        for (int ai = 0; ai < 2; ++ai)
#pragma unroll
            for (int m = 0; m < 4; ++m) rsv[ai][m] = SS[row0 + ai * HALF + m * 16];
#pragma unroll
        for (int ai = 0; ai < 2; ++ai)
#pragma unroll
            for (int m = 0; m < 4; ++m) {
                const float rs = __builtin_amdgcn_rsqf(rsv[ai][m] * (1.0f / D) + 1e-6f);
                float v[8];
#pragma unroll
                for (int n = 0; n < 2; ++n)
#pragma unroll
                    for (int j = 0; j < 4; ++j) { const float gt = acc[ai][0][m][n][j] * rs, up = acc[ai][1][m][n][j] * rs; v[4 * n + j] = siluf_(gt) * up; }
                *(u32x4*)(H + (size_t)(row0 + ai * HALF + m * 16) * FF + col0) = pack8(v);
            }
    }
};
template <bool HALFSTEP> struct EpiResidual {
    static constexpr bool PERM = false;
    static constexpr float scale = HALFSTEP ? 0.5f : 1.0f;
    const float* base; float* out; bf16_t* XN; float* SS;
    __device__ __forceinline__ void operator()(const f32x4 (&acc)[2][2][4][2], const Unit& u, int wr, int wc, int fr, int fq) const {
        const int row0 = u.pm * BM + wr * 64 + fr, col0 = u.pn * BM + wc * 32 + 4 * fq;
#pragma unroll
        for (int ai = 0; ai < 2; ++ai) {
            f32x4 bv[4][2][2];
#pragma unroll
            for (int m = 0; m < 4; ++m)
#pragma unroll
                for (int bj = 0; bj < 2; ++bj)
#pragma unroll
                    for (int n = 0; n < 2; ++n) bv[m][bj][n] = *(const f32x4*)(base + (size_t)(row0 + ai * HALF + m * 16) * D + col0 + bj * HALF + n * 16);
#pragma unroll
            for (int m = 0; m < 4; ++m) { const int row = row0 + ai * HALF + m * 16; const size_t ro = (size_t)row * D + col0; float ss = 0.f;
#pragma unroll
                for (int bj = 0; bj < 2; ++bj)
#pragma unroll
                    for (int n = 0; n < 2; ++n) { const f32x4 r = bv[m][bj][n] + acc[ai][bj][m][n] * scale; *(f32x4*)(out + ro + bj * HALF + n * 16) = r;
                        if (XN) { u32x2 w; w.x = pk2(r.x, r.y); w.y = pk2(r.z, r.w); *(u32x2*)(XN + ro + bj * HALF + n * 16) = w; ss += (r.x * r.x + r.y * r.y) + (r.z * r.z + r.w * r.w); } }
                if (XN) { ss += __shfl_xor(ss, 16); ss += __shfl_xor(ss, 32); if (fq == 0) atomicAdd(SS + row, ss); } }
        }
    }
};
struct EpiBf16 {
    static constexpr bool PERM = true;
    bf16_t* O; int ldc; const float* SS;
    __device__ __forceinline__ void operator()(const f32x4 (&acc)[2][2][4][2], const Unit& u, int wr, int wc, int fr, int fq) const {
        const int row0 = u.pm * BM + wr * 64 + fr, col0 = u.pn * BM + wc * 32 + 8 * fq;
        float rsv[2][4];
#pragma unroll
        for (int ai = 0; ai < 2; ++ai)
#pragma unroll
            for (int m = 0; m < 4; ++m) rsv[ai][m] = SS[row0 + ai * HALF + m * 16];
#pragma unroll
        for (int ai = 0; ai < 2; ++ai)
#pragma unroll
            for (int m = 0; m < 4; ++m) { bf16_t* rowp = O + (size_t)(row0 + ai * HALF + m * 16) * ldc + col0;
                const float rs = __builtin_amdgcn_rsqf(rsv[ai][m] * (1.0f / D) + 1e-6f);
#pragma unroll
                for (int bj = 0; bj < 2; ++bj) { const f32x4 v0 = acc[ai][bj][m][0] * rs, v1 = acc[ai][bj][m][1] * rs;
                    u32x4 w; w.x = pk2(v0[0], v0[1]); w.y = pk2(v0[2], v0[3]); w.z = pk2(v1[0], v1[1]); w.w = pk2(v1[2], v1[3]);
                    *(u32x4*)(rowp + bj * HALF) = w; } }
    }
};
struct EpiLR {
    static constexpr bool PERM = true;
    bf16_t* O; const float* w0; const float* a0;
    template <int KIND> __device__ __forceinline__ void body(const f32x4 (&acc)[2][2][4][2], const float* bp, int row0, int col0) const {
#pragma unroll
        for (int bj = 0; bj < 2; ++bj) {
            f32x4 b0 = (f32x4){0.f, 0.f, 0.f, 0.f}, b1 = b0;
            if (KIND < 2) { b0 = *(const f32x4*)(bp + bj * HALF); b1 = *(const f32x4*)(bp + bj * HALF + 4); }
#pragma unroll
            for (int ai = 0; ai < 2; ++ai)
#pragma unroll
                for (int m = 0; m < 4; ++m) {
                    u32x4 w;
#pragma unroll
                    for (int n = 0; n < 2; ++n) {
                        float r[4];
#pragma unroll
                        for (int j = 0; j < 4; ++j) { const float x = acc[ai][bj][m][n][j] + (n == 0 ? b0[j] : b1[j]);
                            if (KIND == 0) { const float e = __expf(-x); r[j] = -0.60653065971f * __builtin_amdgcn_rcpf(1.0f + e); }
                            else if (KIND == 1) r[j] = __builtin_amdgcn_rcpf(1.0f + __expf(-x)); else r[j] = x; }
                        if (n == 0) { w.x = pk2(r[0], r[1]); w.y = pk2(r[2], r[3]); } else { w.z = pk2(r[0], r[1]); w.w = pk2(r[2], r[3]); }
                    }
                    *(u32x4*)(O + (size_t)(row0 + ai * HALF + m * 16) * 1536 + col0 + bj * HALF) = w;
                }
        }
    }
    __device__ __forceinline__ void operator()(const f32x4 (&acc)[2][2][4][2], const Unit& u, int wr, int wc, int fr, int fq) const {
        const int row0 = u.pm * BM + wr * 64 + fr, col0 = u.pn * BM + wc * 32 + 8 * fq, kind = u.pn >> 1, f0 = col0 - 512 * kind;
        if (kind == 0) body<0>(acc, w0 + f0, row0, col0); else if (kind == 1) body<1>(acc, a0 + f0, row0, col0); else body<2>(acc, nullptr, row0, col0);
    }
};
struct EpiGLU {
    static constexpr bool PERM = true;
    const bf16_t* Z; bf16_t* Y; const float* b;
    __device__ __forceinline__ void operator()(const f32x4 (&acc)[2][2][4][2], const Unit& u, int wr, int wc, int fr, int fq) const {
        const int row0 = u.pm * BM + wr * 64 + fr, col0 = u.pn * BM + wc * 32 + 8 * fq;
#pragma unroll
        for (int bj = 0; bj < 2; ++bj) {
            const f32x4 bias0 = *(const f32x4*)(b + col0 + bj * HALF), bias1 = *(const f32x4*)(b + col0 + bj * HALF + 4);
            u32x4 zr[2][4];
#pragma unroll
            for (int ai = 0; ai < 2; ++ai)
#pragma unroll
                for (int m = 0; m < 4; ++m) zr[ai][m] = *(const u32x4*)(Z + (size_t)(row0 + ai * HALF + m * 16) * 512 + col0 + bj * HALF);
#pragma unroll
            for (int ai = 0; ai < 2; ++ai)
#pragma unroll
                for (int m = 0; m < 4; ++m) { const size_t r = (size_t)(row0 + ai * HALF + m * 16);
                    float z[8], v[8]; unpack8(zr[ai][m], z);
#pragma unroll
                    for (int n = 0; n < 2; ++n)
#pragma unroll
                        for (int j = 0; j < 4; ++j) v[4 * n + j] = z[4 * n + j] * sigmoidf_(acc[ai][bj][m][n][j] + (n == 0 ? bias0[j] : bias1[j]));
                    *(u32x4*)(Y + r * D + 1024 + col0 + bj * HALF) = pack8(v); }
        }
    }
};
}

template <class Epi> __device__ __forceinline__ void run_gemm(LAS unsigned char* lds, const bf16_t* A, const bf16_t* Bt, int N, int K, const Epi E) {
    pg8::Gemm g; g.A = A; g.Bt = Bt; g.M = T; g.N = N; g.K = K;
    pg8::StaticOrder S; S.init(T, N, gridDim.x, opaque_bid());
    pg8::gemm_phase<Epi>(lds, g, S, E);
}

struct TrItem { const float* W; int ldw, k0, n0; const float* gs; bf16_t* Dst; int ldd, drow0, dk0; };
__device__ __forceinline__ void tr_load(const TrItem& it, f32x4 (&v)[8], int lane) {
    if (it.W) {
#pragma unroll
        for (int i = 0; i < 8; ++i) { const int kk = 8 * i + (lane >> 3); v[i] = *(const f32x4*)(it.W + (size_t)(it.k0 + kk) * it.ldw + it.n0 + 4 * (lane & 7)); }
    } else {
#pragma unroll
        for (int i = 0; i < 8; ++i) v[i] = (f32x4){0.f, 0.f, 0.f, 0.f};
    }
}
__device__ __forceinline__ void tr_finish(const TrItem& it, const f32x4 (&v)[8], LAS float* scr, int lane) {
#pragma unroll
    for (int i = 0; i < 8; ++i) { const int kk = 8 * i + (lane >> 3); f32x4 x = v[i]; if (it.gs) x = x * it.gs[it.k0 + kk];
        LAS float* d = scr + kk * 33 + 4 * (lane & 7); d[0] = x.x; d[1] = x.y; d[2] = x.z; d[3] = x.w; }
    LDS_FENCE();
    const int c = lane & 7;
#pragma unroll
    for (int j = 0; j < 4; ++j) { const int n = (lane >> 3) + 8 * j; const LAS float* s = scr + (8 * c) * 33 + n;
        u32x4 o; o.x = pk2(s[0 * 33], s[1 * 33]); o.y = pk2(s[2 * 33], s[3 * 33]); o.z = pk2(s[4 * 33], s[5 * 33]); o.w = pk2(s[6 * 33], s[7 * 33]);
        *(u32x4*)(it.Dst + (size_t)(it.drow0 + n) * it.ldd + it.dk0 + it.k0 + 8 * c) = o; }
    LDS_FENCE();
}
__device__ __forceinline__ TrItem conv_item(ArgsRef a, int l, int it) {
    unsigned char* ws = a.ws;
    constexpr int I_GU = (D / 64) * (FF / 32), I_DN = (FF / 64) * (D / 32), I_IN = (D / 64) * (DIN / 32), I_OUT = (D / 64) * (D / 32), I_GLU = 8 * 16;
    static_assert(I_GU == I_DN, "items");
    TrItem t; t.gs = nullptr; t.dk0 = 0;
    int r = it;
    if (r < 6 * I_GU) {
        const int which = r / I_GU; r -= which * I_GU;
        const int f = which >= 3, m = which % 3;
        if (m < 2) {
            const int nblk = FF / 32, kb = r / nblk, nb = r % nblk, n0 = 32 * nb;
            t.W = (const float*)a.in[(f ? 36 : 3) + m] + (size_t)l * D * FF; t.ldw = FF; t.k0 = 64 * kb; t.n0 = n0; t.gs = (const float*)a.in[f ? 35 : 2] + (size_t)l * D;
            t.Dst = (bf16_t*)(ws + (f ? W_UP2 : W_UP1)); t.ldd = D; t.drow0 = (n0 >> 7) * 256 + (n0 & 127) + 128 * m;
        } else {
            const int nblk = D / 32, kb = r / nblk, nb = r % nblk;
            t.W = (const float*)a.in[f ? 38 : 5] + (size_t)l * FF * D; t.ldw = D; t.k0 = 64 * kb; t.n0 = 32 * nb; t.Dst = (bf16_t*)(ws + (f ? W_DN2 : W_DN1)); t.ldd = FF; t.drow0 = 32 * nb;
        }
        return t;
    }
    r -= 6 * I_GU;
    if (r < I_IN) { const int nblk = DIN / 32, kb = r / nblk, nb = r % nblk;
        t.W = (const float*)a.in[7] + (size_t)l * D * DIN; t.ldw = DIN; t.k0 = 64 * kb; t.n0 = 32 * nb; t.gs = (const float*)a.in[6] + (size_t)l * D; t.Dst = (bf16_t*)(ws + W_IN); t.ldd = D; t.drow0 = 32 * nb; return t; }
    r -= I_IN;
    if (r < I_OUT) { const int nblk = D / 32, kb = r / nblk, nb = r % nblk;
        t.W = (const float*)a.in[34] + (size_t)l * D * D; t.ldw = D; t.k0 = 64 * kb; t.n0 = 32 * nb; t.Dst = (bf16_t*)(ws + W_OUT); t.ldd = D; t.drow0 = 32 * nb; return t; }
    r -= I_OUT;
    if (r < I_GLU) { const int kb = r / 16, nb = r % 16;
        t.W = (const float*)a.in[30] + (size_t)l * 512 * 512; t.ldw = 512; t.k0 = 64 * kb; t.n0 = 32 * nb; t.Dst = (bf16_t*)(ws + W_GLU); t.ldd = 512; t.drow0 = 32 * nb; return t; }
    r -= I_GLU;
    {
        const int nb = r >> 2, kb = r & 3, kind = nb >> 4, nn0 = 32 * (nb & 15);
        const float* W = nullptr; int k0 = 0;
        if (kind == 0 && kb == 0) { W = (const float*)a.in[10] + (size_t)l * 64 * 512; k0 = 0; }
        else if (kind == 1 && kb == 1) { W = (const float*)a.in[12] + (size_t)l * 64 * 512; k0 = 0; }
        else if (kind == 2 && kb >= 2) { W = (const float*)a.in[13] + (size_t)l * 128 * 512; k0 = 64 * (kb - 2); }
        t.W = W; t.ldw = 512; t.k0 = k0; t.n0 = nn0; t.Dst = (bf16_t*)(ws + W_LR); t.ldd = 256; t.drow0 = 32 * nb; t.dk0 = 64 * kb - k0;
    }
    return t;
}
__device__ __forceinline__ void conv_phase(ArgsRef a, int l, LAS unsigned char* lds) {
    const int TID = opaque_tid(), BID = opaque_bid();
    const int wave = TID >> 6, lane = TID & 63;
    LAS float* scr = (LAS float*)(lds + wave * 8704);
    const int gw = BID * NWAVES + wave, NGW = gridDim.x * NWAVES;
    constexpr int NITEMS = 6 * (D / 64) * (FF / 32) + (D / 64) * (DIN / 32) + (D / 64) * (D / 32) + 8 * 16 + 48 * 4;
    if (gw >= NITEMS) return;
    TrItem cur = conv_item(a, l, gw);
    f32x4 v[8]; tr_load(cur, v, lane);
    for (int it = gw; it < NITEMS; it += NGW) {
        f32x4 w[8];
#pragma unroll
        for (int i = 0; i < 8; ++i) w[i] = v[i];
        const TrItem me = cur;
        if (it + NGW < NITEMS) { cur = conv_item(a, l, it + NGW); tr_load(cur, v, lane); }
        tr_finish(me, w, scr, lane);
    }
}

__device__ __forceinline__ void norm_phase(const float* x, bf16_t* XN, float* SS) {
    const int TID = opaque_tid(), BID = opaque_bid(); (void)TID; (void)BID;
    const int wave = TID >> 6, lane = TID & 63;
    const int gw = BID * NWAVES + wave, NGW = gridDim.x * NWAVES;
    for (int m = gw; m < T; m += NGW) {
        const f32x4* xr = (const f32x4*)(x + (size_t)m * D) + lane;
        f32x4 v[8]; float s = 0.f;
#pragma unroll
        for (int j = 0; j < 8; ++j) { v[j] = xr[64 * j]; s += (v[j].x * v[j].x + v[j].y * v[j].y) + (v[j].z * v[j].z + v[j].w * v[j].w); }
        s = wave_sum(s); if (lane == 0) SS[m] = s;
        u32x2* o = (u32x2*)(XN + (size_t)m * D) + lane;
#pragma unroll
        for (int j = 0; j < 8; ++j) { u32x2 w; w.x = pk2(v[j].x, v[j].y); w.y = pk2(v[j].z, v[j].w); o[64 * j] = w; }
    }
}

__device__ __forceinline__ void zero_phase(float* p, int n) {
    const int TID = opaque_tid(), BID = opaque_bid();
    for (int i = BID * NTHREADS + TID; i < n; i += gridDim.x * NTHREADS) p[i] = 0.f;
}
__device__ __forceinline__ void alr_phase(ArgsRef a, int l) {
    const int TID = opaque_tid(), BID = opaque_bid(); (void)TID; (void)BID;
    const bf16_t* P = (const bf16_t*)(a.ws + WS_PROJ); bf16_t* ALR = (bf16_t*)(a.ws + WS_ALR);
    const float* mu = (const float*)a.in[8] + (size_t)l * 1792 + 1536;
    const int gt = BID * NTHREADS + TID, NGT = gridDim.x * NTHREADS;
    for (int it = gt; it < T * 32; it += NGT) {
        const int t = it >> 5, cg = it & 31, c0 = 8 * cg;
        float cur[8], prv[8], o[8];
        unpack8(*(const u32x4*)(P + (size_t)t * DIN + 1536 + c0), cur);
        if ((t & (SEQ - 1)) != 0) unpack8(*(const u32x4*)(P + (size_t)(t - 1) * DIN + 1536 + c0), prv);
        else {
#pragma unroll
            for (int j = 0; j < 8; ++j) prv[j] = 0.f; }
#pragma unroll
        for (int j = 0; j < 8; ++j) { const float v = cur[j] + (prv[j] - cur[j]) * mu[c0 + j];
            o[j] = c0 < 64 ? tanhf(v) : (c0 < 128 ? v : sigmoidf_(v)); }
        *(u32x4*)(ALR + (size_t)t * 256 + c0) = pack8(o);
    }
}

__device__ __forceinline__ void rwkv_full(ArgsRef a, int l, LAS unsigned char* lds, int job, int tid) {
    const bf16_t* P = (const bf16_t*)(a.ws + WS_PROJ); const bf16_t* LR = (const bf16_t*)(a.ws + WS_LRO); bf16_t* Y = (bf16_t*)(a.ws + WS_YC);
    LAS float* sR = (LAS float*)lds; LAS float* sW = sR + 4096; LAS float* sK = sW + 4096; LAS float* sKK = sK + 4096; LAS float* sB = sKK + 4096;
    LAS float* sV = sB + 4096; LAS float* sO = sV + 4096; LAS float* sBon = sO + 4096;
    const int wave = tid >> 6, lane = tid & 63, tt = tid >> 3, cg = tid & 7;
    const int b = job >> 3, h = job & 7, c0 = 64 * h + 8 * cg;
    float mur[8], muk[8], muv[8], kkw[8], kaw[8], rkw[8], lnw[8], lnb[8];
#pragma unroll
    for (int j = 0; j < 8; ++j) {
        mur[j] = ((const float*)a.in[8])[(size_t)l * 1792 + c0 + j]; muk[j] = ((const float*)a.in[8])[(size_t)l * 1792 + 512 + c0 + j]; muv[j] = ((const float*)a.in[8])[(size_t)l * 1792 + 1024 + c0 + j];
        kkw[j] = ((const float*)a.in[14])[(size_t)l * 512 + c0 + j]; kaw[j] = ((const float*)a.in[15])[(size_t)l * 512 + c0 + j]; rkw[j] = ((const float*)a.in[16])[(size_t)l * 512 + c0 + j];
        lnw[j] = ((const float*)a.in[17])[(size_t)l * 512 + c0 + j]; lnb[j] = ((const float*)a.in[18])[(size_t)l * 512 + c0 + j]; }
    f32x2 st0 = (f32x2){0.f, 0.f}, st1 = st0, st2 = st0, st3 = st0;
    const int row = 8 * wave + (lane >> 3), jq = lane & 7;
    u32x4 graw[9];
    const u32x4 zero4 = (u32x4){0u, 0u, 0u, 0u};
#define RWF_ISSUE(ch_) do { const int s_ = (ch_) * 64 + tt; const size_t t_ = (size_t)b * SEQ + s_; \
        graw[0] = *(const u32x4*)(P + t_ * DIN + c0); graw[1] = *(const u32x4*)(P + t_ * DIN + 512 + c0); graw[2] = *(const u32x4*)(P + t_ * DIN + 1024 + c0); \
        if (s_ != 0) { graw[3] = *(const u32x4*)(P + (t_ - 1) * DIN + c0); graw[4] = *(const u32x4*)(P + (t_ - 1) * DIN + 512 + c0); graw[5] = *(const u32x4*)(P + (t_ - 1) * DIN + 1024 + c0); } \
        else { graw[3] = zero4; graw[4] = zero4; graw[5] = zero4; } \
        graw[6] = *(const u32x4*)(LR + t_ * 1536 + c0); graw[7] = *(const u32x4*)(LR + t_ * 1536 + 512 + c0); graw[8] = *(const u32x4*)(LR + t_ * 1536 + 1024 + c0); } while (0)
    RWF_ISSUE(0);
    for (int ch = 0; ch < SEQ / 64; ++ch) {
        __syncthreads();
        float gate[8];
        {
            float r[8], k[8], v[8], pr[8], ld[8], av[8];
            unpack8(graw[0], r); unpack8(graw[1], k); unpack8(graw[2], v);
            unpack8(graw[3], pr);
#pragma unroll
            for (int j = 0; j < 8; ++j) r[j] += (pr[j] - r[j]) * mur[j];
            unpack8(graw[4], pr);
#pragma unroll
            for (int j = 0; j < 8; ++j) k[j] += (pr[j] - k[j]) * muk[j];
            unpack8(graw[5], pr);
#pragma unroll
            for (int j = 0; j < 8; ++j) v[j] += (pr[j] - v[j]) * muv[j];
            unpack8(graw[6], ld); unpack8(graw[7], av); unpack8(graw[8], gate);
            if (ch + 1 < SEQ / 64) RWF_ISSUE(ch + 1);
            float kk[8], ss = 0.f, bp = 0.f;
#pragma unroll
            for (int j = 0; j < 8; ++j) { kk[j] = k[j] * kkw[j]; ss += kk[j] * kk[j]; }
            ss = red8(ss);
            const float inv = __builtin_amdgcn_rsqf(fmaxf(ss, 1e-24f));
            float w8[8], k8[8], b8[8];
#pragma unroll
            for (int j = 0; j < 8; ++j) { kk[j] *= inv; k8[j] = k[j] * (1.0f + (av[j] - 1.0f) * kaw[j]); b8[j] = kk[j] * av[j]; w8[j] = __expf(ld[j]); bp += r[j] * k8[j] * rkw[j]; }
            bp = red8(bp);
            if (cg == 0) sBon[tt] = bp;
            LAS float* d;
            d = sR + tt * 64 + 8 * cg; *(LAS f32x4*)d = (f32x4){r[0], r[1], r[2], r[3]}; *(LAS f32x4*)(d + 4) = (f32x4){r[4], r[5], r[6], r[7]};
            d = sW + tt * 64 + 8 * cg; *(LAS f32x4*)d = (f32x4){w8[0], w8[1], w8[2], w8[3]}; *(LAS f32x4*)(d + 4) = (f32x4){w8[4], w8[5], w8[6], w8[7]};
            d = sK + tt * 64 + 8 * cg; *(LAS f32x4*)d = (f32x4){k8[0], k8[1], k8[2], k8[3]}; *(LAS f32x4*)(d + 4) = (f32x4){k8[4], k8[5], k8[6], k8[7]};
            d = sKK + tt * 64 + 8 * cg; *(LAS f32x4*)d = (f32x4){kk[0], kk[1], kk[2], kk[3]}; *(LAS f32x4*)(d + 4) = (f32x4){kk[4], kk[5], kk[6], kk[7]};
            d = sB + tt * 64 + 8 * cg; *(LAS f32x4*)d = (f32x4){b8[0], b8[1], b8[2], b8[3]}; *(LAS f32x4*)(d + 4) = (f32x4){b8[4], b8[5], b8[6], b8[7]};
            d = sV + tt * 64 + 8 * cg; *(LAS f32x4*)d = (f32x4){v[0], v[1], v[2], v[3]}; *(LAS f32x4*)(d + 4) = (f32x4){v[4], v[5], v[6], v[7]};
        }
        __syncthreads();
        {
#define RWF_LD(arr, s_) const f32x4 arr##a = *(const LAS f32x4*)(arr + (s_) * 64 + 8 * jq), arr##b = *(const LAS f32x4*)(arr + (s_) * 64 + 8 * jq + 4)
            f32x4 w_a = *(const LAS f32x4*)(sW + 8 * jq), w_b = *(const LAS f32x4*)(sW + 8 * jq + 4), kk_a = *(const LAS f32x4*)(sKK + 8 * jq), kk_b = *(const LAS f32x4*)(sKK + 8 * jq + 4),
                  b_a = *(const LAS f32x4*)(sB + 8 * jq), b_b = *(const LAS f32x4*)(sB + 8 * jq + 4), k_a = *(const LAS f32x4*)(sK + 8 * jq), k_b = *(const LAS f32x4*)(sK + 8 * jq + 4),
                  r_a = *(const LAS f32x4*)(sR + 8 * jq), r_b = *(const LAS f32x4*)(sR + 8 * jq + 4);
            float vi = sV[row];
            f32x2 pyp = (f32x2){0.f, 0.f}; float ykeep = 0.f;
#pragma unroll 1
            for (int s8 = 0; s8 < 64; s8 += 8) {
#pragma unroll
                for (int u = 0; u < 8; ++u) {
                    const int sn = (s8 + u + 1) & 63;
                    RWF_LD(sW, sn); RWF_LD(sKK, sn); RWF_LD(sB, sn); RWF_LD(sK, sn); RWF_LD(sR, sn);
                    const float nvi = sV[sn * 64 + row];
                    f32x2 pa = st0 * (f32x2){kk_a.x, kk_a.y}; pa = pfma(st1, (f32x2){kk_a.z, kk_a.w}, pa); pa = pfma(st2, (f32x2){kk_b.x, kk_b.y}, pa); pa = pfma(st3, (f32x2){kk_b.z, kk_b.w}, pa);
                    float av = pa.x + pa.y, yv = pyp.x + pyp.y;
                    av += dpp<XOR1>(av); yv += dpp<XOR1>(yv); av += dpp<XOR2>(av); yv += dpp<XOR2>(yv); av += dpp<XOR7>(av); yv += dpp<XOR7>(yv);
                    if (u > 0) ykeep = (jq == u - 1) ? yv : ykeep;
                    else if (s8 > 0) { ykeep = (jq == 7) ? yv : ykeep; sO[(s8 - 8 + jq) * 64 + row] = ykeep; }
                    const float sa = -av;
                    const f32x2 sa2 = (f32x2){sa, sa}, vi2 = (f32x2){vi, vi};
                    st0 = pfma(st0, (f32x2){w_a.x, w_a.y}, pfma(vi2, (f32x2){k_a.x, k_a.y}, sa2 * (f32x2){b_a.x, b_a.y}));
                    st1 = pfma(st1, (f32x2){w_a.z, w_a.w}, pfma(vi2, (f32x2){k_a.z, k_a.w}, sa2 * (f32x2){b_a.z, b_a.w}));
                    st2 = pfma(st2, (f32x2){w_b.x, w_b.y}, pfma(vi2, (f32x2){k_b.x, k_b.y}, sa2 * (f32x2){b_b.x, b_b.y}));
                    st3 = pfma(st3, (f32x2){w_b.z, w_b.w}, pfma(vi2, (f32x2){k_b.z, k_b.w}, sa2 * (f32x2){b_b.z, b_b.w}));
                    pyp = st0 * (f32x2){r_a.x, r_a.y}; pyp = pfma(st1, (f32x2){r_a.z, r_a.w}, pyp); pyp = pfma(st2, (f32x2){r_b.x, r_b.y}, pyp); pyp = pfma(st3, (f32x2){r_b.z, r_b.w}, pyp);
                    w_a = sWa; w_b = sWb; kk_a = sKKa; kk_b = sKKb; b_a = sBa; b_b = sBb; k_a = sKa; k_b = sKb; r_a = sRa; r_b = sRb; vi = nvi;
                }
            }
            const float yv = red8(pyp.x + pyp.y);
            ykeep = (jq == 7) ? yv : ykeep; sO[(56 + jq) * 64 + row] = ykeep;
#undef RWF_LD
        }
        __syncthreads();
        {
            const size_t t = (size_t)b * SEQ + ch * 64 + tt;
            const f32x4 o0 = *(const LAS f32x4*)(sO + tt * 64 + 8 * cg), o1 = *(const LAS f32x4*)(sO + tt * 64 + 8 * cg + 4);
            const f32x4 v0 = *(const LAS f32x4*)(sV + tt * 64 + 8 * cg), v1 = *(const LAS f32x4*)(sV + tt * 64 + 8 * cg + 4);
            float o[8] = {o0.x, o0.y, o0.z, o0.w, o1.x, o1.y, o1.z, o1.w}; const float vv[8] = {v0.x, v0.y, v0.z, v0.w, v1.x, v1.y, v1.z, v1.w};
            float sm = 0.f;
#pragma unroll
            for (int j = 0; j < 8; ++j) sm += o[j];
            const float mean = red8(sm) * (1.0f / 64.0f);
            float q = 0.f;
#pragma unroll
            for (int j = 0; j < 8; ++j) { o[j] -= mean; q += o[j] * o[j]; }
            const float rstd = __builtin_amdgcn_rsqf(red8(q) * (1.0f / 64.0f) + 64e-5f);
            const float bon = sBon[tt];
            float y[8];
#pragma unroll
            for (int j = 0; j < 8; ++j) y[j] = (o[j] * rstd * lnw[j] + lnb[j] + bon * vv[j]) * gate[j];
            *(u32x4*)(Y + t * D + c0) = pack8(y);
        }
    }
#undef RWF_ISSUE
}

__device__ __forceinline__ void hgrn_full(ArgsRef a, int l, LAS unsigned char* lds, int job, int tid) {
    const bf16_t* P = (const bf16_t*)(a.ws + WS_PROJ); bf16_t* Y = (bf16_t*)(a.ws + WS_YC);
    LAS float* sQ = (LAS float*)lds; LAS float* sF = sQ + 4096; LAS float* sV = sF + 4096; LAS float* sO = sV + 4096;
    const int wave = tid >> 6, lane = tid & 63, tt = tid >> 3, cg = tid & 7;
    const float* lbp = (const float*)a.in[32];
    const int b = job >> 3, h = job & 7, c0 = 64 * h + 8 * cg;
    float lb[8], gn[8];
#pragma unroll
    for (int j = 0; j < 8; ++j) { lb[j] = (l == 0) ? 0.f : sigmoidf_(lbp[512 + c0 + j] - lbp[c0 + j]); gn[j] = ((const float*)a.in[33])[(size_t)l * 64 + 8 * cg + j]; }
    f32x2 st0 = (f32x2){0.f, 0.f}, st1 = st0, st2 = st0, st3 = st0;
    const int col = 8 * wave + (lane >> 3), dq = lane & 7;
    u32x4 gq, gf, gv, gg;
#define HGF_ISSUE(ch_) do { const size_t t_ = (size_t)b * SEQ + (ch_) * 64 + tt; gq = *(const u32x4*)(P + t_ * DIN + C_HG + c0); gf = *(const u32x4*)(P + t_ * DIN + C_HG + 512 + c0); \
        gv = *(const u32x4*)(P + t_ * DIN + C_HG + 1024 + c0); gg = *(const u32x4*)(P + t_ * DIN + C_HG + 1536 + c0); } while (0)
    HGF_ISSUE(0);
    for (int ch = 0; ch < SEQ / 64; ++ch) {
        __syncthreads();
        float gate[8];
        {
            float q[8], f[8], v[8];
            unpack8(gq, q); unpack8(gf, f); unpack8(gv, v); unpack8(gg, gate);
            if (ch + 1 < SEQ / 64) HGF_ISSUE(ch + 1);
#pragma unroll
            for (int j = 0; j < 8; ++j) { q[j] = siluf_(q[j]) * 0.125f; f[j] = lb[j] + (1.0f - lb[j]) * sigmoidf_(f[j]); }
            LAS float* d;
            d = sQ + tt * 64 + 8 * cg; *(LAS f32x4*)d = (f32x4){q[0], q[1], q[2], q[3]}; *(LAS f32x4*)(d + 4) = (f32x4){q[4], q[5], q[6], q[7]};
            d = sF + tt * 64 + 8 * cg; *(LAS f32x4*)d = (f32x4){f[0], f[1], f[2], f[3]}; *(LAS f32x4*)(d + 4) = (f32x4){f[4], f[5], f[6], f[7]};
            d = sV + tt * 64 + 8 * cg; *(LAS f32x4*)d = (f32x4){v[0], v[1], v[2], v[3]}; *(LAS f32x4*)(d + 4) = (f32x4){v[4], v[5], v[6], v[7]};
        }
        __syncthreads();
        {
            f32x4 f_a = *(const LAS f32x4*)(sF + 8 * dq), f_b = *(const LAS f32x4*)(sF + 8 * dq + 4), q_a = *(const LAS f32x4*)(sQ + 8 * dq), q_b = *(const LAS f32x4*)(sQ + 8 * dq + 4);
            float vi = sV[col];
            float ykeep = 0.f;
#pragma unroll 1
            for (int s8 = 0; s8 < 64; s8 += 8) {
#pragma unroll
                for (int u = 0; u < 8; ++u) {
                    const int sn = (s8 + u + 1) & 63;
                    const f32x4 nf_a = *(const LAS f32x4*)(sF + sn * 64 + 8 * dq), nf_b = *(const LAS f32x4*)(sF + sn * 64 + 8 * dq + 4),
                                nq_a = *(const LAS f32x4*)(sQ + sn * 64 + 8 * dq), nq_b = *(const LAS f32x4*)(sQ + sn * 64 + 8 * dq + 4);
                    const float nvi = sV[sn * 64 + col];
                    const f32x2 vi2 = (f32x2){vi, vi};
                    st0 = pfma((f32x2){f_a.x, f_a.y}, st0 - vi2, vi2); st1 = pfma((f32x2){f_a.z, f_a.w}, st1 - vi2, vi2);
                    st2 = pfma((f32x2){f_b.x, f_b.y}, st2 - vi2, vi2); st3 = pfma((f32x2){f_b.z, f_b.w}, st3 - vi2, vi2);
                    f32x2 py = st0 * (f32x2){q_a.x, q_a.y}; py = pfma(st1, (f32x2){q_a.z, q_a.w}, py); py = pfma(st2, (f32x2){q_b.x, q_b.y}, py); py = pfma(st3, (f32x2){q_b.z, q_b.w}, py);
                    const float y = red8(py.x + py.y);
                    ykeep = (dq == u) ? y : ykeep;
                    f_a = nf_a; f_b = nf_b; q_a = nq_a; q_b = nq_b; vi = nvi;
                }
                sO[(s8 + dq) * 64 + col] = ykeep;
            }
        }
        __syncthreads();
        {
            const size_t t = (size_t)b * SEQ + ch * 64 + tt;
            const f32x4 o0 = *(const LAS f32x4*)(sO + tt * 64 + 8 * cg), o1 = *(const LAS f32x4*)(sO + tt * 64 + 8 * cg + 4);
            const float o[8] = {o0.x, o0.y, o0.z, o0.w, o1.x, o1.y, o1.z, o1.w};
            float q = 0.f;
#pragma unroll
            for (int j = 0; j < 8; ++j) q += o[j] * o[j];
            const float rs = __builtin_amdgcn_rsqf(red8(q) * (1.0f / 64.0f) + 1e-6f);
            float y[8];
#pragma unroll
            for (int j = 0; j < 8; ++j) y[j] = o[j] * rs * gn[j] * siluf_(gate[j]);
            *(u32x4*)(Y + t * D + 1536 + c0) = pack8(y);
        }
    }
#undef HGF_ISSUE
}

__device__ __forceinline__ void attn_phase(ArgsRef a, int l, LAS unsigned char* lds) {
    const int TID = opaque_tid(), BID = opaque_bid();
    const bf16_t* P = (const bf16_t*)(a.ws + WS_PROJ); bf16_t* Y = (bf16_t*)(a.ws + WS_YC);
    const int* pos = (const int*)a.in[1];
    const float* qn = (const float*)a.in[19] + (size_t)l * 64; const float* kn = (const float*)a.in[20] + (size_t)l * 64; const float* sinks = (const float*)a.in[21] + (size_t)l * 8;
    constexpr int KST = 144, VST = 528;
    LAS unsigned char* sK = lds; LAS unsigned char* sVt = sK + 256 * KST; LAS unsigned char* sQ = sVt + 64 * VST; LAS float* sM = (LAS float*)(sQ + 512 * KST);
    const int tid = TID, cg = tid & 7, wave = tid >> 6, lane = tid & 63;
    float kmaxg = 0.f;
    for (int j = 0; j < 64; ++j) kmaxg = fmaxf(kmaxg, fabsf(kn[j]));
    const float kbound = 8.0f * kmaxg;
    float gk[8], gq[8], invf[8];
#pragma unroll
    for (int j = 0; j < 8; ++j) { gk[j] = kn[8 * cg + j]; gq[j] = qn[8 * cg + j]; invf[j] = exp2f(-(float)j * (18.931568569324174f / 8.0f)); }
    for (int job = BID; job < 512; job += gridDim.x) {
        const int b = job >> 5, nb = (job >> 1) & 15, kvh = job & 1;
        __syncthreads();
#pragma unroll 1
        for (int r = 0; r < 4; ++r) {
            const int kj = (tid >> 3) + 64 * r, s = (nb - 1) * 128 + kj;
            float k[8], v[8];
            if (s >= 0) {
                const size_t t = (size_t)b * SEQ + s;
                unpack8(*(const u32x4*)(P + t * DIN + C_ATT + 512 + 64 * kvh + 8 * cg), k); unpack8(*(const u32x4*)(P + t * DIN + C_ATT + 640 + 64 * kvh + 8 * cg), v);
            } else {
#pragma unroll
                for (int j = 0; j < 8; ++j) { k[j] = 0.f; v[j] = 0.f; } }
            float ss = 0.f;
#pragma unroll
            for (int j = 0; j < 8; ++j) ss += k[j] * k[j];
            ss = red8(ss);
            const float rs = __builtin_amdgcn_rsqf(ss * (1.0f / 64.0f) + 1e-6f);
#pragma unroll
            for (int j = 0; j < 8; ++j) k[j] = k[j] * rs * gk[j];
            const float pf = (float)pos[b * SEQ + (s >= 0 ? s : 0)];
#pragma unroll
            for (int j = 0; j < 8; ++j) {
                const float other = dpp<XOR1>(k[j]);
                if (cg < 2) { float sn, cs; sincos_big(pf * invf[j], sn, cs); k[j] = (cg == 0) ? (k[j] * cs - other * sn) : (k[j] * cs + other * sn); }
            }
            *(LAS u32x4*)(sK + kj * KST + 16 * cg) = pack8(k);
#pragma unroll
            for (int j = 0; j < 8; j += 2) { const unsigned w = pk2(v[j], v[j + 1]);
                *(LAS unsigned short*)(sVt + (8 * cg + j) * VST + 2 * kj) = (unsigned short)(w & 0xffffu); *(LAS unsigned short*)(sVt + (8 * cg + j + 1) * VST + 2 * kj) = (unsigned short)(w >> 16); }
        }
#pragma unroll 1
        for (int r = 0; r < 8; ++r) {
            const int row = (tid >> 3) + 64 * r, g = row >> 7, qi = row & 127, hq = 4 * kvh + g;
            const size_t tq = (size_t)b * SEQ + nb * 128 + qi;
            float q[8];
            unpack8(*(const u32x4*)(P + tq * DIN + C_ATT + 64 * hq + 8 * cg), q);
            float ss = 0.f;
#pragma unroll
            for (int j = 0; j < 8; ++j) ss += q[j] * q[j];
            ss = red8(ss);
            const float rs = 0.125f * __builtin_amdgcn_rsqf(ss * (1.0f / 64.0f) + 1e-6f);
#pragma unroll
            for (int j = 0; j < 8; ++j) q[j] = q[j] * rs * gq[j];
            const float pf = (float)pos[b * SEQ + nb * 128 + qi];
            float qq = 0.f;
#pragma unroll
            for (int j = 0; j < 8; ++j) {
                const float other = dpp<XOR1>(q[j]);
                if (cg < 2) { float sn, cs; sincos_big(pf * invf[j], sn, cs); q[j] = (cg == 0) ? (q[j] * cs - other * sn) : (q[j] * cs + other * sn); }
                qq += q[j] * q[j];
            }
            qq = red8(qq);
            if (cg == 0) sM[row] = sqrtf(qq) * kbound;
            *(LAS u32x4*)(sQ + row * KST + 16 * cg) = pack8(q);
        }
        __syncthreads();
        const int g = wave >> 1, qh = wave & 1, hq = 4 * kvh + g, fr = lane & 15, fq = lane >> 4;
        const float sinkv = sinks[hq];
#pragma unroll 1
        for (int qt = 0; qt < 4; ++qt) {
            const int qi0 = 64 * qh + 16 * qt, R0 = g * 128 + qi0, kt0 = qi0 >> 4;
            const bf16x8 qf0 = *(const LAS bf16x8*)(sQ + (R0 + fr) * KST + 16 * fq), qf1 = *(const LAS bf16x8*)(sQ + (R0 + fr) * KST + 16 * fq + 64);
            const float msh = sM[R0 + fr];
            const int ql = qi0 + fr;
            f32x4 oacc[4];
#pragma unroll
            for (int dt = 0; dt < 4; ++dt) oacc[dt] = (f32x4){0.f, 0.f, 0.f, 0.f};
            float lsum = 0.f;
#pragma unroll
            for (int ks = 0; ks < 5; ++ks) {
                unsigned pw[4];
#pragma unroll
                for (int h2 = 0; h2 < 2; ++h2) {
                    const int ti = 2 * ks + h2, kt = (kt0 + ti) < 15 ? (kt0 + ti) : 15;
                    const bf16x8 kf0 = *(const LAS bf16x8*)(sK + (16 * kt + fr) * KST + 16 * fq), kf1 = *(const LAS bf16x8*)(sK + (16 * kt + fr) * KST + 16 * fq + 64);
                    f32x4 sc = (f32x4){0.f, 0.f, 0.f, 0.f};
                    sc = __builtin_amdgcn_mfma_f32_16x16x32_bf16(kf0, qf0, sc, 0, 0, 0);
                    sc = __builtin_amdgcn_mfma_f32_16x16x32_bf16(kf1, qf1, sc, 0, 0, 0);
                    float p[4];
#pragma unroll
                    for (int j = 0; j < 4; ++j) { const int kj = 16 * (kt0 + ti) + 4 * fq + j;
                        const bool valid = (kj > ql) && (kj <= ql + 128) && (nb > 0 || kj >= 128);
                        p[j] = valid ? __expf(sc[j] - msh) : 0.f; lsum += p[j]; }
                    pw[2 * h2] = pk2(p[0], p[1]); pw[2 * h2 + 1] = pk2(p[2], p[3]);
                }
                const u32x4 pq = (u32x4){pw[0], pw[1], pw[2], pw[3]};
                const bf16x8 pf = __builtin_bit_cast(bf16x8, pq);
                const int kta = (kt0 + 2 * ks) < 15 ? (kt0 + 2 * ks) : 15, ktb = (kt0 + 2 * ks + 1) < 15 ? (kt0 + 2 * ks + 1) : 15;
#pragma unroll
                for (int dt = 0; dt < 4; ++dt) {
                    const u32x2 va = *(const LAS u32x2*)(sVt + (16 * dt + fr) * VST + (16 * kta + 4 * fq) * 2), vb = *(const LAS u32x2*)(sVt + (16 * dt + fr) * VST + (16 * ktb + 4 * fq) * 2);
                    const u32x4 vq = (u32x4){va.x, va.y, vb.x, vb.y};
                    oacc[dt] = __builtin_amdgcn_mfma_f32_16x16x32_bf16(__builtin_bit_cast(bf16x8, vq), pf, oacc[dt], 0, 0, 0);
                }
            }
            lsum += __shfl_xor(lsum, 16); lsum += __shfl_xor(lsum, 32);
            const float inv = __builtin_amdgcn_rcpf(lsum + __expf(sinkv - msh));
            const size_t tq = (size_t)b * SEQ + nb * 128 + ql;
#pragma unroll
            for (int dt = 0; dt < 4; ++dt) { u32x2 w; w.x = pk2(oacc[dt][0] * inv, oacc[dt][1] * inv); w.y = pk2(oacc[dt][2] * inv, oacc[dt][3] * inv);
                *(u32x2*)(Y + tq * D + 512 + 64 * hq + 16 * dt + 4 * fq) = w; }
        }
    }
    __syncthreads();
}

__device__ __forceinline__ float gelu_erf(float v) {
    const float t = __builtin_amdgcn_rcpf(fabsf(v) * 0.2316418882f + 1.0f);
    float q = t * 0.5307027145f + (-0.7265760135f); q = q * t + 0.7107068705f; q = q * t + (-0.142248368f); q = q * t + 0.127414796f; q = q * t;
    const float e = __builtin_amdgcn_exp2f(v * v * (-0.72134752044f));
    const float m = v * (q * e);
    return v < 0.f ? m : v - m;
}
__device__ __forceinline__ void s5_jobs(ArgsRef a, int l, LAS unsigned char* lds, unsigned* qctr) {
    const int TID = opaque_tid();
    LAS int* sJob = (LAS int*)(lds + 8 * 16 * 130 * 4 + 4096);
    const bf16_t* P = (const bf16_t*)(a.ws + WS_PROJ); bf16_t* Z = (bf16_t*)(a.ws + WS_Z);
    const int tid = TID, wave = tid >> 6, lane = tid & 63, fr16 = lane & 15, fq = lane >> 4;
    LAS float* sX = (LAS float*)lds + wave * (16 * 130);
    LAS float* sE = (LAS float*)lds + 8 * 16 * 130;
    for (;;) {
        if (TID == 0) *sJob = (int)__hip_atomic_fetch_add(qctr, 1u, __ATOMIC_RELAXED, __HIP_MEMORY_SCOPE_AGENT);
        __syncthreads();
        const int job = *sJob;
        if (job >= 512) break;
        const int b = job >> 5, g = job & 31;
        const float dt = expf(((const float*)a.in[24])[l * 32 + g]);
        float lbr, lbi;
        { const float lre = ((const float*)a.in[22])[(size_t)l * 2048 + g * 64 + lane], lim = ((const float*)a.in[23])[(size_t)l * 2048 + g * 64 + lane];
          float sn, cs; sincos_big(lim * dt, sn, cs); const float er = expf(lre * dt); lbr = er * cs; lbi = er * sn; }
        bf16x8 bfrag[8];
#pragma unroll
        for (int k = 0; k < 4; ++k) {
            const int p = fr16 + 16 * k;
            const float lre = ((const float*)a.in[22])[(size_t)l * 2048 + g * 64 + p], lim = ((const float*)a.in[23])[(size_t)l * 2048 + g * 64 + p];
            float sn, cs; sincos_big(lim * dt, sn, cs); const float er = expf(lre * dt), pbr = er * cs, pbi = er * sn;
            const float den = __builtin_amdgcn_rcpf(lre * lre + lim * lim);
            const float fr = ((pbr - 1.0f) * lre + pbi * lim) * den, fi = (pbi * lre - (pbr - 1.0f) * lim) * den;
            const float* brp = (const float*)a.in[25] + ((size_t)l * 2048 + g * 64 + p) * 16 + 8 * (fq & 1);
            const float* bip = (const float*)a.in[26] + ((size_t)l * 2048 + g * 64 + p) * 16 + 8 * (fq & 1);
            float vr[8], vi[8];
#pragma unroll
            for (int i = 0; i < 8; ++i) { const float br = brp[i], bi = bip[i]; float xr = fr * br - fi * bi, xi = fr * bi + fi * br;
                const unsigned hw = pk2(xr, xi);
                if (fq >= 2) { xr -= bflo(hw); xi -= bfhi(hw); }
                vr[i] = xr; vi[i] = xi; }
            bfrag[k] = __builtin_bit_cast(bf16x8, pack8(vr)); bfrag[4 + k] = __builtin_bit_cast(bf16x8, pack8(vi));
        }
        float creg[32];
        {
            const float* cre = (const float*)a.in[27] + ((size_t)l * 32 + g) * 1024 + fr16 * 64 + fq;
            const float* cim = (const float*)a.in[28] + ((size_t)l * 32 + g) * 1024 + fr16 * 64 + fq;
#pragma unroll
            for (int kk = 0; kk < 16; ++kk) { creg[kk] = cre[4 * kk]; creg[16 + kk] = -cim[4 * kk]; }
        }
        f32x4 dsk;
        { const float* dp = (const float*)a.in[29] + (size_t)l * 512 + 16 * g + 4 * fq; dsk = (f32x4){dp[0], dp[1], dp[2], dp[3]}; }
        const size_t tbase = (size_t)b * SEQ + wave * 256;
        const bf16_t* ua = P + (tbase + fr16) * DIN + C_S5 + 16 * g + 8 * (fq & 1);
        const bf16_t* ue = P + (tbase + fr16) * DIN + C_S5 + 16 * g + 4 * fq;
        f32x2 xs = (f32x2){0.f, 0.f}; const f32x2 lbr2 = (f32x2){lbr, lbr}, lbi2 = (f32x2){lbi, lbi};
        {
            u32x4 au = *(const u32x4*)ua;
#pragma unroll 1
            for (int gi = 0; gi < 16; ++gi) {
                const bf16x8 af = __builtin_bit_cast(bf16x8, au);
                if (gi + 1 < 16) au = *(const u32x4*)(ua + (size_t)(gi + 1) * 16 * DIN);
#pragma unroll
                for (int nt = 0; nt < 8; ++nt) { const f32x4 d = __builtin_amdgcn_mfma_f32_16x16x32_bf16(af, bfrag[nt], (f32x4){0.f, 0.f, 0.f, 0.f}, 0, 0, 0);
#pragma unroll
                    for (int j = 0; j < 4; ++j) sX[(4 * fq + j) * 130 + fr16 + 16 * nt] = d[j]; }
                LDS_FENCE();
#pragma unroll
                for (int s = 0; s < 16; ++s) { const f32x2 bu = (f32x2){sX[s * 130 + lane], sX[s * 130 + 64 + lane]};
                    const f32x2 nx = pfma(lbr2, xs, bu); xs = pfma(lbi2, (f32x2){-xs.y, xs.x}, nx); }
                LDS_FENCE();
            }
        }
        sE[wave * 128 + lane] = xs.x; sE[wave * 128 + 64 + lane] = xs.y;
        float pr = lbr, pi = lbi;
#pragma unroll
        for (int i = 0; i < 8; ++i) { const float nr = pr * pr - pi * pi, ni = 2.0f * pr * pi; pr = nr; pi = ni; }
        __syncthreads();
        xs = (f32x2){0.f, 0.f};
        for (int w = 0; w < wave; ++w) { const float er_ = sE[w * 128 + lane], ei_ = sE[w * 128 + 64 + lane];
            const float nr = pr * xs.x - pi * xs.y + er_, ni = pr * xs.y + pi * xs.x + ei_; xs.x = nr; xs.y = ni; }
        {
            u32x4 au = *(const u32x4*)ua; u32x2 eu = *(const u32x2*)ue;
#pragma unroll 1
            for (int gi = 0; gi < 16; ++gi) {
                const bf16x8 af = __builtin_bit_cast(bf16x8, au); const u32x2 eun = eu;
                if (gi + 1 < 16) { au = *(const u32x4*)(ua + (size_t)(gi + 1) * 16 * DIN); eu = *(const u32x2*)(ue + (size_t)(gi + 1) * 16 * DIN); }
#pragma unroll
                for (int nt = 0; nt < 8; ++nt) { const f32x4 d = __builtin_amdgcn_mfma_f32_16x16x32_bf16(af, bfrag[nt], (f32x4){0.f, 0.f, 0.f, 0.f}, 0, 0, 0);
#pragma unroll
                    for (int j = 0; j < 4; ++j) sX[(4 * fq + j) * 130 + fr16 + 16 * nt] = d[j]; }
                LDS_FENCE();
#pragma unroll
                for (int s = 0; s < 16; ++s) { const f32x2 bu = (f32x2){sX[s * 130 + lane], sX[s * 130 + 64 + lane]};
                    const f32x2 nx = pfma(lbr2, xs, bu); xs = pfma(lbi2, (f32x2){-xs.y, xs.x}, nx);
                    sX[s * 130 + lane] = xs.x; sX[s * 130 + 64 + lane] = xs.y; }
                LDS_FENCE();
                f32x4 yacc = (f32x4){0.f, 0.f, 0.f, 0.f}, yacc1 = yacc, yacc2 = yacc, yacc3 = yacc;
                const LAS float* xp = sX + fr16 * 130 + fq;
#pragma unroll
                for (int kk = 0; kk < 32; kk += 4) {
                    yacc = __builtin_amdgcn_mfma_f32_16x16x4f32(creg[kk], xp[4 * kk], yacc, 0, 0, 0);
                    yacc1 = __builtin_amdgcn_mfma_f32_16x16x4f32(creg[kk + 1], xp[4 * kk + 4], yacc1, 0, 0, 0);
                    yacc2 = __builtin_amdgcn_mfma_f32_16x16x4f32(creg[kk + 2], xp[4 * kk + 8], yacc2, 0, 0, 0);
                    yacc3 = __builtin_amdgcn_mfma_f32_16x16x4f32(creg[kk + 3], xp[4 * kk + 12], yacc3, 0, 0, 0);
                }
                yacc = (yacc + yacc1) + (yacc2 + yacc3);
                const float u0 = bflo(eun.x), u1 = bfhi(eun.x), u2 = bflo(eun.y), u3 = bfhi(eun.y);
                const float z0 = gelu_erf(yacc[0] + dsk[0] * u0), z1 = gelu_erf(yacc[1] + dsk[1] * u1), z2 = gelu_erf(yacc[2] + dsk[2] * u2), z3 = gelu_erf(yacc[3] + dsk[3] * u3);
                u32x2 w; w.x = pk2(z0, z1); w.y = pk2(z2, z3);
                *(u32x2*)(Z + (tbase + gi * 16 + fr16) * 512 + 16 * g + 4 * fq) = w;
                LDS_FENCE();
            }
        }
        __syncthreads();
    }
}

__device__ __forceinline__ void scan_phase(ArgsRef a, int l, LAS unsigned char* lds) {
    const int TID = opaque_tid(), BID = opaque_bid();
    if (gridDim.x == 256) {
        if (BID < 128) rwkv_full(a, l, lds, BID, TID); else hgrn_full(a, l, lds, BID - 128, TID);
    } else {
        for (int job = BID; job < 256; job += gridDim.x) { if (job < 128) rwkv_full(a, l, lds, job, TID); else hgrn_full(a, l, lds, job - 128, TID); __syncthreads(); }
    }
    __syncthreads();
    s5_jobs(a, l, lds, (unsigned*)(a.ws + WS_BAR) + 3584 + 64 * l);
    __syncthreads();
}

#define XB_TMO      128
#define XB_XCNT(j)  (256  + 64 * (j))
#define XB_XSUB(j)  (1280 + 64 * (j))
#define XB_XGEN(j)  (2304 + 64 * (j))
#define XB_TOP      3328
#define XB_TOPGEN   3392
#define XCD_BAR_WORDS 3456
#define XB_SPIN_CAP (1u << 18)

__device__ __forceinline__ unsigned xb_ld(unsigned* p)              { return __hip_atomic_load(p, __ATOMIC_RELAXED, __HIP_MEMORY_SCOPE_AGENT); }
__device__ __forceinline__ unsigned xb_add(unsigned* p, unsigned v) { return __hip_atomic_fetch_add(p, v, __ATOMIC_RELAXED, __HIP_MEMORY_SCOPE_AGENT); }
__device__ __forceinline__ unsigned xb_xcc_id() { return (unsigned)__builtin_amdgcn_s_getreg((3 << 11) | 20) & 0xFu; }
#define XB_SPIN(cond, bar) do { unsigned _sp = 0; while (cond) { __builtin_amdgcn_s_sleep(1); \
    if ((++_sp & 255u) == 0u) { if (xb_ld(&(bar)[XB_TMO])) break; if (_sp > XB_SPIN_CAP) { atomicAdd(&(bar)[XB_TMO], 1u); break; } } } } while (0)

struct XcdBarrier {
    unsigned* bar; unsigned x;
    volatile LAS unsigned* st;
};

__device__ __forceinline__ XcdBarrier xcd_barrier_post(unsigned* bar, volatile LAS unsigned* st) {
    XcdBarrier b; b.bar = bar; b.x = xb_xcc_id(); b.st = st;
    if (threadIdx.x == 0) (void)xb_add(&bar[XB_XCNT(b.x)], 1u);
    return b;
}
__device__ __forceinline__ void xcd_barrier_complete(unsigned* bar, unsigned x, unsigned& nloc, unsigned& nx) {
    const unsigned G = gridDim.x * gridDim.y * gridDim.z;
    unsigned sum, cnt, mine, sp = 0u;
    for (;;) {
        sum = 0u; cnt = 0u; mine = 0u;
#pragma unroll
        for (unsigned j = 0; j < 16; ++j) { const unsigned c = xb_ld(&bar[XB_XCNT(j)]); sum += c; cnt += (c > 0u) ? 1u : 0u; mine = (j == x) ? c : mine; }
        if (sum == G) break;
        __builtin_amdgcn_s_sleep(1);
        if ((++sp & 255u) == 0u) { if (xb_ld(&bar[XB_TMO])) break; if (sp > XB_SPIN_CAP) { atomicAdd(&bar[XB_TMO], 1u); break; } }
    }
    nloc = mine > 0u ? mine : 1u; nx = cnt > 0u ? cnt : 1u;
}

__device__ __forceinline__ void xcd_barrier(const XcdBarrier& b) {
    asm volatile("s_waitcnt vmcnt(0)" ::: "memory");
    __syncthreads();
    if (threadIdx.x == 0) {
        unsigned* bar = b.bar;
        __builtin_amdgcn_s_waitcnt(0);
        unsigned nloc = b.st[0], nx = b.st[1];
        if (nloc == 0u) { xcd_barrier_complete(bar, b.x, nloc, nx); b.st[0] = nloc; b.st[1] = nx; }
        const unsigned old = xb_add(&bar[XB_XSUB(b.x)], 1u);
        const unsigned gen = old / nloc;
        if (old + 1u == (gen + 1u) * nloc) {
            __builtin_amdgcn_fence(__ATOMIC_RELEASE, "agent");
            asm volatile("s_waitcnt vmcnt(0)" ::: "memory");
            const unsigned og = xb_add(&bar[XB_TOP], 1u);
            const unsigned tg = og / nx;
            if (og + 1u == (tg + 1u) * nx) xb_add(&bar[XB_TOPGEN], 1u);
            else XB_SPIN(xb_ld(&bar[XB_TOPGEN]) == tg, bar);
            __builtin_amdgcn_fence(__ATOMIC_ACQUIRE, "agent");
            xb_add(&bar[XB_XGEN(b.x)], 1u);
            asm volatile("s_waitcnt vmcnt(0)" ::: "memory");
        } else {
            XB_SPIN(xb_ld(&bar[XB_XGEN(b.x)]) == gen, bar);
            __builtin_amdgcn_fence(__ATOMIC_ACQUIRE, "agent");
            asm volatile("s_waitcnt vmcnt(0)" ::: "memory");
        }
    }
    __syncthreads();
}


constexpr int NPH = 11;
#ifndef DUPMASK
#define DUPMASK 0
#endif
__global__ void __launch_bounds__(NTHREADS, 2) mega(Args a_, int lo, int hi) {
    extern __shared__ __attribute__((aligned(16))) unsigned char lds_raw[];
    LAS unsigned char* lds = (LAS unsigned char*)lds_raw;
#ifdef EXTRA_SYNCS
    for (int i = 0; i < EXTRA_SYNCS; ++i) { __syncthreads(); cg::this_grid().sync(); }
#endif
    LAS unsigned* xst = (LAS unsigned*)(lds + LDS_BYTES - 16);
    if (hi - lo > 1) {
        if (threadIdx.x == 0) { xst[0] = 0u; xst[1] = 0u; }
        __syncthreads();
        if (blockIdx.x == 0) {
            const __attribute__((address_space(4))) Args* ap0 = (const __attribute__((address_space(4))) Args*)__builtin_amdgcn_kernarg_segment_ptr();
            unsigned* bw = (unsigned*)(ap0->ws + WS_BAR);
            for (int i = threadIdx.x; i < 4096; i += NTHREADS) bw[i] = 0u;
        }
    }
#pragma unroll 1
    for (int step2 = 2 * lo; step2 < 2 * hi; ++step2) {
        const int step = step2 >> 1;
        if ((step2 & 1) && !((DUPMASK >> (step % NPH)) & 1)) continue;
        const __attribute__((address_space(4))) Args* ap = (const __attribute__((address_space(4))) Args*)__builtin_amdgcn_kernarg_segment_ptr();
        asm volatile("" : "+s"(ap));
        ArgsRef a = *ap;
        unsigned char* ws = a.ws;
        float* SSa = (float*)(ws + WS_SS); float* SSb = SSa + T; float* SSc = SSb + T;
        const int l = step / NPH, ph = step % NPH;
        const float* xin = (l == 0) ? (const float*)a.in[0] : (const float*)a.out;
#ifndef PHMASK
#define PHMASK 0x7ff
#endif
        switch (ph) {
        case 0: if (PHMASK & (1 << 0)) { conv_phase(a, l, lds); if (l == 0) norm_phase(xin, (bf16_t*)(ws + WS_XN), SSa); zero_phase(SSb, T); } break;
        case 1: if (PHMASK & (1 << 1)) { pg8::EpiSwiGLU E; E.H = (bf16_t*)(ws + WS_HID); E.SS = SSa; run_gemm(lds, (const bf16_t*)(ws + WS_XN), (const bf16_t*)(ws + W_UP1), 2 * FF, D, E); } break;
        case 2: if (PHMASK & (1 << 2)) { pg8::EpiResidual<true> E; E.base = xin; E.out = a.out; E.XN = (bf16_t*)(ws + WS_XN); E.SS = SSb; run_gemm(lds, (const bf16_t*)(ws + WS_HID), (const bf16_t*)(ws + W_DN1), D, FF, E); } break;
        case 3: if (PHMASK & (1 << 3)) { pg8::EpiBf16 E; E.O = (bf16_t*)(ws + WS_PROJ); E.ldc = DIN; E.SS = SSb; run_gemm(lds, (const bf16_t*)(ws + WS_XN), (const bf16_t*)(ws + W_IN), DIN, D, E); } break;
        case 4: if (PHMASK & (1 << 4)) { zero_phase(SSa, T); zero_phase(SSc, T); alr_phase(a, l); attn_phase(a, l, lds); } break;
        case 5: if (PHMASK & (1 << 5)) { pg8::EpiLR E; E.O = (bf16_t*)(ws + WS_LRO); E.w0 = (const float*)a.in[9] + (size_t)l * 512; E.a0 = (const float*)a.in[11] + (size_t)l * 512;
                  run_gemm(lds, (const bf16_t*)(ws + WS_ALR), (const bf16_t*)(ws + W_LR), 1536, 256, E); } break;
        case 6: if (PHMASK & (1 << 6)) scan_phase(a, l, lds); break;
        case 7: if (PHMASK & (1 << 7)) { pg8::EpiGLU G; G.Z = (const bf16_t*)(ws + WS_Z); G.Y = (bf16_t*)(ws + WS_YC); G.b = (const float*)a.in[31] + (size_t)l * 512;
                  run_gemm(lds, (const bf16_t*)(ws + WS_Z), (const bf16_t*)(ws + W_GLU), 512, 512, G); } break;
        case 8: if (PHMASK & (1 << 8)) { pg8::EpiResidual<false> E; E.base = a.out; E.out = a.out; E.XN = (bf16_t*)(ws + WS_XN); E.SS = SSc; run_gemm(lds, (const bf16_t*)(ws + WS_YC), (const bf16_t*)(ws + W_OUT), D, D, E); } break;
        case 9: if (PHMASK & (1 << 9)) { pg8::EpiSwiGLU E; E.H = (bf16_t*)(ws + WS_HID); E.SS = SSc; run_gemm(lds, (const bf16_t*)(ws + WS_XN), (const bf16_t*)(ws + W_UP2), 2 * FF, D, E); } break;
        case 10: if (PHMASK & (1 << 10)) { pg8::EpiResidual<true> E; E.base = a.out; E.out = a.out; E.XN = (l + 1 < NL) ? (bf16_t*)(ws + WS_XN) : nullptr; E.SS = SSa; run_gemm(lds, (const bf16_t*)(ws + WS_HID), (const bf16_t*)(ws + W_DN2), D, FF, E); } break;
        }
        if ((step2 + 2 < 2 * hi) || (((step2 & 1) == 0) && ((DUPMASK >> ((step2 >> 1) % NPH)) & 1))) {
            if (step2 == 2 * lo) { __syncthreads(); cg::this_grid().sync(); (void)xcd_barrier_post((unsigned*)(ws + WS_BAR), (volatile LAS unsigned*)xst); }
            else { XcdBarrier xb; xb.bar = (unsigned*)(ws + WS_BAR); xb.x = xb_xcc_id(); xb.st = (volatile LAS unsigned*)xst; xcd_barrier(xb); }
        }
    }
}

extern "C" void kernel_launch(void* const* d_in, const int* in_sizes, int n_in, void* d_out, int out_size, void* d_ws, size_t ws_size, hipStream_t stream) {
    static int grid = 0;
    if (!grid) {
        int dev = 0, cus = 0, per_cu = 0;
        hipGetDevice(&dev);
        hipDeviceGetAttribute(&cus, hipDeviceAttributeMultiprocessorCount, dev);
        hipFuncSetAttribute((const void*)mega, hipFuncAttributeMaxDynamicSharedMemorySize, LDS_BYTES);
        hipOccupancyMaxActiveBlocksPerMultiprocessor(&per_cu, (const void*)mega, NTHREADS, LDS_BYTES);
        if (per_cu < 1) per_cu = 1;
        grid = cus * 1;
        if (grid != 256) fprintf(stderr, "kernel_launch: grid %d (cus %d, per_cu %d)\n", grid, cus, per_cu);
    }
    Args a{};
    for (int i = 0; i < 39; ++i) a.in[i] = d_in[i];
    a.out = (float*)d_out; a.ws = (unsigned char*)d_ws;
#if ONE_LAUNCH
    int lo = 0, hi = NL * NPH;
    void* args[] = {&a, &lo, &hi};
    hipError_t e = hipLaunchCooperativeKernel((void*)mega, dim3(grid), dim3(NTHREADS), args, LDS_BYTES, stream);
    if (e != hipSuccess) fprintf(stderr, "cooperative launch failed: %s (grid %d)\n", hipGetErrorString(e), grid);
#else
    for (int s = 0; s < NL * NPH; ++s) hipLaunchKernelGGL(mega, dim3(grid), dim3(NTHREADS), LDS_BYTES, stream, a, s, s + 1);
#endif
}
```

```cpp
#include <hip/hip_runtime.h>
#include <hip/hip_cooperative_groups.h>
#include <cstdio>
#include <cstdint>
namespace cg = cooperative_groups;

#ifndef ONE_LAUNCH
#define ONE_LAUNCH 1
#endif

#define LAS __attribute__((address_space(3)))
typedef unsigned short bf16_t;
typedef short bf16x8 __attribute__((ext_vector_type(8)));
typedef float f32x4 __attribute__((ext_vector_type(4)));
typedef float f32x2 __attribute__((ext_vector_type(2)));
typedef unsigned u32x4 __attribute__((ext_vector_type(4)));
typedef unsigned u32x2 __attribute__((ext_vector_type(2)));

constexpr int T = 32768, SEQ = 2048, NB = 16, D = 2048, FF = 5632, DIN = 5120, NL = 2;
constexpr int C_RWKV = 0, C_ATT = 1792, C_S5 = 2560, C_HG = 3072;
constexpr int NTHREADS = 512, NWAVES = 8;

constexpr size_t SZ_UP = (size_t)2 * FF * D * 2, SZ_DN = (size_t)D * FF * 2, SZ_IN = (size_t)DIN * D * 2, SZ_LR = (size_t)1536 * 256 * 2,
                 SZ_GLU = (size_t)512 * 512 * 2, SZ_OUT = (size_t)D * D * 2;
constexpr size_t W_UP1 = 0, W_DN1 = W_UP1 + SZ_UP, W_IN = W_DN1 + SZ_DN, W_LR = W_IN + SZ_IN, W_GLU = W_LR + SZ_LR, W_OUT = W_GLU + SZ_GLU,
                 W_UP2 = W_OUT + SZ_OUT, W_DN2 = W_UP2 + SZ_UP, W_END = W_DN2 + SZ_DN;
constexpr size_t WS_XN = W_END, WS_BIG = WS_XN + (size_t)T * D * 2;
constexpr size_t WS_HID = WS_BIG;
constexpr size_t WS_PROJ = WS_BIG, WS_LRO = WS_PROJ + (size_t)T * DIN * 2, WS_ALR = WS_LRO + (size_t)T * 1536 * 2, WS_Z = WS_ALR + (size_t)T * 256 * 2,
                 WS_OR = WS_Z + (size_t)T * 512 * 2, WS_OH = WS_OR + (size_t)T * 512 * 4, WS_BON = WS_OH + (size_t)T * 512 * 4, WS_YC = WS_BON + (size_t)T * 8 * 4, WS_SS = WS_YC + (size_t)T * D * 2, WS_BAR = WS_SS + (size_t)3 * T * 4, WS_END = WS_BAR + 16384;
static_assert(WS_END <= (size_t)1 << 30, "workspace");
static_assert(WS_HID + (size_t)T * FF * 2 <= (size_t)1 << 30, "workspace");

constexpr int LDS_BYTES = 147456;

struct Args { const void* in[39]; float* out; unsigned char* ws; };
typedef const __attribute__((address_space(4))) Args& ArgsRef;

typedef __bf16 bf16x2_t __attribute__((ext_vector_type(2)));
__device__ __forceinline__ unsigned pk2(float lo, float hi) { const f32x2 v = (f32x2){lo, hi}; return __builtin_bit_cast(unsigned, __builtin_convertvector(v, bf16x2_t)); }
__device__ __forceinline__ float bflo(unsigned w) { return __uint_as_float(w << 16); }
__device__ __forceinline__ float bfhi(unsigned w) { return __uint_as_float(w & 0xffff0000u); }
__device__ __forceinline__ void unpack8(u32x4 q, float* f) { f[0] = bflo(q.x); f[1] = bfhi(q.x); f[2] = bflo(q.y); f[3] = bfhi(q.y); f[4] = bflo(q.z); f[5] = bfhi(q.z); f[6] = bflo(q.w); f[7] = bfhi(q.w); }
__device__ __forceinline__ u32x4 pack8(const float* f) { u32x4 o; o.x = pk2(f[0], f[1]); o.y = pk2(f[2], f[3]); o.z = pk2(f[4], f[5]); o.w = pk2(f[6], f[7]); return o; }
template <int CTRL> __device__ __forceinline__ float dpp(float x) { return __builtin_bit_cast(float, __builtin_amdgcn_mov_dpp(__builtin_bit_cast(int, x), CTRL, 0xf, 0xf, true)); }
constexpr int XOR1 = 0xB1, XOR2 = 0x4E, XOR7 = 0x141, XOR8 = 0x128;
__device__ __forceinline__ float red8(float v) { v += dpp<XOR1>(v); v += dpp<XOR2>(v); v += dpp<XOR7>(v); return v; }
__device__ __forceinline__ float red16(float v) { v = red8(v); v += dpp<XOR8>(v); return v; }
__device__ __forceinline__ float wave_sum(float v) {
#pragma unroll
    for (int o = 1; o < 64; o <<= 1) v += __shfl_xor(v, o);
    return v;
}
__device__ __forceinline__ float sigmoidf_(float x) { return __builtin_amdgcn_rcpf(1.0f + __expf(-x)); }
__device__ __forceinline__ float siluf_(float x) { return x * __builtin_amdgcn_rcpf(1.0f + __expf(-x)); }
__device__ __forceinline__ int opaque_tid() { int t = threadIdx.x; asm volatile("" : "+v"(t)); return t; }
__device__ __forceinline__ int opaque_bid() { int t = blockIdx.x; asm volatile("" : "+s"(t)); return t; }
__device__ __forceinline__ f32x2 pfma(f32x2 a, f32x2 b, f32x2 c) { return __builtin_elementwise_fma(a, b, c); }
#define LDS_FENCE() asm volatile("s_waitcnt lgkmcnt(0)" ::: "memory")
__device__ __forceinline__ void sincos_big(float x, float& sn, float& cs) {
    const float n = rintf(x * 0.15915494309189535f);
    float r = fmaf(-n, 6.28318548202514648f, x); r = fmaf(-n, -1.7484555e-7f, r);
    sn = __sinf(r); cs = __cosf(r);
}

namespace pg8 {
constexpr int BM = 256, BK = 64, HALF = 128, HTB = HALF * BK * 2, STAGE_BYTES = 8 * HTB, NXCD = 8, WGM = 8;
__host__ __device__ __forceinline__ int lds_byte(int r, int c) { const int st = (r >> 4) * 2 + (c >> 5), rr = r & 15, cc = c & 31, ob = rr * 64 + cc * 2; return st * 1024 + (ob ^ (((ob >> 9) & 1) << 5)); }
__host__ __device__ __forceinline__ void stage_rc(int b, int& R, int& C) { const int st = b / 1024, sb = b % 1024, swz = sb ^ (((sb >> 9) & 1) << 5); R = (st >> 1) * 16 + swz / 64; C = (st & 1) * 32 + (swz % 64) / 2; }
__host__ __device__ __forceinline__ int perm32(int rho) { const int n = rho >> 4, i = rho & 15; return 8 * (i >> 2) + 4 * n + (i & 3); }
struct Unit { int pm, pn; };
struct Gemm { const bf16_t* A; const bf16_t* Bt; int M, N, K; };
struct StaticOrder {
    int nM, nN, nwg, G, c;
    __device__ void init(int M, int N, int G_, int c_) { nM = M / BM; nN = N / BM; nwg = nM * nN; G = G_; c = c_; }
    __device__ bool next(int i, Unit& u) const {
        const long L = (long)i * G + c; if (L >= nwg) return false;
        int wgid = (int)L; { const int q = nwg / NXCD, r = nwg % NXCD, xcd = wgid % NXCD, off = wgid / NXCD; wgid = (xcd < r ? xcd * (q + 1) : r * (q + 1) + (xcd - r) * q) + off; }
        const int nig = WGM * nN, gid = wgid / nig, fm = gid * WGM, gsz = (nM - fm) < WGM ? (nM - fm) : WGM;
        u.pm = fm + ((wgid % nig) % gsz); u.pn = (wgid % nig) / gsz; return true;
    }
};
#ifndef GEMM_SP2
#define GEMM_SP2 true
#endif
#ifndef GEMM_ALIGN
#define GEMM_ALIGN true
#endif
template <class Epi, bool ALIGN_EPI = GEMM_ALIGN, bool SP2 = GEMM_SP2>
__device__ __forceinline__ void gemm_phase(LAS unsigned char* lds, const Gemm g, const StaticOrder S, const Epi E) {
    const int TID = opaque_tid(), BID = opaque_bid(); (void)TID; (void)BID;
    const int tid = TID, wid = __builtin_amdgcn_readfirstlane(tid >> 6), lane = tid & 63, wr = wid >> 2, wc = wid & 3, fr = lane & 15, fq = lane >> 4;
    const int K = g.K, nt = K / BK;
    unsigned voffA[2], voffB[2];
#pragma unroll
    for (int i = 0; i < 2; ++i) { int R, C; stage_rc(tid * 16 + i * 8192, R, C); const int Rb = Epi::PERM ? ((R & ~31) + perm32(R & 31)) : R;
        voffA[i] = (unsigned)(R * K + C) * 2u; voffB[i] = (unsigned)(Rb * K + C) * 2u; }
    const size_t kstep = (size_t)(BK * 2);
    const size_t hstep = (size_t)HALF * K * 2;
    const size_t tstep = 2 * hstep;
    const unsigned ldsw = (unsigned)wid * 1024u;
    const int aoff = lds_byte(wr * 64 + fr, fq * 8), boff = lds_byte(wc * 32 + fr, fq * 8);
#define PG8_SA(b, h) (((b) * 2 + (h)) * HTB)
#define PG8_SB(b, h) ((4 + (b) * 2 + (h)) * HTB)
#define PG8_STAGE(bufoff, gbase, voff) do { _Pragma("unroll") for (int _i = 0; _i < 2; ++_i) \
        __builtin_amdgcn_global_load_lds((const unsigned*)((const char*)(gbase) + (voff)[_i]), (LAS unsigned*)(lds + (bufoff) + ldsw + _i * 8192), 16, 0, 0); } while (0)
#define PG8_LDA(dst, b, h) do { _Pragma("unroll") for (int m = 0; m < 4; ++m) _Pragma("unroll") for (int k = 0; k < 2; ++k) dst[m][k] = *(const LAS bf16x8*)(lds + PG8_SA(b, h) + aoff + m * 2048 + k * 1024); } while (0)
#define PG8_LDB(dst, b, h) do { _Pragma("unroll") for (int n = 0; n < 2; ++n) _Pragma("unroll") for (int k = 0; k < 2; ++k) dst[n][k] = *(const LAS bf16x8*)(lds + PG8_SB(b, h) + boff + n * 2048 + k * 1024); } while (0)
#define PG8_MMA(ai, bj, At, Bt) do { __builtin_amdgcn_s_setprio(1); _Pragma("unroll") for (int m = 0; m < 4; ++m) _Pragma("unroll") for (int n = 0; n < 2; ++n) _Pragma("unroll") for (int k = 0; k < 2; ++k) \
        acc[ai][bj][m][n] = __builtin_amdgcn_mfma_f32_16x16x32_bf16(Bt[n][k], At[m][k], acc[ai][bj][m][n], 0, 0, 0); __builtin_amdgcn_s_setprio(0); } while (0)
#define PG8_WAIT_V(n) asm volatile("s_waitcnt vmcnt(" #n ")" ::: "memory")
#define PG8_WAIT_L(n) asm volatile("s_waitcnt lgkmcnt(" #n ")" ::: "memory")
#define PG8_BAR __builtin_amdgcn_s_barrier()
#define PG8_SCHED __builtin_amdgcn_sched_barrier(0)
    Unit cur, nxt; int ui = 0;
    if (!S.next(0, cur)) return;
    f32x4 acc[2][2][4][2];
#pragma unroll
    for (int a = 0; a < 2; ++a)
#pragma unroll
        for (int b = 0; b < 2; ++b)
#pragma unroll
            for (int m = 0; m < 4; ++m)
#pragma unroll
                for (int n = 0; n < 2; ++n) acc[a][b][m][n] = (f32x4){0.f, 0.f, 0.f, 0.f};
    bf16x8 At[4][2], B0[2][2], B1[2][2];
    const char* cA = (const char*)g.A + (size_t)cur.pm * tstep; const char* cB = (const char*)g.Bt + (size_t)cur.pn * tstep;
    if constexpr (SP2) {
        PG8_STAGE(PG8_SB(0, 0), cB, voffB); PG8_STAGE(PG8_SB(0, 1), cB + hstep, voffB); PG8_STAGE(PG8_SA(0, 0), cA, voffA); PG8_STAGE(PG8_SA(0, 1), cA + hstep, voffA);
        if (wr == 1) PG8_BAR;
        PG8_WAIT_V(2); PG8_BAR;
        PG8_STAGE(PG8_SB(1, 0), cB + kstep, voffB); PG8_STAGE(PG8_SA(1, 0), cA + kstep, voffA); PG8_STAGE(PG8_SB(1, 1), cB + hstep + kstep, voffB);
        PG8_WAIT_V(6); PG8_BAR;
    } else {
        PG8_STAGE(PG8_SB(0, 0), cB, voffB); PG8_STAGE(PG8_SA(0, 0), cA, voffA); PG8_STAGE(PG8_SB(0, 1), cB + hstep, voffB); PG8_STAGE(PG8_SA(0, 1), cA + hstep, voffA);
        if (wr == 1) PG8_BAR;
        PG8_WAIT_V(4); PG8_BAR;
        PG8_STAGE(PG8_SB(1, 0), cB + kstep, voffB); PG8_STAGE(PG8_SA(1, 0), cA + kstep, voffA); PG8_STAGE(PG8_SB(1, 1), cB + hstep + kstep, voffB);
        PG8_WAIT_V(6); PG8_BAR;
    }
    for (;;) {
        const bool has_next = S.next(ui + 1, nxt);
        const char* nA = has_next ? (const char*)g.A + (size_t)nxt.pm * tstep : cA; const char* nB = has_next ? (const char*)g.Bt + (size_t)nxt.pn * tstep : cB;
#pragma unroll 1
        for (int t = 0; t < nt; t += 2) {
            const bool last = (t == nt - 2);
            const char* a1 = cA + (size_t)(t + 1) * kstep;
            const char* a2 = last ? nA : cA + (size_t)(t + 2) * kstep; const char* b2 = last ? nB : cB + (size_t)(t + 2) * kstep;
            const char* a3 = a2 + kstep; const char* b3 = b2 + kstep;
            if constexpr (SP2) {
            PG8_LDB(B0, 0, 0); PG8_LDB(B1, 0, 1); PG8_SCHED; PG8_LDA(At, 0, 0); PG8_STAGE(PG8_SA(1, 1), a1 + hstep, voffA);
            PG8_WAIT_V(8); PG8_WAIT_L(0); PG8_BAR; PG8_MMA(0, 0, At, B0); PG8_MMA(0, 1, At, B1); PG8_BAR; PG8_SCHED;
            PG8_LDA(At, 0, 1); PG8_STAGE(PG8_SB(0, 0), b2, voffB); PG8_STAGE(PG8_SB(0, 1), b2 + hstep, voffB); PG8_STAGE(PG8_SA(0, 0), a2, voffA);
            PG8_WAIT_V(8); PG8_WAIT_L(0); PG8_BAR; PG8_MMA(1, 0, At, B0); PG8_MMA(1, 1, At, B1); PG8_BAR; PG8_SCHED;
            PG8_LDB(B0, 1, 0); PG8_LDB(B1, 1, 1); PG8_SCHED; PG8_LDA(At, 1, 0); PG8_STAGE(PG8_SA(0, 1), a2 + hstep, voffA);
            PG8_WAIT_V(8); PG8_WAIT_L(0); PG8_BAR; PG8_MMA(0, 0, At, B0); PG8_MMA(0, 1, At, B1); PG8_BAR; PG8_SCHED;
            PG8_LDA(At, 1, 1); PG8_STAGE(PG8_SB(1, 0), b3, voffB); PG8_STAGE(PG8_SB(1, 1), b3 + hstep, voffB); PG8_STAGE(PG8_SA(1, 0), a3, voffA);
            PG8_WAIT_V(8); PG8_WAIT_L(0); PG8_BAR; PG8_MMA(1, 0, At, B0); PG8_MMA(1, 1, At, B1); PG8_BAR; PG8_SCHED;
            } else {
            PG8_LDB(B0, 0, 0); PG8_SCHED; PG8_LDA(At, 0, 0); PG8_STAGE(PG8_SA(1, 1), a1 + hstep, voffA);
            PG8_WAIT_L(8); PG8_BAR; PG8_WAIT_L(0); PG8_MMA(0, 0, At, B0); PG8_BAR; PG8_SCHED;
            PG8_LDB(B1, 0, 1); PG8_STAGE(PG8_SB(0, 0), b2, voffB);
            PG8_BAR; PG8_WAIT_L(0); PG8_MMA(0, 1, At, B1); PG8_BAR;
            PG8_LDA(At, 0, 1); PG8_STAGE(PG8_SA(0, 0), a2, voffA);
            PG8_BAR; PG8_WAIT_L(0); PG8_MMA(1, 0, At, B0); PG8_BAR; PG8_SCHED;
            PG8_STAGE(PG8_SB(0, 1), b2 + hstep, voffB);
            PG8_WAIT_V(6); PG8_BAR; PG8_MMA(1, 1, At, B1); PG8_BAR;
            PG8_LDB(B0, 1, 0); PG8_SCHED; PG8_LDA(At, 1, 0); PG8_STAGE(PG8_SA(0, 1), a2 + hstep, voffA);
            PG8_WAIT_L(8); PG8_BAR; PG8_WAIT_L(0); PG8_MMA(0, 0, At, B0); PG8_BAR; PG8_SCHED;
            PG8_LDB(B1, 1, 1); PG8_STAGE(PG8_SB(1, 0), b3, voffB);
            PG8_BAR; PG8_WAIT_L(0); PG8_MMA(0, 1, At, B1); PG8_BAR;
            PG8_LDA(At, 1, 1); PG8_STAGE(PG8_SA(1, 0), a3, voffA);
            PG8_BAR; PG8_WAIT_L(0); PG8_MMA(1, 0, At, B0); PG8_BAR; PG8_SCHED;
            PG8_STAGE(PG8_SB(1, 1), b3 + hstep, voffB);
            PG8_WAIT_V(6); PG8_BAR; PG8_MMA(1, 1, At, B1); PG8_BAR;
            }
        }
        if constexpr (ALIGN_EPI) { if (wr == 0) PG8_BAR; }
        E(acc, cur, wr, wc, fr, fq);
        if (!has_next) break;
#pragma unroll
        for (int a = 0; a < 2; ++a)
#pragma unroll
            for (int b = 0; b < 2; ++b)
#pragma unroll
                for (int m = 0; m < 4; ++m)
#pragma unroll
                    for (int n = 0; n < 2; ++n) acc[a][b][m][n] = (f32x4){0.f, 0.f, 0.f, 0.f};
        cur = nxt; cA = nA; cB = nB; ++ui;
        if constexpr (ALIGN_EPI) { if (wr == 1) PG8_BAR; }
    }
    PG8_WAIT_V(0);
    if constexpr (!ALIGN_EPI) { if (wr == 0) PG8_BAR; }
    PG8_BAR;
#undef PG8_SA
#undef PG8_SB
#undef PG8_STAGE
#undef PG8_LDA
#undef PG8_LDB
#undef PG8_MMA
#undef PG8_WAIT_V
#undef PG8_WAIT_L
#undef PG8_BAR
#undef PG8_SCHED
}

struct EpiSwiGLU {
    static constexpr bool PERM = true;
    bf16_t* H; const float* SS;
    __device__ __forceinline__ void operator()(const f32x4 (&acc)[2][2][4][2], const Unit& u, int wr, int wc, int fr, int fq) const {
        const int row0 = u.pm * BM + wr * 64 + fr, col0 = u.pn * 128 + wc * 32 + 8 * fq;
        float rsv[2][4];
#pragma unroll
        for (int ai = 0; ai < 2; ++ai)
#pragma unroll
            for (int m = 0; m < 4; ++m) rsv[ai][m] = SS[row0 + ai * HALF + m * 16];
#pragma unroll
        for (int ai = 0; ai < 2; ++ai)
#pragma unroll
            for (int m = 0; m < 4; ++m) {
                const float rs = __builtin_amdgcn_rsqf(rsv[ai][m] * (1.0f / D) + 1e-6f);
                const f32x2 rs2 = (f32x2){rs * rs, rs * rs}, ce = (f32x2){-1.44269504089f * rs, -1.44269504089f * rs}, one2 = (f32x2){1.0f, 1.0f};
                float v[8];
#pragma unroll
                for (int n = 0; n < 2; ++n)
#pragma unroll
                    for (int j = 0; j < 4; j += 2) {
                        const f32x2 g2 = (f32x2){acc[ai][0][m][n][j], acc[ai][0][m][n][j + 1]}, u2 = (f32x2){acc[ai][1][m][n][j], acc[ai][1][m][n][j + 1]};
                        const f32x2 t = (g2 * u2) * rs2, x = g2 * ce;
                        const f32x2 d = (f32x2){__builtin_amdgcn_exp2f(x.x), __builtin_amdgcn_exp2f(x.y)} + one2;
                        const f32x2 r = t * (f32x2){__builtin_amdgcn_rcpf(d.x), __builtin_amdgcn_rcpf(d.y)};
                        v[4 * n + j] = r.x; v[4 * n + j + 1] = r.y; }
                *(u32x4*)(H + (size_t)(row0 + ai * HALF + m * 16) * FF + col0) = pack8(v);
            }
    }
};
template <bool HALFSTEP> struct EpiResidual {
    static constexpr bool PERM = false;
    static constexpr float scale = HALFSTEP ? 0.5f : 1.0f;
    const float* base; float* out; bf16_t* XN; float* SS;
    __device__ __forceinline__ void operator()(const f32x4 (&acc)[2][2][4][2], const Unit& u, int wr, int wc, int fr, int fq) const {
        const int row0 = u.pm * BM + wr * 64 + fr, col0 = u.pn * BM + wc * 32 + 4 * fq;
#pragma unroll
        for (int ai = 0; ai < 2; ++ai) {
            f32x4 bv[4][2][2];
#pragma unroll
            for (int m = 0; m < 4; ++m)
#pragma unroll
                for (int bj = 0; bj < 2; ++bj)
#pragma unroll
                    for (int n = 0; n < 2; ++n) bv[m][bj][n] = *(const f32x4*)(base + (size_t)(row0 + ai * HALF + m * 16) * D + col0 + bj * HALF + n * 16);
#pragma unroll
            for (int m = 0; m < 4; ++m) { const int row = row0 + ai * HALF + m * 16; const size_t ro = (size_t)row * D + col0; float ss = 0.f;
#pragma unroll
                for (int bj = 0; bj < 2; ++bj)
#pragma unroll
                    for (int n = 0; n < 2; ++n) { const f32x4 r = bv[m][bj][n] + acc[ai][bj][m][n] * scale; *(f32x4*)(out + ro + bj * HALF + n * 16) = r;
                        if (XN) { u32x2 w; w.x = pk2(r.x, r.y); w.y = pk2(r.z, r.w); *(u32x2*)(XN + ro + bj * HALF + n * 16) = w; ss += (r.x * r.x + r.y * r.y) + (r.z * r.z + r.w * r.w); } }
                if (XN) { ss += __shfl_xor(ss, 16); ss += __shfl_xor(ss, 32); if (fq == 0) atomicAdd(SS + row, ss); } }
        }
    }
};
struct EpiBf16 {
    static constexpr bool PERM = true;
    bf16_t* O; int ldc; const float* SS;
    __device__ __forceinline__ void operator()(const f32x4 (&acc)[2][2][4][2], const Unit& u, int wr, int wc, int fr, int fq) const {
        const int row0 = u.pm * BM + wr * 64 + fr, col0 = u.pn * BM + wc * 32 + 8 * fq;
        float rsv[2][4];
#pragma unroll
        for (int ai = 0; ai < 2; ++ai)
#pragma unroll
            for (int m = 0; m < 4; ++m) rsv[ai][m] = SS[row0 + ai * HALF + m * 16];
#pragma unroll
        for (int ai = 0; ai < 2; ++ai)
#pragma unroll
            for (int m = 0; m < 4; ++m) { bf16_t* rowp = O + (size_t)(row0 + ai * HALF + m * 16) * ldc + col0;
                const float rs = __builtin_amdgcn_rsqf(rsv[ai][m] * (1.0f / D) + 1e-6f);
#pragma unroll
                for (int bj = 0; bj < 2; ++bj) { const f32x4 v0 = acc[ai][bj][m][0] * rs, v1 = acc[ai][bj][m][1] * rs;
                    u32x4 w; w.x = pk2(v0[0], v0[1]); w.y = pk2(v0[2], v0[3]); w.z = pk2(v1[0], v1[1]); w.w = pk2(v1[2], v1[3]);
                    *(u32x4*)(rowp + bj * HALF) = w; } }
    }
};
struct EpiLR {
    static constexpr bool PERM = true;
    bf16_t* O; const float* w0; const float* a0;
    template <int KIND> __device__ __forceinline__ void body(const f32x4 (&acc)[2][2][4][2], const float* bp, int row0, int col0) const {
#pragma unroll
        for (int bj = 0; bj < 2; ++bj) {
            f32x4 b0 = (f32x4){0.f, 0.f, 0.f, 0.f}, b1 = b0;
            if (KIND < 2) { b0 = *(const f32x4*)(bp + bj * HALF); b1 = *(const f32x4*)(bp + bj * HALF + 4); }
#pragma unroll
            for (int ai = 0; ai < 2; ++ai)
#pragma unroll
                for (int m = 0; m < 4; ++m) {
                    u32x4 w;
#pragma unroll
                    for (int n = 0; n < 2; ++n) {
                        float r[4];
#pragma unroll
                        for (int j = 0; j < 4; ++j) { const float x = acc[ai][bj][m][n][j] + (n == 0 ? b0[j] : b1[j]);
                            if (KIND == 0) { const float e = __expf(-x); r[j] = -0.60653065971f * __builtin_amdgcn_rcpf(1.0f + e); }
                            else if (KIND == 1) r[j] = __builtin_amdgcn_rcpf(1.0f + __expf(-x)); else r[j] = x; }
                        if (n == 0) { w.x = pk2(r[0], r[1]); w.y = pk2(r[2], r[3]); } else { w.z = pk2(r[0], r[1]); w.w = pk2(r[2], r[3]); }
                    }
                    *(u32x4*)(O + (size_t)(row0 + ai * HALF + m * 16) * 1536 + col0 + bj * HALF) = w;
                }
        }
    }
    __device__ __forceinline__ void operator()(const f32x4 (&acc)[2][2][4][2], const Unit& u, int wr, int wc, int fr, int fq) const {
        const int row0 = u.pm * BM + wr * 64 + fr, col0 = u.pn * BM + wc * 32 + 8 * fq, kind = u.pn >> 1, f0 = col0 - 512 * kind;
        if (kind == 0) body<0>(acc, w0 + f0, row0, col0); else if (kind == 1) body<1>(acc, a0 + f0, row0, col0); else body<2>(acc, nullptr, row0, col0);
    }
};
struct EpiGLU {
    static constexpr bool PERM = true;
    const bf16_t* Z; bf16_t* Y; const float* b;
    __device__ __forceinline__ void operator()(const f32x4 (&acc)[2][2][4][2], const Unit& u, int wr, int wc, int fr, int fq) const {
        const int row0 = u.pm * BM + wr * 64 + fr, col0 = u.pn * BM + wc * 32 + 8 * fq;
#pragma unroll
        for (int bj = 0; bj < 2; ++bj) {
            const f32x4 bias0 = *(const f32x4*)(b + col0 + bj * HALF), bias1 = *(const f32x4*)(b + col0 + bj * HALF + 4);
            u32x4 zr[2][4];
#pragma unroll
            for (int ai = 0; ai < 2; ++ai)
#pragma unroll
                for (int m = 0; m < 4; ++m) zr[ai][m] = *(const u32x4*)(Z + (size_t)(row0 + ai * HALF + m * 16) * 512 + col0 + bj * HALF);
#pragma unroll
            for (int ai = 0; ai < 2; ++ai)
#pragma unroll
                for (int m = 0; m < 4; ++m) { const size_t r = (size_t)(row0 + ai * HALF + m * 16);
                    float z[8], v[8]; unpack8(zr[ai][m], z);
#pragma unroll
                    for (int n = 0; n < 2; ++n)
#pragma unroll
                        for (int j = 0; j < 4; ++j) v[4 * n + j] = z[4 * n + j] * sigmoidf_(acc[ai][bj][m][n][j] + (n == 0 ? bias0[j] : bias1[j]));
                    *(u32x4*)(Y + r * D + 1024 + col0 + bj * HALF) = pack8(v); }
        }
    }
};
}

template <class Epi> __device__ __forceinline__ void run_gemm(LAS unsigned char* lds, const bf16_t* A, const bf16_t* Bt, int N, int K, const Epi E) {
    pg8::Gemm g; g.A = A; g.Bt = Bt; g.M = T; g.N = N; g.K = K;
    pg8::StaticOrder S; S.init(T, N, gridDim.x, opaque_bid());
    pg8::gemm_phase<Epi>(lds, g, S, E);
}

struct TrItem { const float* W; int ldw, k0, n0; const float* gs; bf16_t* Dst; int ldd, drow0, dk0; };
__device__ __forceinline__ void tr_load(const TrItem& it, f32x4 (&v)[8], int lane) {
    if (it.W) {
#pragma unroll
        for (int i = 0; i < 8; ++i) { const int kk = 8 * i + (lane >> 3); v[i] = *(const f32x4*)(it.W + (size_t)(it.k0 + kk) * it.ldw + it.n0 + 4 * (lane & 7)); }
    } else {
#pragma unroll
        for (int i = 0; i < 8; ++i) v[i] = (f32x4){0.f, 0.f, 0.f, 0.f};
    }
}
__device__ __forceinline__ void tr_finish(const TrItem& it, const f32x4 (&v)[8], LAS float* scr, int lane) {
#pragma unroll
    for (int i = 0; i < 8; ++i) { const int kk = 8 * i + (lane >> 3); f32x4 x = v[i]; if (it.gs) x = x * it.gs[it.k0 + kk];
        LAS float* d = scr + kk * 33 + 4 * (lane & 7); d[0] = x.x; d[1] = x.y; d[2] = x.z; d[3] = x.w; }
    LDS_FENCE();
    const int c = lane & 7;
#pragma unroll
    for (int j = 0; j < 4; ++j) { const int n = (lane >> 3) + 8 * j; const LAS float* s = scr + (8 * c) * 33 + n;
        u32x4 o; o.x = pk2(s[0 * 33], s[1 * 33]); o.y = pk2(s[2 * 33], s[3 * 33]); o.z = pk2(s[4 * 33], s[5 * 33]); o.w = pk2(s[6 * 33], s[7 * 33]);
        *(u32x4*)(it.Dst + (size_t)(it.drow0 + n) * it.ldd + it.dk0 + it.k0 + 8 * c) = o; }
    LDS_FENCE();
}
__device__ __forceinline__ TrItem conv_item(ArgsRef a, int l, int it) {
    unsigned char* ws = a.ws;
    constexpr int I_GU = (D / 64) * (FF / 32), I_DN = (FF / 64) * (D / 32), I_IN = (D / 64) * (DIN / 32), I_OUT = (D / 64) * (D / 32), I_GLU = 8 * 16;
    static_assert(I_GU == I_DN, "items");
    TrItem t; t.gs = nullptr; t.dk0 = 0;
    int r = it;
    if (r < 6 * I_GU) {
        const int which = r / I_GU; r -= which * I_GU;
        const int f = which >= 3, m = which % 3;
        if (m < 2) {
            const int nblk = FF / 32, kb = r / nblk, nb = r % nblk, n0 = 32 * nb;
            t.W = (const float*)a.in[(f ? 36 : 3) + m] + (size_t)l * D * FF; t.ldw = FF; t.k0 = 64 * kb; t.n0 = n0; t.gs = (const float*)a.in[f ? 35 : 2] + (size_t)l * D;
            t.Dst = (bf16_t*)(ws + (f ? W_UP2 : W_UP1)); t.ldd = D; t.drow0 = (n0 >> 7) * 256 + (n0 & 127) + 128 * m;
        } else {
            const int nblk = D / 32, kb = r / nblk, nb = r % nblk;
            t.W = (const float*)a.in[f ? 38 : 5] + (size_t)l * FF * D; t.ldw = D; t.k0 = 64 * kb; t.n0 = 32 * nb; t.Dst = (bf16_t*)(ws + (f ? W_DN2 : W_DN1)); t.ldd = FF; t.drow0 = 32 * nb;
        }
        return t;
    }
    r -= 6 * I_GU;
    if (r < I_IN) { const int nblk = DIN / 32, kb = r / nblk, nb = r % nblk;
        t.W = (const float*)a.in[7] + (size_t)l * D * DIN; t.ldw = DIN; t.k0 = 64 * kb; t.n0 = 32 * nb; t.gs = (const float*)a.in[6] + (size_t)l * D; t.Dst = (bf16_t*)(ws + W_IN); t.ldd = D; t.drow0 = 32 * nb; return t; }
    r -= I_IN;
    if (r < I_OUT) { const int nblk = D / 32, kb = r / nblk, nb = r % nblk;
        t.W = (const float*)a.in[34] + (size_t)l * D * D; t.ldw = D; t.k0 = 64 * kb; t.n0 = 32 * nb; t.Dst = (bf16_t*)(ws + W_OUT); t.ldd = D; t.drow0 = 32 * nb; return t; }
    r -= I_OUT;
    if (r < I_GLU) { const int kb = r / 16, nb = r % 16;
        t.W = (const float*)a.in[30] + (size_t)l * 512 * 512; t.ldw = 512; t.k0 = 64 * kb; t.n0 = 32 * nb; t.Dst = (bf16_t*)(ws + W_GLU); t.ldd = 512; t.drow0 = 32 * nb; return t; }
    r -= I_GLU;
    {
        const int nb = r >> 2, kb = r & 3, kind = nb >> 4, nn0 = 32 * (nb & 15);
        const float* W = nullptr; int k0 = 0;
        if (kind == 0 && kb == 0) { W = (const float*)a.in[10] + (size_t)l * 64 * 512; k0 = 0; }
        else if (kind == 1 && kb == 1) { W = (const float*)a.in[12] + (size_t)l * 64 * 512; k0 = 0; }
        else if (kind == 2 && kb >= 2) { W = (const float*)a.in[13] + (size_t)l * 128 * 512; k0 = 64 * (kb - 2); }
        t.W = W; t.ldw = 512; t.k0 = k0; t.n0 = nn0; t.Dst = (bf16_t*)(ws + W_LR); t.ldd = 256; t.drow0 = 32 * nb; t.dk0 = 64 * kb - k0;
    }
    return t;
}
__device__ __forceinline__ void conv_phase(ArgsRef a, int l, LAS unsigned char* lds) {
    const int TID = opaque_tid(), BID = opaque_bid();
    const int wave = TID >> 6, lane = TID & 63;
    LAS float* scr = (LAS float*)(lds + wave * 8704);
    const int gw = BID * NWAVES + wave, NGW = gridDim.x * NWAVES;
    constexpr int NITEMS = 6 * (D / 64) * (FF / 32) + (D / 64) * (DIN / 32) + (D / 64) * (D / 32) + 8 * 16 + 48 * 4;
    if (gw >= NITEMS) return;
    TrItem cur = conv_item(a, l, gw);
    f32x4 v[8]; tr_load(cur, v, lane);
    for (int it = gw; it < NITEMS; it += NGW) {
        f32x4 w[8];
#pragma unroll
        for (int i = 0; i < 8; ++i) w[i] = v[i];
        const TrItem me = cur;
        if (it + NGW < NITEMS) { cur = conv_item(a, l, it + NGW); tr_load(cur, v, lane); }
        tr_finish(me, w, scr, lane);
    }
}

__device__ __forceinline__ void norm_phase(const float* x, bf16_t* XN, float* SS) {
    const int TID = opaque_tid(), BID = opaque_bid(); (void)TID; (void)BID;
    const int wave = TID >> 6, lane = TID & 63;
    const int gw = BID * NWAVES + wave, NGW = gridDim.x * NWAVES;
    for (int m = gw; m < T; m += NGW) {
        const f32x4* xr = (const f32x4*)(x + (size_t)m * D) + lane;
        f32x4 v[8]; float s = 0.f;
#pragma unroll
        for (int j = 0; j < 8; ++j) { v[j] = xr[64 * j]; s += (v[j].x * v[j].x + v[j].y * v[j].y) + (v[j].z * v[j].z + v[j].w * v[j].w); }
        s = wave_sum(s); if (lane == 0) SS[m] = s;
        u32x2* o = (u32x2*)(XN + (size_t)m * D) + lane;
#pragma unroll
        for (int j = 0; j < 8; ++j) { u32x2 w; w.x = pk2(v[j].x, v[j].y); w.y = pk2(v[j].z, v[j].w); o[64 * j] = w; }
    }
}

__device__ __forceinline__ void zero_phase(float* p, int n) {
    const int TID = opaque_tid(), BID = opaque_bid();
    for (int i = BID * NTHREADS + TID; i < n; i += gridDim.x * NTHREADS) p[i] = 0.f;
}
__device__ __forceinline__ void alr_phase(ArgsRef a, int l) {
    const int TID = opaque_tid(), BID = opaque_bid(); (void)TID; (void)BID;
    const bf16_t* P = (const bf16_t*)(a.ws + WS_PROJ); bf16_t* ALR = (bf16_t*)(a.ws + WS_ALR);
    const float* mu = (const float*)a.in[8] + (size_t)l * 1792 + 1536;
    const int gt = BID * NTHREADS + TID, NGT = gridDim.x * NTHREADS;
    for (int it = gt; it < T * 32; it += NGT) {
        const int t = it >> 5, cg = it & 31, c0 = 8 * cg;
        float cur[8], prv[8], o[8];
        unpack8(*(const u32x4*)(P + (size_t)t * DIN + 1536 + c0), cur);
        if ((t & (SEQ - 1)) != 0) unpack8(*(const u32x4*)(P + (size_t)(t - 1) * DIN + 1536 + c0), prv);
        else {
#pragma unroll
            for (int j = 0; j < 8; ++j) prv[j] = 0.f; }
#pragma unroll
        for (int j = 0; j < 8; ++j) { const float v = cur[j] + (prv[j] - cur[j]) * mu[c0 + j];
            o[j] = c0 < 64 ? tanhf(v) : (c0 < 128 ? v : sigmoidf_(v)); }
        *(u32x4*)(ALR + (size_t)t * 256 + c0) = pack8(o);
    }
}

__device__ __forceinline__ void rwkv_full(ArgsRef a, int l, LAS unsigned char* lds, int job, int tid) {
    const bf16_t* P = (const bf16_t*)(a.ws + WS_PROJ); const bf16_t* LR = (const bf16_t*)(a.ws + WS_LRO); bf16_t* Y = (bf16_t*)(a.ws + WS_YC);
    LAS float* sR = (LAS float*)lds; LAS float* sW = sR + 4096; LAS float* sK = sW + 4096; LAS float* sKK = sK + 4096; LAS float* sB = sKK + 4096;
    LAS float* sV = sB + 4096; LAS float* sO = sV + 4096; LAS float* sBon = sO + 4096;
    const int wave = tid >> 6, lane = tid & 63, tt = tid >> 3, cg = tid & 7;
    const int b = job >> 3, h = job & 7, c0 = 64 * h + 8 * cg;
    float mur[8], muk[8], muv[8], kkw[8], kaw[8], rkw[8], lnw[8], lnb[8];
#pragma unroll
    for (int j = 0; j < 8; ++j) {
        mur[j] = ((const float*)a.in[8])[(size_t)l * 1792 + c0 + j]; muk[j] = ((const float*)a.in[8])[(size_t)l * 1792 + 512 + c0 + j]; muv[j] = ((const float*)a.in[8])[(size_t)l * 1792 + 1024 + c0 + j];
        kkw[j] = ((const float*)a.in[14])[(size_t)l * 512 + c0 + j]; kaw[j] = ((const float*)a.in[15])[(size_t)l * 512 + c0 + j]; rkw[j] = ((const float*)a.in[16])[(size_t)l * 512 + c0 + j];
        lnw[j] = ((const float*)a.in[17])[(size_t)l * 512 + c0 + j]; lnb[j] = ((const float*)a.in[18])[(size_t)l * 512 + c0 + j]; }
    f32x2 st0 = (f32x2){0.f, 0.f}, st1 = st0, st2 = st0, st3 = st0;
    const int row = 8 * wave + (lane >> 3), jq = lane & 7;
    u32x4 graw[9];
    const u32x4 zero4 = (u32x4){0u, 0u, 0u, 0u};
#define RWF_ISSUE(ch_) do { const int s_ = (ch_) * 64 + tt; const size_t t_ = (size_t)b * SEQ + s_; \
        graw[0] = *(const u32x4*)(P + t_ * DIN + c0); graw[1] = *(const u32x4*)(P + t_ * DIN + 512 + c0); graw[2] = *(const u32x4*)(P + t_ * DIN + 1024 + c0); \
        if (s_ != 0) { graw[3] = *(const u32x4*)(P + (t_ - 1) * DIN + c0); graw[4] = *(const u32x4*)(P + (t_ - 1) * DIN + 512 + c0); graw[5] = *(const u32x4*)(P + (t_ - 1) * DIN + 1024 + c0); } \
        else { graw[3] = zero4; graw[4] = zero4; graw[5] = zero4; } \
        graw[6] = *(const u32x4*)(LR + t_ * 1536 + c0); graw[7] = *(const u32x4*)(LR + t_ * 1536 + 512 + c0); graw[8] = *(const u32x4*)(LR + t_ * 1536 + 1024 + c0); } while (0)
    RWF_ISSUE(0);
    for (int ch = 0; ch < SEQ / 64; ++ch) {
        __syncthreads();
        float gate[8];
        {
            float r[8], k[8], v[8], pr[8], ld[8], av[8];
            unpack8(graw[0], r); unpack8(graw[1], k); unpack8(graw[2], v);
            unpack8(graw[3], pr);
#pragma unroll
            for (int j = 0; j < 8; ++j) r[j] += (pr[j] - r[j]) * mur[j];
            unpack8(graw[4], pr);
#pragma unroll
            for (int j = 0; j < 8; ++j) k[j] += (pr[j] - k[j]) * muk[j];
            unpack8(graw[5], pr);
#pragma unroll
            for (int j = 0; j < 8; ++j) v[j] += (pr[j] - v[j]) * muv[j];
            unpack8(graw[6], ld); unpack8(graw[7], av); unpack8(graw[8], gate);
            if (ch + 1 < SEQ / 64) RWF_ISSUE(ch + 1);
            float kk[8], ss = 0.f, bp = 0.f;
#pragma unroll
            for (int j = 0; j < 8; ++j) { kk[j] = k[j] * kkw[j]; ss += kk[j] * kk[j]; }
            ss = red8(ss);
            const float inv = __builtin_amdgcn_rsqf(fmaxf(ss, 1e-24f));
            float w8[8], k8[8], b8[8];
#pragma unroll
            for (int j = 0; j < 8; ++j) { kk[j] *= inv; k8[j] = k[j] * (1.0f + (av[j] - 1.0f) * kaw[j]); b8[j] = kk[j] * av[j]; w8[j] = __expf(ld[j]); bp += r[j] * k8[j] * rkw[j]; }
            bp = red8(bp);
            if (cg == 0) sBon[tt] = bp;
            LAS float* d;
            d = sR + tt * 64 + 8 * cg; *(LAS f32x4*)d = (f32x4){r[0], r[1], r[2], r[3]}; *(LAS f32x4*)(d + 4) = (f32x4){r[4], r[5], r[6], r[7]};
            d = sW + tt * 64 + 8 * cg; *(LAS f32x4*)d = (f32x4){w8[0], w8[1], w8[2], w8[3]}; *(LAS f32x4*)(d + 4) = (f32x4){w8[4], w8[5], w8[6], w8[7]};
            d = sK + tt * 64 + 8 * cg; *(LAS f32x4*)d = (f32x4){k8[0], k8[1], k8[2], k8[3]}; *(LAS f32x4*)(d + 4) = (f32x4){k8[4], k8[5], k8[6], k8[7]};
            d = sKK + tt * 64 + 8 * cg; *(LAS f32x4*)d = (f32x4){kk[0], kk[1], kk[2], kk[3]}; *(LAS f32x4*)(d + 4) = (f32x4){kk[4], kk[5], kk[6], kk[7]};
            d = sB + tt * 64 + 8 * cg; *(LAS f32x4*)d = (f32x4){b8[0], b8[1], b8[2], b8[3]}; *(LAS f32x4*)(d + 4) = (f32x4){b8[4], b8[5], b8[6], b8[7]};
            d = sV + tt * 64 + 8 * cg; *(LAS f32x4*)d = (f32x4){v[0], v[1], v[2], v[3]}; *(LAS f32x4*)(d + 4) = (f32x4){v[4], v[5], v[6], v[7]};
        }
        __syncthreads();
        {
#define RWF_LD(arr, s_) const f32x4 arr##a = *(const LAS f32x4*)(arr + (s_) * 64 + 8 * jq), arr##b = *(const LAS f32x4*)(arr + (s_) * 64 + 8 * jq + 4)
            f32x4 w_a = *(const LAS f32x4*)(sW + 8 * jq), w_b = *(const LAS f32x4*)(sW + 8 * jq + 4), kk_a = *(const LAS f32x4*)(sKK + 8 * jq), kk_b = *(const LAS f32x4*)(sKK + 8 * jq + 4),
                  b_a = *(const LAS f32x4*)(sB + 8 * jq), b_b = *(const LAS f32x4*)(sB + 8 * jq + 4), k_a = *(const LAS f32x4*)(sK + 8 * jq), k_b = *(const LAS f32x4*)(sK + 8 * jq + 4),
                  r_a = *(const LAS f32x4*)(sR + 8 * jq), r_b = *(const LAS f32x4*)(sR + 8 * jq + 4);
            float vi = sV[row];
            f32x2 pyp = (f32x2){0.f, 0.f}; float ykeep = 0.f;
#pragma unroll 1
            for (int s8 = 0; s8 < 64; s8 += 8) {
#pragma unroll
                for (int u = 0; u < 8; ++u) {
                    const int sn = (s8 + u + 1) & 63;
                    RWF_LD(sW, sn); RWF_LD(sKK, sn); RWF_LD(sB, sn); RWF_LD(sK, sn); RWF_LD(sR, sn);
                    const float nvi = sV[sn * 64 + row];
                    f32x2 pa = st0 * (f32x2){kk_a.x, kk_a.y}; pa = pfma(st1, (f32x2){kk_a.z, kk_a.w}, pa); pa = pfma(st2, (f32x2){kk_b.x, kk_b.y}, pa); pa = pfma(st3, (f32x2){kk_b.z, kk_b.w}, pa);
                    float av = pa.x + pa.y, yv = pyp.x + pyp.y;
                    av += dpp<XOR1>(av); yv += dpp<XOR1>(yv); av += dpp<XOR2>(av); yv += dpp<XOR2>(yv); av += dpp<XOR7>(av); yv += dpp<XOR7>(yv);
                    if (u > 0) ykeep = (jq == u - 1) ? yv : ykeep;
                    else if (s8 > 0) { ykeep = (jq == 7) ? yv : ykeep; sO[(s8 - 8 + jq) * 64 + row] = ykeep; }
                    const float sa = -av;
                    const f32x2 sa2 = (f32x2){sa, sa}, vi2 = (f32x2){vi, vi};
                    st0 = pfma(st0, (f32x2){w_a.x, w_a.y}, pfma(vi2, (f32x2){k_a.x, k_a.y}, sa2 * (f32x2){b_a.x, b_a.y}));
                    st1 = pfma(st1, (f32x2){w_a.z, w_a.w}, pfma(vi2, (f32x2){k_a.z, k_a.w}, sa2 * (f32x2){b_a.z, b_a.w}));
                    st2 = pfma(st2, (f32x2){w_b.x, w_b.y}, pfma(vi2, (f32x2){k_b.x, k_b.y}, sa2 * (f32x2){b_b.x, b_b.y}));
                    st3 = pfma(st3, (f32x2){w_b.z, w_b.w}, pfma(vi2, (f32x2){k_b.z, k_b.w}, sa2 * (f32x2){b_b.z, b_b.w}));
                    pyp = st0 * (f32x2){r_a.x, r_a.y}; pyp = pfma(st1, (f32x2){r_a.z, r_a.w}, pyp); pyp = pfma(st2, (f32x2){r_b.x, r_b.y}, pyp); pyp = pfma(st3, (f32x2){r_b.z, r_b.w}, pyp);
                    w_a = sWa; w_b = sWb; kk_a = sKKa; kk_b = sKKb; b_a = sBa; b_b = sBb; k_a = sKa; k_b = sKb; r_a = sRa; r_b = sRb; vi = nvi;
                }
            }
            const float yv = red8(pyp.x + pyp.y);
            ykeep = (jq == 7) ? yv : ykeep; sO[(56 + jq) * 64 + row] = ykeep;
#undef RWF_LD
        }
        __syncthreads();
        {
            const size_t t = (size_t)b * SEQ + ch * 64 + tt;
            const f32x4 o0 = *(const LAS f32x4*)(sO + tt * 64 + 8 * cg), o1 = *(const LAS f32x4*)(sO + tt * 64 + 8 * cg + 4);
            const f32x4 v0 = *(const LAS f32x4*)(sV + tt * 64 + 8 * cg), v1 = *(const LAS f32x4*)(sV + tt * 64 + 8 * cg + 4);
            float o[8] = {o0.x, o0.y, o0.z, o0.w, o1.x, o1.y, o1.z, o1.w}; const float vv[8] = {v0.x, v0.y, v0.z, v0.w, v1.x, v1.y, v1.z, v1.w};
            float sm = 0.f;
#pragma unroll
            for (int j = 0; j < 8; ++j) sm += o[j];
            const float mean = red8(sm) * (1.0f / 64.0f);
            float q = 0.f;
#pragma unroll
            for (int j = 0; j < 8; ++j) { o[j] -= mean; q += o[j] * o[j]; }
            const float rstd = __builtin_amdgcn_rsqf(red8(q) * (1.0f / 64.0f) + 64e-5f);
            const float bon = sBon[tt];
            float y[8];
#pragma unroll
            for (int j = 0; j < 8; ++j) y[j] = (o[j] * rstd * lnw[j] + lnb[j] + bon * vv[j]) * gate[j];
            *(u32x4*)(Y + t * D + c0) = pack8(y);
        }
    }
#undef RWF_ISSUE
}

__device__ __forceinline__ void hgrn_full(ArgsRef a, int l, LAS unsigned char* lds, int job, int tid) {
    const bf16_t* P = (const bf16_t*)(a.ws + WS_PROJ); bf16_t* Y = (bf16_t*)(a.ws + WS_YC);
    LAS float* sQ = (LAS float*)lds; LAS float* sF = sQ + 4096; LAS float* sV = sF + 4096; LAS float* sO = sV + 4096;
    const int wave = tid >> 6, lane = tid & 63, tt = tid >> 3, cg = tid & 7;
    const float* lbp = (const float*)a.in[32];
    const int b = job >> 3, h = job & 7, c0 = 64 * h + 8 * cg;
    float lb[8], gn[8];
#pragma unroll
    for (int j = 0; j < 8; ++j) { lb[j] = (l == 0) ? 0.f : sigmoidf_(lbp[512 + c0 + j] - lbp[c0 + j]); gn[j] = ((const float*)a.in[33])[(size_t)l * 64 + 8 * cg + j]; }
    f32x2 st0 = (f32x2){0.f, 0.f}, st1 = st0, st2 = st0, st3 = st0;
    const int col = 8 * wave + (lane >> 3), dq = lane & 7;
    u32x4 gq, gf, gv, gg;
#define HGF_ISSUE(ch_) do { const size_t t_ = (size_t)b * SEQ + (ch_) * 64 + tt; gq = *(const u32x4*)(P + t_ * DIN + C_HG + c0); gf = *(const u32x4*)(P + t_ * DIN + C_HG + 512 + c0); \
        gv = *(const u32x4*)(P + t_ * DIN + C_HG + 1024 + c0); gg = *(const u32x4*)(P + t_ * DIN + C_HG + 1536 + c0); } while (0)
    HGF_ISSUE(0);
    for (int ch = 0; ch < SEQ / 64; ++ch) {
        __syncthreads();
        float gate[8];
        {
            float q[8], f[8], v[8];
            unpack8(gq, q); unpack8(gf, f); unpack8(gv, v); unpack8(gg, gate);
            if (ch + 1 < SEQ / 64) HGF_ISSUE(ch + 1);
#pragma unroll
            for (int j = 0; j < 8; ++j) { q[j] = siluf_(q[j]) * 0.125f; f[j] = lb[j] + (1.0f - lb[j]) * sigmoidf_(f[j]); }
            LAS float* d;
            d = sQ + tt * 64 + 8 * cg; *(LAS f32x4*)d = (f32x4){q[0], q[1], q[2], q[3]}; *(LAS f32x4*)(d + 4) = (f32x4){q[4], q[5], q[6], q[7]};
            d = sF + tt * 64 + 8 * cg; *(LAS f32x4*)d = (f32x4){f[0], f[1], f[2], f[3]}; *(LAS f32x4*)(d + 4) = (f32x4){f[4], f[5], f[6], f[7]};
            d = sV + tt * 64 + 8 * cg; *(LAS f32x4*)d = (f32x4){v[0], v[1], v[2], v[3]}; *(LAS f32x4*)(d + 4) = (f32x4){v[4], v[5], v[6], v[7]};
        }
        __syncthreads();
        {
            f32x4 f_a = *(const LAS f32x4*)(sF + 8 * dq), f_b = *(const LAS f32x4*)(sF + 8 * dq + 4), q_a = *(const LAS f32x4*)(sQ + 8 * dq), q_b = *(const LAS f32x4*)(sQ + 8 * dq + 4);
            float vi = sV[col];
            float ykeep = 0.f;
#pragma unroll 1
            for (int s8 = 0; s8 < 64; s8 += 8) {
#pragma unroll
                for (int u = 0; u < 8; ++u) {
                    const int sn = (s8 + u + 1) & 63;
                    const f32x4 nf_a = *(const LAS f32x4*)(sF + sn * 64 + 8 * dq), nf_b = *(const LAS f32x4*)(sF + sn * 64 + 8 * dq + 4),
                                nq_a = *(const LAS f32x4*)(sQ + sn * 64 + 8 * dq), nq_b = *(const LAS f32x4*)(sQ + sn * 64 + 8 * dq + 4);
                    const float nvi = sV[sn * 64 + col];
                    const f32x2 vi2 = (f32x2){vi, vi};
                    st0 = pfma((f32x2){f_a.x, f_a.y}, st0 - vi2, vi2); st1 = pfma((f32x2){f_a.z, f_a.w}, st1 - vi2, vi2);
                    st2 = pfma((f32x2){f_b.x, f_b.y}, st2 - vi2, vi2); st3 = pfma((f32x2){f_b.z, f_b.w}, st3 - vi2, vi2);
                    f32x2 py = st0 * (f32x2){q_a.x, q_a.y}; py = pfma(st1, (f32x2){q_a.z, q_a.w}, py); py = pfma(st2, (f32x2){q_b.x, q_b.y}, py); py = pfma(st3, (f32x2){q_b.z, q_b.w}, py);
                    const float y = red8(py.x + py.y);
                    ykeep = (dq == u) ? y : ykeep;
                    f_a = nf_a; f_b = nf_b; q_a = nq_a; q_b = nq_b; vi = nvi;
                }
                sO[(s8 + dq) * 64 + col] = ykeep;
            }
        }
        __syncthreads();
        {
            const size_t t = (size_t)b * SEQ + ch * 64 + tt;
            const f32x4 o0 = *(const LAS f32x4*)(sO + tt * 64 + 8 * cg), o1 = *(const LAS f32x4*)(sO + tt * 64 + 8 * cg + 4);
            const float o[8] = {o0.x, o0.y, o0.z, o0.w, o1.x, o1.y, o1.z, o1.w};
            float q = 0.f;
#pragma unroll
            for (int j = 0; j < 8; ++j) q += o[j] * o[j];
            const float rs = __builtin_amdgcn_rsqf(red8(q) * (1.0f / 64.0f) + 1e-6f);
            float y[8];
#pragma unroll
            for (int j = 0; j < 8; ++j) y[j] = o[j] * rs * gn[j] * siluf_(gate[j]);
            *(u32x4*)(Y + t * D + 1536 + c0) = pack8(y);
        }
    }
#undef HGF_ISSUE
}

__device__ __forceinline__ void attn_phase(ArgsRef a, int l, LAS unsigned char* lds) {
    const int TID = opaque_tid(), BID = opaque_bid();
    const bf16_t* P = (const bf16_t*)(a.ws + WS_PROJ); bf16_t* Y = (bf16_t*)(a.ws + WS_YC);
    const int* pos = (const int*)a.in[1];
    const float* qn = (const float*)a.in[19] + (size_t)l * 64; const float* kn = (const float*)a.in[20] + (size_t)l * 64; const float* sinks = (const float*)a.in[21] + (size_t)l * 8;
    constexpr int KST = 144, VST = 528;
    LAS unsigned char* sK = lds; LAS unsigned char* sVt = sK + 256 * KST; LAS unsigned char* sQ = sVt + 64 * VST; LAS float* sM = (LAS float*)(sQ + 512 * KST);
    const int tid = TID, cg = tid & 7, wave = tid >> 6, lane = tid & 63;
    float kmaxg = 0.f;
    for (int j = 0; j < 64; ++j) kmaxg = fmaxf(kmaxg, fabsf(kn[j]));
    const float kbound = 8.0f * kmaxg;
    float gk[8], gq[8], invf[8];
#pragma unroll
    for (int j = 0; j < 8; ++j) { gk[j] = kn[8 * cg + j]; gq[j] = qn[8 * cg + j]; invf[j] = exp2f(-(float)j * (18.931568569324174f / 8.0f)); }
    for (int job = BID; job < 512; job += gridDim.x) {
        const int b = job >> 5, nb = (job >> 1) & 15, kvh = job & 1;
        __syncthreads();
#pragma unroll 1
        for (int r = 0; r < 4; ++r) {
            const int kj = (tid >> 3) + 64 * r, s = (nb - 1) * 128 + kj;
            float k[8], v[8];
            if (s >= 0) {
                const size_t t = (size_t)b * SEQ + s;
                unpack8(*(const u32x4*)(P + t * DIN + C_ATT + 512 + 64 * kvh + 8 * cg), k); unpack8(*(const u32x4*)(P + t * DIN + C_ATT + 640 + 64 * kvh + 8 * cg), v);
            } else {
#pragma unroll
                for (int j = 0; j < 8; ++j) { k[j] = 0.f; v[j] = 0.f; } }
            float ss = 0.f;
#pragma unroll
            for (int j = 0; j < 8; ++j) ss += k[j] * k[j];
            ss = red8(ss);
            const float rs = __builtin_amdgcn_rsqf(ss * (1.0f / 64.0f) + 1e-6f);
#pragma unroll
            for (int j = 0; j < 8; ++j) k[j] = k[j] * rs * gk[j];
            const float pf = (float)pos[b * SEQ + (s >= 0 ? s : 0)];
#pragma unroll
            for (int j = 0; j < 8; ++j) {
                const float other = dpp<XOR1>(k[j]);
                if (cg < 2) { float sn, cs; sincos_big(pf * invf[j], sn, cs); k[j] = (cg == 0) ? (k[j] * cs - other * sn) : (k[j] * cs + other * sn); }
            }
            *(LAS u32x4*)(sK + kj * KST + 16 * cg) = pack8(k);
#pragma unroll
            for (int j = 0; j < 8; j += 2) { const unsigned w = pk2(v[j], v[j + 1]);
                *(LAS unsigned short*)(sVt + (8 * cg + j) * VST + 2 * kj) = (unsigned short)(w & 0xffffu); *(LAS unsigned short*)(sVt + (8 * cg + j + 1) * VST + 2 * kj) = (unsigned short)(w >> 16); }
        }
#pragma unroll 1
        for (int r = 0; r < 8; ++r) {
            const int row = (tid >> 3) + 64 * r, g = row >> 7, qi = row & 127, hq = 4 * kvh + g;
            const size_t tq = (size_t)b * SEQ + nb * 128 + qi;
            float q[8];
            unpack8(*(const u32x4*)(P + tq * DIN + C_ATT + 64 * hq + 8 * cg), q);
            float ss = 0.f;
#pragma unroll
            for (int j = 0; j < 8; ++j) ss += q[j] * q[j];
            ss = red8(ss);
            const float rs = 0.125f * __builtin_amdgcn_rsqf(ss * (1.0f / 64.0f) + 1e-6f);
#pragma unroll
            for (int j = 0; j < 8; ++j) q[j] = q[j] * rs * gq[j];
            const float pf = (float)pos[b * SEQ + nb * 128 + qi];
            float qq = 0.f;
#pragma unroll
            for (int j = 0; j < 8; ++j) {
                const float other = dpp<XOR1>(q[j]);
                if (cg < 2) { float sn, cs; sincos_big(pf * invf[j], sn, cs); q[j] = (cg == 0) ? (q[j] * cs - other * sn) : (q[j] * cs + other * sn); }
                qq += q[j] * q[j];
            }
            qq = red8(qq);
            if (cg == 0) sM[row] = sqrtf(qq) * kbound;
            *(LAS u32x4*)(sQ + row * KST + 16 * cg) = pack8(q);
        }
        __syncthreads();
        const int g = wave >> 1, qh = wave & 1, hq = 4 * kvh + g, fr = lane & 15, fq = lane >> 4;
        const float sinkv = sinks[hq];
#pragma unroll 1
        for (int qt = 0; qt < 4; ++qt) {
            const int qi0 = 64 * qh + 16 * qt, R0 = g * 128 + qi0, kt0 = qi0 >> 4;
            const bf16x8 qf0 = *(const LAS bf16x8*)(sQ + (R0 + fr) * KST + 16 * fq), qf1 = *(const LAS bf16x8*)(sQ + (R0 + fr) * KST + 16 * fq + 64);
            const float msh = sM[R0 + fr];
            const int ql = qi0 + fr;
            f32x4 oacc[4];
#pragma unroll
            for (int dt = 0; dt < 4; ++dt) oacc[dt] = (f32x4){0.f, 0.f, 0.f, 0.f};
            float lsum = 0.f;
#pragma unroll
            for (int ks = 0; ks < 5; ++ks) {
                unsigned pw[4];
#pragma unroll
                for (int h2 = 0; h2 < 2; ++h2) {
                    const int ti = 2 * ks + h2, kt = (kt0 + ti) < 15 ? (kt0 + ti) : 15;
                    const bf16x8 kf0 = *(const LAS bf16x8*)(sK + (16 * kt + fr) * KST + 16 * fq), kf1 = *(const LAS bf16x8*)(sK + (16 * kt + fr) * KST + 16 * fq + 64);
                    f32x4 sc = (f32x4){0.f, 0.f, 0.f, 0.f};
                    sc = __builtin_amdgcn_mfma_f32_16x16x32_bf16(kf0, qf0, sc, 0, 0, 0);
                    sc = __builtin_amdgcn_mfma_f32_16x16x32_bf16(kf1, qf1, sc, 0, 0, 0);
                    float p[4];
#pragma unroll
                    for (int j = 0; j < 4; ++j) { const int kj = 16 * (kt0 + ti) + 4 * fq + j;
                        const bool valid = (kj > ql) && (kj <= ql + 128) && (nb > 0 || kj >= 128);
                        p[j] = valid ? __expf(sc[j] - msh) : 0.f; lsum += p[j]; }
                    pw[2 * h2] = pk2(p[0], p[1]); pw[2 * h2 + 1] = pk2(p[2], p[3]);
                }
                const u32x4 pq = (u32x4){pw[0], pw[1], pw[2], pw[3]};
                const bf16x8 pf = __builtin_bit_cast(bf16x8, pq);
                const int kta = (kt0 + 2 * ks) < 15 ? (kt0 + 2 * ks) : 15, ktb = (kt0 + 2 * ks + 1) < 15 ? (kt0 + 2 * ks + 1) : 15;
#pragma unroll
                for (int dt = 0; dt < 4; ++dt) {
                    const u32x2 va = *(const LAS u32x2*)(sVt + (16 * dt + fr) * VST + (16 * kta + 4 * fq) * 2), vb = *(const LAS u32x2*)(sVt + (16 * dt + fr) * VST + (16 * ktb + 4 * fq) * 2);
                    const u32x4 vq = (u32x4){va.x, va.y, vb.x, vb.y};
                    oacc[dt] = __builtin_amdgcn_mfma_f32_16x16x32_bf16(__builtin_bit_cast(bf16x8, vq), pf, oacc[dt], 0, 0, 0);
                }
            }
            lsum += __shfl_xor(lsum, 16); lsum += __shfl_xor(lsum, 32);
            const float inv = __builtin_amdgcn_rcpf(lsum + __expf(sinkv - msh));
            const size_t tq = (size_t)b * SEQ + nb * 128 + ql;
#pragma unroll
            for (int dt = 0; dt < 4; ++dt) { u32x2 w; w.x = pk2(oacc[dt][0] * inv, oacc[dt][1] * inv); w.y = pk2(oacc[dt][2] * inv, oacc[dt][3] * inv);
                *(u32x2*)(Y + tq * D + 512 + 64 * hq + 16 * dt + 4 * fq) = w; }
        }
    }
    __syncthreads();
}

__device__ __forceinline__ float gelu_erf(float v) {
    const float t = __builtin_amdgcn_rcpf(fabsf(v) * 0.2316418882f + 1.0f);
    float q = t * 0.5307027145f + (-0.7265760135f); q = q * t + 0.7107068705f; q = q * t + (-0.142248368f); q = q * t + 0.127414796f; q = q * t;
    const float e = __builtin_amdgcn_exp2f(v * v * (-0.72134752044f));
    const float m = v * (q * e);
    return v < 0.f ? m : v - m;
}
__device__ __forceinline__ void s5_jobs(ArgsRef a, int l, LAS unsigned char* lds, unsigned* qctr) {
    const int TID = opaque_tid();
    LAS int* sJob = (LAS int*)(lds + 8 * 16 * 130 * 4 + 4096);
    const bf16_t* P = (const bf16_t*)(a.ws + WS_PROJ); bf16_t* Z = (bf16_t*)(a.ws + WS_Z);
    const int tid = TID, wave = tid >> 6, lane = tid & 63, fr16 = lane & 15, fq = lane >> 4;
    LAS float* sX = (LAS float*)lds + wave * (16 * 130);
    LAS float* sE = (LAS float*)lds + 8 * 16 * 130;
    for (;;) {
        if (TID == 0) *sJob = (int)__hip_atomic_fetch_add(qctr, 1u, __ATOMIC_RELAXED, __HIP_MEMORY_SCOPE_AGENT);
        __syncthreads();
        const int job = *sJob;
        if (job >= 512) break;
        const int b = job >> 5, g = job & 31;
        const float dt = expf(((const float*)a.in[24])[l * 32 + g]);
        float lbr, lbi;
        { const float lre = ((const float*)a.in[22])[(size_t)l * 2048 + g * 64 + lane], lim = ((const float*)a.in[23])[(size_t)l * 2048 + g * 64 + lane];
          float sn, cs; sincos_big(lim * dt, sn, cs); const float er = expf(lre * dt); lbr = er * cs; lbi = er * sn; }
        bf16x8 bfrag[8];
#pragma unroll
        for (int k = 0; k < 4; ++k) {
            const int p = fr16 + 16 * k;
            const float lre = ((const float*)a.in[22])[(size_t)l * 2048 + g * 64 + p], lim = ((const float*)a.in[23])[(size_t)l * 2048 + g * 64 + p];
            float sn, cs; sincos_big(lim * dt, sn, cs); const float er = expf(lre * dt), pbr = er * cs, pbi = er * sn;
            const float den = __builtin_amdgcn_rcpf(lre * lre + lim * lim);
            const float fr = ((pbr - 1.0f) * lre + pbi * lim) * den, fi = (pbi * lre - (pbr - 1.0f) * lim) * den;
            const float* brp = (const float*)a.in[25] + ((size_t)l * 2048 + g * 64 + p) * 16 + 8 * (fq & 1);
            const float* bip = (const float*)a.in[26] + ((size_t)l * 2048 + g * 64 + p) * 16 + 8 * (fq & 1);
            float vr[8], vi[8];
#pragma unroll
            for (int i = 0; i < 8; ++i) { const float br = brp[i], bi = bip[i]; float xr = fr * br - fi * bi, xi = fr * bi + fi * br;
                const unsigned hw = pk2(xr, xi);
                if (fq >= 2) { xr -= bflo(hw); xi -= bfhi(hw); }
                vr[i] = xr; vi[i] = xi; }
            bfrag[k] = __builtin_bit_cast(bf16x8, pack8(vr)); bfrag[4 + k] = __builtin_bit_cast(bf16x8, pack8(vi));
        }
        float creg[32];
        {
            const float* cre = (const float*)a.in[27] + ((size_t)l * 32 + g) * 1024 + fr16 * 64 + fq;
            const float* cim = (const float*)a.in[28] + ((size_t)l * 32 + g) * 1024 + fr16 * 64 + fq;
#pragma unroll
            for (int kk = 0; kk < 16; ++kk) { creg[kk] = cre[4 * kk]; creg[16 + kk] = -cim[4 * kk]; }
        }
        f32x4 dsk;
        { const float* dp = (const float*)a.in[29] + (size_t)l * 512 + 16 * g + 4 * fq; dsk = (f32x4){dp[0], dp[1], dp[2], dp[3]}; }
        const size_t tbase = (size_t)b * SEQ + wave * 256;
        const bf16_t* ua = P + (tbase + fr16) * DIN + C_S5 + 16 * g + 8 * (fq & 1);
        const bf16_t* ue = P + (tbase + fr16) * DIN + C_S5 + 16 * g + 4 * fq;
        f32x2 xs = (f32x2){0.f, 0.f}; const f32x2 lbr2 = (f32x2){lbr, lbr}, lbi2 = (f32x2){lbi, lbi};
        {
            u32x4 au = *(const u32x4*)ua;
#pragma unroll 1
            for (int gi = 0; gi < 16; ++gi) {
                const bf16x8 af = __builtin_bit_cast(bf16x8, au);
                if (gi + 1 < 16) au = *(const u32x4*)(ua + (size_t)(gi + 1) * 16 * DIN);
#pragma unroll
                for (int nt = 0; nt < 8; ++nt) { const f32x4 d = __builtin_amdgcn_mfma_f32_16x16x32_bf16(af, bfrag[nt], (f32x4){0.f, 0.f, 0.f, 0.f}, 0, 0, 0);
#pragma unroll
                    for (int j = 0; j < 4; ++j) sX[(4 * fq + j) * 130 + fr16 + 16 * nt] = d[j]; }
                LDS_FENCE();
#pragma unroll
                for (int s = 0; s < 16; ++s) { const f32x2 bu = (f32x2){sX[s * 130 + lane], sX[s * 130 + 64 + lane]};
                    const f32x2 nx = pfma(lbr2, xs, bu); xs = pfma(lbi2, (f32x2){-xs.y, xs.x}, nx); }
                LDS_FENCE();
            }
        }
        sE[wave * 128 + lane] = xs.x; sE[wave * 128 + 64 + lane] = xs.y;
        float pr = lbr, pi = lbi;
#pragma unroll
        for (int i = 0; i < 8; ++i) { const float nr = pr * pr - pi * pi, ni = 2.0f * pr * pi; pr = nr; pi = ni; }
        __syncthreads();
        xs = (f32x2){0.f, 0.f};
        for (int w = 0; w < wave; ++w) { const float er_ = sE[w * 128 + lane], ei_ = sE[w * 128 + 64 + lane];
            const float nr = pr * xs.x - pi * xs.y + er_, ni = pr * xs.y + pi * xs.x + ei_; xs.x = nr; xs.y = ni; }
        {
            u32x4 au = *(const u32x4*)ua; u32x2 eu = *(const u32x2*)ue;
#pragma unroll 1
            for (int gi = 0; gi < 16; ++gi) {
                const bf16x8 af = __builtin_bit_cast(bf16x8, au); const u32x2 eun = eu;
                if (gi + 1 < 16) { au = *(const u32x4*)(ua + (size_t)(gi + 1) * 16 * DIN); eu = *(const u32x2*)(ue + (size_t)(gi + 1) * 16 * DIN); }
#pragma unroll
                for (int nt = 0; nt < 8; ++nt) { const f32x4 d = __builtin_amdgcn_mfma_f32_16x16x32_bf16(af, bfrag[nt], (f32x4){0.f, 0.f, 0.f, 0.f}, 0, 0, 0);
#pragma unroll
                    for (int j = 0; j < 4; ++j) sX[(4 * fq + j) * 130 + fr16 + 16 * nt] = d[j]; }
                LDS_FENCE();
#pragma unroll
                for (int s = 0; s < 16; ++s) { const f32x2 bu = (f32x2){sX[s * 130 + lane], sX[s * 130 + 64 + lane]};
                    const f32x2 nx = pfma(lbr2, xs, bu); xs = pfma(lbi2, (f32x2){-xs.y, xs.x}, nx);
                    sX[s * 130 + lane] = xs.x; sX[s * 130 + 64 + lane] = xs.y; }
                LDS_FENCE();
                f32x4 yacc = (f32x4){0.f, 0.f, 0.f, 0.f}, yacc1 = yacc, yacc2 = yacc, yacc3 = yacc;
                const LAS float* xp = sX + fr16 * 130 + fq;
#pragma unroll
                for (int kk = 0; kk < 32; kk += 4) {
                    yacc = __builtin_amdgcn_mfma_f32_16x16x4f32(creg[kk], xp[4 * kk], yacc, 0, 0, 0);
                    yacc1 = __builtin_amdgcn_mfma_f32_16x16x4f32(creg[kk + 1], xp[4 * kk + 4], yacc1, 0, 0, 0);
                    yacc2 = __builtin_amdgcn_mfma_f32_16x16x4f32(creg[kk + 2], xp[4 * kk + 8], yacc2, 0, 0, 0);
                    yacc3 = __builtin_amdgcn_mfma_f32_16x16x4f32(creg[kk + 3], xp[4 * kk + 12], yacc3, 0, 0, 0);
                }
                yacc = (yacc + yacc1) + (yacc2 + yacc3);
                const float u0 = bflo(eun.x), u1 = bfhi(eun.x), u2 = bflo(eun.y), u3 = bfhi(eun.y);
                const float z0 = gelu_erf(yacc[0] + dsk[0] * u0), z1 = gelu_erf(yacc[1] + dsk[1] * u1), z2 = gelu_erf(yacc[2] + dsk[2] * u2), z3 = gelu_erf(yacc[3] + dsk[3] * u3);
                u32x2 w; w.x = pk2(z0, z1); w.y = pk2(z2, z3);
                *(u32x2*)(Z + (tbase + gi * 16 + fr16) * 512 + 16 * g + 4 * fq) = w;
                LDS_FENCE();
            }
        }
        __syncthreads();
    }
}

__device__ __forceinline__ void scan_phase(ArgsRef a, int l, LAS unsigned char* lds) {
    const int TID = opaque_tid(), BID = opaque_bid();
    if (gridDim.x == 256) {
        if (BID < 128) rwkv_full(a, l, lds, BID, TID); else hgrn_full(a, l, lds, BID - 128, TID);
    } else {
        for (int job = BID; job < 256; job += gridDim.x) { if (job < 128) rwkv_full(a, l, lds, job, TID); else hgrn_full(a, l, lds, job - 128, TID); __syncthreads(); }
    }
    __syncthreads();
    s5_jobs(a, l, lds, (unsigned*)(a.ws + WS_BAR) + 3584 + 64 * l);
    __syncthreads();
}

#define XB_TMO      128
#define XB_XCNT(j)  (256  + 64 * (j))
#define XB_XSUB(j)  (1280 + 64 * (j))
#define XB_XGEN(j)  (2304 + 64 * (j))
#define XB_TOP      3328
#define XB_TOPGEN   3392
#define XCD_BAR_WORDS 3456
#define XB_SPIN_CAP (1u << 18)

__device__ __forceinline__ unsigned xb_ld(unsigned* p)              { return __hip_atomic_load(p, __ATOMIC_RELAXED, __HIP_MEMORY_SCOPE_AGENT); }
__device__ __forceinline__ unsigned xb_add(unsigned* p, unsigned v) { return __hip_atomic_fetch_add(p, v, __ATOMIC_RELAXED, __HIP_MEMORY_SCOPE_AGENT); }
__device__ __forceinline__ unsigned xb_xcc_id() { return (unsigned)__builtin_amdgcn_s_getreg((3 << 11) | 20) & 0xFu; }
#define XB_SPIN(cond, bar) do { unsigned _sp = 0; while (cond) { __builtin_amdgcn_s_sleep(1); \
    if ((++_sp & 255u) == 0u) { if (xb_ld(&(bar)[XB_TMO])) break; if (_sp > XB_SPIN_CAP) { atomicAdd(&(bar)[XB_TMO], 1u); break; } } } } while (0)

struct XcdBarrier {
    unsigned* bar; unsigned x;
    volatile LAS unsigned* st;
};

__device__ __forceinline__ XcdBarrier xcd_barrier_post(unsigned* bar, volatile LAS unsigned* st) {
    XcdBarrier b; b.bar = bar; b.x = xb_xcc_id(); b.st = st;
    if (threadIdx.x == 0) (void)xb_add(&bar[XB_XCNT(b.x)], 1u);
    return b;
}
__device__ __forceinline__ void xcd_barrier_complete(unsigned* bar, unsigned x, unsigned& nloc, unsigned& nx) {
    const unsigned G = gridDim.x * gridDim.y * gridDim.z;
    unsigned sum, cnt, mine, sp = 0u;
    for (;;) {
        sum = 0u; cnt = 0u; mine = 0u;
#pragma unroll
        for (unsigned j = 0; j < 16; ++j) { const unsigned c = xb_ld(&bar[XB_XCNT(j)]); sum += c; cnt += (c > 0u) ? 1u : 0u; mine = (j == x) ? c : mine; }
        if (sum == G) break;
        __builtin_amdgcn_s_sleep(1);
        if ((++sp & 255u) == 0u) { if (xb_ld(&bar[XB_TMO])) break; if (sp > XB_SPIN_CAP) { atomicAdd(&bar[XB_TMO], 1u); break; } }
    }
    nloc = mine > 0u ? mine : 1u; nx = cnt > 0u ? cnt : 1u;
}

__device__ __forceinline__ void xcd_barrier(const XcdBarrier& b) {
    asm volatile("s_waitcnt vmcnt(0)" ::: "memory");
    __syncthreads();
    if (threadIdx.x == 0) {
        unsigned* bar = b.bar;
        __builtin_amdgcn_s_waitcnt(0);
        unsigned nloc = b.st[0], nx = b.st[1];
        if (nloc == 0u) { xcd_barrier_complete(bar, b.x, nloc, nx); b.st[0] = nloc; b.st[1] = nx; }
        const unsigned old = xb_add(&bar[XB_XSUB(b.x)], 1u);
        const unsigned gen = old / nloc;
        if (old + 1u == (gen + 1u) * nloc) {
            __builtin_amdgcn_fence(__ATOMIC_RELEASE, "agent");
            asm volatile("s_waitcnt vmcnt(0)" ::: "memory");
            const unsigned og = xb_add(&bar[XB_TOP], 1u);
            const unsigned tg = og / nx;
            if (og + 1u == (tg + 1u) * nx) xb_add(&bar[XB_TOPGEN], 1u);
            else XB_SPIN(xb_ld(&bar[XB_TOPGEN]) == tg, bar);
            __builtin_amdgcn_fence(__ATOMIC_ACQUIRE, "agent");
            xb_add(&bar[XB_XGEN(b.x)], 1u);
            asm volatile("s_waitcnt vmcnt(0)" ::: "memory");
        } else {
            XB_SPIN(xb_ld(&bar[XB_XGEN(b.x)]) == gen, bar);
            __builtin_amdgcn_fence(__ATOMIC_ACQUIRE, "agent");
            asm volatile("s_waitcnt vmcnt(0)" ::: "memory");
        }
    }
    __syncthreads();
}


constexpr int NPH = 11;
#ifndef DUPMASK
#define DUPMASK 0
#endif
__global__ void __launch_bounds__(NTHREADS, 2) mega(Args a_, int lo, int hi) {
    extern __shared__ __attribute__((aligned(16))) unsigned char lds_raw[];
    LAS unsigned char* lds = (LAS unsigned char*)lds_raw;
#ifdef EXTRA_SYNCS
    for (int i = 0; i < EXTRA_SYNCS; ++i) { __syncthreads(); cg::this_grid().sync(); }
#endif
    LAS unsigned* xst = (LAS unsigned*)(lds + LDS_BYTES - 16);
    if (hi - lo > 1) {
        if (threadIdx.x == 0) { xst[0] = 0u; xst[1] = 0u; }
        __syncthreads();
        if (blockIdx.x == 0) {
            const __attribute__((address_space(4))) Args* ap0 = (const __attribute__((address_space(4))) Args*)__builtin_amdgcn_kernarg_segment_ptr();
            unsigned* bw = (unsigned*)(ap0->ws + WS_BAR);
            for (int i = threadIdx.x; i < 4096; i += NTHREADS) bw[i] = 0u;
        }
    }
#pragma unroll 1
    for (int step2 = 2 * lo; step2 < 2 * hi; ++step2) {
        const int step = step2 >> 1;
        if ((step2 & 1) && !((DUPMASK >> (step % NPH)) & 1)) continue;
        const __attribute__((address_space(4))) Args* ap = (const __attribute__((address_space(4))) Args*)__builtin_amdgcn_kernarg_segment_ptr();
        asm volatile("" : "+s"(ap));
        ArgsRef a = *ap;
        unsigned char* ws = a.ws;
        float* SSa = (float*)(ws + WS_SS); float* SSb = SSa + T; float* SSc = SSb + T;
        const int l = step / NPH, ph = step % NPH;
        const float* xin = (l == 0) ? (const float*)a.in[0] : (const float*)a.out;
#ifndef PHMASK
#define PHMASK 0x7ff
#endif
        switch (ph) {
        case 0: if (PHMASK & (1 << 0)) { conv_phase(a, l, lds); if (l == 0) norm_phase(xin, (bf16_t*)(ws + WS_XN), SSa); zero_phase(SSb, T); } break;
        case 1: if (PHMASK & (1 << 1)) { pg8::EpiSwiGLU E; E.H = (bf16_t*)(ws + WS_HID); E.SS = SSa; run_gemm(lds, (const bf16_t*)(ws + WS_XN), (const bf16_t*)(ws + W_UP1), 2 * FF, D, E); } break;
        case 2: if (PHMASK & (1 << 2)) { pg8::EpiResidual<true> E; E.base = xin; E.out = a.out; E.XN = (bf16_t*)(ws + WS_XN); E.SS = SSb; run_gemm(lds, (const bf16_t*)(ws + WS_HID), (const bf16_t*)(ws + W_DN1), D, FF, E); } break;
        case 3: if (PHMASK & (1 << 3)) { pg8::EpiBf16 E; E.O = (bf16_t*)(ws + WS_PROJ); E.ldc = DIN; E.SS = SSb; run_gemm(lds, (const bf16_t*)(ws + WS_XN), (const bf16_t*)(ws + W_IN), DIN, D, E); } break;
        case 4: if (PHMASK & (1 << 4)) { zero_phase(SSa, T); zero_phase(SSc, T); alr_phase(a, l); attn_phase(a, l, lds); } break;
        case 5: if (PHMASK & (1 << 5)) { pg8::EpiLR E; E.O = (bf16_t*)(ws + WS_LRO); E.w0 = (const float*)a.in[9] + (size_t)l * 512; E.a0 = (const float*)a.in[11] + (size_t)l * 512;
                  run_gemm(lds, (const bf16_t*)(ws + WS_ALR), (const bf16_t*)(ws + W_LR), 1536, 256, E); } break;
        case 6: if (PHMASK & (1 << 6)) scan_phase(a, l, lds); break;
        case 7: if (PHMASK & (1 << 7)) { pg8::EpiGLU G; G.Z = (const bf16_t*)(ws + WS_Z); G.Y = (bf16_t*)(ws + WS_YC); G.b = (const float*)a.in[31] + (size_t)l * 512;
                  run_gemm(lds, (const bf16_t*)(ws + WS_Z), (const bf16_t*)(ws + W_GLU), 512, 512, G); } break;
        case 8: if (PHMASK & (1 << 8)) { pg8::EpiResidual<false> E; E.base = a.out; E.out = a.out; E.XN = (bf16_t*)(ws + WS_XN); E.SS = SSc; run_gemm(lds, (const bf16_t*)(ws + WS_YC), (const bf16_t*)(ws + W_OUT), D, D, E); } break;
        case 9: if (PHMASK & (1 << 9)) { pg8::EpiSwiGLU E; E.H = (bf16_t*)(ws + WS_HID); E.SS = SSc; run_gemm(lds, (const bf16_t*)(ws + WS_XN), (const bf16_t*)(ws + W_UP2), 2 * FF, D, E); } break;
        case 10: if (PHMASK & (1 << 10)) { pg8::EpiResidual<true> E; E.base = a.out; E.out = a.out; E.XN = (l + 1 < NL) ? (bf16_t*)(ws + WS_XN) : nullptr; E.SS = SSa; run_gemm(lds, (const bf16_t*)(ws + WS_HID), (const bf16_t*)(ws + W_DN2), D, FF, E); } break;
        }
        if ((step2 + 2 < 2 * hi) || (((step2 & 1) == 0) && ((DUPMASK >> ((step2 >> 1) % NPH)) & 1))) {
            if (step2 == 2 * lo) { __syncthreads(); cg::this_grid().sync(); (void)xcd_barrier_post((unsigned*)(ws + WS_BAR), (volatile LAS unsigned*)xst); }
            else { XcdBarrier xb; xb.bar = (unsigned*)(ws + WS_BAR); xb.x = xb_xcc_id(); xb.st = (volatile LAS unsigned*)xst; xcd_barrier(xb); }
        }
    }
}

extern "C" void kernel_launch(void* const* d_in, const int* in_sizes, int n_in, void* d_out, int out_size, void* d_ws, size_t ws_size, hipStream_t stream) {
    static int grid = 0;
    if (!grid) {
        int dev = 0, cus = 0, per_cu = 0;
        hipGetDevice(&dev);
        hipDeviceGetAttribute(&cus, hipDeviceAttributeMultiprocessorCount, dev);
        hipFuncSetAttribute((const void*)mega, hipFuncAttributeMaxDynamicSharedMemorySize, LDS_BYTES);
        hipOccupancyMaxActiveBlocksPerMultiprocessor(&per_cu, (const void*)mega, NTHREADS, LDS_BYTES);
        if (per_cu < 1) per_cu = 1;
        grid = cus * 1;
        if (grid != 256) fprintf(stderr, "kernel_launch: grid %d (cus %d, per_cu %d)\n", grid, cus, per_cu);
    }
    Args a{};
    for (int i = 0; i < 39; ++i) a.in[i] = d_in[i];
    a.out = (float*)d_out; a.ws = (unsigned char*)d_ws;
#if ONE_LAUNCH
    int lo = 0, hi = NL * NPH;
    void* args[] = {&a, &lo, &hi};
    hipError_t e = hipLaunchCooperativeKernel((void*)mega, dim3(grid), dim3(NTHREADS), args, LDS_BYTES, stream);
    if (e != hipSuccess) fprintf(stderr, "cooperative launch failed: %s (grid %d)\n", hipGetErrorString(e), grid);
#else
    for (int s = 0; s < NL * NPH; ++s) hipLaunchKernelGGL(mega, dim3(grid), dim3(NTHREADS), LDS_BYTES, stream, a, s, s + 1);
#endif
}
```

```cpp
#include <hip/hip_runtime.h>
#include <hip/hip_cooperative_groups.h>
#include <cstdio>
#include <cstdint>
namespace cg = cooperative_groups;

#ifndef ONE_LAUNCH
#define ONE_LAUNCH 1
#endif

#define LAS __attribute__((address_space(3)))
typedef unsigned short bf16_t;
typedef short bf16x8 __attribute__((ext_vector_type(8)));
typedef float f32x4 __attribute__((ext_vector_type(4)));
typedef float f32x2 __attribute__((ext_vector_type(2)));
typedef unsigned u32x4 __attribute__((ext_vector_type(4)));
typedef unsigned u32x2 __attribute__((ext_vector_type(2)));

constexpr int T = 32768, SEQ = 2048, NB = 16, D = 2048, FF = 5632, DIN = 5120, NL = 2;
constexpr int C_RWKV = 0, C_ATT = 1792, C_S5 = 2560, C_HG = 3072;
constexpr int NTHREADS = 512, NWAVES = 8;

constexpr size_t SZ_UP = (size_t)2 * FF * D * 2, SZ_DN = (size_t)D * FF * 2, SZ_IN = (size_t)DIN * D * 2, SZ_LR = (size_t)1536 * 256 * 2,
                 SZ_GLU = (size_t)512 * 512 * 2, SZ_OUT = (size_t)D * D * 2;
constexpr size_t W_UP1 = 0, W_DN1 = W_UP1 + SZ_UP, W_IN = W_DN1 + SZ_DN, W_LR = W_IN + SZ_IN, W_GLU = W_LR + SZ_LR, W_OUT = W_GLU + SZ_GLU,
                 W_UP2 = W_OUT + SZ_OUT, W_DN2 = W_UP2 + SZ_UP, W_END = W_DN2 + SZ_DN;
constexpr size_t WS_XN = W_END, WS_BIG = WS_XN + (size_t)T * D * 2;
constexpr size_t WS_HID = WS_BIG;
constexpr size_t WS_PROJ = WS_BIG, WS_LRO = WS_PROJ + (size_t)T * DIN * 2, WS_ALR = WS_LRO + (size_t)T * 1536 * 2, WS_Z = WS_ALR + (size_t)T * 256 * 2,
                 WS_OR = WS_Z + (size_t)T * 512 * 2, WS_OH = WS_OR + (size_t)T * 512 * 4, WS_BON = WS_OH + (size_t)T * 512 * 4, WS_YC = WS_BON + (size_t)T * 8 * 4, WS_SS = WS_YC + (size_t)T * D * 2, WS_BAR = WS_SS + (size_t)3 * T * 4, WS_END = WS_BAR + 16384;
static_assert(WS_END <= (size_t)1 << 30, "workspace");
static_assert(WS_HID + (size_t)T * FF * 2 <= (size_t)1 << 30, "workspace");

constexpr int LDS_BYTES = 147456;

struct Args { const void* in[39]; float* out; unsigned char* ws; };
typedef const __attribute__((address_space(4))) Args& ArgsRef;

typedef __bf16 bf16x2_t __attribute__((ext_vector_type(2)));
__device__ __forceinline__ unsigned pk2(float lo, float hi) { const f32x2 v = (f32x2){lo, hi}; return __builtin_bit_cast(unsigned, __builtin_convertvector(v, bf16x2_t)); }
__device__ __forceinline__ float bflo(unsigned w) { return __uint_as_float(w << 16); }
__device__ __forceinline__ float bfhi(unsigned w) { return __uint_as_float(w & 0xffff0000u); }
__device__ __forceinline__ void unpack8(u32x4 q, float* f) { f[0] = bflo(q.x); f[1] = bfhi(q.x); f[2] = bflo(q.y); f[3] = bfhi(q.y); f[4] = bflo(q.z); f[5] = bfhi(q.z); f[6] = bflo(q.w); f[7] = bfhi(q.w); }
__device__ __forceinline__ u32x4 pack8(const float* f) { u32x4 o; o.x = pk2(f[0], f[1]); o.y = pk2(f[2], f[3]); o.z = pk2(f[4], f[5]); o.w = pk2(f[6], f[7]); return o; }
template <int CTRL> __device__ __forceinline__ float dpp(float x) { return __builtin_bit_cast(float, __builtin_amdgcn_mov_dpp(__builtin_bit_cast(int, x), CTRL, 0xf, 0xf, true)); }
constexpr int XOR1 = 0xB1, XOR2 = 0x4E, XOR7 = 0x141, XOR8 = 0x128;
__device__ __forceinline__ float red8(float v) { v += dpp<XOR1>(v); v += dpp<XOR2>(v); v += dpp<XOR7>(v); return v; }
__device__ __forceinline__ float red16(float v) { v = red8(v); v += dpp<XOR8>(v); return v; }
__device__ __forceinline__ float wave_sum(float v) {
#pragma unroll
    for (int o = 1; o < 64; o <<= 1) v += __shfl_xor(v, o);
    return v;
}
__device__ __forceinline__ float sigmoidf_(float x) { return __builtin_amdgcn_rcpf(1.0f + __expf(-x)); }
__device__ __forceinline__ float siluf_(float x) { return x * __builtin_amdgcn_rcpf(1.0f + __expf(-x)); }
__device__ __forceinline__ int opaque_tid() { int t = threadIdx.x; asm volatile("" : "+v"(t)); return t; }
__device__ __forceinline__ int opaque_bid() { int t = blockIdx.x; asm volatile("" : "+s"(t)); return t; }
__device__ __forceinline__ f32x2 pfma(f32x2 a, f32x2 b, f32x2 c) { return __builtin_elementwise_fma(a, b, c); }
#define LDS_FENCE() asm volatile("s_waitcnt lgkmcnt(0)" ::: "memory")
__device__ __forceinline__ void sincos_big(float x, float& sn, float& cs) {
    const float n = rintf(x * 0.15915494309189535f);
    float r = fmaf(-n, 6.28318548202514648f, x); r = fmaf(-n, -1.7484555e-7f, r);
    sn = __sinf(r); cs = __cosf(r);
}

namespace pg8 {
constexpr int BM = 256, BK = 64, HALF = 128, HTB = HALF * BK * 2, STAGE_BYTES = 8 * HTB, NXCD = 8, WGM = 4;
__host__ __device__ __forceinline__ int lds_byte(int r, int c) { const int st = (r >> 4) * 2 + (c >> 5), rr = r & 15, cc = c & 31, ob = rr * 64 + cc * 2; return st * 1024 + (ob ^ (((ob >> 9) & 1) << 5)); }
__host__ __device__ __forceinline__ void stage_rc(int b, int& R, int& C) { const int st = b / 1024, sb = b % 1024, swz = sb ^ (((sb >> 9) & 1) << 5); R = (st >> 1) * 16 + swz / 64; C = (st & 1) * 32 + (swz % 64) / 2; }
__host__ __device__ __forceinline__ int perm32(int rho) { const int n = rho >> 4, i = rho & 15; return 8 * (i >> 2) + 4 * n + (i & 3); }
struct Unit { int pm, pn; };
struct Gemm { const bf16_t* A; const bf16_t* Bt; int M, N, K; };
struct StaticOrder {
    int nM, nN, nwg, G, c;
    __device__ void init(int M, int N, int G_, int c_) { nM = M / BM; nN = N / BM; nwg = nM * nN; G = G_; c = c_; }
    __device__ bool next(int i, Unit& u) const {
        const long L = (long)i * G + c; if (L >= nwg) return false;
        int wgid = (int)L; { const int q = nwg / NXCD, r = nwg % NXCD, xcd = wgid % NXCD, off = wgid / NXCD; wgid = (xcd < r ? xcd * (q + 1) : r * (q + 1) + (xcd - r) * q) + off; }
        const int nig = WGM * nN, gid = wgid / nig, fm = gid * WGM, gsz = (nM - fm) < WGM ? (nM - fm) : WGM;
        u.pm = fm + ((wgid % nig) % gsz); u.pn = (wgid % nig) / gsz; return true;
    }
};
#ifndef GEMM_SP2
#define GEMM_SP2 true
#endif
#ifndef GEMM_ALIGN
#define GEMM_ALIGN true
#endif
template <class Epi, bool ALIGN_EPI = GEMM_ALIGN, bool SP2 = GEMM_SP2>
__device__ __forceinline__ void gemm_phase(LAS unsigned char* lds, const Gemm g, const StaticOrder S, const Epi E) {
    const int TID = opaque_tid(), BID = opaque_bid(); (void)TID; (void)BID;
    const int tid = TID, wid = __builtin_amdgcn_readfirstlane(tid >> 6), lane = tid & 63, wr = wid >> 2, wc = wid & 3, fr = lane & 15, fq = lane >> 4;
    const int K = g.K, nt = K / BK;
    unsigned voffA[2], voffB[2];
#pragma unroll
    for (int i = 0; i < 2; ++i) { int R, C; stage_rc(tid * 16 + i * 8192, R, C); const int Rb = Epi::PERM ? ((R & ~31) + perm32(R & 31)) : R;
        voffA[i] = (unsigned)(R * K + C) * 2u; voffB[i] = (unsigned)(Rb * K + C) * 2u; }
    const size_t kstep = (size_t)(BK * 2);
    const size_t hstep = (size_t)HALF * K * 2;
    const size_t tstep = 2 * hstep;
    const unsigned ldsw = (unsigned)wid * 1024u;
    const int aoff = lds_byte(wr * 64 + fr, fq * 8), boff = lds_byte(wc * 32 + fr, fq * 8);
#define PG8_SA(b, h) (((b) * 2 + (h)) * HTB)
#define PG8_SB(b, h) ((4 + (b) * 2 + (h)) * HTB)
#define PG8_STAGE(bufoff, gbase, voff) do { _Pragma("unroll") for (int _i = 0; _i < 2; ++_i) \
        __builtin_amdgcn_global_load_lds((const unsigned*)((const char*)(gbase) + (voff)[_i]), (LAS unsigned*)(lds + (bufoff) + ldsw + _i * 8192), 16, 0, 0); } while (0)
#define PG8_LDA(dst, b, h) do { _Pragma("unroll") for (int m = 0; m < 4; ++m) _Pragma("unroll") for (int k = 0; k < 2; ++k) dst[m][k] = *(const LAS bf16x8*)(lds + PG8_SA(b, h) + aoff + m * 2048 + k * 1024); } while (0)
#define PG8_LDB(dst, b, h) do { _Pragma("unroll") for (int n = 0; n < 2; ++n) _Pragma("unroll") for (int k = 0; k < 2; ++k) dst[n][k] = *(const LAS bf16x8*)(lds + PG8_SB(b, h) + boff + n * 2048 + k * 1024); } while (0)
#define PG8_MMA(ai, bj, At, Bt) do { __builtin_amdgcn_s_setprio(1); _Pragma("unroll") for (int m = 0; m < 4; ++m) _Pragma("unroll") for (int n = 0; n < 2; ++n) _Pragma("unroll") for (int k = 0; k < 2; ++k) \
        acc[ai][bj][m][n] = __builtin_amdgcn_mfma_f32_16x16x32_bf16(Bt[n][k], At[m][k], acc[ai][bj][m][n], 0, 0, 0); __builtin_amdgcn_s_setprio(0); } while (0)
#define PG8_WAIT_V(n) asm volatile("s_waitcnt vmcnt(" #n ")" ::: "memory")
#define PG8_WAIT_L(n) asm volatile("s_waitcnt lgkmcnt(" #n ")" ::: "memory")
#define PG8_BAR __builtin_amdgcn_s_barrier()
#define PG8_SCHED __builtin_amdgcn_sched_barrier(0)
    Unit cur, nxt; int ui = 0;
    if (!S.next(0, cur)) return;
    f32x4 acc[2][2][4][2];
#pragma unroll
    for (int a = 0; a < 2; ++a)
#pragma unroll
        for (int b = 0; b < 2; ++b)
#pragma unroll
            for (int m = 0; m < 4; ++m)
#pragma unroll
                for (int n = 0; n < 2; ++n) acc[a][b][m][n] = (f32x4){0.f, 0.f, 0.f, 0.f};
    bf16x8 At[4][2], B0[2][2], B1[2][2];
    const char* cA = (const char*)g.A + (size_t)cur.pm * tstep; const char* cB = (const char*)g.Bt + (size_t)cur.pn * tstep;
    if constexpr (SP2) {
        PG8_STAGE(PG8_SB(0, 0), cB, voffB); PG8_STAGE(PG8_SB(0, 1), cB + hstep, voffB); PG8_STAGE(PG8_SA(0, 0), cA, voffA); PG8_STAGE(PG8_SA(0, 1), cA + hstep, voffA);
        if (wr == 1) PG8_BAR;
        PG8_WAIT_V(2); PG8_BAR;
        PG8_STAGE(PG8_SB(1, 0), cB + kstep, voffB); PG8_STAGE(PG8_SA(1, 0), cA + kstep, voffA); PG8_STAGE(PG8_SB(1, 1), cB + hstep + kstep, voffB);
        PG8_WAIT_V(6); PG8_BAR;
    } else {
        PG8_STAGE(PG8_SB(0, 0), cB, voffB); PG8_STAGE(PG8_SA(0, 0), cA, voffA); PG8_STAGE(PG8_SB(0, 1), cB + hstep, voffB); PG8_STAGE(PG8_SA(0, 1), cA + hstep, voffA);
        if (wr == 1) PG8_BAR;
        PG8_WAIT_V(4); PG8_BAR;
        PG8_STAGE(PG8_SB(1, 0), cB + kstep, voffB); PG8_STAGE(PG8_SA(1, 0), cA + kstep, voffA); PG8_STAGE(PG8_SB(1, 1), cB + hstep + kstep, voffB);
        PG8_WAIT_V(6); PG8_BAR;
    }
    for (;;) {
        const bool has_next = S.next(ui + 1, nxt);
        const char* nA = has_next ? (const char*)g.A + (size_t)nxt.pm * tstep : cA; const char* nB = has_next ? (const char*)g.Bt + (size_t)nxt.pn * tstep : cB;
#pragma unroll 1
        for (int t = 0; t < nt; t += 2) {
            const bool last = (t == nt - 2);
            const char* a1 = cA + (size_t)(t + 1) * kstep;
            const char* a2 = last ? nA : cA + (size_t)(t + 2) * kstep; const char* b2 = last ? nB : cB + (size_t)(t + 2) * kstep;
            const char* a3 = a2 + kstep; const char* b3 = b2 + kstep;
            if constexpr (SP2) {
            PG8_LDB(B0, 0, 0); PG8_LDB(B1, 0, 1); PG8_SCHED; PG8_LDA(At, 0, 0); PG8_STAGE(PG8_SA(1, 1), a1 + hstep, voffA);
            PG8_WAIT_V(8); PG8_WAIT_L(0); PG8_BAR; PG8_MMA(0, 0, At, B0); PG8_MMA(0, 1, At, B1); PG8_BAR; PG8_SCHED;
            PG8_LDA(At, 0, 1); PG8_STAGE(PG8_SB(0, 0), b2, voffB); PG8_STAGE(PG8_SB(0, 1), b2 + hstep, voffB); PG8_STAGE(PG8_SA(0, 0), a2, voffA);
            PG8_WAIT_V(8); PG8_WAIT_L(0); PG8_BAR; PG8_MMA(1, 0, At, B0); PG8_MMA(1, 1, At, B1); PG8_BAR; PG8_SCHED;
            PG8_LDB(B0, 1, 0); PG8_LDB(B1, 1, 1); PG8_SCHED; PG8_LDA(At, 1, 0); PG8_STAGE(PG8_SA(0, 1), a2 + hstep, voffA);
            PG8_WAIT_V(8); PG8_WAIT_L(0); PG8_BAR; PG8_MMA(0, 0, At, B0); PG8_MMA(0, 1, At, B1); PG8_BAR; PG8_SCHED;
            PG8_LDA(At, 1, 1); PG8_STAGE(PG8_SB(1, 0), b3, voffB); PG8_STAGE(PG8_SB(1, 1), b3 + hstep, voffB); PG8_STAGE(PG8_SA(1, 0), a3, voffA);
            PG8_WAIT_V(8); PG8_WAIT_L(0); PG8_BAR; PG8_MMA(1, 0, At, B0); PG8_MMA(1, 1, At, B1); PG8_BAR; PG8_SCHED;
            } else {
            PG8_LDB(B0, 0, 0); PG8_SCHED; PG8_LDA(At, 0, 0); PG8_STAGE(PG8_SA(1, 1), a1 + hstep, voffA);
            PG8_WAIT_L(8); PG8_BAR; PG8_WAIT_L(0); PG8_MMA(0, 0, At, B0); PG8_BAR; PG8_SCHED;
            PG8_LDB(B1, 0, 1); PG8_STAGE(PG8_SB(0, 0), b2, voffB);
            PG8_BAR; PG8_WAIT_L(0); PG8_MMA(0, 1, At, B1); PG8_BAR;
            PG8_LDA(At, 0, 1); PG8_STAGE(PG8_SA(0, 0), a2, voffA);
            PG8_BAR; PG8_WAIT_L(0); PG8_MMA(1, 0, At, B0); PG8_BAR; PG8_SCHED;
            PG8_STAGE(PG8_SB(0, 1), b2 + hstep, voffB);
            PG8_WAIT_V(6); PG8_BAR; PG8_MMA(1, 1, At, B1); PG8_BAR;
            PG8_LDB(B0, 1, 0); PG8_SCHED; PG8_LDA(At, 1, 0); PG8_STAGE(PG8_SA(0, 1), a2 + hstep, voffA);
            PG8_WAIT_L(8); PG8_BAR; PG8_WAIT_L(0); PG8_MMA(0, 0, At, B0); PG8_BAR; PG8_SCHED;
            PG8_LDB(B1, 1, 1); PG8_STAGE(PG8_SB(1, 0), b3, voffB);
            PG8_BAR; PG8_WAIT_L(0); PG8_MMA(0, 1, At, B1); PG8_BAR;
            PG8_LDA(At, 1, 1); PG8_STAGE(PG8_SA(1, 0), a3, voffA);
            PG8_BAR; PG8_WAIT_L(0); PG8_MMA(1, 0, At, B0); PG8_BAR; PG8_SCHED;
            PG8_STAGE(PG8_SB(1, 1), b3 + hstep, voffB);
            PG8_WAIT_V(6); PG8_BAR; PG8_MMA(1, 1, At, B1); PG8_BAR;
            }
        }
        if constexpr (ALIGN_EPI) { if (wr == 0) PG8_BAR; }
        E(acc, cur, wr, wc, fr, fq);
        if (!has_next) break;
#pragma unroll
        for (int a = 0; a < 2; ++a)
#pragma unroll
            for (int b = 0; b < 2; ++b)
#pragma unroll
                for (int m = 0; m < 4; ++m)
#pragma unroll
                    for (int n = 0; n < 2; ++n) acc[a][b][m][n] = (f32x4){0.f, 0.f, 0.f, 0.f};
        cur = nxt; cA = nA; cB = nB; ++ui;
        if constexpr (ALIGN_EPI) { if (wr == 1) PG8_BAR; }
    }
    PG8_WAIT_V(0);
    if constexpr (!ALIGN_EPI) { if (wr == 0) PG8_BAR; }
    PG8_BAR;
#undef PG8_SA
#undef PG8_SB
#undef PG8_STAGE
#undef PG8_LDA
#undef PG8_LDB
#undef PG8_MMA
#undef PG8_WAIT_V
#undef PG8_WAIT_L
#undef PG8_BAR
#undef PG8_SCHED
}

struct EpiSwiGLU {
    static constexpr bool PERM = true;
    bf16_t* H; const float* SS;
    __device__ __forceinline__ void operator()(const f32x4 (&acc)[2][2][4][2], const Unit& u, int wr, int wc, int fr, int fq) const {
        const int row0 = u.pm * BM + wr * 64 + fr, col0 = u.pn * 128 + wc * 32 + 8 * fq;
        float rsv[2][4];
#pragma unroll
        for (int ai = 0; ai < 2; ++ai)
#pragma unroll
            for (int m = 0; m < 4; ++m) rsv[ai][m] = SS[row0 + ai * HALF + m * 16];
#pragma unroll
        for (int ai = 0; ai < 2; ++ai)
#pragma unroll
            for (int m = 0; m < 4; ++m) {
                const float rs = __builtin_amdgcn_rsqf(rsv[ai][m] * (1.0f / D) + 1e-6f);
                const f32x2 rs2 = (f32x2){rs * rs, rs * rs}, ce = (f32x2){-1.44269504089f * rs, -1.44269504089f * rs}, one2 = (f32x2){1.0f, 1.0f};
                float v[8];
#pragma unroll
                for (int n = 0; n < 2; ++n)
#pragma unroll
                    for (int j = 0; j < 4; j += 2) {
                        const f32x2 g2 = (f32x2){acc[ai][0][m][n][j], acc[ai][0][m][n][j + 1]}, u2 = (f32x2){acc[ai][1][m][n][j], acc[ai][1][m][n][j + 1]};
                        const f32x2 t = (g2 * u2) * rs2, x = g2 * ce;
                        const f32x2 d = (f32x2){__builtin_amdgcn_exp2f(x.x), __builtin_amdgcn_exp2f(x.y)} + one2;
                        const f32x2 r = t * (f32x2){__builtin_amdgcn_rcpf(d.x), __builtin_amdgcn_rcpf(d.y)};
                        v[4 * n + j] = r.x; v[4 * n + j + 1] = r.y; }
                *(u32x4*)(H + (size_t)(row0 + ai * HALF + m * 16) * FF + col0) = pack8(v);
            }
    }
};
template <bool HALFSTEP> struct EpiResidual {
    static constexpr bool PERM = false;
    static constexpr float scale = HALFSTEP ? 0.5f : 1.0f;
    const float* base; float* out; bf16_t* XN; float* SS;
    __device__ __forceinline__ void operator()(const f32x4 (&acc)[2][2][4][2], const Unit& u, int wr, int wc, int fr, int fq) const {
        const int row0 = u.pm * BM + wr * 64 + fr, col0 = u.pn * BM + wc * 32 + 4 * fq;
#pragma unroll
        for (int ai = 0; ai < 2; ++ai) {
            f32x4 bv[4][2][2];
#pragma unroll
            for (int m = 0; m < 4; ++m)
#pragma unroll
                for (int bj = 0; bj < 2; ++bj)
#pragma unroll
                    for (int n = 0; n < 2; ++n) bv[m][bj][n] = *(const f32x4*)(base + (size_t)(row0 + ai * HALF + m * 16) * D + col0 + bj * HALF + n * 16);
#pragma unroll
            for (int m = 0; m < 4; ++m) { const int row = row0 + ai * HALF + m * 16; const size_t ro = (size_t)row * D + col0; float ss = 0.f;
#pragma unroll
                for (int bj = 0; bj < 2; ++bj)
#pragma unroll
                    for (int n = 0; n < 2; ++n) { const f32x4 r = bv[m][bj][n] + acc[ai][bj][m][n] * scale; *(f32x4*)(out + ro + bj * HALF + n * 16) = r;
                        if (XN) { u32x2 w; w.x = pk2(r.x, r.y); w.y = pk2(r.z, r.w); *(u32x2*)(XN + ro + bj * HALF + n * 16) = w; ss += (r.x * r.x + r.y * r.y) + (r.z * r.z + r.w * r.w); } }
                if (XN) { ss += __shfl_xor(ss, 16); ss += __shfl_xor(ss, 32); if (fq == 0) atomicAdd(SS + row, ss); } }
        }
    }
};
struct EpiBf16 {
    static constexpr bool PERM = true;
    bf16_t* O; int ldc; const float* SS;
    __device__ __forceinline__ void operator()(const f32x4 (&acc)[2][2][4][2], const Unit& u, int wr, int wc, int fr, int fq) const {
        const int row0 = u.pm * BM + wr * 64 + fr, col0 = u.pn * BM + wc * 32 + 8 * fq;
        float rsv[2][4];
#pragma unroll
        for (int ai = 0; ai < 2; ++ai)
#pragma unroll
            for (int m = 0; m < 4; ++m) rsv[ai][m] = SS[row0 + ai * HALF + m * 16];
#pragma unroll
        for (int ai = 0; ai < 2; ++ai)
#pragma unroll
            for (int m = 0; m < 4; ++m) { bf16_t* rowp = O + (size_t)(row0 + ai * HALF + m * 16) * ldc + col0;
                const float rs = __builtin_amdgcn_rsqf(rsv[ai][m] * (1.0f / D) + 1e-6f);
#pragma unroll
                for (int bj = 0; bj < 2; ++bj) { const f32x4 v0 = acc[ai][bj][m][0] * rs, v1 = acc[ai][bj][m][1] * rs;
                    u32x4 w; w.x = pk2(v0[0], v0[1]); w.y = pk2(v0[2], v0[3]); w.z = pk2(v1[0], v1[1]); w.w = pk2(v1[2], v1[3]);
                    *(u32x4*)(rowp + bj * HALF) = w; } }
    }
};
struct EpiLR {
    static constexpr bool PERM = true;
    bf16_t* O; const float* w0; const float* a0;
    template <int KIND> __device__ __forceinline__ void body(const f32x4 (&acc)[2][2][4][2], const float* bp, int row0, int col0) const {
#pragma unroll
        for (int bj = 0; bj < 2; ++bj) {
            f32x4 b0 = (f32x4){0.f, 0.f, 0.f, 0.f}, b1 = b0;
            if (KIND < 2) { b0 = *(const f32x4*)(bp + bj * HALF); b1 = *(const f32x4*)(bp + bj * HALF + 4); }
#pragma unroll
            for (int ai = 0; ai < 2; ++ai)
#pragma unroll
                for (int m = 0; m < 4; ++m) {
                    u32x4 w;
#pragma unroll
                    for (int n = 0; n < 2; ++n) {
                        float r[4];
#pragma unroll
                        for (int j = 0; j < 4; ++j) { const float x = acc[ai][bj][m][n][j] + (n == 0 ? b0[j] : b1[j]);
                            if (KIND == 0) { const float e = __expf(-x); r[j] = -0.60653065971f * __builtin_amdgcn_rcpf(1.0f + e); }
                            else if (KIND == 1) r[j] = __builtin_amdgcn_rcpf(1.0f + __expf(-x)); else r[j] = x; }
                        if (n == 0) { w.x = pk2(r[0], r[1]); w.y = pk2(r[2], r[3]); } else { w.z = pk2(r[0], r[1]); w.w = pk2(r[2], r[3]); }
                    }
                    *(u32x4*)(O + (size_t)(row0 + ai * HALF + m * 16) * 1536 + col0 + bj * HALF) = w;
                }
        }
    }
    __device__ __forceinline__ void operator()(const f32x4 (&acc)[2][2][4][2], const Unit& u, int wr, int wc, int fr, int fq) const {
        const int row0 = u.pm * BM + wr * 64 + fr, col0 = u.pn * BM + wc * 32 + 8 * fq, kind = u.pn >> 1, f0 = col0 - 512 * kind;
        if (kind == 0) body<0>(acc, w0 + f0, row0, col0); else if (kind == 1) body<1>(acc, a0 + f0, row0, col0); else body<2>(acc, nullptr, row0, col0);
    }
};
struct EpiGLU {
    static constexpr bool PERM = true;
    const bf16_t* Z; bf16_t* Y; const float* b;
    __device__ __forceinline__ void operator()(const f32x4 (&acc)[2][2][4][2], const Unit& u, int wr, int wc, int fr, int fq) const {
        const int row0 = u.pm * BM + wr * 64 + fr, col0 = u.pn * BM + wc * 32 + 8 * fq;
#pragma unroll
        for (int bj = 0; bj < 2; ++bj) {
            const f32x4 bias0 = *(const f32x4*)(b + col0 + bj * HALF), bias1 = *(const f32x4*)(b + col0 + bj * HALF + 4);
            u32x4 zr[2][4];
#pragma unroll
            for (int ai = 0; ai < 2; ++ai)
#pragma unroll
                for (int m = 0; m < 4; ++m) zr[ai][m] = *(const u32x4*)(Z + (size_t)(row0 + ai * HALF + m * 16) * 512 + col0 + bj * HALF);
#pragma unroll
            for (int ai = 0; ai < 2; ++ai)
#pragma unroll
                for (int m = 0; m < 4; ++m) { const size_t r = (size_t)(row0 + ai * HALF + m * 16);
                    float z[8], v[8]; unpack8(zr[ai][m], z);
#pragma unroll
                    for (int n = 0; n < 2; ++n)
#pragma unroll
                        for (int j = 0; j < 4; ++j) v[4 * n + j] = z[4 * n + j] * sigmoidf_(acc[ai][bj][m][n][j] + (n == 0 ? bias0[j] : bias1[j]));
                    *(u32x4*)(Y + r * D + 1024 + col0 + bj * HALF) = pack8(v); }
        }
    }
};
}

template <class Epi> __device__ __forceinline__ void run_gemm(LAS unsigned char* lds, const bf16_t* A, const bf16_t* Bt, int N, int K, const Epi E) {
    pg8::Gemm g; g.A = A; g.Bt = Bt; g.M = T; g.N = N; g.K = K;
    pg8::StaticOrder S; S.init(T, N, gridDim.x, opaque_bid());
    pg8::gemm_phase<Epi>(lds, g, S, E);
}

struct TrItem { const float* W; int ldw, k0, n0; const float* gs; bf16_t* Dst; int ldd, drow0, dk0; };
__device__ __forceinline__ void tr_load(const TrItem& it, f32x4 (&v)[8], int lane) {
    if (it.W) {
#pragma unroll
        for (int i = 0; i < 8; ++i) { const int kk = 8 * i + (lane >> 3); v[i] = *(const f32x4*)(it.W + (size_t)(it.k0 + kk) * it.ldw + it.n0 + 4 * (lane & 7)); }
    } else {
#pragma unroll
        for (int i = 0; i < 8; ++i) v[i] = (f32x4){0.f, 0.f, 0.f, 0.f};
    }
}
__device__ __forceinline__ void tr_finish(const TrItem& it, const f32x4 (&v)[8], LAS float* scr, int lane) {
#pragma unroll
    for (int i = 0; i < 8; ++i) { const int kk = 8 * i + (lane >> 3); f32x4 x = v[i]; if (it.gs) x = x * it.gs[it.k0 + kk];
        LAS float* d = scr + kk * 33 + 4 * (lane & 7); d[0] = x.x; d[1] = x.y; d[2] = x.z; d[3] = x.w; }
    LDS_FENCE();
    const int c = lane & 7;
#pragma unroll
    for (int j = 0; j < 4; ++j) { const int n = (lane >> 3) + 8 * j; const LAS float* s = scr + (8 * c) * 33 + n;
        u32x4 o; o.x = pk2(s[0 * 33], s[1 * 33]); o.y = pk2(s[2 * 33], s[3 * 33]); o.z = pk2(s[4 * 33], s[5 * 33]); o.w = pk2(s[6 * 33], s[7 * 33]);
        *(u32x4*)(it.Dst + (size_t)(it.drow0 + n) * it.ldd + it.dk0 + it.k0 + 8 * c) = o; }
    LDS_FENCE();
}
__device__ __forceinline__ TrItem conv_item(ArgsRef a, int l, int it) {
    unsigned char* ws = a.ws;
    constexpr int I_GU = (D / 64) * (FF / 32), I_DN = (FF / 64) * (D / 32), I_IN = (D / 64) * (DIN / 32), I_OUT = (D / 64) * (D / 32), I_GLU = 8 * 16;
    static_assert(I_GU == I_DN, "items");
    TrItem t; t.gs = nullptr; t.dk0 = 0;
    int r = it;
    if (r < 6 * I_GU) {
        const int which = r / I_GU; r -= which * I_GU;
        const int f = which >= 3, m = which % 3;
        if (m < 2) {
            const int nblk = FF / 32, kb = r / nblk, nb = r % nblk, n0 = 32 * nb;
            t.W = (const float*)a.in[(f ? 36 : 3) + m] + (size_t)l * D * FF; t.ldw = FF; t.k0 = 64 * kb; t.n0 = n0; t.gs = (const float*)a.in[f ? 35 : 2] + (size_t)l * D;
            t.Dst = (bf16_t*)(ws + (f ? W_UP2 : W_UP1)); t.ldd = D; t.drow0 = (n0 >> 7) * 256 + (n0 & 127) + 128 * m;
        } else {
            const int nblk = D / 32, kb = r / nblk, nb = r % nblk;
            t.W = (const float*)a.in[f ? 38 : 5] + (size_t)l * FF * D; t.ldw = D; t.k0 = 64 * kb; t.n0 = 32 * nb; t.Dst = (bf16_t*)(ws + (f ? W_DN2 : W_DN1)); t.ldd = FF; t.drow0 = 32 * nb;
        }
        return t;
    }
    r -= 6 * I_GU;
    if (r < I_IN) { const int nblk = DIN / 32, kb = r / nblk, nb = r % nblk;
        t.W = (const float*)a.in[7] + (size_t)l * D * DIN; t.ldw = DIN; t.k0 = 64 * kb; t.n0 = 32 * nb; t.gs = (const float*)a.in[6] + (size_t)l * D; t.Dst = (bf16_t*)(ws + W_IN); t.ldd = D; t.drow0 = 32 * nb; return t; }
    r -= I_IN;
    if (r < I_OUT) { const int nblk = D / 32, kb = r / nblk, nb = r % nblk;
        t.W = (const float*)a.in[34] + (size_t)l * D * D; t.ldw = D; t.k0 = 64 * kb; t.n0 = 32 * nb; t.Dst = (bf16_t*)(ws + W_OUT); t.ldd = D; t.drow0 = 32 * nb; return t; }
    r -= I_OUT;
    if (r < I_GLU) { const int kb = r / 16, nb = r % 16;
        t.W = (const float*)a.in[30] + (size_t)l * 512 * 512; t.ldw = 512; t.k0 = 64 * kb; t.n0 = 32 * nb; t.Dst = (bf16_t*)(ws + W_GLU); t.ldd = 512; t.drow0 = 32 * nb; return t; }
    r -= I_GLU;
    {
        const int nb = r >> 2, kb = r & 3, kind = nb >> 4, nn0 = 32 * (nb & 15);
        const float* W = nullptr; int k0 = 0;
        if (kind == 0 && kb == 0) { W = (const float*)a.in[10] + (size_t)l * 64 * 512; k0 = 0; }
        else if (kind == 1 && kb == 1) { W = (const float*)a.in[12] + (size_t)l * 64 * 512; k0 = 0; }
        else if (kind == 2 && kb >= 2) { W = (const float*)a.in[13] + (size_t)l * 128 * 512; k0 = 64 * (kb - 2); }
        t.W = W; t.ldw = 512; t.k0 = k0; t.n0 = nn0; t.Dst = (bf16_t*)(ws + W_LR); t.ldd = 256; t.drow0 = 32 * nb; t.dk0 = 64 * kb - k0;
    }
    return t;
}
__device__ __forceinline__ void conv_phase(ArgsRef a, int l, LAS unsigned char* lds) {
    const int TID = opaque_tid(), BID = opaque_bid();
    const int wave = TID >> 6, lane = TID & 63;
    LAS float* scr = (LAS float*)(lds + wave * 8704);
    const int gw = BID * NWAVES + wave, NGW = gridDim.x * NWAVES;
    constexpr int NITEMS = 6 * (D / 64) * (FF / 32) + (D / 64) * (DIN / 32) + (D / 64) * (D / 32) + 8 * 16 + 48 * 4;
    if (gw >= NITEMS) return;
    TrItem cur = conv_item(a, l, gw);
    f32x4 v[8]; tr_load(cur, v, lane);
    for (int it = gw; it < NITEMS; it += NGW) {
        f32x4 w[8];
#pragma unroll
        for (int i = 0; i < 8; ++i) w[i] = v[i];
        const TrItem me = cur;
        if (it + NGW < NITEMS) { cur = conv_item(a, l, it + NGW); tr_load(cur, v, lane); }
        tr_finish(me, w, scr, lane);
    }
}

__device__ __forceinline__ void norm_phase(const float* x, bf16_t* XN, float* SS) {
    const int TID = opaque_tid(), BID = opaque_bid(); (void)TID; (void)BID;
    const int wave = TID >> 6, lane = TID & 63;
    const int gw = BID * NWAVES + wave, NGW = gridDim.x * NWAVES;
    for (int m = gw; m < T; m += NGW) {
        const f32x4* xr = (const f32x4*)(x + (size_t)m * D) + lane;
        f32x4 v[8]; float s = 0.f;
#pragma unroll
        for (int j = 0; j < 8; ++j) { v[j] = xr[64 * j]; s += (v[j].x * v[j].x + v[j].y * v[j].y) + (v[j].z * v[j].z + v[j].w * v[j].w); }
        s = wave_sum(s); if (lane == 0) SS[m] = s;
        u32x2* o = (u32x2*)(XN + (size_t)m * D) + lane;
#pragma unroll
        for (int j = 0; j < 8; ++j) { u32x2 w; w.x = pk2(v[j].x, v[j].y); w.y = pk2(v[j].z, v[j].w); o[64 * j] = w; }
    }
}

__device__ __forceinline__ void zero_phase(float* p, int n) {
    const int TID = opaque_tid(), BID = opaque_bid();
    for (int i = BID * NTHREADS + TID; i < n; i += gridDim.x * NTHREADS) p[i] = 0.f;
}
__device__ __forceinline__ void alr_phase(ArgsRef a, int l) {
    const int TID = opaque_tid(), BID = opaque_bid(); (void)TID; (void)BID;
    const bf16_t* P = (const bf16_t*)(a.ws + WS_PROJ); bf16_t* ALR = (bf16_t*)(a.ws + WS_ALR);
    const float* mu = (const float*)a.in[8] + (size_t)l * 1792 + 1536;
    const int gt = BID * NTHREADS + TID, NGT = gridDim.x * NTHREADS;
    for (int it = gt; it < T * 32; it += NGT) {
        const int t = it >> 5, cg = it & 31, c0 = 8 * cg;
        float cur[8], prv[8], o[8];
        unpack8(*(const u32x4*)(P + (size_t)t * DIN + 1536 + c0), cur);
        if ((t & (SEQ - 1)) != 0) unpack8(*(const u32x4*)(P + (size_t)(t - 1) * DIN + 1536 + c0), prv);
        else {
#pragma unroll
            for (int j = 0; j < 8; ++j) prv[j] = 0.f; }
#pragma unroll
        for (int j = 0; j < 8; ++j) { const float v = cur[j] + (prv[j] - cur[j]) * mu[c0 + j];
            o[j] = c0 < 64 ? tanhf(v) : (c0 < 128 ? v : sigmoidf_(v)); }
        *(u32x4*)(ALR + (size_t)t * 256 + c0) = pack8(o);
    }
}

__device__ __forceinline__ void rwkv_full(ArgsRef a, int l, LAS unsigned char* lds, int job, int tid) {
    const bf16_t* P = (const bf16_t*)(a.ws + WS_PROJ); const bf16_t* LR = (const bf16_t*)(a.ws + WS_LRO); bf16_t* Y = (bf16_t*)(a.ws + WS_YC);
    LAS float* sR = (LAS float*)lds; LAS float* sW = sR + 4096; LAS float* sK = sW + 4096; LAS float* sKK = sK + 4096; LAS float* sB = sKK + 4096;
    LAS float* sV = sB + 4096; LAS float* sO = sV + 4096; LAS float* sBon = sO + 4096;
    const int wave = tid >> 6, lane = tid & 63, tt = tid >> 3, cg = tid & 7;
    const int b = job >> 3, h = job & 7, c0 = 64 * h + 8 * cg;
    float mur[8], muk[8], muv[8], kkw[8], kaw[8], rkw[8], lnw[8], lnb[8];
#pragma unroll
    for (int j = 0; j < 8; ++j) {
        mur[j] = ((const float*)a.in[8])[(size_t)l * 1792 + c0 + j]; muk[j] = ((const float*)a.in[8])[(size_t)l * 1792 + 512 + c0 + j]; muv[j] = ((const float*)a.in[8])[(size_t)l * 1792 + 1024 + c0 + j];
        kkw[j] = ((const float*)a.in[14])[(size_t)l * 512 + c0 + j]; kaw[j] = ((const float*)a.in[15])[(size_t)l * 512 + c0 + j]; rkw[j] = ((const float*)a.in[16])[(size_t)l * 512 + c0 + j];
        lnw[j] = ((const float*)a.in[17])[(size_t)l * 512 + c0 + j]; lnb[j] = ((const float*)a.in[18])[(size_t)l * 512 + c0 + j]; }
    f32x2 st0 = (f32x2){0.f, 0.f}, st1 = st0, st2 = st0, st3 = st0;
    const int row = 8 * wave + (lane >> 3), jq = lane & 7;
    u32x4 graw[9];
    const u32x4 zero4 = (u32x4){0u, 0u, 0u, 0u};
#define RWF_ISSUE(ch_) do { const int s_ = (ch_) * 64 + tt; const size_t t_ = (size_t)b * SEQ + s_; \
        graw[0] = *(const u32x4*)(P + t_ * DIN + c0); graw[1] = *(const u32x4*)(P + t_ * DIN + 512 + c0); graw[2] = *(const u32x4*)(P + t_ * DIN + 1024 + c0); \
        if (s_ != 0) { graw[3] = *(const u32x4*)(P + (t_ - 1) * DIN + c0); graw[4] = *(const u32x4*)(P + (t_ - 1) * DIN + 512 + c0); graw[5] = *(const u32x4*)(P + (t_ - 1) * DIN + 1024 + c0); } \
        else { graw[3] = zero4; graw[4] = zero4; graw[5] = zero4; } \
        graw[6] = *(const u32x4*)(LR + t_ * 1536 + c0); graw[7] = *(const u32x4*)(LR + t_ * 1536 + 512 + c0); graw[8] = *(const u32x4*)(LR + t_ * 1536 + 1024 + c0); } while (0)
    RWF_ISSUE(0);
    for (int ch = 0; ch < SEQ / 64; ++ch) {
        __syncthreads();
        float gate[8];
        {
            float r[8], k[8], v[8], pr[8], ld[8], av[8];
            unpack8(graw[0], r); unpack8(graw[1], k); unpack8(graw[2], v);
            unpack8(graw[3], pr);
#pragma unroll
            for (int j = 0; j < 8; ++j) r[j] += (pr[j] - r[j]) * mur[j];
            unpack8(graw[4], pr);
#pragma unroll
            for (int j = 0; j < 8; ++j) k[j] += (pr[j] - k[j]) * muk[j];
            unpack8(graw[5], pr);
#pragma unroll
            for (int j = 0; j < 8; ++j) v[j] += (pr[j] - v[j]) * muv[j];
            unpack8(graw[6], ld); unpack8(graw[7], av); unpack8(graw[8], gate);
            if (ch + 1 < SEQ / 64) RWF_ISSUE(ch + 1);
            float kk[8], ss = 0.f, bp = 0.f;
#pragma unroll
            for (int j = 0; j < 8; ++j) { kk[j] = k[j] * kkw[j]; ss += kk[j] * kk[j]; }
            ss = red8(ss);
            const float inv = __builtin_amdgcn_rsqf(fmaxf(ss, 1e-24f));
            float w8[8], k8[8], b8[8];
#pragma unroll
            for (int j = 0; j < 8; ++j) { kk[j] *= inv; k8[j] = k[j] * (1.0f + (av[j] - 1.0f) * kaw[j]); b8[j] = kk[j] * av[j]; w8[j] = __expf(ld[j]); bp += r[j] * k8[j] * rkw[j]; }
            bp = red8(bp);
            if (cg == 0) sBon[tt] = bp;
            LAS float* d;
            d = sR + tt * 64 + 8 * cg; *(LAS f32x4*)d = (f32x4){r[0], r[1], r[2], r[3]}; *(LAS f32x4*)(d + 4) = (f32x4){r[4], r[5], r[6], r[7]};
            d = sW + tt * 64 + 8 * cg; *(LAS f32x4*)d = (f32x4){w8[0], w8[1], w8[2], w8[3]}; *(LAS f32x4*)(d + 4) = (f32x4){w8[4], w8[5], w8[6], w8[7]};
            d = sK + tt * 64 + 8 * cg; *(LAS f32x4*)d = (f32x4){k8[0], k8[1], k8[2], k8[3]}; *(LAS f32x4*)(d + 4) = (f32x4){k8[4], k8[5], k8[6], k8[7]};
            d = sKK + tt * 64 + 8 * cg; *(LAS f32x4*)d = (f32x4){kk[0], kk[1], kk[2], kk[3]}; *(LAS f32x4*)(d + 4) = (f32x4){kk[4], kk[5], kk[6], kk[7]};
            d = sB + tt * 64 + 8 * cg; *(LAS f32x4*)d = (f32x4){b8[0], b8[1], b8[2], b8[3]}; *(LAS f32x4*)(d + 4) = (f32x4){b8[4], b8[5], b8[6], b8[7]};
            d = sV + tt * 64 + 8 * cg; *(LAS f32x4*)d = (f32x4){v[0], v[1], v[2], v[3]}; *(LAS f32x4*)(d + 4) = (f32x4){v[4], v[5], v[6], v[7]};
        }
        __syncthreads();
        {
#define RWF_LD(arr, s_) const f32x4 arr##a = *(const LAS f32x4*)(arr + (s_) * 64 + 8 * jq), arr##b = *(const LAS f32x4*)(arr + (s_) * 64 + 8 * jq + 4)
            f32x4 w_a = *(const LAS f32x4*)(sW + 8 * jq), w_b = *(const LAS f32x4*)(sW + 8 * jq + 4), kk_a = *(const LAS f32x4*)(sKK + 8 * jq), kk_b = *(const LAS f32x4*)(sKK + 8 * jq + 4),
                  b_a = *(const LAS f32x4*)(sB + 8 * jq), b_b = *(const LAS f32x4*)(sB + 8 * jq + 4), k_a = *(const LAS f32x4*)(sK + 8 * jq), k_b = *(const LAS f32x4*)(sK + 8 * jq + 4),
                  r_a = *(const LAS f32x4*)(sR + 8 * jq), r_b = *(const LAS f32x4*)(sR + 8 * jq + 4);
            float vi = sV[row];
            f32x2 pyp = (f32x2){0.f, 0.f}; float ykeep = 0.f;
#pragma unroll 1
            for (int s8 = 0; s8 < 64; s8 += 8) {
#pragma unroll
                for (int u = 0; u < 8; ++u) {
                    const int sn = (s8 + u + 1) & 63;
                    RWF_LD(sW, sn); RWF_LD(sKK, sn); RWF_LD(sB, sn); RWF_LD(sK, sn); RWF_LD(sR, sn);
                    const float nvi = sV[sn * 64 + row];
                    f32x2 pa = st0 * (f32x2){kk_a.x, kk_a.y}; pa = pfma(st1, (f32x2){kk_a.z, kk_a.w}, pa); pa = pfma(st2, (f32x2){kk_b.x, kk_b.y}, pa); pa = pfma(st3, (f32x2){kk_b.z, kk_b.w}, pa);
                    float av = pa.x + pa.y, yv = pyp.x + pyp.y;
                    av += dpp<XOR1>(av); yv += dpp<XOR1>(yv); av += dpp<XOR2>(av); yv += dpp<XOR2>(yv); av += dpp<XOR7>(av); yv += dpp<XOR7>(yv);
                    if (u > 0) ykeep = (jq == u - 1) ? yv : ykeep;
                    else if (s8 > 0) { ykeep = (jq == 7) ? yv : ykeep; sO[(s8 - 8 + jq) * 64 + row] = ykeep; }
                    const float sa = -av;
                    const f32x2 sa2 = (f32x2){sa, sa}, vi2 = (f32x2){vi, vi};
                    st0 = pfma(st0, (f32x2){w_a.x, w_a.y}, pfma(vi2, (f32x2){k_a.x, k_a.y}, sa2 * (f32x2){b_a.x, b_a.y}));
                    st1 = pfma(st1, (f32x2){w_a.z, w_a.w}, pfma(vi2, (f32x2){k_a.z, k_a.w}, sa2 * (f32x2){b_a.z, b_a.w}));
                    st2 = pfma(st2, (f32x2){w_b.x, w_b.y}, pfma(vi2, (f32x2){k_b.x, k_b.y}, sa2 * (f32x2){b_b.x, b_b.y}));
                    st3 = pfma(st3, (f32x2){w_b.z, w_b.w}, pfma(vi2, (f32x2){k_b.z, k_b.w}, sa2 * (f32x2){b_b.z, b_b.w}));
                    pyp = st0 * (f32x2){r_a.x, r_a.y}; pyp = pfma(st1, (f32x2){r_a.z, r_a.w}, pyp); pyp = pfma(st2, (f32x2){r_b.x, r_b.y}, pyp); pyp = pfma(st3, (f32x2){r_b.z, r_b.w}, pyp);
                    w_a = sWa; w_b = sWb; kk_a = sKKa; kk_b = sKKb; b_a = sBa; b_b = sBb; k_a = sKa; k_b = sKb; r_a = sRa; r_b = sRb; vi = nvi;
                }
            }
            const float yv = red8(pyp.x + pyp.y);
            ykeep = (jq == 7) ? yv : ykeep; sO[(56 + jq) * 64 + row] = ykeep;
#undef RWF_LD
        }
        __syncthreads();
        {
            const size_t t = (size_t)b * SEQ + ch * 64 + tt;
            const f32x4 o0 = *(const LAS f32x4*)(sO + tt * 64 + 8 * cg), o1 = *(const LAS f32x4*)(sO + tt * 64 + 8 * cg + 4);
            const f32x4 v0 = *(const LAS f32x4*)(sV + tt * 64 + 8 * cg), v1 = *(const LAS f32x4*)(sV + tt * 64 + 8 * cg + 4);
            float o[8] = {o0.x, o0.y, o0.z, o0.w, o1.x, o1.y, o1.z, o1.w}; const float vv[8] = {v0.x, v0.y, v0.z, v0.w, v1.x, v1.y, v1.z, v1.w};
            float sm = 0.f;
#pragma unroll
            for (int j = 0; j < 8; ++j) sm += o[j];
            const float mean = red8(sm) * (1.0f / 64.0f);
            float q = 0.f;
#pragma unroll
            for (int j = 0; j < 8; ++j) { o[j] -= mean; q += o[j] * o[j]; }
            const float rstd = __builtin_amdgcn_rsqf(red8(q) * (1.0f / 64.0f) + 64e-5f);
            const float bon = sBon[tt];
            float y[8];
#pragma unroll
            for (int j = 0; j < 8; ++j) y[j] = (o[j] * rstd * lnw[j] + lnb[j] + bon * vv[j]) * gate[j];
            *(u32x4*)(Y + t * D + c0) = pack8(y);
        }
    }
#undef RWF_ISSUE
}

__device__ __forceinline__ void hgrn_full(ArgsRef a, int l, LAS unsigned char* lds, int job, int tid) {
    const bf16_t* P = (const bf16_t*)(a.ws + WS_PROJ); bf16_t* Y = (bf16_t*)(a.ws + WS_YC);
    LAS float* sQ = (LAS float*)lds; LAS float* sF = sQ + 4096; LAS float* sV = sF + 4096; LAS float* sO = sV + 4096;
    const int wave = tid >> 6, lane = tid & 63, tt = tid >> 3, cg = tid & 7;
    const float* lbp = (const float*)a.in[32];
    const int b = job >> 3, h = job & 7, c0 = 64 * h + 8 * cg;
    float lb[8], gn[8];
#pragma unroll
    for (int j = 0; j < 8; ++j) { lb[j] = (l == 0) ? 0.f : sigmoidf_(lbp[512 + c0 + j] - lbp[c0 + j]); gn[j] = ((const float*)a.in[33])[(size_t)l * 64 + 8 * cg + j]; }
    f32x2 st0 = (f32x2){0.f, 0.f}, st1 = st0, st2 = st0, st3 = st0;
    const int col = 8 * wave + (lane >> 3), dq = lane & 7;
    u32x4 gq, gf, gv, gg;
#define HGF_ISSUE(ch_) do { const size_t t_ = (size_t)b * SEQ + (ch_) * 64 + tt; gq = *(const u32x4*)(P + t_ * DIN + C_HG + c0); gf = *(const u32x4*)(P + t_ * DIN + C_HG + 512 + c0); \
        gv = *(const u32x4*)(P + t_ * DIN + C_HG + 1024 + c0); gg = *(const u32x4*)(P + t_ * DIN + C_HG + 1536 + c0); } while (0)
    HGF_ISSUE(0);
    for (int ch = 0; ch < SEQ / 64; ++ch) {
        __syncthreads();
        float gate[8];
        {
            float q[8], f[8], v[8];
            unpack8(gq, q); unpack8(gf, f); unpack8(gv, v); unpack8(gg, gate);
            if (ch + 1 < SEQ / 64) HGF_ISSUE(ch + 1);
#pragma unroll
            for (int j = 0; j < 8; ++j) { q[j] = siluf_(q[j]) * 0.125f; f[j] = lb[j] + (1.0f - lb[j]) * sigmoidf_(f[j]); }
            LAS float* d;
            d = sQ + tt * 64 + 8 * cg; *(LAS f32x4*)d = (f32x4){q[0], q[1], q[2], q[3]}; *(LAS f32x4*)(d + 4) = (f32x4){q[4], q[5], q[6], q[7]};
            d = sF + tt * 64 + 8 * cg; *(LAS f32x4*)d = (f32x4){f[0], f[1], f[2], f[3]}; *(LAS f32x4*)(d + 4) = (f32x4){f[4], f[5], f[6], f[7]};
            d = sV + tt * 64 + 8 * cg; *(LAS f32x4*)d = (f32x4){v[0], v[1], v[2], v[3]}; *(LAS f32x4*)(d + 4) = (f32x4){v[4], v[5], v[6], v[7]};
        }
        __syncthreads();
        {
            f32x4 f_a = *(const LAS f32x4*)(sF + 8 * dq), f_b = *(const LAS f32x4*)(sF + 8 * dq + 4), q_a = *(const LAS f32x4*)(sQ + 8 * dq), q_b = *(const LAS f32x4*)(sQ + 8 * dq + 4);
            float vi = sV[col];
            float ykeep = 0.f;
#pragma unroll 1
            for (int s8 = 0; s8 < 64; s8 += 8) {
#pragma unroll
                for (int u = 0; u < 8; ++u) {
                    const int sn = (s8 + u + 1) & 63;
                    const f32x4 nf_a = *(const LAS f32x4*)(sF + sn * 64 + 8 * dq), nf_b = *(const LAS f32x4*)(sF + sn * 64 + 8 * dq + 4),
                                nq_a = *(const LAS f32x4*)(sQ + sn * 64 + 8 * dq), nq_b = *(const LAS f32x4*)(sQ + sn * 64 + 8 * dq + 4);
                    const float nvi = sV[sn * 64 + col];
                    const f32x2 vi2 = (f32x2){vi, vi};
                    st0 = pfma((f32x2){f_a.x, f_a.y}, st0 - vi2, vi2); st1 = pfma((f32x2){f_a.z, f_a.w}, st1 - vi2, vi2);
                    st2 = pfma((f32x2){f_b.x, f_b.y}, st2 - vi2, vi2); st3 = pfma((f32x2){f_b.z, f_b.w}, st3 - vi2, vi2);
                    f32x2 py = st0 * (f32x2){q_a.x, q_a.y}; py = pfma(st1, (f32x2){q_a.z, q_a.w}, py); py = pfma(st2, (f32x2){q_b.x, q_b.y}, py); py = pfma(st3, (f32x2){q_b.z, q_b.w}, py);
                    const float y = red8(py.x + py.y);
                    ykeep = (dq == u) ? y : ykeep;
                    f_a = nf_a; f_b = nf_b; q_a = nq_a; q_b = nq_b; vi = nvi;
                }
                sO[(s8 + dq) * 64 + col] = ykeep;
            }
        }
        __syncthreads();
        {
            const size_t t = (size_t)b * SEQ + ch * 64 + tt;
            const f32x4 o0 = *(const LAS f32x4*)(sO + tt * 64 + 8 * cg), o1 = *(const LAS f32x4*)(sO + tt * 64 + 8 * cg + 4);
            const float o[8] = {o0.x, o0.y, o0.z, o0.w, o1.x, o1.y, o1.z, o1.w};
            float q = 0.f;
#pragma unroll
            for (int j = 0; j < 8; ++j) q += o[j] * o[j];
            const float rs = __builtin_amdgcn_rsqf(red8(q) * (1.0f / 64.0f) + 1e-6f);
            float y[8];
#pragma unroll
            for (int j = 0; j < 8; ++j) y[j] = o[j] * rs * gn[j] * siluf_(gate[j]);
            *(u32x4*)(Y + t * D + 1536 + c0) = pack8(y);
        }
    }
#undef HGF_ISSUE
}

__device__ __forceinline__ void attn_phase(ArgsRef a, int l, LAS unsigned char* lds) {
    const int TID = opaque_tid(), BID = opaque_bid();
    const bf16_t* P = (const bf16_t*)(a.ws + WS_PROJ); bf16_t* Y = (bf16_t*)(a.ws + WS_YC);
    const int* pos = (const int*)a.in[1];
    const float* qn = (const float*)a.in[19] + (size_t)l * 64; const float* kn = (const float*)a.in[20] + (size_t)l * 64; const float* sinks = (const float*)a.in[21] + (size_t)l * 8;
    constexpr int KST = 144, VST = 528;
    LAS unsigned char* sK = lds; LAS unsigned char* sVt = sK + 256 * KST; LAS unsigned char* sQ = sVt + 64 * VST; LAS float* sM = (LAS float*)(sQ + 512 * KST);
    const int tid = TID, cg = tid & 7, wave = tid >> 6, lane = tid & 63;
    float kmaxg = 0.f;
    for (int j = 0; j < 64; ++j) kmaxg = fmaxf(kmaxg, fabsf(kn[j]));
    const float kbound = 8.0f * kmaxg;
    float gk[8], gq[8], invf[8];
#pragma unroll
    for (int j = 0; j < 8; ++j) { gk[j] = kn[8 * cg + j]; gq[j] = qn[8 * cg + j]; invf[j] = exp2f(-(float)j * (18.931568569324174f / 8.0f)); }
    for (int job = BID; job < 512; job += gridDim.x) {
        const int b = job >> 5, nb = (job >> 1) & 15, kvh = job & 1;
        __syncthreads();
#pragma unroll 1
        for (int r = 0; r < 4; ++r) {
            const int kj = (tid >> 3) + 64 * r, s = (nb - 1) * 128 + kj;
            float k[8], v[8];
            if (s >= 0) {
                const size_t t = (size_t)b * SEQ + s;
                unpack8(*(const u32x4*)(P + t * DIN + C_ATT + 512 + 64 * kvh + 8 * cg), k); unpack8(*(const u32x4*)(P + t * DIN + C_ATT + 640 + 64 * kvh + 8 * cg), v);
            } else {
#pragma unroll
                for (int j = 0; j < 8; ++j) { k[j] = 0.f; v[j] = 0.f; } }
            float ss = 0.f;
#pragma unroll
            for (int j = 0; j < 8; ++j) ss += k[j] * k[j];
            ss = red8(ss);
            const float rs = __builtin_amdgcn_rsqf(ss * (1.0f / 64.0f) + 1e-6f);
#pragma unroll
            for (int j = 0; j < 8; ++j) k[j] = k[j] * rs * gk[j];
            const float pf = (float)pos[b * SEQ + (s >= 0 ? s : 0)];
#pragma unroll
            for (int j = 0; j < 8; ++j) {
                const float other = dpp<XOR1>(k[j]);
                if (cg < 2) { float sn, cs; sincos_big(pf * invf[j], sn, cs); k[j] = (cg == 0) ? (k[j] * cs - other * sn) : (k[j] * cs + other * sn); }
            }
            *(LAS u32x4*)(sK + kj * KST + 16 * cg) = pack8(k);
#pragma unroll
            for (int j = 0; j < 8; j += 2) { const unsigned w = pk2(v[j], v[j + 1]);
                *(LAS unsigned short*)(sVt + (8 * cg + j) * VST + 2 * kj) = (unsigned short)(w & 0xffffu); *(LAS unsigned short*)(sVt + (8 * cg + j + 1) * VST + 2 * kj) = (unsigned short)(w >> 16); }
        }
#pragma unroll 1
        for (int r = 0; r < 8; ++r) {
            const int row = (tid >> 3) + 64 * r, g = row >> 7, qi = row & 127, hq = 4 * kvh + g;
            const size_t tq = (size_t)b * SEQ + nb * 128 + qi;
            float q[8];
            unpack8(*(const u32x4*)(P + tq * DIN + C_ATT + 64 * hq + 8 * cg), q);
            float ss = 0.f;
#pragma unroll
            for (int j = 0; j < 8; ++j) ss += q[j] * q[j];
            ss = red8(ss);
            const float rs = 0.125f * __builtin_amdgcn_rsqf(ss * (1.0f / 64.0f) + 1e-6f);
#pragma unroll
            for (int j = 0; j < 8; ++j) q[j] = q[j] * rs * gq[j];
            const float pf = (float)pos[b * SEQ + nb * 128 + qi];
            float qq = 0.f;
#pragma unroll
            for (int j = 0; j < 8; ++j) {
                const float other = dpp<XOR1>(q[j]);
                if (cg < 2) { float sn, cs; sincos_big(pf * invf[j], sn, cs); q[j] = (cg == 0) ? (q[j] * cs - other * sn) : (q[j] * cs + other * sn); }
                qq += q[j] * q[j];
            }
            qq = red8(qq);
            if (cg == 0) sM[row] = sqrtf(qq) * kbound;
            *(LAS u32x4*)(sQ + row * KST + 16 * cg) = pack8(q);
        }
        __syncthreads();
        const int g = wave >> 1, qh = wave & 1, hq = 4 * kvh + g, fr = lane & 15, fq = lane >> 4;
        const float sinkv = sinks[hq];
#pragma unroll 1
        for (int qt = 0; qt < 4; ++qt) {
            const int qi0 = 64 * qh + 16 * qt, R0 = g * 128 + qi0, kt0 = qi0 >> 4;
            const bf16x8 qf0 = *(const LAS bf16x8*)(sQ + (R0 + fr) * KST + 16 * fq), qf1 = *(const LAS bf16x8*)(sQ + (R0 + fr) * KST + 16 * fq + 64);
            const float msh = sM[R0 + fr];
            const int ql = qi0 + fr;
            f32x4 oacc[4];
#pragma unroll
            for (int dt = 0; dt < 4; ++dt) oacc[dt] = (f32x4){0.f, 0.f, 0.f, 0.f};
            float lsum = 0.f;
#pragma unroll
            for (int ks = 0; ks < 5; ++ks) {
                unsigned pw[4];
#pragma unroll
                for (int h2 = 0; h2 < 2; ++h2) {
                    const int ti = 2 * ks + h2, kt = (kt0 + ti) < 15 ? (kt0 + ti) : 15;
                    const bf16x8 kf0 = *(const LAS bf16x8*)(sK + (16 * kt + fr) * KST + 16 * fq), kf1 = *(const LAS bf16x8*)(sK + (16 * kt + fr) * KST + 16 * fq + 64);
                    f32x4 sc = (f32x4){0.f, 0.f, 0.f, 0.f};
                    sc = __builtin_amdgcn_mfma_f32_16x16x32_bf16(kf0, qf0, sc, 0, 0, 0);
                    sc = __builtin_amdgcn_mfma_f32_16x16x32_bf16(kf1, qf1, sc, 0, 0, 0);
                    float p[4];
#pragma unroll
                    for (int j = 0; j < 4; ++j) { const int kj = 16 * (kt0 + ti) + 4 * fq + j;
                        const bool valid = (kj > ql) && (kj <= ql + 128) && (nb > 0 || kj >= 128);
                        p[j] = valid ? __expf(sc[j] - msh) : 0.f; lsum += p[j]; }
                    pw[2 * h2] = pk2(p[0], p[1]); pw[2 * h2 + 1] = pk2(p[2], p[3]);
                }
                const u32x4 pq = (u32x4){pw[0], pw[1], pw[2], pw[3]};
                const bf16x8 pf = __builtin_bit_cast(bf16x8, pq);
                const int kta = (kt0 + 2 * ks) < 15 ? (kt0 + 2 * ks) : 15, ktb = (kt0 + 2 * ks + 1) < 15 ? (kt0 + 2 * ks + 1) : 15;
#pragma unroll
                for (int dt = 0; dt < 4; ++dt) {
                    const u32x2 va = *(const LAS u32x2*)(sVt + (16 * dt + fr) * VST + (16 * kta + 4 * fq) * 2), vb = *(const LAS u32x2*)(sVt + (16 * dt + fr) * VST + (16 * ktb + 4 * fq) * 2);
                    const u32x4 vq = (u32x4){va.x, va.y, vb.x, vb.y};
                    oacc[dt] = __builtin_amdgcn_mfma_f32_16x16x32_bf16(__builtin_bit_cast(bf16x8, vq), pf, oacc[dt], 0, 0, 0);
                }
            }
            lsum += __shfl_xor(lsum, 16); lsum += __shfl_xor(lsum, 32);
            const float inv = __builtin_amdgcn_rcpf(lsum + __expf(sinkv - msh));
            const size_t tq = (size_t)b * SEQ + nb * 128 + ql;
#pragma unroll
            for (int dt = 0; dt < 4; ++dt) { u32x2 w; w.x = pk2(oacc[dt][0] * inv, oacc[dt][1] * inv); w.y = pk2(oacc[dt][2] * inv, oacc[dt][3] * inv);
                *(u32x2*)(Y + tq * D + 512 + 64 * hq + 16 * dt + 4 * fq) = w; }
        }
    }
    __syncthreads();
}

__device__ __forceinline__ float gelu_erf(float v) {
    const float t = __builtin_amdgcn_rcpf(fabsf(v) * 0.2316418882f + 1.0f);
    float q = t * 0.5307027145f + (-0.7265760135f); q = q * t + 0.7107068705f; q = q * t + (-0.142248368f); q = q * t + 0.127414796f; q = q * t;
    const float e = __builtin_amdgcn_exp2f(v * v * (-0.72134752044f));
    const float m = v * (q * e);
    return v < 0.f ? m : v - m;
}
__device__ __forceinline__ void s5_jobs(ArgsRef a, int l, LAS unsigned char* lds, unsigned* qctr) {
    const int TID = opaque_tid();
    LAS int* sJob = (LAS int*)(lds + 8 * 16 * 130 * 4 + 4096);
    const bf16_t* P = (const bf16_t*)(a.ws + WS_PROJ); bf16_t* Z = (bf16_t*)(a.ws + WS_Z);
    const int tid = TID, wave = tid >> 6, lane = tid & 63, fr16 = lane & 15, fq = lane >> 4;
    LAS float* sX = (LAS float*)lds + wave * (16 * 130);
    LAS float* sE = (LAS float*)lds + 8 * 16 * 130;
    for (;;) {
        if (TID == 0) *sJob = (int)__hip_atomic_fetch_add(qctr, 1u, __ATOMIC_RELAXED, __HIP_MEMORY_SCOPE_AGENT);
        __syncthreads();
        const int job = *sJob;
        if (job >= 512) break;
        const int b = job >> 5, g = job & 31;
        const float dt = expf(((const float*)a.in[24])[l * 32 + g]);
        float lbr, lbi;
        { const float lre = ((const float*)a.in[22])[(size_t)l * 2048 + g * 64 + lane], lim = ((const float*)a.in[23])[(size_t)l * 2048 + g * 64 + lane];
          float sn, cs; sincos_big(lim * dt, sn, cs); const float er = expf(lre * dt); lbr = er * cs; lbi = er * sn; }
        bf16x8 bfrag[8];
#pragma unroll
        for (int k = 0; k < 4; ++k) {
            const int p = fr16 + 16 * k;
            const float lre = ((const float*)a.in[22])[(size_t)l * 2048 + g * 64 + p], lim = ((const float*)a.in[23])[(size_t)l * 2048 + g * 64 + p];
            float sn, cs; sincos_big(lim * dt, sn, cs); const float er = expf(lre * dt), pbr = er * cs, pbi = er * sn;
            const float den = __builtin_amdgcn_rcpf(lre * lre + lim * lim);
            const float fr = ((pbr - 1.0f) * lre + pbi * lim) * den, fi = (pbi * lre - (pbr - 1.0f) * lim) * den;
            const float* brp = (const float*)a.in[25] + ((size_t)l * 2048 + g * 64 + p) * 16 + 8 * (fq & 1);
            const float* bip = (const float*)a.in[26] + ((size_t)l * 2048 + g * 64 + p) * 16 + 8 * (fq & 1);
            float vr[8], vi[8];
#pragma unroll
            for (int i = 0; i < 8; ++i) { const float br = brp[i], bi = bip[i]; float xr = fr * br - fi * bi, xi = fr * bi + fi * br;
                const unsigned hw = pk2(xr, xi);
                if (fq >= 2) { xr -= bflo(hw); xi -= bfhi(hw); }
                vr[i] = xr; vi[i] = xi; }
            bfrag[k] = __builtin_bit_cast(bf16x8, pack8(vr)); bfrag[4 + k] = __builtin_bit_cast(bf16x8, pack8(vi));
        }
        float creg[32];
        {
            const float* cre = (const float*)a.in[27] + ((size_t)l * 32 + g) * 1024 + fr16 * 64 + fq;
            const float* cim = (const float*)a.in[28] + ((size_t)l * 32 + g) * 1024 + fr16 * 64 + fq;
#pragma unroll
            for (int kk = 0; kk < 16; ++kk) { creg[kk] = cre[4 * kk]; creg[16 + kk] = -cim[4 * kk]; }
        }
        f32x4 dsk;
        { const float* dp = (const float*)a.in[29] + (size_t)l * 512 + 16 * g + 4 * fq; dsk = (f32x4){dp[0], dp[1], dp[2], dp[3]}; }
        const size_t tbase = (size_t)b * SEQ + wave * 256;
        const bf16_t* ua = P + (tbase + fr16) * DIN + C_S5 + 16 * g + 8 * (fq & 1);
        const bf16_t* ue = P + (tbase + fr16) * DIN + C_S5 + 16 * g + 4 * fq;
        f32x2 xs = (f32x2){0.f, 0.f}; const f32x2 lbr2 = (f32x2){lbr, lbr}, lbi2 = (f32x2){lbi, lbi};
        {
            u32x4 au = *(const u32x4*)ua;
#pragma unroll 1
            for (int gi = 0; gi < 16; ++gi) {
                const bf16x8 af = __builtin_bit_cast(bf16x8, au);
                if (gi + 1 < 16) au = *(const u32x4*)(ua + (size_t)(gi + 1) * 16 * DIN);
#pragma unroll
                for (int nt = 0; nt < 8; ++nt) { const f32x4 d = __builtin_amdgcn_mfma_f32_16x16x32_bf16(af, bfrag[nt], (f32x4){0.f, 0.f, 0.f, 0.f}, 0, 0, 0);
#pragma unroll
                    for (int j = 0; j < 4; ++j) sX[(4 * fq + j) * 130 + fr16 + 16 * nt] = d[j]; }
                LDS_FENCE();
#pragma unroll
                for (int s = 0; s < 16; ++s) { const f32x2 bu = (f32x2){sX[s * 130 + lane], sX[s * 130 + 64 + lane]};
                    const f32x2 nx = pfma(lbr2, xs, bu); xs = pfma(lbi2, (f32x2){-xs.y, xs.x}, nx); }
                LDS_FENCE();
            }
        }
        sE[wave * 128 + lane] = xs.x; sE[wave * 128 + 64 + lane] = xs.y;
        float pr = lbr, pi = lbi;
#pragma unroll
        for (int i = 0; i < 8; ++i) { const float nr = pr * pr - pi * pi, ni = 2.0f * pr * pi; pr = nr; pi = ni; }
        __syncthreads();
        xs = (f32x2){0.f, 0.f};
        for (int w = 0; w < wave; ++w) { const float er_ = sE[w * 128 + lane], ei_ = sE[w * 128 + 64 + lane];
            const float nr = pr * xs.x - pi * xs.y + er_, ni = pr * xs.y + pi * xs.x + ei_; xs.x = nr; xs.y = ni; }
        {
            u32x4 au = *(const u32x4*)ua; u32x2 eu = *(const u32x2*)ue;
#pragma unroll 1
            for (int gi = 0; gi < 16; ++gi) {
                const bf16x8 af = __builtin_bit_cast(bf16x8, au); const u32x2 eun = eu;
                if (gi + 1 < 16) { au = *(const u32x4*)(ua + (size_t)(gi + 1) * 16 * DIN); eu = *(const u32x2*)(ue + (size_t)(gi + 1) * 16 * DIN); }
#pragma unroll
                for (int nt = 0; nt < 8; ++nt) { const f32x4 d = __builtin_amdgcn_mfma_f32_16x16x32_bf16(af, bfrag[nt], (f32x4){0.f, 0.f, 0.f, 0.f}, 0, 0, 0);
#pragma unroll
                    for (int j = 0; j < 4; ++j) sX[(4 * fq + j) * 130 + fr16 + 16 * nt] = d[j]; }
                LDS_FENCE();
#pragma unroll
                for (int s = 0; s < 16; ++s) { const f32x2 bu = (f32x2){sX[s * 130 + lane], sX[s * 130 + 64 + lane]};
                    const f32x2 nx = pfma(lbr2, xs, bu); xs = pfma(lbi2, (f32x2){-xs.y, xs.x}, nx);
                    sX[s * 130 + lane] = xs.x; sX[s * 130 + 64 + lane] = xs.y; }
                LDS_FENCE();
                f32x4 yacc = (f32x4){0.f, 0.f, 0.f, 0.f}, yacc1 = yacc, yacc2 = yacc, yacc3 = yacc;
                const LAS float* xp = sX + fr16 * 130 + fq;
#pragma unroll
                for (int kk = 0; kk < 32; kk += 4) {
                    yacc = __builtin_amdgcn_mfma_f32_16x16x4f32(creg[kk], xp[4 * kk], yacc, 0, 0, 0);
                    yacc1 = __builtin_amdgcn_mfma_f32_16x16x4f32(creg[kk + 1], xp[4 * kk + 4], yacc1, 0, 0, 0);
                    yacc2 = __builtin_amdgcn_mfma_f32_16x16x4f32(creg[kk + 2], xp[4 * kk + 8], yacc2, 0, 0, 0);
                    yacc3 = __builtin_amdgcn_mfma_f32_16x16x4f32(creg[kk + 3], xp[4 * kk + 12], yacc3, 0, 0, 0);
                }
                yacc = (yacc + yacc1) + (yacc2 + yacc3);
                const float u0 = bflo(eun.x), u1 = bfhi(eun.x), u2 = bflo(eun.y), u3 = bfhi(eun.y);
                const float z0 = gelu_erf(yacc[0] + dsk[0] * u0), z1 = gelu_erf(yacc[1] + dsk[1] * u1), z2 = gelu_erf(yacc[2] + dsk[2] * u2), z3 = gelu_erf(yacc[3] + dsk[3] * u3);
                u32x2 w; w.x = pk2(z0, z1); w.y = pk2(z2, z3);
                *(u32x2*)(Z + (tbase + gi * 16 + fr16) * 512 + 16 * g + 4 * fq) = w;
                LDS_FENCE();
            }
        }
        __syncthreads();
    }
}

__device__ __forceinline__ void scan_phase(ArgsRef a, int l, LAS unsigned char* lds) {
    const int TID = opaque_tid(), BID = opaque_bid();
    if (gridDim.x == 256) {
        if (BID < 128) rwkv_full(a, l, lds, BID, TID); else hgrn_full(a, l, lds, BID - 128, TID);
    } else {
        for (int job = BID; job < 256; job += gridDim.x) { if (job < 128) rwkv_full(a, l, lds, job, TID); else hgrn_full(a, l, lds, job - 128, TID); __syncthreads(); }
    }
    __syncthreads();
    s5_jobs(a, l, lds, (unsigned*)(a.ws + WS_BAR) + 3584 + 64 * l);
    __syncthreads();
}

#define XB_TMO      128
#define XB_XCNT(j)  (256  + 64 * (j))
#define XB_XSUB(j)  (1280 + 64 * (j))
#define XB_XGEN(j)  (2304 + 64 * (j))
#define XB_TOP      3328
#define XB_TOPGEN   3392
#define XCD_BAR_WORDS 3456
#define XB_SPIN_CAP (1u << 18)

__device__ __forceinline__ unsigned xb_ld(unsigned* p)              { return __hip_atomic_load(p, __ATOMIC_RELAXED, __HIP_MEMORY_SCOPE_AGENT); }
__device__ __forceinline__ unsigned xb_add(unsigned* p, unsigned v) { return __hip_atomic_fetch_add(p, v, __ATOMIC_RELAXED, __HIP_MEMORY_SCOPE_AGENT); }
__device__ __forceinline__ unsigned xb_xcc_id() { return (unsigned)__builtin_amdgcn_s_getreg((3 << 11) | 20) & 0xFu; }
#define XB_SPIN(cond, bar) do { unsigned _sp = 0; while (cond) { __builtin_amdgcn_s_sleep(1); \
    if ((++_sp & 255u) == 0u) { if (xb_ld(&(bar)[XB_TMO])) break; if (_sp > XB_SPIN_CAP) { atomicAdd(&(bar)[XB_TMO], 1u); break; } } } } while (0)

struct XcdBarrier {
    unsigned* bar; unsigned x;
    volatile LAS unsigned* st;
};

__device__ __forceinline__ XcdBarrier xcd_barrier_post(unsigned* bar, volatile LAS unsigned* st) {
    XcdBarrier b; b.bar = bar; b.x = xb_xcc_id(); b.st = st;
    if (threadIdx.x == 0) (void)xb_add(&bar[XB_XCNT(b.x)], 1u);
    return b;
}
__device__ __forceinline__ void xcd_barrier_complete(unsigned* bar, unsigned x, unsigned& nloc, unsigned& nx) {
    const unsigned G = gridDim.x * gridDim.y * gridDim.z;
    unsigned sum, cnt, mine, sp = 0u;
    for (;;) {
        sum = 0u; cnt = 0u; mine = 0u;
#pragma unroll
        for (unsigned j = 0; j < 16; ++j) { const unsigned c = xb_ld(&bar[XB_XCNT(j)]); sum += c; cnt += (c > 0u) ? 1u : 0u; mine = (j == x) ? c : mine; }
        if (sum == G) break;
        __builtin_amdgcn_s_sleep(1);
        if ((++sp & 255u) == 0u) { if (xb_ld(&bar[XB_TMO])) break; if (sp > XB_SPIN_CAP) { atomicAdd(&bar[XB_TMO], 1u); break; } }
    }
    nloc = mine > 0u ? mine : 1u; nx = cnt > 0u ? cnt : 1u;
}

__device__ __forceinline__ void xcd_barrier(const XcdBarrier& b) {
    asm volatile("s_waitcnt vmcnt(0)" ::: "memory");
    __syncthreads();
    if (threadIdx.x == 0) {
        unsigned* bar = b.bar;
        __builtin_amdgcn_s_waitcnt(0);
        unsigned nloc = b.st[0], nx = b.st[1];
        if (nloc == 0u) { xcd_barrier_complete(bar, b.x, nloc, nx); b.st[0] = nloc; b.st[1] = nx; }
        const unsigned old = xb_add(&bar[XB_XSUB(b.x)], 1u);
        const unsigned gen = old / nloc;
        if (old + 1u == (gen + 1u) * nloc) {
            __builtin_amdgcn_fence(__ATOMIC_RELEASE, "agent");
            asm volatile("s_waitcnt vmcnt(0)" ::: "memory");
            const unsigned og = xb_add(&bar[XB_TOP], 1u);
            const unsigned tg = og / nx;
            if (og + 1u == (tg + 1u) * nx) xb_add(&bar[XB_TOPGEN], 1u);
            else XB_SPIN(xb_ld(&bar[XB_TOPGEN]) == tg, bar);
            __builtin_amdgcn_fence(__ATOMIC_ACQUIRE, "agent");
            xb_add(&bar[XB_XGEN(b.x)], 1u);
            asm volatile("s_waitcnt vmcnt(0)" ::: "memory");
        } else {
            XB_SPIN(xb_ld(&bar[XB_XGEN(b.x)]) == gen, bar);
            __builtin_amdgcn_fence(__ATOMIC_ACQUIRE, "agent");
            asm volatile("s_waitcnt vmcnt(0)" ::: "memory");
        }
    }
    __syncthreads();
}


constexpr int NPH = 11;
#ifndef DUPMASK
#define DUPMASK 0
#endif
__global__ void __launch_bounds__(NTHREADS, 2) mega(Args a_, int lo, int hi) {
    extern __shared__ __attribute__((aligned(16))) unsigned char lds_raw[];
    LAS unsigned char* lds = (LAS unsigned char*)lds_raw;
#ifdef EXTRA_SYNCS
    for (int i = 0; i < EXTRA_SYNCS; ++i) { __syncthreads(); cg::this_grid().sync(); }
#endif
    LAS unsigned* xst = (LAS unsigned*)(lds + LDS_BYTES - 16);
    if (hi - lo > 1) {
        if (threadIdx.x == 0) { xst[0] = 0u; xst[1] = 0u; }
        __syncthreads();
        if (blockIdx.x == 0) {
            const __attribute__((address_space(4))) Args* ap0 = (const __attribute__((address_space(4))) Args*)__builtin_amdgcn_kernarg_segment_ptr();
            unsigned* bw = (unsigned*)(ap0->ws + WS_BAR);
            for (int i = threadIdx.x; i < 4096; i += NTHREADS) bw[i] = 0u;
        }
    }
#pragma unroll 1
    for (int step2 = 2 * lo; step2 < 2 * hi; ++step2) {
        const int step = step2 >> 1;
        if ((step2 & 1) && !((DUPMASK >> (step % NPH)) & 1)) continue;
        const __attribute__((address_space(4))) Args* ap = (const __attribute__((address_space(4))) Args*)__builtin_amdgcn_kernarg_segment_ptr();
        asm volatile("" : "+s"(ap));
        ArgsRef a = *ap;
        unsigned char* ws = a.ws;
        float* SSa = (float*)(ws + WS_SS); float* SSb = SSa + T; float* SSc = SSb + T;
        const int l = step / NPH, ph = step % NPH;
        const float* xin = (l == 0) ? (const float*)a.in[0] : (const float*)a.out;
#ifndef PHMASK
#define PHMASK 0x7ff
#endif
        switch (ph) {
        case 0: if (PHMASK & (1 << 0)) { conv_phase(a, l, lds); if (l == 0) norm_phase(xin, (bf16_t*)(ws + WS_XN), SSa); zero_phase(SSb, T); } break;
        case 1: if (PHMASK & (1 << 1)) { pg8::EpiSwiGLU E; E.H = (bf16_t*)(ws + WS_HID); E.SS = SSa; run_gemm(lds, (const bf16_t*)(ws + WS_XN), (const bf16_t*)(ws + W_UP1), 2 * FF, D, E); } break;
        case 2: if (PHMASK & (1 << 2)) { pg8::EpiResidual<true> E; E.base = xin; E.out = a.out; E.XN = (bf16_t*)(ws + WS_XN); E.SS = SSb; run_gemm(lds, (const bf16_t*)(ws + WS_HID), (const bf16_t*)(ws + W_DN1), D, FF, E); } break;
        case 3: if (PHMASK & (1 << 3)) { pg8::EpiBf16 E; E.O = (bf16_t*)(ws + WS_PROJ); E.ldc = DIN; E.SS = SSb; run_gemm(lds, (const bf16_t*)(ws + WS_XN), (const bf16_t*)(ws + W_IN), DIN, D, E); } break;
        case 4: if (PHMASK & (1 << 4)) { zero_phase(SSa, T); zero_phase(SSc, T); alr_phase(a, l); attn_phase(a, l, lds); } break;
        case 5: if (PHMASK & (1 << 5)) { pg8::EpiLR E; E.O = (bf16_t*)(ws + WS_LRO); E.w0 = (const float*)a.in[9] + (size_t)l * 512; E.a0 = (const float*)a.in[11] + (size_t)l * 512;
                  run_gemm(lds, (const bf16_t*)(ws + WS_ALR), (const bf16_t*)(ws + W_LR), 1536, 256, E); } break;
        case 6: if (PHMASK & (1 << 6)) scan_phase(a, l, lds); break;
        case 7: if (PHMASK & (1 << 7)) { pg8::EpiGLU G; G.Z = (const bf16_t*)(ws + WS_Z); G.Y = (bf16_t*)(ws + WS_YC); G.b = (const float*)a.in[31] + (size_t)l * 512;
                  run_gemm(lds, (const bf16_t*)(ws + WS_Z), (const bf16_t*)(ws + W_GLU), 512, 512, G); } break;
        case 8: if (PHMASK & (1 << 8)) { pg8::EpiResidual<false> E; E.base = a.out; E.out = a.out; E.XN = (bf16_t*)(ws + WS_XN); E.SS = SSc; run_gemm(lds, (const bf16_t*)(ws + WS_YC), (const bf16_t*)(ws + W_OUT), D, D, E); } break;
        case 9: if (PHMASK & (1 << 9)) { pg8::EpiSwiGLU E; E.H = (bf16_t*)(ws + WS_HID); E.SS = SSc; run_gemm(lds, (const bf16_t*)(ws + WS_XN), (const bf16_t*)(ws + W_UP2), 2 * FF, D, E); } break;
        case 10: if (PHMASK & (1 << 10)) { pg8::EpiResidual<true> E; E.base = a.out; E.out = a.out; E.XN = (l + 1 < NL) ? (bf16_t*)(ws + WS_XN) : nullptr; E.SS = SSa; run_gemm(lds, (const bf16_t*)(ws + WS_HID), (const bf16_t*)(ws + W_DN2), D, FF, E); } break;
        }
        if ((step2 + 2 < 2 * hi) || (((step2 & 1) == 0) && ((DUPMASK >> ((step2 >> 1) % NPH)) & 1))) {
            if (step2 == 2 * lo) { __syncthreads(); cg::this_grid().sync(); (void)xcd_barrier_post((unsigned*)(ws + WS_BAR), (volatile LAS unsigned*)xst); }
            else { XcdBarrier xb; xb.bar = (unsigned*)(ws + WS_BAR); xb.x = xb_xcc_id(); xb.st = (volatile LAS unsigned*)xst; xcd_barrier(xb); }
        }
    }
}

extern "C" void kernel_launch(void* const* d_in, const int* in_sizes, int n_in, void* d_out, int out_size, void* d_ws, size_t ws_size, hipStream_t stream) {
    static int grid = 0;
    if (!grid) {
        int dev = 0, cus = 0, per_cu = 0;
        hipGetDevice(&dev);
        hipDeviceGetAttribute(&cus, hipDeviceAttributeMultiprocessorCount, dev);
        hipFuncSetAttribute((const void*)mega, hipFuncAttributeMaxDynamicSharedMemorySize, LDS_BYTES);
        hipOccupancyMaxActiveBlocksPerMultiprocessor(&per_cu, (const void*)mega, NTHREADS, LDS_BYTES);
        if (per_cu < 1) per_cu = 1;
        grid = cus * 1;
        if (grid != 256) fprintf(stderr, "kernel_launch: grid %d (cus %d, per_cu %d)\n", grid, cus, per_cu);
    }
    Args a{};
    for (int i = 0; i < 39; ++i) a.in[i] = d_in[i];
    a.out = (float*)d_out; a.ws = (unsigned char*)d_ws;
#if ONE_LAUNCH
    int lo = 0, hi = NL * NPH;
    void* args[] = {&a, &lo, &hi};
    hipError_t e = hipLaunchCooperativeKernel((void*)mega, dim3(grid), dim3(NTHREADS), args, LDS_BYTES, stream);
    if (e != hipSuccess) fprintf(stderr, "cooperative launch failed: %s (grid %d)\n", hipGetErrorString(e), grid);
#else
    for (int s = 0; s < NL * NPH; ++s) hipLaunchKernelGGL(mega, dim3(grid), dim3(NTHREADS), LDS_BYTES, stream, a, s, s + 1);
#endif
}
```
